# Optimizing an MI355X kernel written in HIP

```python
import jax
import jax.numpy as jnp
from jax import lax
import numpy as np

D_MODEL = 1024
BATCH = 16
SEQ = 4096
DEPTH = 1

D_MIX = D_MODEL
NORM_EPS = 1e-6

RWKV_HEADS = 8
RWKV_HEAD_DIM = 64
D_RWKV = RWKV_HEADS * RWKV_HEAD_DIM
DECAY_LORA = 32
ICLR_LORA = 32
GATE_LORA = 96
GN_EPS = 64e-5
RWKV_IN_SIZES = (D_RWKV, D_RWKV, D_RWKV, DECAY_LORA, ICLR_LORA, GATE_LORA)
D_RWKV_IN = sum(RWKV_IN_SIZES)

MLA_HEADS = 8
QK_NOPE_DIM = 64
QK_ROPE_DIM = 32
QK_HEAD_DIM = QK_NOPE_DIM + QK_ROPE_DIM
V_HEAD_DIM = 64
D_MLA = MLA_HEADS * V_HEAD_DIM
Q_LORA_RANK = 256
KV_LORA_RANK = 128
ROPE_THETA = 10000.0
Q_BLOCK = 128
MAX_POS_OFFSET = 4096
D_MLA_IN = Q_LORA_RANK + KV_LORA_RANK + QK_ROPE_DIM

D_IN = D_RWKV_IN + D_MLA_IN

N_EXPERTS = 256
TOP_K = 8
N_GROUPS = 8
TOPK_GROUPS = 4
D_EXPERT = 256
D_SHARED = 256
ROUTED_SCALE = 2.5
MOE_BLOCK = 256

kernel_name = 'hybrid_rwkv7_mla_moe_adaln'


def rms_norm(x, gain):
    xf = x.astype(jnp.float32)
    y = xf * lax.rsqrt(jnp.mean(xf * xf, axis=-1, keepdims=True) + NORM_EPS)
    return (y * gain.astype(jnp.float32)).astype(x.dtype)


def swiglu(gu):
    g, u = jnp.split(gu, 2, axis=-1)
    return jax.nn.silu(g) * u


def token_shift(u, mu):
    prev = jnp.pad(u, ((0, 0), (1, 0), (0, 0)))[:, :-1]
    return u + (prev - u) * mu


def rope_tables(positions):
    inv_freq = ROPE_THETA ** (-jnp.arange(0, QK_ROPE_DIM, 2, dtype=jnp.float32) / QK_ROPE_DIM)
    ang = positions.astype(jnp.float32)[..., None] * inv_freq
    return jnp.cos(ang)[:, :, None, :], jnp.sin(ang)[:, :, None, :]


def apply_rope_tail(x, cos, sin):
    x_nope, x_pe = jnp.split(x.astype(jnp.float32), [QK_NOPE_DIM], axis=-1)
    x1, x2 = jnp.split(x_pe, 2, axis=-1)
    x_pe = jnp.concatenate([x1 * cos - x2 * sin, x2 * cos + x1 * sin], axis=-1)
    return jnp.concatenate([x_nope, x_pe], axis=-1).astype(x.dtype)


def rwkv7_scan(r, decay, k, v, kk, a):
    B, T, H, N = r.shape

    def step(S, inp):
        r_t, w_t, k_t, v_t, kk_t, a_t = inp
        sa = jnp.einsum('bhvk,bhk->bhv', S, -kk_t)
        S = (S * w_t[:, :, None, :]
             + sa[..., None] * (kk_t * a_t)[:, :, None, :]
             + v_t[..., None] * k_t[:, :, None, :])
        y = jnp.einsum('bhvk,bhk->bhv', S, r_t)
        return S, y

    xs = tuple(jnp.moveaxis(t, 1, 0) for t in (r, decay, k, v, kk, a))
    S0 = jnp.zeros((B, H, N, N), jnp.float32)
    _, ys = lax.scan(step, S0, xs)
    return jnp.moveaxis(ys, 0, 1)


def rwkv7_group(u, mu, decay_w0, decay_up, iclr_a0, iclr_up, gate_up, k_k, k_a, r_k, ln_w, ln_b):
    B, T, _ = u.shape
    H, N = RWKV_HEADS, RWKV_HEAD_DIM
    out_dtype = u.dtype
    u = token_shift(u.astype(jnp.float32), mu.astype(jnp.float32))
    r, k, v, xw, xa, xg = jnp.split(u, np.cumsum(RWKV_IN_SIZES)[:-1].tolist(), axis=-1)
    log_w = -jax.nn.softplus(-(decay_w0 + jnp.tanh(xw) @ decay_up)) - 0.5
    decay = jnp.exp(-jnp.exp(log_w))
    a = jax.nn.sigmoid(iclr_a0 + xa @ iclr_up)
    g = jax.nn.sigmoid(xg) @ gate_up
    heads = lambda t: t.reshape(B, T, H, N)
    kk = heads(k * k_k)
    kk = kk * lax.rsqrt(jnp.maximum(jnp.sum(kk * kk, axis=-1, keepdims=True), 1e-24))
    k = k * (1.0 + (a - 1.0) * k_a)
    r, k, v, decay, a = heads(r), heads(k), heads(v), heads(decay), heads(a)
    y = rwkv7_scan(r, decay, k, v, kk, a)
    mean = jnp.mean(y, axis=-1, keepdims=True)
    var = jnp.mean(jnp.square(y - mean), axis=-1, keepdims=True)
    y = ((y - mean) * lax.rsqrt(var + GN_EPS)).reshape(B, T, D_RWKV) * ln_w + ln_b
    bonus = jnp.sum(r * k * r_k, axis=-1, keepdims=True) * v
    y = (y + bonus.reshape(B, T, D_RWKV)) * g
    return y.astype(out_dtype)


def causal_block_attention(q, k, v):
    T = q.shape[1]
    scale = QK_HEAD_DIM ** -0.5
    outs = []
    for start in range(0, T, Q_BLOCK):
        end = min(start + Q_BLOCK, T)
        s = jnp.einsum('bqhd,bkhd->bhqk', q[:, start:end], k[:, :end]).astype(jnp.float32) * scale
        q_pos = jnp.arange(start, end)[:, None]
        k_pos = jnp.arange(end)[None, :]
        s = jnp.where(k_pos <= q_pos, s, -jnp.inf)
        p = jax.nn.softmax(s, axis=-1).astype(v.dtype)
        outs.append(jnp.einsum('bhqk,bkhd->bqhd', p, v[:, :end]))
    return jnp.concatenate(outs, axis=1)


def mla_group(u, cos, sin, q_a_norm, w_q_b, kv_a_norm, w_kv_b, q_norm, k_norm):
    B, T, _ = u.shape
    H = MLA_HEADS
    out_dtype = u.dtype
    q_lat, kv_lat, k_pe = jnp.split(u, [Q_LORA_RANK, Q_LORA_RANK + KV_LORA_RANK], axis=-1)
    q = (rms_norm(q_lat, q_a_norm) @ w_q_b).reshape(B, T, H, QK_HEAD_DIM)
    kv = (rms_norm(kv_lat, kv_a_norm) @ w_kv_b).reshape(B, T, H, QK_NOPE_DIM + V_HEAD_DIM)
    k_nope, v = jnp.split(kv, [QK_NOPE_DIM], axis=-1)
    k = jnp.concatenate([k_nope, jnp.broadcast_to(k_pe[:, :, None, :], (B, T, H, QK_ROPE_DIM))], axis=-1)
    q = apply_rope_tail(rms_norm(q, q_norm), cos, sin)
    k = apply_rope_tail(rms_norm(k, k_norm), cos, sin)
    o = causal_block_attention(q, k, v)
    return o.reshape(B, T, D_MLA).astype(out_dtype)


def moe_ffn(h, w_router, router_bias, w_e_gate_up, w_e_down, w_sh_gate_up, w_sh_down):
    B, T, D = h.shape
    N = B * T
    NK = N * TOP_K
    xt = h.reshape(N, D)
    scores = jax.nn.sigmoid((xt @ w_router).astype(jnp.float32))
    sel = scores + router_bias.astype(jnp.float32)
    grp = sel.reshape(N, N_GROUPS, N_EXPERTS // N_GROUPS)
    grp_score = jnp.sum(lax.top_k(grp, 2)[0], axis=-1)
    _, top_grp = lax.top_k(grp_score, TOPK_GROUPS)
    grp_mask = jnp.any(top_grp[..., None] == jnp.arange(N_GROUPS), axis=1)
    exp_mask = jnp.repeat(grp_mask, N_EXPERTS // N_GROUPS, axis=-1)
    _, top_e = lax.top_k(jnp.where(exp_mask, sel, -jnp.inf), TOP_K)
    w = jnp.take_along_axis(scores, top_e, axis=-1)
    w = w / jnp.sum(w, axis=-1, keepdims=True) * ROUTED_SCALE

    e_flat = top_e.reshape(NK).astype(jnp.int32)
    tok_flat = jnp.repeat(jnp.arange(N, dtype=jnp.int32), TOP_K)
    w_flat = w.reshape(NK)
    order = jnp.argsort(e_flat, stable=True)
    e_sorted, tok_sorted, w_sorted = e_flat[order], tok_flat[order], w_flat[order]
    counts = jnp.bincount(e_flat, length=N_EXPERTS).astype(jnp.int32)
    starts = jnp.cumsum(counts) - counts
    padded = (counts + MOE_BLOCK - 1) // MOE_BLOCK * MOE_BLOCK
    pad_ends = jnp.cumsum(padded)
    pad_starts = pad_ends - padded
    dest = pad_starts[e_sorted] + (jnp.arange(NK, dtype=jnp.int32) - starts[e_sorted])
    n_blocks = (NK + N_EXPERTS * (MOE_BLOCK - 1)) // MOE_BLOCK
    P = n_blocks * MOE_BLOCK
    buf_tok = jnp.full((P,), N, jnp.int32).at[dest].set(tok_sorted)
    buf_w = jnp.zeros((P,), jnp.float32).at[dest].set(w_sorted)
    block_expert = jnp.minimum(
        jnp.searchsorted(pad_ends, jnp.arange(n_blocks, dtype=jnp.int32) * MOE_BLOCK, side='right'),
        N_EXPERTS - 1).astype(jnp.int32)

    x_pad = jnp.concatenate([xt, jnp.zeros((1, D), xt.dtype)], axis=0)

    def body(acc, blk):
        idx, wts, e = blk
        xb = x_pad[idx]
        yb = swiglu(xb @ w_e_gate_up[e]) @ w_e_down[e]
        return acc.at[idx].add(yb.astype(jnp.float32) * wts[:, None]), None

    acc0 = jnp.zeros((N + 1, D), jnp.float32)
    acc, _ = lax.scan(body, acc0, (buf_tok.reshape(n_blocks, MOE_BLOCK),
                                   buf_w.reshape(n_blocks, MOE_BLOCK), block_expert))
    shared = swiglu(xt @ w_sh_gate_up) @ w_sh_down
    return (acc[:N].astype(h.dtype) + shared).reshape(B, T, D)


def hybrid_layer(x, c_act, cos, sin, ada_w, ada_b, norm_mix, w_in, rwkv_mu, decay_w0, decay_up,
                 iclr_a0, iclr_up, gate_up, rwkv_k_k, rwkv_k_a, rwkv_r_k, ln_x_w, ln_x_b,
                 q_a_norm, w_q_b, kv_a_norm, w_kv_b, q_norm, k_norm, w_out, norm_ffn,
                 w_router, router_bias, w_e_gate_up, w_e_down, w_sh_gate_up, w_sh_down):
    mod = c_act @ ada_w + ada_b
    sh_a, sc_a, g_a, sh_f, sc_f, g_f = [m[:, None, :] for m in jnp.split(mod, 6, axis=-1)]
    h = rms_norm(x, norm_mix) * (1.0 + sc_a) + sh_a
    u = h @ w_in
    y_r = rwkv7_group(u[..., :D_RWKV_IN], rwkv_mu, decay_w0, decay_up, iclr_a0, iclr_up, gate_up,
                      rwkv_k_k, rwkv_k_a, rwkv_r_k, ln_x_w, ln_x_b)
    y_m = mla_group(u[..., D_RWKV_IN:], cos, sin, q_a_norm, w_q_b, kv_a_norm, w_kv_b,
                    q_norm, k_norm)
    x = x + g_a * (jnp.concatenate([y_r, y_m], axis=-1) @ w_out)
    h = rms_norm(x, norm_ffn) * (1.0 + sc_f) + sh_f
    x = x + g_f * moe_ffn(h, w_router, router_bias, w_e_gate_up, w_e_down, w_sh_gate_up, w_sh_down)
    return x


def setup_inputs(seed: int = 0) -> dict:
    key = jax.random.key(seed)
    ks = iter(jax.random.split(key, 40))
    f32 = jnp.float32
    L, D = DEPTH, D_MODEL

    def nrm(shape, scale):
        return jax.random.normal(next(ks), shape, f32) * scale

    def gain(shape):
        return 1.0 + nrm(shape, 0.02)

    x = nrm((BATCH, SEQ, D), 1.0)
    c = nrm((BATCH, D), 1.0)
    start = jax.random.randint(next(ks), (BATCH, 1), 0, MAX_POS_OFFSET, jnp.int32)
    positions = start + jnp.arange(SEQ, dtype=jnp.int32)[None, :]
    return {
        'x': x,
        'c': c,
        'positions': positions,
        'ada_w': nrm((L, D, 6 * D), 0.5 * D ** -0.5),
        'ada_b': nrm((L, 6 * D), 0.02),
        'norm_mix': gain((L, D)),
        'w_in': nrm((L, D, D_IN), D ** -0.5),
        'rwkv_mu': jax.random.uniform(next(ks), (L, D_RWKV_IN), f32),
        'decay_w0': jax.random.uniform(next(ks), (L, D_RWKV), f32, minval=-5.0, maxval=1.0),
        'decay_up': nrm((L, DECAY_LORA, D_RWKV), DECAY_LORA ** -0.5),
        'iclr_a0': nrm((L, D_RWKV), 0.1),
        'iclr_up': nrm((L, ICLR_LORA, D_RWKV), ICLR_LORA ** -0.5),
        'gate_up': nrm((L, GATE_LORA, D_RWKV), GATE_LORA ** -0.5),
        'rwkv_k_k': 0.85 + nrm((L, D_RWKV), 0.05),
        'rwkv_k_a': 1.0 + nrm((L, D_RWKV), 0.05),
        'rwkv_r_k': nrm((L, RWKV_HEADS, RWKV_HEAD_DIM), 0.1),
        'ln_x_w': gain((L, D_RWKV)),
        'ln_x_b': nrm((L, D_RWKV), 0.02),
        'q_a_norm': gain((L, Q_LORA_RANK)),
        'w_q_b': nrm((L, Q_LORA_RANK, MLA_HEADS * QK_HEAD_DIM), Q_LORA_RANK ** -0.5),
        'kv_a_norm': gain((L, KV_LORA_RANK)),
        'w_kv_b': nrm((L, KV_LORA_RANK, MLA_HEADS * (QK_NOPE_DIM + V_HEAD_DIM)), KV_LORA_RANK ** -0.5),
        'q_norm': gain((L, QK_HEAD_DIM)),
        'k_norm': gain((L, QK_HEAD_DIM)),
        'w_out': nrm((L, D_MIX, D), D_MIX ** -0.5),
        'norm_ffn': gain((L, D)),
        'w_router': nrm((L, D, N_EXPERTS), D ** -0.5),
        'router_bias': nrm((L, N_EXPERTS), 0.01),
        'w_e_gate_up': nrm((L, N_EXPERTS, D, 2 * D_EXPERT), D ** -0.5),
        'w_e_down': nrm((L, N_EXPERTS, D_EXPERT, D), D_EXPERT ** -0.5),
        'w_sh_gate_up': nrm((L, D, 2 * D_SHARED), D ** -0.5),
        'w_sh_down': nrm((L, D_SHARED, D), D_SHARED ** -0.5),
    }


def reference(x, c, positions, ada_w, ada_b, norm_mix, w_in, rwkv_mu, decay_w0, decay_up,
              iclr_a0, iclr_up, gate_up, rwkv_k_k, rwkv_k_a, rwkv_r_k, ln_x_w, ln_x_b,
              q_a_norm, w_q_b, kv_a_norm, w_kv_b, q_norm, k_norm, w_out, norm_ffn,
              w_router, router_bias, w_e_gate_up, w_e_down, w_sh_gate_up, w_sh_down):
    cos, sin = rope_tables(positions)
    c_act = jax.nn.silu(c)
    for l in range(DEPTH):
        x = hybrid_layer(x, c_act, cos, sin, ada_w[l], ada_b[l], norm_mix[l], w_in[l], rwkv_mu[l],
                         decay_w0[l], decay_up[l], iclr_a0[l], iclr_up[l], gate_up[l],
                         rwkv_k_k[l], rwkv_k_a[l], rwkv_r_k[l], ln_x_w[l], ln_x_b[l],
                         q_a_norm[l], w_q_b[l], kv_a_norm[l], w_kv_b[l], q_norm[l], k_norm[l],
                         w_out[l], norm_ffn[l], w_router[l], router_bias[l], w_e_gate_up[l],
                         w_e_down[l], w_sh_gate_up[l], w_sh_down[l])
    return x
```

```cpp
#include <hip/hip_runtime.h>
#include <stdint.h>
#include <stdio.h>
#define DI __device__ __forceinline__

#ifndef ONE_LAUNCH
#define ONE_LAUNCH 0
#endif

typedef unsigned short bf16_t;
typedef short bf16x8 __attribute__((ext_vector_type(8)));
typedef float f32x4 __attribute__((ext_vector_type(4)));
typedef float f32x16 __attribute__((ext_vector_type(16)));
typedef float f32x2_t __attribute__((ext_vector_type(2)));
typedef unsigned u32x4 __attribute__((ext_vector_type(4)));
typedef unsigned u32x2 __attribute__((ext_vector_type(2)));
#define LAUNDER(v) asm volatile("" : "+v"(v))
DI u32x4 mk4(unsigned a, unsigned b, unsigned c, unsigned d) { return (u32x4){a, b, c, d}; }
DI u32x2 mk2(unsigned a, unsigned b) { return (u32x2){a, b}; }

typedef __bf16 bf16x2_t __attribute__((ext_vector_type(2)));

constexpr int NB = 16, NT_ = 4096, DM = 1024, NTOK = NB * NT_;
constexpr int LDU = 2176;
constexpr int UQ = 0, UKV = 256, UR = 384, UK = 896, UV = 1408, UXW = 1920, UXA = 1952, UXG = 1984, UPE = 2080;
constexpr int NEXP = 256, TOPK = 8;
constexpr int LDS_BYTES = 73728;
constexpr float QSCALE = 0.14724444f;

#define XB_TMO      128
#define XB_XCNT(j)  (256  + 64 * (j))
#define XB_XSUB(j)  (1280 + 64 * (j))
#define XB_XGEN(j)  (2304 + 64 * (j))
#define XB_TOP      3328
#define XB_TOPGEN   3392
#define XCD_BAR_WORDS 3456
#define XB_SPIN_CAP (1u << 22)
#define LAS __attribute__((address_space(3)))
constexpr int CTRL_ATTNQ = 4096, CTRL_ECNT = 4352, CTRL_WORDS = 8192;

DI unsigned xb_ld(unsigned* p)              { return __hip_atomic_load(p, __ATOMIC_RELAXED, __HIP_MEMORY_SCOPE_AGENT); }
DI unsigned xb_add(unsigned* p, unsigned v) { return __hip_atomic_fetch_add(p, v, __ATOMIC_RELAXED, __HIP_MEMORY_SCOPE_AGENT); }
DI unsigned xb_xcc_id() { return (unsigned)__builtin_amdgcn_s_getreg((3 << 11) | 20) & 0xFu; }
#define XB_SPIN(cond, bar) do { unsigned _sp = 0; while (cond) { __builtin_amdgcn_s_sleep(1); \
    if ((++_sp & 255u) == 0u) { if (xb_ld(&(bar)[XB_TMO])) break; if (_sp > XB_SPIN_CAP) { atomicAdd(&(bar)[XB_TMO], 1u); break; } } } } while (0)

struct XcdBarrier { unsigned* bar; unsigned x; volatile LAS unsigned* st; };

DI XcdBarrier xcd_barrier_post(unsigned* bar, volatile LAS unsigned* st) {
    XcdBarrier b; b.bar = bar; b.x = xb_xcc_id(); b.st = st;
    if (threadIdx.x == 0) (void)xb_add(&bar[XB_XCNT(b.x)], 1u);
    return b;
}
DI void xcd_barrier_complete(unsigned* bar, unsigned x, unsigned& nloc, unsigned& nx) {
    const unsigned G = gridDim.x * gridDim.y * gridDim.z;
    unsigned sum, cnt, mine, sp = 0u;
    for (;;) {
        sum = 0u; cnt = 0u; mine = 0u;
#pragma unroll
        for (unsigned j = 0; j < 16; ++j) { const unsigned c = xb_ld(&bar[XB_XCNT(j)]); sum += c; cnt += (c > 0u) ? 1u : 0u; mine = (j == x) ? c : mine; }
        if (sum == G) break;
        __builtin_amdgcn_s_sleep(1);
        if ((++sp & 255u) == 0u) { if (xb_ld(&bar[XB_TMO])) break; if (sp > XB_SPIN_CAP) { atomicAdd(&bar[XB_TMO], 1u); break; } }
    }
    nloc = mine > 0u ? mine : 1u; nx = cnt > 0u ? cnt : 1u;
}
DI void xcd_barrier(const XcdBarrier& b) {
    asm volatile("s_waitcnt vmcnt(0)" ::: "memory");
    __syncthreads();
    if (threadIdx.x == 0) {
        unsigned* bar = b.bar;
        __builtin_amdgcn_s_waitcnt(0);
        unsigned nloc = b.st[0], nx = b.st[1];
        if (nloc == 0u) { xcd_barrier_complete(bar, b.x, nloc, nx); b.st[0] = nloc; b.st[1] = nx; }
        const unsigned old = xb_add(&bar[XB_XSUB(b.x)], 1u);
        const unsigned gen = old / nloc;
        if (old + 1u == (gen + 1u) * nloc) {
            __builtin_amdgcn_fence(__ATOMIC_RELEASE, "agent");
            asm volatile("s_waitcnt vmcnt(0)" ::: "memory");
            const unsigned og = xb_add(&bar[XB_TOP], 1u);
            const unsigned tg = og / nx;
            if (og + 1u == (tg + 1u) * nx) xb_add(&bar[XB_TOPGEN], 1u);
            else XB_SPIN(xb_ld(&bar[XB_TOPGEN]) == tg, bar);
            __builtin_amdgcn_fence(__ATOMIC_ACQUIRE, "agent");
            xb_add(&bar[XB_XGEN(b.x)], 1u);
            asm volatile("s_waitcnt vmcnt(0)" ::: "memory");
        } else {
            XB_SPIN(xb_ld(&bar[XB_XGEN(b.x)]) == gen, bar);
            __builtin_amdgcn_fence(__ATOMIC_ACQUIRE, "agent");
            asm volatile("s_waitcnt vmcnt(0)" ::: "memory");
        }
    }
    __syncthreads();
}

struct Params {
    const float* x; const float* c; const int* positions; const float* ada_w; const float* ada_b; const float* norm_mix; const float* w_in;
    const float* rwkv_mu; const float* decay_w0; const float* decay_up; const float* iclr_a0; const float* iclr_up; const float* gate_up;
    const float* k_k; const float* k_a; const float* r_k; const float* ln_w; const float* ln_b;
    const float* q_a_norm; const float* w_q_b; const float* kv_a_norm; const float* w_kv_b; const float* q_norm; const float* k_norm;
    const float* w_out; const float* norm_ffn; const float* w_router; const float* router_bias;
    const float* w_e_gu; const float* w_e_d; const float* w_sh_gu; const float* w_sh_d;
    float* out;
    unsigned* ctrl; float* mod; float* rope;
    bf16_t* win_t; bf16_t* wq_t; bf16_t* wkv_t; bf16_t* wdec_t; bf16_t* wiclr_t; bf16_t* wgate_t; bf16_t* wout_t; bf16_t* wr_t; bf16_t* wsgu_t; bf16_t* wsd_t;
    bf16_t* wegu_t; bf16_t* wed_t;
    bf16_t* H; int* topk_idx; float* topk_w; int* elist; unsigned char* bscr;
    bf16_t* U; bf16_t* Q; bf16_t* Kb; bf16_t* Vt; bf16_t* SC; bf16_t* Gg; float* yraw; bf16_t* Y; bf16_t* slot;
};
constexpr size_t BSCR_PER_BLOCK = 196608;

DI float bf2f(bf16_t v) { return __uint_as_float(((unsigned)v) << 16); }
DI unsigned pk2(float a, float b) { f32x2_t f = {a, b}; bf16x2_t r = __builtin_convertvector(f, bf16x2_t); return __builtin_bit_cast(unsigned, r); }
DI bf16_t f2bf(float a) { return (bf16_t)(pk2(a, 0.f) & 0xffffu); }
DI float lo2f(unsigned w) { return __uint_as_float(w << 16); }
DI float hi2f(unsigned w) { return __uint_as_float(w & 0xffff0000u); }
DI float sigmoidf_(float x) { return 1.0f / (1.0f + __expf(-x)); }
DI float wave_sum(float v) {
#pragma unroll
    for (int o = 32; o > 0; o >>= 1) v += __shfl_xor(v, o);
    return v;
}
DI float dpp_sum8(float s) {
    s += __builtin_bit_cast(float, __builtin_amdgcn_update_dpp(0, __builtin_bit_cast(int, s), 0xB1, 0xf, 0xf, true));
    s += __builtin_bit_cast(float, __builtin_amdgcn_update_dpp(0, __builtin_bit_cast(int, s), 0x4E, 0xf, 0xf, true));
    s += __builtin_bit_cast(float, __builtin_amdgcn_update_dpp(0, __builtin_bit_cast(int, s), 0x141, 0xf, 0xf, true));
    return s;
}

struct APlain { const bf16_t* base; int ld; DI const bf16_t* row(int r) const { return base + (size_t)r * ld; } };
struct AGather { const bf16_t* base; const int* idx; DI const bf16_t* row(int r) const { return base + (size_t)idx[r] * DM; } };

template <int NT, int BK, class AP>
DI void gemm_core(const AP ap, const bf16_t* __restrict__ Bt, const int ldb, const int K, f32x4 (&acc)[4][NT], unsigned char* lds) {
    constexpr int CPR = BK / 8, RB = BK * 2, R256 = 256 / RB, BN = NT * 32;
    constexpr int A_BYTES = 128 * RB, B_BYTES = BN * RB;
    constexpr int A_CH = (128 * CPR) / 256, B_TOT = BN * CPR, B_CH = (B_TOT + 255) / 256, RSTEP = 256 / CPR;
    const int t = threadIdx.x, lane = t & 63, wid = t >> 6, wr = wid >> 1, wc = wid & 1;
    const int ch = t % CPR, r0 = t / CPR;
    const bf16_t* pa[A_CH]; const bf16_t* pb[B_CH]; int offa[A_CH], offb[B_CH]; bool vb[B_CH];
#pragma unroll
    for (int i = 0; i < A_CH; ++i) { const int row = r0 + i * RSTEP; pa[i] = ap.row(row) + ch * 8; offa[i] = row * RB + ((ch ^ ((row / R256) & (CPR - 1))) << 4); }
#pragma unroll
    for (int i = 0; i < B_CH; ++i) { const int row = r0 + i * RSTEP; vb[i] = row < BN; const int rr = vb[i] ? row : 0; pb[i] = Bt + (size_t)rr * ldb + ch * 8; offb[i] = 2 * A_BYTES + rr * RB + ((ch ^ ((rr / R256) & (CPR - 1))) << 4); }
#pragma unroll
    for (int i = 0; i < 4; ++i)
#pragma unroll
        for (int j = 0; j < NT; ++j) acc[i][j] = (f32x4){0.f, 0.f, 0.f, 0.f};
    const int KT = K / BK;
    u32x4 ra[A_CH], rb[B_CH];
#pragma unroll
    for (int i = 0; i < A_CH; ++i) ra[i] = *(const u32x4*)(pa[i]);
#pragma unroll
    for (int i = 0; i < B_CH; ++i) rb[i] = *(const u32x4*)(pb[i]);
    __syncthreads();
#pragma unroll
    for (int i = 0; i < A_CH; ++i) *(u32x4*)(lds + offa[i]) = ra[i];
#pragma unroll
    for (int i = 0; i < B_CH; ++i) if (vb[i]) *(u32x4*)(lds + offb[i]) = rb[i];
    __syncthreads();
    const int sw = ((lane & 15) / R256) & (CPR - 1);
    const int arow = (wr * 64 + (lane & 15)) * RB, brow = (wc * NT * 16 + (lane & 15)) * RB;
    for (int kt = 0; kt < KT; ++kt) {
        const int cur = kt & 1;
        if (kt + 1 < KT) {
#pragma unroll
            for (int i = 0; i < A_CH; ++i) ra[i] = *(const u32x4*)(pa[i] + (kt + 1) * BK);
#pragma unroll
            for (int i = 0; i < B_CH; ++i) rb[i] = *(const u32x4*)(pb[i] + (kt + 1) * BK);
        }
        const unsigned char* Ab = lds + cur * A_BYTES + arow;
        const unsigned char* Bb = lds + 2 * A_BYTES + cur * B_BYTES + brow;
#pragma unroll
        for (int ks = 0; ks < BK / 32; ++ks) {
            const int co = ((ks * 4 + (lane >> 4)) ^ sw) << 4;
            bf16x8 af[4], bfr[NT];
#pragma unroll
            for (int i = 0; i < 4; ++i) af[i] = *(const bf16x8*)(Ab + i * 16 * RB + co);
#pragma unroll
            for (int j = 0; j < NT; ++j) bfr[j] = *(const bf16x8*)(Bb + j * 16 * RB + co);
#pragma unroll
            for (int i = 0; i < 4; ++i)
#pragma unroll
                for (int j = 0; j < NT; ++j) acc[i][j] = __builtin_amdgcn_mfma_f32_16x16x32_bf16(bfr[j], af[i], acc[i][j], 0, 0, 0);
        }
        if (kt + 1 < KT) {
            const int nb = cur ^ 1;
#pragma unroll
            for (int i = 0; i < A_CH; ++i) *(u32x4*)(lds + nb * A_BYTES + offa[i]) = ra[i];
#pragma unroll
            for (int i = 0; i < B_CH; ++i) if (vb[i]) *(u32x4*)(lds + nb * B_BYTES + offb[i]) = rb[i];
        }
        __syncthreads();
    }
}

template <int NT> DI void acc_to_lds(const f32x4 (&acc)[4][NT], float* tile, const int ld) {
    const int t = threadIdx.x, lane = t & 63, wid = t >> 6, wr = wid >> 1, wc = wid & 1;
#pragma unroll
    for (int i = 0; i < 4; ++i)
#pragma unroll
        for (int j = 0; j < NT; ++j) {
            const int row = wr * 64 + i * 16 + (lane & 15), col = wc * NT * 16 + j * 16 + (lane >> 4) * 4;
            *(f32x4*)(tile + row * ld + col) = acc[i][j];
        }
}

DI int map_win(int n) { return n < 384 ? n + 1696 : (n < 2080 ? n - 384 : (n < 2112 ? n : -1)); }
DI int map_gu(int n) { const int tile = n >> 7, w = n & 127; return w < 64 ? tile * 64 + w : 256 + tile * 64 + (w - 64); }

template <int MAP> DI void tconv_simple(const float* __restrict__ src, bf16_t* __restrict__ dst, int K, int Ns, int Nd, const float* __restrict__ scale, int gtid, int gthreads) {
    const int total = Nd * K;
    for (int idx = gtid; idx < total; idx += gthreads) {
        const int n = idx / K, k = idx - n * K;
        const int m = (MAP == 1) ? map_win(n) : (MAP == 2 ? map_gu(n) : n);
        float v = 0.f;
        if (m >= 0) { v = src[(size_t)k * Ns + m]; if (scale) v *= scale[k]; }
        dst[idx] = f2bf(v);
    }
}
template <int MAP> DI void tconv_tiled(const float* __restrict__ src, bf16_t* __restrict__ dst, int E, int K, int N, float* ldsf, int bid, int G) {
    const int tk = K / 64, tn = N / 64, per = tk * tn, total = E * per;
    const int t = threadIdx.x;
    for (int tile = bid; tile < total; tile += G) {
        const int e = tile / per, r = tile - e * per, kt = r / tn, nt = r - kt * tn;
        const float* s = src + (size_t)e * K * N + (size_t)(kt * 64) * N;
        __syncthreads();
        {
            const int nl = t & 63, n = nt * 64 + nl;
            const int m = (MAP == 2) ? map_gu(n) : n;
#pragma unroll
            for (int i = 0; i < 16; ++i) { const int kl = (t >> 6) + 4 * i; ldsf[kl * 65 + nl] = s[(size_t)kl * N + m]; }
        }
        __syncthreads();
        {
            const int nl = t >> 2, kc = (t & 3) * 16;
            unsigned w[8];
#pragma unroll
            for (int i = 0; i < 8; ++i) w[i] = pk2(ldsf[(kc + 2 * i) * 65 + nl], ldsf[(kc + 2 * i + 1) * 65 + nl]);
            bf16_t* d = dst + (size_t)e * K * N + (size_t)(nt * 64 + nl) * K + kt * 64 + kc;
            *(u32x4*)(d) = mk4(w[0], w[1], w[2], w[3]);
            *(u32x4*)(d + 8) = mk4(w[4], w[5], w[6], w[7]);
        }
    }
}

DI void phase0(const Params& p, unsigned char* lds, int bid, int G) {
    const int t = threadIdx.x;
    float* ldsf = (float*)lds;
    for (int item = bid; item < 192; item += G) {
        __syncthreads();
        for (int i = t; i < NB * DM; i += 256) { const float v = p.c[i]; ldsf[i] = v * sigmoidf_(v); }
        __syncthreads();
        const int col = item * 32 + (t & 31), kp = t >> 5;
        float a[NB];
#pragma unroll
        for (int b = 0; b < NB; ++b) a[b] = 0.f;
        for (int k = kp * 128; k < kp * 128 + 128; ++k) {
            const float w = p.ada_w[(size_t)k * 6144 + col];
#pragma unroll
            for (int b = 0; b < NB; ++b) a[b] += ldsf[b * DM + k] * w;
        }
        __syncthreads();
#pragma unroll
        for (int b = 0; b < NB; ++b) ldsf[(kp * NB + b) * 32 + (t & 31)] = a[b];
        __syncthreads();
        for (int o = t; o < NB * 32; o += 256) {
            const int b = o >> 5, cl = o & 31; float s = 0.f;
#pragma unroll
            for (int q = 0; q < 8; ++q) s += ldsf[(q * NB + b) * 32 + cl];
            p.mod[b * 6144 + item * 32 + cl] = s + p.ada_b[item * 32 + cl];
        }
    }
    __syncthreads();
    const int gtid = bid * 256 + t, gth = G * 256;
    tconv_simple<1>(p.w_in, p.win_t, 1024, 2112, LDU, nullptr, gtid, gth);
    tconv_simple<0>(p.w_q_b, p.wq_t, 256, 768, 768, p.q_a_norm, gtid, gth);
    tconv_simple<0>(p.w_kv_b, p.wkv_t, 128, 1024, 1024, p.kv_a_norm, gtid, gth);
    tconv_simple<0>(p.decay_up, p.wdec_t, 32, 512, 512, nullptr, gtid, gth);
    tconv_simple<0>(p.iclr_up, p.wiclr_t, 32, 512, 512, nullptr, gtid, gth);
    tconv_simple<0>(p.gate_up, p.wgate_t, 96, 512, 512, nullptr, gtid, gth);
    tconv_simple<0>(p.w_out, p.wout_t, 1024, 1024, 1024, nullptr, gtid, gth);
    tconv_simple<0>(p.w_router, p.wr_t, 1024, 256, 256, nullptr, gtid, gth);
    tconv_simple<2>(p.w_sh_gu, p.wsgu_t, 1024, 512, 512, nullptr, gtid, gth);
    tconv_simple<0>(p.w_sh_d, p.wsd_t, 256, 1024, 1024, nullptr, gtid, gth);
    tconv_tiled<2>(p.w_e_gu, p.wegu_t, NEXP, 1024, 512, ldsf, bid, G);
    tconv_tiled<0>(p.w_e_d, p.wed_t, NEXP, 256, 1024, ldsf, bid, G);
}

DI void phase1(const Params& p, int bid, int G) {
    const int lane = threadIdx.x & 63, gw = bid * 4 + (threadIdx.x >> 6), nw = G * 4;
    for (int row = gw; row < NTOK; row += nw) {
        const int b = row >> 12;
        const float* xr = p.x + (size_t)row * DM;
        f32x4 v[4]; float ss = 0.f;
#pragma unroll
        for (int i = 0; i < 4; ++i) { v[i] = *(const f32x4*)(xr + lane * 4 + 256 * i); ss += v[i][0] * v[i][0] + v[i][1] * v[i][1] + v[i][2] * v[i][2] + v[i][3] * v[i][3]; }
        ss = wave_sum(ss);
        const float rs = rsqrtf(ss * (1.0f / DM) + 1e-6f);
        const float* mod = p.mod + b * 6144;
#pragma unroll
        for (int i = 0; i < 4; ++i) {
            const int c = lane * 4 + 256 * i;
            const f32x4 g = *(const f32x4*)(p.norm_mix + c), sh = *(const f32x4*)(mod + c), sc = *(const f32x4*)(mod + 1024 + c);
            float o[4];
#pragma unroll
            for (int e = 0; e < 4; ++e) o[e] = v[i][e] * rs * g[e] * (1.0f + sc[e]) + sh[e];
            *(u32x2*)(p.H + (size_t)row * DM + c) = mk2(pk2(o[0], o[1]), pk2(o[2], o[3]));
        }
        if (lane < 16) {
            const double inv = exp(-(double)lane * (9.210340371976184 / 16.0));
            const double ang = (double)p.positions[row] * inv;
            p.rope[(size_t)row * 32 + lane] = (float)cos(ang);
            p.rope[(size_t)row * 32 + 16 + lane] = (float)sin(ang);
        }
    }
}

DI void phase2(const Params& p, unsigned char* lds, int bid, int G) {
    constexpr int NCT = LDU / 128;
    const int t = threadIdx.x, lane = t & 63, wid = t >> 6, wr = wid >> 1, wc = wid & 1;
    const int total = (NTOK / 128) * NCT;
    for (int L = bid; L < total; L += G) {
        const int xcd = L & 7, j = L >> 3, rt = 8 * (j / NCT) + xcd, ct = j % NCT;
        f32x4 acc[4][4];
        APlain ap{p.H + (size_t)rt * 128 * DM, DM};
        gemm_core<4, 64>(ap, p.win_t + (size_t)ct * 128 * DM, DM, DM, acc, lds);
        bf16_t* tile = (bf16_t*)lds;
#pragma unroll
        for (int i = 0; i < 4; ++i)
#pragma unroll
            for (int jj = 0; jj < 4; ++jj) {
                const int row = wr * 64 + i * 16 + (lane & 15), col = wc * 64 + jj * 16 + (lane >> 4) * 4;
                *(u32x2*)(tile + row * 136 + col) = mk2(pk2(acc[i][jj][0], acc[i][jj][1]), pk2(acc[i][jj][2], acc[i][jj][3]));
            }
        __syncthreads();
#pragma unroll
        for (int i = 0; i < 8; ++i) {
            const int c = t + 256 * i, row = c >> 4, chn = c & 15;
            *(u32x4*)(p.U + (size_t)(rt * 128 + row) * LDU + ct * 128 + chn * 8) = *(const u32x4*)(tile + row * 136 + chn * 8);
        }
    }
}

DI void head_norm_rope_store(float (&v)[48], const int half, const float* __restrict__ gain, const float* __restrict__ ropeRow, const float scale, bf16_t* __restrict__ dstRow) {
    float ss = 0.f;
#pragma unroll
    for (int c = 0; c < 48; ++c) ss += v[c] * v[c];
    ss += __shfl_xor(ss, 1);
    const float rs = rsqrtf(ss * (1.0f / 96.0f) + 1e-6f);
#pragma unroll
    for (int c = 0; c < 48; ++c) v[c] = v[c] * rs * gain[half * 48 + c];
    if (half) {
#pragma unroll
        for (int i = 0; i < 16; ++i) {
            const float cs = ropeRow[i], sn = ropeRow[16 + i], x1 = v[16 + i], x2 = v[32 + i];
            v[16 + i] = x1 * cs - x2 * sn; v[32 + i] = x2 * cs + x1 * sn;
        }
    }
#pragma unroll
    for (int c = 0; c < 6; ++c)
        *(u32x4*)(dstRow + half * 48 + c * 8) = mk4(pk2(v[c * 8] * scale, v[c * 8 + 1] * scale), pk2(v[c * 8 + 2] * scale, v[c * 8 + 3] * scale),
                                                          pk2(v[c * 8 + 4] * scale, v[c * 8 + 5] * scale), pk2(v[c * 8 + 6] * scale, v[c * 8 + 7] * scale));
}

DI float shifted(const bf16_t* __restrict__ urow, const bool has_prev, const int col, const float mu) {
    const float cur = bf2f(urow[col]);
    const float prev = has_prev ? bf2f(urow[col - LDU]) : 0.f;
    return cur + (prev - cur) * mu;
}

DI void phase3(const Params& p, unsigned char* lds, int bid, int G) {
    const int t = threadIdx.x;
    float* tile = (float*)lds;
    float* rstd_q = (float*)(lds + 69632);
    float* rstd_kv = rstd_q + 128;
    bf16_t* lora = (bf16_t*)(p.bscr + (size_t)bid * BSCR_PER_BLOCK + 131072);
    for (int rt = bid; rt < NTOK / 128; rt += G) {
        __syncthreads();
        {
            int tl = t; LAUNDER(tl);
            const int row = tl >> 1, half = tl & 1, grow = rt * 128 + row;
            const bf16_t* urow = p.U + (size_t)grow * LDU;
            float s = 0.f;
#pragma unroll
            for (int c = 0; c < 16; ++c) { const u32x4 w = *(const u32x4*)(urow + UQ + half * 128 + c * 8);
                s += lo2f(w.x) * lo2f(w.x) + hi2f(w.x) * hi2f(w.x) + lo2f(w.y) * lo2f(w.y) + hi2f(w.y) * hi2f(w.y) + lo2f(w.z) * lo2f(w.z) + hi2f(w.z) * hi2f(w.z) + lo2f(w.w) * lo2f(w.w) + hi2f(w.w) * hi2f(w.w); }
            s += __shfl_xor(s, 1);
            float s2 = 0.f;
#pragma unroll
            for (int c = 0; c < 8; ++c) { const u32x4 w = *(const u32x4*)(urow + UKV + half * 64 + c * 8);
                s2 += lo2f(w.x) * lo2f(w.x) + hi2f(w.x) * hi2f(w.x) + lo2f(w.y) * lo2f(w.y) + hi2f(w.y) * hi2f(w.y) + lo2f(w.z) * lo2f(w.z) + hi2f(w.z) * hi2f(w.z) + lo2f(w.w) * lo2f(w.w) + hi2f(w.w) * hi2f(w.w); }
            s2 += __shfl_xor(s2, 1);
            if (half == 0) { rstd_q[row] = rsqrtf(s * (1.0f / 256.0f) + 1e-6f); rstd_kv[row] = rsqrtf(s2 * (1.0f / 128.0f) + 1e-6f); }
        }
        {
            int tl = t; LAUNDER(tl);
            const int row = tl >> 1, half = tl & 1, grow = rt * 128 + row, tt = grow & 4095;
            const bf16_t* urow = p.U + (size_t)grow * LDU;
            const bool hp = tt > 0;
#pragma unroll 4
            for (int c = 0; c < 80; ++c) {
                const int cc = half * 80 + c;
                float v = shifted(urow, hp, UXW + cc, p.rwkv_mu[1536 + cc]);
                v = cc < 32 ? tanhf(v) : (cc < 64 ? v : sigmoidf_(v));
                lora[row * 160 + cc] = f2bf(v);
            }
        }
        __syncthreads();
#pragma unroll 1
        for (int h = 0; h < 8; ++h) {
            f32x4 acc[4][3];
            APlain ap{p.U + (size_t)rt * 128 * LDU + UQ, LDU};
            gemm_core<3, 64>(ap, p.wq_t + (size_t)h * 96 * 256, 256, 256, acc, lds);
            acc_to_lds<3>(acc, tile, 100);
            __syncthreads();
            int tl = t; LAUNDER(tl);
            const int row = tl >> 1, half = tl & 1, grow = rt * 128 + row, b = grow >> 12, tt = grow & 4095;
            float v[48]; const float rq = rstd_q[row];
#pragma unroll
            for (int c = 0; c < 12; ++c) { const f32x4 x = *(const f32x4*)(tile + row * 100 + half * 48 + c * 4); v[c * 4] = x[0] * rq; v[c * 4 + 1] = x[1] * rq; v[c * 4 + 2] = x[2] * rq; v[c * 4 + 3] = x[3] * rq; }
            head_norm_rope_store(v, half, p.q_norm, p.rope + (size_t)grow * 32, QSCALE, p.Q + ((size_t)(b * 8 + h) * NT_ + tt) * 96);
        }
#pragma unroll 1
        for (int h = 0; h < 8; ++h) {
            f32x4 acc[4][4];
            APlain ap{p.U + (size_t)rt * 128 * LDU + UKV, LDU};
            gemm_core<4, 64>(ap, p.wkv_t + (size_t)h * 128 * 128, 128, 128, acc, lds);
            acc_to_lds<4>(acc, tile, 132);
            __syncthreads();
            {
                int tl = t; LAUNDER(tl);
                const int row = tl >> 1, half = tl & 1, grow = rt * 128 + row, b = grow >> 12, tt = grow & 4095;
                const bf16_t* urow = p.U + (size_t)grow * LDU;
                float v[48]; const float rk = rstd_kv[row];
#pragma unroll
                for (int c = 0; c < 48; ++c) {
                    const int col = half * 48 + c;
                    v[c] = col < 64 ? tile[row * 132 + col] * rk : bf2f(urow[UPE + col - 64]);
                }
                head_norm_rope_store(v, half, p.k_norm, p.rope + (size_t)grow * 32, 1.0f, p.Kb + ((size_t)(b * 8 + h) * NT_ + tt) * 96);
            }
            {
                int tl = t; LAUNDER(tl);
                const int dv = tl >> 2, tc = tl & 3;
                unsigned w[16];
#pragma unroll
                for (int i = 0; i < 16; ++i) { const int r0 = tc * 32 + 2 * i; w[i] = pk2(tile[r0 * 132 + 64 + dv] * rstd_kv[r0], tile[(r0 + 1) * 132 + 64 + dv] * rstd_kv[r0 + 1]); }
                bf16_t* d = p.Vt + ((size_t)((rt >> 5) * 8 + h) * 64 + dv) * NT_ + ((rt & 31) * 128) + tc * 32;
#pragma unroll
                for (int i = 0; i < 4; ++i) *(u32x4*)(d + i * 8) = mk4(w[4 * i], w[4 * i + 1], w[4 * i + 2], w[4 * i + 3]);
            }
        }
#pragma unroll 1
        for (int ct = 0; ct < 4; ++ct) {
            {
                f32x4 acc[4][4];
                APlain ap{lora, 160};
                gemm_core<4, 32>(ap, p.wdec_t + (size_t)ct * 128 * 32, 32, 32, acc, lds);
                acc_to_lds<4>(acc, tile, 132);
                __syncthreads();
                int tl = t; LAUNDER(tl);
                const int row = tl >> 1, half = tl & 1, grow = rt * 128 + row, b = grow >> 12, tt = grow & 4095;
                const int head = ct * 2 + half, c0 = head * 64;
                const bf16_t* urow = p.U + (size_t)grow * LDU; (void)urow;
                const bool hp = tt > 0; (void)hp;
                bf16_t* sc = p.SC + ((size_t)(b * 8 + head) * NT_ + tt) * 384; (void)sc;
#pragma unroll 2
                for (int c8 = 0; c8 < 8; ++c8) {
                    float o[8];
#pragma unroll
                    for (int e = 0; e < 8; ++e) {
                        const int c = c8 * 8 + e;
                        const float z = -(p.decay_w0[c0 + c] + tile[row * 132 + half * 64 + c]);
                        const float sp = fmaxf(z, 0.f) + log1pf(__expf(-fabsf(z)));
                        const float lw = -sp - 0.5f;
                        o[e] = -expm1f(-__expf(lw));
                    }
                    *(u32x4*)(sc + c8 * 8) = mk4(pk2(o[0], o[1]), pk2(o[2], o[3]), pk2(o[4], o[5]), pk2(o[6], o[7]));
                }
            }
            {
                f32x4 acc[4][4];
                APlain ap{lora + 32, 160};
                gemm_core<4, 32>(ap, p.wiclr_t + (size_t)ct * 128 * 32, 32, 32, acc, lds);
                acc_to_lds<4>(acc, tile, 132);
                __syncthreads();
                int tl = t; LAUNDER(tl);
                const int row = tl >> 1, half = tl & 1, grow = rt * 128 + row, b = grow >> 12, tt = grow & 4095;
                const int head = ct * 2 + half, c0 = head * 64;
                const bf16_t* urow = p.U + (size_t)grow * LDU; (void)urow;
                const bool hp = tt > 0; (void)hp;
                bf16_t* sc = p.SC + ((size_t)(b * 8 + head) * NT_ + tt) * 384; (void)sc;
                float ssq = 0.f;
                for (int c = 0; c < 64; ++c) { const float ks = shifted(urow, hp, UK + c0 + c, p.rwkv_mu[512 + c0 + c]) * p.k_k[c0 + c]; ssq += ks * ks; }
                const float rn = rsqrtf(fmaxf(ssq, 1e-24f));
#pragma unroll 1
                for (int c8 = 0; c8 < 8; ++c8) {
                    float okk[8], obb[8], okp[8], ov[8], orr[8];
#pragma unroll
                    for (int e = 0; e < 8; ++e) {
                        const int c = c8 * 8 + e;
                        const float a = sigmoidf_(p.iclr_a0[c0 + c] + tile[row * 132 + half * 64 + c]);
                        const float ks = shifted(urow, hp, UK + c0 + c, p.rwkv_mu[512 + c0 + c]);
                        const float kk = ks * p.k_k[c0 + c] * rn;
                        okk[e] = kk; obb[e] = a * kk; okp[e] = ks * (1.0f + (a - 1.0f) * p.k_a[c0 + c]);
                        ov[e] = shifted(urow, hp, UV + c0 + c, p.rwkv_mu[1024 + c0 + c]);
                        orr[e] = shifted(urow, hp, UR + c0 + c, p.rwkv_mu[c0 + c]);
                    }
                    *(u32x4*)(sc + 64 + c8 * 8) = mk4(pk2(okk[0], okk[1]), pk2(okk[2], okk[3]), pk2(okk[4], okk[5]), pk2(okk[6], okk[7]));
                    *(u32x4*)(sc + 128 + c8 * 8) = mk4(pk2(obb[0], obb[1]), pk2(obb[2], obb[3]), pk2(obb[4], obb[5]), pk2(obb[6], obb[7]));
                    *(u32x4*)(sc + 192 + c8 * 8) = mk4(pk2(okp[0], okp[1]), pk2(okp[2], okp[3]), pk2(okp[4], okp[5]), pk2(okp[6], okp[7]));
                    *(u32x4*)(sc + 256 + c8 * 8) = mk4(pk2(ov[0], ov[1]), pk2(ov[2], ov[3]), pk2(ov[4], ov[5]), pk2(ov[6], ov[7]));
                    *(u32x4*)(sc + 320 + c8 * 8) = mk4(pk2(orr[0], orr[1]), pk2(orr[2], orr[3]), pk2(orr[4], orr[5]), pk2(orr[6], orr[7]));
                }
            }
            {
                f32x4 acc[4][4];
                APlain ap{lora + 64, 160};
                gemm_core<4, 32>(ap, p.wgate_t + (size_t)ct * 128 * 96, 96, 96, acc, lds);
                acc_to_lds<4>(acc, tile, 132);
                __syncthreads();
                int tl = t; LAUNDER(tl);
                const int row = tl >> 1, half = tl & 1, grow = rt * 128 + row, b = grow >> 12, tt = grow & 4095;
                const int head = ct * 2 + half, c0 = head * 64;
                const bf16_t* urow = p.U + (size_t)grow * LDU; (void)urow;
                const bool hp = tt > 0; (void)hp;
                bf16_t* sc = p.SC + ((size_t)(b * 8 + head) * NT_ + tt) * 384; (void)sc;
                bf16_t* g = p.Gg + (size_t)grow * 512 + c0;
#pragma unroll
                for (int c8 = 0; c8 < 8; ++c8) {
                    const f32x4 x0 = *(const f32x4*)(tile + row * 132 + half * 64 + c8 * 8), x1 = *(const f32x4*)(tile + row * 132 + half * 64 + c8 * 8 + 4);
                    *(u32x4*)(g + c8 * 8) = mk4(pk2(x0[0], x0[1]), pk2(x0[2], x0[3]), pk2(x1[0], x1[1]), pk2(x1[2], x1[3]));
                }
            }
        }
    }
}

DI void scan_task(const Params& p, unsigned char* lds, const int task) {
    constexpr int CS = 16;
    const int t = threadIdx.x, lane = t & 63, w = t >> 6;
    const int bh = task >> 1, hf = task & 1, b = bh >> 3, head = bh & 7;
    const int rloc = w * 8 + (lane >> 3), kseg = lane & 7;
    const int vrow = hf * 32 + rloc;
    float* stage = (float*)lds;
    float* ybuf = (float*)(lds + 49152);
    const bf16_t* src = p.SC + (size_t)bh * NT_ * 384;
    float s[8];
#pragma unroll
    for (int j = 0; j < 8; ++j) s[j] = 0.f;
    u32x4 rg[3];
    __syncthreads();
#pragma unroll
    for (int i = 0; i < 3; ++i) rg[i] = *(const u32x4*)(src + (size_t)(t + 256 * i) * 8);
#pragma unroll
    for (int i = 0; i < 3; ++i) { float* d = stage + (t + 256 * i) * 8;
        *(f32x4*)d = (f32x4){lo2f(rg[i].x), hi2f(rg[i].x), lo2f(rg[i].y), hi2f(rg[i].y)}; *(f32x4*)(d + 4) = (f32x4){lo2f(rg[i].z), hi2f(rg[i].z), lo2f(rg[i].w), hi2f(rg[i].w)}; }
    __syncthreads();
    constexpr int NCH = NT_ / CS;
    for (int c = 0; c < NCH; ++c) {
        const int cur = c & 1;
        if (c + 1 < NCH) {
#pragma unroll
            for (int i = 0; i < 3; ++i) rg[i] = *(const u32x4*)(src + (size_t)(c + 1) * CS * 384 + (size_t)(t + 256 * i) * 8);
        }
        if (c > 0) {
            const float* yb = ybuf + (cur ^ 1) * CS * 32;
            const int st = t >> 4, r2 = (t & 15) * 2;
            *(f32x2_t*)(p.yraw + ((size_t)(b * NT_ + (c - 1) * CS + st)) * 512 + head * 64 + hf * 32 + r2) = *(const f32x2_t*)(yb + st * 32 + r2);
        }
        const float* sb = stage + cur * CS * 384;
        float* yb = ybuf + cur * CS * 32;
#pragma unroll 4
        for (int st = 0; st < CS; ++st) {
            const float* q = sb + st * 384 + kseg * 8;
            const f32x4 d0 = *(const f32x4*)(q), d1 = *(const f32x4*)(q + 4);
            const f32x4 k0 = *(const f32x4*)(q + 64), k1 = *(const f32x4*)(q + 68);
            const f32x4 b0 = *(const f32x4*)(q + 128), b1 = *(const f32x4*)(q + 132);
            const f32x4 p0 = *(const f32x4*)(q + 192), p1 = *(const f32x4*)(q + 196);
            const f32x4 r0 = *(const f32x4*)(q + 320), r1 = *(const f32x4*)(q + 324);
            const float vv = sb[st * 384 + 256 + vrow];
            float dot = 0.f, tmp[8];
#pragma unroll
            for (int j = 0; j < 4; ++j) { dot += s[j] * k0[j]; dot += s[4 + j] * k1[j]; }
#pragma unroll
            for (int j = 0; j < 4; ++j) { tmp[j] = s[j] - s[j] * d0[j] + vv * p0[j]; tmp[4 + j] = s[4 + j] - s[4 + j] * d1[j] + vv * p1[j]; }
            dot = dpp_sum8(dot);
            float y = 0.f;
#pragma unroll
            for (int j = 0; j < 4; ++j) { s[j] = tmp[j] - dot * b0[j]; s[4 + j] = tmp[4 + j] - dot * b1[j]; y += s[j] * r0[j]; y += s[4 + j] * r1[j]; }
            y = dpp_sum8(y);
            if (kseg == 0) yb[st * 32 + rloc] = y;
        }
        if (c + 1 < NCH) {
            float* dbase = stage + (cur ^ 1) * CS * 384;
#pragma unroll
            for (int i = 0; i < 3; ++i) { float* d = dbase + (t + 256 * i) * 8;
                *(f32x4*)d = (f32x4){lo2f(rg[i].x), hi2f(rg[i].x), lo2f(rg[i].y), hi2f(rg[i].y)}; *(f32x4*)(d + 4) = (f32x4){lo2f(rg[i].z), hi2f(rg[i].z), lo2f(rg[i].w), hi2f(rg[i].w)}; }
        }
        __syncthreads();
    }
    {
        const float* yb = ybuf + ((NCH - 1) & 1) * CS * 32;
        const int st = t >> 4, r2 = (t & 15) * 2;
        *(f32x2_t*)(p.yraw + ((size_t)(b * NT_ + (NCH - 1) * CS + st)) * 512 + head * 64 + hf * 32 + r2) = *(const f32x2_t*)(yb + st * 32 + r2);
    }
}

DI void attn_item(const Params& p, unsigned char* lds, const int item) {
    constexpr int KROW = 208, VROW = 136, KB = 64 * KROW, BUF = KB + 64 * VROW;
    const int t = threadIdx.x, lane = t & 63, w = t >> 6, l31 = lane & 31, h = lane >> 5;
    const int qt = 31 - item / 128, bh = item % 128;
    const bf16_t* Kg = p.Kb + (size_t)bh * NT_ * 96;
    const bf16_t* Vg = p.Vt + (size_t)bh * 64 * NT_;
    const int q = qt * 128 + w * 32 + l31;
    bf16x8 qf[6];
    {
        const bf16_t* qrow = p.Q + ((size_t)bh * NT_ + q) * 96 + 8 * h;
#pragma unroll
        for (int s = 0; s < 6; ++s) qf[s] = *(const bf16x8*)(qrow + 16 * s);
    }
    f32x16 O[2];
#pragma unroll
    for (int i = 0; i < 16; ++i) { O[0][i] = 0.f; O[1][i] = 0.f; }
    float m = -INFINITY, l = 0.f;
    const int njt = 2 * qt + 2;
    int koff[3], kgo[3], voff[2], vgo[2];
#pragma unroll
    for (int i = 0; i < 3; ++i) { const int c = t + 256 * i, r = c / 12, ch = c - r * 12; koff[i] = r * KROW + ch * 16; kgo[i] = r * 96 + ch * 8; }
#pragma unroll
    for (int i = 0; i < 2; ++i) { const int c = t + 256 * i, dv = c >> 3, ch = c & 7; voff[i] = KB + dv * VROW + ch * 16; vgo[i] = dv * NT_ + ch * 8; }
    u32x4 rk[3], rv[2];
#pragma unroll
    for (int i = 0; i < 3; ++i) rk[i] = *(const u32x4*)(Kg + kgo[i]);
#pragma unroll
    for (int i = 0; i < 2; ++i) rv[i] = *(const u32x4*)(Vg + vgo[i]);
    __syncthreads();
#pragma unroll
    for (int i = 0; i < 3; ++i) *(u32x4*)(lds + koff[i]) = rk[i];
#pragma unroll
    for (int i = 0; i < 2; ++i) { *(u32x2*)(lds + voff[i]) = mk2(rv[i].x, rv[i].y); *(u32x2*)(lds + voff[i] + 8) = mk2(rv[i].z, rv[i].w); }
    __syncthreads();
    for (int j = 0; j < njt; ++j) {
        const int cur = j & 1;
        if (j + 1 < njt) {
#pragma unroll
            for (int i = 0; i < 3; ++i) rk[i] = *(const u32x4*)(Kg + (size_t)(j + 1) * 64 * 96 + kgo[i]);
#pragma unroll
            for (int i = 0; i < 2; ++i) rv[i] = *(const u32x4*)(Vg + (j + 1) * 64 + vgo[i]);
        }
        const bool active = (j * 64) <= (qt * 128 + w * 32 + 31);
        if (active) {
            const unsigned char* Kt = lds + cur * BUF;
            const unsigned char* Vtile = Kt + KB;
            f32x16 S[2];
#pragma unroll
            for (int k2 = 0; k2 < 2; ++k2) {
#pragma unroll
                for (int i = 0; i < 16; ++i) S[k2][i] = 0.f;
#pragma unroll
                for (int s = 0; s < 6; ++s) {
                    const bf16x8 kf = *(const bf16x8*)(Kt + (k2 * 32 + l31) * KROW + s * 32 + h * 16);
                    S[k2] = __builtin_amdgcn_mfma_f32_32x32x16_bf16(kf, qf[s], S[k2], 0, 0, 0);
                }
            }
            if (j >= 2 * qt) {
#pragma unroll
                for (int k2 = 0; k2 < 2; ++k2)
#pragma unroll
                    for (int i = 0; i < 16; ++i) { const int key = j * 64 + k2 * 32 + (i & 3) + 8 * (i >> 2) + 4 * h; if (key > q) S[k2][i] = -INFINITY; }
            }
            float mx = S[0][0];
#pragma unroll
            for (int i = 1; i < 16; ++i) mx = fmaxf(mx, S[0][i]);
#pragma unroll
            for (int i = 0; i < 16; ++i) mx = fmaxf(mx, S[1][i]);
            mx = fmaxf(mx, __shfl_xor(mx, 32));
            const float mn = fmaxf(m, mx);
            const float alpha = exp2f(m - mn);
            m = mn;
            float ps = 0.f;
#pragma unroll
            for (int k2 = 0; k2 < 2; ++k2)
#pragma unroll
                for (int i = 0; i < 16; ++i) { const float e = exp2f(S[k2][i] - mn); S[k2][i] = e; ps += e; }
            l = l * alpha + ps;
#pragma unroll
            for (int i = 0; i < 16; ++i) { O[0][i] *= alpha; O[1][i] *= alpha; }
#pragma unroll
            for (int k2 = 0; k2 < 2; ++k2)
#pragma unroll
                for (int s2 = 0; s2 < 2; ++s2) {
                    unsigned pw[4];
#pragma unroll
                    for (int e = 0; e < 4; ++e) pw[e] = pk2(S[k2][8 * s2 + 2 * e], S[k2][8 * s2 + 2 * e + 1]);
                    const bf16x8 pf = __builtin_bit_cast(bf16x8, mk4(pw[0], pw[1], pw[2], pw[3]));
#pragma unroll
                    for (int dt = 0; dt < 2; ++dt) {
                        const unsigned char* vp = Vtile + (dt * 32 + l31) * VROW + (k2 * 32 + s2 * 16 + 4 * h) * 2;
                        const u32x2 v0 = *(const u32x2*)(vp), v1 = *(const u32x2*)(vp + 16);
                        const bf16x8 vf = __builtin_bit_cast(bf16x8, mk4(v0.x, v0.y, v1.x, v1.y));
                        O[dt] = __builtin_amdgcn_mfma_f32_32x32x16_bf16(vf, pf, O[dt], 0, 0, 0);
                    }
                }
        }
        if (j + 1 < njt) {
            unsigned char* nb = lds + (cur ^ 1) * BUF;
#pragma unroll
            for (int i = 0; i < 3; ++i) *(u32x4*)(nb + koff[i]) = rk[i];
#pragma unroll
            for (int i = 0; i < 2; ++i) { *(u32x2*)(nb + voff[i]) = mk2(rv[i].x, rv[i].y); *(u32x2*)(nb + voff[i] + 8) = mk2(rv[i].z, rv[i].w); }
        }
        __syncthreads();
    }
    l += __shfl_xor(l, 32);
    const float inv = 1.0f / l;
    bf16_t* yrow = p.Y + ((size_t)((bh >> 3) * NT_ + q)) * DM + 512 + (bh & 7) * 64;
#pragma unroll
    for (int dt = 0; dt < 2; ++dt)
#pragma unroll
        for (int g = 0; g < 4; ++g)
            *(u32x2*)(yrow + dt * 32 + 8 * g + 4 * h) = mk2(pk2(O[dt][4 * g] * inv, O[dt][4 * g + 1] * inv), pk2(O[dt][4 * g + 2] * inv, O[dt][4 * g + 3] * inv));
}

DI void phase4(const Params& p, unsigned char* lds, int bid, int G) {
    int* sh_item = (int*)(lds + LDS_BYTES - 64);
    for (int task = bid; task < 256; task += G) scan_task(p, lds, task);
    for (;;) {
        __syncthreads();
        if (threadIdx.x == 0) *sh_item = (int)atomicAdd(&p.ctrl[CTRL_ATTNQ], 1u);
        __syncthreads();
        const int item = *sh_item;
        if (item >= 4096) break;
        attn_item(p, lds, item);
    }
}

DI void phase5(const Params& p, unsigned char* lds, int bid, int G) {
    const int t = threadIdx.x, lane = t & 63, wid = t >> 6, wr = wid >> 1, wc = wid & 1;
    float* tile = (float*)lds;
    float* ssq = (float*)(lds + 69632);
    float* scores = (float*)(p.bscr + (size_t)bid * BSCR_PER_BLOCK);
    bf16_t* act = (bf16_t*)(p.bscr + (size_t)bid * BSCR_PER_BLOCK + 131072);
    for (int rt = bid; rt < NTOK / 128; rt += G) {
        const int b = rt >> 5;
        const float* mod = p.mod + b * 6144;
        __syncthreads();
        if (t < 128) ssq[t] = 0.f;
#pragma unroll 1
        for (int it = 0; it < 16; ++it) {
            int tl = t; LAUNDER(tl);
            const int pr = (tl >> 2) + 64 * it;
            const int row = pr >> 3, head = pr & 7, part = tl & 3, grow = rt * 128 + row, tt = grow & 4095;
            const int ch = head * 64 + part * 16;
            const float* yr = p.yraw + (size_t)grow * 512 + ch;
            float y[16];
#pragma unroll
            for (int i = 0; i < 4; ++i) { const f32x4 v = *(const f32x4*)(yr + 4 * i); y[4 * i] = v[0]; y[4 * i + 1] = v[1]; y[4 * i + 2] = v[2]; y[4 * i + 3] = v[3]; }
            float sm = 0.f;
#pragma unroll
            for (int i = 0; i < 16; ++i) sm += y[i];
            sm += __shfl_xor(sm, 1); sm += __shfl_xor(sm, 2);
            const float mean = sm * (1.0f / 64.0f);
            float vr = 0.f;
#pragma unroll
            for (int i = 0; i < 16; ++i) { const float d = y[i] - mean; vr += d * d; }
            vr += __shfl_xor(vr, 1); vr += __shfl_xor(vr, 2);
            const float rs = rsqrtf(vr * (1.0f / 64.0f) + 64e-5f);
            const bf16_t* sc = p.SC + ((size_t)(b * 8 + head) * NT_ + tt) * 384 + part * 16;
            float kp[16], vv[16], rr[16];
#pragma unroll
            for (int i = 0; i < 2; ++i) {
                const u32x4 a = *(const u32x4*)(sc + 192 + 8 * i), c = *(const u32x4*)(sc + 256 + 8 * i), d = *(const u32x4*)(sc + 320 + 8 * i);
                kp[8 * i] = lo2f(a.x); kp[8 * i + 1] = hi2f(a.x); kp[8 * i + 2] = lo2f(a.y); kp[8 * i + 3] = hi2f(a.y); kp[8 * i + 4] = lo2f(a.z); kp[8 * i + 5] = hi2f(a.z); kp[8 * i + 6] = lo2f(a.w); kp[8 * i + 7] = hi2f(a.w);
                vv[8 * i] = lo2f(c.x); vv[8 * i + 1] = hi2f(c.x); vv[8 * i + 2] = lo2f(c.y); vv[8 * i + 3] = hi2f(c.y); vv[8 * i + 4] = lo2f(c.z); vv[8 * i + 5] = hi2f(c.z); vv[8 * i + 6] = lo2f(c.w); vv[8 * i + 7] = hi2f(c.w);
                rr[8 * i] = lo2f(d.x); rr[8 * i + 1] = hi2f(d.x); rr[8 * i + 2] = lo2f(d.y); rr[8 * i + 3] = hi2f(d.y); rr[8 * i + 4] = lo2f(d.z); rr[8 * i + 5] = hi2f(d.z); rr[8 * i + 6] = lo2f(d.w); rr[8 * i + 7] = hi2f(d.w);
            }
            float bn = 0.f;
#pragma unroll
            for (int i = 0; i < 16; ++i) bn += rr[i] * kp[i] * p.r_k[ch + i];
            bn += __shfl_xor(bn, 1); bn += __shfl_xor(bn, 2);
            const bf16_t* gg = p.Gg + (size_t)grow * 512 + ch;
            const u32x4 g0 = *(const u32x4*)(gg), g1 = *(const u32x4*)(gg + 8);
            float g[16] = {lo2f(g0.x), hi2f(g0.x), lo2f(g0.y), hi2f(g0.y), lo2f(g0.z), hi2f(g0.z), lo2f(g0.w), hi2f(g0.w), lo2f(g1.x), hi2f(g1.x), lo2f(g1.y), hi2f(g1.y), lo2f(g1.z), hi2f(g1.z), lo2f(g1.w), hi2f(g1.w)};
            float o[16];
#pragma unroll
            for (int i = 0; i < 16; ++i) o[i] = ((y[i] - mean) * rs * p.ln_w[ch + i] + p.ln_b[ch + i] + bn * vv[i]) * g[i];
            bf16_t* yd = p.Y + (size_t)grow * DM + ch;
            *(u32x4*)(yd) = mk4(pk2(o[0], o[1]), pk2(o[2], o[3]), pk2(o[4], o[5]), pk2(o[6], o[7]));
            *(u32x4*)(yd + 8) = mk4(pk2(o[8], o[9]), pk2(o[10], o[11]), pk2(o[12], o[13]), pk2(o[14], o[15]));
        }
        asm volatile("s_waitcnt vmcnt(0)" ::: "memory");
        __syncthreads();
#pragma unroll 1
        for (int ct = 0; ct < 8; ++ct) {
            f32x4 acc[4][4];
            APlain ap{p.Y + (size_t)rt * 128 * DM, DM};
            gemm_core<4, 64>(ap, p.wout_t + (size_t)ct * 128 * DM, DM, DM, acc, lds);
            int ll = lane; LAUNDER(ll);
#pragma unroll
            for (int i = 0; i < 4; ++i) {
                const int row = wr * 64 + i * 16 + (ll & 15), grow = rt * 128 + row;
                float s = 0.f;
#pragma unroll
                for (int j = 0; j < 4; ++j) {
                    const int col = ct * 128 + wc * 64 + j * 16 + (ll >> 4) * 4;
                    const f32x4 xv = *(const f32x4*)(p.x + (size_t)grow * DM + col), ga = *(const f32x4*)(mod + 2048 + col);
                    f32x4 o;
#pragma unroll
                    for (int e = 0; e < 4; ++e) { o[e] = xv[e] + ga[e] * acc[i][j][e]; s += o[e] * o[e]; }
                    *(f32x4*)(p.out + (size_t)grow * DM + col) = o;
                }
                s += __shfl_xor(s, 16); s += __shfl_xor(s, 32);
                if ((ll >> 4) == 0) atomicAdd(&ssq[row], s);
            }
        }
        asm volatile("s_waitcnt vmcnt(0)" ::: "memory");
        __syncthreads();
#pragma unroll 1
        for (int r = wid; r < 128; r += 4) {
            int ll = lane; LAUNDER(ll);
            const int grow = rt * 128 + r;
            const float rs = rsqrtf(ssq[r] * (1.0f / DM) + 1e-6f);
#pragma unroll
            for (int i = 0; i < 4; ++i) {
                const int c = ll * 4 + 256 * i;
                const f32x4 v = *(const f32x4*)(p.out + (size_t)grow * DM + c), g = *(const f32x4*)(p.norm_ffn + c), sh = *(const f32x4*)(mod + 3072 + c), sc = *(const f32x4*)(mod + 4096 + c);
                float o[4];
#pragma unroll
                for (int e = 0; e < 4; ++e) o[e] = v[e] * rs * g[e] * (1.0f + sc[e]) + sh[e];
                *(u32x2*)(p.H + (size_t)grow * DM + c) = mk2(pk2(o[0], o[1]), pk2(o[2], o[3]));
            }
        }
        asm volatile("s_waitcnt vmcnt(0)" ::: "memory");
        __syncthreads();
#pragma unroll 1
        for (int ct = 0; ct < 2; ++ct) {
            f32x4 acc[4][4];
            APlain ap{p.H + (size_t)rt * 128 * DM, DM};
            gemm_core<4, 64>(ap, p.wr_t + (size_t)ct * 128 * DM, DM, DM, acc, lds);
            int ll = lane; LAUNDER(ll);
#pragma unroll
            for (int i = 0; i < 4; ++i)
#pragma unroll
                for (int j = 0; j < 4; ++j) {
                    const int row = wr * 64 + i * 16 + (ll & 15), col = ct * 128 + wc * 64 + j * 16 + (ll >> 4) * 4;
                    f32x4 o;
#pragma unroll
                    for (int e = 0; e < 4; ++e) o[e] = sigmoidf_(acc[i][j][e]);
                    *(f32x4*)(scores + row * 256 + col) = o;
                }
        }
        asm volatile("s_waitcnt vmcnt(0)" ::: "memory");
        __syncthreads();
#pragma unroll 1
        for (int r = wid; r < 128; r += 4) {
            const int token = rt * 128 + r;
            const f32x4 sc4 = *(const f32x4*)(scores + r * 256 + lane * 4), bi4 = *(const f32x4*)(p.router_bias + lane * 4);
            float sc[4] = {sc4[0], sc4[1], sc4[2], sc4[3]};
            float val[4] = {sc4[0] + bi4[0], sc4[1] + bi4[1], sc4[2] + bi4[2], sc4[3] + bi4[3]};
            float m1 = fmaxf(val[0], val[1]), m2 = fminf(val[0], val[1]);
#pragma unroll
            for (int e = 2; e < 4; ++e) { const float v = val[e]; m2 = fmaxf(m2, fminf(m1, v)); m1 = fmaxf(m1, v); }
#pragma unroll
            for (int o = 1; o < 8; o <<= 1) { const float o1 = __shfl_xor(m1, o), o2 = __shfl_xor(m2, o); const float n1 = fmaxf(m1, o1), n2 = fmaxf(fminf(m1, o1), fmaxf(m2, o2)); m1 = n1; m2 = n2; }
            const float gs = m1 + m2; const int mg = lane >> 3;
            int rank = 0;
#pragma unroll
            for (int g2 = 0; g2 < 8; ++g2) { const float os = __shfl(gs, g2 * 8); rank += (os > gs || (os == gs && g2 < mg)) ? 1 : 0; }
            if (rank >= 4) { val[0] = -INFINITY; val[1] = -INFINITY; val[2] = -INFINITY; val[3] = -INFINITY; }
            int esel[8]; float ssel[8]; float wsum = 0.f;
#pragma unroll
            for (int k = 0; k < 8; ++k) {
                float bv = val[0]; int bi = lane * 4;
#pragma unroll
                for (int e = 1; e < 4; ++e) if (val[e] > bv) { bv = val[e]; bi = lane * 4 + e; }
#pragma unroll
                for (int o = 1; o < 64; o <<= 1) { const float ov = __shfl_xor(bv, o); const int oi = __shfl_xor(bi, o); if (ov > bv || (ov == bv && oi < bi)) { bv = ov; bi = oi; } }
                const int e = bi & 3;
                const float mysc = e == 0 ? sc[0] : (e == 1 ? sc[1] : (e == 2 ? sc[2] : sc[3]));
                const float s = __shfl(mysc, bi >> 2);
                if ((bi >> 2) == lane) { if (e == 0) val[0] = -INFINITY; else if (e == 1) val[1] = -INFINITY; else if (e == 2) val[2] = -INFINITY; else val[3] = -INFINITY; }
                esel[k] = bi; ssel[k] = s; wsum += s;
            }
            if (lane < 8) {
                int e = esel[0]; float s = ssel[0];
#pragma unroll
                for (int k = 1; k < 8; ++k) if (lane == k) { e = esel[k]; s = ssel[k]; }
                p.topk_idx[token * 8 + lane] = e;
                p.topk_w[token * 8 + lane] = s / wsum * 2.5f;
                const unsigned pos = atomicAdd(&p.ctrl[CTRL_ECNT + e], 1u);
                p.elist[(size_t)e * NTOK + pos] = token * 8 + lane;
            }
        }
#pragma unroll 1
        for (int ct = 0; ct < 4; ++ct) {
            f32x4 acc[4][4];
            APlain ap{p.H + (size_t)rt * 128 * DM, DM};
            gemm_core<4, 64>(ap, p.wsgu_t + (size_t)ct * 128 * DM, DM, DM, acc, lds);
            acc_to_lds<4>(acc, tile, 132);
            __syncthreads();
            int tl = t; LAUNDER(tl);
            const int row = tl >> 1, half = tl & 1;
            unsigned w[16];
#pragma unroll
            for (int i = 0; i < 16; ++i) {
                const int c = half * 32 + 2 * i;
                const float g0 = tile[row * 132 + c], g1 = tile[row * 132 + c + 1], u0 = tile[row * 132 + 64 + c], u1 = tile[row * 132 + 64 + c + 1];
                w[i] = pk2(g0 * sigmoidf_(g0) * u0, g1 * sigmoidf_(g1) * u1);
            }
            bf16_t* d = act + row * 256 + ct * 64 + half * 32;
#pragma unroll
            for (int i = 0; i < 4; ++i) *(u32x4*)(d + 8 * i) = mk4(w[4 * i], w[4 * i + 1], w[4 * i + 2], w[4 * i + 3]);
        }
        asm volatile("s_waitcnt vmcnt(0)" ::: "memory");
        __syncthreads();
#pragma unroll 1
        for (int ct = 0; ct < 8; ++ct) {
            f32x4 acc[4][4];
            APlain ap{act, 256};
            gemm_core<4, 64>(ap, p.wsd_t + (size_t)ct * 128 * 256, 256, 256, acc, lds);
            int ll = lane; LAUNDER(ll);
#pragma unroll
            for (int i = 0; i < 4; ++i)
#pragma unroll
                for (int j = 0; j < 4; ++j) {
                    const int row = wr * 64 + i * 16 + (ll & 15), grow = rt * 128 + row, col = ct * 128 + wc * 64 + j * 16 + (ll >> 4) * 4;
                    const f32x4 xv = *(const f32x4*)(p.out + (size_t)grow * DM + col), gf = *(const f32x4*)(mod + 5120 + col);
                    f32x4 o;
#pragma unroll
                    for (int e = 0; e < 4; ++e) o[e] = xv[e] + gf[e] * acc[i][j][e];
                    *(f32x4*)(p.out + (size_t)grow * DM + col) = o;
                }
        }
    }
}

DI void phase6(const Params& p, unsigned char* lds, int bid, int G) {
    const int t = threadIdx.x, lane = t & 63, wid = t >> 6, wr = wid >> 1, wc = wid & 1;
    float* tile = (float*)lds;
    int* pre = (int*)(lds + 69632);
    int* rowtok = (int*)(lds + 69632 + 1056);
    int* rowslot = rowtok + 128;
    float* roww = (float*)(rowslot + 128);
    bf16_t* act = (bf16_t*)(p.bscr + (size_t)bid * BSCR_PER_BLOCK + 131072);
    __syncthreads();
    pre[t + 1] = ((int)p.ctrl[CTRL_ECNT + t] + 127) >> 7;
    __syncthreads();
    if (t == 0) { int s = 0; pre[0] = 0; for (int e = 1; e <= NEXP; ++e) { s += pre[e]; pre[e] = s; } }
    __syncthreads();
    const int total = pre[NEXP];
    for (int item = bid; item < total; item += G) {
        int lo = 0, hi = NEXP - 1;
        while (lo < hi) { const int mid = (lo + hi + 1) >> 1; if (pre[mid] <= item) lo = mid; else hi = mid - 1; }
        const int e = lo, tl = item - pre[e], cnt = (int)p.ctrl[CTRL_ECNT + e];
        __syncthreads();
        if (t < 128) {
            const int r = tl * 128 + t;
            if (r < cnt) { const int ts = p.elist[(size_t)e * NTOK + r]; rowtok[t] = ts >> 3; rowslot[t] = ts; roww[t] = p.topk_w[ts]; }
            else { rowtok[t] = 0; rowslot[t] = -1; roww[t] = 0.f; }
        }
        __syncthreads();
#pragma unroll 1
        for (int ct = 0; ct < 4; ++ct) {
            f32x4 acc[4][4];
            AGather ap{p.H, rowtok};
            gemm_core<4, 64>(ap, p.wegu_t + ((size_t)e * 512 + ct * 128) * DM, DM, DM, acc, lds);
            acc_to_lds<4>(acc, tile, 132);
            __syncthreads();
            int tl = t; LAUNDER(tl);
            const int row = tl >> 1, half = tl & 1;
            unsigned w[16];
#pragma unroll
            for (int i = 0; i < 16; ++i) {
                const int c = half * 32 + 2 * i;
                const float g0 = tile[row * 132 + c], g1 = tile[row * 132 + c + 1], u0 = tile[row * 132 + 64 + c], u1 = tile[row * 132 + 64 + c + 1];
                w[i] = pk2(g0 * sigmoidf_(g0) * u0, g1 * sigmoidf_(g1) * u1);
            }
            bf16_t* d = act + row * 256 + ct * 64 + half * 32;
#pragma unroll
            for (int i = 0; i < 4; ++i) *(u32x4*)(d + 8 * i) = mk4(w[4 * i], w[4 * i + 1], w[4 * i + 2], w[4 * i + 3]);
        }
        asm volatile("s_waitcnt vmcnt(0)" ::: "memory");
        __syncthreads();
#pragma unroll 1
        for (int ct = 0; ct < 8; ++ct) {
            f32x4 acc[4][4];
            APlain ap{act, 256};
            gemm_core<4, 64>(ap, p.wed_t + ((size_t)e * 1024 + ct * 128) * 256, 256, 256, acc, lds);
            int ll = lane; LAUNDER(ll);
#pragma unroll
            for (int i = 0; i < 4; ++i) {
                const int row = wr * 64 + i * 16 + (ll & 15), srow = rowslot[row];
                const float ww = roww[row];
                if (srow >= 0) {
#pragma unroll
                    for (int j = 0; j < 4; ++j) {
                        const int col = ct * 128 + wc * 64 + j * 16 + (ll >> 4) * 4;
                        *(u32x2*)(p.slot + (size_t)srow * DM + col) = mk2(pk2(acc[i][j][0] * ww, acc[i][j][1] * ww), pk2(acc[i][j][2] * ww, acc[i][j][3] * ww));
                    }
                }
            }
        }
    }
}

DI void phase7(const Params& p, int bid, int G) {
    const int lane = threadIdx.x & 63, gw = bid * 4 + (threadIdx.x >> 6), nw = G * 4;
    for (int row = gw; row < NTOK; row += nw) {
        const float* mod = p.mod + (row >> 12) * 6144 + 5120;
#pragma unroll
        for (int i = 0; i < 4; ++i) {
            const int c = lane * 4 + 256 * i;
            float s[4] = {0.f, 0.f, 0.f, 0.f};
#pragma unroll
            for (int k = 0; k < 8; ++k) { const u32x2 w = *(const u32x2*)(p.slot + ((size_t)row * 8 + k) * DM + c); s[0] += lo2f(w.x); s[1] += hi2f(w.x); s[2] += lo2f(w.y); s[3] += hi2f(w.y); }
            const f32x4 gf = *(const f32x4*)(mod + c);
            f32x4 o = *(const f32x4*)(p.out + (size_t)row * DM + c);
#pragma unroll
            for (int e = 0; e < 4; ++e) o[e] += gf[e] * s[e];
            *(f32x4*)(p.out + (size_t)row * DM + c) = o;
        }
    }
}

extern __shared__ __attribute__((aligned(16))) unsigned char smem[];

template <int PH> DI void run_phase(const Params& p, unsigned char* lds, int bid, int G) {
    if (PH == 0) phase0(p, lds, bid, G);
    if (PH == 1) phase1(p, bid, G);
    if (PH == 2) phase2(p, lds, bid, G);
    if (PH == 3) phase3(p, lds, bid, G);
    if (PH == 4) phase4(p, lds, bid, G);
    if (PH == 5) phase5(p, lds, bid, G);
    if (PH == 6) phase6(p, lds, bid, G);
    if (PH == 7) phase7(p, bid, G);
}

template <int PH> __global__ void __launch_bounds__(256, 2) phase_kernel(Params p) { run_phase<PH>(p, smem, blockIdx.x, gridDim.x); }

#if ONE_LAUNCH
__global__ void __launch_bounds__(256, 2) mega_kernel(Params p) {
    volatile LAS unsigned* st = (volatile LAS unsigned*)(smem + LDS_BYTES - 16);
    if (threadIdx.x == 0) { st[0] = 0u; st[1] = 0u; st[2] = 0u; st[3] = 0u; }
    __syncthreads();
    XcdBarrier bar = xcd_barrier_post(p.ctrl, st);
    const int bid = blockIdx.x, G = gridDim.x;
    run_phase<0>(p, smem, bid, G); xcd_barrier(bar);
    run_phase<1>(p, smem, bid, G); xcd_barrier(bar);
    run_phase<2>(p, smem, bid, G); xcd_barrier(bar);
    run_phase<3>(p, smem, bid, G); xcd_barrier(bar);
    run_phase<4>(p, smem, bid, G); xcd_barrier(bar);
    run_phase<5>(p, smem, bid, G); xcd_barrier(bar);
    run_phase<6>(p, smem, bid, G); xcd_barrier(bar);
    run_phase<7>(p, smem, bid, G);
}
#define OCC_KERNEL mega_kernel
#else
#define OCC_KERNEL phase_kernel<5>
#endif

static inline size_t al256(size_t x) { return (x + 255) & ~(size_t)255; }

extern "C" void kernel_launch(void* const* d_in, const int* in_sizes, int n_in, void* d_out, int out_size, void* d_ws, size_t ws_size, hipStream_t stream) {
    (void)in_sizes; (void)n_in; (void)out_size;
    Params p{};
    p.x = (const float*)d_in[0]; p.c = (const float*)d_in[1]; p.positions = (const int*)d_in[2]; p.ada_w = (const float*)d_in[3]; p.ada_b = (const float*)d_in[4];
    p.norm_mix = (const float*)d_in[5]; p.w_in = (const float*)d_in[6]; p.rwkv_mu = (const float*)d_in[7]; p.decay_w0 = (const float*)d_in[8]; p.decay_up = (const float*)d_in[9];
    p.iclr_a0 = (const float*)d_in[10]; p.iclr_up = (const float*)d_in[11]; p.gate_up = (const float*)d_in[12]; p.k_k = (const float*)d_in[13]; p.k_a = (const float*)d_in[14];
    p.r_k = (const float*)d_in[15]; p.ln_w = (const float*)d_in[16]; p.ln_b = (const float*)d_in[17]; p.q_a_norm = (const float*)d_in[18]; p.w_q_b = (const float*)d_in[19];
    p.kv_a_norm = (const float*)d_in[20]; p.w_kv_b = (const float*)d_in[21]; p.q_norm = (const float*)d_in[22]; p.k_norm = (const float*)d_in[23]; p.w_out = (const float*)d_in[24];
    p.norm_ffn = (const float*)d_in[25]; p.w_router = (const float*)d_in[26]; p.router_bias = (const float*)d_in[27]; p.w_e_gu = (const float*)d_in[28]; p.w_e_d = (const float*)d_in[29];
    p.w_sh_gu = (const float*)d_in[30]; p.w_sh_d = (const float*)d_in[31];
    p.out = (float*)d_out;

    static int grid = 0;
    if (!grid) {
        int dev = 0, cus = 0, per_cu = 0;
        (void)hipGetDevice(&dev);
        (void)hipDeviceGetAttribute(&cus, hipDeviceAttributeMultiprocessorCount, dev);
#if ONE_LAUNCH
        (void)hipFuncSetAttribute((const void*)mega_kernel, hipFuncAttributeMaxDynamicSharedMemorySize, LDS_BYTES);
#endif
        (void)hipFuncSetAttribute((const void*)phase_kernel<0>, hipFuncAttributeMaxDynamicSharedMemorySize, LDS_BYTES);
        (void)hipFuncSetAttribute((const void*)phase_kernel<1>, hipFuncAttributeMaxDynamicSharedMemorySize, LDS_BYTES);
        (void)hipFuncSetAttribute((const void*)phase_kernel<2>, hipFuncAttributeMaxDynamicSharedMemorySize, LDS_BYTES);
        (void)hipFuncSetAttribute((const void*)phase_kernel<3>, hipFuncAttributeMaxDynamicSharedMemorySize, LDS_BYTES);
        (void)hipFuncSetAttribute((const void*)phase_kernel<4>, hipFuncAttributeMaxDynamicSharedMemorySize, LDS_BYTES);
        (void)hipFuncSetAttribute((const void*)phase_kernel<5>, hipFuncAttributeMaxDynamicSharedMemorySize, LDS_BYTES);
        (void)hipFuncSetAttribute((const void*)phase_kernel<6>, hipFuncAttributeMaxDynamicSharedMemorySize, LDS_BYTES);
        (void)hipFuncSetAttribute((const void*)phase_kernel<7>, hipFuncAttributeMaxDynamicSharedMemorySize, LDS_BYTES);
        (void)hipOccupancyMaxActiveBlocksPerMultiprocessor(&per_cu, (const void*)OCC_KERNEL, 256, LDS_BYTES);
        if (cus <= 0) cus = 256;
        if (per_cu < 1) per_cu = 1;
        grid = cus * (per_cu < 2 ? per_cu : 2);
    }
    unsigned char* w = (unsigned char*)d_ws; size_t o = 0;
    auto take = [&](size_t bytes) { unsigned char* r = w + o; o = al256(o + bytes); return r; };
    p.ctrl = (unsigned*)take(CTRL_WORDS * 4);
    p.mod = (float*)take((size_t)NB * 6144 * 4);
    p.rope = (float*)take((size_t)NTOK * 32 * 4);
    p.win_t = (bf16_t*)take((size_t)LDU * 1024 * 2);
    p.wq_t = (bf16_t*)take((size_t)768 * 256 * 2);
    p.wkv_t = (bf16_t*)take((size_t)1024 * 128 * 2);
    p.wdec_t = (bf16_t*)take((size_t)512 * 32 * 2);
    p.wiclr_t = (bf16_t*)take((size_t)512 * 32 * 2);
    p.wgate_t = (bf16_t*)take((size_t)512 * 96 * 2);
    p.wout_t = (bf16_t*)take((size_t)1024 * 1024 * 2);
    p.wr_t = (bf16_t*)take((size_t)256 * 1024 * 2);
    p.wsgu_t = (bf16_t*)take((size_t)512 * 1024 * 2);
    p.wsd_t = (bf16_t*)take((size_t)1024 * 256 * 2);
    p.wegu_t = (bf16_t*)take((size_t)NEXP * 512 * 1024 * 2);
    p.wed_t = (bf16_t*)take((size_t)NEXP * 1024 * 256 * 2);
    p.H = (bf16_t*)take((size_t)NTOK * DM * 2);
    p.topk_idx = (int*)take((size_t)NTOK * 8 * 4);
    p.topk_w = (float*)take((size_t)NTOK * 8 * 4);
    p.elist = (int*)take((size_t)NEXP * NTOK * 4);
    p.bscr = take((size_t)grid * BSCR_PER_BLOCK);
    const size_t ov = o;
    p.U = (bf16_t*)take((size_t)NTOK * LDU * 2);
    p.Q = (bf16_t*)take((size_t)NTOK * 8 * 96 * 2);
    p.Kb = (bf16_t*)take((size_t)NTOK * 8 * 96 * 2);
    p.Vt = (bf16_t*)take((size_t)NTOK * 8 * 64 * 2);
    p.SC = (bf16_t*)take((size_t)NTOK * 8 * 384 * 2);
    p.Gg = (bf16_t*)take((size_t)NTOK * 512 * 2);
    p.yraw = (float*)take((size_t)NTOK * 512 * 4);
    p.Y = (bf16_t*)take((size_t)NTOK * DM * 2);
    p.slot = (bf16_t*)(w + ov);
    const size_t need_slot = ov + (size_t)NTOK * 8 * DM * 2;
    if (o > ws_size || need_slot > ws_size) { fprintf(stderr, "workspace too small: need %zu / %zu, have %zu\n", o, need_slot, ws_size); return; }

    (void)hipMemsetAsync(p.ctrl, 0, CTRL_WORDS * 4, stream);
#if ONE_LAUNCH
    hipLaunchKernelGGL(mega_kernel, dim3(grid), dim3(256), LDS_BYTES, stream, p);
#else
    hipLaunchKernelGGL(phase_kernel<0>, dim3(grid), dim3(256), LDS_BYTES, stream, p);
    hipLaunchKernelGGL(phase_kernel<1>, dim3(grid), dim3(256), LDS_BYTES, stream, p);
    hipLaunchKernelGGL(phase_kernel<2>, dim3(grid), dim3(256), LDS_BYTES, stream, p);
    hipLaunchKernelGGL(phase_kernel<3>, dim3(grid), dim3(256), LDS_BYTES, stream, p);
    hipLaunchKernelGGL(phase_kernel<4>, dim3(grid), dim3(256), LDS_BYTES, stream, p);
    hipLaunchKernelGGL(phase_kernel<5>, dim3(grid), dim3(256), LDS_BYTES, stream, p);
    hipLaunchKernelGGL(phase_kernel<6>, dim3(grid), dim3(256), LDS_BYTES, stream, p);
    hipLaunchKernelGGL(phase_kernel<7>, dim3(grid), dim3(256), LDS_BYTES, stream, p);
#endif
}
```

```cpp
#include <hip/hip_runtime.h>
#include <stdint.h>
#include <stdio.h>
#define DI __device__ __forceinline__

#ifndef ONE_LAUNCH
#define ONE_LAUNCH 1
#endif

typedef unsigned short bf16_t;
typedef short bf16x8 __attribute__((ext_vector_type(8)));
typedef float f32x4 __attribute__((ext_vector_type(4)));
typedef float f32x16 __attribute__((ext_vector_type(16)));
typedef float f32x2_t __attribute__((ext_vector_type(2)));
typedef unsigned u32x4 __attribute__((ext_vector_type(4)));
typedef unsigned u32x2 __attribute__((ext_vector_type(2)));
#define LAUNDER(v) asm volatile("" : "+v"(v))
DI u32x4 mk4(unsigned a, unsigned b, unsigned c, unsigned d) { return (u32x4){a, b, c, d}; }
DI u32x2 mk2(unsigned a, unsigned b) { return (u32x2){a, b}; }

typedef __bf16 bf16x2_t __attribute__((ext_vector_type(2)));

constexpr int NB = 16, NT_ = 4096, DM = 1024, NTOK = NB * NT_;
constexpr int LDU = 2176;
constexpr int UQ = 0, UKV = 256, UR = 384, UK = 896, UV = 1408, UXW = 1920, UXA = 1952, UXG = 1984, UPE = 2080;
constexpr int NEXP = 256, TOPK = 8;
constexpr int LDS_BYTES = 73728;
constexpr float QSCALE = 0.14724444f;

#define XB_TMO      128
#define XB_XCNT(j)  (256  + 64 * (j))
#define XB_XSUB(j)  (1280 + 64 * (j))
#define XB_XGEN(j)  (2304 + 64 * (j))
#define XB_TOP      3328
#define XB_TOPGEN   3392
#define XCD_BAR_WORDS 3456
#define XB_SPIN_CAP (1u << 22)
#define LAS __attribute__((address_space(3)))
constexpr int CTRL_ATTNQ = 4096, CTRL_ECNT = 4352, CTRL_WORDS = 8192;

DI unsigned xb_ld(unsigned* p)              { return __hip_atomic_load(p, __ATOMIC_RELAXED, __HIP_MEMORY_SCOPE_AGENT); }
DI unsigned xb_add(unsigned* p, unsigned v) { return __hip_atomic_fetch_add(p, v, __ATOMIC_RELAXED, __HIP_MEMORY_SCOPE_AGENT); }
DI unsigned xb_xcc_id() { return (unsigned)__builtin_amdgcn_s_getreg((3 << 11) | 20) & 0xFu; }
#define XB_SPIN(cond, bar) do { unsigned _sp = 0; while (cond) { __builtin_amdgcn_s_sleep(1); \
    if ((++_sp & 255u) == 0u) { if (xb_ld(&(bar)[XB_TMO])) break; if (_sp > XB_SPIN_CAP) { atomicAdd(&(bar)[XB_TMO], 1u); break; } } } } while (0)

struct XcdBarrier { unsigned* bar; unsigned x; volatile LAS unsigned* st; };

DI XcdBarrier xcd_barrier_post(unsigned* bar, volatile LAS unsigned* st) {
    XcdBarrier b; b.bar = bar; b.x = xb_xcc_id(); b.st = st;
    if (threadIdx.x == 0) (void)xb_add(&bar[XB_XCNT(b.x)], 1u);
    return b;
}
DI void xcd_barrier_complete(unsigned* bar, unsigned x, unsigned& nloc, unsigned& nx) {
    const unsigned G = gridDim.x * gridDim.y * gridDim.z;
    unsigned sum, cnt, mine, sp = 0u;
    for (;;) {
        sum = 0u; cnt = 0u; mine = 0u;
#pragma unroll
        for (unsigned j = 0; j < 16; ++j) { const unsigned c = xb_ld(&bar[XB_XCNT(j)]); sum += c; cnt += (c > 0u) ? 1u : 0u; mine = (j == x) ? c : mine; }
        if (sum == G) break;
        __builtin_amdgcn_s_sleep(1);
        if ((++sp & 255u) == 0u) { if (xb_ld(&bar[XB_TMO])) break; if (sp > XB_SPIN_CAP) { atomicAdd(&bar[XB_TMO], 1u); break; } }
    }
    nloc = mine > 0u ? mine : 1u; nx = cnt > 0u ? cnt : 1u;
}
DI void xcd_barrier(const XcdBarrier& b) {
    asm volatile("s_waitcnt vmcnt(0)" ::: "memory");
    __syncthreads();
    if (threadIdx.x == 0) {
        unsigned* bar = b.bar;
        __builtin_amdgcn_s_waitcnt(0);
        unsigned nloc = b.st[0], nx = b.st[1];
        if (nloc == 0u) { xcd_barrier_complete(bar, b.x, nloc, nx); b.st[0] = nloc; b.st[1] = nx; }
        const unsigned old = xb_add(&bar[XB_XSUB(b.x)], 1u);
        const unsigned gen = old / nloc;
        if (old + 1u == (gen + 1u) * nloc) {
            __builtin_amdgcn_fence(__ATOMIC_RELEASE, "agent");
            asm volatile("s_waitcnt vmcnt(0)" ::: "memory");
            const unsigned og = xb_add(&bar[XB_TOP], 1u);
            const unsigned tg = og / nx;
            if (og + 1u == (tg + 1u) * nx) xb_add(&bar[XB_TOPGEN], 1u);
            else XB_SPIN(xb_ld(&bar[XB_TOPGEN]) == tg, bar);
            __builtin_amdgcn_fence(__ATOMIC_ACQUIRE, "agent");
            xb_add(&bar[XB_XGEN(b.x)], 1u);
            asm volatile("s_waitcnt vmcnt(0)" ::: "memory");
        } else {
            XB_SPIN(xb_ld(&bar[XB_XGEN(b.x)]) == gen, bar);
            __builtin_amdgcn_fence(__ATOMIC_ACQUIRE, "agent");
            asm volatile("s_waitcnt vmcnt(0)" ::: "memory");
        }
    }
    __syncthreads();
}

struct Params {
    const float* x; const float* c; const int* positions; const float* ada_w; const float* ada_b; const float* norm_mix; const float* w_in;
    const float* rwkv_mu; const float* decay_w0; const float* decay_up; const float* iclr_a0; const float* iclr_up; const float* gate_up;
    const float* k_k; const float* k_a; const float* r_k; const float* ln_w; const float* ln_b;
    const float* q_a_norm; const float* w_q_b; const float* kv_a_norm; const float* w_kv_b; const float* q_norm; const float* k_norm;
    const float* w_out; const float* norm_ffn; const float* w_router; const float* router_bias;
    const float* w_e_gu; const float* w_e_d; const float* w_sh_gu; const float* w_sh_d;
    float* out;
    unsigned* ctrl; float* mod; float* rope;
    bf16_t* win_t; bf16_t* wq_t; bf16_t* wkv_t; bf16_t* wdec_t; bf16_t* wiclr_t; bf16_t* wgate_t; bf16_t* wout_t; bf16_t* wr_t; bf16_t* wsgu_t; bf16_t* wsd_t;
    bf16_t* wegu_t; bf16_t* wed_t;
    bf16_t* H; int* topk_idx; float* topk_w; int* elist; unsigned char* bscr;
    bf16_t* U; bf16_t* Q; bf16_t* Kb; bf16_t* Vt; bf16_t* SC; bf16_t* Gg; float* yraw; bf16_t* Y; bf16_t* slot;
};
constexpr size_t BSCR_PER_BLOCK = 196608;

DI float bf2f(bf16_t v) { return __uint_as_float(((unsigned)v) << 16); }
DI unsigned pk2(float a, float b) { f32x2_t f = {a, b}; bf16x2_t r = __builtin_convertvector(f, bf16x2_t); return __builtin_bit_cast(unsigned, r); }
DI bf16_t f2bf(float a) { return (bf16_t)(pk2(a, 0.f) & 0xffffu); }
DI float lo2f(unsigned w) { return __uint_as_float(w << 16); }
DI float hi2f(unsigned w) { return __uint_as_float(w & 0xffff0000u); }
DI float sigmoidf_(float x) { return 1.0f / (1.0f + __expf(-x)); }
DI float wave_sum(float v) {
#pragma unroll
    for (int o = 32; o > 0; o >>= 1) v += __shfl_xor(v, o);
    return v;
}
DI float dpp_sum8(float s) {
    s += __builtin_bit_cast(float, __builtin_amdgcn_update_dpp(0, __builtin_bit_cast(int, s), 0xB1, 0xf, 0xf, true));
    s += __builtin_bit_cast(float, __builtin_amdgcn_update_dpp(0, __builtin_bit_cast(int, s), 0x4E, 0xf, 0xf, true));
    s += __builtin_bit_cast(float, __builtin_amdgcn_update_dpp(0, __builtin_bit_cast(int, s), 0x141, 0xf, 0xf, true));
    return s;
}

struct APlain { const bf16_t* base; int ld; DI const bf16_t* row(int r) const { return base + (size_t)r * ld; } };
struct AGather { const bf16_t* base; const int* idx; DI const bf16_t* row(int r) const { return base + (size_t)idx[r] * DM; } };

template <int NT, int BK, class AP>
DI void gemm_core(const AP ap, const bf16_t* __restrict__ Bt, const int ldb, const int K, f32x4 (&acc)[4][NT], unsigned char* lds) {
    constexpr int CPR = BK / 8, RB = BK * 2, R256 = 256 / RB, BN = NT * 32;
    constexpr int A_BYTES = 128 * RB, B_BYTES = BN * RB;
    constexpr int A_CH = (128 * CPR) / 256, B_TOT = BN * CPR, B_CH = (B_TOT + 255) / 256, RSTEP = 256 / CPR;
    int t = threadIdx.x; LAUNDER(t);
    const int lane = t & 63, wid = t >> 6, wr = wid >> 1, wc = wid & 1;
    const int ch = t % CPR, r0 = t / CPR;
    const bf16_t* pa[A_CH]; const bf16_t* pb[B_CH]; int offa[A_CH], offb[B_CH]; bool vb[B_CH];
#pragma unroll
    for (int i = 0; i < A_CH; ++i) { const int row = r0 + i * RSTEP; pa[i] = ap.row(row) + ch * 8; offa[i] = row * RB + ((ch ^ ((row / R256) & (CPR - 1))) << 4); }
#pragma unroll
    for (int i = 0; i < B_CH; ++i) { const int row = r0 + i * RSTEP; vb[i] = row < BN; const int rr = vb[i] ? row : 0; pb[i] = Bt + (size_t)rr * ldb + ch * 8; offb[i] = 2 * A_BYTES + rr * RB + ((ch ^ ((rr / R256) & (CPR - 1))) << 4); }
#pragma unroll
    for (int i = 0; i < 4; ++i)
#pragma unroll
        for (int j = 0; j < NT; ++j) acc[i][j] = (f32x4){0.f, 0.f, 0.f, 0.f};
    const int KT = K / BK;
    u32x4 ra[A_CH], rb[B_CH];
#pragma unroll
    for (int i = 0; i < A_CH; ++i) ra[i] = *(const u32x4*)(pa[i]);
#pragma unroll
    for (int i = 0; i < B_CH; ++i) rb[i] = *(const u32x4*)(pb[i]);
    __syncthreads();
#pragma unroll
    for (int i = 0; i < A_CH; ++i) *(u32x4*)(lds + offa[i]) = ra[i];
#pragma unroll
    for (int i = 0; i < B_CH; ++i) if (vb[i]) *(u32x4*)(lds + offb[i]) = rb[i];
    __syncthreads();
    const int sw = ((lane & 15) / R256) & (CPR - 1);
    const int arow = (wr * 64 + (lane & 15)) * RB, brow = (wc * NT * 16 + (lane & 15)) * RB;
    for (int kt = 0; kt < KT; ++kt) {
        const int cur = kt & 1;
        if (kt + 1 < KT) {
#pragma unroll
            for (int i = 0; i < A_CH; ++i) ra[i] = *(const u32x4*)(pa[i] + (kt + 1) * BK);
#pragma unroll
            for (int i = 0; i < B_CH; ++i) rb[i] = *(const u32x4*)(pb[i] + (kt + 1) * BK);
        }
        const unsigned char* Ab = lds + cur * A_BYTES + arow;
        const unsigned char* Bb = lds + 2 * A_BYTES + cur * B_BYTES + brow;
#pragma unroll
        for (int ks = 0; ks < BK / 32; ++ks) {
            const int co = ((ks * 4 + (lane >> 4)) ^ sw) << 4;
            bf16x8 af[4], bfr[NT];
#pragma unroll
            for (int i = 0; i < 4; ++i) af[i] = *(const bf16x8*)(Ab + i * 16 * RB + co);
#pragma unroll
            for (int j = 0; j < NT; ++j) bfr[j] = *(const bf16x8*)(Bb + j * 16 * RB + co);
#pragma unroll
            for (int i = 0; i < 4; ++i)
#pragma unroll
                for (int j = 0; j < NT; ++j) acc[i][j] = __builtin_amdgcn_mfma_f32_16x16x32_bf16(bfr[j], af[i], acc[i][j], 0, 0, 0);
        }
        if (kt + 1 < KT) {
            const int nb = cur ^ 1;
#pragma unroll
            for (int i = 0; i < A_CH; ++i) *(u32x4*)(lds + nb * A_BYTES + offa[i]) = ra[i];
#pragma unroll
            for (int i = 0; i < B_CH; ++i) if (vb[i]) *(u32x4*)(lds + nb * B_BYTES + offb[i]) = rb[i];
        }
        __syncthreads();
    }
}

template <int NT> DI void acc_to_lds(const f32x4 (&acc)[4][NT], float* tile, const int ld) {
    int t = threadIdx.x; LAUNDER(t);
    const int lane = t & 63, wid = t >> 6, wr = wid >> 1, wc = wid & 1;
#pragma unroll
    for (int i = 0; i < 4; ++i)
#pragma unroll
        for (int j = 0; j < NT; ++j) {
            const int row = wr * 64 + i * 16 + (lane & 15), col = wc * NT * 16 + j * 16 + (lane >> 4) * 4;
            *(f32x4*)(tile + row * ld + col) = acc[i][j];
        }
}

DI int map_win(int n) { return n < 384 ? n + 1696 : (n < 2080 ? n - 384 : (n < 2112 ? n : -1)); }
DI int map_gu(int n) { const int tile = n >> 7, w = n & 127; return w < 64 ? tile * 64 + w : 256 + tile * 64 + (w - 64); }

template <int MAP> DI void tconv_simple(const float* __restrict__ src, bf16_t* __restrict__ dst, int K, int Ns, int Nd, const float* __restrict__ scale, int gtid, int gthreads) {
    const int total = Nd * K;
    for (int idx = gtid; idx < total; idx += gthreads) {
        const int n = idx / K, k = idx - n * K;
        const int m = (MAP == 1) ? map_win(n) : (MAP == 2 ? map_gu(n) : n);
        float v = 0.f;
        if (m >= 0) { v = src[(size_t)k * Ns + m]; if (scale) v *= scale[k]; }
        dst[idx] = f2bf(v);
    }
}
template <int MAP> DI void tconv_tiled(const float* __restrict__ src, bf16_t* __restrict__ dst, int E, int K, int N, float* ldsf, int bid, int G) {
    const int tk = K / 64, tn = N / 64, per = tk * tn, total = E * per;
    const int t = threadIdx.x;
    for (int tile = bid; tile < total; tile += G) {
        const int e = tile / per, r = tile - e * per, kt = r / tn, nt = r - kt * tn;
        const float* s = src + (size_t)e * K * N + (size_t)(kt * 64) * N;
        __syncthreads();
        {
            const int nl = t & 63, n = nt * 64 + nl;
            const int m = (MAP == 2) ? map_gu(n) : n;
#pragma unroll
            for (int i = 0; i < 16; ++i) { const int kl = (t >> 6) + 4 * i; ldsf[kl * 65 + nl] = s[(size_t)kl * N + m]; }
        }
        __syncthreads();
        {
            const int nl = t >> 2, kc = (t & 3) * 16;
            unsigned w[8];
#pragma unroll
            for (int i = 0; i < 8; ++i) w[i] = pk2(ldsf[(kc + 2 * i) * 65 + nl], ldsf[(kc + 2 * i + 1) * 65 + nl]);
            bf16_t* d = dst + (size_t)e * K * N + (size_t)(nt * 64 + nl) * K + kt * 64 + kc;
            *(u32x4*)(d) = mk4(w[0], w[1], w[2], w[3]);
            *(u32x4*)(d + 8) = mk4(w[4], w[5], w[6], w[7]);
        }
    }
}

DI void phase0(const Params& p, unsigned char* lds, int bid, int G) {
    const int t = threadIdx.x;
    float* ldsf = (float*)lds;
    for (int item = bid; item < 192; item += G) {
        __syncthreads();
        for (int i = t; i < NB * DM; i += 256) { const float v = p.c[i]; ldsf[i] = v * sigmoidf_(v); }
        __syncthreads();
        const int col = item * 32 + (t & 31), kp = t >> 5;
        float a[NB];
#pragma unroll
        for (int b = 0; b < NB; ++b) a[b] = 0.f;
        for (int k = kp * 128; k < kp * 128 + 128; ++k) {
            const float w = p.ada_w[(size_t)k * 6144 + col];
#pragma unroll
            for (int b = 0; b < NB; ++b) a[b] += ldsf[b * DM + k] * w;
        }
        __syncthreads();
#pragma unroll
        for (int b = 0; b < NB; ++b) ldsf[(kp * NB + b) * 32 + (t & 31)] = a[b];
        __syncthreads();
        for (int o = t; o < NB * 32; o += 256) {
            const int b = o >> 5, cl = o & 31; float s = 0.f;
#pragma unroll
            for (int q = 0; q < 8; ++q) s += ldsf[(q * NB + b) * 32 + cl];
            p.mod[b * 6144 + item * 32 + cl] = s + p.ada_b[item * 32 + cl];
        }
    }
    __syncthreads();
    const int gtid = bid * 256 + t, gth = G * 256;
    tconv_simple<1>(p.w_in, p.win_t, 1024, 2112, LDU, nullptr, gtid, gth);
    tconv_simple<0>(p.w_q_b, p.wq_t, 256, 768, 768, p.q_a_norm, gtid, gth);
    tconv_simple<0>(p.w_kv_b, p.wkv_t, 128, 1024, 1024, p.kv_a_norm, gtid, gth);
    tconv_simple<0>(p.decay_up, p.wdec_t, 32, 512, 512, nullptr, gtid, gth);
    tconv_simple<0>(p.iclr_up, p.wiclr_t, 32, 512, 512, nullptr, gtid, gth);
    tconv_simple<0>(p.gate_up, p.wgate_t, 96, 512, 512, nullptr, gtid, gth);
    tconv_simple<0>(p.w_out, p.wout_t, 1024, 1024, 1024, nullptr, gtid, gth);
    tconv_simple<0>(p.w_router, p.wr_t, 1024, 256, 256, nullptr, gtid, gth);
    tconv_simple<2>(p.w_sh_gu, p.wsgu_t, 1024, 512, 512, nullptr, gtid, gth);
    tconv_simple<0>(p.w_sh_d, p.wsd_t, 256, 1024, 1024, nullptr, gtid, gth);
    tconv_tiled<2>(p.w_e_gu, p.wegu_t, NEXP, 1024, 512, ldsf, bid, G);
    tconv_tiled<0>(p.w_e_d, p.wed_t, NEXP, 256, 1024, ldsf, bid, G);
}

DI void phase1(const Params& p, int bid, int G) {
    const int lane = threadIdx.x & 63, gw = bid * 4 + (threadIdx.x >> 6), nw = G * 4;
    for (int row = gw; row < NTOK; row += nw) {
        const int b = row >> 12;
        const float* xr = p.x + (size_t)row * DM;
        f32x4 v[4]; float ss = 0.f;
#pragma unroll
        for (int i = 0; i < 4; ++i) { v[i] = *(const f32x4*)(xr + lane * 4 + 256 * i); ss += v[i][0] * v[i][0] + v[i][1] * v[i][1] + v[i][2] * v[i][2] + v[i][3] * v[i][3]; }
        ss = wave_sum(ss);
        const float rs = rsqrtf(ss * (1.0f / DM) + 1e-6f);
        const float* mod = p.mod + b * 6144;
#pragma unroll
        for (int i = 0; i < 4; ++i) {
            const int c = lane * 4 + 256 * i;
            const f32x4 g = *(const f32x4*)(p.norm_mix + c), sh = *(const f32x4*)(mod + c), sc = *(const f32x4*)(mod + 1024 + c);
            float o[4];
#pragma unroll
            for (int e = 0; e < 4; ++e) o[e] = v[i][e] * rs * g[e] * (1.0f + sc[e]) + sh[e];
            *(u32x2*)(p.H + (size_t)row * DM + c) = mk2(pk2(o[0], o[1]), pk2(o[2], o[3]));
        }
        if (lane < 16) {
            const double inv = exp(-(double)lane * (9.210340371976184 / 16.0));
            const double ang = (double)p.positions[row] * inv;
            p.rope[(size_t)row * 32 + lane] = (float)cos(ang);
            p.rope[(size_t)row * 32 + 16 + lane] = (float)sin(ang);
        }
    }
}

DI void phase2(const Params& p, unsigned char* lds, int bid, int G) {
    constexpr int NCT = LDU / 128;
    const int t = threadIdx.x, lane = t & 63, wid = t >> 6, wr = wid >> 1, wc = wid & 1;
    const int total = (NTOK / 128) * NCT;
    for (int L = bid; L < total; L += G) {
        const int xcd = L & 7, j = L >> 3, rt = 8 * (j / NCT) + xcd, ct = j % NCT;
        f32x4 acc[4][4];
        APlain ap{p.H + (size_t)rt * 128 * DM, DM};
        gemm_core<4, 64>(ap, p.win_t + (size_t)ct * 128 * DM, DM, DM, acc, lds);
        bf16_t* tile = (bf16_t*)lds;
#pragma unroll
        for (int i = 0; i < 4; ++i)
#pragma unroll
            for (int jj = 0; jj < 4; ++jj) {
                const int row = wr * 64 + i * 16 + (lane & 15), col = wc * 64 + jj * 16 + (lane >> 4) * 4;
                *(u32x2*)(tile + row * 136 + col) = mk2(pk2(acc[i][jj][0], acc[i][jj][1]), pk2(acc[i][jj][2], acc[i][jj][3]));
            }
        __syncthreads();
#pragma unroll
        for (int i = 0; i < 8; ++i) {
            const int c = t + 256 * i, row = c >> 4, chn = c & 15;
            *(u32x4*)(p.U + (size_t)(rt * 128 + row) * LDU + ct * 128 + chn * 8) = *(const u32x4*)(tile + row * 136 + chn * 8);
        }
    }
}

DI void head_norm_rope_store(float (&v)[48], const int half, const float* __restrict__ gain, const float* __restrict__ ropeRow, const float scale, bf16_t* __restrict__ dstRow) {
    float ss = 0.f;
#pragma unroll
    for (int c = 0; c < 48; ++c) ss += v[c] * v[c];
    ss += __shfl_xor(ss, 1);
    const float rs = rsqrtf(ss * (1.0f / 96.0f) + 1e-6f);
#pragma unroll
    for (int c = 0; c < 48; ++c) v[c] = v[c] * rs * gain[half * 48 + c];
    if (half) {
#pragma unroll
        for (int i = 0; i < 16; ++i) {
            const float cs = ropeRow[i], sn = ropeRow[16 + i], x1 = v[16 + i], x2 = v[32 + i];
            v[16 + i] = x1 * cs - x2 * sn; v[32 + i] = x2 * cs + x1 * sn;
        }
    }
#pragma unroll
    for (int c = 0; c < 6; ++c)
        *(u32x4*)(dstRow + half * 48 + c * 8) = mk4(pk2(v[c * 8] * scale, v[c * 8 + 1] * scale), pk2(v[c * 8 + 2] * scale, v[c * 8 + 3] * scale),
                                                          pk2(v[c * 8 + 4] * scale, v[c * 8 + 5] * scale), pk2(v[c * 8 + 6] * scale, v[c * 8 + 7] * scale));
}

DI float shifted(const bf16_t* __restrict__ urow, const bool has_prev, const int col, const float mu) {
    const float cur = bf2f(urow[col]);
    const float prev = has_prev ? bf2f(urow[col - LDU]) : 0.f;
    return cur + (prev - cur) * mu;
}

DI void phase3(const Params& p, unsigned char* lds, int bid, int G) {
    const int t = threadIdx.x;
    float* tile = (float*)lds;
    float* rstd_q = (float*)(lds + 69632);
    float* rstd_kv = rstd_q + 128;
    bf16_t* lora = (bf16_t*)(p.bscr + (size_t)bid * BSCR_PER_BLOCK + 131072);
    for (int rt = bid; rt < NTOK / 128; rt += G) {
        __syncthreads();
        {
            int tl = t; LAUNDER(tl);
            const int row = tl >> 1, half = tl & 1, grow = rt * 128 + row;
            const bf16_t* urow = p.U + (size_t)grow * LDU;
            float s = 0.f;
#pragma unroll
            for (int c = 0; c < 16; ++c) { const u32x4 w = *(const u32x4*)(urow + UQ + half * 128 + c * 8);
                s += lo2f(w.x) * lo2f(w.x) + hi2f(w.x) * hi2f(w.x) + lo2f(w.y) * lo2f(w.y) + hi2f(w.y) * hi2f(w.y) + lo2f(w.z) * lo2f(w.z) + hi2f(w.z) * hi2f(w.z) + lo2f(w.w) * lo2f(w.w) + hi2f(w.w) * hi2f(w.w); }
            s += __shfl_xor(s, 1);
            float s2 = 0.f;
#pragma unroll
            for (int c = 0; c < 8; ++c) { const u32x4 w = *(const u32x4*)(urow + UKV + half * 64 + c * 8);
                s2 += lo2f(w.x) * lo2f(w.x) + hi2f(w.x) * hi2f(w.x) + lo2f(w.y) * lo2f(w.y) + hi2f(w.y) * hi2f(w.y) + lo2f(w.z) * lo2f(w.z) + hi2f(w.z) * hi2f(w.z) + lo2f(w.w) * lo2f(w.w) + hi2f(w.w) * hi2f(w.w); }
            s2 += __shfl_xor(s2, 1);
            if (half == 0) { rstd_q[row] = rsqrtf(s * (1.0f / 256.0f) + 1e-6f); rstd_kv[row] = rsqrtf(s2 * (1.0f / 128.0f) + 1e-6f); }
        }
        {
            int tl = t; LAUNDER(tl);
            const int row = tl >> 1, half = tl & 1, grow = rt * 128 + row, tt = grow & 4095;
            const bf16_t* urow = p.U + (size_t)grow * LDU;
            const bool hp = tt > 0;
#pragma unroll 4
            for (int c = 0; c < 80; ++c) {
                const int cc = half * 80 + c;
                float v = shifted(urow, hp, UXW + cc, p.rwkv_mu[1536 + cc]);
                v = cc < 32 ? tanhf(v) : (cc < 64 ? v : sigmoidf_(v));
                lora[row * 160 + cc] = f2bf(v);
            }
        }
        __syncthreads();
#pragma unroll 1
        for (int h = 0; h < 8; ++h) {
            f32x4 acc[4][3];
            APlain ap{p.U + (size_t)rt * 128 * LDU + UQ, LDU};
            gemm_core<3, 64>(ap, p.wq_t + (size_t)h * 96 * 256, 256, 256, acc, lds);
            acc_to_lds<3>(acc, tile, 100);
            __syncthreads();
            int tl = t; LAUNDER(tl);
            const int row = tl >> 1, half = tl & 1, grow = rt * 128 + row, b = grow >> 12, tt = grow & 4095;
            float v[48]; const float rq = rstd_q[row];
#pragma unroll
            for (int c = 0; c < 12; ++c) { const f32x4 x = *(const f32x4*)(tile + row * 100 + half * 48 + c * 4); v[c * 4] = x[0] * rq; v[c * 4 + 1] = x[1] * rq; v[c * 4 + 2] = x[2] * rq; v[c * 4 + 3] = x[3] * rq; }
            head_norm_rope_store(v, half, p.q_norm, p.rope + (size_t)grow * 32, QSCALE, p.Q + ((size_t)(b * 8 + h) * NT_ + tt) * 96);
        }
#pragma unroll 1
        for (int h = 0; h < 8; ++h) {
            f32x4 acc[4][4];
            APlain ap{p.U + (size_t)rt * 128 * LDU + UKV, LDU};
            gemm_core<4, 64>(ap, p.wkv_t + (size_t)h * 128 * 128, 128, 128, acc, lds);
            acc_to_lds<4>(acc, tile, 132);
            __syncthreads();
            {
                int tl = t; LAUNDER(tl);
                const int row = tl >> 1, half = tl & 1, grow = rt * 128 + row, b = grow >> 12, tt = grow & 4095;
                const bf16_t* urow = p.U + (size_t)grow * LDU;
                float v[48]; const float rk = rstd_kv[row];
#pragma unroll
                for (int c = 0; c < 48; ++c) {
                    const int col = half * 48 + c;
                    v[c] = col < 64 ? tile[row * 132 + col] * rk : bf2f(urow[UPE + col - 64]);
                }
                head_norm_rope_store(v, half, p.k_norm, p.rope + (size_t)grow * 32, 1.0f, p.Kb + ((size_t)(b * 8 + h) * NT_ + tt) * 96);
            }
            {
                int tl = t; LAUNDER(tl);
                const int dv = tl >> 2, tc = tl & 3;
                unsigned w[16];
#pragma unroll
                for (int i = 0; i < 16; ++i) { const int r0 = tc * 32 + 2 * i; w[i] = pk2(tile[r0 * 132 + 64 + dv] * rstd_kv[r0], tile[(r0 + 1) * 132 + 64 + dv] * rstd_kv[r0 + 1]); }
                bf16_t* d = p.Vt + ((size_t)((rt >> 5) * 8 + h) * 64 + dv) * NT_ + ((rt & 31) * 128) + tc * 32;
#pragma unroll
                for (int i = 0; i < 4; ++i) *(u32x4*)(d + i * 8) = mk4(w[4 * i], w[4 * i + 1], w[4 * i + 2], w[4 * i + 3]);
            }
        }
#pragma unroll 1
        for (int ct = 0; ct < 4; ++ct) {
            {
                f32x4 acc[4][4];
                APlain ap{lora, 160};
                gemm_core<4, 32>(ap, p.wdec_t + (size_t)ct * 128 * 32, 32, 32, acc, lds);
                acc_to_lds<4>(acc, tile, 132);
                __syncthreads();
                int tl = t; LAUNDER(tl);
                const int row = tl >> 1, half = tl & 1, grow = rt * 128 + row, b = grow >> 12, tt = grow & 4095;
                const int head = ct * 2 + half, c0 = head * 64;
                const bf16_t* urow = p.U + (size_t)grow * LDU; (void)urow;
                const bool hp = tt > 0; (void)hp;
                bf16_t* sc = p.SC + ((size_t)(b * 8 + head) * NT_ + tt) * 384; (void)sc;
#pragma unroll 2
                for (int c8 = 0; c8 < 8; ++c8) {
                    float o[8];
#pragma unroll
                    for (int e = 0; e < 8; ++e) {
                        const int c = c8 * 8 + e;
                        const float z = -(p.decay_w0[c0 + c] + tile[row * 132 + half * 64 + c]);
                        const float sp = fmaxf(z, 0.f) + log1pf(__expf(-fabsf(z)));
                        const float lw = -sp - 0.5f;
                        o[e] = -expm1f(-__expf(lw));
                    }
                    *(u32x4*)(sc + c8 * 8) = mk4(pk2(o[0], o[1]), pk2(o[2], o[3]), pk2(o[4], o[5]), pk2(o[6], o[7]));
                }
            }
            {
                f32x4 acc[4][4];
                APlain ap{lora + 32, 160};
                gemm_core<4, 32>(ap, p.wiclr_t + (size_t)ct * 128 * 32, 32, 32, acc, lds);
                acc_to_lds<4>(acc, tile, 132);
                __syncthreads();
                int tl = t; LAUNDER(tl);
                const int row = tl >> 1, half = tl & 1, grow = rt * 128 + row, b = grow >> 12, tt = grow & 4095;
                const int head = ct * 2 + half, c0 = head * 64;
                const bf16_t* urow = p.U + (size_t)grow * LDU; (void)urow;
                const bool hp = tt > 0; (void)hp;
                bf16_t* sc = p.SC + ((size_t)(b * 8 + head) * NT_ + tt) * 384; (void)sc;
                float ssq = 0.f;
                for (int c = 0; c < 64; ++c) { const float ks = shifted(urow, hp, UK + c0 + c, p.rwkv_mu[512 + c0 + c]) * p.k_k[c0 + c]; ssq += ks * ks; }
                const float rn = rsqrtf(fmaxf(ssq, 1e-24f));
#pragma unroll 1
                for (int c8 = 0; c8 < 8; ++c8) {
                    float okk[8], obb[8], okp[8], ov[8], orr[8];
#pragma unroll
                    for (int e = 0; e < 8; ++e) {
                        const int c = c8 * 8 + e;
                        const float a = sigmoidf_(p.iclr_a0[c0 + c] + tile[row * 132 + half * 64 + c]);
                        const float ks = shifted(urow, hp, UK + c0 + c, p.rwkv_mu[512 + c0 + c]);
                        const float kk = ks * p.k_k[c0 + c] * rn;
                        okk[e] = kk; obb[e] = a * kk; okp[e] = ks * (1.0f + (a - 1.0f) * p.k_a[c0 + c]);
                        ov[e] = shifted(urow, hp, UV + c0 + c, p.rwkv_mu[1024 + c0 + c]);
                        orr[e] = shifted(urow, hp, UR + c0 + c, p.rwkv_mu[c0 + c]);
                    }
                    *(u32x4*)(sc + 64 + c8 * 8) = mk4(pk2(okk[0], okk[1]), pk2(okk[2], okk[3]), pk2(okk[4], okk[5]), pk2(okk[6], okk[7]));
                    *(u32x4*)(sc + 128 + c8 * 8) = mk4(pk2(obb[0], obb[1]), pk2(obb[2], obb[3]), pk2(obb[4], obb[5]), pk2(obb[6], obb[7]));
                    *(u32x4*)(sc + 192 + c8 * 8) = mk4(pk2(okp[0], okp[1]), pk2(okp[2], okp[3]), pk2(okp[4], okp[5]), pk2(okp[6], okp[7]));
                    *(u32x4*)(sc + 256 + c8 * 8) = mk4(pk2(ov[0], ov[1]), pk2(ov[2], ov[3]), pk2(ov[4], ov[5]), pk2(ov[6], ov[7]));
                    *(u32x4*)(sc + 320 + c8 * 8) = mk4(pk2(orr[0], orr[1]), pk2(orr[2], orr[3]), pk2(orr[4], orr[5]), pk2(orr[6], orr[7]));
                }
            }
            {
                f32x4 acc[4][4];
                APlain ap{lora + 64, 160};
                gemm_core<4, 32>(ap, p.wgate_t + (size_t)ct * 128 * 96, 96, 96, acc, lds);
                acc_to_lds<4>(acc, tile, 132);
                __syncthreads();
                int tl = t; LAUNDER(tl);
                const int row = tl >> 1, half = tl & 1, grow = rt * 128 + row, b = grow >> 12, tt = grow & 4095;
                const int head = ct * 2 + half, c0 = head * 64;
                const bf16_t* urow = p.U + (size_t)grow * LDU; (void)urow;
                const bool hp = tt > 0; (void)hp;
                bf16_t* sc = p.SC + ((size_t)(b * 8 + head) * NT_ + tt) * 384; (void)sc;
                bf16_t* g = p.Gg + (size_t)grow * 512 + c0;
#pragma unroll
                for (int c8 = 0; c8 < 8; ++c8) {
                    const f32x4 x0 = *(const f32x4*)(tile + row * 132 + half * 64 + c8 * 8), x1 = *(const f32x4*)(tile + row * 132 + half * 64 + c8 * 8 + 4);
                    *(u32x4*)(g + c8 * 8) = mk4(pk2(x0[0], x0[1]), pk2(x0[2], x0[3]), pk2(x1[0], x1[1]), pk2(x1[2], x1[3]));
                }
            }
        }
    }
}

DI void scan_task(const Params& p, unsigned char* lds, const int task) {
    constexpr int CS = 16;
    const int t = threadIdx.x, lane = t & 63, w = t >> 6;
    const int bh = task >> 1, hf = task & 1, b = bh >> 3, head = bh & 7;
    const int rloc = w * 8 + (lane >> 3), kseg = lane & 7;
    const int vrow = hf * 32 + rloc;
    float* stage = (float*)lds;
    float* ybuf = (float*)(lds + 49152);
    const bf16_t* src = p.SC + (size_t)bh * NT_ * 384;
    float s[8];
#pragma unroll
    for (int j = 0; j < 8; ++j) s[j] = 0.f;
    u32x4 rg[3];
    __syncthreads();
#pragma unroll
    for (int i = 0; i < 3; ++i) rg[i] = *(const u32x4*)(src + (size_t)(t + 256 * i) * 8);
#pragma unroll
    for (int i = 0; i < 3; ++i) { float* d = stage + (t + 256 * i) * 8;
        *(f32x4*)d = (f32x4){lo2f(rg[i].x), hi2f(rg[i].x), lo2f(rg[i].y), hi2f(rg[i].y)}; *(f32x4*)(d + 4) = (f32x4){lo2f(rg[i].z), hi2f(rg[i].z), lo2f(rg[i].w), hi2f(rg[i].w)}; }
    __syncthreads();
    constexpr int NCH = NT_ / CS;
    for (int c = 0; c < NCH; ++c) {
        const int cur = c & 1;
        if (c + 1 < NCH) {
#pragma unroll
            for (int i = 0; i < 3; ++i) rg[i] = *(const u32x4*)(src + (size_t)(c + 1) * CS * 384 + (size_t)(t + 256 * i) * 8);
        }
        if (c > 0) {
            const float* yb = ybuf + (cur ^ 1) * CS * 32;
            const int st = t >> 4, r2 = (t & 15) * 2;
            *(f32x2_t*)(p.yraw + ((size_t)(b * NT_ + (c - 1) * CS + st)) * 512 + head * 64 + hf * 32 + r2) = *(const f32x2_t*)(yb + st * 32 + r2);
        }
        const float* sb = stage + cur * CS * 384;
        float* yb = ybuf + cur * CS * 32;
#pragma unroll 4
        for (int st = 0; st < CS; ++st) {
            const float* q = sb + st * 384 + kseg * 8;
            const f32x4 d0 = *(const f32x4*)(q), d1 = *(const f32x4*)(q + 4);
            const f32x4 k0 = *(const f32x4*)(q + 64), k1 = *(const f32x4*)(q + 68);
            const f32x4 b0 = *(const f32x4*)(q + 128), b1 = *(const f32x4*)(q + 132);
            const f32x4 p0 = *(const f32x4*)(q + 192), p1 = *(const f32x4*)(q + 196);
            const f32x4 r0 = *(const f32x4*)(q + 320), r1 = *(const f32x4*)(q + 324);
            const float vv = sb[st * 384 + 256 + vrow];
            float dot = 0.f, tmp[8];
#pragma unroll
            for (int j = 0; j < 4; ++j) { dot += s[j] * k0[j]; dot += s[4 + j] * k1[j]; }
#pragma unroll
            for (int j = 0; j < 4; ++j) { tmp[j] = s[j] - s[j] * d0[j] + vv * p0[j]; tmp[4 + j] = s[4 + j] - s[4 + j] * d1[j] + vv * p1[j]; }
            dot = dpp_sum8(dot);
            float y = 0.f;
#pragma unroll
            for (int j = 0; j < 4; ++j) { s[j] = tmp[j] - dot * b0[j]; s[4 + j] = tmp[4 + j] - dot * b1[j]; y += s[j] * r0[j]; y += s[4 + j] * r1[j]; }
            y = dpp_sum8(y);
            if (kseg == 0) yb[st * 32 + rloc] = y;
        }
        if (c + 1 < NCH) {
            float* dbase = stage + (cur ^ 1) * CS * 384;
#pragma unroll
            for (int i = 0; i < 3; ++i) { float* d = dbase + (t + 256 * i) * 8;
                *(f32x4*)d = (f32x4){lo2f(rg[i].x), hi2f(rg[i].x), lo2f(rg[i].y), hi2f(rg[i].y)}; *(f32x4*)(d + 4) = (f32x4){lo2f(rg[i].z), hi2f(rg[i].z), lo2f(rg[i].w), hi2f(rg[i].w)}; }
        }
        __syncthreads();
    }
    {
        const float* yb = ybuf + ((NCH - 1) & 1) * CS * 32;
        const int st = t >> 4, r2 = (t & 15) * 2;
        *(f32x2_t*)(p.yraw + ((size_t)(b * NT_ + (NCH - 1) * CS + st)) * 512 + head * 64 + hf * 32 + r2) = *(const f32x2_t*)(yb + st * 32 + r2);
    }
}

DI void attn_item(const Params& p, unsigned char* lds, const int item) {
    constexpr int KROW = 208, VROW = 136, KB = 64 * KROW, BUF = KB + 64 * VROW;
    const int t = threadIdx.x, lane = t & 63, w = t >> 6, l31 = lane & 31, h = lane >> 5;
    const int qt = 31 - item / 128, bh = item % 128;
    const bf16_t* Kg = p.Kb + (size_t)bh * NT_ * 96;
    const bf16_t* Vg = p.Vt + (size_t)bh * 64 * NT_;
    const int q = qt * 128 + w * 32 + l31;
    bf16x8 qf[6];
    {
        const bf16_t* qrow = p.Q + ((size_t)bh * NT_ + q) * 96 + 8 * h;
#pragma unroll
        for (int s = 0; s < 6; ++s) qf[s] = *(const bf16x8*)(qrow + 16 * s);
    }
    f32x16 O[2];
#pragma unroll
    for (int i = 0; i < 16; ++i) { O[0][i] = 0.f; O[1][i] = 0.f; }
    float m = -INFINITY, l = 0.f;
    const int njt = 2 * qt + 2;
    int koff[3], kgo[3], voff[2], vgo[2];
#pragma unroll
    for (int i = 0; i < 3; ++i) { const int c = t + 256 * i, r = c / 12, ch = c - r * 12; koff[i] = r * KROW + ch * 16; kgo[i] = r * 96 + ch * 8; }
#pragma unroll
    for (int i = 0; i < 2; ++i) { const int c = t + 256 * i, dv = c >> 3, ch = c & 7; voff[i] = KB + dv * VROW + ch * 16; vgo[i] = dv * NT_ + ch * 8; }
    u32x4 rk[3], rv[2];
#pragma unroll
    for (int i = 0; i < 3; ++i) rk[i] = *(const u32x4*)(Kg + kgo[i]);
#pragma unroll
    for (int i = 0; i < 2; ++i) rv[i] = *(const u32x4*)(Vg + vgo[i]);
    __syncthreads();
#pragma unroll
    for (int i = 0; i < 3; ++i) *(u32x4*)(lds + koff[i]) = rk[i];
#pragma unroll
    for (int i = 0; i < 2; ++i) { *(u32x2*)(lds + voff[i]) = mk2(rv[i].x, rv[i].y); *(u32x2*)(lds + voff[i] + 8) = mk2(rv[i].z, rv[i].w); }
    __syncthreads();
    for (int j = 0; j < njt; ++j) {
        const int cur = j & 1;
        if (j + 1 < njt) {
#pragma unroll
            for (int i = 0; i < 3; ++i) rk[i] = *(const u32x4*)(Kg + (size_t)(j + 1) * 64 * 96 + kgo[i]);
#pragma unroll
            for (int i = 0; i < 2; ++i) rv[i] = *(const u32x4*)(Vg + (j + 1) * 64 + vgo[i]);
        }
        const bool active = (j * 64) <= (qt * 128 + w * 32 + 31);
        if (active) {
            const unsigned char* Kt = lds + cur * BUF;
            const unsigned char* Vtile = Kt + KB;
            f32x16 S[2];
#pragma unroll
            for (int k2 = 0; k2 < 2; ++k2) {
#pragma unroll
                for (int i = 0; i < 16; ++i) S[k2][i] = 0.f;
#pragma unroll
                for (int s = 0; s < 6; ++s) {
                    const bf16x8 kf = *(const bf16x8*)(Kt + (k2 * 32 + l31) * KROW + s * 32 + h * 16);
                    S[k2] = __builtin_amdgcn_mfma_f32_32x32x16_bf16(kf, qf[s], S[k2], 0, 0, 0);
                }
            }
            if (j >= 2 * qt) {
#pragma unroll
                for (int k2 = 0; k2 < 2; ++k2)
#pragma unroll
                    for (int i = 0; i < 16; ++i) { const int key = j * 64 + k2 * 32 + (i & 3) + 8 * (i >> 2) + 4 * h; if (key > q) S[k2][i] = -INFINITY; }
            }
            float mx = S[0][0];
#pragma unroll
            for (int i = 1; i < 16; ++i) mx = fmaxf(mx, S[0][i]);
#pragma unroll
            for (int i = 0; i < 16; ++i) mx = fmaxf(mx, S[1][i]);
            mx = fmaxf(mx, __shfl_xor(mx, 32));
            const float mn = fmaxf(m, mx);
            const float alpha = exp2f(m - mn);
            m = mn;
            float ps = 0.f;
#pragma unroll
            for (int k2 = 0; k2 < 2; ++k2)
#pragma unroll
                for (int i = 0; i < 16; ++i) { const float e = exp2f(S[k2][i] - mn); S[k2][i] = e; ps += e; }
            l = l * alpha + ps;
#pragma unroll
            for (int i = 0; i < 16; ++i) { O[0][i] *= alpha; O[1][i] *= alpha; }
#pragma unroll
            for (int k2 = 0; k2 < 2; ++k2)
#pragma unroll
                for (int s2 = 0; s2 < 2; ++s2) {
                    unsigned pw[4];
#pragma unroll
                    for (int e = 0; e < 4; ++e) pw[e] = pk2(S[k2][8 * s2 + 2 * e], S[k2][8 * s2 + 2 * e + 1]);
                    const bf16x8 pf = __builtin_bit_cast(bf16x8, mk4(pw[0], pw[1], pw[2], pw[3]));
#pragma unroll
                    for (int dt = 0; dt < 2; ++dt) {
                        const unsigned char* vp = Vtile + (dt * 32 + l31) * VROW + (k2 * 32 + s2 * 16 + 4 * h) * 2;
                        const u32x2 v0 = *(const u32x2*)(vp), v1 = *(const u32x2*)(vp + 16);
                        const bf16x8 vf = __builtin_bit_cast(bf16x8, mk4(v0.x, v0.y, v1.x, v1.y));
                        O[dt] = __builtin_amdgcn_mfma_f32_32x32x16_bf16(vf, pf, O[dt], 0, 0, 0);
                    }
                }
        }
        if (j + 1 < njt) {
            unsigned char* nb = lds + (cur ^ 1) * BUF;
#pragma unroll
            for (int i = 0; i < 3; ++i) *(u32x4*)(nb + koff[i]) = rk[i];
#pragma unroll
            for (int i = 0; i < 2; ++i) { *(u32x2*)(nb + voff[i]) = mk2(rv[i].x, rv[i].y); *(u32x2*)(nb + voff[i] + 8) = mk2(rv[i].z, rv[i].w); }
        }
        __syncthreads();
    }
    l += __shfl_xor(l, 32);
    const float inv = 1.0f / l;
    bf16_t* yrow = p.Y + ((size_t)((bh >> 3) * NT_ + q)) * DM + 512 + (bh & 7) * 64;
#pragma unroll
    for (int dt = 0; dt < 2; ++dt)
#pragma unroll
        for (int g = 0; g < 4; ++g)
            *(u32x2*)(yrow + dt * 32 + 8 * g + 4 * h) = mk2(pk2(O[dt][4 * g] * inv, O[dt][4 * g + 1] * inv), pk2(O[dt][4 * g + 2] * inv, O[dt][4 * g + 3] * inv));
}

DI void phase4(const Params& p, unsigned char* lds, int bid, int G) {
    int* sh_item = (int*)(lds + LDS_BYTES - 64);
    for (int task = bid; task < 256; task += G) scan_task(p, lds, task);
    for (;;) {
        __syncthreads();
        if (threadIdx.x == 0) *sh_item = (int)atomicAdd(&p.ctrl[CTRL_ATTNQ], 1u);
        __syncthreads();
        const int item = *sh_item;
        if (item >= 4096) break;
        attn_item(p, lds, item);
    }
}

DI void phase5(const Params& p, unsigned char* lds, int bid, int G) {
    const int t = threadIdx.x, lane = t & 63, wid = t >> 6, wr = wid >> 1, wc = wid & 1;
    float* tile = (float*)lds;
    float* ssq = (float*)(lds + 69632);
    float* scores = (float*)(p.bscr + (size_t)bid * BSCR_PER_BLOCK);
    bf16_t* act = (bf16_t*)(p.bscr + (size_t)bid * BSCR_PER_BLOCK + 131072);
    for (int rt = bid; rt < NTOK / 128; rt += G) {
        const int b = rt >> 5;
        const float* mod = p.mod + b * 6144;
        __syncthreads();
        if (t < 128) ssq[t] = 0.f;
#pragma unroll 1
        for (int it = 0; it < 16; ++it) {
            int tl = t; LAUNDER(tl);
            const int pr = (tl >> 2) + 64 * it;
            const int row = pr >> 3, head = pr & 7, part = tl & 3, grow = rt * 128 + row, tt = grow & 4095;
            const int ch = head * 64 + part * 16;
            const float* yr = p.yraw + (size_t)grow * 512 + ch;
            float y[16];
#pragma unroll
            for (int i = 0; i < 4; ++i) { const f32x4 v = *(const f32x4*)(yr + 4 * i); y[4 * i] = v[0]; y[4 * i + 1] = v[1]; y[4 * i + 2] = v[2]; y[4 * i + 3] = v[3]; }
            float sm = 0.f;
#pragma unroll
            for (int i = 0; i < 16; ++i) sm += y[i];
            sm += __shfl_xor(sm, 1); sm += __shfl_xor(sm, 2);
            const float mean = sm * (1.0f / 64.0f);
            float vr = 0.f;
#pragma unroll
            for (int i = 0; i < 16; ++i) { const float d = y[i] - mean; vr += d * d; }
            vr += __shfl_xor(vr, 1); vr += __shfl_xor(vr, 2);
            const float rs = rsqrtf(vr * (1.0f / 64.0f) + 64e-5f);
            const bf16_t* sc = p.SC + ((size_t)(b * 8 + head) * NT_ + tt) * 384 + part * 16;
            float kp[16], vv[16], rr[16];
#pragma unroll
            for (int i = 0; i < 2; ++i) {
                const u32x4 a = *(const u32x4*)(sc + 192 + 8 * i), c = *(const u32x4*)(sc + 256 + 8 * i), d = *(const u32x4*)(sc + 320 + 8 * i);
                kp[8 * i] = lo2f(a.x); kp[8 * i + 1] = hi2f(a.x); kp[8 * i + 2] = lo2f(a.y); kp[8 * i + 3] = hi2f(a.y); kp[8 * i + 4] = lo2f(a.z); kp[8 * i + 5] = hi2f(a.z); kp[8 * i + 6] = lo2f(a.w); kp[8 * i + 7] = hi2f(a.w);
                vv[8 * i] = lo2f(c.x); vv[8 * i + 1] = hi2f(c.x); vv[8 * i + 2] = lo2f(c.y); vv[8 * i + 3] = hi2f(c.y); vv[8 * i + 4] = lo2f(c.z); vv[8 * i + 5] = hi2f(c.z); vv[8 * i + 6] = lo2f(c.w); vv[8 * i + 7] = hi2f(c.w);
                rr[8 * i] = lo2f(d.x); rr[8 * i + 1] = hi2f(d.x); rr[8 * i + 2] = lo2f(d.y); rr[8 * i + 3] = hi2f(d.y); rr[8 * i + 4] = lo2f(d.z); rr[8 * i + 5] = hi2f(d.z); rr[8 * i + 6] = lo2f(d.w); rr[8 * i + 7] = hi2f(d.w);
            }
            float bn = 0.f;
#pragma unroll
            for (int i = 0; i < 16; ++i) bn += rr[i] * kp[i] * p.r_k[ch + i];
            bn += __shfl_xor(bn, 1); bn += __shfl_xor(bn, 2);
            const bf16_t* gg = p.Gg + (size_t)grow * 512 + ch;
            const u32x4 g0 = *(const u32x4*)(gg), g1 = *(const u32x4*)(gg + 8);
            float g[16] = {lo2f(g0.x), hi2f(g0.x), lo2f(g0.y), hi2f(g0.y), lo2f(g0.z), hi2f(g0.z), lo2f(g0.w), hi2f(g0.w), lo2f(g1.x), hi2f(g1.x), lo2f(g1.y), hi2f(g1.y), lo2f(g1.z), hi2f(g1.z), lo2f(g1.w), hi2f(g1.w)};
            float o[16];
#pragma unroll
            for (int i = 0; i < 16; ++i) o[i] = ((y[i] - mean) * rs * p.ln_w[ch + i] + p.ln_b[ch + i] + bn * vv[i]) * g[i];
            bf16_t* yd = p.Y + (size_t)grow * DM + ch;
            *(u32x4*)(yd) = mk4(pk2(o[0], o[1]), pk2(o[2], o[3]), pk2(o[4], o[5]), pk2(o[6], o[7]));
            *(u32x4*)(yd + 8) = mk4(pk2(o[8], o[9]), pk2(o[10], o[11]), pk2(o[12], o[13]), pk2(o[14], o[15]));
        }
        asm volatile("s_waitcnt vmcnt(0)" ::: "memory");
        __syncthreads();
#pragma unroll 1
        for (int ct = 0; ct < 8; ++ct) {
            f32x4 acc[4][4];
            APlain ap{p.Y + (size_t)rt * 128 * DM, DM};
            gemm_core<4, 64>(ap, p.wout_t + (size_t)ct * 128 * DM, DM, DM, acc, lds);
            int ll = lane; LAUNDER(ll);
#pragma unroll
            for (int i = 0; i < 4; ++i) {
                const int row = wr * 64 + i * 16 + (ll & 15), grow = rt * 128 + row;
                float s = 0.f;
#pragma unroll
                for (int j = 0; j < 4; ++j) {
                    const int col = ct * 128 + wc * 64 + j * 16 + (ll >> 4) * 4;
                    const f32x4 xv = *(const f32x4*)(p.x + (size_t)grow * DM + col), ga = *(const f32x4*)(mod + 2048 + col);
                    f32x4 o;
#pragma unroll
                    for (int e = 0; e < 4; ++e) { o[e] = xv[e] + ga[e] * acc[i][j][e]; s += o[e] * o[e]; }
                    *(f32x4*)(p.out + (size_t)grow * DM + col) = o;
                }
                s += __shfl_xor(s, 16); s += __shfl_xor(s, 32);
                if ((ll >> 4) == 0) atomicAdd(&ssq[row], s);
            }
        }
        asm volatile("s_waitcnt vmcnt(0)" ::: "memory");
        __syncthreads();
#pragma unroll 1
        for (int r = wid; r < 128; r += 4) {
            int ll = lane; LAUNDER(ll);
            const int grow = rt * 128 + r;
            const float rs = rsqrtf(ssq[r] * (1.0f / DM) + 1e-6f);
#pragma unroll
            for (int i = 0; i < 4; ++i) {
                const int c = ll * 4 + 256 * i;
                const f32x4 v = *(const f32x4*)(p.out + (size_t)grow * DM + c), g = *(const f32x4*)(p.norm_ffn + c), sh = *(const f32x4*)(mod + 3072 + c), sc = *(const f32x4*)(mod + 4096 + c);
                float o[4];
#pragma unroll
                for (int e = 0; e < 4; ++e) o[e] = v[e] * rs * g[e] * (1.0f + sc[e]) + sh[e];
                *(u32x2*)(p.H + (size_t)grow * DM + c) = mk2(pk2(o[0], o[1]), pk2(o[2], o[3]));
            }
        }
        asm volatile("s_waitcnt vmcnt(0)" ::: "memory");
        __syncthreads();
#pragma unroll 1
        for (int ct = 0; ct < 2; ++ct) {
            f32x4 acc[4][4];
            APlain ap{p.H + (size_t)rt * 128 * DM, DM};
            gemm_core<4, 64>(ap, p.wr_t + (size_t)ct * 128 * DM, DM, DM, acc, lds);
            int ll = lane; LAUNDER(ll);
#pragma unroll
            for (int i = 0; i < 4; ++i)
#pragma unroll
                for (int j = 0; j < 4; ++j) {
                    const int row = wr * 64 + i * 16 + (ll & 15), col = ct * 128 + wc * 64 + j * 16 + (ll >> 4) * 4;
                    f32x4 o;
#pragma unroll
                    for (int e = 0; e < 4; ++e) o[e] = sigmoidf_(acc[i][j][e]);
                    *(f32x4*)(scores + row * 256 + col) = o;
                }
        }
        asm volatile("s_waitcnt vmcnt(0)" ::: "memory");
        __syncthreads();
#pragma unroll 1
        for (int r = wid; r < 128; r += 4) {
            const int token = rt * 128 + r;
            const f32x4 sc4 = *(const f32x4*)(scores + r * 256 + lane * 4), bi4 = *(const f32x4*)(p.router_bias + lane * 4);
            float sc[4] = {sc4[0], sc4[1], sc4[2], sc4[3]};
            float val[4] = {sc4[0] + bi4[0], sc4[1] + bi4[1], sc4[2] + bi4[2], sc4[3] + bi4[3]};
            float m1 = fmaxf(val[0], val[1]), m2 = fminf(val[0], val[1]);
#pragma unroll
            for (int e = 2; e < 4; ++e) { const float v = val[e]; m2 = fmaxf(m2, fminf(m1, v)); m1 = fmaxf(m1, v); }
#pragma unroll
            for (int o = 1; o < 8; o <<= 1) { const float o1 = __shfl_xor(m1, o), o2 = __shfl_xor(m2, o); const float n1 = fmaxf(m1, o1), n2 = fmaxf(fminf(m1, o1), fmaxf(m2, o2)); m1 = n1; m2 = n2; }
            const float gs = m1 + m2; const int mg = lane >> 3;
            int rank = 0;
#pragma unroll
            for (int g2 = 0; g2 < 8; ++g2) { const float os = __shfl(gs, g2 * 8); rank += (os > gs || (os == gs && g2 < mg)) ? 1 : 0; }
            if (rank >= 4) { val[0] = -INFINITY; val[1] = -INFINITY; val[2] = -INFINITY; val[3] = -INFINITY; }
            int esel[8]; float ssel[8]; float wsum = 0.f;
#pragma unroll
            for (int k = 0; k < 8; ++k) {
                float bv = val[0]; int bi = lane * 4;
#pragma unroll
                for (int e = 1; e < 4; ++e) if (val[e] > bv) { bv = val[e]; bi = lane * 4 + e; }
#pragma unroll
                for (int o = 1; o < 64; o <<= 1) { const float ov = __shfl_xor(bv, o); const int oi = __shfl_xor(bi, o); if (ov > bv || (ov == bv && oi < bi)) { bv = ov; bi = oi; } }
                const int e = bi & 3;
                const float mysc = e == 0 ? sc[0] : (e == 1 ? sc[1] : (e == 2 ? sc[2] : sc[3]));
                const float s = __shfl(mysc, bi >> 2);
                if ((bi >> 2) == lane) { if (e == 0) val[0] = -INFINITY; else if (e == 1) val[1] = -INFINITY; else if (e == 2) val[2] = -INFINITY; else val[3] = -INFINITY; }
                esel[k] = bi; ssel[k] = s; wsum += s;
            }
            if (lane < 8) {
                int e = esel[0]; float s = ssel[0];
#pragma unroll
                for (int k = 1; k < 8; ++k) if (lane == k) { e = esel[k]; s = ssel[k]; }
                p.topk_idx[token * 8 + lane] = e;
                p.topk_w[token * 8 + lane] = s / wsum * 2.5f;
                const unsigned pos = atomicAdd(&p.ctrl[CTRL_ECNT + e], 1u);
                p.elist[(size_t)e * NTOK + pos] = token * 8 + lane;
            }
        }
#pragma unroll 1
        for (int ct = 0; ct < 4; ++ct) {
            f32x4 acc[4][4];
            APlain ap{p.H + (size_t)rt * 128 * DM, DM};
            gemm_core<4, 64>(ap, p.wsgu_t + (size_t)ct * 128 * DM, DM, DM, acc, lds);
            acc_to_lds<4>(acc, tile, 132);
            __syncthreads();
            int tl = t; LAUNDER(tl);
            const int row = tl >> 1, half = tl & 1;
            unsigned w[16];
#pragma unroll
            for (int i = 0; i < 16; ++i) {
                const int c = half * 32 + 2 * i;
                const float g0 = tile[row * 132 + c], g1 = tile[row * 132 + c + 1], u0 = tile[row * 132 + 64 + c], u1 = tile[row * 132 + 64 + c + 1];
                w[i] = pk2(g0 * sigmoidf_(g0) * u0, g1 * sigmoidf_(g1) * u1);
            }
            bf16_t* d = act + row * 256 + ct * 64 + half * 32;
#pragma unroll
            for (int i = 0; i < 4; ++i) *(u32x4*)(d + 8 * i) = mk4(w[4 * i], w[4 * i + 1], w[4 * i + 2], w[4 * i + 3]);
        }
        asm volatile("s_waitcnt vmcnt(0)" ::: "memory");
        __syncthreads();
#pragma unroll 1
        for (int ct = 0; ct < 8; ++ct) {
            f32x4 acc[4][4];
            APlain ap{act, 256};
            gemm_core<4, 64>(ap, p.wsd_t + (size_t)ct * 128 * 256, 256, 256, acc, lds);
            int ll = lane; LAUNDER(ll);
#pragma unroll
            for (int i = 0; i < 4; ++i)
#pragma unroll
                for (int j = 0; j < 4; ++j) {
                    const int row = wr * 64 + i * 16 + (ll & 15), grow = rt * 128 + row, col = ct * 128 + wc * 64 + j * 16 + (ll >> 4) * 4;
                    const f32x4 xv = *(const f32x4*)(p.out + (size_t)grow * DM + col), gf = *(const f32x4*)(mod + 5120 + col);
                    f32x4 o;
#pragma unroll
                    for (int e = 0; e < 4; ++e) o[e] = xv[e] + gf[e] * acc[i][j][e];
                    *(f32x4*)(p.out + (size_t)grow * DM + col) = o;
                }
        }
    }
}

DI void phase6(const Params& p, unsigned char* lds, int bid, int G) {
    const int t = threadIdx.x, lane = t & 63, wid = t >> 6, wr = wid >> 1, wc = wid & 1;
    float* tile = (float*)lds;
    int* pre = (int*)(lds + 69632);
    int* rowtok = (int*)(lds + 69632 + 1056);
    int* rowslot = rowtok + 128;
    float* roww = (float*)(rowslot + 128);
    bf16_t* act = (bf16_t*)(p.bscr + (size_t)bid * BSCR_PER_BLOCK + 131072);
    __syncthreads();
    pre[t + 1] = ((int)p.ctrl[CTRL_ECNT + t] + 127) >> 7;
    __syncthreads();
    if (t == 0) { int s = 0; pre[0] = 0; for (int e = 1; e <= NEXP; ++e) { s += pre[e]; pre[e] = s; } }
    __syncthreads();
    const int total = pre[NEXP];
    for (int item = bid; item < total; item += G) {
        int lo = 0, hi = NEXP - 1;
        while (lo < hi) { const int mid = (lo + hi + 1) >> 1; if (pre[mid] <= item) lo = mid; else hi = mid - 1; }
        const int e = lo, tl = item - pre[e], cnt = (int)p.ctrl[CTRL_ECNT + e];
        __syncthreads();
        if (t < 128) {
            const int r = tl * 128 + t;
            if (r < cnt) { const int ts = p.elist[(size_t)e * NTOK + r]; rowtok[t] = ts >> 3; rowslot[t] = ts; roww[t] = p.topk_w[ts]; }
            else { rowtok[t] = 0; rowslot[t] = -1; roww[t] = 0.f; }
        }
        __syncthreads();
#pragma unroll 1
        for (int ct = 0; ct < 4; ++ct) {
            f32x4 acc[4][4];
            AGather ap{p.H, rowtok};
            gemm_core<4, 64>(ap, p.wegu_t + ((size_t)e * 512 + ct * 128) * DM, DM, DM, acc, lds);
            acc_to_lds<4>(acc, tile, 132);
            __syncthreads();
            int tl = t; LAUNDER(tl);
            const int row = tl >> 1, half = tl & 1;
            unsigned w[16];
#pragma unroll
            for (int i = 0; i < 16; ++i) {
                const int c = half * 32 + 2 * i;
                const float g0 = tile[row * 132 + c], g1 = tile[row * 132 + c + 1], u0 = tile[row * 132 + 64 + c], u1 = tile[row * 132 + 64 + c + 1];
                w[i] = pk2(g0 * sigmoidf_(g0) * u0, g1 * sigmoidf_(g1) * u1);
            }
            bf16_t* d = act + row * 256 + ct * 64 + half * 32;
#pragma unroll
            for (int i = 0; i < 4; ++i) *(u32x4*)(d + 8 * i) = mk4(w[4 * i], w[4 * i + 1], w[4 * i + 2], w[4 * i + 3]);
        }
        asm volatile("s_waitcnt vmcnt(0)" ::: "memory");
        __syncthreads();
#pragma unroll 1
        for (int ct = 0; ct < 8; ++ct) {
            f32x4 acc[4][4];
            APlain ap{act, 256};
            gemm_core<4, 64>(ap, p.wed_t + ((size_t)e * 1024 + ct * 128) * 256, 256, 256, acc, lds);
            int ll = lane; LAUNDER(ll);
#pragma unroll
            for (int i = 0; i < 4; ++i) {
                const int row = wr * 64 + i * 16 + (ll & 15), srow = rowslot[row];
                const float ww = roww[row];
                if (srow >= 0) {
#pragma unroll
                    for (int j = 0; j < 4; ++j) {
                        const int col = ct * 128 + wc * 64 + j * 16 + (ll >> 4) * 4;
                        *(u32x2*)(p.slot + (size_t)srow * DM + col) = mk2(pk2(acc[i][j][0] * ww, acc[i][j][1] * ww), pk2(acc[i][j][2] * ww, acc[i][j][3] * ww));
                    }
                }
            }
        }
    }
}

DI void phase7(const Params& p, int bid, int G) {
    const int lane = threadIdx.x & 63, gw = bid * 4 + (threadIdx.x >> 6), nw = G * 4;
    for (int row = gw; row < NTOK; row += nw) {
        const float* mod = p.mod + (row >> 12) * 6144 + 5120;
#pragma unroll
        for (int i = 0; i < 4; ++i) {
            const int c = lane * 4 + 256 * i;
            float s[4] = {0.f, 0.f, 0.f, 0.f};
#pragma unroll
            for (int k = 0; k < 8; ++k) { const u32x2 w = *(const u32x2*)(p.slot + ((size_t)row * 8 + k) * DM + c); s[0] += lo2f(w.x); s[1] += hi2f(w.x); s[2] += lo2f(w.y); s[3] += hi2f(w.y); }
            const f32x4 gf = *(const f32x4*)(mod + c);
            f32x4 o = *(const f32x4*)(p.out + (size_t)row * DM + c);
#pragma unroll
            for (int e = 0; e < 4; ++e) o[e] += gf[e] * s[e];
            *(f32x4*)(p.out + (size_t)row * DM + c) = o;
        }
    }
}

extern __shared__ __attribute__((aligned(16))) unsigned char smem[];

template <int PH> DI void run_phase(const Params& p, unsigned char* lds, int bid, int G) {
    if (PH == 0) phase0(p, lds, bid, G);
    if (PH == 1) phase1(p, bid, G);
    if (PH == 2) phase2(p, lds, bid, G);
    if (PH == 3) phase3(p, lds, bid, G);
    if (PH == 4) phase4(p, lds, bid, G);
    if (PH == 5) phase5(p, lds, bid, G);
    if (PH == 6) phase6(p, lds, bid, G);
    if (PH == 7) phase7(p, bid, G);
}

#if !ONE_LAUNCH
template <int PH> __global__ void __launch_bounds__(256, 2) phase_kernel(Params p) { run_phase<PH>(p, smem, blockIdx.x, gridDim.x); }
#endif

#if ONE_LAUNCH
__global__ void __launch_bounds__(256, 2) mega_kernel(Params p) {
    volatile LAS unsigned* st = (volatile LAS unsigned*)(smem + LDS_BYTES - 16);
    if (threadIdx.x == 0) { st[0] = 0u; st[1] = 0u; st[2] = 0u; st[3] = 0u; }
    __syncthreads();
    XcdBarrier bar = xcd_barrier_post(p.ctrl, st);
    const int bid = blockIdx.x, G = gridDim.x;
    run_phase<0>(p, smem, bid, G); xcd_barrier(bar);
    run_phase<1>(p, smem, bid, G); xcd_barrier(bar);
    run_phase<2>(p, smem, bid, G); xcd_barrier(bar);
    run_phase<3>(p, smem, bid, G); xcd_barrier(bar);
    run_phase<4>(p, smem, bid, G); xcd_barrier(bar);
    run_phase<5>(p, smem, bid, G); xcd_barrier(bar);
    run_phase<6>(p, smem, bid, G); xcd_barrier(bar);
    run_phase<7>(p, smem, bid, G);
}
#define OCC_KERNEL mega_kernel
#else
#define OCC_KERNEL phase_kernel<5>
#endif

static inline size_t al256(size_t x) { return (x + 255) & ~(size_t)255; }

extern "C" void kernel_launch(void* const* d_in, const int* in_sizes, int n_in, void* d_out, int out_size, void* d_ws, size_t ws_size, hipStream_t stream) {
    (void)in_sizes; (void)n_in; (void)out_size;
    Params p{};
    p.x = (const float*)d_in[0]; p.c = (const float*)d_in[1]; p.positions = (const int*)d_in[2]; p.ada_w = (const float*)d_in[3]; p.ada_b = (const float*)d_in[4];
    p.norm_mix = (const float*)d_in[5]; p.w_in = (const float*)d_in[6]; p.rwkv_mu = (const float*)d_in[7]; p.decay_w0 = (const float*)d_in[8]; p.decay_up = (const float*)d_in[9];
    p.iclr_a0 = (const float*)d_in[10]; p.iclr_up = (const float*)d_in[11]; p.gate_up = (const float*)d_in[12]; p.k_k = (const float*)d_in[13]; p.k_a = (const float*)d_in[14];
    p.r_k = (const float*)d_in[15]; p.ln_w = (const float*)d_in[16]; p.ln_b = (const float*)d_in[17]; p.q_a_norm = (const float*)d_in[18]; p.w_q_b = (const float*)d_in[19];
    p.kv_a_norm = (const float*)d_in[20]; p.w_kv_b = (const float*)d_in[21]; p.q_norm = (const float*)d_in[22]; p.k_norm = (const float*)d_in[23]; p.w_out = (const float*)d_in[24];
    p.norm_ffn = (const float*)d_in[25]; p.w_router = (const float*)d_in[26]; p.router_bias = (const float*)d_in[27]; p.w_e_gu = (const float*)d_in[28]; p.w_e_d = (const float*)d_in[29];
    p.w_sh_gu = (const float*)d_in[30]; p.w_sh_d = (const float*)d_in[31];
    p.out = (float*)d_out;

    static int grid = 0;
    if (!grid) {
        int dev = 0, cus = 0, per_cu = 0;
        (void)hipGetDevice(&dev);
        (void)hipDeviceGetAttribute(&cus, hipDeviceAttributeMultiprocessorCount, dev);
#if ONE_LAUNCH
        (void)hipFuncSetAttribute((const void*)mega_kernel, hipFuncAttributeMaxDynamicSharedMemorySize, LDS_BYTES);
#endif
#if !ONE_LAUNCH
        (void)hipFuncSetAttribute((const void*)phase_kernel<0>, hipFuncAttributeMaxDynamicSharedMemorySize, LDS_BYTES);
#endif
#if !ONE_LAUNCH
        (void)hipFuncSetAttribute((const void*)phase_kernel<1>, hipFuncAttributeMaxDynamicSharedMemorySize, LDS_BYTES);
#endif
#if !ONE_LAUNCH
        (void)hipFuncSetAttribute((const void*)phase_kernel<2>, hipFuncAttributeMaxDynamicSharedMemorySize, LDS_BYTES);
#endif
#if !ONE_LAUNCH
        (void)hipFuncSetAttribute((const void*)phase_kernel<3>, hipFuncAttributeMaxDynamicSharedMemorySize, LDS_BYTES);
#endif
#if !ONE_LAUNCH
        (void)hipFuncSetAttribute((const void*)phase_kernel<4>, hipFuncAttributeMaxDynamicSharedMemorySize, LDS_BYTES);
#endif
#if !ONE_LAUNCH
        (void)hipFuncSetAttribute((const void*)phase_kernel<5>, hipFuncAttributeMaxDynamicSharedMemorySize, LDS_BYTES);
#endif
#if !ONE_LAUNCH
        (void)hipFuncSetAttribute((const void*)phase_kernel<6>, hipFuncAttributeMaxDynamicSharedMemorySize, LDS_BYTES);
#endif
#if !ONE_LAUNCH
        (void)hipFuncSetAttribute((const void*)phase_kernel<7>, hipFuncAttributeMaxDynamicSharedMemorySize, LDS_BYTES);
#endif
        (void)hipOccupancyMaxActiveBlocksPerMultiprocessor(&per_cu, (const void*)OCC_KERNEL, 256, LDS_BYTES);
        if (cus <= 0) cus = 256;
        if (per_cu < 1) per_cu = 1;
        grid = cus * (per_cu < 2 ? per_cu : 2);
    }
    unsigned char* w = (unsigned char*)d_ws; size_t o = 0;
    auto take = [&](size_t bytes) { unsigned char* r = w + o; o = al256(o + bytes); return r; };
    p.ctrl = (unsigned*)take(CTRL_WORDS * 4);
    p.mod = (float*)take((size_t)NB * 6144 * 4);
    p.rope = (float*)take((size_t)NTOK * 32 * 4);
    p.win_t = (bf16_t*)take((size_t)LDU * 1024 * 2);
    p.wq_t = (bf16_t*)take((size_t)768 * 256 * 2);
    p.wkv_t = (bf16_t*)take((size_t)1024 * 128 * 2);
    p.wdec_t = (bf16_t*)take((size_t)512 * 32 * 2);
    p.wiclr_t = (bf16_t*)take((size_t)512 * 32 * 2);
    p.wgate_t = (bf16_t*)take((size_t)512 * 96 * 2);
    p.wout_t = (bf16_t*)take((size_t)1024 * 1024 * 2);
    p.wr_t = (bf16_t*)take((size_t)256 * 1024 * 2);
    p.wsgu_t = (bf16_t*)take((size_t)512 * 1024 * 2);
    p.wsd_t = (bf16_t*)take((size_t)1024 * 256 * 2);
    p.wegu_t = (bf16_t*)take((size_t)NEXP * 512 * 1024 * 2);
    p.wed_t = (bf16_t*)take((size_t)NEXP * 1024 * 256 * 2);
    p.H = (bf16_t*)take((size_t)NTOK * DM * 2);
    p.topk_idx = (int*)take((size_t)NTOK * 8 * 4);
    p.topk_w = (float*)take((size_t)NTOK * 8 * 4);
    p.elist = (int*)take((size_t)NEXP * NTOK * 4);
    p.bscr = take((size_t)grid * BSCR_PER_BLOCK);
    const size_t ov = o;
    p.U = (bf16_t*)take((size_t)NTOK * LDU * 2);
    p.Q = (bf16_t*)take((size_t)NTOK * 8 * 96 * 2);
    p.Kb = (bf16_t*)take((size_t)NTOK * 8 * 96 * 2);
    p.Vt = (bf16_t*)take((size_t)NTOK * 8 * 64 * 2);
    p.SC = (bf16_t*)take((size_t)NTOK * 8 * 384 * 2);
    p.Gg = (bf16_t*)take((size_t)NTOK * 512 * 2);
    p.yraw = (float*)take((size_t)NTOK * 512 * 4);
    p.Y = (bf16_t*)take((size_t)NTOK * DM * 2);
    p.slot = (bf16_t*)(w + ov);
    const size_t need_slot = ov + (size_t)NTOK * 8 * DM * 2;
    if (o > ws_size || need_slot > ws_size) { fprintf(stderr, "workspace too small: need %zu / %zu, have %zu\n", o, need_slot, ws_size); return; }

    (void)hipMemsetAsync(p.ctrl, 0, CTRL_WORDS * 4, stream);
#if ONE_LAUNCH
    hipLaunchKernelGGL(mega_kernel, dim3(grid), dim3(256), LDS_BYTES, stream, p);
#else
    hipLaunchKernelGGL(phase_kernel<0>, dim3(grid), dim3(256), LDS_BYTES, stream, p);
    hipLaunchKernelGGL(phase_kernel<1>, dim3(grid), dim3(256), LDS_BYTES, stream, p);
    hipLaunchKernelGGL(phase_kernel<2>, dim3(grid), dim3(256), LDS_BYTES, stream, p);
    hipLaunchKernelGGL(phase_kernel<3>, dim3(grid), dim3(256), LDS_BYTES, stream, p);
    hipLaunchKernelGGL(phase_kernel<4>, dim3(grid), dim3(256), LDS_BYTES, stream, p);
    hipLaunchKernelGGL(phase_kernel<5>, dim3(grid), dim3(256), LDS_BYTES, stream, p);
    hipLaunchKernelGGL(phase_kernel<6>, dim3(grid), dim3(256), LDS_BYTES, stream, p);
    hipLaunchKernelGGL(phase_kernel<7>, dim3(grid), dim3(256), LDS_BYTES, stream, p);
#endif
}
```

```cpp
#include <hip/hip_runtime.h>
#include <stdint.h>
#include <stdio.h>
#define DI __device__ __forceinline__

#ifndef ONE_LAUNCH
#define ONE_LAUNCH 1
#endif

typedef unsigned short bf16_t;
typedef short bf16x8 __attribute__((ext_vector_type(8)));
typedef float f32x4 __attribute__((ext_vector_type(4)));
typedef float f32x16 __attribute__((ext_vector_type(16)));
typedef float f32x2_t __attribute__((ext_vector_type(2)));
typedef unsigned u32x4 __attribute__((ext_vector_type(4)));
typedef unsigned u32x2 __attribute__((ext_vector_type(2)));
#define LAUNDER(v) asm volatile("" : "+v"(v))
DI u32x4 mk4(unsigned a, unsigned b, unsigned c, unsigned d) { return (u32x4){a, b, c, d}; }
DI u32x2 mk2(unsigned a, unsigned b) { return (u32x2){a, b}; }

typedef __bf16 bf16x2_t __attribute__((ext_vector_type(2)));

constexpr int NB = 16, NT_ = 4096, DM = 1024, NTOK = NB * NT_;
constexpr int LDU = 2176;
constexpr int UQ = 0, UKV = 256, UR = 384, UK = 896, UV = 1408, UXW = 1920, UXA = 1952, UXG = 1984, UPE = 2080;
constexpr int NEXP = 256, TOPK = 8;
constexpr int LDS_BYTES = 73728;
constexpr float QSCALE = 0.14724444f;

#define XB_TMO      128
#define XB_XCNT(j)  (256  + 64 * (j))
#define XB_XSUB(j)  (1280 + 64 * (j))
#define XB_XGEN(j)  (2304 + 64 * (j))
#define XB_TOP      3328
#define XB_TOPGEN   3392
#define XCD_BAR_WORDS 3456
#define XB_SPIN_CAP (1u << 22)
#define LAS __attribute__((address_space(3)))
constexpr int CTRL_ATTNQ = 4096, CTRL_ECNT = 4352, CTRL_WORDS = 8192;

DI unsigned xb_ld(unsigned* p)              { return __hip_atomic_load(p, __ATOMIC_RELAXED, __HIP_MEMORY_SCOPE_AGENT); }
DI unsigned xb_add(unsigned* p, unsigned v) { return __hip_atomic_fetch_add(p, v, __ATOMIC_RELAXED, __HIP_MEMORY_SCOPE_AGENT); }
DI unsigned xb_xcc_id() { return (unsigned)__builtin_amdgcn_s_getreg((3 << 11) | 20) & 0xFu; }
#define XB_SPIN(cond, bar) do { unsigned _sp = 0; while (cond) { __builtin_amdgcn_s_sleep(1); \
    if ((++_sp & 255u) == 0u) { if (xb_ld(&(bar)[XB_TMO])) break; if (_sp > XB_SPIN_CAP) { atomicAdd(&(bar)[XB_TMO], 1u); break; } } } } while (0)

struct XcdBarrier { unsigned* bar; unsigned x; volatile LAS unsigned* st; };

DI XcdBarrier xcd_barrier_post(unsigned* bar, volatile LAS unsigned* st) {
    XcdBarrier b; b.bar = bar; b.x = xb_xcc_id(); b.st = st;
    if (threadIdx.x == 0) (void)xb_add(&bar[XB_XCNT(b.x)], 1u);
    return b;
}
DI void xcd_barrier_complete(unsigned* bar, unsigned x, unsigned& nloc, unsigned& nx) {
    const unsigned G = gridDim.x * gridDim.y * gridDim.z;
    unsigned sum, cnt, mine, sp = 0u;
    for (;;) {
        sum = 0u; cnt = 0u; mine = 0u;
#pragma unroll
        for (unsigned j = 0; j < 16; ++j) { const unsigned c = xb_ld(&bar[XB_XCNT(j)]); sum += c; cnt += (c > 0u) ? 1u : 0u; mine = (j == x) ? c : mine; }
        if (sum == G) break;
        __builtin_amdgcn_s_sleep(1);
        if ((++sp & 255u) == 0u) { if (xb_ld(&bar[XB_TMO])) break; if (sp > XB_SPIN_CAP) { atomicAdd(&bar[XB_TMO], 1u); break; } }
    }
    nloc = mine > 0u ? mine : 1u; nx = cnt > 0u ? cnt : 1u;
}
DI void xcd_barrier(const XcdBarrier& b) {
    asm volatile("s_waitcnt vmcnt(0)" ::: "memory");
    __syncthreads();
    if (threadIdx.x == 0) {
        unsigned* bar = b.bar;
        __builtin_amdgcn_s_waitcnt(0);
        unsigned nloc = b.st[0], nx = b.st[1];
        if (nloc == 0u) { xcd_barrier_complete(bar, b.x, nloc, nx); b.st[0] = nloc; b.st[1] = nx; }
        const unsigned old = xb_add(&bar[XB_XSUB(b.x)], 1u);
        const unsigned gen = old / nloc;
        if (old + 1u == (gen + 1u) * nloc) {
            __builtin_amdgcn_fence(__ATOMIC_RELEASE, "agent");
            asm volatile("s_waitcnt vmcnt(0)" ::: "memory");
            const unsigned og = xb_add(&bar[XB_TOP], 1u);
            const unsigned tg = og / nx;
            if (og + 1u == (tg + 1u) * nx) xb_add(&bar[XB_TOPGEN], 1u);
            else XB_SPIN(xb_ld(&bar[XB_TOPGEN]) == tg, bar);
            __builtin_amdgcn_fence(__ATOMIC_ACQUIRE, "agent");
            xb_add(&bar[XB_XGEN(b.x)], 1u);
            asm volatile("s_waitcnt vmcnt(0)" ::: "memory");
        } else {
            XB_SPIN(xb_ld(&bar[XB_XGEN(b.x)]) == gen, bar);
            __builtin_amdgcn_fence(__ATOMIC_ACQUIRE, "agent");
            asm volatile("s_waitcnt vmcnt(0)" ::: "memory");
        }
    }
    __syncthreads();
}

struct Params {
    const float* x; const float* c; const int* positions; const float* ada_w; const float* ada_b; const float* norm_mix; const float* w_in;
    const float* rwkv_mu; const float* decay_w0; const float* decay_up; const float* iclr_a0; const float* iclr_up; const float* gate_up;
    const float* k_k; const float* k_a; const float* r_k; const float* ln_w; const float* ln_b;
    const float* q_a_norm; const float* w_q_b; const float* kv_a_norm; const float* w_kv_b; const float* q_norm; const float* k_norm;
    const float* w_out; const float* norm_ffn; const float* w_router; const float* router_bias;
    const float* w_e_gu; const float* w_e_d; const float* w_sh_gu; const float* w_sh_d;
    float* out;
    unsigned* ctrl; float* mod; float* rope;
    bf16_t* win_t; bf16_t* wq_t; bf16_t* wkv_t; bf16_t* wdec_t; bf16_t* wiclr_t; bf16_t* wgate_t; bf16_t* wout_t; bf16_t* wr_t; bf16_t* wsgu_t; bf16_t* wsd_t;
    bf16_t* wegu_t; bf16_t* wed_t;
    bf16_t* H; int* topk_idx; float* topk_w; int* elist; unsigned char* bscr;
    bf16_t* U; bf16_t* Q; bf16_t* Kb; bf16_t* Vt; bf16_t* SC; bf16_t* Gg; float* yraw; bf16_t* Y; bf16_t* slot;
};
constexpr size_t BSCR_PER_BLOCK = 196608;

DI float bf2f(bf16_t v) { return __uint_as_float(((unsigned)v) << 16); }
DI unsigned pk2(float a, float b) { f32x2_t f = {a, b}; bf16x2_t r = __builtin_convertvector(f, bf16x2_t); return __builtin_bit_cast(unsigned, r); }
DI bf16_t f2bf(float a) { return (bf16_t)(pk2(a, 0.f) & 0xffffu); }
DI float lo2f(unsigned w) { return __uint_as_float(w << 16); }
DI float hi2f(unsigned w) { return __uint_as_float(w & 0xffff0000u); }
DI float sigmoidf_(float x) { return 1.0f / (1.0f + __expf(-x)); }
DI float wave_sum(float v) {
#pragma unroll
    for (int o = 32; o > 0; o >>= 1) v += __shfl_xor(v, o);
    return v;
}
DI float dpp_sum8(float s) {
    s += __builtin_bit_cast(float, __builtin_amdgcn_update_dpp(0, __builtin_bit_cast(int, s), 0xB1, 0xf, 0xf, true));
    s += __builtin_bit_cast(float, __builtin_amdgcn_update_dpp(0, __builtin_bit_cast(int, s), 0x4E, 0xf, 0xf, true));
    s += __builtin_bit_cast(float, __builtin_amdgcn_update_dpp(0, __builtin_bit_cast(int, s), 0x141, 0xf, 0xf, true));
    return s;
}

struct APlain { const bf16_t* base; int ld; DI const bf16_t* row(int r) const { return base + (size_t)r * ld; } };
struct AGather { const bf16_t* base; const int* idx; DI const bf16_t* row(int r) const { return base + (size_t)idx[r] * DM; } };

template <int MT, int NT, int WR, int BK, int NSWAP, class AP>
DI void gemm_tile(const AP ap, const bf16_t* __restrict__ Bt, const int ldb, const int K, f32x4 (&acc)[MT][NT], unsigned char* lds) {
    constexpr int WC = 4 / WR, CPR = BK / 8, RB = BK * 2, R256 = 256 / RB, BN = WC * NT * 16;
    static_assert(WR * MT * 16 == 128, "tile is 128 rows");
    constexpr int A_BYTES = 128 * RB, B_BYTES = BN * RB;
    constexpr int A_CH = (128 * CPR) / 256, B_TOT = BN * CPR, B_CH = (B_TOT + 255) / 256, RSTEP = 256 / CPR;
    int t = threadIdx.x; LAUNDER(t);
    const int lane = t & 63, wid = t >> 6, wr = wid / WC, wc = wid % WC;
    const int ch = t % CPR, r0 = t / CPR;
    const bf16_t* pa[A_CH]; const bf16_t* pb[B_CH]; int offa[A_CH], offb[B_CH]; bool vb[B_CH];
#pragma unroll
    for (int i = 0; i < A_CH; ++i) { const int row = r0 + i * RSTEP; pa[i] = ap.row(row) + ch * 8; offa[i] = row * RB + ((ch ^ ((row / R256) & (CPR - 1))) << 4); }
#pragma unroll
    for (int i = 0; i < B_CH; ++i) { const int row = r0 + i * RSTEP; vb[i] = row < BN; const int rr = vb[i] ? row : 0; pb[i] = Bt + (size_t)rr * ldb + ch * 8; offb[i] = 2 * A_BYTES + rr * RB + ((ch ^ ((rr / R256) & (CPR - 1))) << 4); }
#pragma unroll
    for (int i = 0; i < MT; ++i)
#pragma unroll
        for (int j = 0; j < NT; ++j) acc[i][j] = (f32x4){0.f, 0.f, 0.f, 0.f};
    const int KT = K / BK;
    u32x4 ra[A_CH], rb[B_CH];
#pragma unroll
    for (int i = 0; i < A_CH; ++i) ra[i] = *(const u32x4*)(pa[i]);
#pragma unroll
    for (int i = 0; i < B_CH; ++i) rb[i] = *(const u32x4*)(pb[i]);
    __syncthreads();
#pragma unroll
    for (int i = 0; i < A_CH; ++i) *(u32x4*)(lds + offa[i]) = ra[i];
#pragma unroll
    for (int i = 0; i < B_CH; ++i) if (vb[i]) *(u32x4*)(lds + offb[i]) = rb[i];
    __syncthreads();
    const int sw = ((lane & 15) / R256) & (CPR - 1);
    const int arow = (wr * MT * 16 + (lane & 15)) * RB, brow = (wc * NT * 16 + (lane & 15)) * RB;
    for (int kt = 0; kt < KT; ++kt) {
        const int cur = kt & 1;
        if (kt + 1 < KT) {
#pragma unroll
            for (int i = 0; i < A_CH; ++i) ra[i] = *(const u32x4*)(pa[i] + (kt + 1) * BK);
#pragma unroll
            for (int i = 0; i < B_CH; ++i) rb[i] = *(const u32x4*)(pb[i] + (kt + 1) * BK);
        }
        const unsigned char* Ab = lds + cur * A_BYTES + arow;
        const unsigned char* Bb = lds + 2 * A_BYTES + cur * B_BYTES + brow;
#pragma unroll
        for (int ks = 0; ks < BK / 32; ++ks) {
            const int co = ((ks * 4 + (lane >> 4)) ^ sw) << 4;
            bf16x8 af[MT], bfr[NT];
#pragma unroll
            for (int i = 0; i < MT; ++i) af[i] = *(const bf16x8*)(Ab + i * 16 * RB + co);
#pragma unroll
            for (int j = 0; j < NT; ++j) bfr[j] = *(const bf16x8*)(Bb + j * 16 * RB + co);
#pragma unroll
            for (int i = 0; i < MT; ++i)
#pragma unroll
                for (int j = 0; j < NT; ++j)
                    acc[i][j] = (j < NSWAP) ? __builtin_amdgcn_mfma_f32_16x16x32_bf16(bfr[j], af[i], acc[i][j], 0, 0, 0)
                                            : __builtin_amdgcn_mfma_f32_16x16x32_bf16(af[i], bfr[j], acc[i][j], 0, 0, 0);
        }
        if (kt + 1 < KT) {
            const int nb = cur ^ 1;
#pragma unroll
            for (int i = 0; i < A_CH; ++i) *(u32x4*)(lds + nb * A_BYTES + offa[i]) = ra[i];
#pragma unroll
            for (int i = 0; i < B_CH; ++i) if (vb[i]) *(u32x4*)(lds + nb * B_BYTES + offb[i]) = rb[i];
        }
        __syncthreads();
    }
}
template <int NT, int BK, class AP>
DI void gemm_core(const AP ap, const bf16_t* __restrict__ Bt, const int ldb, const int K, f32x4 (&acc)[4][NT], unsigned char* lds) {
    gemm_tile<4, NT, 2, BK, NT>(ap, Bt, ldb, K, acc, lds);
}

template <int NT> DI void acc_to_lds(const f32x4 (&acc)[4][NT], float* tile, const int ld) {
    int t = threadIdx.x; LAUNDER(t);
    const int lane = t & 63, wid = t >> 6, wr = wid >> 1, wc = wid & 1;
#pragma unroll
    for (int i = 0; i < 4; ++i)
#pragma unroll
        for (int j = 0; j < NT; ++j) {
            const int row = wr * 64 + i * 16 + (lane & 15), col = wc * NT * 16 + j * 16 + (lane >> 4) * 4;
            *(f32x4*)(tile + row * ld + col) = acc[i][j];
        }
}

DI int map_win(int n) { return n < 384 ? n + 1696 : (n < 2080 ? n - 384 : (n < 2112 ? n : -1)); }
DI int map_gu(int n) { const int tile = n >> 7, w = n & 127; return w < 64 ? tile * 64 + w : 256 + tile * 64 + (w - 64); }

template <int MAP> DI void tconv_simple(const float* __restrict__ src, bf16_t* __restrict__ dst, int K, int Ns, int Nd, const float* __restrict__ scale, int gtid, int gthreads) {
    const int total = Nd * K;
    for (int idx = gtid; idx < total; idx += gthreads) {
        const int n = idx / K, k = idx - n * K;
        const int m = (MAP == 1) ? map_win(n) : (MAP == 2 ? map_gu(n) : n);
        float v = 0.f;
        if (m >= 0) { v = src[(size_t)k * Ns + m]; if (scale) v *= scale[k]; }
        dst[idx] = f2bf(v);
    }
}
template <int MAP> DI void tconv_tiled(const float* __restrict__ src, bf16_t* __restrict__ dst, int E, int K, int N, float* ldsf, int bid, int G) {
    const int tk = K / 64, tn = N / 64, per = tk * tn, total = E * per;
    const int t = threadIdx.x;
    for (int tile = bid; tile < total; tile += G) {
        const int e = tile / per, r = tile - e * per, kt = r / tn, nt = r - kt * tn;
        const float* s = src + (size_t)e * K * N + (size_t)(kt * 64) * N;
        __syncthreads();
        {
            const int nl = t & 63, n = nt * 64 + nl;
            const int m = (MAP == 2) ? map_gu(n) : n;
#pragma unroll
            for (int i = 0; i < 16; ++i) { const int kl = (t >> 6) + 4 * i; ldsf[kl * 65 + nl] = s[(size_t)kl * N + m]; }
        }
        __syncthreads();
        {
            const int nl = t >> 2, kc = (t & 3) * 16;
            unsigned w[8];
#pragma unroll
            for (int i = 0; i < 8; ++i) w[i] = pk2(ldsf[(kc + 2 * i) * 65 + nl], ldsf[(kc + 2 * i + 1) * 65 + nl]);
            bf16_t* d = dst + (size_t)e * K * N + (size_t)(nt * 64 + nl) * K + kt * 64 + kc;
            *(u32x4*)(d) = mk4(w[0], w[1], w[2], w[3]);
            *(u32x4*)(d + 8) = mk4(w[4], w[5], w[6], w[7]);
        }
    }
}

DI void phase0(const Params& p, unsigned char* lds, int bid, int G) {
    const int t = threadIdx.x;
    float* ldsf = (float*)lds;
    for (int item = bid; item < 192; item += G) {
        __syncthreads();
        for (int i = t; i < NB * DM; i += 256) { const float v = p.c[i]; ldsf[i] = v * sigmoidf_(v); }
        __syncthreads();
        const int col = item * 32 + (t & 31), kp = t >> 5;
        float a[NB];
#pragma unroll
        for (int b = 0; b < NB; ++b) a[b] = 0.f;
        for (int k = kp * 128; k < kp * 128 + 128; ++k) {
            const float w = p.ada_w[(size_t)k * 6144 + col];
#pragma unroll
            for (int b = 0; b < NB; ++b) a[b] += ldsf[b * DM + k] * w;
        }
        __syncthreads();
#pragma unroll
        for (int b = 0; b < NB; ++b) ldsf[(kp * NB + b) * 32 + (t & 31)] = a[b];
        __syncthreads();
        for (int o = t; o < NB * 32; o += 256) {
            const int b = o >> 5, cl = o & 31; float s = 0.f;
#pragma unroll
            for (int q = 0; q < 8; ++q) s += ldsf[(q * NB + b) * 32 + cl];
            p.mod[b * 6144 + item * 32 + cl] = s + p.ada_b[item * 32 + cl];
        }
    }
    __syncthreads();
    const int gtid = bid * 256 + t, gth = G * 256;
    tconv_simple<1>(p.w_in, p.win_t, 1024, 2112, LDU, nullptr, gtid, gth);
    tconv_simple<0>(p.w_q_b, p.wq_t, 256, 768, 768, p.q_a_norm, gtid, gth);
    tconv_simple<0>(p.w_kv_b, p.wkv_t, 128, 1024, 1024, p.kv_a_norm, gtid, gth);
    tconv_simple<0>(p.decay_up, p.wdec_t, 32, 512, 512, nullptr, gtid, gth);
    tconv_simple<0>(p.iclr_up, p.wiclr_t, 32, 512, 512, nullptr, gtid, gth);
    tconv_simple<0>(p.gate_up, p.wgate_t, 96, 512, 512, nullptr, gtid, gth);
    tconv_simple<0>(p.w_out, p.wout_t, 1024, 1024, 1024, nullptr, gtid, gth);
    tconv_simple<0>(p.w_router, p.wr_t, 1024, 256, 256, nullptr, gtid, gth);
    tconv_simple<2>(p.w_sh_gu, p.wsgu_t, 1024, 512, 512, nullptr, gtid, gth);
    tconv_simple<0>(p.w_sh_d, p.wsd_t, 256, 1024, 1024, nullptr, gtid, gth);
    tconv_tiled<2>(p.w_e_gu, p.wegu_t, NEXP, 1024, 512, ldsf, bid, G);
    tconv_tiled<0>(p.w_e_d, p.wed_t, NEXP, 256, 1024, ldsf, bid, G);
}

DI void phase1(const Params& p, int bid, int G) {
    const int lane = threadIdx.x & 63, gw = bid * 4 + (threadIdx.x >> 6), nw = G * 4;
    for (int row = gw; row < NTOK; row += nw) {
        const int b = row >> 12;
        const float* xr = p.x + (size_t)row * DM;
        f32x4 v[4]; float ss = 0.f;
#pragma unroll
        for (int i = 0; i < 4; ++i) { v[i] = *(const f32x4*)(xr + lane * 4 + 256 * i); ss += v[i][0] * v[i][0] + v[i][1] * v[i][1] + v[i][2] * v[i][2] + v[i][3] * v[i][3]; }
        ss = wave_sum(ss);
        const float rs = rsqrtf(ss * (1.0f / DM) + 1e-6f);
        const float* mod = p.mod + b * 6144;
#pragma unroll
        for (int i = 0; i < 4; ++i) {
            const int c = lane * 4 + 256 * i;
            const f32x4 g = *(const f32x4*)(p.norm_mix + c), sh = *(const f32x4*)(mod + c), sc = *(const f32x4*)(mod + 1024 + c);
            float o[4];
#pragma unroll
            for (int e = 0; e < 4; ++e) o[e] = v[i][e] * rs * g[e] * (1.0f + sc[e]) + sh[e];
            *(u32x2*)(p.H + (size_t)row * DM + c) = mk2(pk2(o[0], o[1]), pk2(o[2], o[3]));
        }
        if (lane < 16) {
            const double inv = exp(-(double)lane * (9.210340371976184 / 16.0));
            const double ang = (double)p.positions[row] * inv;
            p.rope[(size_t)row * 32 + lane] = (float)cos(ang);
            p.rope[(size_t)row * 32 + 16 + lane] = (float)sin(ang);
        }
    }
}

DI void phase2(const Params& p, unsigned char* lds, int bid, int G) {
    constexpr int NCT = LDU / 128;
    const int t = threadIdx.x, lane = t & 63, wid = t >> 6, wr = wid >> 1, wc = wid & 1;
    const int total = (NTOK / 128) * NCT;
    for (int L = bid; L < total; L += G) {
        const int xcd = L & 7, j = L >> 3, rt = 8 * (j / NCT) + xcd, ct = j % NCT;
        f32x4 acc[4][4];
        APlain ap{p.H + (size_t)rt * 128 * DM, DM};
        gemm_core<4, 64>(ap, p.win_t + (size_t)ct * 128 * DM, DM, DM, acc, lds);
        bf16_t* tile = (bf16_t*)lds;
#pragma unroll
        for (int i = 0; i < 4; ++i)
#pragma unroll
            for (int jj = 0; jj < 4; ++jj) {
                const int row = wr * 64 + i * 16 + (lane & 15), col = wc * 64 + jj * 16 + (lane >> 4) * 4;
                *(u32x2*)(tile + row * 136 + col) = mk2(pk2(acc[i][jj][0], acc[i][jj][1]), pk2(acc[i][jj][2], acc[i][jj][3]));
            }
        __syncthreads();
#pragma unroll
        for (int i = 0; i < 8; ++i) {
            const int c = t + 256 * i, row = c >> 4, chn = c & 15;
            *(u32x4*)(p.U + (size_t)(rt * 128 + row) * LDU + ct * 128 + chn * 8) = *(const u32x4*)(tile + row * 136 + chn * 8);
        }
    }
}

DI void unpack8(const u32x4 w, float (&f)[8]) { f[0] = lo2f(w.x); f[1] = hi2f(w.x); f[2] = lo2f(w.y); f[3] = hi2f(w.y); f[4] = lo2f(w.z); f[5] = hi2f(w.z); f[6] = lo2f(w.w); f[7] = hi2f(w.w); }
DI f32x4 unpack4(const u32x2 w) { return (f32x4){lo2f(w.x), hi2f(w.x), lo2f(w.y), hi2f(w.y)}; }
DI u32x2 pack4(const f32x4 v) { return mk2(pk2(v[0], v[1]), pk2(v[2], v[3])); }
DI f32x4 shifted4(const bf16_t* __restrict__ up, const bool has_prev, const f32x4 mu) {
    const f32x4 cur = unpack4(*(const u32x2*)up);
    f32x4 prev = (f32x4){0.f, 0.f, 0.f, 0.f};
    if (has_prev) prev = unpack4(*(const u32x2*)(up - LDU));
    return cur + (prev - cur) * mu;
}
DI void head96_finish(f32x4 (&v)[6], const int q, const float* __restrict__ gain, const float* __restrict__ ropeRow, const float scale, bf16_t* __restrict__ dstRow) {
    float ss = 0.f;
#pragma unroll
    for (int j = 0; j < 6; ++j) ss += v[j][0] * v[j][0] + v[j][1] * v[j][1] + v[j][2] * v[j][2] + v[j][3] * v[j][3];
    ss += __shfl_xor(ss, 16); ss += __shfl_xor(ss, 32);
    const float rs = rsqrtf(ss * (1.0f / 96.0f) + 1e-6f);
#pragma unroll
    for (int j = 0; j < 6; ++j) v[j] = v[j] * rs * *(const f32x4*)(gain + j * 16 + q * 4);
    const f32x4 cs = *(const f32x4*)(ropeRow + q * 4), sn = *(const f32x4*)(ropeRow + 16 + q * 4);
    const f32x4 x1 = v[4], x2 = v[5];
    v[4] = x1 * cs - x2 * sn; v[5] = x2 * cs + x1 * sn;
#pragma unroll
    for (int j = 0; j < 6; ++j) *(u32x2*)(dstRow + j * 16 + q * 4) = pack4(v[j] * scale);
}

DI void phase3(const Params& p, unsigned char* lds, int bid, int G) {
    const int t = threadIdx.x;
    float* rstd_q = (float*)(lds + 69632);
    float* rstd_kv = rstd_q + 128;
    bf16_t* lora = (bf16_t*)(p.bscr + (size_t)bid * BSCR_PER_BLOCK + 131072);
    for (int rt = bid; rt < NTOK / 128; rt += G) {
        __syncthreads();
        {
            int tl = t; LAUNDER(tl);
            const int row = tl >> 1, half = tl & 1, grow = rt * 128 + row;
            const bf16_t* urow = p.U + (size_t)grow * LDU;
            float s = 0.f;
#pragma unroll
            for (int c = 0; c < 16; ++c) { float f[8]; unpack8(*(const u32x4*)(urow + UQ + half * 128 + c * 8), f);
#pragma unroll
                for (int e = 0; e < 8; ++e) s += f[e] * f[e]; }
            s += __shfl_xor(s, 1);
            float s2 = 0.f;
#pragma unroll
            for (int c = 0; c < 8; ++c) { float f[8]; unpack8(*(const u32x4*)(urow + UKV + half * 64 + c * 8), f);
#pragma unroll
                for (int e = 0; e < 8; ++e) s2 += f[e] * f[e]; }
            s2 += __shfl_xor(s2, 1);
            if (half == 0) { rstd_q[row] = rsqrtf(s * (1.0f / 256.0f) + 1e-6f); rstd_kv[row] = rsqrtf(s2 * (1.0f / 128.0f) + 1e-6f); }
        }
#pragma unroll 1
        for (int i = 0; i < 10; ++i) {
            int tl = t; LAUNDER(tl);
            const int c = tl + 256 * i, row = c / 20, chn = c - row * 20, grow = rt * 128 + row;
            const bf16_t* up = p.U + (size_t)grow * LDU + UXW + chn * 8;
            float cur[8], prv[8];
            unpack8(*(const u32x4*)up, cur);
            if ((grow & 4095) > 0) unpack8(*(const u32x4*)(up - LDU), prv);
            else {
#pragma unroll
                for (int e = 0; e < 8; ++e) prv[e] = 0.f; }
            const f32x4 m0 = *(const f32x4*)(p.rwkv_mu + 1536 + chn * 8), m1 = *(const f32x4*)(p.rwkv_mu + 1536 + chn * 8 + 4);
            float o[8];
#pragma unroll
            for (int e = 0; e < 8; ++e) {
                const float x = cur[e] + (prv[e] - cur[e]) * (e < 4 ? m0[e & 3] : m1[e & 3]);
                o[e] = chn < 4 ? tanhf(x) : (chn < 8 ? x : sigmoidf_(x));
            }
            *(u32x4*)(lora + row * 160 + chn * 8) = mk4(pk2(o[0], o[1]), pk2(o[2], o[3]), pk2(o[4], o[5]), pk2(o[6], o[7]));
        }
        asm volatile("s_waitcnt vmcnt(0)" ::: "memory");
        __syncthreads();
#pragma unroll 1
        for (int h = 0; h < 8; ++h) {
            f32x4 acc[2][6];
            APlain ap{p.U + (size_t)rt * 128 * LDU + UQ, LDU};
            gemm_tile<2, 6, 4, 64, 6>(ap, p.wq_t + (size_t)h * 96 * 256, 256, 256, acc, lds);
            int tl = t; LAUNDER(tl);
            const int lane = tl & 63, w = tl >> 6, r = lane & 15, q = lane >> 4;
#pragma unroll
            for (int i = 0; i < 2; ++i) {
                const int row = 32 * w + 16 * i + r, grow = rt * 128 + row, b = grow >> 12, tt = grow & 4095;
                const float rq = rstd_q[row];
                f32x4 v[6];
#pragma unroll
                for (int j = 0; j < 6; ++j) v[j] = acc[i][j] * rq;
                head96_finish(v, q, p.q_norm, p.rope + (size_t)grow * 32, QSCALE, p.Q + ((size_t)(b * 8 + h) * NT_ + tt) * 96);
            }
        }
#pragma unroll 1
        for (int h = 0; h < 8; ++h) {
            f32x4 acc[2][8];
            APlain ap{p.U + (size_t)rt * 128 * LDU + UKV, LDU};
            gemm_tile<2, 8, 4, 64, 4>(ap, p.wkv_t + (size_t)h * 128 * 128, 128, 128, acc, lds);
            int tl = t; LAUNDER(tl);
            const int lane = tl & 63, w = tl >> 6, r = lane & 15, q = lane >> 4;
#pragma unroll
            for (int i = 0; i < 2; ++i) {
                const int row = 32 * w + 16 * i + r, grow = rt * 128 + row, b = grow >> 12, tt = grow & 4095;
                const float rk = rstd_kv[row];
                const bf16_t* urow = p.U + (size_t)grow * LDU;
                f32x4 v[6];
#pragma unroll
                for (int j = 0; j < 4; ++j) v[j] = acc[i][j] * rk;
                v[4] = unpack4(*(const u32x2*)(urow + UPE + q * 4));
                v[5] = unpack4(*(const u32x2*)(urow + UPE + 16 + q * 4));
                head96_finish(v, q, p.k_norm, p.rope + (size_t)grow * 32, 1.0f, p.Kb + ((size_t)(b * 8 + h) * NT_ + tt) * 96);
                const int tok0 = 32 * w + 16 * i + 4 * q;
                const f32x4 rk4 = *(const f32x4*)(rstd_kv + tok0);
                bf16_t* vd = p.Vt + ((size_t)((rt >> 5) * 8 + h) * 64) * NT_ + (rt & 31) * 128 + tok0;
#pragma unroll
                for (int j = 4; j < 8; ++j) *(u32x2*)(vd + (size_t)((j - 4) * 16 + r) * NT_) = pack4(acc[i][j] * rk4);
            }
        }
#pragma unroll 1
        for (int ct = 0; ct < 4; ++ct) {
            {
                f32x4 acc[4][4];
                APlain ap{lora, 160};
                gemm_tile<4, 4, 2, 32, 4>(ap, p.wdec_t + (size_t)ct * 128 * 32, 32, 32, acc, lds);
                int tl = t; LAUNDER(tl);
                const int lane = tl & 63, wid = tl >> 6, wr = wid >> 1, wc = wid & 1, r = lane & 15, q = lane >> 4, head = ct * 2 + wc;
#pragma unroll
                for (int i = 0; i < 4; ++i) {
                    const int grow = rt * 128 + wr * 64 + i * 16 + r, b = grow >> 12, tt = grow & 4095;
                    bf16_t* sc = p.SC + ((size_t)(b * 8 + head) * NT_ + tt) * 384 + q * 4;
#pragma unroll
                    for (int j = 0; j < 4; ++j) {
                        const f32x4 w0 = *(const f32x4*)(p.decay_w0 + head * 64 + j * 16 + q * 4);
                        f32x4 o;
#pragma unroll
                        for (int e = 0; e < 4; ++e) o[e] = 1.0f - __expf(-0.6065306597f * sigmoidf_(w0[e] + acc[i][j][e]));
                        *(u32x2*)(sc + j * 16) = pack4(o);
                    }
                }
            }
            {
                f32x4 acc[4][4];
                APlain ap{lora + 32, 160};
                gemm_tile<4, 4, 2, 32, 4>(ap, p.wiclr_t + (size_t)ct * 128 * 32, 32, 32, acc, lds);
                int tl = t; LAUNDER(tl);
                const int lane = tl & 63, wid = tl >> 6, wr = wid >> 1, wc = wid & 1, r = lane & 15, q = lane >> 4, head = ct * 2 + wc;
#pragma unroll
                for (int i = 0; i < 4; ++i) {
                    const int grow = rt * 128 + wr * 64 + i * 16 + r, b = grow >> 12, tt = grow & 4095;
                    const bool hp = tt > 0;
                    const bf16_t* urow = p.U + (size_t)grow * LDU + head * 64 + q * 4;
                    bf16_t* sc = p.SC + ((size_t)(b * 8 + head) * NT_ + tt) * 384 + q * 4;
                    f32x4 ks[4]; float ssq = 0.f;
#pragma unroll
                    for (int j = 0; j < 4; ++j) {
                        const int gc = head * 64 + j * 16 + q * 4;
                        ks[j] = shifted4(urow + UK + j * 16, hp, *(const f32x4*)(p.rwkv_mu + 512 + gc));
                        const f32x4 kq = ks[j] * *(const f32x4*)(p.k_k + gc);
                        ssq += kq[0] * kq[0] + kq[1] * kq[1] + kq[2] * kq[2] + kq[3] * kq[3];
                    }
                    ssq += __shfl_xor(ssq, 16); ssq += __shfl_xor(ssq, 32);
                    const float rn = rsqrtf(fmaxf(ssq, 1e-24f));
#pragma unroll
                    for (int j = 0; j < 4; ++j) {
                        const int gc = head * 64 + j * 16 + q * 4;
                        const f32x4 a0 = *(const f32x4*)(p.iclr_a0 + gc), kkw = *(const f32x4*)(p.k_k + gc), kaw = *(const f32x4*)(p.k_a + gc);
                        f32x4 a, kk, bb, kp;
#pragma unroll
                        for (int e = 0; e < 4; ++e) {
                            a[e] = sigmoidf_(a0[e] + acc[i][j][e]);
                            kk[e] = ks[j][e] * kkw[e] * rn; bb[e] = a[e] * kk[e]; kp[e] = ks[j][e] * (1.0f + (a[e] - 1.0f) * kaw[e]);
                        }
                        const f32x4 vs = shifted4(urow + UV + j * 16, hp, *(const f32x4*)(p.rwkv_mu + 1024 + gc));
                        const f32x4 rs = shifted4(urow + UR + j * 16, hp, *(const f32x4*)(p.rwkv_mu + gc));
                        *(u32x2*)(sc + 64 + j * 16) = pack4(kk);
                        *(u32x2*)(sc + 128 + j * 16) = pack4(bb);
                        *(u32x2*)(sc + 192 + j * 16) = pack4(kp);
                        *(u32x2*)(sc + 256 + j * 16) = pack4(vs);
                        *(u32x2*)(sc + 320 + j * 16) = pack4(rs);
                    }
                }
            }
            {
                f32x4 acc[4][4];
                APlain ap{lora + 64, 160};
                gemm_tile<4, 4, 2, 32, 4>(ap, p.wgate_t + (size_t)ct * 128 * 96, 96, 96, acc, lds);
                int tl = t; LAUNDER(tl);
                const int lane = tl & 63, wid = tl >> 6, wr = wid >> 1, wc = wid & 1, r = lane & 15, q = lane >> 4, head = ct * 2 + wc;
#pragma unroll
                for (int i = 0; i < 4; ++i) {
                    const int grow = rt * 128 + wr * 64 + i * 16 + r;
                    bf16_t* g = p.Gg + (size_t)grow * 512 + head * 64 + q * 4;
#pragma unroll
                    for (int j = 0; j < 4; ++j) *(u32x2*)(g + j * 16) = pack4(acc[i][j]);
                }
            }
        }
    }
}

DI void scan_task(const Params& p, unsigned char* lds, const int task) {
    constexpr int CS = 16;
    const int t = threadIdx.x, lane = t & 63, w = t >> 6;
    const int bh = task >> 1, hf = task & 1, b = bh >> 3, head = bh & 7;
    const int rloc = w * 8 + (lane >> 3), kseg = lane & 7;
    const int vrow = hf * 32 + rloc;
    float* stage = (float*)lds;
    float* ybuf = (float*)(lds + 49152);
    const bf16_t* src = p.SC + (size_t)bh * NT_ * 384;
    float s[8];
#pragma unroll
    for (int j = 0; j < 8; ++j) s[j] = 0.f;
    u32x4 rg[3];
    __syncthreads();
#pragma unroll
    for (int i = 0; i < 3; ++i) rg[i] = *(const u32x4*)(src + (size_t)(t + 256 * i) * 8);
#pragma unroll
    for (int i = 0; i < 3; ++i) { float* d = stage + (t + 256 * i) * 8;
        *(f32x4*)d = (f32x4){lo2f(rg[i].x), hi2f(rg[i].x), lo2f(rg[i].y), hi2f(rg[i].y)}; *(f32x4*)(d + 4) = (f32x4){lo2f(rg[i].z), hi2f(rg[i].z), lo2f(rg[i].w), hi2f(rg[i].w)}; }
    __syncthreads();
    constexpr int NCH = NT_ / CS;
    for (int c = 0; c < NCH; ++c) {
        const int cur = c & 1;
        if (c + 1 < NCH) {
#pragma unroll
            for (int i = 0; i < 3; ++i) rg[i] = *(const u32x4*)(src + (size_t)(c + 1) * CS * 384 + (size_t)(t + 256 * i) * 8);
        }
        if (c > 0) {
            const float* yb = ybuf + (cur ^ 1) * CS * 32;
            const int st = t >> 4, r2 = (t & 15) * 2;
            *(f32x2_t*)(p.yraw + ((size_t)(b * NT_ + (c - 1) * CS + st)) * 512 + head * 64 + hf * 32 + r2) = *(const f32x2_t*)(yb + st * 32 + r2);
        }
        const float* sb = stage + cur * CS * 384;
        float* yb = ybuf + cur * CS * 32;
#pragma unroll 4
        for (int st = 0; st < CS; ++st) {
            const float* q = sb + st * 384 + kseg * 8;
            const f32x4 d0 = *(const f32x4*)(q), d1 = *(const f32x4*)(q + 4);
            const f32x4 k0 = *(const f32x4*)(q + 64), k1 = *(const f32x4*)(q + 68);
            const f32x4 b0 = *(const f32x4*)(q + 128), b1 = *(const f32x4*)(q + 132);
            const f32x4 p0 = *(const f32x4*)(q + 192), p1 = *(const f32x4*)(q + 196);
            const f32x4 r0 = *(const f32x4*)(q + 320), r1 = *(const f32x4*)(q + 324);
            const float vv = sb[st * 384 + 256 + vrow];
            float dot = 0.f, tmp[8];
#pragma unroll
            for (int j = 0; j < 4; ++j) { dot += s[j] * k0[j]; dot += s[4 + j] * k1[j]; }
#pragma unroll
            for (int j = 0; j < 4; ++j) { tmp[j] = s[j] - s[j] * d0[j] + vv * p0[j]; tmp[4 + j] = s[4 + j] - s[4 + j] * d1[j] + vv * p1[j]; }
            dot = dpp_sum8(dot);
            float y = 0.f;
#pragma unroll
            for (int j = 0; j < 4; ++j) { s[j] = tmp[j] - dot * b0[j]; s[4 + j] = tmp[4 + j] - dot * b1[j]; y += s[j] * r0[j]; y += s[4 + j] * r1[j]; }
            y = dpp_sum8(y);
            if (kseg == 0) yb[st * 32 + rloc] = y;
        }
        if (c + 1 < NCH) {
            float* dbase = stage + (cur ^ 1) * CS * 384;
#pragma unroll
            for (int i = 0; i < 3; ++i) { float* d = dbase + (t + 256 * i) * 8;
                *(f32x4*)d = (f32x4){lo2f(rg[i].x), hi2f(rg[i].x), lo2f(rg[i].y), hi2f(rg[i].y)}; *(f32x4*)(d + 4) = (f32x4){lo2f(rg[i].z), hi2f(rg[i].z), lo2f(rg[i].w), hi2f(rg[i].w)}; }
        }
        __syncthreads();
    }
    {
        const float* yb = ybuf + ((NCH - 1) & 1) * CS * 32;
        const int st = t >> 4, r2 = (t & 15) * 2;
        *(f32x2_t*)(p.yraw + ((size_t)(b * NT_ + (NCH - 1) * CS + st)) * 512 + head * 64 + hf * 32 + r2) = *(const f32x2_t*)(yb + st * 32 + r2);
    }
}

DI void attn_item(const Params& p, unsigned char* lds, const int item) {
    constexpr int KROW = 208, VROW = 136, KB = 64 * KROW, BUF = KB + 64 * VROW;
    const int t = threadIdx.x, lane = t & 63, w = t >> 6, l31 = lane & 31, h = lane >> 5;
    const int qt = 31 - item / 128, bh = item % 128;
    const bf16_t* Kg = p.Kb + (size_t)bh * NT_ * 96;
    const bf16_t* Vg = p.Vt + (size_t)bh * 64 * NT_;
    const int q = qt * 128 + w * 32 + l31;
    bf16x8 qf[6];
    {
        const bf16_t* qrow = p.Q + ((size_t)bh * NT_ + q) * 96 + 8 * h;
#pragma unroll
        for (int s = 0; s < 6; ++s) qf[s] = *(const bf16x8*)(qrow + 16 * s);
    }
    f32x16 O[2];
#pragma unroll
    for (int i = 0; i < 16; ++i) { O[0][i] = 0.f; O[1][i] = 0.f; }
    float m = -INFINITY, l = 0.f;
    const int njt = 2 * qt + 2;
    int koff[3], kgo[3], voff[2], vgo[2];
#pragma unroll
    for (int i = 0; i < 3; ++i) { const int c = t + 256 * i, r = c / 12, ch = c - r * 12; koff[i] = r * KROW + ch * 16; kgo[i] = r * 96 + ch * 8; }
#pragma unroll
    for (int i = 0; i < 2; ++i) { const int c = t + 256 * i, dv = c >> 3, ch = c & 7; voff[i] = KB + dv * VROW + ch * 16; vgo[i] = dv * NT_ + ch * 8; }
    u32x4 rk[3], rv[2];
#pragma unroll
    for (int i = 0; i < 3; ++i) rk[i] = *(const u32x4*)(Kg + kgo[i]);
#pragma unroll
    for (int i = 0; i < 2; ++i) rv[i] = *(const u32x4*)(Vg + vgo[i]);
    __syncthreads();
#pragma unroll
    for (int i = 0; i < 3; ++i) *(u32x4*)(lds + koff[i]) = rk[i];
#pragma unroll
    for (int i = 0; i < 2; ++i) { *(u32x2*)(lds + voff[i]) = mk2(rv[i].x, rv[i].y); *(u32x2*)(lds + voff[i] + 8) = mk2(rv[i].z, rv[i].w); }
    __syncthreads();
    for (int j = 0; j < njt; ++j) {
        const int cur = j & 1;
        if (j + 1 < njt) {
#pragma unroll
            for (int i = 0; i < 3; ++i) rk[i] = *(const u32x4*)(Kg + (size_t)(j + 1) * 64 * 96 + kgo[i]);
#pragma unroll
            for (int i = 0; i < 2; ++i) rv[i] = *(const u32x4*)(Vg + (j + 1) * 64 + vgo[i]);
        }
        const bool active = (j * 64) <= (qt * 128 + w * 32 + 31);
        if (active) {
            const unsigned char* Kt = lds + cur * BUF;
            const unsigned char* Vtile = Kt + KB;
            f32x16 S[2];
#pragma unroll
            for (int k2 = 0; k2 < 2; ++k2) {
#pragma unroll
                for (int i = 0; i < 16; ++i) S[k2][i] = 0.f;
#pragma unroll
                for (int s = 0; s < 6; ++s) {
                    const bf16x8 kf = *(const bf16x8*)(Kt + (k2 * 32 + l31) * KROW + s * 32 + h * 16);
                    S[k2] = __builtin_amdgcn_mfma_f32_32x32x16_bf16(kf, qf[s], S[k2], 0, 0, 0);
                }
            }
            if (j >= 2 * qt) {
#pragma unroll
                for (int k2 = 0; k2 < 2; ++k2)
#pragma unroll
                    for (int i = 0; i < 16; ++i) { const int key = j * 64 + k2 * 32 + (i & 3) + 8 * (i >> 2) + 4 * h; if (key > q) S[k2][i] = -INFINITY; }
            }
            float mx = S[0][0];
#pragma unroll
            for (int i = 1; i < 16; ++i) mx = fmaxf(mx, S[0][i]);
#pragma unroll
            for (int i = 0; i < 16; ++i) mx = fmaxf(mx, S[1][i]);
            mx = fmaxf(mx, __shfl_xor(mx, 32));
            const float mn = fmaxf(m, mx);
            const float alpha = exp2f(m - mn);
            m = mn;
            float ps = 0.f;
#pragma unroll
            for (int k2 = 0; k2 < 2; ++k2)
#pragma unroll
                for (int i = 0; i < 16; ++i) { const float e = exp2f(S[k2][i] - mn); S[k2][i] = e; ps += e; }
            l = l * alpha + ps;
#pragma unroll
            for (int i = 0; i < 16; ++i) { O[0][i] *= alpha; O[1][i] *= alpha; }
#pragma unroll
            for (int k2 = 0; k2 < 2; ++k2)
#pragma unroll
                for (int s2 = 0; s2 < 2; ++s2) {
                    unsigned pw[4];
#pragma unroll
                    for (int e = 0; e < 4; ++e) pw[e] = pk2(S[k2][8 * s2 + 2 * e], S[k2][8 * s2 + 2 * e + 1]);
                    const bf16x8 pf = __builtin_bit_cast(bf16x8, mk4(pw[0], pw[1], pw[2], pw[3]));
#pragma unroll
                    for (int dt = 0; dt < 2; ++dt) {
                        const unsigned char* vp = Vtile + (dt * 32 + l31) * VROW + (k2 * 32 + s2 * 16 + 4 * h) * 2;
                        const u32x2 v0 = *(const u32x2*)(vp), v1 = *(const u32x2*)(vp + 16);
                        const bf16x8 vf = __builtin_bit_cast(bf16x8, mk4(v0.x, v0.y, v1.x, v1.y));
                        O[dt] = __builtin_amdgcn_mfma_f32_32x32x16_bf16(vf, pf, O[dt], 0, 0, 0);
                    }
                }
        }
        if (j + 1 < njt) {
            unsigned char* nb = lds + (cur ^ 1) * BUF;
#pragma unroll
            for (int i = 0; i < 3; ++i) *(u32x4*)(nb + koff[i]) = rk[i];
#pragma unroll
            for (int i = 0; i < 2; ++i) { *(u32x2*)(nb + voff[i]) = mk2(rv[i].x, rv[i].y); *(u32x2*)(nb + voff[i] + 8) = mk2(rv[i].z, rv[i].w); }
        }
        __syncthreads();
    }
    l += __shfl_xor(l, 32);
    const float inv = 1.0f / l;
    bf16_t* yrow = p.Y + ((size_t)((bh >> 3) * NT_ + q)) * DM + 512 + (bh & 7) * 64;
#pragma unroll
    for (int dt = 0; dt < 2; ++dt)
#pragma unroll
        for (int g = 0; g < 4; ++g)
            *(u32x2*)(yrow + dt * 32 + 8 * g + 4 * h) = mk2(pk2(O[dt][4 * g] * inv, O[dt][4 * g + 1] * inv), pk2(O[dt][4 * g + 2] * inv, O[dt][4 * g + 3] * inv));
}

DI void phase4(const Params& p, unsigned char* lds, int bid, int G) {
    int* sh_item = (int*)(lds + LDS_BYTES - 64);
    for (int task = bid; task < 256; task += G) scan_task(p, lds, task);
    for (;;) {
        __syncthreads();
        if (threadIdx.x == 0) *sh_item = (int)atomicAdd(&p.ctrl[CTRL_ATTNQ], 1u);
        __syncthreads();
        const int item = *sh_item;
        if (item >= 4096) break;
        attn_item(p, lds, item);
    }
}

DI void phase5(const Params& p, unsigned char* lds, int bid, int G) {
    const int t = threadIdx.x, lane = t & 63, wid = t >> 6, wr = wid >> 1, wc = wid & 1;
    float* tile = (float*)lds;
    float* ssq = (float*)(lds + 69632);
    float* scores = (float*)(p.bscr + (size_t)bid * BSCR_PER_BLOCK);
    bf16_t* act = (bf16_t*)(p.bscr + (size_t)bid * BSCR_PER_BLOCK + 131072);
    for (int rt = bid; rt < NTOK / 128; rt += G) {
        const int b = rt >> 5;
        const float* mod = p.mod + b * 6144;
        __syncthreads();
        if (t < 128) ssq[t] = 0.f;
#pragma unroll 1
        for (int it = 0; it < 16; ++it) {
            int tl = t; LAUNDER(tl);
            const int pr = (tl >> 2) + 64 * it;
            const int row = pr >> 3, head = pr & 7, part = tl & 3, grow = rt * 128 + row, tt = grow & 4095;
            const int ch = head * 64 + part * 16;
            const float* yr = p.yraw + (size_t)grow * 512 + ch;
            float y[16];
#pragma unroll
            for (int i = 0; i < 4; ++i) { const f32x4 v = *(const f32x4*)(yr + 4 * i); y[4 * i] = v[0]; y[4 * i + 1] = v[1]; y[4 * i + 2] = v[2]; y[4 * i + 3] = v[3]; }
            float sm = 0.f;
#pragma unroll
            for (int i = 0; i < 16; ++i) sm += y[i];
            sm += __shfl_xor(sm, 1); sm += __shfl_xor(sm, 2);
            const float mean = sm * (1.0f / 64.0f);
            float vr = 0.f;
#pragma unroll
            for (int i = 0; i < 16; ++i) { const float d = y[i] - mean; vr += d * d; }
            vr += __shfl_xor(vr, 1); vr += __shfl_xor(vr, 2);
            const float rs = rsqrtf(vr * (1.0f / 64.0f) + 64e-5f);
            const bf16_t* sc = p.SC + ((size_t)(b * 8 + head) * NT_ + tt) * 384 + part * 16;
            float kp[16], vv[16], rr[16];
#pragma unroll
            for (int i = 0; i < 2; ++i) {
                const u32x4 a = *(const u32x4*)(sc + 192 + 8 * i), c = *(const u32x4*)(sc + 256 + 8 * i), d = *(const u32x4*)(sc + 320 + 8 * i);
                kp[8 * i] = lo2f(a.x); kp[8 * i + 1] = hi2f(a.x); kp[8 * i + 2] = lo2f(a.y); kp[8 * i + 3] = hi2f(a.y); kp[8 * i + 4] = lo2f(a.z); kp[8 * i + 5] = hi2f(a.z); kp[8 * i + 6] = lo2f(a.w); kp[8 * i + 7] = hi2f(a.w);
                vv[8 * i] = lo2f(c.x); vv[8 * i + 1] = hi2f(c.x); vv[8 * i + 2] = lo2f(c.y); vv[8 * i + 3] = hi2f(c.y); vv[8 * i + 4] = lo2f(c.z); vv[8 * i + 5] = hi2f(c.z); vv[8 * i + 6] = lo2f(c.w); vv[8 * i + 7] = hi2f(c.w);
                rr[8 * i] = lo2f(d.x); rr[8 * i + 1] = hi2f(d.x); rr[8 * i + 2] = lo2f(d.y); rr[8 * i + 3] = hi2f(d.y); rr[8 * i + 4] = lo2f(d.z); rr[8 * i + 5] = hi2f(d.z); rr[8 * i + 6] = lo2f(d.w); rr[8 * i + 7] = hi2f(d.w);
            }
            float bn = 0.f;
#pragma unroll
            for (int i = 0; i < 16; ++i) bn += rr[i] * kp[i] * p.r_k[ch + i];
            bn += __shfl_xor(bn, 1); bn += __shfl_xor(bn, 2);
            const bf16_t* gg = p.Gg + (size_t)grow * 512 + ch;
            const u32x4 g0 = *(const u32x4*)(gg), g1 = *(const u32x4*)(gg + 8);
            float g[16] = {lo2f(g0.x), hi2f(g0.x), lo2f(g0.y), hi2f(g0.y), lo2f(g0.z), hi2f(g0.z), lo2f(g0.w), hi2f(g0.w), lo2f(g1.x), hi2f(g1.x), lo2f(g1.y), hi2f(g1.y), lo2f(g1.z), hi2f(g1.z), lo2f(g1.w), hi2f(g1.w)};
            float o[16];
#pragma unroll
            for (int i = 0; i < 16; ++i) o[i] = ((y[i] - mean) * rs * p.ln_w[ch + i] + p.ln_b[ch + i] + bn * vv[i]) * g[i];
            bf16_t* yd = p.Y + (size_t)grow * DM + ch;
            *(u32x4*)(yd) = mk4(pk2(o[0], o[1]), pk2(o[2], o[3]), pk2(o[4], o[5]), pk2(o[6], o[7]));
            *(u32x4*)(yd + 8) = mk4(pk2(o[8], o[9]), pk2(o[10], o[11]), pk2(o[12], o[13]), pk2(o[14], o[15]));
        }
        asm volatile("s_waitcnt vmcnt(0)" ::: "memory");
        __syncthreads();
#pragma unroll 1
        for (int ct = 0; ct < 8; ++ct) {
            f32x4 acc[4][4];
            APlain ap{p.Y + (size_t)rt * 128 * DM, DM};
            gemm_core<4, 64>(ap, p.wout_t + (size_t)ct * 128 * DM, DM, DM, acc, lds);
            int ll = lane; LAUNDER(ll);
#pragma unroll
            for (int i = 0; i < 4; ++i) {
                const int row = wr * 64 + i * 16 + (ll & 15), grow = rt * 128 + row;
                float s = 0.f;
#pragma unroll
                for (int j = 0; j < 4; ++j) {
                    const int col = ct * 128 + wc * 64 + j * 16 + (ll >> 4) * 4;
                    const f32x4 xv = *(const f32x4*)(p.x + (size_t)grow * DM + col), ga = *(const f32x4*)(mod + 2048 + col);
                    f32x4 o;
#pragma unroll
                    for (int e = 0; e < 4; ++e) { o[e] = xv[e] + ga[e] * acc[i][j][e]; s += o[e] * o[e]; }
                    *(f32x4*)(p.out + (size_t)grow * DM + col) = o;
                }
                s += __shfl_xor(s, 16); s += __shfl_xor(s, 32);
                if ((ll >> 4) == 0) atomicAdd(&ssq[row], s);
            }
        }
        asm volatile("s_waitcnt vmcnt(0)" ::: "memory");
        __syncthreads();
#pragma unroll 1
        for (int r = wid; r < 128; r += 4) {
            int ll = lane; LAUNDER(ll);
            const int grow = rt * 128 + r;
            const float rs = rsqrtf(ssq[r] * (1.0f / DM) + 1e-6f);
#pragma unroll
            for (int i = 0; i < 4; ++i) {
                const int c = ll * 4 + 256 * i;
                const f32x4 v = *(const f32x4*)(p.out + (size_t)grow * DM + c), g = *(const f32x4*)(p.norm_ffn + c), sh = *(const f32x4*)(mod + 3072 + c), sc = *(const f32x4*)(mod + 4096 + c);
                float o[4];
#pragma unroll
                for (int e = 0; e < 4; ++e) o[e] = v[e] * rs * g[e] * (1.0f + sc[e]) + sh[e];
                *(u32x2*)(p.H + (size_t)grow * DM + c) = mk2(pk2(o[0], o[1]), pk2(o[2], o[3]));
            }
        }
        asm volatile("s_waitcnt vmcnt(0)" ::: "memory");
        __syncthreads();
#pragma unroll 1
        for (int ct = 0; ct < 2; ++ct) {
            f32x4 acc[4][4];
            APlain ap{p.H + (size_t)rt * 128 * DM, DM};
            gemm_core<4, 64>(ap, p.wr_t + (size_t)ct * 128 * DM, DM, DM, acc, lds);
            int ll = lane; LAUNDER(ll);
#pragma unroll
            for (int i = 0; i < 4; ++i)
#pragma unroll
                for (int j = 0; j < 4; ++j) {
                    const int row = wr * 64 + i * 16 + (ll & 15), col = ct * 128 + wc * 64 + j * 16 + (ll >> 4) * 4;
                    f32x4 o;
#pragma unroll
                    for (int e = 0; e < 4; ++e) o[e] = sigmoidf_(acc[i][j][e]);
                    *(f32x4*)(scores + row * 256 + col) = o;
                }
        }
        asm volatile("s_waitcnt vmcnt(0)" ::: "memory");
        __syncthreads();
#pragma unroll 1
        for (int r = wid; r < 128; r += 4) {
            const int token = rt * 128 + r;
            const f32x4 sc4 = *(const f32x4*)(scores + r * 256 + lane * 4), bi4 = *(const f32x4*)(p.router_bias + lane * 4);
            float sc[4] = {sc4[0], sc4[1], sc4[2], sc4[3]};
            float val[4] = {sc4[0] + bi4[0], sc4[1] + bi4[1], sc4[2] + bi4[2], sc4[3] + bi4[3]};
            float m1 = fmaxf(val[0], val[1]), m2 = fminf(val[0], val[1]);
#pragma unroll
            for (int e = 2; e < 4; ++e) { const float v = val[e]; m2 = fmaxf(m2, fminf(m1, v)); m1 = fmaxf(m1, v); }
#pragma unroll
            for (int o = 1; o < 8; o <<= 1) { const float o1 = __shfl_xor(m1, o), o2 = __shfl_xor(m2, o); const float n1 = fmaxf(m1, o1), n2 = fmaxf(fminf(m1, o1), fmaxf(m2, o2)); m1 = n1; m2 = n2; }
            const float gs = m1 + m2; const int mg = lane >> 3;
            int rank = 0;
#pragma unroll
            for (int g2 = 0; g2 < 8; ++g2) { const float os = __shfl(gs, g2 * 8); rank += (os > gs || (os == gs && g2 < mg)) ? 1 : 0; }
            if (rank >= 4) { val[0] = -INFINITY; val[1] = -INFINITY; val[2] = -INFINITY; val[3] = -INFINITY; }
            int esel[8]; float ssel[8]; float wsum = 0.f;
#pragma unroll
            for (int k = 0; k < 8; ++k) {
                float bv = val[0]; int bi = lane * 4;
#pragma unroll
                for (int e = 1; e < 4; ++e) if (val[e] > bv) { bv = val[e]; bi = lane * 4 + e; }
#pragma unroll
                for (int o = 1; o < 64; o <<= 1) { const float ov = __shfl_xor(bv, o); const int oi = __shfl_xor(bi, o); if (ov > bv || (ov == bv && oi < bi)) { bv = ov; bi = oi; } }
                const int e = bi & 3;
                const float mysc = e == 0 ? sc[0] : (e == 1 ? sc[1] : (e == 2 ? sc[2] : sc[3]));
                const float s = __shfl(mysc, bi >> 2);
                if ((bi >> 2) == lane) { if (e == 0) val[0] = -INFINITY; else if (e == 1) val[1] = -INFINITY; else if (e == 2) val[2] = -INFINITY; else val[3] = -INFINITY; }
                esel[k] = bi; ssel[k] = s; wsum += s;
            }
            if (lane < 8) {
                int e = esel[0]; float s = ssel[0];
#pragma unroll
                for (int k = 1; k < 8; ++k) if (lane == k) { e = esel[k]; s = ssel[k]; }
                p.topk_idx[token * 8 + lane] = e;
                p.topk_w[token * 8 + lane] = s / wsum * 2.5f;
                const unsigned pos = atomicAdd(&p.ctrl[CTRL_ECNT + e], 1u);
                p.elist[(size_t)e * NTOK + pos] = token * 8 + lane;
            }
        }
#pragma unroll 1
        for (int ct = 0; ct < 4; ++ct) {
            f32x4 acc[4][4];
            APlain ap{p.H + (size_t)rt * 128 * DM, DM};
            gemm_core<4, 64>(ap, p.wsgu_t + (size_t)ct * 128 * DM, DM, DM, acc, lds);
            acc_to_lds<4>(acc, tile, 132);
            __syncthreads();
            int tl = t; LAUNDER(tl);
            const int row = tl >> 1, half = tl & 1;
            unsigned w[16];
#pragma unroll
            for (int i = 0; i < 16; ++i) {
                const int c = half * 32 + 2 * i;
                const float g0 = tile[row * 132 + c], g1 = tile[row * 132 + c + 1], u0 = tile[row * 132 + 64 + c], u1 = tile[row * 132 + 64 + c + 1];
                w[i] = pk2(g0 * sigmoidf_(g0) * u0, g1 * sigmoidf_(g1) * u1);
            }
            bf16_t* d = act + row * 256 + ct * 64 + half * 32;
#pragma unroll
            for (int i = 0; i < 4; ++i) *(u32x4*)(d + 8 * i) = mk4(w[4 * i], w[4 * i + 1], w[4 * i + 2], w[4 * i + 3]);
        }
        asm volatile("s_waitcnt vmcnt(0)" ::: "memory");
        __syncthreads();
#pragma unroll 1
        for (int ct = 0; ct < 8; ++ct) {
            f32x4 acc[4][4];
            APlain ap{act, 256};
            gemm_core<4, 64>(ap, p.wsd_t + (size_t)ct * 128 * 256, 256, 256, acc, lds);
            int ll = lane; LAUNDER(ll);
#pragma unroll
            for (int i = 0; i < 4; ++i)
#pragma unroll
                for (int j = 0; j < 4; ++j) {
                    const int row = wr * 64 + i * 16 + (ll & 15), grow = rt * 128 + row, col = ct * 128 + wc * 64 + j * 16 + (ll >> 4) * 4;
                    const f32x4 xv = *(const f32x4*)(p.out + (size_t)grow * DM + col), gf = *(const f32x4*)(mod + 5120 + col);
                    f32x4 o;
#pragma unroll
                    for (int e = 0; e < 4; ++e) o[e] = xv[e] + gf[e] * acc[i][j][e];
                    *(f32x4*)(p.out + (size_t)grow * DM + col) = o;
                }
        }
    }
}

DI void phase6(const Params& p, unsigned char* lds, int bid, int G) {
    const int t = threadIdx.x, lane = t & 63, wid = t >> 6, wr = wid >> 1, wc = wid & 1;
    float* tile = (float*)lds;
    int* pre = (int*)(lds + 69632);
    int* rowtok = (int*)(lds + 69632 + 1056);
    int* rowslot = rowtok + 128;
    float* roww = (float*)(rowslot + 128);
    bf16_t* act = (bf16_t*)(p.bscr + (size_t)bid * BSCR_PER_BLOCK + 131072);
    __syncthreads();
    pre[t + 1] = ((int)p.ctrl[CTRL_ECNT + t] + 127) >> 7;
    __syncthreads();
    if (t == 0) { int s = 0; pre[0] = 0; for (int e = 1; e <= NEXP; ++e) { s += pre[e]; pre[e] = s; } }
    __syncthreads();
    const int total = pre[NEXP];
    for (int item = bid; item < total; item += G) {
        int lo = 0, hi = NEXP - 1;
        while (lo < hi) { const int mid = (lo + hi + 1) >> 1; if (pre[mid] <= item) lo = mid; else hi = mid - 1; }
        const int e = lo, tl = item - pre[e], cnt = (int)p.ctrl[CTRL_ECNT + e];
        __syncthreads();
        if (t < 128) {
            const int r = tl * 128 + t;
            if (r < cnt) { const int ts = p.elist[(size_t)e * NTOK + r]; rowtok[t] = ts >> 3; rowslot[t] = ts; roww[t] = p.topk_w[ts]; }
            else { rowtok[t] = 0; rowslot[t] = -1; roww[t] = 0.f; }
        }
        __syncthreads();
#pragma unroll 1
        for (int ct = 0; ct < 4; ++ct) {
            f32x4 acc[4][4];
            AGather ap{p.H, rowtok};
            gemm_core<4, 64>(ap, p.wegu_t + ((size_t)e * 512 + ct * 128) * DM, DM, DM, acc, lds);
            acc_to_lds<4>(acc, tile, 132);
            __syncthreads();
            int tl = t; LAUNDER(tl);
            const int row = tl >> 1, half = tl & 1;
            unsigned w[16];
#pragma unroll
            for (int i = 0; i < 16; ++i) {
                const int c = half * 32 + 2 * i;
                const float g0 = tile[row * 132 + c], g1 = tile[row * 132 + c + 1], u0 = tile[row * 132 + 64 + c], u1 = tile[row * 132 + 64 + c + 1];
                w[i] = pk2(g0 * sigmoidf_(g0) * u0, g1 * sigmoidf_(g1) * u1);
            }
            bf16_t* d = act + row * 256 + ct * 64 + half * 32;
#pragma unroll
            for (int i = 0; i < 4; ++i) *(u32x4*)(d + 8 * i) = mk4(w[4 * i], w[4 * i + 1], w[4 * i + 2], w[4 * i + 3]);
        }
        asm volatile("s_waitcnt vmcnt(0)" ::: "memory");
        __syncthreads();
#pragma unroll 1
        for (int ct = 0; ct < 8; ++ct) {
            f32x4 acc[4][4];
            APlain ap{act, 256};
            gemm_core<4, 64>(ap, p.wed_t + ((size_t)e * 1024 + ct * 128) * 256, 256, 256, acc, lds);
            int ll = lane; LAUNDER(ll);
#pragma unroll
            for (int i = 0; i < 4; ++i) {
                const int row = wr * 64 + i * 16 + (ll & 15), srow = rowslot[row];
                const float ww = roww[row];
                if (srow >= 0) {
#pragma unroll
                    for (int j = 0; j < 4; ++j) {
                        const int col = ct * 128 + wc * 64 + j * 16 + (ll >> 4) * 4;
                        *(u32x2*)(p.slot + (size_t)srow * DM + col) = mk2(pk2(acc[i][j][0] * ww, acc[i][j][1] * ww), pk2(acc[i][j][2] * ww, acc[i][j][3] * ww));
                    }
                }
            }
        }
    }
}

DI void phase7(const Params& p, int bid, int G) {
    const int lane = threadIdx.x & 63, gw = bid * 4 + (threadIdx.x >> 6), nw = G * 4;
    for (int row = gw; row < NTOK; row += nw) {
        const float* mod = p.mod + (row >> 12) * 6144 + 5120;
#pragma unroll
        for (int i = 0; i < 4; ++i) {
            const int c = lane * 4 + 256 * i;
            float s[4] = {0.f, 0.f, 0.f, 0.f};
#pragma unroll
            for (int k = 0; k < 8; ++k) { const u32x2 w = *(const u32x2*)(p.slot + ((size_t)row * 8 + k) * DM + c); s[0] += lo2f(w.x); s[1] += hi2f(w.x); s[2] += lo2f(w.y); s[3] += hi2f(w.y); }
            const f32x4 gf = *(const f32x4*)(mod + c);
            f32x4 o = *(const f32x4*)(p.out + (size_t)row * DM + c);
#pragma unroll
            for (int e = 0; e < 4; ++e) o[e] += gf[e] * s[e];
            *(f32x4*)(p.out + (size_t)row * DM + c) = o;
        }
    }
}

extern __shared__ __attribute__((aligned(16))) unsigned char smem[];

template <int PH> DI void run_phase(const Params& p, unsigned char* lds, int bid, int G) {
    if (PH == 0) phase0(p, lds, bid, G);
    if (PH == 1) phase1(p, bid, G);
    if (PH == 2) phase2(p, lds, bid, G);
    if (PH == 3) phase3(p, lds, bid, G);
    if (PH == 4) phase4(p, lds, bid, G);
    if (PH == 5) phase5(p, lds, bid, G);
    if (PH == 6) phase6(p, lds, bid, G);
    if (PH == 7) phase7(p, bid, G);
}

#if !ONE_LAUNCH
template <int PH> __global__ void __launch_bounds__(256, 2) phase_kernel(Params p) { run_phase<PH>(p, smem, blockIdx.x, gridDim.x); }
#endif

#if ONE_LAUNCH
__global__ void __launch_bounds__(256, 2) mega_kernel(Params p) {
    volatile LAS unsigned* st = (volatile LAS unsigned*)(smem + LDS_BYTES - 16);
    if (threadIdx.x == 0) { st[0] = 0u; st[1] = 0u; st[2] = 0u; st[3] = 0u; }
    __syncthreads();
    XcdBarrier bar = xcd_barrier_post(p.ctrl, st);
    const int bid = blockIdx.x, G = gridDim.x;
#ifdef PROBE_PHASE
    unsigned long long pt0 = 0, pt1 = 0;
#define PROBE_A(k) if (PROBE_PHASE == (k)) pt0 = __builtin_amdgcn_s_memrealtime();
#define PROBE_B(k) if (PROBE_PHASE == (k)) pt1 = __builtin_amdgcn_s_memrealtime();
#else
#define PROBE_A(k)
#define PROBE_B(k)
#endif
    PROBE_A(0) run_phase<0>(p, smem, bid, G); xcd_barrier(bar); PROBE_B(0)
    PROBE_A(1) run_phase<1>(p, smem, bid, G); xcd_barrier(bar); PROBE_B(1)
    PROBE_A(2) run_phase<2>(p, smem, bid, G); xcd_barrier(bar); PROBE_B(2)
    PROBE_A(3) run_phase<3>(p, smem, bid, G); xcd_barrier(bar); PROBE_B(3)
    PROBE_A(4) run_phase<4>(p, smem, bid, G); xcd_barrier(bar); PROBE_B(4)
    PROBE_A(5) run_phase<5>(p, smem, bid, G); xcd_barrier(bar); PROBE_B(5)
    PROBE_A(6) run_phase<6>(p, smem, bid, G); xcd_barrier(bar); PROBE_B(6)
    PROBE_A(7) run_phase<7>(p, smem, bid, G); PROBE_B(7)
#ifdef PROBE_PHASE
    { const unsigned long long t0 = __builtin_amdgcn_s_memrealtime(); while (__builtin_amdgcn_s_memrealtime() - t0 < pt1 - pt0) __builtin_amdgcn_s_sleep(8); }
#endif
}
#define OCC_KERNEL mega_kernel
#else
#define OCC_KERNEL phase_kernel<5>
#endif

static inline size_t al256(size_t x) { return (x + 255) & ~(size_t)255; }

extern "C" void kernel_launch(void* const* d_in, const int* in_sizes, int n_in, void* d_out, int out_size, void* d_ws, size_t ws_size, hipStream_t stream) {
    (void)in_sizes; (void)n_in; (void)out_size;
    Params p{};
    p.x = (const float*)d_in[0]; p.c = (const float*)d_in[1]; p.positions = (const int*)d_in[2]; p.ada_w = (const float*)d_in[3]; p.ada_b = (const float*)d_in[4];
    p.norm_mix = (const float*)d_in[5]; p.w_in = (const float*)d_in[6]; p.rwkv_mu = (const float*)d_in[7]; p.decay_w0 = (const float*)d_in[8]; p.decay_up = (const float*)d_in[9];
    p.iclr_a0 = (const float*)d_in[10]; p.iclr_up = (const float*)d_in[11]; p.gate_up = (const float*)d_in[12]; p.k_k = (const float*)d_in[13]; p.k_a = (const float*)d_in[14];
    p.r_k = (const float*)d_in[15]; p.ln_w = (const float*)d_in[16]; p.ln_b = (const float*)d_in[17]; p.q_a_norm = (const float*)d_in[18]; p.w_q_b = (const float*)d_in[19];
    p.kv_a_norm = (const float*)d_in[20]; p.w_kv_b = (const float*)d_in[21]; p.q_norm = (const float*)d_in[22]; p.k_norm = (const float*)d_in[23]; p.w_out = (const float*)d_in[24];
    p.norm_ffn = (const float*)d_in[25]; p.w_router = (const float*)d_in[26]; p.router_bias = (const float*)d_in[27]; p.w_e_gu = (const float*)d_in[28]; p.w_e_d = (const float*)d_in[29];
    p.w_sh_gu = (const float*)d_in[30]; p.w_sh_d = (const float*)d_in[31];
    p.out = (float*)d_out;

    static int grid = 0;
    if (!grid) {
        int dev = 0, cus = 0, per_cu = 0;
        (void)hipGetDevice(&dev);
        (void)hipDeviceGetAttribute(&cus, hipDeviceAttributeMultiprocessorCount, dev);
#if ONE_LAUNCH
        (void)hipFuncSetAttribute((const void*)mega_kernel, hipFuncAttributeMaxDynamicSharedMemorySize, LDS_BYTES);
#endif
#if !ONE_LAUNCH
        (void)hipFuncSetAttribute((const void*)phase_kernel<0>, hipFuncAttributeMaxDynamicSharedMemorySize, LDS_BYTES);
#endif
#if !ONE_LAUNCH
        (void)hipFuncSetAttribute((const void*)phase_kernel<1>, hipFuncAttributeMaxDynamicSharedMemorySize, LDS_BYTES);
#endif
#if !ONE_LAUNCH
        (void)hipFuncSetAttribute((const void*)phase_kernel<2>, hipFuncAttributeMaxDynamicSharedMemorySize, LDS_BYTES);
#endif
#if !ONE_LAUNCH
        (void)hipFuncSetAttribute((const void*)phase_kernel<3>, hipFuncAttributeMaxDynamicSharedMemorySize, LDS_BYTES);
#endif
#if !ONE_LAUNCH
        (void)hipFuncSetAttribute((const void*)phase_kernel<4>, hipFuncAttributeMaxDynamicSharedMemorySize, LDS_BYTES);
#endif
#if !ONE_LAUNCH
        (void)hipFuncSetAttribute((const void*)phase_kernel<5>, hipFuncAttributeMaxDynamicSharedMemorySize, LDS_BYTES);
#endif
#if !ONE_LAUNCH
        (void)hipFuncSetAttribute((const void*)phase_kernel<6>, hipFuncAttributeMaxDynamicSharedMemorySize, LDS_BYTES);
#endif
#if !ONE_LAUNCH
        (void)hipFuncSetAttribute((const void*)phase_kernel<7>, hipFuncAttributeMaxDynamicSharedMemorySize, LDS_BYTES);
#endif
        (void)hipOccupancyMaxActiveBlocksPerMultiprocessor(&per_cu, (const void*)OCC_KERNEL, 256, LDS_BYTES);
        if (cus <= 0) cus = 256;
        if (per_cu < 1) per_cu = 1;
        grid = cus * (per_cu < 2 ? per_cu : 2);
    }
    unsigned char* w = (unsigned char*)d_ws; size_t o = 0;
    auto take = [&](size_t bytes) { unsigned char* r = w + o; o = al256(o + bytes); return r; };
    p.ctrl = (unsigned*)take(CTRL_WORDS * 4);
    p.mod = (float*)take((size_t)NB * 6144 * 4);
    p.rope = (float*)take((size_t)NTOK * 32 * 4);
    p.win_t = (bf16_t*)take((size_t)LDU * 1024 * 2);
    p.wq_t = (bf16_t*)take((size_t)768 * 256 * 2);
    p.wkv_t = (bf16_t*)take((size_t)1024 * 128 * 2);
    p.wdec_t = (bf16_t*)take((size_t)512 * 32 * 2);
    p.wiclr_t = (bf16_t*)take((size_t)512 * 32 * 2);
    p.wgate_t = (bf16_t*)take((size_t)512 * 96 * 2);
    p.wout_t = (bf16_t*)take((size_t)1024 * 1024 * 2);
    p.wr_t = (bf16_t*)take((size_t)256 * 1024 * 2);
    p.wsgu_t = (bf16_t*)take((size_t)512 * 1024 * 2);
    p.wsd_t = (bf16_t*)take((size_t)1024 * 256 * 2);
    p.wegu_t = (bf16_t*)take((size_t)NEXP * 512 * 1024 * 2);
    p.wed_t = (bf16_t*)take((size_t)NEXP * 1024 * 256 * 2);
    p.H = (bf16_t*)take((size_t)NTOK * DM * 2);
    p.topk_idx = (int*)take((size_t)NTOK * 8 * 4);
    p.topk_w = (float*)take((size_t)NTOK * 8 * 4);
    p.elist = (int*)take((size_t)NEXP * NTOK * 4);
    p.bscr = take((size_t)grid * BSCR_PER_BLOCK);
    const size_t ov = o;
    p.U = (bf16_t*)take((size_t)NTOK * LDU * 2);
    p.Q = (bf16_t*)take((size_t)NTOK * 8 * 96 * 2);
    p.Kb = (bf16_t*)take((size_t)NTOK * 8 * 96 * 2);
    p.Vt = (bf16_t*)take((size_t)NTOK * 8 * 64 * 2);
    p.SC = (bf16_t*)take((size_t)NTOK * 8 * 384 * 2);
    p.Gg = (bf16_t*)take((size_t)NTOK * 512 * 2);
    p.yraw = (float*)take((size_t)NTOK * 512 * 4);
    p.Y = (bf16_t*)take((size_t)NTOK * DM * 2);
    p.slot = (bf16_t*)(w + ov);
    const size_t need_slot = ov + (size_t)NTOK * 8 * DM * 2;
    if (o > ws_size || need_slot > ws_size) { fprintf(stderr, "workspace too small: need %zu / %zu, have %zu\n", o, need_slot, ws_size); return; }

    (void)hipMemsetAsync(p.ctrl, 0, CTRL_WORDS * 4, stream);
#if ONE_LAUNCH
    hipLaunchKernelGGL(mega_kernel, dim3(grid), dim3(256), LDS_BYTES, stream, p);
#else
    hipLaunchKernelGGL(phase_kernel<0>, dim3(grid), dim3(256), LDS_BYTES, stream, p);
    hipLaunchKernelGGL(phase_kernel<1>, dim3(grid), dim3(256), LDS_BYTES, stream, p);
    hipLaunchKernelGGL(phase_kernel<2>, dim3(grid), dim3(256), LDS_BYTES, stream, p);
    hipLaunchKernelGGL(phase_kernel<3>, dim3(grid), dim3(256), LDS_BYTES, stream, p);
    hipLaunchKernelGGL(phase_kernel<4>, dim3(grid), dim3(256), LDS_BYTES, stream, p);
    hipLaunchKernelGGL(phase_kernel<5>, dim3(grid), dim3(256), LDS_BYTES, stream, p);
    hipLaunchKernelGGL(phase_kernel<6>, dim3(grid), dim3(256), LDS_BYTES, stream, p);
    hipLaunchKernelGGL(phase_kernel<7>, dim3(grid), dim3(256), LDS_BYTES, stream, p);
#endif
}
```

```cpp
#include <hip/hip_runtime.h>
#include <stdint.h>
#include <stdio.h>
#define DI __device__ __forceinline__

#ifndef ONE_LAUNCH
#define ONE_LAUNCH 1
#endif

typedef unsigned short bf16_t;
typedef short bf16x8 __attribute__((ext_vector_type(8)));
typedef float f32x4 __attribute__((ext_vector_type(4)));
typedef float f32x16 __attribute__((ext_vector_type(16)));
typedef float f32x2_t __attribute__((ext_vector_type(2)));
typedef unsigned u32x4 __attribute__((ext_vector_type(4)));
typedef unsigned u32x2 __attribute__((ext_vector_type(2)));
#define LAUNDER(v) asm volatile("" : "+v"(v))
DI u32x4 mk4(unsigned a, unsigned b, unsigned c, unsigned d) { return (u32x4){a, b, c, d}; }
DI u32x2 mk2(unsigned a, unsigned b) { return (u32x2){a, b}; }

typedef __bf16 bf16x2_t __attribute__((ext_vector_type(2)));

constexpr int NB = 16, NT_ = 4096, DM = 1024, NTOK = NB * NT_;
constexpr int LDU = 2176;
constexpr int UQ = 0, UKV = 256, UR = 384, UK = 896, UV = 1408, UXW = 1920, UXA = 1952, UXG = 1984, UPE = 2080;
constexpr int NEXP = 256, TOPK = 8;
constexpr int LDS_BYTES = 73728;
constexpr float QSCALE = 0.14724444f;

#define XB_TMO      128
#define XB_XCNT(j)  (256  + 64 * (j))
#define XB_XSUB(j)  (1280 + 64 * (j))
#define XB_XGEN(j)  (2304 + 64 * (j))
#define XB_TOP      3328
#define XB_TOPGEN   3392
#define XCD_BAR_WORDS 3456
#define XB_SPIN_CAP (1u << 22)
#define LAS __attribute__((address_space(3)))
constexpr int CTRL_ATTNQ = 4096, CTRL_ECNT = 8192, ECNT_STRIDE = 64, CTRL_WORDS = 24576;
constexpr int CTRL_STAMP = 4160;
#ifdef PROBE_A
#define STAMP(id) do { if (blockIdx.x == 0 && threadIdx.x == 0) __hip_atomic_store((unsigned long long*)(p.ctrl + CTRL_STAMP) + (id), (unsigned long long)__builtin_amdgcn_s_memrealtime(), __ATOMIC_RELAXED, __HIP_MEMORY_SCOPE_AGENT); } while (0)
#else
#define STAMP(id)
#endif

DI unsigned xb_ld(unsigned* p)              { return __hip_atomic_load(p, __ATOMIC_RELAXED, __HIP_MEMORY_SCOPE_AGENT); }
DI unsigned xb_add(unsigned* p, unsigned v) { return __hip_atomic_fetch_add(p, v, __ATOMIC_RELAXED, __HIP_MEMORY_SCOPE_AGENT); }
DI unsigned xb_xcc_id() { return (unsigned)__builtin_amdgcn_s_getreg((3 << 11) | 20) & 0xFu; }
#define XB_SPIN(cond, bar) do { unsigned _sp = 0; while (cond) { __builtin_amdgcn_s_sleep(1); \
    if ((++_sp & 255u) == 0u) { if (xb_ld(&(bar)[XB_TMO])) break; if (_sp > XB_SPIN_CAP) { atomicAdd(&(bar)[XB_TMO], 1u); break; } } } } while (0)

struct XcdBarrier { unsigned* bar; unsigned x; volatile LAS unsigned* st; };

DI XcdBarrier xcd_barrier_post(unsigned* bar, volatile LAS unsigned* st) {
    XcdBarrier b; b.bar = bar; b.x = xb_xcc_id(); b.st = st;
    if (threadIdx.x == 0) (void)xb_add(&bar[XB_XCNT(b.x)], 1u);
    return b;
}
DI void xcd_barrier_complete(unsigned* bar, unsigned x, unsigned& nloc, unsigned& nx) {
    const unsigned G = gridDim.x * gridDim.y * gridDim.z;
    unsigned sum, cnt, mine, sp = 0u;
    for (;;) {
        sum = 0u; cnt = 0u; mine = 0u;
#pragma unroll
        for (unsigned j = 0; j < 16; ++j) { const unsigned c = xb_ld(&bar[XB_XCNT(j)]); sum += c; cnt += (c > 0u) ? 1u : 0u; mine = (j == x) ? c : mine; }
        if (sum == G) break;
        __builtin_amdgcn_s_sleep(1);
        if ((++sp & 255u) == 0u) { if (xb_ld(&bar[XB_TMO])) break; if (sp > XB_SPIN_CAP) { atomicAdd(&bar[XB_TMO], 1u); break; } }
    }
    nloc = mine > 0u ? mine : 1u; nx = cnt > 0u ? cnt : 1u;
}
DI void xcd_barrier(const XcdBarrier& b) {
    asm volatile("s_waitcnt vmcnt(0)" ::: "memory");
    __syncthreads();
    if (threadIdx.x == 0) {
        unsigned* bar = b.bar;
        __builtin_amdgcn_s_waitcnt(0);
        unsigned nloc = b.st[0], nx = b.st[1];
        if (nloc == 0u) { xcd_barrier_complete(bar, b.x, nloc, nx); b.st[0] = nloc; b.st[1] = nx; }
        const unsigned old = xb_add(&bar[XB_XSUB(b.x)], 1u);
        const unsigned gen = old / nloc;
        if (old + 1u == (gen + 1u) * nloc) {
            __builtin_amdgcn_fence(__ATOMIC_RELEASE, "agent");
            asm volatile("s_waitcnt vmcnt(0)" ::: "memory");
            const unsigned og = xb_add(&bar[XB_TOP], 1u);
            const unsigned tg = og / nx;
            if (og + 1u == (tg + 1u) * nx) xb_add(&bar[XB_TOPGEN], 1u);
            else XB_SPIN(xb_ld(&bar[XB_TOPGEN]) == tg, bar);
            __builtin_amdgcn_fence(__ATOMIC_ACQUIRE, "agent");
            xb_add(&bar[XB_XGEN(b.x)], 1u);
            asm volatile("s_waitcnt vmcnt(0)" ::: "memory");
        } else {
            XB_SPIN(xb_ld(&bar[XB_XGEN(b.x)]) == gen, bar);
            __builtin_amdgcn_fence(__ATOMIC_ACQUIRE, "agent");
            asm volatile("s_waitcnt vmcnt(0)" ::: "memory");
        }
    }
    __syncthreads();
}

struct Params {
    const float* x; const float* c; const int* positions; const float* ada_w; const float* ada_b; const float* norm_mix; const float* w_in;
    const float* rwkv_mu; const float* decay_w0; const float* decay_up; const float* iclr_a0; const float* iclr_up; const float* gate_up;
    const float* k_k; const float* k_a; const float* r_k; const float* ln_w; const float* ln_b;
    const float* q_a_norm; const float* w_q_b; const float* kv_a_norm; const float* w_kv_b; const float* q_norm; const float* k_norm;
    const float* w_out; const float* norm_ffn; const float* w_router; const float* router_bias;
    const float* w_e_gu; const float* w_e_d; const float* w_sh_gu; const float* w_sh_d;
    float* out;
    unsigned* ctrl; float* mod; float* rope;
    bf16_t* win_t; bf16_t* wq_t; bf16_t* wkv_t; bf16_t* wdec_t; bf16_t* wiclr_t; bf16_t* wgate_t; bf16_t* wout_t; bf16_t* wr_t; bf16_t* wsgu_t; bf16_t* wsd_t;
    bf16_t* wegu_t; bf16_t* wed_t;
    bf16_t* H; int* topk_idx; float* topk_w; int* elist; unsigned char* bscr;
    bf16_t* U; bf16_t* Q; bf16_t* Kb; bf16_t* Vt; bf16_t* SC; bf16_t* Gg; float* yraw; bf16_t* Y; bf16_t* slot;
};
constexpr size_t BSCR_PER_BLOCK = 196608;

DI float bf2f(bf16_t v) { return __uint_as_float(((unsigned)v) << 16); }
DI unsigned pk2(float a, float b) { f32x2_t f = {a, b}; bf16x2_t r = __builtin_convertvector(f, bf16x2_t); return __builtin_bit_cast(unsigned, r); }
DI bf16_t f2bf(float a) { return (bf16_t)(pk2(a, 0.f) & 0xffffu); }
DI float lo2f(unsigned w) { return __uint_as_float(w << 16); }
DI float hi2f(unsigned w) { return __uint_as_float(w & 0xffff0000u); }
DI float sigmoidf_(float x) { return 1.0f / (1.0f + __expf(-x)); }
DI float wave_sum(float v) {
#pragma unroll
    for (int o = 32; o > 0; o >>= 1) v += __shfl_xor(v, o);
    return v;
}
DI float dpp_sum8(float s) {
    s += __builtin_bit_cast(float, __builtin_amdgcn_update_dpp(0, __builtin_bit_cast(int, s), 0xB1, 0xf, 0xf, true));
    s += __builtin_bit_cast(float, __builtin_amdgcn_update_dpp(0, __builtin_bit_cast(int, s), 0x4E, 0xf, 0xf, true));
    s += __builtin_bit_cast(float, __builtin_amdgcn_update_dpp(0, __builtin_bit_cast(int, s), 0x141, 0xf, 0xf, true));
    return s;
}

struct APlain { const bf16_t* base; int ld; DI const bf16_t* row(int r) const { return base + (size_t)r * ld; } };
struct AGather { const bf16_t* base; const int* idx; DI const bf16_t* row(int r) const { return base + (size_t)idx[r] * DM; } };

template <int MT, int NT, int WR, int BK, int NSWAP, class AP>
DI void gemm_tile(const AP ap, const bf16_t* __restrict__ Bt, const int ldb, const int K, f32x4 (&acc)[MT][NT], unsigned char* lds) {
    constexpr int WC = 4 / WR, CPR = BK / 8, RB = BK * 2, R256 = 256 / RB, BN = WC * NT * 16;
    static_assert(WR * MT * 16 == 128, "tile is 128 rows");
    constexpr int A_BYTES = 128 * RB, B_BYTES = BN * RB;
    constexpr int A_CH = (128 * CPR) / 256, B_TOT = BN * CPR, B_CH = (B_TOT + 255) / 256, RSTEP = 256 / CPR;
    int t = threadIdx.x; LAUNDER(t);
    const int lane = t & 63, wid = t >> 6, wr = wid / WC, wc = wid % WC;
    const int ch = t % CPR, r0 = t / CPR;
    const bf16_t* pa[A_CH]; const bf16_t* pb[B_CH]; int offa[A_CH], offb[B_CH]; bool vb[B_CH];
#pragma unroll
    for (int i = 0; i < A_CH; ++i) { const int row = r0 + i * RSTEP; pa[i] = ap.row(row) + ch * 8; offa[i] = row * RB + ((ch ^ ((row / R256) & (CPR - 1))) << 4); }
#pragma unroll
    for (int i = 0; i < B_CH; ++i) { const int row = r0 + i * RSTEP; vb[i] = row < BN; const int rr = vb[i] ? row : 0; pb[i] = Bt + (size_t)rr * ldb + ch * 8; offb[i] = 2 * A_BYTES + rr * RB + ((ch ^ ((rr / R256) & (CPR - 1))) << 4); }
#pragma unroll
    for (int i = 0; i < MT; ++i)
#pragma unroll
        for (int j = 0; j < NT; ++j) acc[i][j] = (f32x4){0.f, 0.f, 0.f, 0.f};
    const int KT = K / BK;
    u32x4 ra[A_CH], rb[B_CH];
#pragma unroll
    for (int i = 0; i < A_CH; ++i) ra[i] = *(const u32x4*)(pa[i]);
#pragma unroll
    for (int i = 0; i < B_CH; ++i) rb[i] = *(const u32x4*)(pb[i]);
    __syncthreads();
#pragma unroll
    for (int i = 0; i < A_CH; ++i) *(u32x4*)(lds + offa[i]) = ra[i];
#pragma unroll
    for (int i = 0; i < B_CH; ++i) if (vb[i]) *(u32x4*)(lds + offb[i]) = rb[i];
    __syncthreads();
    const int sw = ((lane & 15) / R256) & (CPR - 1);
    const int arow = (wr * MT * 16 + (lane & 15)) * RB, brow = (wc * NT * 16 + (lane & 15)) * RB;
    for (int kt = 0; kt < KT; ++kt) {
        const int cur = kt & 1;
        if (kt + 1 < KT) {
#pragma unroll
            for (int i = 0; i < A_CH; ++i) ra[i] = *(const u32x4*)(pa[i] + (kt + 1) * BK);
#pragma unroll
            for (int i = 0; i < B_CH; ++i) rb[i] = *(const u32x4*)(pb[i] + (kt + 1) * BK);
        }
        const unsigned char* Ab = lds + cur * A_BYTES + arow;
        const unsigned char* Bb = lds + 2 * A_BYTES + cur * B_BYTES + brow;
#pragma unroll
        for (int ks = 0; ks < BK / 32; ++ks) {
            const int co = ((ks * 4 + (lane >> 4)) ^ sw) << 4;
            bf16x8 af[MT], bfr[NT];
#pragma unroll
            for (int i = 0; i < MT; ++i) af[i] = *(const bf16x8*)(Ab + i * 16 * RB + co);
#pragma unroll
            for (int j = 0; j < NT; ++j) bfr[j] = *(const bf16x8*)(Bb + j * 16 * RB + co);
#pragma unroll
            for (int i = 0; i < MT; ++i)
#pragma unroll
                for (int j = 0; j < NT; ++j)
                    acc[i][j] = (j < NSWAP) ? __builtin_amdgcn_mfma_f32_16x16x32_bf16(bfr[j], af[i], acc[i][j], 0, 0, 0)
                                            : __builtin_amdgcn_mfma_f32_16x16x32_bf16(af[i], bfr[j], acc[i][j], 0, 0, 0);
        }
        if (kt + 1 < KT) {
            const int nb = cur ^ 1;
#pragma unroll
            for (int i = 0; i < A_CH; ++i) *(u32x4*)(lds + nb * A_BYTES + offa[i]) = ra[i];
#pragma unroll
            for (int i = 0; i < B_CH; ++i) if (vb[i]) *(u32x4*)(lds + nb * B_BYTES + offb[i]) = rb[i];
        }
        __syncthreads();
    }
}
template <int NT, int BK, class AP>
DI void gemm_core(const AP ap, const bf16_t* __restrict__ Bt, const int ldb, const int K, f32x4 (&acc)[4][NT], unsigned char* lds) {
    gemm_tile<4, NT, 2, BK, NT>(ap, Bt, ldb, K, acc, lds);
}

template <int NT> DI void acc_to_lds(const f32x4 (&acc)[4][NT], float* tile, const int ld) {
    int t = threadIdx.x; LAUNDER(t);
    const int lane = t & 63, wid = t >> 6, wr = wid >> 1, wc = wid & 1;
#pragma unroll
    for (int i = 0; i < 4; ++i)
#pragma unroll
        for (int j = 0; j < NT; ++j) {
            const int row = wr * 64 + i * 16 + (lane & 15), col = wc * NT * 16 + j * 16 + (lane >> 4) * 4;
            *(f32x4*)(tile + row * ld + col) = acc[i][j];
        }
}

DI int map_win(int n) { return n < 384 ? n + 1696 : (n < 2080 ? n - 384 : (n < 2112 ? n : -1)); }
DI int map_gu(int n) { const int tile = n >> 7, w = n & 127; return w < 64 ? tile * 64 + w : 256 + tile * 64 + (w - 64); }

template <int MAP> DI void tconv_simple(const float* __restrict__ src, bf16_t* __restrict__ dst, int K, int Ns, int Nd, const float* __restrict__ scale, int gtid, int gthreads) {
    const int total = Nd * K;
    for (int idx = gtid; idx < total; idx += gthreads) {
        const int n = idx / K, k = idx - n * K;
        const int m = (MAP == 1) ? map_win(n) : (MAP == 2 ? map_gu(n) : n);
        float v = 0.f;
        if (m >= 0) { v = src[(size_t)k * Ns + m]; if (scale) v *= scale[k]; }
        dst[idx] = f2bf(v);
    }
}
template <int MAP> DI void tconv_tiled(const float* __restrict__ src, bf16_t* __restrict__ dst, int E, int K, int N, float* ldsf, int bid, int G) {
    const int tk = K / 64, tn = N / 64, per = tk * tn, total = E * per;
    const int t = threadIdx.x;
    for (int tile = bid; tile < total; tile += G) {
        const int e = tile / per, r = tile - e * per, kt = r / tn, nt = r - kt * tn;
        const float* s = src + (size_t)e * K * N + (size_t)(kt * 64) * N;
        __syncthreads();
        {
            const int nl = t & 63, n = nt * 64 + nl;
            const int m = (MAP == 2) ? map_gu(n) : n;
#pragma unroll
            for (int i = 0; i < 16; ++i) { const int kl = (t >> 6) + 4 * i; ldsf[kl * 65 + nl] = s[(size_t)kl * N + m]; }
        }
        __syncthreads();
        {
            const int nl = t >> 2, kc = (t & 3) * 16;
            unsigned w[8];
#pragma unroll
            for (int i = 0; i < 8; ++i) w[i] = pk2(ldsf[(kc + 2 * i) * 65 + nl], ldsf[(kc + 2 * i + 1) * 65 + nl]);
            bf16_t* d = dst + (size_t)e * K * N + (size_t)(nt * 64 + nl) * K + kt * 64 + kc;
            *(u32x4*)(d) = mk4(w[0], w[1], w[2], w[3]);
            *(u32x4*)(d + 8) = mk4(w[4], w[5], w[6], w[7]);
        }
    }
}

DI void phase0(const Params& p, unsigned char* lds, int bid, int G) {
    const int t = threadIdx.x;
    float* ldsf = (float*)lds;
    for (int item = bid; item < 192; item += G) {
        __syncthreads();
        for (int i = t; i < NB * DM; i += 256) { const float v = p.c[i]; ldsf[i] = v * sigmoidf_(v); }
        __syncthreads();
        const int col = item * 32 + (t & 31), kp = t >> 5;
        float a[NB];
#pragma unroll
        for (int b = 0; b < NB; ++b) a[b] = 0.f;
        for (int k = kp * 128; k < kp * 128 + 128; ++k) {
            const float w = p.ada_w[(size_t)k * 6144 + col];
#pragma unroll
            for (int b = 0; b < NB; ++b) a[b] += ldsf[b * DM + k] * w;
        }
        __syncthreads();
#pragma unroll
        for (int b = 0; b < NB; ++b) ldsf[(kp * NB + b) * 32 + (t & 31)] = a[b];
        __syncthreads();
        for (int o = t; o < NB * 32; o += 256) {
            const int b = o >> 5, cl = o & 31; float s = 0.f;
#pragma unroll
            for (int q = 0; q < 8; ++q) s += ldsf[(q * NB + b) * 32 + cl];
            p.mod[b * 6144 + item * 32 + cl] = s + p.ada_b[item * 32 + cl];
        }
    }
    __syncthreads();
    const int gtid = bid * 256 + t, gth = G * 256;
    tconv_simple<1>(p.w_in, p.win_t, 1024, 2112, LDU, nullptr, gtid, gth);
    tconv_simple<0>(p.w_q_b, p.wq_t, 256, 768, 768, p.q_a_norm, gtid, gth);
    tconv_simple<0>(p.w_kv_b, p.wkv_t, 128, 1024, 1024, p.kv_a_norm, gtid, gth);
    tconv_simple<0>(p.decay_up, p.wdec_t, 32, 512, 512, nullptr, gtid, gth);
    tconv_simple<0>(p.iclr_up, p.wiclr_t, 32, 512, 512, nullptr, gtid, gth);
    tconv_simple<0>(p.gate_up, p.wgate_t, 96, 512, 512, nullptr, gtid, gth);
    tconv_simple<0>(p.w_out, p.wout_t, 1024, 1024, 1024, nullptr, gtid, gth);
    tconv_simple<0>(p.w_router, p.wr_t, 1024, 256, 256, nullptr, gtid, gth);
    tconv_simple<2>(p.w_sh_gu, p.wsgu_t, 1024, 512, 512, nullptr, gtid, gth);
    tconv_simple<0>(p.w_sh_d, p.wsd_t, 256, 1024, 1024, nullptr, gtid, gth);
    tconv_tiled<2>(p.w_e_gu, p.wegu_t, NEXP, 1024, 512, ldsf, bid, G);
    tconv_tiled<0>(p.w_e_d, p.wed_t, NEXP, 256, 1024, ldsf, bid, G);
}

DI void phase1(const Params& p, int bid, int G) {
    const int lane = threadIdx.x & 63, gw = bid * 4 + (threadIdx.x >> 6), nw = G * 4;
    for (int row = gw; row < NTOK; row += nw) {
        const int b = row >> 12;
        const float* xr = p.x + (size_t)row * DM;
        f32x4 v[4]; float ss = 0.f;
#pragma unroll
        for (int i = 0; i < 4; ++i) { v[i] = *(const f32x4*)(xr + lane * 4 + 256 * i); ss += v[i][0] * v[i][0] + v[i][1] * v[i][1] + v[i][2] * v[i][2] + v[i][3] * v[i][3]; }
        ss = wave_sum(ss);
        const float rs = rsqrtf(ss * (1.0f / DM) + 1e-6f);
        const float* mod = p.mod + b * 6144;
#pragma unroll
        for (int i = 0; i < 4; ++i) {
            const int c = lane * 4 + 256 * i;
            const f32x4 g = *(const f32x4*)(p.norm_mix + c), sh = *(const f32x4*)(mod + c), sc = *(const f32x4*)(mod + 1024 + c);
            float o[4];
#pragma unroll
            for (int e = 0; e < 4; ++e) o[e] = v[i][e] * rs * g[e] * (1.0f + sc[e]) + sh[e];
            *(u32x2*)(p.H + (size_t)row * DM + c) = mk2(pk2(o[0], o[1]), pk2(o[2], o[3]));
        }
        if (lane < 16) {
            const double inv = exp(-(double)lane * (9.210340371976184 / 16.0));
            const double ang = (double)p.positions[row] * inv;
            p.rope[(size_t)row * 32 + lane] = (float)cos(ang);
            p.rope[(size_t)row * 32 + 16 + lane] = (float)sin(ang);
        }
    }
}

DI void phase2(const Params& p, unsigned char* lds, int bid, int G) {
    constexpr int NCT = LDU / 128;
    const int t = threadIdx.x, lane = t & 63, wid = t >> 6, wr = wid >> 1, wc = wid & 1;
    const int total = (NTOK / 128) * NCT;
    for (int L = bid; L < total; L += G) {
        const int xcd = L & 7, j = L >> 3, rt = 8 * (j / NCT) + xcd, ct = j % NCT;
        f32x4 acc[4][4];
        APlain ap{p.H + (size_t)rt * 128 * DM, DM};
        gemm_core<4, 64>(ap, p.win_t + (size_t)ct * 128 * DM, DM, DM, acc, lds);
        bf16_t* tile = (bf16_t*)lds;
#pragma unroll
        for (int i = 0; i < 4; ++i)
#pragma unroll
            for (int jj = 0; jj < 4; ++jj) {
                const int row = wr * 64 + i * 16 + (lane & 15), col = wc * 64 + jj * 16 + (lane >> 4) * 4;
                *(u32x2*)(tile + row * 136 + col) = mk2(pk2(acc[i][jj][0], acc[i][jj][1]), pk2(acc[i][jj][2], acc[i][jj][3]));
            }
        __syncthreads();
#pragma unroll
        for (int i = 0; i < 8; ++i) {
            const int c = t + 256 * i, row = c >> 4, chn = c & 15;
            *(u32x4*)(p.U + (size_t)(rt * 128 + row) * LDU + ct * 128 + chn * 8) = *(const u32x4*)(tile + row * 136 + chn * 8);
        }
    }
}

DI void unpack8(const u32x4 w, float (&f)[8]) { f[0] = lo2f(w.x); f[1] = hi2f(w.x); f[2] = lo2f(w.y); f[3] = hi2f(w.y); f[4] = lo2f(w.z); f[5] = hi2f(w.z); f[6] = lo2f(w.w); f[7] = hi2f(w.w); }
DI f32x4 unpack4(const u32x2 w) { return (f32x4){lo2f(w.x), hi2f(w.x), lo2f(w.y), hi2f(w.y)}; }
DI u32x2 pack4(const f32x4 v) { return mk2(pk2(v[0], v[1]), pk2(v[2], v[3])); }
DI f32x4 shifted4(const bf16_t* __restrict__ up, const bool has_prev, const f32x4 mu) {
    const f32x4 cur = unpack4(*(const u32x2*)up);
    f32x4 prev = (f32x4){0.f, 0.f, 0.f, 0.f};
    if (has_prev) prev = unpack4(*(const u32x2*)(up - LDU));
    return cur + (prev - cur) * mu;
}
DI void head96_finish(f32x4 (&v)[6], const int q, const float* __restrict__ gain, const float* __restrict__ ropeRow, const float scale, bf16_t* __restrict__ dstRow) {
    float ss = 0.f;
#pragma unroll
    for (int j = 0; j < 6; ++j) ss += v[j][0] * v[j][0] + v[j][1] * v[j][1] + v[j][2] * v[j][2] + v[j][3] * v[j][3];
    ss += __shfl_xor(ss, 16); ss += __shfl_xor(ss, 32);
    const float rs = rsqrtf(ss * (1.0f / 96.0f) + 1e-6f);
#pragma unroll
    for (int j = 0; j < 6; ++j) v[j] = v[j] * rs * *(const f32x4*)(gain + j * 16 + q * 4);
    const f32x4 cs = *(const f32x4*)(ropeRow + q * 4), sn = *(const f32x4*)(ropeRow + 16 + q * 4);
    const f32x4 x1 = v[4], x2 = v[5];
    v[4] = x1 * cs - x2 * sn; v[5] = x2 * cs + x1 * sn;
#pragma unroll
    for (int j = 0; j < 6; ++j) *(u32x2*)(dstRow + j * 16 + q * 4) = pack4(v[j] * scale);
}

DI void phase3(const Params& p, unsigned char* lds, int bid, int G) {
    const int t = threadIdx.x;
    float* rstd_q = (float*)(lds + 69632);
    float* rstd_kv = rstd_q + 128;
    bf16_t* lora = (bf16_t*)(p.bscr + (size_t)bid * BSCR_PER_BLOCK + 131072);
    for (int rt = bid; rt < NTOK / 128; rt += G) {
        __syncthreads();
        {
            int tl = t; LAUNDER(tl);
            const int row = tl >> 1, half = tl & 1, grow = rt * 128 + row;
            const bf16_t* urow = p.U + (size_t)grow * LDU;
            float s = 0.f;
#pragma unroll
            for (int c = 0; c < 16; ++c) { float f[8]; unpack8(*(const u32x4*)(urow + UQ + half * 128 + c * 8), f);
#pragma unroll
                for (int e = 0; e < 8; ++e) s += f[e] * f[e]; }
            s += __shfl_xor(s, 1);
            float s2 = 0.f;
#pragma unroll
            for (int c = 0; c < 8; ++c) { float f[8]; unpack8(*(const u32x4*)(urow + UKV + half * 64 + c * 8), f);
#pragma unroll
                for (int e = 0; e < 8; ++e) s2 += f[e] * f[e]; }
            s2 += __shfl_xor(s2, 1);
            if (half == 0) { rstd_q[row] = rsqrtf(s * (1.0f / 256.0f) + 1e-6f); rstd_kv[row] = rsqrtf(s2 * (1.0f / 128.0f) + 1e-6f); }
        }
#pragma unroll 1
        for (int i = 0; i < 10; ++i) {
            int tl = t; LAUNDER(tl);
            const int c = tl + 256 * i, row = c / 20, chn = c - row * 20, grow = rt * 128 + row;
            const bf16_t* up = p.U + (size_t)grow * LDU + UXW + chn * 8;
            float cur[8], prv[8];
            unpack8(*(const u32x4*)up, cur);
            if ((grow & 4095) > 0) unpack8(*(const u32x4*)(up - LDU), prv);
            else {
#pragma unroll
                for (int e = 0; e < 8; ++e) prv[e] = 0.f; }
            const f32x4 m0 = *(const f32x4*)(p.rwkv_mu + 1536 + chn * 8), m1 = *(const f32x4*)(p.rwkv_mu + 1536 + chn * 8 + 4);
            float o[8];
#pragma unroll
            for (int e = 0; e < 8; ++e) {
                const float x = cur[e] + (prv[e] - cur[e]) * (e < 4 ? m0[e & 3] : m1[e & 3]);
                o[e] = chn < 4 ? tanhf(x) : (chn < 8 ? x : sigmoidf_(x));
            }
            *(u32x4*)(lora + row * 160 + chn * 8) = mk4(pk2(o[0], o[1]), pk2(o[2], o[3]), pk2(o[4], o[5]), pk2(o[6], o[7]));
        }
        asm volatile("s_waitcnt vmcnt(0)" ::: "memory");
        __syncthreads();
        STAMP(17);
#pragma unroll 1
        for (int h = 0; h < 8; ++h) {
            f32x4 acc[2][6];
            APlain ap{p.U + (size_t)rt * 128 * LDU + UQ, LDU};
            gemm_tile<2, 6, 4, 64, 6>(ap, p.wq_t + (size_t)h * 96 * 256, 256, 256, acc, lds);
            int tl = t; LAUNDER(tl);
            const int lane = tl & 63, w = tl >> 6, r = lane & 15, q = lane >> 4;
#pragma unroll
            for (int i = 0; i < 2; ++i) {
                const int row = 32 * w + 16 * i + r, grow = rt * 128 + row, b = grow >> 12, tt = grow & 4095;
                const float rq = rstd_q[row];
                f32x4 v[6];
#pragma unroll
                for (int j = 0; j < 6; ++j) v[j] = acc[i][j] * rq;
                head96_finish(v, q, p.q_norm, p.rope + (size_t)grow * 32, QSCALE, p.Q + ((size_t)(b * 8 + h) * NT_ + tt) * 96);
            }
        }
        STAMP(18);
#pragma unroll 1
        for (int h = 0; h < 8; ++h) {
            f32x4 acc[2][8];
            APlain ap{p.U + (size_t)rt * 128 * LDU + UKV, LDU};
            gemm_tile<2, 8, 4, 64, 4>(ap, p.wkv_t + (size_t)h * 128 * 128, 128, 128, acc, lds);
            int tl = t; LAUNDER(tl);
            const int lane = tl & 63, w = tl >> 6, r = lane & 15, q = lane >> 4;
#pragma unroll
            for (int i = 0; i < 2; ++i) {
                const int row = 32 * w + 16 * i + r, grow = rt * 128 + row, b = grow >> 12, tt = grow & 4095;
                const float rk = rstd_kv[row];
                const bf16_t* urow = p.U + (size_t)grow * LDU;
                f32x4 v[6];
#pragma unroll
                for (int j = 0; j < 4; ++j) v[j] = acc[i][j] * rk;
                v[4] = unpack4(*(const u32x2*)(urow + UPE + q * 4));
                v[5] = unpack4(*(const u32x2*)(urow + UPE + 16 + q * 4));
                head96_finish(v, q, p.k_norm, p.rope + (size_t)grow * 32, 1.0f, p.Kb + ((size_t)(b * 8 + h) * NT_ + tt) * 96);
                const int tok0 = 32 * w + 16 * i + 4 * q;
                const f32x4 rk4 = *(const f32x4*)(rstd_kv + tok0);
                bf16_t* vd = p.Vt + ((size_t)((rt >> 5) * 8 + h) * 64) * NT_ + (rt & 31) * 128 + tok0;
#pragma unroll
                for (int j = 4; j < 8; ++j) *(u32x2*)(vd + (size_t)((j - 4) * 16 + r) * NT_) = pack4(acc[i][j] * rk4);
            }
        }
        STAMP(19);
#pragma unroll 1
        for (int ct = 0; ct < 4; ++ct) {
            {
                f32x4 acc[4][4];
                APlain ap{lora, 160};
                gemm_tile<4, 4, 2, 32, 4>(ap, p.wdec_t + (size_t)ct * 128 * 32, 32, 32, acc, lds);
                int tl = t; LAUNDER(tl);
                const int lane = tl & 63, wid = tl >> 6, wr = wid >> 1, wc = wid & 1, r = lane & 15, q = lane >> 4, head = ct * 2 + wc;
#pragma unroll
                for (int i = 0; i < 4; ++i) {
                    const int grow = rt * 128 + wr * 64 + i * 16 + r, b = grow >> 12, tt = grow & 4095;
                    bf16_t* sc = p.SC + ((size_t)(b * 8 + head) * NT_ + tt) * 384 + q * 4;
#pragma unroll
                    for (int j = 0; j < 4; ++j) {
                        const f32x4 w0 = *(const f32x4*)(p.decay_w0 + head * 64 + j * 16 + q * 4);
                        f32x4 o;
#pragma unroll
                        for (int e = 0; e < 4; ++e) o[e] = 1.0f - __expf(-0.6065306597f * sigmoidf_(w0[e] + acc[i][j][e]));
                        *(u32x2*)(sc + j * 16) = pack4(o);
                    }
                }
            }
            {
                f32x4 acc[4][4];
                APlain ap{lora + 32, 160};
                gemm_tile<4, 4, 2, 32, 4>(ap, p.wiclr_t + (size_t)ct * 128 * 32, 32, 32, acc, lds);
                int tl = t; LAUNDER(tl);
                const int lane = tl & 63, wid = tl >> 6, wr = wid >> 1, wc = wid & 1, r = lane & 15, q = lane >> 4, head = ct * 2 + wc;
#pragma unroll
                for (int i = 0; i < 4; ++i) {
                    const int grow = rt * 128 + wr * 64 + i * 16 + r, b = grow >> 12, tt = grow & 4095;
                    const bool hp = tt > 0;
                    const bf16_t* urow = p.U + (size_t)grow * LDU + head * 64 + q * 4;
                    bf16_t* sc = p.SC + ((size_t)(b * 8 + head) * NT_ + tt) * 384 + q * 4;
                    f32x4 ks[4]; float ssq = 0.f;
#pragma unroll
                    for (int j = 0; j < 4; ++j) {
                        const int gc = head * 64 + j * 16 + q * 4;
                        ks[j] = shifted4(urow + UK + j * 16, hp, *(const f32x4*)(p.rwkv_mu + 512 + gc));
                        const f32x4 kq = ks[j] * *(const f32x4*)(p.k_k + gc);
                        ssq += kq[0] * kq[0] + kq[1] * kq[1] + kq[2] * kq[2] + kq[3] * kq[3];
                    }
                    ssq += __shfl_xor(ssq, 16); ssq += __shfl_xor(ssq, 32);
                    const float rn = rsqrtf(fmaxf(ssq, 1e-24f));
#pragma unroll
                    for (int j = 0; j < 4; ++j) {
                        const int gc = head * 64 + j * 16 + q * 4;
                        const f32x4 a0 = *(const f32x4*)(p.iclr_a0 + gc), kkw = *(const f32x4*)(p.k_k + gc), kaw = *(const f32x4*)(p.k_a + gc);
                        f32x4 a, kk, bb, kp;
#pragma unroll
                        for (int e = 0; e < 4; ++e) {
                            a[e] = sigmoidf_(a0[e] + acc[i][j][e]);
                            kk[e] = ks[j][e] * kkw[e] * rn; bb[e] = a[e] * kk[e]; kp[e] = ks[j][e] * (1.0f + (a[e] - 1.0f) * kaw[e]);
                        }
                        const f32x4 vs = shifted4(urow + UV + j * 16, hp, *(const f32x4*)(p.rwkv_mu + 1024 + gc));
                        const f32x4 rs = shifted4(urow + UR + j * 16, hp, *(const f32x4*)(p.rwkv_mu + gc));
                        *(u32x2*)(sc + 64 + j * 16) = pack4(kk);
                        *(u32x2*)(sc + 128 + j * 16) = pack4(bb);
                        *(u32x2*)(sc + 192 + j * 16) = pack4(kp);
                        *(u32x2*)(sc + 256 + j * 16) = pack4(vs);
                        *(u32x2*)(sc + 320 + j * 16) = pack4(rs);
                    }
                }
            }
            {
                f32x4 acc[4][4];
                APlain ap{lora + 64, 160};
                gemm_tile<4, 4, 2, 32, 4>(ap, p.wgate_t + (size_t)ct * 128 * 96, 96, 96, acc, lds);
                int tl = t; LAUNDER(tl);
                const int lane = tl & 63, wid = tl >> 6, wr = wid >> 1, wc = wid & 1, r = lane & 15, q = lane >> 4, head = ct * 2 + wc;
#pragma unroll
                for (int i = 0; i < 4; ++i) {
                    const int grow = rt * 128 + wr * 64 + i * 16 + r;
                    bf16_t* g = p.Gg + (size_t)grow * 512 + head * 64 + q * 4;
#pragma unroll
                    for (int j = 0; j < 4; ++j) *(u32x2*)(g + j * 16) = pack4(acc[i][j]);
                }
            }
        }
    }
}

struct ScanOps { f32x2_t d[4], k[4], b[4], p[4], r[4]; float v; };
DI void scan_load(ScanOps& o, const float* __restrict__ q, const float* __restrict__ vp) {
    const f32x4 d0 = *(const f32x4*)(q), d1 = *(const f32x4*)(q + 4), k0 = *(const f32x4*)(q + 64), k1 = *(const f32x4*)(q + 68);
    const f32x4 b0 = *(const f32x4*)(q + 128), b1 = *(const f32x4*)(q + 132), p0 = *(const f32x4*)(q + 192), p1 = *(const f32x4*)(q + 196);
    const f32x4 r0 = *(const f32x4*)(q + 320), r1 = *(const f32x4*)(q + 324);
    o.d[0] = (f32x2_t){d0[0], d0[1]}; o.d[1] = (f32x2_t){d0[2], d0[3]}; o.d[2] = (f32x2_t){d1[0], d1[1]}; o.d[3] = (f32x2_t){d1[2], d1[3]};
    o.k[0] = (f32x2_t){k0[0], k0[1]}; o.k[1] = (f32x2_t){k0[2], k0[3]}; o.k[2] = (f32x2_t){k1[0], k1[1]}; o.k[3] = (f32x2_t){k1[2], k1[3]};
    o.b[0] = (f32x2_t){b0[0], b0[1]}; o.b[1] = (f32x2_t){b0[2], b0[3]}; o.b[2] = (f32x2_t){b1[0], b1[1]}; o.b[3] = (f32x2_t){b1[2], b1[3]};
    o.p[0] = (f32x2_t){p0[0], p0[1]}; o.p[1] = (f32x2_t){p0[2], p0[3]}; o.p[2] = (f32x2_t){p1[0], p1[1]}; o.p[3] = (f32x2_t){p1[2], p1[3]};
    o.r[0] = (f32x2_t){r0[0], r0[1]}; o.r[1] = (f32x2_t){r0[2], r0[3]}; o.r[2] = (f32x2_t){r1[0], r1[1]}; o.r[3] = (f32x2_t){r1[2], r1[3]};
    o.v = *vp;
}
DI void scan_task(const Params& p, unsigned char* lds, const int task) {
    constexpr int CS = 16;
    const int t = threadIdx.x, lane = t & 63, w = t >> 6;
    const int bh = task >> 1, hf = task & 1, b = bh >> 3, head = bh & 7;
    const int rloc = w * 8 + (lane >> 3), kseg = lane & 7;
    const int vrow = hf * 32 + rloc;
    float* stage = (float*)lds;
    float* ybuf = (float*)(lds + 49152);
    const bf16_t* src = p.SC + (size_t)bh * NT_ * 384;
    f32x2_t s2[4];
#pragma unroll
    for (int j = 0; j < 4; ++j) s2[j] = (f32x2_t){0.f, 0.f};
    u32x4 rg[3];
    __builtin_amdgcn_s_setprio(3);
    __syncthreads();
#pragma unroll
    for (int i = 0; i < 3; ++i) rg[i] = *(const u32x4*)(src + (size_t)(t + 256 * i) * 8);
#pragma unroll
    for (int i = 0; i < 3; ++i) { float* d = stage + (t + 256 * i) * 8;
        *(f32x4*)d = (f32x4){lo2f(rg[i].x), hi2f(rg[i].x), lo2f(rg[i].y), hi2f(rg[i].y)}; *(f32x4*)(d + 4) = (f32x4){lo2f(rg[i].z), hi2f(rg[i].z), lo2f(rg[i].w), hi2f(rg[i].w)}; }
    __syncthreads();
    constexpr int NCH = NT_ / CS;
    for (int c = 0; c < NCH; ++c) {
        const int cur = c & 1;
        if (c + 1 < NCH) {
#pragma unroll
            for (int i = 0; i < 3; ++i) rg[i] = *(const u32x4*)(src + (size_t)(c + 1) * CS * 384 + (size_t)(t + 256 * i) * 8);
        }
        if (c > 0) {
            const float* yb = ybuf + (cur ^ 1) * CS * 32;
            const int st = t >> 4, r2 = (t & 15) * 2;
            *(f32x2_t*)(p.yraw + ((size_t)(b * NT_ + (c - 1) * CS + st)) * 512 + head * 64 + hf * 32 + r2) = *(const f32x2_t*)(yb + st * 32 + r2);
        }
        const float* sb = stage + cur * CS * 384 + kseg * 8;
        float* yb = ybuf + cur * CS * 32;
        float yv[CS];
        ScanOps oc, on;
        scan_load(oc, sb, sb + 256 - kseg * 8 + vrow);
#pragma unroll
        for (int st = 0; st < CS; ++st) {
            if (st + 1 < CS) scan_load(on, sb + (st + 1) * 384, sb + (st + 1) * 384 + 256 - kseg * 8 + vrow);
            f32x2_t t0 = s2[0] * oc.k[0], t1 = s2[1] * oc.k[1];
            t0 = s2[2] * oc.k[2] + t0; t1 = s2[3] * oc.k[3] + t1;
            t0 = t0 + t1;
            float dot = dpp_sum8(t0.x + t0.y);
            const f32x2_t vv2 = {oc.v, oc.v}, nd2 = {-dot, -dot};
            f32x2_t u0, u1;
#pragma unroll
            for (int j = 0; j < 4; ++j) { f32x2_t tmp = s2[j] - s2[j] * oc.d[j]; tmp = vv2 * oc.p[j] + tmp; s2[j] = nd2 * oc.b[j] + tmp; }
            u0 = s2[0] * oc.r[0]; u1 = s2[1] * oc.r[1];
            u0 = s2[2] * oc.r[2] + u0; u1 = s2[3] * oc.r[3] + u1;
            u0 = u0 + u1;
            yv[st] = dpp_sum8(u0.x + u0.y);
            if (st + 1 < CS) oc = on;
        }
        if (kseg == 0) {
#pragma unroll
            for (int st = 0; st < CS; ++st) yb[st * 32 + rloc] = yv[st];
        }
        if (c + 1 < NCH) {
            float* dbase = stage + (cur ^ 1) * CS * 384;
#pragma unroll
            for (int i = 0; i < 3; ++i) { float* d = dbase + (t + 256 * i) * 8;
                *(f32x4*)d = (f32x4){lo2f(rg[i].x), hi2f(rg[i].x), lo2f(rg[i].y), hi2f(rg[i].y)}; *(f32x4*)(d + 4) = (f32x4){lo2f(rg[i].z), hi2f(rg[i].z), lo2f(rg[i].w), hi2f(rg[i].w)}; }
        }
        __syncthreads();
    }
    {
        const float* yb = ybuf + ((NCH - 1) & 1) * CS * 32;
        const int st = t >> 4, r2 = (t & 15) * 2;
        *(f32x2_t*)(p.yraw + ((size_t)(b * NT_ + (NCH - 1) * CS + st)) * 512 + head * 64 + hf * 32 + r2) = *(const f32x2_t*)(yb + st * 32 + r2);
    }
    __builtin_amdgcn_s_setprio(0);
}

DI void attn_item(const Params& p, unsigned char* lds, const int item) {
    constexpr int KROW = 208, VROW = 136, KB = 64 * KROW, BUF = KB + 64 * VROW;
    const int t = threadIdx.x, lane = t & 63, w = t >> 6, l31 = lane & 31, h = lane >> 5;
    const int qt = 31 - item / 128, bh = item % 128;
    const bf16_t* Kg = p.Kb + (size_t)bh * NT_ * 96;
    const bf16_t* Vg = p.Vt + (size_t)bh * 64 * NT_;
    const int q = qt * 128 + w * 32 + l31;
    bf16x8 qf[6];
    {
        const bf16_t* qrow = p.Q + ((size_t)bh * NT_ + q) * 96 + 8 * h;
#pragma unroll
        for (int s = 0; s < 6; ++s) qf[s] = *(const bf16x8*)(qrow + 16 * s);
    }
    f32x16 O[2];
#pragma unroll
    for (int i = 0; i < 16; ++i) { O[0][i] = 0.f; O[1][i] = 0.f; }
    float m = -INFINITY, l = 0.f;
    const int njt = 2 * qt + 2;
    int koff[3], kgo[3], voff[2], vgo[2];
#pragma unroll
    for (int i = 0; i < 3; ++i) { const int c = t + 256 * i, r = c / 12, ch = c - r * 12; koff[i] = r * KROW + ch * 16; kgo[i] = r * 96 + ch * 8; }
#pragma unroll
    for (int i = 0; i < 2; ++i) { const int c = t + 256 * i, dv = c >> 3, ch = c & 7; voff[i] = KB + dv * VROW + ch * 16; vgo[i] = dv * NT_ + ch * 8; }
    u32x4 rk[3], rv[2];
#pragma unroll
    for (int i = 0; i < 3; ++i) rk[i] = *(const u32x4*)(Kg + kgo[i]);
#pragma unroll
    for (int i = 0; i < 2; ++i) rv[i] = *(const u32x4*)(Vg + vgo[i]);
    __syncthreads();
#pragma unroll
    for (int i = 0; i < 3; ++i) *(u32x4*)(lds + koff[i]) = rk[i];
#pragma unroll
    for (int i = 0; i < 2; ++i) { *(u32x2*)(lds + voff[i]) = mk2(rv[i].x, rv[i].y); *(u32x2*)(lds + voff[i] + 8) = mk2(rv[i].z, rv[i].w); }
    __syncthreads();
    for (int j = 0; j < njt; ++j) {
        const int cur = j & 1;
        if (j + 1 < njt) {
#pragma unroll
            for (int i = 0; i < 3; ++i) rk[i] = *(const u32x4*)(Kg + (size_t)(j + 1) * 64 * 96 + kgo[i]);
#pragma unroll
            for (int i = 0; i < 2; ++i) rv[i] = *(const u32x4*)(Vg + (j + 1) * 64 + vgo[i]);
        }
        const bool active = (j * 64) <= (qt * 128 + w * 32 + 31);
        if (active) {
            const unsigned char* Kt = lds + cur * BUF;
            const unsigned char* Vtile = Kt + KB;
            f32x16 S[2];
#pragma unroll
            for (int k2 = 0; k2 < 2; ++k2) {
#pragma unroll
                for (int i = 0; i < 16; ++i) S[k2][i] = 0.f;
#pragma unroll
                for (int s = 0; s < 6; ++s) {
                    const bf16x8 kf = *(const bf16x8*)(Kt + (k2 * 32 + l31) * KROW + s * 32 + h * 16);
                    S[k2] = __builtin_amdgcn_mfma_f32_32x32x16_bf16(kf, qf[s], S[k2], 0, 0, 0);
                }
            }
            if (j >= 2 * qt) {
#pragma unroll
                for (int k2 = 0; k2 < 2; ++k2)
#pragma unroll
                    for (int i = 0; i < 16; ++i) { const int key = j * 64 + k2 * 32 + (i & 3) + 8 * (i >> 2) + 4 * h; if (key > q) S[k2][i] = -INFINITY; }
            }
            float mx = S[0][0];
#pragma unroll
            for (int i = 1; i < 16; ++i) mx = fmaxf(mx, S[0][i]);
#pragma unroll
            for (int i = 0; i < 16; ++i) mx = fmaxf(mx, S[1][i]);
            mx = fmaxf(mx, __shfl_xor(mx, 32));
            const float mn = fmaxf(m, mx);
            const float alpha = exp2f(m - mn);
            m = mn;
            float ps = 0.f;
#pragma unroll
            for (int k2 = 0; k2 < 2; ++k2)
#pragma unroll
                for (int i = 0; i < 16; ++i) { const float e = exp2f(S[k2][i] - mn); S[k2][i] = e; ps += e; }
            l = l * alpha + ps;
#pragma unroll
            for (int i = 0; i < 16; ++i) { O[0][i] *= alpha; O[1][i] *= alpha; }
#pragma unroll
            for (int k2 = 0; k2 < 2; ++k2)
#pragma unroll
                for (int s2 = 0; s2 < 2; ++s2) {
                    unsigned pw[4];
#pragma unroll
                    for (int e = 0; e < 4; ++e) pw[e] = pk2(S[k2][8 * s2 + 2 * e], S[k2][8 * s2 + 2 * e + 1]);
                    const bf16x8 pf = __builtin_bit_cast(bf16x8, mk4(pw[0], pw[1], pw[2], pw[3]));
#pragma unroll
                    for (int dt = 0; dt < 2; ++dt) {
                        const unsigned char* vp = Vtile + (dt * 32 + l31) * VROW + (k2 * 32 + s2 * 16 + 4 * h) * 2;
                        const u32x2 v0 = *(const u32x2*)(vp), v1 = *(const u32x2*)(vp + 16);
                        const bf16x8 vf = __builtin_bit_cast(bf16x8, mk4(v0.x, v0.y, v1.x, v1.y));
                        O[dt] = __builtin_amdgcn_mfma_f32_32x32x16_bf16(vf, pf, O[dt], 0, 0, 0);
                    }
                }
        }
        if (j + 1 < njt) {
            unsigned char* nb = lds + (cur ^ 1) * BUF;
#pragma unroll
            for (int i = 0; i < 3; ++i) *(u32x4*)(nb + koff[i]) = rk[i];
#pragma unroll
            for (int i = 0; i < 2; ++i) { *(u32x2*)(nb + voff[i]) = mk2(rv[i].x, rv[i].y); *(u32x2*)(nb + voff[i] + 8) = mk2(rv[i].z, rv[i].w); }
        }
        __syncthreads();
    }
    l += __shfl_xor(l, 32);
    const float inv = 1.0f / l;
    bf16_t* yrow = p.Y + ((size_t)((bh >> 3) * NT_ + q)) * DM + 512 + (bh & 7) * 64;
#pragma unroll
    for (int dt = 0; dt < 2; ++dt)
#pragma unroll
        for (int g = 0; g < 4; ++g)
            *(u32x2*)(yrow + dt * 32 + 8 * g + 4 * h) = mk2(pk2(O[dt][4 * g] * inv, O[dt][4 * g + 1] * inv), pk2(O[dt][4 * g + 2] * inv, O[dt][4 * g + 3] * inv));
}

DI void phase4(const Params& p, unsigned char* lds, int bid, int G) {
    int* sh_item = (int*)(lds + LDS_BYTES - 64);
    for (int task = bid; task < 256; task += G) scan_task(p, lds, task);
    STAMP(10);
    for (;;) {
        __syncthreads();
        if (threadIdx.x == 0) *sh_item = (int)atomicAdd(&p.ctrl[CTRL_ATTNQ], 1u);
        __syncthreads();
        const int item = *sh_item;
        if (item >= 4096) break;
        attn_item(p, lds, item);
    }
}

DI void phase5(const Params& p, unsigned char* lds, int bid, int G) {
    const int t = threadIdx.x, lane = t & 63, wid = t >> 6, wr = wid >> 1, wc = wid & 1;
    float* tile = (float*)lds;
    float* ssq = (float*)(lds + 69632);
    float* biasl = ssq + 128;
    int* lcnt = (int*)(lds + 65536);
    int* lbase = lcnt + 256;
    unsigned char* le = (unsigned char*)(lbase + 256);
    unsigned char* lp = le + 1024;
    __syncthreads();
    biasl[t] = p.router_bias[t];
    float* scores = (float*)(p.bscr + (size_t)bid * BSCR_PER_BLOCK);
    bf16_t* act = (bf16_t*)(p.bscr + (size_t)bid * BSCR_PER_BLOCK + 131072);
    for (int rt = bid; rt < NTOK / 128; rt += G) {
        const int b = rt >> 5;
        const float* mod = p.mod + b * 6144;
        __syncthreads();
        if (t < 128) ssq[t] = 0.f;
        lcnt[t] = 0;
#pragma unroll 1
        for (int it = 0; it < 16; ++it) {
            int tl = t; LAUNDER(tl);
            const int pr = (tl >> 2) + 64 * it;
            const int row = pr >> 3, head = pr & 7, part = tl & 3, grow = rt * 128 + row, tt = grow & 4095;
            const int ch = head * 64 + part * 16;
            const float* yr = p.yraw + (size_t)grow * 512 + ch;
            float y[16];
#pragma unroll
            for (int i = 0; i < 4; ++i) { const f32x4 v = *(const f32x4*)(yr + 4 * i); y[4 * i] = v[0]; y[4 * i + 1] = v[1]; y[4 * i + 2] = v[2]; y[4 * i + 3] = v[3]; }
            float sm = 0.f;
#pragma unroll
            for (int i = 0; i < 16; ++i) sm += y[i];
            sm += __shfl_xor(sm, 1); sm += __shfl_xor(sm, 2);
            const float mean = sm * (1.0f / 64.0f);
            float vr = 0.f;
#pragma unroll
            for (int i = 0; i < 16; ++i) { const float d = y[i] - mean; vr += d * d; }
            vr += __shfl_xor(vr, 1); vr += __shfl_xor(vr, 2);
            const float rs = rsqrtf(vr * (1.0f / 64.0f) + 64e-5f);
            const bf16_t* sc = p.SC + ((size_t)(b * 8 + head) * NT_ + tt) * 384 + part * 16;
            float kp[16], vv[16], rr[16];
#pragma unroll
            for (int i = 0; i < 2; ++i) {
                const u32x4 a = *(const u32x4*)(sc + 192 + 8 * i), c = *(const u32x4*)(sc + 256 + 8 * i), d = *(const u32x4*)(sc + 320 + 8 * i);
                kp[8 * i] = lo2f(a.x); kp[8 * i + 1] = hi2f(a.x); kp[8 * i + 2] = lo2f(a.y); kp[8 * i + 3] = hi2f(a.y); kp[8 * i + 4] = lo2f(a.z); kp[8 * i + 5] = hi2f(a.z); kp[8 * i + 6] = lo2f(a.w); kp[8 * i + 7] = hi2f(a.w);
                vv[8 * i] = lo2f(c.x); vv[8 * i + 1] = hi2f(c.x); vv[8 * i + 2] = lo2f(c.y); vv[8 * i + 3] = hi2f(c.y); vv[8 * i + 4] = lo2f(c.z); vv[8 * i + 5] = hi2f(c.z); vv[8 * i + 6] = lo2f(c.w); vv[8 * i + 7] = hi2f(c.w);
                rr[8 * i] = lo2f(d.x); rr[8 * i + 1] = hi2f(d.x); rr[8 * i + 2] = lo2f(d.y); rr[8 * i + 3] = hi2f(d.y); rr[8 * i + 4] = lo2f(d.z); rr[8 * i + 5] = hi2f(d.z); rr[8 * i + 6] = lo2f(d.w); rr[8 * i + 7] = hi2f(d.w);
            }
            float bn = 0.f;
#pragma unroll
            for (int i = 0; i < 16; ++i) bn += rr[i] * kp[i] * p.r_k[ch + i];
            bn += __shfl_xor(bn, 1); bn += __shfl_xor(bn, 2);
            const bf16_t* gg = p.Gg + (size_t)grow * 512 + ch;
            const u32x4 g0 = *(const u32x4*)(gg), g1 = *(const u32x4*)(gg + 8);
            float g[16] = {lo2f(g0.x), hi2f(g0.x), lo2f(g0.y), hi2f(g0.y), lo2f(g0.z), hi2f(g0.z), lo2f(g0.w), hi2f(g0.w), lo2f(g1.x), hi2f(g1.x), lo2f(g1.y), hi2f(g1.y), lo2f(g1.z), hi2f(g1.z), lo2f(g1.w), hi2f(g1.w)};
            float o[16];
#pragma unroll
            for (int i = 0; i < 16; ++i) o[i] = ((y[i] - mean) * rs * p.ln_w[ch + i] + p.ln_b[ch + i] + bn * vv[i]) * g[i];
            bf16_t* yd = p.Y + (size_t)grow * DM + ch;
            *(u32x4*)(yd) = mk4(pk2(o[0], o[1]), pk2(o[2], o[3]), pk2(o[4], o[5]), pk2(o[6], o[7]));
            *(u32x4*)(yd + 8) = mk4(pk2(o[8], o[9]), pk2(o[10], o[11]), pk2(o[12], o[13]), pk2(o[14], o[15]));
        }
        asm volatile("s_waitcnt vmcnt(0)" ::: "memory");
        __syncthreads();
        STAMP(11);
#pragma unroll 1
        for (int ct = 0; ct < 8; ++ct) {
            f32x4 acc[4][4];
            APlain ap{p.Y + (size_t)rt * 128 * DM, DM};
            gemm_core<4, 64>(ap, p.wout_t + (size_t)ct * 128 * DM, DM, DM, acc, lds);
            int ll = lane; LAUNDER(ll);
#pragma unroll
            for (int i = 0; i < 4; ++i) {
                const int row = wr * 64 + i * 16 + (ll & 15), grow = rt * 128 + row;
                float s = 0.f;
#pragma unroll
                for (int j = 0; j < 4; ++j) {
                    const int col = ct * 128 + wc * 64 + j * 16 + (ll >> 4) * 4;
                    const f32x4 xv = *(const f32x4*)(p.x + (size_t)grow * DM + col), ga = *(const f32x4*)(mod + 2048 + col);
                    f32x4 o;
#pragma unroll
                    for (int e = 0; e < 4; ++e) { o[e] = xv[e] + ga[e] * acc[i][j][e]; s += o[e] * o[e]; }
                    *(f32x4*)(p.out + (size_t)grow * DM + col) = o;
                }
                s += __shfl_xor(s, 16); s += __shfl_xor(s, 32);
                if ((ll >> 4) == 0) atomicAdd(&ssq[row], s);
            }
        }
        asm volatile("s_waitcnt vmcnt(0)" ::: "memory");
        __syncthreads();
        STAMP(12);
#pragma unroll 1
        for (int mg = 0; mg < 8; ++mg) {
            int ll = lane; LAUNDER(ll);
            f32x4 xv[4][4];
#pragma unroll
            for (int u = 0; u < 4; ++u)
#pragma unroll
                for (int i = 0; i < 4; ++i) xv[u][i] = *(const f32x4*)(p.out + (size_t)(rt * 128 + wid + 4 * (mg * 4 + u)) * DM + ll * 4 + 256 * i);
#pragma unroll
            for (int u = 0; u < 4; ++u) {
                const int r = wid + 4 * (mg * 4 + u), grow = rt * 128 + r;
                const float rs = rsqrtf(ssq[r] * (1.0f / DM) + 1e-6f);
#pragma unroll
                for (int i = 0; i < 4; ++i) {
                    const int c = ll * 4 + 256 * i;
                    const f32x4 g = *(const f32x4*)(p.norm_ffn + c), sh = *(const f32x4*)(mod + 3072 + c), sc = *(const f32x4*)(mod + 4096 + c);
                    float o[4];
#pragma unroll
                    for (int e = 0; e < 4; ++e) o[e] = xv[u][i][e] * rs * g[e] * (1.0f + sc[e]) + sh[e];
                    *(u32x2*)(p.H + (size_t)grow * DM + c) = mk2(pk2(o[0], o[1]), pk2(o[2], o[3]));
                }
            }
        }
        asm volatile("s_waitcnt vmcnt(0)" ::: "memory");
        __syncthreads();
        STAMP(13);
#pragma unroll 1
        for (int ct = 0; ct < 2; ++ct) {
            f32x4 acc[4][4];
            APlain ap{p.H + (size_t)rt * 128 * DM, DM};
            gemm_core<4, 64>(ap, p.wr_t + (size_t)ct * 128 * DM, DM, DM, acc, lds);
            int ll = lane; LAUNDER(ll);
#pragma unroll
            for (int i = 0; i < 4; ++i)
#pragma unroll
                for (int j = 0; j < 4; ++j) {
                    const int row = wr * 64 + i * 16 + (ll & 15), col = ct * 128 + wc * 64 + j * 16 + (ll >> 4) * 4;
#pragma unroll
                    for (int e = 0; e < 4; ++e) scores[(col + e) * 128 + row] = sigmoidf_(acc[i][j][e]);
                }
        }
        asm volatile("s_waitcnt vmcnt(0)" ::: "memory");
        __syncthreads();
        STAMP(14);
#pragma unroll 1
        for (int hh = 0; hh < 2; ++hh) {
            __syncthreads();
            {
                int tl = t; LAUNDER(tl);
                f32x4 rgs[16];
#pragma unroll
                for (int i = 0; i < 16; ++i) { const int c = tl + 256 * i; rgs[i] = *(const f32x4*)(scores + (c >> 4) * 128 + hh * 64 + (c & 15) * 4); }
#pragma unroll
                for (int i = 0; i < 16; ++i) *(f32x4*)(tile + (tl + 256 * i) * 4) = rgs[i];
            }
            __syncthreads();
            if (t < 64) {
                int tl = t; LAUNDER(tl);
                const int token = rt * 128 + hh * 64 + tl;
                const float* sc = tile + tl;
                float gs[8];
#pragma unroll
                for (int g = 0; g < 8; ++g) {
                    float m1 = -INFINITY, m2 = -INFINITY;
#pragma unroll 8
                    for (int i = 0; i < 32; ++i) { const float v = sc[(g * 32 + i) * 64] + biasl[g * 32 + i]; m2 = fmaxf(m2, fminf(m1, v)); m1 = fmaxf(m1, v); }
                    gs[g] = m1 + m2;
                }
                unsigned selmask = 0u;
#pragma unroll
                for (int g = 0; g < 8; ++g) {
                    int rank = 0;
#pragma unroll
                    for (int g2 = 0; g2 < 8; ++g2) rank += (gs[g2] > gs[g] || (gs[g2] == gs[g] && g2 < g)) ? 1 : 0;
                    selmask |= (rank < 4 ? 1u : 0u) << g;
                }
                float tv[8]; int ti[8];
#pragma unroll
                for (int k = 0; k < 8; ++k) { tv[k] = -INFINITY; ti[k] = 0; }
#pragma unroll 1
                for (int g = 0; g < 8; ++g) {
                    if ((selmask >> g) & 1u) {
#pragma unroll 4
                        for (int i = 0; i < 32; ++i) {
                            const int e = g * 32 + i;
                            const float v = sc[e * 64] + biasl[e];
                            if (v > tv[7]) {
#pragma unroll
                                for (int k = 7; k >= 1; --k) {
                                    if (v > tv[k - 1]) { tv[k] = tv[k - 1]; ti[k] = ti[k - 1]; }
                                    else if (v > tv[k]) { tv[k] = v; ti[k] = e; }
                                }
                                if (v > tv[0]) { tv[0] = v; ti[0] = e; }
                            }
                        }
                    }
                }
                float ws[8], wsum = 0.f;
#pragma unroll
                for (int k = 0; k < 8; ++k) { ws[k] = sc[ti[k] * 64]; wsum += ws[k]; }
                const float sc25 = 2.5f / wsum;
#pragma unroll
                for (int k = 0; k < 8; ++k) {
                    p.topk_idx[token * 8 + k] = ti[k];
                    p.topk_w[token * 8 + k] = ws[k] * sc25;
                    le[(hh * 64 + tl) * 8 + k] = (unsigned char)ti[k];
                    lp[(hh * 64 + tl) * 8 + k] = (unsigned char)atomicAdd(&lcnt[ti[k]], 1);
                }
            }
        }
        __syncthreads();
        { const int c = lcnt[t]; lbase[t] = c > 0 ? (int)atomicAdd(&p.ctrl[CTRL_ECNT + t * ECNT_STRIDE], (unsigned)c) : 0; }
        __syncthreads();
#pragma unroll
        for (int i = 0; i < 4; ++i) {
            const int a = t + 256 * i, e = le[a];
            p.elist[(size_t)e * NTOK + lbase[e] + lp[a]] = (rt * 128) * 8 + a;
        }
        STAMP(15);
#pragma unroll 1
        for (int ct = 0; ct < 4; ++ct) {
            f32x4 acc[4][4];
            APlain ap{p.H + (size_t)rt * 128 * DM, DM};
            gemm_core<4, 64>(ap, p.wsgu_t + (size_t)ct * 128 * DM, DM, DM, acc, lds);
            acc_to_lds<4>(acc, tile, 132);
            __syncthreads();
            int tl = t; LAUNDER(tl);
            const int row = tl >> 1, half = tl & 1;
            unsigned w[16];
#pragma unroll
            for (int i = 0; i < 16; ++i) {
                const int c = half * 32 + 2 * i;
                const float g0 = tile[row * 132 + c], g1 = tile[row * 132 + c + 1], u0 = tile[row * 132 + 64 + c], u1 = tile[row * 132 + 64 + c + 1];
                w[i] = pk2(g0 * sigmoidf_(g0) * u0, g1 * sigmoidf_(g1) * u1);
            }
            bf16_t* d = act + row * 256 + ct * 64 + half * 32;
#pragma unroll
            for (int i = 0; i < 4; ++i) *(u32x4*)(d + 8 * i) = mk4(w[4 * i], w[4 * i + 1], w[4 * i + 2], w[4 * i + 3]);
        }
        asm volatile("s_waitcnt vmcnt(0)" ::: "memory");
        __syncthreads();
        STAMP(16);
#pragma unroll 1
        for (int ct = 0; ct < 8; ++ct) {
            f32x4 acc[4][4];
            APlain ap{act, 256};
            gemm_core<4, 64>(ap, p.wsd_t + (size_t)ct * 128 * 256, 256, 256, acc, lds);
            int ll = lane; LAUNDER(ll);
#pragma unroll
            for (int i = 0; i < 4; ++i)
#pragma unroll
                for (int j = 0; j < 4; ++j) {
                    const int row = wr * 64 + i * 16 + (ll & 15), grow = rt * 128 + row, col = ct * 128 + wc * 64 + j * 16 + (ll >> 4) * 4;
                    const f32x4 xv = *(const f32x4*)(p.out + (size_t)grow * DM + col), gf = *(const f32x4*)(mod + 5120 + col);
                    f32x4 o;
#pragma unroll
                    for (int e = 0; e < 4; ++e) o[e] = xv[e] + gf[e] * acc[i][j][e];
                    *(f32x4*)(p.out + (size_t)grow * DM + col) = o;
                }
        }
    }
}

DI void phase6(const Params& p, unsigned char* lds, int bid, int G) {
    const int t = threadIdx.x, lane = t & 63, wid = t >> 6, wr = wid >> 1, wc = wid & 1;
    float* tile = (float*)lds;
    int* pre = (int*)(lds + 69632);
    int* rowtok = (int*)(lds + 69632 + 1056);
    int* rowslot = rowtok + 128;
    float* roww = (float*)(rowslot + 128);
    bf16_t* act = (bf16_t*)(p.bscr + (size_t)bid * BSCR_PER_BLOCK + 131072);
    __syncthreads();
    pre[t + 1] = ((int)p.ctrl[CTRL_ECNT + t * ECNT_STRIDE] + 127) >> 7;
    __syncthreads();
    if (t == 0) { int s = 0; pre[0] = 0; for (int e = 1; e <= NEXP; ++e) { s += pre[e]; pre[e] = s; } }
    __syncthreads();
    const int total = pre[NEXP];
    for (int item = bid; item < total; item += G) {
        int lo = 0, hi = NEXP - 1;
        while (lo < hi) { const int mid = (lo + hi + 1) >> 1; if (pre[mid] <= item) lo = mid; else hi = mid - 1; }
        const int e = lo, tl = item - pre[e], cnt = (int)p.ctrl[CTRL_ECNT + e * ECNT_STRIDE];
        __syncthreads();
        if (t < 128) {
            const int r = tl * 128 + t;
            if (r < cnt) { const int ts = p.elist[(size_t)e * NTOK + r]; rowtok[t] = ts >> 3; rowslot[t] = ts; roww[t] = p.topk_w[ts]; }
            else { rowtok[t] = 0; rowslot[t] = -1; roww[t] = 0.f; }
        }
        __syncthreads();
#pragma unroll 1
        for (int ct = 0; ct < 4; ++ct) {
            f32x4 acc[4][4];
            AGather ap{p.H, rowtok};
            gemm_core<4, 64>(ap, p.wegu_t + ((size_t)e * 512 + ct * 128) * DM, DM, DM, acc, lds);
            acc_to_lds<4>(acc, tile, 132);
            __syncthreads();
            int tl = t; LAUNDER(tl);
            const int row = tl >> 1, half = tl & 1;
            unsigned w[16];
#pragma unroll
            for (int i = 0; i < 16; ++i) {
                const int c = half * 32 + 2 * i;
                const float g0 = tile[row * 132 + c], g1 = tile[row * 132 + c + 1], u0 = tile[row * 132 + 64 + c], u1 = tile[row * 132 + 64 + c + 1];
                w[i] = pk2(g0 * sigmoidf_(g0) * u0, g1 * sigmoidf_(g1) * u1);
            }
            bf16_t* d = act + row * 256 + ct * 64 + half * 32;
#pragma unroll
            for (int i = 0; i < 4; ++i) *(u32x4*)(d + 8 * i) = mk4(w[4 * i], w[4 * i + 1], w[4 * i + 2], w[4 * i + 3]);
        }
        asm volatile("s_waitcnt vmcnt(0)" ::: "memory");
        __syncthreads();
#pragma unroll 1
        for (int ct = 0; ct < 8; ++ct) {
            f32x4 acc[4][4];
            APlain ap{act, 256};
            gemm_core<4, 64>(ap, p.wed_t + ((size_t)e * 1024 + ct * 128) * 256, 256, 256, acc, lds);
            int ll = lane; LAUNDER(ll);
#pragma unroll
            for (int i = 0; i < 4; ++i) {
                const int row = wr * 64 + i * 16 + (ll & 15), srow = rowslot[row];
                const float ww = roww[row];
                if (srow >= 0) {
#pragma unroll
                    for (int j = 0; j < 4; ++j) {
                        const int col = ct * 128 + wc * 64 + j * 16 + (ll >> 4) * 4;
                        *(u32x2*)(p.slot + (size_t)srow * DM + col) = mk2(pk2(acc[i][j][0] * ww, acc[i][j][1] * ww), pk2(acc[i][j][2] * ww, acc[i][j][3] * ww));
                    }
                }
            }
        }
    }
}

DI void phase7(const Params& p, int bid, int G) {
    const int lane = threadIdx.x & 63, gw = bid * 4 + (threadIdx.x >> 6), nw = G * 4;
    for (int row = gw; row < NTOK; row += nw) {
        const float* mod = p.mod + (row >> 12) * 6144 + 5120;
#pragma unroll
        for (int i = 0; i < 4; ++i) {
            const int c = lane * 4 + 256 * i;
            float s[4] = {0.f, 0.f, 0.f, 0.f};
#pragma unroll
            for (int k = 0; k < 8; ++k) { const u32x2 w = *(const u32x2*)(p.slot + ((size_t)row * 8 + k) * DM + c); s[0] += lo2f(w.x); s[1] += hi2f(w.x); s[2] += lo2f(w.y); s[3] += hi2f(w.y); }
            const f32x4 gf = *(const f32x4*)(mod + c);
            f32x4 o = *(const f32x4*)(p.out + (size_t)row * DM + c);
#pragma unroll
            for (int e = 0; e < 4; ++e) o[e] += gf[e] * s[e];
            *(f32x4*)(p.out + (size_t)row * DM + c) = o;
        }
    }
}

extern __shared__ __attribute__((aligned(16))) unsigned char smem[];

template <int PH> DI void run_phase(const Params& p, unsigned char* lds, int bid, int G) {
    if (PH == 0) phase0(p, lds, bid, G);
    if (PH == 1) phase1(p, bid, G);
    if (PH == 2) phase2(p, lds, bid, G);
    if (PH == 3) phase3(p, lds, bid, G);
    if (PH == 4) phase4(p, lds, bid, G);
    if (PH == 5) phase5(p, lds, bid, G);
    if (PH == 6) phase6(p, lds, bid, G);
    if (PH == 7) phase7(p, bid, G);
}

#if !ONE_LAUNCH
template <int PH> __global__ void __launch_bounds__(256, 2) phase_kernel(Params p) { run_phase<PH>(p, smem, blockIdx.x, gridDim.x); }
#endif

#if ONE_LAUNCH
__global__ void __launch_bounds__(256, 2) mega_kernel(Params p) {
    volatile LAS unsigned* st = (volatile LAS unsigned*)(smem + LDS_BYTES - 16);
    if (threadIdx.x == 0) { st[0] = 0u; st[1] = 0u; st[2] = 0u; st[3] = 0u; }
    __syncthreads();
    XcdBarrier bar = xcd_barrier_post(p.ctrl, st);
    const int bid = blockIdx.x, G = gridDim.x;
    STAMP(0);
    run_phase<0>(p, smem, bid, G); xcd_barrier(bar); STAMP(1);
    run_phase<1>(p, smem, bid, G); xcd_barrier(bar); STAMP(2);
    run_phase<2>(p, smem, bid, G); xcd_barrier(bar); STAMP(3);
    run_phase<3>(p, smem, bid, G); xcd_barrier(bar); STAMP(4);
    run_phase<4>(p, smem, bid, G); xcd_barrier(bar); STAMP(5);
    run_phase<5>(p, smem, bid, G); xcd_barrier(bar); STAMP(6);
    run_phase<6>(p, smem, bid, G); xcd_barrier(bar); STAMP(7);
    run_phase<7>(p, smem, bid, G);
#ifdef PROBE_A
    xcd_barrier(bar); STAMP(8);
    xcd_barrier(bar);
    {
        const unsigned long long* sp = (const unsigned long long*)(p.ctrl + CTRL_STAMP);
        const unsigned long long ta = __hip_atomic_load(sp + PROBE_A, __ATOMIC_RELAXED, __HIP_MEMORY_SCOPE_AGENT), tb = __hip_atomic_load(sp + PROBE_B, __ATOMIC_RELAXED, __HIP_MEMORY_SCOPE_AGENT);
        const unsigned long long t0 = __builtin_amdgcn_s_memrealtime();
        while (__builtin_amdgcn_s_memrealtime() - t0 < tb - ta) __builtin_amdgcn_s_sleep(8);
    }
#endif
}
#define OCC_KERNEL mega_kernel
#else
#define OCC_KERNEL phase_kernel<5>
#endif

static inline size_t al256(size_t x) { return (x + 255) & ~(size_t)255; }

extern "C" void kernel_launch(void* const* d_in, const int* in_sizes, int n_in, void* d_out, int out_size, void* d_ws, size_t ws_size, hipStream_t stream) {
    (void)in_sizes; (void)n_in; (void)out_size;
    Params p{};
    p.x = (const float*)d_in[0]; p.c = (const float*)d_in[1]; p.positions = (const int*)d_in[2]; p.ada_w = (const float*)d_in[3]; p.ada_b = (const float*)d_in[4];
    p.norm_mix = (const float*)d_in[5]; p.w_in = (const float*)d_in[6]; p.rwkv_mu = (const float*)d_in[7]; p.decay_w0 = (const float*)d_in[8]; p.decay_up = (const float*)d_in[9];
    p.iclr_a0 = (const float*)d_in[10]; p.iclr_up = (const float*)d_in[11]; p.gate_up = (const float*)d_in[12]; p.k_k = (const float*)d_in[13]; p.k_a = (const float*)d_in[14];
    p.r_k = (const float*)d_in[15]; p.ln_w = (const float*)d_in[16]; p.ln_b = (const float*)d_in[17]; p.q_a_norm = (const float*)d_in[18]; p.w_q_b = (const float*)d_in[19];
    p.kv_a_norm = (const float*)d_in[20]; p.w_kv_b = (const float*)d_in[21]; p.q_norm = (const float*)d_in[22]; p.k_norm = (const float*)d_in[23]; p.w_out = (const float*)d_in[24];
    p.norm_ffn = (const float*)d_in[25]; p.w_router = (const float*)d_in[26]; p.router_bias = (const float*)d_in[27]; p.w_e_gu = (const float*)d_in[28]; p.w_e_d = (const float*)d_in[29];
    p.w_sh_gu = (const float*)d_in[30]; p.w_sh_d = (const float*)d_in[31];
    p.out = (float*)d_out;

    static int grid = 0;
    if (!grid) {
        int dev = 0, cus = 0, per_cu = 0;
        (void)hipGetDevice(&dev);
        (void)hipDeviceGetAttribute(&cus, hipDeviceAttributeMultiprocessorCount, dev);
#if ONE_LAUNCH
        (void)hipFuncSetAttribute((const void*)mega_kernel, hipFuncAttributeMaxDynamicSharedMemorySize, LDS_BYTES);
#endif
#if !ONE_LAUNCH
        (void)hipFuncSetAttribute((const void*)phase_kernel<0>, hipFuncAttributeMaxDynamicSharedMemorySize, LDS_BYTES);
#endif
#if !ONE_LAUNCH
        (void)hipFuncSetAttribute((const void*)phase_kernel<1>, hipFuncAttributeMaxDynamicSharedMemorySize, LDS_BYTES);
#endif
#if !ONE_LAUNCH
        (void)hipFuncSetAttribute((const void*)phase_kernel<2>, hipFuncAttributeMaxDynamicSharedMemorySize, LDS_BYTES);
#endif
#if !ONE_LAUNCH
        (void)hipFuncSetAttribute((const void*)phase_kernel<3>, hipFuncAttributeMaxDynamicSharedMemorySize, LDS_BYTES);
#endif
#if !ONE_LAUNCH
        (void)hipFuncSetAttribute((const void*)phase_kernel<4>, hipFuncAttributeMaxDynamicSharedMemorySize, LDS_BYTES);
#endif
#if !ONE_LAUNCH
        (void)hipFuncSetAttribute((const void*)phase_kernel<5>, hipFuncAttributeMaxDynamicSharedMemorySize, LDS_BYTES);
#endif
#if !ONE_LAUNCH
        (void)hipFuncSetAttribute((const void*)phase_kernel<6>, hipFuncAttributeMaxDynamicSharedMemorySize, LDS_BYTES);
#endif
#if !ONE_LAUNCH
        (void)hipFuncSetAttribute((const void*)phase_kernel<7>, hipFuncAttributeMaxDynamicSharedMemorySize, LDS_BYTES);
#endif
        (void)hipOccupancyMaxActiveBlocksPerMultiprocessor(&per_cu, (const void*)OCC_KERNEL, 256, LDS_BYTES);
        if (cus <= 0) cus = 256;
        if (per_cu < 1) per_cu = 1;
        grid = cus * (per_cu < 2 ? per_cu : 2);
    }
    unsigned char* w = (unsigned char*)d_ws; size_t o = 0;
    auto take = [&](size_t bytes) { unsigned char* r = w + o; o = al256(o + bytes); return r; };
    p.ctrl = (unsigned*)take(CTRL_WORDS * 4);
    p.mod = (float*)take((size_t)NB * 6144 * 4);
    p.rope = (float*)take((size_t)NTOK * 32 * 4);
    p.win_t = (bf16_t*)take((size_t)LDU * 1024 * 2);
    p.wq_t = (bf16_t*)take((size_t)768 * 256 * 2);
    p.wkv_t = (bf16_t*)take((size_t)1024 * 128 * 2);
    p.wdec_t = (bf16_t*)take((size_t)512 * 32 * 2);
    p.wiclr_t = (bf16_t*)take((size_t)512 * 32 * 2);
    p.wgate_t = (bf16_t*)take((size_t)512 * 96 * 2);
    p.wout_t = (bf16_t*)take((size_t)1024 * 1024 * 2);
    p.wr_t = (bf16_t*)take((size_t)256 * 1024 * 2);
    p.wsgu_t = (bf16_t*)take((size_t)512 * 1024 * 2);
    p.wsd_t = (bf16_t*)take((size_t)1024 * 256 * 2);
    p.wegu_t = (bf16_t*)take((size_t)NEXP * 512 * 1024 * 2);
    p.wed_t = (bf16_t*)take((size_t)NEXP * 1024 * 256 * 2);
    p.H = (bf16_t*)take((size_t)NTOK * DM * 2);
    p.topk_idx = (int*)take((size_t)NTOK * 8 * 4);
    p.topk_w = (float*)take((size_t)NTOK * 8 * 4);
    p.elist = (int*)take((size_t)NEXP * NTOK * 4);
    p.bscr = take((size_t)grid * BSCR_PER_BLOCK);
    const size_t ov = o;
    p.U = (bf16_t*)take((size_t)NTOK * LDU * 2);
    p.Q = (bf16_t*)take((size_t)NTOK * 8 * 96 * 2);
    p.Kb = (bf16_t*)take((size_t)NTOK * 8 * 96 * 2);
    p.Vt = (bf16_t*)take((size_t)NTOK * 8 * 64 * 2);
    p.SC = (bf16_t*)take((size_t)NTOK * 8 * 384 * 2);
    p.Gg = (bf16_t*)take((size_t)NTOK * 512 * 2);
    p.yraw = (float*)take((size_t)NTOK * 512 * 4);
    p.Y = (bf16_t*)take((size_t)NTOK * DM * 2);
    p.slot = (bf16_t*)(w + ov);
    const size_t need_slot = ov + (size_t)NTOK * 8 * DM * 2;
    if (o > ws_size || need_slot > ws_size) { fprintf(stderr, "workspace too small: need %zu / %zu, have %zu\n", o, need_slot, ws_size); return; }

    (void)hipMemsetAsync(p.ctrl, 0, CTRL_WORDS * 4, stream);
#if ONE_LAUNCH
    hipLaunchKernelGGL(mega_kernel, dim3(grid), dim3(256), LDS_BYTES, stream, p);
#else
    hipLaunchKernelGGL(phase_kernel<0>, dim3(grid), dim3(256), LDS_BYTES, stream, p);
    hipLaunchKernelGGL(phase_kernel<1>, dim3(grid), dim3(256), LDS_BYTES, stream, p);
    hipLaunchKernelGGL(phase_kernel<2>, dim3(grid), dim3(256), LDS_BYTES, stream, p);
    hipLaunchKernelGGL(phase_kernel<3>, dim3(grid), dim3(256), LDS_BYTES, stream, p);
    hipLaunchKernelGGL(phase_kernel<4>, dim3(grid), dim3(256), LDS_BYTES, stream, p);
    hipLaunchKernelGGL(phase_kernel<5>, dim3(grid), dim3(256), LDS_BYTES, stream, p);
    hipLaunchKernelGGL(phase_kernel<6>, dim3(grid), dim3(256), LDS_BYTES, stream, p);
    hipLaunchKernelGGL(phase_kernel<7>, dim3(grid), dim3(256), LDS_BYTES, stream, p);
#endif
}
```

```cpp
#include <hip/hip_runtime.h>
#include <stdint.h>
#include <stdio.h>
#define DI __device__ __forceinline__

#ifndef ONE_LAUNCH
#define ONE_LAUNCH 1
#endif

typedef unsigned short bf16_t;
typedef short bf16x8 __attribute__((ext_vector_type(8)));
typedef float f32x4 __attribute__((ext_vector_type(4)));
typedef float f32x16 __attribute__((ext_vector_type(16)));
typedef float f32x2_t __attribute__((ext_vector_type(2)));
typedef unsigned u32x4 __attribute__((ext_vector_type(4)));
typedef unsigned u32x2 __attribute__((ext_vector_type(2)));
#define LAUNDER(v) asm volatile("" : "+v"(v))
DI u32x4 mk4(unsigned a, unsigned b, unsigned c, unsigned d) { return (u32x4){a, b, c, d}; }
DI u32x2 mk2(unsigned a, unsigned b) { return (u32x2){a, b}; }

typedef __bf16 bf16x2_t __attribute__((ext_vector_type(2)));

constexpr int NB = 16, NT_ = 4096, DM = 1024, NTOK = NB * NT_;
constexpr int LDU = 2176;
constexpr int UQ = 0, UKV = 256, UR = 384, UK = 896, UV = 1408, UXW = 1920, UXA = 1952, UXG = 1984, UPE = 2080;
constexpr int NEXP = 256, TOPK = 8;
constexpr int LDS_BYTES = 73728;
constexpr float QSCALE = 0.14724444f;

#define XB_TMO      128
#define XB_XCNT(j)  (256  + 64 * (j))
#define XB_XSUB(j)  (1280 + 64 * (j))
#define XB_XGEN(j)  (2304 + 64 * (j))
#define XB_TOP      3328
#define XB_TOPGEN   3392
#define XCD_BAR_WORDS 3456
#define XB_SPIN_CAP (1u << 22)
#define LAS __attribute__((address_space(3)))
constexpr int CTRL_ATTNQ = 4096, CTRL_ECNT = 8192, ECNT_STRIDE = 64, CTRL_WORDS = 24576;
constexpr int CTRL_STAMP = 4160;
constexpr int CTRL_Q6 = 4608;
#ifdef PROBE_A
#define STAMP(id) do { if (blockIdx.x == 0 && threadIdx.x == 0) __hip_atomic_store((unsigned long long*)(p.ctrl + CTRL_STAMP) + (id), (unsigned long long)__builtin_amdgcn_s_memrealtime(), __ATOMIC_RELAXED, __HIP_MEMORY_SCOPE_AGENT); } while (0)
#else
#define STAMP(id)
#endif

DI unsigned xb_ld(unsigned* p)              { return __hip_atomic_load(p, __ATOMIC_RELAXED, __HIP_MEMORY_SCOPE_AGENT); }
DI unsigned xb_add(unsigned* p, unsigned v) { return __hip_atomic_fetch_add(p, v, __ATOMIC_RELAXED, __HIP_MEMORY_SCOPE_AGENT); }
DI unsigned xb_xcc_id() { return (unsigned)__builtin_amdgcn_s_getreg((3 << 11) | 20) & 0xFu; }
#define XB_SPIN(cond, bar) do { unsigned _sp = 0; while (cond) { __builtin_amdgcn_s_sleep(1); \
    if ((++_sp & 255u) == 0u) { if (xb_ld(&(bar)[XB_TMO])) break; if (_sp > XB_SPIN_CAP) { atomicAdd(&(bar)[XB_TMO], 1u); break; } } } } while (0)

struct XcdBarrier { unsigned* bar; unsigned x; volatile LAS unsigned* st; };

DI XcdBarrier xcd_barrier_post(unsigned* bar, volatile LAS unsigned* st) {
    XcdBarrier b; b.bar = bar; b.x = xb_xcc_id(); b.st = st;
    if (threadIdx.x == 0) (void)xb_add(&bar[XB_XCNT(b.x)], 1u);
    return b;
}
DI void xcd_barrier_complete(unsigned* bar, unsigned x, unsigned& nloc, unsigned& nx) {
    const unsigned G = gridDim.x * gridDim.y * gridDim.z;
    unsigned sum, cnt, mine, sp = 0u;
    for (;;) {
        sum = 0u; cnt = 0u; mine = 0u;
#pragma unroll
        for (unsigned j = 0; j < 16; ++j) { const unsigned c = xb_ld(&bar[XB_XCNT(j)]); sum += c; cnt += (c > 0u) ? 1u : 0u; mine = (j == x) ? c : mine; }
        if (sum == G) break;
        __builtin_amdgcn_s_sleep(1);
        if ((++sp & 255u) == 0u) { if (xb_ld(&bar[XB_TMO])) break; if (sp > XB_SPIN_CAP) { atomicAdd(&bar[XB_TMO], 1u); break; } }
    }
    nloc = mine > 0u ? mine : 1u; nx = cnt > 0u ? cnt : 1u;
}
DI void xcd_barrier(const XcdBarrier& b) {
    asm volatile("s_waitcnt vmcnt(0)" ::: "memory");
    __syncthreads();
    if (threadIdx.x == 0) {
        unsigned* bar = b.bar;
        __builtin_amdgcn_s_waitcnt(0);
        unsigned nloc = b.st[0], nx = b.st[1];
        if (nloc == 0u) { xcd_barrier_complete(bar, b.x, nloc, nx); b.st[0] = nloc; b.st[1] = nx; }
        const unsigned old = xb_add(&bar[XB_XSUB(b.x)], 1u);
        const unsigned gen = old / nloc;
        if (old + 1u == (gen + 1u) * nloc) {
            __builtin_amdgcn_fence(__ATOMIC_RELEASE, "agent");
            asm volatile("s_waitcnt vmcnt(0)" ::: "memory");
            const unsigned og = xb_add(&bar[XB_TOP], 1u);
            const unsigned tg = og / nx;
            if (og + 1u == (tg + 1u) * nx) xb_add(&bar[XB_TOPGEN], 1u);
            else XB_SPIN(xb_ld(&bar[XB_TOPGEN]) == tg, bar);
            __builtin_amdgcn_fence(__ATOMIC_ACQUIRE, "agent");
            xb_add(&bar[XB_XGEN(b.x)], 1u);
            asm volatile("s_waitcnt vmcnt(0)" ::: "memory");
        } else {
            XB_SPIN(xb_ld(&bar[XB_XGEN(b.x)]) == gen, bar);
            __builtin_amdgcn_fence(__ATOMIC_ACQUIRE, "agent");
            asm volatile("s_waitcnt vmcnt(0)" ::: "memory");
        }
    }
    __syncthreads();
}

struct Params {
    const float* x; const float* c; const int* positions; const float* ada_w; const float* ada_b; const float* norm_mix; const float* w_in;
    const float* rwkv_mu; const float* decay_w0; const float* decay_up; const float* iclr_a0; const float* iclr_up; const float* gate_up;
    const float* k_k; const float* k_a; const float* r_k; const float* ln_w; const float* ln_b;
    const float* q_a_norm; const float* w_q_b; const float* kv_a_norm; const float* w_kv_b; const float* q_norm; const float* k_norm;
    const float* w_out; const float* norm_ffn; const float* w_router; const float* router_bias;
    const float* w_e_gu; const float* w_e_d; const float* w_sh_gu; const float* w_sh_d;
    float* out;
    unsigned* ctrl; float* mod; float* rope;
    bf16_t* win_t; bf16_t* wq_t; bf16_t* wkv_t; bf16_t* wdec_t; bf16_t* wiclr_t; bf16_t* wgate_t; bf16_t* wout_t; bf16_t* wr_t; bf16_t* wsgu_t; bf16_t* wsd_t;
    bf16_t* wegu_t; bf16_t* wed_t;
    bf16_t* H; int* topk_idx; float* topk_w; int* elist; unsigned char* bscr;
    bf16_t* U; bf16_t* Q; bf16_t* Kb; bf16_t* Vt; bf16_t* SC; bf16_t* Gg; float* yraw; bf16_t* Y; bf16_t* slot;
};
constexpr size_t BSCR_PER_BLOCK = 196608;

DI float bf2f(bf16_t v) { return __uint_as_float(((unsigned)v) << 16); }
DI unsigned pk2(float a, float b) { f32x2_t f = {a, b}; bf16x2_t r = __builtin_convertvector(f, bf16x2_t); return __builtin_bit_cast(unsigned, r); }
DI bf16_t f2bf(float a) { return (bf16_t)(pk2(a, 0.f) & 0xffffu); }
DI float lo2f(unsigned w) { return __uint_as_float(w << 16); }
DI float hi2f(unsigned w) { return __uint_as_float(w & 0xffff0000u); }
DI float sigmoidf_(float x) { return 1.0f / (1.0f + __expf(-x)); }
DI float wave_sum(float v) {
#pragma unroll
    for (int o = 32; o > 0; o >>= 1) v += __shfl_xor(v, o);
    return v;
}
DI float dpp_sum8(float s) {
    s += __builtin_bit_cast(float, __builtin_amdgcn_update_dpp(0, __builtin_bit_cast(int, s), 0xB1, 0xf, 0xf, true));
    s += __builtin_bit_cast(float, __builtin_amdgcn_update_dpp(0, __builtin_bit_cast(int, s), 0x4E, 0xf, 0xf, true));
    s += __builtin_bit_cast(float, __builtin_amdgcn_update_dpp(0, __builtin_bit_cast(int, s), 0x141, 0xf, 0xf, true));
    return s;
}

struct APlain { const bf16_t* base; int ld; DI const bf16_t* row(int r) const { return base + (size_t)r * ld; } };
struct AGather { const bf16_t* base; const int* idx; DI const bf16_t* row(int r) const { return base + (size_t)idx[r] * DM; } };

template <int MT, int NT, int WR, int BK, int NSWAP, class AP>
DI void gemm_tile(const AP ap, const bf16_t* __restrict__ Bt, const int ldb, const int K, f32x4 (&acc)[MT][NT], unsigned char* lds) {
    constexpr int WC = 4 / WR, CPR = BK / 8, RB = BK * 2, R256 = 256 / RB, BN = WC * NT * 16;
    static_assert(WR * MT * 16 == 128, "tile is 128 rows");
    constexpr int A_BYTES = 128 * RB, B_BYTES = BN * RB;
    constexpr int A_CH = (128 * CPR) / 256, B_TOT = BN * CPR, B_CH = (B_TOT + 255) / 256, RSTEP = 256 / CPR;
    int t = threadIdx.x; LAUNDER(t);
    const int lane = t & 63, wid = t >> 6, wr = wid / WC, wc = wid % WC;
    const int ch = t % CPR, r0 = t / CPR;
    const bf16_t* pa[A_CH]; const bf16_t* pb[B_CH]; int offa[A_CH], offb[B_CH]; bool vb[B_CH];
#pragma unroll
    for (int i = 0; i < A_CH; ++i) { const int row = r0 + i * RSTEP; pa[i] = ap.row(row) + ch * 8; offa[i] = row * RB + ((ch ^ ((row / R256) & (CPR - 1))) << 4); }
#pragma unroll
    for (int i = 0; i < B_CH; ++i) { const int row = r0 + i * RSTEP; vb[i] = row < BN; const int rr = vb[i] ? row : 0; pb[i] = Bt + (size_t)rr * ldb + ch * 8; offb[i] = 2 * A_BYTES + rr * RB + ((ch ^ ((rr / R256) & (CPR - 1))) << 4); }
#pragma unroll
    for (int i = 0; i < MT; ++i)
#pragma unroll
        for (int j = 0; j < NT; ++j) acc[i][j] = (f32x4){0.f, 0.f, 0.f, 0.f};
    const int KT = K / BK;
    u32x4 ra0[A_CH], rb0[B_CH], ra1[A_CH], rb1[B_CH];
#define G_LOAD(RA, RB, KTI) { _Pragma("unroll") for (int i = 0; i < A_CH; ++i) RA[i] = *(const u32x4*)(pa[i] + (KTI) * BK); \
                              _Pragma("unroll") for (int i = 0; i < B_CH; ++i) RB[i] = *(const u32x4*)(pb[i] + (KTI) * BK); }
#define G_WRITE(RA, RB, BUF) { _Pragma("unroll") for (int i = 0; i < A_CH; ++i) *(u32x4*)(lds + (BUF) * A_BYTES + offa[i]) = RA[i]; \
                               _Pragma("unroll") for (int i = 0; i < B_CH; ++i) if (vb[i]) *(u32x4*)(lds + (BUF) * B_BYTES + offb[i]) = RB[i]; }
#define G_COMPUTE(BUF) { const unsigned char* Ab = lds + (BUF) * A_BYTES + arow; const unsigned char* Bb = lds + 2 * A_BYTES + (BUF) * B_BYTES + brow; \
        _Pragma("unroll") for (int ks = 0; ks < BK / 32; ++ks) { const int co = ((ks * 4 + (lane >> 4)) ^ sw) << 4; bf16x8 af[MT], bfr[NT]; \
            _Pragma("unroll") for (int i = 0; i < MT; ++i) af[i] = *(const bf16x8*)(Ab + i * 16 * RB + co); \
            _Pragma("unroll") for (int j = 0; j < NT; ++j) bfr[j] = *(const bf16x8*)(Bb + j * 16 * RB + co); \
            _Pragma("unroll") for (int i = 0; i < MT; ++i) _Pragma("unroll") for (int j = 0; j < NT; ++j) \
                acc[i][j] = (j < NSWAP) ? __builtin_amdgcn_mfma_f32_16x16x32_bf16(bfr[j], af[i], acc[i][j], 0, 0, 0) \
                                        : __builtin_amdgcn_mfma_f32_16x16x32_bf16(af[i], bfr[j], acc[i][j], 0, 0, 0); } }
    const int sw = ((lane & 15) / R256) & (CPR - 1);
    const int arow = (wr * MT * 16 + (lane & 15)) * RB, brow = (wc * NT * 16 + (lane & 15)) * RB;
    G_LOAD(ra0, rb0, 0)
    if (KT > 1) G_LOAD(ra1, rb1, 1)
    __syncthreads();
    G_WRITE(ra0, rb0, 0)
    if (KT > 2) G_LOAD(ra0, rb0, 2)
    __syncthreads();
    for (int kt = 0; kt < KT; kt += 2) {
        G_COMPUTE(0)
        if (kt + 1 < KT) { G_WRITE(ra1, rb1, 1) if (kt + 3 < KT) G_LOAD(ra1, rb1, kt + 3) }
        __syncthreads();
        if (kt + 1 >= KT) break;
        G_COMPUTE(1)
        if (kt + 2 < KT) { G_WRITE(ra0, rb0, 0) if (kt + 4 < KT) G_LOAD(ra0, rb0, kt + 4) }
        __syncthreads();
    }
#undef G_LOAD
#undef G_WRITE
#undef G_COMPUTE
}
template <int MT, int NT, int WR, int BK, int NSWAP, class AP, class UF, class EPI>
DI void gemm_stream(const AP ap, const bf16_t* __restrict__ Bt, const int ldb, const int K, const int nunits, const UF uoff, const EPI epi, unsigned char* lds) {
    constexpr int WC = 4 / WR, CPR = BK / 8, RB = BK * 2, R256 = 256 / RB, BN = WC * NT * 16;
    static_assert(WR * MT * 16 == 128, "tile is 128 rows");
    constexpr int A_BYTES = 128 * RB, B_BYTES = BN * RB;
    constexpr int A_CH = (128 * CPR) / 256, B_TOT = BN * CPR, B_CH = (B_TOT + 255) / 256, RSTEP = 256 / CPR;
    int t = threadIdx.x; LAUNDER(t);
    const int lane = t & 63, wid = t >> 6, wr = wid / WC, wc = wid % WC;
    const int ch = t % CPR, r0 = t / CPR;
    const bf16_t* pa[A_CH]; const bf16_t* pb[B_CH]; int offa[A_CH], offb[B_CH]; bool vb[B_CH];
#pragma unroll
    for (int i = 0; i < A_CH; ++i) { const int row = r0 + i * RSTEP; pa[i] = ap.row(row) + ch * 8; offa[i] = row * RB + ((ch ^ ((row / R256) & (CPR - 1))) << 4); }
#pragma unroll
    for (int i = 0; i < B_CH; ++i) { const int row = r0 + i * RSTEP; vb[i] = row < BN; const int rr = vb[i] ? row : 0; pb[i] = Bt + (size_t)rr * ldb + ch * 8; offb[i] = 2 * A_BYTES + rr * RB + ((ch ^ ((rr / R256) & (CPR - 1))) << 4); }
    f32x4 acc[MT][NT];
#pragma unroll
    for (int i = 0; i < MT; ++i)
#pragma unroll
        for (int j = 0; j < NT; ++j) acc[i][j] = (f32x4){0.f, 0.f, 0.f, 0.f};
    const int KT = K / BK, NG = nunits * KT;
    int lu = 0, lkt = 0, cu = 0, ckt = 0;
    u32x4 ra0[A_CH], rb0[B_CH], ra1[A_CH], rb1[B_CH];
#define S_LOAD(RA, RB) { int ao, bo; uoff(lu, ao, bo); ao += lkt * BK; bo += lkt * BK; \
                         _Pragma("unroll") for (int i = 0; i < A_CH; ++i) RA[i] = *(const u32x4*)(pa[i] + ao); \
                         _Pragma("unroll") for (int i = 0; i < B_CH; ++i) RB[i] = *(const u32x4*)(pb[i] + bo); \
                         if (++lkt == KT) { lkt = 0; ++lu; } }
#define S_WRITE(RA, RB, BUF) { _Pragma("unroll") for (int i = 0; i < A_CH; ++i) *(u32x4*)(lds + (BUF) * A_BYTES + offa[i]) = RA[i]; \
                               _Pragma("unroll") for (int i = 0; i < B_CH; ++i) if (vb[i]) *(u32x4*)(lds + (BUF) * B_BYTES + offb[i]) = RB[i]; }
#define S_COMPUTE(BUF) { const unsigned char* Ab = lds + (BUF) * A_BYTES + arow; const unsigned char* Bb = lds + 2 * A_BYTES + (BUF) * B_BYTES + brow; \
        _Pragma("unroll") for (int ks = 0; ks < BK / 32; ++ks) { const int co = ((ks * 4 + (lane >> 4)) ^ sw) << 4; bf16x8 af[MT], bfr[NT]; \
            _Pragma("unroll") for (int i = 0; i < MT; ++i) af[i] = *(const bf16x8*)(Ab + i * 16 * RB + co); \
            _Pragma("unroll") for (int j = 0; j < NT; ++j) bfr[j] = *(const bf16x8*)(Bb + j * 16 * RB + co); \
            _Pragma("unroll") for (int i = 0; i < MT; ++i) _Pragma("unroll") for (int j = 0; j < NT; ++j) \
                acc[i][j] = (j < NSWAP) ? __builtin_amdgcn_mfma_f32_16x16x32_bf16(bfr[j], af[i], acc[i][j], 0, 0, 0) \
                                        : __builtin_amdgcn_mfma_f32_16x16x32_bf16(af[i], bfr[j], acc[i][j], 0, 0, 0); } }
#define S_EPI { if (++ckt == KT) { epi(cu, acc); ckt = 0; ++cu; \
                _Pragma("unroll") for (int i = 0; i < MT; ++i) _Pragma("unroll") for (int j = 0; j < NT; ++j) acc[i][j] = (f32x4){0.f, 0.f, 0.f, 0.f}; } }
    const int sw = ((lane & 15) / R256) & (CPR - 1);
    const int arow = (wr * MT * 16 + (lane & 15)) * RB, brow = (wc * NT * 16 + (lane & 15)) * RB;
    S_LOAD(ra0, rb0)
    if (NG > 1) S_LOAD(ra1, rb1)
    __syncthreads();
    S_WRITE(ra0, rb0, 0)
    if (NG > 2) S_LOAD(ra0, rb0)
    __syncthreads();
#pragma unroll 1
    for (int g = 0; g < NG; g += 2) {
        S_COMPUTE(0)
        if (g + 1 < NG) { S_WRITE(ra1, rb1, 1) if (g + 3 < NG) S_LOAD(ra1, rb1) }
        S_EPI
        __syncthreads();
        if (g + 1 >= NG) break;
        S_COMPUTE(1)
        if (g + 2 < NG) { S_WRITE(ra0, rb0, 0) if (g + 4 < NG) S_LOAD(ra0, rb0) }
        S_EPI
        __syncthreads();
    }
#undef S_LOAD
#undef S_WRITE
#undef S_COMPUTE
#undef S_EPI
}

template <int NT, int BK, class AP>
DI void gemm_core(const AP ap, const bf16_t* __restrict__ Bt, const int ldb, const int K, f32x4 (&acc)[4][NT], unsigned char* lds) {
    gemm_tile<4, NT, 2, BK, NT>(ap, Bt, ldb, K, acc, lds);
}

template <int NT> DI void acc_to_lds(const f32x4 (&acc)[4][NT], float* tile, const int ld) {
    int t = threadIdx.x; LAUNDER(t);
    const int lane = t & 63, wid = t >> 6, wr = wid >> 1, wc = wid & 1;
#pragma unroll
    for (int i = 0; i < 4; ++i)
#pragma unroll
        for (int j = 0; j < NT; ++j) {
            const int row = wr * 64 + i * 16 + (lane & 15), col = wc * NT * 16 + j * 16 + (lane >> 4) * 4;
            *(f32x4*)(tile + row * ld + col) = acc[i][j];
        }
}

DI int map_win(int n) { return n < 384 ? n + 1696 : (n < 2080 ? n - 384 : (n < 2112 ? n : -1)); }
DI int map_gu(int n) { const int tile = n >> 7, w = n & 127, wc = w >> 6, j = (w >> 4) & 3, r = w & 15; const int a = tile * 64 + wc * 32 + (j >> 1) * 16 + r; return (j & 1) ? 256 + a : a; }

template <int MAP> DI void tconv_simple(const float* __restrict__ src, bf16_t* __restrict__ dst, int K, int Ns, int Nd, const float* __restrict__ scale, int gtid, int gthreads) {
    const int total = Nd * K;
    for (int idx = gtid; idx < total; idx += gthreads) {
        const int n = idx / K, k = idx - n * K;
        const int m = (MAP == 1) ? map_win(n) : (MAP == 2 ? map_gu(n) : n);
        float v = 0.f;
        if (m >= 0) { v = src[(size_t)k * Ns + m]; if (scale) v *= scale[k]; }
        dst[idx] = f2bf(v);
    }
}
template <int MAP> DI void tconv_tiled(const float* __restrict__ src, bf16_t* __restrict__ dst, int E, int K, int N, float* ldsf, int bid, int G) {
    const int tk = K / 64, tn = N / 64, per = tk * tn, total = E * per;
    const int t = threadIdx.x;
    for (int tile = bid; tile < total; tile += G) {
        const int e = tile / per, r = tile - e * per, kt = r / tn, nt = r - kt * tn;
        const float* s = src + (size_t)e * K * N + (size_t)(kt * 64) * N;
        __syncthreads();
        {
            const int nl = t & 63, n = nt * 64 + nl;
            const int m = (MAP == 2) ? map_gu(n) : n;
#pragma unroll
            for (int i = 0; i < 16; ++i) { const int kl = (t >> 6) + 4 * i; ldsf[kl * 65 + nl] = s[(size_t)kl * N + m]; }
        }
        __syncthreads();
        {
            const int nl = t >> 2, kc = (t & 3) * 16;
            unsigned w[8];
#pragma unroll
            for (int i = 0; i < 8; ++i) w[i] = pk2(ldsf[(kc + 2 * i) * 65 + nl], ldsf[(kc + 2 * i + 1) * 65 + nl]);
            bf16_t* d = dst + (size_t)e * K * N + (size_t)(nt * 64 + nl) * K + kt * 64 + kc;
            *(u32x4*)(d) = mk4(w[0], w[1], w[2], w[3]);
            *(u32x4*)(d + 8) = mk4(w[4], w[5], w[6], w[7]);
        }
    }
}

DI void phase0(const Params& p, unsigned char* lds, int bid, int G) {
    const int t = threadIdx.x;
    float* ldsf = (float*)lds;
    for (int item = bid; item < 192; item += G) {
        __syncthreads();
        for (int i = t; i < NB * DM; i += 256) { const float v = p.c[i]; ldsf[i] = v * sigmoidf_(v); }
        __syncthreads();
        const int col = item * 32 + (t & 31), kp = t >> 5;
        float a[NB];
#pragma unroll
        for (int b = 0; b < NB; ++b) a[b] = 0.f;
        for (int k = kp * 128; k < kp * 128 + 128; ++k) {
            const float w = p.ada_w[(size_t)k * 6144 + col];
#pragma unroll
            for (int b = 0; b < NB; ++b) a[b] += ldsf[b * DM + k] * w;
        }
        __syncthreads();
#pragma unroll
        for (int b = 0; b < NB; ++b) ldsf[(kp * NB + b) * 32 + (t & 31)] = a[b];
        __syncthreads();
        for (int o = t; o < NB * 32; o += 256) {
            const int b = o >> 5, cl = o & 31; float s = 0.f;
#pragma unroll
            for (int q = 0; q < 8; ++q) s += ldsf[(q * NB + b) * 32 + cl];
            p.mod[b * 6144 + item * 32 + cl] = s + p.ada_b[item * 32 + cl];
        }
    }
    __syncthreads();
    const int gtid = bid * 256 + t, gth = G * 256;
    tconv_simple<1>(p.w_in, p.win_t, 1024, 2112, LDU, nullptr, gtid, gth);
    tconv_simple<0>(p.w_q_b, p.wq_t, 256, 768, 768, p.q_a_norm, gtid, gth);
    tconv_simple<0>(p.w_kv_b, p.wkv_t, 128, 1024, 1024, p.kv_a_norm, gtid, gth);
    tconv_simple<0>(p.decay_up, p.wdec_t, 32, 512, 512, nullptr, gtid, gth);
    tconv_simple<0>(p.iclr_up, p.wiclr_t, 32, 512, 512, nullptr, gtid, gth);
    tconv_simple<0>(p.gate_up, p.wgate_t, 96, 512, 512, nullptr, gtid, gth);
    tconv_simple<0>(p.w_out, p.wout_t, 1024, 1024, 1024, nullptr, gtid, gth);
    tconv_simple<0>(p.w_router, p.wr_t, 1024, 256, 256, nullptr, gtid, gth);
    tconv_simple<2>(p.w_sh_gu, p.wsgu_t, 1024, 512, 512, nullptr, gtid, gth);
    tconv_simple<0>(p.w_sh_d, p.wsd_t, 256, 1024, 1024, nullptr, gtid, gth);
    tconv_tiled<2>(p.w_e_gu, p.wegu_t, NEXP, 1024, 512, ldsf, bid, G);
    tconv_tiled<0>(p.w_e_d, p.wed_t, NEXP, 256, 1024, ldsf, bid, G);
}

DI void phase1(const Params& p, int bid, int G) {
    const int lane = threadIdx.x & 63, gw = bid * 4 + (threadIdx.x >> 6), nw = G * 4;
    for (int row = gw; row < NTOK; row += nw) {
        const int b = row >> 12;
        const float* xr = p.x + (size_t)row * DM;
        f32x4 v[4]; float ss = 0.f;
#pragma unroll
        for (int i = 0; i < 4; ++i) { v[i] = *(const f32x4*)(xr + lane * 4 + 256 * i); ss += v[i][0] * v[i][0] + v[i][1] * v[i][1] + v[i][2] * v[i][2] + v[i][3] * v[i][3]; }
        ss = wave_sum(ss);
        const float rs = rsqrtf(ss * (1.0f / DM) + 1e-6f);
        const float* mod = p.mod + b * 6144;
#pragma unroll
        for (int i = 0; i < 4; ++i) {
            const int c = lane * 4 + 256 * i;
            const f32x4 g = *(const f32x4*)(p.norm_mix + c), sh = *(const f32x4*)(mod + c), sc = *(const f32x4*)(mod + 1024 + c);
            float o[4];
#pragma unroll
            for (int e = 0; e < 4; ++e) o[e] = v[i][e] * rs * g[e] * (1.0f + sc[e]) + sh[e];
            *(u32x2*)(p.H + (size_t)row * DM + c) = mk2(pk2(o[0], o[1]), pk2(o[2], o[3]));
        }
        if (lane < 16) {
            const double inv = exp(-(double)lane * (9.210340371976184 / 16.0));
            const double ang = (double)p.positions[row] * inv;
            p.rope[(size_t)row * 32 + lane] = (float)cos(ang);
            p.rope[(size_t)row * 32 + 16 + lane] = (float)sin(ang);
        }
    }
}

DI void phase2(const Params& p, unsigned char* lds, int bid, int G) {
    constexpr int NCT = LDU / 128;
    const int t = threadIdx.x, lane = t & 63, wid = t >> 6, wr = wid >> 1, wc = wid & 1;
    const int total = (NTOK / 128) * NCT;
    for (int L = bid; L < total; L += G) {
        const int xcd = L & 7, j = L >> 3, rt = 8 * (j / NCT) + xcd, ct = j % NCT;
        f32x4 acc[4][4];
        APlain ap{p.H + (size_t)rt * 128 * DM, DM};
        gemm_core<4, 64>(ap, p.win_t + (size_t)ct * 128 * DM, DM, DM, acc, lds);
        bf16_t* tile = (bf16_t*)lds;
#pragma unroll
        for (int i = 0; i < 4; ++i)
#pragma unroll
            for (int jj = 0; jj < 4; ++jj) {
                const int row = wr * 64 + i * 16 + (lane & 15), col = wc * 64 + jj * 16 + (lane >> 4) * 4;
                *(u32x2*)(tile + row * 136 + col) = mk2(pk2(acc[i][jj][0], acc[i][jj][1]), pk2(acc[i][jj][2], acc[i][jj][3]));
            }
        __syncthreads();
#pragma unroll
        for (int i = 0; i < 8; ++i) {
            const int c = t + 256 * i, row = c >> 4, chn = c & 15;
            *(u32x4*)(p.U + (size_t)(rt * 128 + row) * LDU + ct * 128 + chn * 8) = *(const u32x4*)(tile + row * 136 + chn * 8);
        }
    }
}

DI void unpack8(const u32x4 w, float (&f)[8]) { f[0] = lo2f(w.x); f[1] = hi2f(w.x); f[2] = lo2f(w.y); f[3] = hi2f(w.y); f[4] = lo2f(w.z); f[5] = hi2f(w.z); f[6] = lo2f(w.w); f[7] = hi2f(w.w); }
DI f32x4 unpack4(const u32x2 w) { return (f32x4){lo2f(w.x), hi2f(w.x), lo2f(w.y), hi2f(w.y)}; }
DI u32x2 pack4(const f32x4 v) { return mk2(pk2(v[0], v[1]), pk2(v[2], v[3])); }
DI f32x4 shifted4(const bf16_t* __restrict__ up, const bool has_prev, const f32x4 mu) {
    const f32x4 cur = unpack4(*(const u32x2*)up);
    f32x4 prev = (f32x4){0.f, 0.f, 0.f, 0.f};
    if (has_prev) prev = unpack4(*(const u32x2*)(up - LDU));
    return cur + (prev - cur) * mu;
}
DI void head96_finish(f32x4 (&v)[6], const int q, const float* __restrict__ gain, const float* __restrict__ ropeRow, const float scale, bf16_t* __restrict__ dstRow) {
    float ss = 0.f;
#pragma unroll
    for (int j = 0; j < 6; ++j) ss += v[j][0] * v[j][0] + v[j][1] * v[j][1] + v[j][2] * v[j][2] + v[j][3] * v[j][3];
    ss += __shfl_xor(ss, 16); ss += __shfl_xor(ss, 32);
    const float rs = rsqrtf(ss * (1.0f / 96.0f) + 1e-6f);
#pragma unroll
    for (int j = 0; j < 6; ++j) v[j] = v[j] * rs * *(const f32x4*)(gain + j * 16 + q * 4);
    const f32x4 cs = *(const f32x4*)(ropeRow + q * 4), sn = *(const f32x4*)(ropeRow + 16 + q * 4);
    const f32x4 x1 = v[4], x2 = v[5];
    v[4] = x1 * cs - x2 * sn; v[5] = x2 * cs + x1 * sn;
#pragma unroll
    for (int j = 0; j < 6; ++j) *(u32x2*)(dstRow + j * 16 + q * 4) = pack4(v[j] * scale);
}

DI void phase3(const Params& p, unsigned char* lds, int bid, int G) {
    const int t = threadIdx.x;
    float* rstd_q = (float*)(lds + 69632);
    float* rstd_kv = rstd_q + 128;
    bf16_t* lora = (bf16_t*)(p.bscr + (size_t)bid * BSCR_PER_BLOCK + 131072);
    for (int rt = bid; rt < NTOK / 128; rt += G) {
        __syncthreads();
        {
            int tl = t; LAUNDER(tl);
            const int row = tl >> 1, half = tl & 1, grow = rt * 128 + row;
            const bf16_t* urow = p.U + (size_t)grow * LDU;
            float s = 0.f;
#pragma unroll
            for (int c = 0; c < 16; ++c) { float f[8]; unpack8(*(const u32x4*)(urow + UQ + half * 128 + c * 8), f);
#pragma unroll
                for (int e = 0; e < 8; ++e) s += f[e] * f[e]; }
            s += __shfl_xor(s, 1);
            float s2 = 0.f;
#pragma unroll
            for (int c = 0; c < 8; ++c) { float f[8]; unpack8(*(const u32x4*)(urow + UKV + half * 64 + c * 8), f);
#pragma unroll
                for (int e = 0; e < 8; ++e) s2 += f[e] * f[e]; }
            s2 += __shfl_xor(s2, 1);
            if (half == 0) { rstd_q[row] = rsqrtf(s * (1.0f / 256.0f) + 1e-6f); rstd_kv[row] = rsqrtf(s2 * (1.0f / 128.0f) + 1e-6f); }
        }
#pragma unroll 1
        for (int i = 0; i < 10; ++i) {
            int tl = t; LAUNDER(tl);
            const int c = tl + 256 * i, row = c / 20, chn = c - row * 20, grow = rt * 128 + row;
            const bf16_t* up = p.U + (size_t)grow * LDU + UXW + chn * 8;
            float cur[8], prv[8];
            unpack8(*(const u32x4*)up, cur);
            if ((grow & 4095) > 0) unpack8(*(const u32x4*)(up - LDU), prv);
            else {
#pragma unroll
                for (int e = 0; e < 8; ++e) prv[e] = 0.f; }
            const f32x4 m0 = *(const f32x4*)(p.rwkv_mu + 1536 + chn * 8), m1 = *(const f32x4*)(p.rwkv_mu + 1536 + chn * 8 + 4);
            float o[8];
#pragma unroll
            for (int e = 0; e < 8; ++e) {
                const float x = cur[e] + (prv[e] - cur[e]) * (e < 4 ? m0[e & 3] : m1[e & 3]);
                o[e] = chn < 4 ? tanhf(x) : (chn < 8 ? x : sigmoidf_(x));
            }
            *(u32x4*)(lora + row * 160 + chn * 8) = mk4(pk2(o[0], o[1]), pk2(o[2], o[3]), pk2(o[4], o[5]), pk2(o[6], o[7]));
        }
        asm volatile("s_waitcnt vmcnt(0)" ::: "memory");
        __syncthreads();
        STAMP(17);
        {
            APlain ap{p.U + (size_t)rt * 128 * LDU + UQ, LDU};
            gemm_stream<2, 6, 4, 64, 6>(ap, p.wq_t, 256, 256, 8, [](int u, int& ao, int& bo) { ao = 0; bo = u * 96 * 256; },
                [&](const int h, f32x4 (&acc)[2][6]) {
                    int tl = t; LAUNDER(tl);
                    const int lane = tl & 63, w = tl >> 6, r = lane & 15, q = lane >> 4;
#pragma unroll
                    for (int i = 0; i < 2; ++i) {
                        const int row = 32 * w + 16 * i + r, grow = rt * 128 + row, b = grow >> 12, tt = grow & 4095;
                        const float rq = rstd_q[row];
                        f32x4 v[6];
#pragma unroll
                        for (int j = 0; j < 6; ++j) v[j] = acc[i][j] * rq;
                        head96_finish(v, q, p.q_norm, p.rope + (size_t)grow * 32, QSCALE, p.Q + ((size_t)(b * 8 + h) * NT_ + tt) * 96);
                    }
                }, lds);
        }
        STAMP(18);
        {
            APlain ap{p.U + (size_t)rt * 128 * LDU + UKV, LDU};
            gemm_stream<2, 8, 4, 64, 4>(ap, p.wkv_t, 128, 128, 8, [](int u, int& ao, int& bo) { ao = 0; bo = u * 128 * 128; },
                [&](const int h, f32x4 (&acc)[2][8]) {
                    int tl = t; LAUNDER(tl);
                    const int lane = tl & 63, w = tl >> 6, r = lane & 15, q = lane >> 4;
#pragma unroll
                    for (int i = 0; i < 2; ++i) {
                        const int row = 32 * w + 16 * i + r, grow = rt * 128 + row, b = grow >> 12, tt = grow & 4095;
                        const float rk = rstd_kv[row];
                        const bf16_t* urow = p.U + (size_t)grow * LDU;
                        f32x4 v[6];
#pragma unroll
                        for (int j = 0; j < 4; ++j) v[j] = acc[i][j] * rk;
                        v[4] = unpack4(*(const u32x2*)(urow + UPE + q * 4));
                        v[5] = unpack4(*(const u32x2*)(urow + UPE + 16 + q * 4));
                        head96_finish(v, q, p.k_norm, p.rope + (size_t)grow * 32, 1.0f, p.Kb + ((size_t)(b * 8 + h) * NT_ + tt) * 96);
                        const int tok0 = 32 * w + 16 * i + 4 * q;
                        const f32x4 rk4 = *(const f32x4*)(rstd_kv + tok0);
                        bf16_t* vd = p.Vt + ((size_t)((rt >> 5) * 8 + h) * 64) * NT_ + (rt & 31) * 128 + tok0;
#pragma unroll
                        for (int j = 4; j < 8; ++j) *(u32x2*)(vd + (size_t)((j - 4) * 16 + r) * NT_) = pack4(acc[i][j] * rk4);
                    }
                }, lds);
        }
        STAMP(19);
        bf16_t* abuf = (bf16_t*)(p.bscr + (size_t)bid * BSCR_PER_BLOCK);
        {
            APlain ap{lora, 160};
            gemm_stream<4, 4, 2, 32, 4>(ap, p.wdec_t, 32, 32, 4, [](int u, int& ao, int& bo) { ao = 0; bo = u * 128 * 32; },
                [&](const int ct, f32x4 (&acc)[4][4]) {
                    int tl = t; LAUNDER(tl);
                    const int lane = tl & 63, wid = tl >> 6, wr = wid >> 1, wc = wid & 1, r = lane & 15, q = lane >> 4, head = ct * 2 + wc;
#pragma unroll
                    for (int i = 0; i < 4; ++i) {
                        const int grow = rt * 128 + wr * 64 + i * 16 + r, b = grow >> 12, tt = grow & 4095;
                        bf16_t* sc = p.SC + ((size_t)(b * 8 + head) * NT_ + tt) * 384 + q * 4;
#pragma unroll
                        for (int j = 0; j < 4; ++j) {
                            const f32x4 w0 = *(const f32x4*)(p.decay_w0 + head * 64 + j * 16 + q * 4);
                            f32x4 o;
#pragma unroll
                            for (int e = 0; e < 4; ++e) o[e] = 1.0f - __expf(-0.6065306597f * sigmoidf_(w0[e] + acc[i][j][e]));
                            *(u32x2*)(sc + j * 16) = pack4(o);
                        }
                    }
                }, lds);
        }
        {
            APlain ap{lora + 32, 160};
            gemm_stream<4, 4, 2, 32, 4>(ap, p.wiclr_t, 32, 32, 4, [](int u, int& ao, int& bo) { ao = 0; bo = u * 128 * 32; },
                [&](const int ct, f32x4 (&acc)[4][4]) {
                    int tl = t; LAUNDER(tl);
                    const int lane = tl & 63, wid = tl >> 6, wr = wid >> 1, wc = wid & 1, r = lane & 15, q = lane >> 4, c0 = ct * 128 + wc * 64 + q * 4;
#pragma unroll
                    for (int i = 0; i < 4; ++i) {
                        bf16_t* ar = abuf + (wr * 64 + i * 16 + r) * 512 + c0;
#pragma unroll
                        for (int j = 0; j < 4; ++j) {
                            const f32x4 a0 = *(const f32x4*)(p.iclr_a0 + c0 + j * 16);
                            f32x4 o;
#pragma unroll
                            for (int e = 0; e < 4; ++e) o[e] = sigmoidf_(a0[e] + acc[i][j][e]);
                            *(u32x2*)(ar + j * 16) = pack4(o);
                        }
                    }
                }, lds);
        }
        {
            APlain ap{lora + 64, 160};
            gemm_stream<4, 4, 2, 32, 4>(ap, p.wgate_t, 96, 96, 4, [](int u, int& ao, int& bo) { ao = 0; bo = u * 128 * 96; },
                [&](const int ct, f32x4 (&acc)[4][4]) {
                    int tl = t; LAUNDER(tl);
                    const int lane = tl & 63, wid = tl >> 6, wr = wid >> 1, wc = wid & 1, r = lane & 15, q = lane >> 4, head = ct * 2 + wc;
#pragma unroll
                    for (int i = 0; i < 4; ++i) {
                        const int grow = rt * 128 + wr * 64 + i * 16 + r;
                        bf16_t* g = p.Gg + (size_t)grow * 512 + head * 64 + q * 4;
#pragma unroll
                        for (int j = 0; j < 4; ++j) *(u32x2*)(g + j * 16) = pack4(acc[i][j]);
                    }
                }, lds);
        }
        asm volatile("s_waitcnt vmcnt(0)" ::: "memory");
        __syncthreads();
#pragma unroll 1
        for (int it = 0; it < 16; ++it) {
            int tl = t; LAUNDER(tl);
            const int lane = tl & 63, w = tl >> 6, c8 = lane * 8;
#pragma unroll
            for (int u = 0; u < 2; ++u) {
                const int row = w + 4 * (it * 2 + u), grow = rt * 128 + row, b = grow >> 12, tt = grow & 4095;
                const bool hp = tt > 0;
                const bf16_t* urow = p.U + (size_t)grow * LDU + c8;
                float kc[8], kp_[8], vc[8], vp[8], rc[8], rp[8], av[8];
                unpack8(*(const u32x4*)(urow + UK), kc); unpack8(*(const u32x4*)(urow + UV), vc); unpack8(*(const u32x4*)(urow + UR), rc);
                unpack8(*(const u32x4*)(abuf + row * 512 + c8), av);
                if (hp) { unpack8(*(const u32x4*)(urow + UK - LDU), kp_); unpack8(*(const u32x4*)(urow + UV - LDU), vp); unpack8(*(const u32x4*)(urow + UR - LDU), rp); }
                else {
#pragma unroll
                    for (int e = 0; e < 8; ++e) { kp_[e] = 0.f; vp[e] = 0.f; rp[e] = 0.f; } }
                float mk[8], mv[8], mr[8], kkw[8], kaw[8];
                *(f32x4*)(mk) = *(const f32x4*)(p.rwkv_mu + 512 + c8); *(f32x4*)(mk + 4) = *(const f32x4*)(p.rwkv_mu + 512 + c8 + 4);
                *(f32x4*)(mv) = *(const f32x4*)(p.rwkv_mu + 1024 + c8); *(f32x4*)(mv + 4) = *(const f32x4*)(p.rwkv_mu + 1024 + c8 + 4);
                *(f32x4*)(mr) = *(const f32x4*)(p.rwkv_mu + c8); *(f32x4*)(mr + 4) = *(const f32x4*)(p.rwkv_mu + c8 + 4);
                *(f32x4*)(kkw) = *(const f32x4*)(p.k_k + c8); *(f32x4*)(kkw + 4) = *(const f32x4*)(p.k_k + c8 + 4);
                *(f32x4*)(kaw) = *(const f32x4*)(p.k_a + c8); *(f32x4*)(kaw + 4) = *(const f32x4*)(p.k_a + c8 + 4);
                float ks[8], kq[8], ssq = 0.f;
#pragma unroll
                for (int e = 0; e < 8; ++e) { ks[e] = kc[e] + (kp_[e] - kc[e]) * mk[e]; kq[e] = ks[e] * kkw[e]; ssq += kq[e] * kq[e]; }
                ssq = dpp_sum8(ssq);
                const float rn = rsqrtf(fmaxf(ssq, 1e-24f));
                float okk[8], obb[8], okp[8], ov[8], orr[8];
#pragma unroll
                for (int e = 0; e < 8; ++e) {
                    okk[e] = kq[e] * rn; obb[e] = av[e] * okk[e]; okp[e] = ks[e] * (1.0f + (av[e] - 1.0f) * kaw[e]);
                    ov[e] = vc[e] + (vp[e] - vc[e]) * mv[e]; orr[e] = rc[e] + (rp[e] - rc[e]) * mr[e];
                }
                bf16_t* sc = p.SC + ((size_t)(b * 8 + (lane >> 3)) * NT_ + tt) * 384 + (lane & 7) * 8;
                *(u32x4*)(sc + 64) = mk4(pk2(okk[0], okk[1]), pk2(okk[2], okk[3]), pk2(okk[4], okk[5]), pk2(okk[6], okk[7]));
                *(u32x4*)(sc + 128) = mk4(pk2(obb[0], obb[1]), pk2(obb[2], obb[3]), pk2(obb[4], obb[5]), pk2(obb[6], obb[7]));
                *(u32x4*)(sc + 192) = mk4(pk2(okp[0], okp[1]), pk2(okp[2], okp[3]), pk2(okp[4], okp[5]), pk2(okp[6], okp[7]));
                *(u32x4*)(sc + 256) = mk4(pk2(ov[0], ov[1]), pk2(ov[2], ov[3]), pk2(ov[4], ov[5]), pk2(ov[6], ov[7]));
                *(u32x4*)(sc + 320) = mk4(pk2(orr[0], orr[1]), pk2(orr[2], orr[3]), pk2(orr[4], orr[5]), pk2(orr[6], orr[7]));
            }
        }
    }
}

struct ScanOps { f32x2_t d[4], k[4], b[4], p[4], r[4]; float v; };
DI void scan_load(ScanOps& o, const float* __restrict__ q, const float* __restrict__ vp) {
    const f32x4 d0 = *(const f32x4*)(q), d1 = *(const f32x4*)(q + 4), k0 = *(const f32x4*)(q + 64), k1 = *(const f32x4*)(q + 68);
    const f32x4 b0 = *(const f32x4*)(q + 128), b1 = *(const f32x4*)(q + 132), p0 = *(const f32x4*)(q + 192), p1 = *(const f32x4*)(q + 196);
    const f32x4 r0 = *(const f32x4*)(q + 320), r1 = *(const f32x4*)(q + 324);
    o.d[0] = (f32x2_t){d0[0], d0[1]}; o.d[1] = (f32x2_t){d0[2], d0[3]}; o.d[2] = (f32x2_t){d1[0], d1[1]}; o.d[3] = (f32x2_t){d1[2], d1[3]};
    o.k[0] = (f32x2_t){k0[0], k0[1]}; o.k[1] = (f32x2_t){k0[2], k0[3]}; o.k[2] = (f32x2_t){k1[0], k1[1]}; o.k[3] = (f32x2_t){k1[2], k1[3]};
    o.b[0] = (f32x2_t){b0[0], b0[1]}; o.b[1] = (f32x2_t){b0[2], b0[3]}; o.b[2] = (f32x2_t){b1[0], b1[1]}; o.b[3] = (f32x2_t){b1[2], b1[3]};
    o.p[0] = (f32x2_t){p0[0], p0[1]}; o.p[1] = (f32x2_t){p0[2], p0[3]}; o.p[2] = (f32x2_t){p1[0], p1[1]}; o.p[3] = (f32x2_t){p1[2], p1[3]};
    o.r[0] = (f32x2_t){r0[0], r0[1]}; o.r[1] = (f32x2_t){r0[2], r0[3]}; o.r[2] = (f32x2_t){r1[0], r1[1]}; o.r[3] = (f32x2_t){r1[2], r1[3]};
    o.v = *vp;
}
DI void scan_task(const Params& p, unsigned char* lds, const int task) {
    constexpr int CS = 16;
    const int t = threadIdx.x, lane = t & 63, w = t >> 6;
    const int bh = task >> 1, hf = task & 1, b = bh >> 3, head = bh & 7;
    const int rloc = w * 8 + (lane >> 3), kseg = lane & 7;
    const int vrow = hf * 32 + rloc;
    float* stage = (float*)lds;
    float* ybuf = (float*)(lds + 49152);
    const bf16_t* src = p.SC + (size_t)bh * NT_ * 384;
    f32x2_t s2[4];
#pragma unroll
    for (int j = 0; j < 4; ++j) s2[j] = (f32x2_t){0.f, 0.f};
    u32x4 rg[3];
    __builtin_amdgcn_s_setprio(3);
    __syncthreads();
#pragma unroll
    for (int i = 0; i < 3; ++i) rg[i] = *(const u32x4*)(src + (size_t)(t + 256 * i) * 8);
#pragma unroll
    for (int i = 0; i < 3; ++i) { float* d = stage + (t + 256 * i) * 8;
        *(f32x4*)d = (f32x4){lo2f(rg[i].x), hi2f(rg[i].x), lo2f(rg[i].y), hi2f(rg[i].y)}; *(f32x4*)(d + 4) = (f32x4){lo2f(rg[i].z), hi2f(rg[i].z), lo2f(rg[i].w), hi2f(rg[i].w)}; }
    __syncthreads();
    constexpr int NCH = NT_ / CS;
    for (int c = 0; c < NCH; ++c) {
        const int cur = c & 1;
        if (c + 1 < NCH) {
#pragma unroll
            for (int i = 0; i < 3; ++i) rg[i] = *(const u32x4*)(src + (size_t)(c + 1) * CS * 384 + (size_t)(t + 256 * i) * 8);
        }
        if (c > 0) {
            const float* yb = ybuf + (cur ^ 1) * CS * 32;
            const int st = t >> 4, r2 = (t & 15) * 2;
            *(f32x2_t*)(p.yraw + ((size_t)(b * NT_ + (c - 1) * CS + st)) * 512 + head * 64 + hf * 32 + r2) = *(const f32x2_t*)(yb + st * 32 + r2);
        }
        const float* sb = stage + cur * CS * 384 + kseg * 8;
        float* yb = ybuf + cur * CS * 32;
        float yv[CS];
        ScanOps oc, on;
        scan_load(oc, sb, sb + 256 - kseg * 8 + vrow);
#pragma unroll
        for (int st = 0; st < CS; ++st) {
            if (st + 1 < CS) scan_load(on, sb + (st + 1) * 384, sb + (st + 1) * 384 + 256 - kseg * 8 + vrow);
            f32x2_t t0 = s2[0] * oc.k[0], t1 = s2[1] * oc.k[1];
            t0 = s2[2] * oc.k[2] + t0; t1 = s2[3] * oc.k[3] + t1;
            t0 = t0 + t1;
            float dot = dpp_sum8(t0.x + t0.y);
            const f32x2_t vv2 = {oc.v, oc.v}, nd2 = {-dot, -dot};
            f32x2_t u0, u1;
#pragma unroll
            for (int j = 0; j < 4; ++j) { f32x2_t tmp = s2[j] - s2[j] * oc.d[j]; tmp = vv2 * oc.p[j] + tmp; s2[j] = nd2 * oc.b[j] + tmp; }
            u0 = s2[0] * oc.r[0]; u1 = s2[1] * oc.r[1];
            u0 = s2[2] * oc.r[2] + u0; u1 = s2[3] * oc.r[3] + u1;
            u0 = u0 + u1;
            yv[st] = dpp_sum8(u0.x + u0.y);
            if (st + 1 < CS) oc = on;
        }
        if (kseg == 0) {
#pragma unroll
            for (int st = 0; st < CS; ++st) yb[st * 32 + rloc] = yv[st];
        }
        if (c + 1 < NCH) {
            float* dbase = stage + (cur ^ 1) * CS * 384;
#pragma unroll
            for (int i = 0; i < 3; ++i) { float* d = dbase + (t + 256 * i) * 8;
                *(f32x4*)d = (f32x4){lo2f(rg[i].x), hi2f(rg[i].x), lo2f(rg[i].y), hi2f(rg[i].y)}; *(f32x4*)(d + 4) = (f32x4){lo2f(rg[i].z), hi2f(rg[i].z), lo2f(rg[i].w), hi2f(rg[i].w)}; }
        }
        __syncthreads();
    }
    {
        const float* yb = ybuf + ((NCH - 1) & 1) * CS * 32;
        const int st = t >> 4, r2 = (t & 15) * 2;
        *(f32x2_t*)(p.yraw + ((size_t)(b * NT_ + (NCH - 1) * CS + st)) * 512 + head * 64 + hf * 32 + r2) = *(const f32x2_t*)(yb + st * 32 + r2);
    }
    __builtin_amdgcn_s_setprio(0);
}

DI void attn_item(const Params& p, unsigned char* lds, const int item) {
    constexpr int KROW = 208, VROW = 136, KB = 64 * KROW, BUF = KB + 64 * VROW;
    const int t = threadIdx.x, lane = t & 63, w = t >> 6, l31 = lane & 31, h = lane >> 5;
    const int qt = 31 - item / 128, bh = item % 128;
    const bf16_t* Kg = p.Kb + (size_t)bh * NT_ * 96;
    const bf16_t* Vg = p.Vt + (size_t)bh * 64 * NT_;
    const int q = qt * 128 + w * 32 + l31;
    bf16x8 qf[6];
    {
        const bf16_t* qrow = p.Q + ((size_t)bh * NT_ + q) * 96 + 8 * h;
#pragma unroll
        for (int s = 0; s < 6; ++s) qf[s] = *(const bf16x8*)(qrow + 16 * s);
    }
    f32x16 O[2];
#pragma unroll
    for (int i = 0; i < 16; ++i) { O[0][i] = 0.f; O[1][i] = 0.f; }
    float m = -INFINITY, l = 0.f;
    const int njt = 2 * qt + 2;
    int koff[3], kgo[3], voff[2], vgo[2];
#pragma unroll
    for (int i = 0; i < 3; ++i) { const int c = t + 256 * i, r = c / 12, ch = c - r * 12; koff[i] = r * KROW + ch * 16; kgo[i] = r * 96 + ch * 8; }
#pragma unroll
    for (int i = 0; i < 2; ++i) { const int c = t + 256 * i, dv = c >> 3, ch = c & 7; voff[i] = KB + dv * VROW + ch * 16; vgo[i] = dv * NT_ + ch * 8; }
    u32x4 rk0[3], rv0[2], rk1[3], rv1[2];
#define AT_LOAD(RK, RV, J) { _Pragma("unroll") for (int i = 0; i < 3; ++i) RK[i] = *(const u32x4*)(Kg + (size_t)(J) * 64 * 96 + kgo[i]); \
                             _Pragma("unroll") for (int i = 0; i < 2; ++i) RV[i] = *(const u32x4*)(Vg + (J) * 64 + vgo[i]); }
#define AT_WRITE(RK, RV, BUFI) { unsigned char* nb = lds + (BUFI) * BUF; _Pragma("unroll") for (int i = 0; i < 3; ++i) *(u32x4*)(nb + koff[i]) = RK[i]; \
                             _Pragma("unroll") for (int i = 0; i < 2; ++i) { *(u32x2*)(nb + voff[i]) = mk2(RV[i].x, RV[i].y); *(u32x2*)(nb + voff[i] + 8) = mk2(RV[i].z, RV[i].w); } }
    auto tile_compute = [&](const int cur, const int j) {
        const bool active = (j * 64) <= (qt * 128 + w * 32 + 31);
        if (active) {
            const unsigned char* Kt = lds + cur * BUF;
            const unsigned char* Vtile = Kt + KB;
            f32x16 S[2];
#pragma unroll
            for (int k2 = 0; k2 < 2; ++k2) {
#pragma unroll
                for (int i = 0; i < 16; ++i) S[k2][i] = 0.f;
#pragma unroll
                for (int s = 0; s < 6; ++s) {
                    const bf16x8 kf = *(const bf16x8*)(Kt + (k2 * 32 + l31) * KROW + s * 32 + h * 16);
                    S[k2] = __builtin_amdgcn_mfma_f32_32x32x16_bf16(kf, qf[s], S[k2], 0, 0, 0);
                }
            }
            if (j >= 2 * qt) {
#pragma unroll
                for (int k2 = 0; k2 < 2; ++k2)
#pragma unroll
                    for (int i = 0; i < 16; ++i) { const int key = j * 64 + k2 * 32 + (i & 3) + 8 * (i >> 2) + 4 * h; if (key > q) S[k2][i] = -INFINITY; }
            }
            float mx = S[0][0];
#pragma unroll
            for (int i = 1; i < 16; ++i) mx = fmaxf(mx, S[0][i]);
#pragma unroll
            for (int i = 0; i < 16; ++i) mx = fmaxf(mx, S[1][i]);
            mx = fmaxf(mx, __shfl_xor(mx, 32));
            if (__any(mx > m)) {
                const float mn = fmaxf(m, mx);
                const float alpha = __builtin_amdgcn_exp2f(m - mn);
                m = mn; l *= alpha;
#pragma unroll
                for (int i = 0; i < 16; ++i) { O[0][i] *= alpha; O[1][i] *= alpha; }
            }
            f32x2_t ps2 = {0.f, 0.f};
#pragma unroll
            for (int k2 = 0; k2 < 2; ++k2)
#pragma unroll
                for (int i = 0; i < 16; i += 2) {
                    const float e0 = __builtin_amdgcn_exp2f(S[k2][i] - m), e1 = __builtin_amdgcn_exp2f(S[k2][i + 1] - m);
                    S[k2][i] = e0; S[k2][i + 1] = e1; ps2 += (f32x2_t){e0, e1};
                }
            l += ps2.x + ps2.y;
#pragma unroll
            for (int k2 = 0; k2 < 2; ++k2)
#pragma unroll
                for (int s2 = 0; s2 < 2; ++s2) {
                    unsigned pw[4];
#pragma unroll
                    for (int e = 0; e < 4; ++e) pw[e] = pk2(S[k2][8 * s2 + 2 * e], S[k2][8 * s2 + 2 * e + 1]);
                    const bf16x8 pf = __builtin_bit_cast(bf16x8, mk4(pw[0], pw[1], pw[2], pw[3]));
#pragma unroll
                    for (int dt = 0; dt < 2; ++dt) {
                        const unsigned char* vp = Vtile + (dt * 32 + l31) * VROW + (k2 * 32 + s2 * 16 + 4 * h) * 2;
                        const u32x2 v0 = *(const u32x2*)(vp), v1 = *(const u32x2*)(vp + 16);
                        const bf16x8 vf = __builtin_bit_cast(bf16x8, mk4(v0.x, v0.y, v1.x, v1.y));
                        O[dt] = __builtin_amdgcn_mfma_f32_32x32x16_bf16(vf, pf, O[dt], 0, 0, 0);
                    }
                }
        }
    };
    AT_LOAD(rk0, rv0, 0)
    if (njt > 1) AT_LOAD(rk1, rv1, 1)
    __syncthreads();
    AT_WRITE(rk0, rv0, 0)
    if (njt > 2) AT_LOAD(rk0, rv0, 2)
    __syncthreads();
#pragma unroll 1
    for (int j = 0; j < njt; j += 2) {
        tile_compute(0, j);
        if (j + 1 < njt) { AT_WRITE(rk1, rv1, 1) if (j + 3 < njt) AT_LOAD(rk1, rv1, j + 3) }
        __syncthreads();
        if (j + 1 >= njt) break;
        tile_compute(1, j + 1);
        if (j + 2 < njt) { AT_WRITE(rk0, rv0, 0) if (j + 4 < njt) AT_LOAD(rk0, rv0, j + 4) }
        __syncthreads();
    }
#undef AT_LOAD
#undef AT_WRITE
    l += __shfl_xor(l, 32);
    const float inv = 1.0f / l;
    bf16_t* yrow = p.Y + ((size_t)((bh >> 3) * NT_ + q)) * DM + 512 + (bh & 7) * 64;
#pragma unroll
    for (int dt = 0; dt < 2; ++dt)
#pragma unroll
        for (int g = 0; g < 4; ++g)
            *(u32x2*)(yrow + dt * 32 + 8 * g + 4 * h) = mk2(pk2(O[dt][4 * g] * inv, O[dt][4 * g + 1] * inv), pk2(O[dt][4 * g + 2] * inv, O[dt][4 * g + 3] * inv));
}

DI void phase4(const Params& p, unsigned char* lds, int bid, int G) {
    int* sh_item = (int*)(lds + LDS_BYTES - 64);
    for (int task = bid; task < 256; task += G) scan_task(p, lds, task);
    STAMP(10);
    for (;;) {
        __syncthreads();
        if (threadIdx.x == 0) *sh_item = (int)atomicAdd(&p.ctrl[CTRL_ATTNQ], 1u);
        __syncthreads();
        const int item = *sh_item;
        if (item >= 4096) break;
        attn_item(p, lds, item);
    }
}

DI void phase5(const Params& p, unsigned char* lds, int bid, int G) {
    const int t = threadIdx.x, lane = t & 63, wid = t >> 6, wr = wid >> 1, wc = wid & 1;
    float* tile = (float*)lds;
    float* ssq = (float*)(lds + 69632);
    float* biasl = ssq + 128;
    int* lcnt = (int*)(lds + 65536);
    int* lbase = lcnt + 256;
    unsigned char* le = (unsigned char*)(lbase + 256);
    unsigned char* lp = le + 1024;
    __syncthreads();
    biasl[t] = p.router_bias[t];
    float* scores = (float*)(p.bscr + (size_t)bid * BSCR_PER_BLOCK);
    bf16_t* act = (bf16_t*)(p.bscr + (size_t)bid * BSCR_PER_BLOCK + 131072);
    for (int rt = bid; rt < NTOK / 128; rt += G) {
        const int b = rt >> 5;
        const float* mod = p.mod + b * 6144;
        __syncthreads();
        if (t < 128) ssq[t] = 0.f;
        lcnt[t] = 0;
#pragma unroll 1
        for (int it = 0; it < 16; ++it) {
            int tl = t; LAUNDER(tl);
            const int pr = (tl >> 2) + 64 * it;
            const int row = pr >> 3, head = pr & 7, part = tl & 3, grow = rt * 128 + row, tt = grow & 4095;
            const int ch = head * 64 + part * 16;
            const float* yr = p.yraw + (size_t)grow * 512 + ch;
            float y[16];
#pragma unroll
            for (int i = 0; i < 4; ++i) { const f32x4 v = *(const f32x4*)(yr + 4 * i); y[4 * i] = v[0]; y[4 * i + 1] = v[1]; y[4 * i + 2] = v[2]; y[4 * i + 3] = v[3]; }
            float sm = 0.f;
#pragma unroll
            for (int i = 0; i < 16; ++i) sm += y[i];
            sm += __shfl_xor(sm, 1); sm += __shfl_xor(sm, 2);
            const float mean = sm * (1.0f / 64.0f);
            float vr = 0.f;
#pragma unroll
            for (int i = 0; i < 16; ++i) { const float d = y[i] - mean; vr += d * d; }
            vr += __shfl_xor(vr, 1); vr += __shfl_xor(vr, 2);
            const float rs = rsqrtf(vr * (1.0f / 64.0f) + 64e-5f);
            const bf16_t* sc = p.SC + ((size_t)(b * 8 + head) * NT_ + tt) * 384 + part * 16;
            float kp[16], vv[16], rr[16];
#pragma unroll
            for (int i = 0; i < 2; ++i) {
                const u32x4 a = *(const u32x4*)(sc + 192 + 8 * i), c = *(const u32x4*)(sc + 256 + 8 * i), d = *(const u32x4*)(sc + 320 + 8 * i);
                kp[8 * i] = lo2f(a.x); kp[8 * i + 1] = hi2f(a.x); kp[8 * i + 2] = lo2f(a.y); kp[8 * i + 3] = hi2f(a.y); kp[8 * i + 4] = lo2f(a.z); kp[8 * i + 5] = hi2f(a.z); kp[8 * i + 6] = lo2f(a.w); kp[8 * i + 7] = hi2f(a.w);
                vv[8 * i] = lo2f(c.x); vv[8 * i + 1] = hi2f(c.x); vv[8 * i + 2] = lo2f(c.y); vv[8 * i + 3] = hi2f(c.y); vv[8 * i + 4] = lo2f(c.z); vv[8 * i + 5] = hi2f(c.z); vv[8 * i + 6] = lo2f(c.w); vv[8 * i + 7] = hi2f(c.w);
                rr[8 * i] = lo2f(d.x); rr[8 * i + 1] = hi2f(d.x); rr[8 * i + 2] = lo2f(d.y); rr[8 * i + 3] = hi2f(d.y); rr[8 * i + 4] = lo2f(d.z); rr[8 * i + 5] = hi2f(d.z); rr[8 * i + 6] = lo2f(d.w); rr[8 * i + 7] = hi2f(d.w);
            }
            float bn = 0.f;
#pragma unroll
            for (int i = 0; i < 16; ++i) bn += rr[i] * kp[i] * p.r_k[ch + i];
            bn += __shfl_xor(bn, 1); bn += __shfl_xor(bn, 2);
            const bf16_t* gg = p.Gg + (size_t)grow * 512 + ch;
            const u32x4 g0 = *(const u32x4*)(gg), g1 = *(const u32x4*)(gg + 8);
            float g[16] = {lo2f(g0.x), hi2f(g0.x), lo2f(g0.y), hi2f(g0.y), lo2f(g0.z), hi2f(g0.z), lo2f(g0.w), hi2f(g0.w), lo2f(g1.x), hi2f(g1.x), lo2f(g1.y), hi2f(g1.y), lo2f(g1.z), hi2f(g1.z), lo2f(g1.w), hi2f(g1.w)};
            float o[16];
#pragma unroll
            for (int i = 0; i < 16; ++i) o[i] = ((y[i] - mean) * rs * p.ln_w[ch + i] + p.ln_b[ch + i] + bn * vv[i]) * g[i];
            bf16_t* yd = p.Y + (size_t)grow * DM + ch;
            *(u32x4*)(yd) = mk4(pk2(o[0], o[1]), pk2(o[2], o[3]), pk2(o[4], o[5]), pk2(o[6], o[7]));
            *(u32x4*)(yd + 8) = mk4(pk2(o[8], o[9]), pk2(o[10], o[11]), pk2(o[12], o[13]), pk2(o[14], o[15]));
        }
        asm volatile("s_waitcnt vmcnt(0)" ::: "memory");
        __syncthreads();
        STAMP(11);
        {
            APlain ap{p.Y + (size_t)rt * 128 * DM, DM};
            gemm_stream<4, 4, 2, 64, 4>(ap, p.wout_t, DM, DM, 8, [](int u, int& ao, int& bo) { ao = 0; bo = u * 128 * DM; },
                [&](const int ct, f32x4 (&acc)[4][4]) {
                    int ll = lane; LAUNDER(ll);
#pragma unroll
                    for (int i = 0; i < 4; ++i) {
                        const int row = wr * 64 + i * 16 + (ll & 15), grow = rt * 128 + row;
                        float sq = 0.f;
#pragma unroll
                        for (int j = 0; j < 4; ++j) {
                            const int col = ct * 128 + wc * 64 + j * 16 + (ll >> 4) * 4;
                            const f32x4 xv = *(const f32x4*)(p.x + (size_t)grow * DM + col), ga = *(const f32x4*)(mod + 2048 + col);
                            f32x4 o;
#pragma unroll
                            for (int e = 0; e < 4; ++e) { o[e] = xv[e] + ga[e] * acc[i][j][e]; sq += o[e] * o[e]; }
                            *(f32x4*)(p.out + (size_t)grow * DM + col) = o;
                        }
                        sq += __shfl_xor(sq, 16); sq += __shfl_xor(sq, 32);
                        if ((ll >> 4) == 0) atomicAdd(&ssq[row], sq);
                    }
                }, lds);
        }
        asm volatile("s_waitcnt vmcnt(0)" ::: "memory");
        __syncthreads();
        STAMP(12);
#pragma unroll 1
        for (int mg = 0; mg < 8; ++mg) {
            int ll = lane; LAUNDER(ll);
            f32x4 xv[4][4];
#pragma unroll
            for (int u = 0; u < 4; ++u)
#pragma unroll
                for (int i = 0; i < 4; ++i) xv[u][i] = *(const f32x4*)(p.out + (size_t)(rt * 128 + wid + 4 * (mg * 4 + u)) * DM + ll * 4 + 256 * i);
#pragma unroll
            for (int u = 0; u < 4; ++u) {
                const int r = wid + 4 * (mg * 4 + u), grow = rt * 128 + r;
                const float rs = rsqrtf(ssq[r] * (1.0f / DM) + 1e-6f);
#pragma unroll
                for (int i = 0; i < 4; ++i) {
                    const int c = ll * 4 + 256 * i;
                    const f32x4 g = *(const f32x4*)(p.norm_ffn + c), sh = *(const f32x4*)(mod + 3072 + c), sc = *(const f32x4*)(mod + 4096 + c);
                    float o[4];
#pragma unroll
                    for (int e = 0; e < 4; ++e) o[e] = xv[u][i][e] * rs * g[e] * (1.0f + sc[e]) + sh[e];
                    *(u32x2*)(p.H + (size_t)grow * DM + c) = mk2(pk2(o[0], o[1]), pk2(o[2], o[3]));
                }
            }
        }
        asm volatile("s_waitcnt vmcnt(0)" ::: "memory");
        __syncthreads();
        STAMP(13);
        {
            APlain ap{p.H + (size_t)rt * 128 * DM, DM};
            gemm_stream<4, 4, 2, 64, 4>(ap, p.wr_t, DM, DM, 2, [](int u, int& ao, int& bo) { ao = 0; bo = u * 128 * DM; },
                [&](const int ct, f32x4 (&acc)[4][4]) {
                    int ll = lane; LAUNDER(ll);
#pragma unroll
                    for (int i = 0; i < 4; ++i)
#pragma unroll
                        for (int j = 0; j < 4; ++j) {
                            const int row = wr * 64 + i * 16 + (ll & 15), col = ct * 128 + wc * 64 + j * 16 + (ll >> 4) * 4;
#pragma unroll
                            for (int e = 0; e < 4; ++e) scores[(col + e) * 128 + row] = sigmoidf_(acc[i][j][e]);
                        }
                }, lds);
        }
        asm volatile("s_waitcnt vmcnt(0)" ::: "memory");
        __syncthreads();
        STAMP(14);
#pragma unroll 1
        for (int hh = 0; hh < 2; ++hh) {
            __syncthreads();
            {
                int tl = t; LAUNDER(tl);
                f32x4 rgs[16];
#pragma unroll
                for (int i = 0; i < 16; ++i) { const int c = tl + 256 * i; rgs[i] = *(const f32x4*)(scores + (c >> 4) * 128 + hh * 64 + (c & 15) * 4); }
#pragma unroll
                for (int i = 0; i < 16; ++i) *(f32x4*)(tile + (tl + 256 * i) * 4) = rgs[i];
            }
            __syncthreads();
            if (t < 64) {
                int tl = t; LAUNDER(tl);
                const int token = rt * 128 + hh * 64 + tl;
                const float* sc = tile + tl;
                float gs[8];
#pragma unroll
                for (int g = 0; g < 8; ++g) {
                    float m1 = -INFINITY, m2 = -INFINITY;
#pragma unroll 8
                    for (int i = 0; i < 32; ++i) { const float v = sc[(g * 32 + i) * 64] + biasl[g * 32 + i]; m2 = fmaxf(m2, fminf(m1, v)); m1 = fmaxf(m1, v); }
                    gs[g] = m1 + m2;
                }
                unsigned selmask = 0u;
#pragma unroll
                for (int g = 0; g < 8; ++g) {
                    int rank = 0;
#pragma unroll
                    for (int g2 = 0; g2 < 8; ++g2) rank += (gs[g2] > gs[g] || (gs[g2] == gs[g] && g2 < g)) ? 1 : 0;
                    selmask |= (rank < 4 ? 1u : 0u) << g;
                }
                float tv[8]; int ti[8];
#pragma unroll
                for (int k = 0; k < 8; ++k) { tv[k] = -INFINITY; ti[k] = 0; }
#pragma unroll 1
                for (int g = 0; g < 8; ++g) {
                    if ((selmask >> g) & 1u) {
#pragma unroll 4
                        for (int i = 0; i < 32; ++i) {
                            const int e = g * 32 + i;
                            const float v = sc[e * 64] + biasl[e];
                            if (v > tv[7]) {
#pragma unroll
                                for (int k = 7; k >= 1; --k) {
                                    if (v > tv[k - 1]) { tv[k] = tv[k - 1]; ti[k] = ti[k - 1]; }
                                    else if (v > tv[k]) { tv[k] = v; ti[k] = e; }
                                }
                                if (v > tv[0]) { tv[0] = v; ti[0] = e; }
                            }
                        }
                    }
                }
                float ws[8], wsum = 0.f;
#pragma unroll
                for (int k = 0; k < 8; ++k) { ws[k] = sc[ti[k] * 64]; wsum += ws[k]; }
                const float sc25 = 2.5f / wsum;
#pragma unroll
                for (int k = 0; k < 8; ++k) {
                    p.topk_idx[token * 8 + k] = ti[k];
                    p.topk_w[token * 8 + k] = ws[k] * sc25;
                    le[(hh * 64 + tl) * 8 + k] = (unsigned char)ti[k];
                    lp[(hh * 64 + tl) * 8 + k] = (unsigned char)atomicAdd(&lcnt[ti[k]], 1);
                }
            }
        }
        __syncthreads();
        { const int c = lcnt[t]; lbase[t] = c > 0 ? (int)atomicAdd(&p.ctrl[CTRL_ECNT + t * ECNT_STRIDE], (unsigned)c) : 0; }
        __syncthreads();
#pragma unroll
        for (int i = 0; i < 4; ++i) {
            const int a = t + 256 * i, e = le[a];
            p.elist[(size_t)e * NTOK + lbase[e] + lp[a]] = (rt * 128) * 8 + a;
        }
        STAMP(15);
        {
            APlain ap{p.H + (size_t)rt * 128 * DM, DM};
            gemm_stream<4, 4, 2, 64, 4>(ap, p.wsgu_t, DM, DM, 4, [](int u, int& ao, int& bo) { ao = 0; bo = u * 128 * DM; },
                [&](const int ct, f32x4 (&acc)[4][4]) {
                    int ll = lane; LAUNDER(ll);
#pragma unroll
                    for (int i = 0; i < 4; ++i) {
                        bf16_t* d = act + (wr * 64 + i * 16 + (ll & 15)) * 256 + ct * 64 + wc * 32 + (ll >> 4) * 4;
#pragma unroll
                        for (int m = 0; m < 2; ++m) {
                            f32x4 o;
#pragma unroll
                            for (int e = 0; e < 4; ++e) { const float g = acc[i][2 * m][e]; o[e] = g * sigmoidf_(g) * acc[i][2 * m + 1][e]; }
                            *(u32x2*)(d + m * 16) = pack4(o);
                        }
                    }
                }, lds);
        }
        asm volatile("s_waitcnt vmcnt(0)" ::: "memory");
        __syncthreads();
        STAMP(16);
        {
            APlain ap{act, 256};
            gemm_stream<4, 4, 2, 64, 4>(ap, p.wsd_t, 256, 256, 8, [](int u, int& ao, int& bo) { ao = 0; bo = u * 128 * 256; },
                [&](const int ct, f32x4 (&acc)[4][4]) {
                    int ll = lane; LAUNDER(ll);
#pragma unroll
                    for (int i = 0; i < 4; ++i)
#pragma unroll
                        for (int j = 0; j < 4; ++j) {
                            const int row = wr * 64 + i * 16 + (ll & 15), grow = rt * 128 + row, col = ct * 128 + wc * 64 + j * 16 + (ll >> 4) * 4;
                            const f32x4 xv = *(const f32x4*)(p.out + (size_t)grow * DM + col), gf = *(const f32x4*)(mod + 5120 + col);
                            f32x4 o;
#pragma unroll
                            for (int e = 0; e < 4; ++e) o[e] = xv[e] + gf[e] * acc[i][j][e];
                            *(f32x4*)(p.out + (size_t)grow * DM + col) = o;
                        }
                }, lds);
        }
    }
}

DI void phase6(const Params& p, unsigned char* lds, int bid, int G) {
    const int t = threadIdx.x, lane = t & 63, wid = t >> 6, wr = wid >> 1, wc = wid & 1;
    float* tile = (float*)lds;
    int* cpre = (int*)(lds + 69632);
    int* rowtok = (int*)(lds + 69632 + 1056);
    int* rowslot = rowtok + 128;
    float* roww = (float*)(rowslot + 128);
    int* sh_it = (int*)(roww + 128);
    bf16_t* act = (bf16_t*)(p.bscr + (size_t)bid * BSCR_PER_BLOCK + 131072);
    (void)G;
    __syncthreads();
    rowtok[t] = ((int)p.ctrl[CTRL_ECNT + t * ECNT_STRIDE] + 127) >> 7;
    __syncthreads();
    if (t < 8) { int sacc = 0; for (int k = 0; k < 32; ++k) { cpre[t * 33 + k] = sacc; sacc += rowtok[8 * k + t]; } cpre[t * 33 + 32] = sacc; }
    __syncthreads();
    const int hq = (int)(xb_xcc_id() & 7u);
    int attempt = 0;
    for (;;) {
        const int qc = (hq + attempt) & 7;
        __syncthreads();
        if (t == 0) sh_it[0] = (int)atomicAdd(&p.ctrl[CTRL_Q6 + qc * 64], 1u);
        __syncthreads();
        const int idx = sh_it[0];
        if (idx >= cpre[qc * 33 + 32]) { if (++attempt >= 8) break; continue; }
        int lo = 0, hi = 31;
        while (lo < hi) { const int mid = (lo + hi + 1) >> 1; if (cpre[qc * 33 + mid] <= idx) lo = mid; else hi = mid - 1; }
        const int e = 8 * lo + qc, tl = idx - cpre[qc * 33 + lo], cnt = (int)p.ctrl[CTRL_ECNT + e * ECNT_STRIDE];
        __syncthreads();
        if (t < 128) {
            const int r = tl * 128 + t;
            if (r < cnt) { const int ts = p.elist[(size_t)e * NTOK + r]; rowtok[t] = ts >> 3; rowslot[t] = ts; roww[t] = p.topk_w[ts]; }
            else { rowtok[t] = 0; rowslot[t] = -1; roww[t] = 0.f; }
        }
        __syncthreads();
        {
            AGather ap{p.H, rowtok};
            gemm_stream<4, 4, 2, 64, 4>(ap, p.wegu_t + (size_t)e * 512 * DM, DM, DM, 4, [](int u, int& ao, int& bo) { ao = 0; bo = u * 128 * DM; },
                [&](const int ct, f32x4 (&acc)[4][4]) {
                    int ll = lane; LAUNDER(ll);
#pragma unroll
                    for (int i = 0; i < 4; ++i) {
                        bf16_t* d = act + (wr * 64 + i * 16 + (ll & 15)) * 256 + ct * 64 + wc * 32 + (ll >> 4) * 4;
#pragma unroll
                        for (int m = 0; m < 2; ++m) {
                            f32x4 o;
#pragma unroll
                            for (int ee = 0; ee < 4; ++ee) { const float g = acc[i][2 * m][ee]; o[ee] = g * sigmoidf_(g) * acc[i][2 * m + 1][ee]; }
                            *(u32x2*)(d + m * 16) = pack4(o);
                        }
                    }
                }, lds);
        }
        asm volatile("s_waitcnt vmcnt(0)" ::: "memory");
        __syncthreads();
        {
            APlain ap{act, 256};
            gemm_stream<4, 4, 2, 64, 4>(ap, p.wed_t + (size_t)e * 1024 * 256, 256, 256, 8, [](int u, int& ao, int& bo) { ao = 0; bo = u * 128 * 256; },
                [&](const int ct, f32x4 (&acc)[4][4]) {
                    int ll = lane; LAUNDER(ll);
#pragma unroll
                    for (int i = 0; i < 4; ++i) {
                        const int row = wr * 64 + i * 16 + (ll & 15), srow = rowslot[row];
                        const float ww = roww[row];
                        if (srow >= 0) {
#pragma unroll
                            for (int j = 0; j < 4; ++j) {
                                const int col = ct * 128 + wc * 64 + j * 16 + (ll >> 4) * 4;
                                *(u32x2*)(p.slot + (size_t)srow * DM + col) = pack4(acc[i][j] * ww);
                            }
                        }
                    }
                }, lds);
        }
    }
}

DI void phase7(const Params& p, int bid, int G) {
    const int lane = threadIdx.x & 63, gw = bid * 4 + (threadIdx.x >> 6), nw = G * 4;
    for (int row = gw; row < NTOK; row += nw) {
        const float* mod = p.mod + (row >> 12) * 6144 + 5120;
#pragma unroll
        for (int i = 0; i < 4; ++i) {
            const int c = lane * 4 + 256 * i;
            float s[4] = {0.f, 0.f, 0.f, 0.f};
#pragma unroll
            for (int k = 0; k < 8; ++k) { const u32x2 w = *(const u32x2*)(p.slot + ((size_t)row * 8 + k) * DM + c); s[0] += lo2f(w.x); s[1] += hi2f(w.x); s[2] += lo2f(w.y); s[3] += hi2f(w.y); }
            const f32x4 gf = *(const f32x4*)(mod + c);
            f32x4 o = *(const f32x4*)(p.out + (size_t)row * DM + c);
#pragma unroll
            for (int e = 0; e < 4; ++e) o[e] += gf[e] * s[e];
            *(f32x4*)(p.out + (size_t)row * DM + c) = o;
        }
    }
}

extern __shared__ __attribute__((aligned(16))) unsigned char smem[];

template <int PH> DI void run_phase(const Params& p, unsigned char* lds, int bid, int G) {
    if (PH == 0) phase0(p, lds, bid, G);
    if (PH == 1) phase1(p, bid, G);
    if (PH == 2) phase2(p, lds, bid, G);
    if (PH == 3) phase3(p, lds, bid, G);
    if (PH == 4) phase4(p, lds, bid, G);
    if (PH == 5) phase5(p, lds, bid, G);
    if (PH == 6) phase6(p, lds, bid, G);
    if (PH == 7) phase7(p, bid, G);
}

#if !ONE_LAUNCH
template <int PH> __global__ void __launch_bounds__(256, 2) phase_kernel(Params p) { run_phase<PH>(p, smem, blockIdx.x, gridDim.x); }
#endif

#if ONE_LAUNCH
__global__ void __launch_bounds__(256, 2) mega_kernel(Params p) {
    volatile LAS unsigned* st = (volatile LAS unsigned*)(smem + LDS_BYTES - 16);
    if (threadIdx.x == 0) { st[0] = 0u; st[1] = 0u; st[2] = 0u; st[3] = 0u; }
    __syncthreads();
    XcdBarrier bar = xcd_barrier_post(p.ctrl, st);
    const int bid = blockIdx.x, G = gridDim.x;
    STAMP(0);
    run_phase<0>(p, smem, bid, G); xcd_barrier(bar); STAMP(1);
    run_phase<1>(p, smem, bid, G); xcd_barrier(bar); STAMP(2);
    run_phase<2>(p, smem, bid, G); xcd_barrier(bar); STAMP(3);
    run_phase<3>(p, smem, bid, G); xcd_barrier(bar); STAMP(4);
    run_phase<4>(p, smem, bid, G); xcd_barrier(bar); STAMP(5);
    run_phase<5>(p, smem, bid, G); xcd_barrier(bar); STAMP(6);
    run_phase<6>(p, smem, bid, G); xcd_barrier(bar); STAMP(7);
    run_phase<7>(p, smem, bid, G);
#ifdef PROBE_A
    xcd_barrier(bar); STAMP(8);
    xcd_barrier(bar);
    {
        const unsigned long long* sp = (const unsigned long long*)(p.ctrl + CTRL_STAMP);
        const unsigned long long ta = __hip_atomic_load(sp + PROBE_A, __ATOMIC_RELAXED, __HIP_MEMORY_SCOPE_AGENT), tb = __hip_atomic_load(sp + PROBE_B, __ATOMIC_RELAXED, __HIP_MEMORY_SCOPE_AGENT);
        const unsigned long long t0 = __builtin_amdgcn_s_memrealtime();
        while (__builtin_amdgcn_s_memrealtime() - t0 < tb - ta) __builtin_amdgcn_s_sleep(8);
    }
#endif
}
#define OCC_KERNEL mega_kernel
#else
#define OCC_KERNEL phase_kernel<5>
#endif

static inline size_t al256(size_t x) { return (x + 255) & ~(size_t)255; }

extern "C" void kernel_launch(void* const* d_in, const int* in_sizes, int n_in, void* d_out, int out_size, void* d_ws, size_t ws_size, hipStream_t stream) {
    (void)in_sizes; (void)n_in; (void)out_size;
    Params p{};
    p.x = (const float*)d_in[0]; p.c = (const float*)d_in[1]; p.positions = (const int*)d_in[2]; p.ada_w = (const float*)d_in[3]; p.ada_b = (const float*)d_in[4];
    p.norm_mix = (const float*)d_in[5]; p.w_in = (const float*)d_in[6]; p.rwkv_mu = (const float*)d_in[7]; p.decay_w0 = (const float*)d_in[8]; p.decay_up = (const float*)d_in[9];
    p.iclr_a0 = (const float*)d_in[10]; p.iclr_up = (const float*)d_in[11]; p.gate_up = (const float*)d_in[12]; p.k_k = (const float*)d_in[13]; p.k_a = (const float*)d_in[14];
    p.r_k = (const float*)d_in[15]; p.ln_w = (const float*)d_in[16]; p.ln_b = (const float*)d_in[17]; p.q_a_norm = (const float*)d_in[18]; p.w_q_b = (const float*)d_in[19];
    p.kv_a_norm = (const float*)d_in[20]; p.w_kv_b = (const float*)d_in[21]; p.q_norm = (const float*)d_in[22]; p.k_norm = (const float*)d_in[23]; p.w_out = (const float*)d_in[24];
    p.norm_ffn = (const float*)d_in[25]; p.w_router = (const float*)d_in[26]; p.router_bias = (const float*)d_in[27]; p.w_e_gu = (const float*)d_in[28]; p.w_e_d = (const float*)d_in[29];
    p.w_sh_gu = (const float*)d_in[30]; p.w_sh_d = (const float*)d_in[31];
    p.out = (float*)d_out;

    static int grid = 0;
    if (!grid) {
        int dev = 0, cus = 0, per_cu = 0;
        (void)hipGetDevice(&dev);
        (void)hipDeviceGetAttribute(&cus, hipDeviceAttributeMultiprocessorCount, dev);
#if ONE_LAUNCH
        (void)hipFuncSetAttribute((const void*)mega_kernel, hipFuncAttributeMaxDynamicSharedMemorySize, LDS_BYTES);
#endif
#if !ONE_LAUNCH
        (void)hipFuncSetAttribute((const void*)phase_kernel<0>, hipFuncAttributeMaxDynamicSharedMemorySize, LDS_BYTES);
#endif
#if !ONE_LAUNCH
        (void)hipFuncSetAttribute((const void*)phase_kernel<1>, hipFuncAttributeMaxDynamicSharedMemorySize, LDS_BYTES);
#endif
#if !ONE_LAUNCH
        (void)hipFuncSetAttribute((const void*)phase_kernel<2>, hipFuncAttributeMaxDynamicSharedMemorySize, LDS_BYTES);
#endif
#if !ONE_LAUNCH
        (void)hipFuncSetAttribute((const void*)phase_kernel<3>, hipFuncAttributeMaxDynamicSharedMemorySize, LDS_BYTES);
#endif
#if !ONE_LAUNCH
        (void)hipFuncSetAttribute((const void*)phase_kernel<4>, hipFuncAttributeMaxDynamicSharedMemorySize, LDS_BYTES);
#endif
#if !ONE_LAUNCH
        (void)hipFuncSetAttribute((const void*)phase_kernel<5>, hipFuncAttributeMaxDynamicSharedMemorySize, LDS_BYTES);
#endif
#if !ONE_LAUNCH
        (void)hipFuncSetAttribute((const void*)phase_kernel<6>, hipFuncAttributeMaxDynamicSharedMemorySize, LDS_BYTES);
#endif
#if !ONE_LAUNCH
        (void)hipFuncSetAttribute((const void*)phase_kernel<7>, hipFuncAttributeMaxDynamicSharedMemorySize, LDS_BYTES);
#endif
        (void)hipOccupancyMaxActiveBlocksPerMultiprocessor(&per_cu, (const void*)OCC_KERNEL, 256, LDS_BYTES);
        if (cus <= 0) cus = 256;
        if (per_cu < 1) per_cu = 1;
        grid = cus * (per_cu < 2 ? per_cu : 2);
    }
    unsigned char* w = (unsigned char*)d_ws; size_t o = 0;
    auto take = [&](size_t bytes) { unsigned char* r = w + o; o = al256(o + bytes); return r; };
    p.ctrl = (unsigned*)take(CTRL_WORDS * 4);
    p.mod = (float*)take((size_t)NB * 6144 * 4);
    p.rope = (float*)take((size_t)NTOK * 32 * 4);
    p.win_t = (bf16_t*)take((size_t)LDU * 1024 * 2);
    p.wq_t = (bf16_t*)take((size_t)768 * 256 * 2);
    p.wkv_t = (bf16_t*)take((size_t)1024 * 128 * 2);
    p.wdec_t = (bf16_t*)take((size_t)512 * 32 * 2);
    p.wiclr_t = (bf16_t*)take((size_t)512 * 32 * 2);
    p.wgate_t = (bf16_t*)take((size_t)512 * 96 * 2);
    p.wout_t = (bf16_t*)take((size_t)1024 * 1024 * 2);
    p.wr_t = (bf16_t*)take((size_t)256 * 1024 * 2);
    p.wsgu_t = (bf16_t*)take((size_t)512 * 1024 * 2);
    p.wsd_t = (bf16_t*)take((size_t)1024 * 256 * 2);
    p.wegu_t = (bf16_t*)take((size_t)NEXP * 512 * 1024 * 2);
    p.wed_t = (bf16_t*)take((size_t)NEXP * 1024 * 256 * 2);
    p.H = (bf16_t*)take((size_t)NTOK * DM * 2);
    p.topk_idx = (int*)take((size_t)NTOK * 8 * 4);
    p.topk_w = (float*)take((size_t)NTOK * 8 * 4);
    p.elist = (int*)take((size_t)NEXP * NTOK * 4);
    p.bscr = take((size_t)grid * BSCR_PER_BLOCK);
    const size_t ov = o;
    p.U = (bf16_t*)take((size_t)NTOK * LDU * 2);
    p.Q = (bf16_t*)take((size_t)NTOK * 8 * 96 * 2);
    p.Kb = (bf16_t*)take((size_t)NTOK * 8 * 96 * 2);
    p.Vt = (bf16_t*)take((size_t)NTOK * 8 * 64 * 2);
    p.SC = (bf16_t*)take((size_t)NTOK * 8 * 384 * 2);
    p.Gg = (bf16_t*)take((size_t)NTOK * 512 * 2);
    p.yraw = (float*)take((size_t)NTOK * 512 * 4);
    p.Y = (bf16_t*)take((size_t)NTOK * DM * 2);
    p.slot = (bf16_t*)(w + ov);
    const size_t need_slot = ov + (size_t)NTOK * 8 * DM * 2;
    if (o > ws_size || need_slot > ws_size) { fprintf(stderr, "workspace too small: need %zu / %zu, have %zu\n", o, need_slot, ws_size); return; }

    (void)hipMemsetAsync(p.ctrl, 0, CTRL_WORDS * 4, stream);
#if ONE_LAUNCH
    hipLaunchKernelGGL(mega_kernel, dim3(grid), dim3(256), LDS_BYTES, stream, p);
#else
    hipLaunchKernelGGL(phase_kernel<0>, dim3(grid), dim3(256), LDS_BYTES, stream, p);
    hipLaunchKernelGGL(phase_kernel<1>, dim3(grid), dim3(256), LDS_BYTES, stream, p);
    hipLaunchKernelGGL(phase_kernel<2>, dim3(grid), dim3(256), LDS_BYTES, stream, p);
    hipLaunchKernelGGL(phase_kernel<3>, dim3(grid), dim3(256), LDS_BYTES, stream, p);
    hipLaunchKernelGGL(phase_kernel<4>, dim3(grid), dim3(256), LDS_BYTES, stream, p);
    hipLaunchKernelGGL(phase_kernel<5>, dim3(grid), dim3(256), LDS_BYTES, stream, p);
    hipLaunchKernelGGL(phase_kernel<6>, dim3(grid), dim3(256), LDS_BYTES, stream, p);
    hipLaunchKernelGGL(phase_kernel<7>, dim3(grid), dim3(256), LDS_BYTES, stream, p);
#endif
}
```

```cpp
#include <hip/hip_runtime.h>
#include <stdint.h>
#include <stdio.h>
#define DI __device__ __forceinline__

#ifndef ONE_LAUNCH
#define ONE_LAUNCH 1
#endif

typedef unsigned short bf16_t;
typedef short bf16x8 __attribute__((ext_vector_type(8)));
typedef float f32x4 __attribute__((ext_vector_type(4)));
typedef float f32x16 __attribute__((ext_vector_type(16)));
typedef float f32x2_t __attribute__((ext_vector_type(2)));
typedef unsigned u32x4 __attribute__((ext_vector_type(4)));
typedef unsigned u32x2 __attribute__((ext_vector_type(2)));
#define LAUNDER(v) asm volatile("" : "+v"(v))
DI u32x4 mk4(unsigned a, unsigned b, unsigned c, unsigned d) { return (u32x4){a, b, c, d}; }
DI u32x2 mk2(unsigned a, unsigned b) { return (u32x2){a, b}; }

typedef __bf16 bf16x2_t __attribute__((ext_vector_type(2)));

constexpr int NB = 16, NT_ = 4096, DM = 1024, NTOK = NB * NT_;
constexpr int LDU = 2176;
constexpr int UQ = 0, UKV = 256, UR = 384, UK = 896, UV = 1408, UXW = 1920, UXA = 1952, UXG = 1984, UPE = 2080;
constexpr int NEXP = 256, TOPK = 8;
constexpr int LDS_BYTES = 73728;
constexpr float QSCALE = 0.14724444f;

#define XB_TMO      128
#define XB_XCNT(j)  (256  + 64 * (j))
#define XB_XSUB(j)  (1280 + 64 * (j))
#define XB_XGEN(j)  (2304 + 64 * (j))
#define XB_TOP      3328
#define XB_TOPGEN   3392
#define XCD_BAR_WORDS 3456
#define XB_SPIN_CAP (1u << 22)
#define LAS __attribute__((address_space(3)))
constexpr int CTRL_ATTNQ = 4096, CTRL_ECNT = 8192, ECNT_STRIDE = 64, CTRL_WORDS = 24576;
constexpr int CTRL_STAMP = 4160;
constexpr int CTRL_Q6 = 4608;
#ifdef PROBE_A
#define STAMP(id) do { if (blockIdx.x == 0 && threadIdx.x == 0) __hip_atomic_store((unsigned long long*)(p.ctrl + CTRL_STAMP) + (id), (unsigned long long)__builtin_amdgcn_s_memrealtime(), __ATOMIC_RELAXED, __HIP_MEMORY_SCOPE_AGENT); } while (0)
#else
#define STAMP(id)
#endif

DI unsigned xb_ld(unsigned* p)              { return __hip_atomic_load(p, __ATOMIC_RELAXED, __HIP_MEMORY_SCOPE_AGENT); }
DI unsigned xb_add(unsigned* p, unsigned v) { return __hip_atomic_fetch_add(p, v, __ATOMIC_RELAXED, __HIP_MEMORY_SCOPE_AGENT); }
DI unsigned xb_xcc_id() { return (unsigned)__builtin_amdgcn_s_getreg((3 << 11) | 20) & 0xFu; }
#define XB_SPIN(cond, bar) do { unsigned _sp = 0; while (cond) { __builtin_amdgcn_s_sleep(1); \
    if ((++_sp & 255u) == 0u) { if (xb_ld(&(bar)[XB_TMO])) break; if (_sp > XB_SPIN_CAP) { atomicAdd(&(bar)[XB_TMO], 1u); break; } } } } while (0)

struct XcdBarrier { unsigned* bar; unsigned x; volatile LAS unsigned* st; };

DI XcdBarrier xcd_barrier_post(unsigned* bar, volatile LAS unsigned* st) {
    XcdBarrier b; b.bar = bar; b.x = xb_xcc_id(); b.st = st;
    if (threadIdx.x == 0) (void)xb_add(&bar[XB_XCNT(b.x)], 1u);
    return b;
}
DI void xcd_barrier_complete(unsigned* bar, unsigned x, unsigned& nloc, unsigned& nx) {
    const unsigned G = gridDim.x * gridDim.y * gridDim.z;
    unsigned sum, cnt, mine, sp = 0u;
    for (;;) {
        sum = 0u; cnt = 0u; mine = 0u;
#pragma unroll
        for (unsigned j = 0; j < 16; ++j) { const unsigned c = xb_ld(&bar[XB_XCNT(j)]); sum += c; cnt += (c > 0u) ? 1u : 0u; mine = (j == x) ? c : mine; }
        if (sum == G) break;
        __builtin_amdgcn_s_sleep(1);
        if ((++sp & 255u) == 0u) { if (xb_ld(&bar[XB_TMO])) break; if (sp > XB_SPIN_CAP) { atomicAdd(&bar[XB_TMO], 1u); break; } }
    }
    nloc = mine > 0u ? mine : 1u; nx = cnt > 0u ? cnt : 1u;
}
DI void xcd_barrier(const XcdBarrier& b) {
    asm volatile("s_waitcnt vmcnt(0)" ::: "memory");
    __syncthreads();
    if (threadIdx.x == 0) {
        unsigned* bar = b.bar;
        __builtin_amdgcn_s_waitcnt(0);
        unsigned nloc = b.st[0], nx = b.st[1];
        if (nloc == 0u) { xcd_barrier_complete(bar, b.x, nloc, nx); b.st[0] = nloc; b.st[1] = nx; }
        const unsigned old = xb_add(&bar[XB_XSUB(b.x)], 1u);
        const unsigned gen = old / nloc;
        if (old + 1u == (gen + 1u) * nloc) {
            __builtin_amdgcn_fence(__ATOMIC_RELEASE, "agent");
            asm volatile("s_waitcnt vmcnt(0)" ::: "memory");
            const unsigned og = xb_add(&bar[XB_TOP], 1u);
            const unsigned tg = og / nx;
            if (og + 1u == (tg + 1u) * nx) xb_add(&bar[XB_TOPGEN], 1u);
            else XB_SPIN(xb_ld(&bar[XB_TOPGEN]) == tg, bar);
            __builtin_amdgcn_fence(__ATOMIC_ACQUIRE, "agent");
            xb_add(&bar[XB_XGEN(b.x)], 1u);
            asm volatile("s_waitcnt vmcnt(0)" ::: "memory");
        } else {
            XB_SPIN(xb_ld(&bar[XB_XGEN(b.x)]) == gen, bar);
            __builtin_amdgcn_fence(__ATOMIC_ACQUIRE, "agent");
            asm volatile("s_waitcnt vmcnt(0)" ::: "memory");
        }
    }
    __syncthreads();
}

struct Params {
    const float* x; const float* c; const int* positions; const float* ada_w; const float* ada_b; const float* norm_mix; const float* w_in;
    const float* rwkv_mu; const float* decay_w0; const float* decay_up; const float* iclr_a0; const float* iclr_up; const float* gate_up;
    const float* k_k; const float* k_a; const float* r_k; const float* ln_w; const float* ln_b;
    const float* q_a_norm; const float* w_q_b; const float* kv_a_norm; const float* w_kv_b; const float* q_norm; const float* k_norm;
    const float* w_out; const float* norm_ffn; const float* w_router; const float* router_bias;
    const float* w_e_gu; const float* w_e_d; const float* w_sh_gu; const float* w_sh_d;
    float* out;
    unsigned* ctrl; float* mod; float* rope;
    bf16_t* win_t; bf16_t* wq_t; bf16_t* wkv_t; bf16_t* wdec_t; bf16_t* wiclr_t; bf16_t* wgate_t; bf16_t* wout_t; bf16_t* wr_t; bf16_t* wsgu_t; bf16_t* wsd_t;
    bf16_t* wegu_t; bf16_t* wed_t;
    bf16_t* H; int* topk_idx; float* topk_w; int* elist; unsigned char* bscr;
    bf16_t* U; bf16_t* Q; bf16_t* Kb; bf16_t* Vt; bf16_t* SC; bf16_t* Gg; float* yraw; bf16_t* Y; bf16_t* slot;
};
constexpr size_t BSCR_PER_BLOCK = 196608;

DI float bf2f(bf16_t v) { return __uint_as_float(((unsigned)v) << 16); }
DI unsigned pk2(float a, float b) { f32x2_t f = {a, b}; bf16x2_t r = __builtin_convertvector(f, bf16x2_t); return __builtin_bit_cast(unsigned, r); }
DI bf16_t f2bf(float a) { return (bf16_t)(pk2(a, 0.f) & 0xffffu); }
DI float lo2f(unsigned w) { return __uint_as_float(w << 16); }
DI float hi2f(unsigned w) { return __uint_as_float(w & 0xffff0000u); }
DI float sigmoidf_(float x) { return 1.0f / (1.0f + __expf(-x)); }
DI float wave_sum(float v) {
#pragma unroll
    for (int o = 32; o > 0; o >>= 1) v += __shfl_xor(v, o);
    return v;
}
DI float dpp_sum8(float s) {
    s += __builtin_bit_cast(float, __builtin_amdgcn_update_dpp(0, __builtin_bit_cast(int, s), 0xB1, 0xf, 0xf, true));
    s += __builtin_bit_cast(float, __builtin_amdgcn_update_dpp(0, __builtin_bit_cast(int, s), 0x4E, 0xf, 0xf, true));
    s += __builtin_bit_cast(float, __builtin_amdgcn_update_dpp(0, __builtin_bit_cast(int, s), 0x141, 0xf, 0xf, true));
    return s;
}

struct APlain { const bf16_t* base; int ld; DI const bf16_t* row(int r) const { return base + (size_t)r * ld; } };
struct AGather { const bf16_t* base; const int* idx; DI const bf16_t* row(int r) const { return base + (size_t)idx[r] * DM; } };

template <int MT, int NT, int WR, int BK, int NSWAP, class AP>
DI void gemm_tile(const AP ap, const bf16_t* __restrict__ Bt, const int ldb, const int K, f32x4 (&acc)[MT][NT], unsigned char* lds) {
    constexpr int WC = 4 / WR, CPR = BK / 8, RB = BK * 2, R256 = 256 / RB, BN = WC * NT * 16;
    static_assert(WR * MT * 16 == 128, "tile is 128 rows");
    constexpr int A_BYTES = 128 * RB, B_BYTES = BN * RB;
    constexpr int A_CH = (128 * CPR) / 256, B_TOT = BN * CPR, B_CH = (B_TOT + 255) / 256, RSTEP = 256 / CPR;
    int t = threadIdx.x; LAUNDER(t);
    const int lane = t & 63, wid = t >> 6, wr = wid / WC, wc = wid % WC;
    const int ch = t % CPR, r0 = t / CPR;
    const bf16_t* pa[A_CH]; const bf16_t* pb[B_CH]; int offa[A_CH], offb[B_CH]; bool vb[B_CH];
#pragma unroll
    for (int i = 0; i < A_CH; ++i) { const int row = r0 + i * RSTEP; pa[i] = ap.row(row) + ch * 8; offa[i] = row * RB + ((ch ^ ((row / R256) & (CPR - 1))) << 4); }
#pragma unroll
    for (int i = 0; i < B_CH; ++i) { const int row = r0 + i * RSTEP; vb[i] = (B_TOT % 256 == 0) || (row < BN); const int rr = vb[i] ? row : 0; pb[i] = Bt + (size_t)rr * ldb + ch * 8; offb[i] = 2 * A_BYTES + rr * RB + ((ch ^ ((rr / R256) & (CPR - 1))) << 4); }
#pragma unroll
    for (int i = 0; i < MT; ++i)
#pragma unroll
        for (int j = 0; j < NT; ++j) acc[i][j] = (f32x4){0.f, 0.f, 0.f, 0.f};
    const int KT = K / BK;
    u32x4 ra0[A_CH], rb0[B_CH], ra1[A_CH], rb1[B_CH];
#define G_LOAD(RA, RB, KTI) { _Pragma("unroll") for (int i = 0; i < A_CH; ++i) RA[i] = *(const u32x4*)(pa[i] + (KTI) * BK); \
                              _Pragma("unroll") for (int i = 0; i < B_CH; ++i) RB[i] = *(const u32x4*)(pb[i] + (KTI) * BK); }
#define G_WRITE(RA, RB, BUF) { _Pragma("unroll") for (int i = 0; i < A_CH; ++i) *(u32x4*)(lds + (BUF) * A_BYTES + offa[i]) = RA[i]; \
                               _Pragma("unroll") for (int i = 0; i < B_CH; ++i) if (vb[i]) *(u32x4*)(lds + (BUF) * B_BYTES + offb[i]) = RB[i]; }
#define G_COMPUTE(BUF) { const unsigned char* Ab = lds + (BUF) * A_BYTES + arow; const unsigned char* Bb = lds + 2 * A_BYTES + (BUF) * B_BYTES + brow; \
        _Pragma("unroll") for (int ks = 0; ks < BK / 32; ++ks) { const int co = ((ks * 4 + (lane >> 4)) ^ sw) << 4; bf16x8 af[MT], bfr[NT]; \
            _Pragma("unroll") for (int i = 0; i < MT; ++i) af[i] = *(const bf16x8*)(Ab + i * 16 * RB + co); \
            _Pragma("unroll") for (int j = 0; j < NT; ++j) bfr[j] = *(const bf16x8*)(Bb + j * 16 * RB + co); \
            _Pragma("unroll") for (int i = 0; i < MT; ++i) _Pragma("unroll") for (int j = 0; j < NT; ++j) \
                acc[i][j] = (j < NSWAP) ? __builtin_amdgcn_mfma_f32_16x16x32_bf16(bfr[j], af[i], acc[i][j], 0, 0, 0) \
                                        : __builtin_amdgcn_mfma_f32_16x16x32_bf16(af[i], bfr[j], acc[i][j], 0, 0, 0); } }
    const int sw = ((lane & 15) / R256) & (CPR - 1);
    const int arow = (wr * MT * 16 + (lane & 15)) * RB, brow = (wc * NT * 16 + (lane & 15)) * RB;
    G_LOAD(ra0, rb0, 0)
    if (KT > 1) G_LOAD(ra1, rb1, 1)
    __syncthreads();
    G_WRITE(ra0, rb0, 0)
    if (KT > 2) G_LOAD(ra0, rb0, 2)
    __syncthreads();
    for (int kt = 0; kt < KT; kt += 2) {
        G_COMPUTE(0)
        if (kt + 1 < KT) { G_WRITE(ra1, rb1, 1) if (kt + 3 < KT) G_LOAD(ra1, rb1, kt + 3) }
        __syncthreads();
        if (kt + 1 >= KT) break;
        G_COMPUTE(1)
        if (kt + 2 < KT) { G_WRITE(ra0, rb0, 0) if (kt + 4 < KT) G_LOAD(ra0, rb0, kt + 4) }
        __syncthreads();
    }
#undef G_LOAD
#undef G_WRITE
#undef G_COMPUTE
}
template <int MT, int NT, int WR, int BK, int NSWAP, class AP, class UF, class EPI>
DI void gemm_stream(const AP ap, const bf16_t* __restrict__ Bt, const int ldb, const int K, const int nunits, const UF uoff, const EPI epi, unsigned char* lds) {
    constexpr int WC = 4 / WR, CPR = BK / 8, RB = BK * 2, R256 = 256 / RB, BN = WC * NT * 16;
    static_assert(WR * MT * 16 == 128, "tile is 128 rows");
    constexpr int A_BYTES = 128 * RB, B_BYTES = BN * RB;
    constexpr int A_CH = (128 * CPR) / 256, B_TOT = BN * CPR, B_CH = (B_TOT + 255) / 256, RSTEP = 256 / CPR;
    int t = threadIdx.x; LAUNDER(t);
    const int lane = t & 63, wid = t >> 6, wr = wid / WC, wc = wid % WC;
    const int ch = t % CPR, r0 = t / CPR;
    const bf16_t* pa[A_CH]; const bf16_t* pb[B_CH]; int offa[A_CH], offb[B_CH]; bool vb[B_CH];
#pragma unroll
    for (int i = 0; i < A_CH; ++i) { const int row = r0 + i * RSTEP; pa[i] = ap.row(row) + ch * 8; offa[i] = row * RB + ((ch ^ ((row / R256) & (CPR - 1))) << 4); }
#pragma unroll
    for (int i = 0; i < B_CH; ++i) { const int row = r0 + i * RSTEP; vb[i] = (B_TOT % 256 == 0) || (row < BN); const int rr = vb[i] ? row : 0; pb[i] = Bt + (size_t)rr * ldb + ch * 8; offb[i] = 2 * A_BYTES + rr * RB + ((ch ^ ((rr / R256) & (CPR - 1))) << 4); }
    f32x4 acc[MT][NT];
#pragma unroll
    for (int i = 0; i < MT; ++i)
#pragma unroll
        for (int j = 0; j < NT; ++j) acc[i][j] = (f32x4){0.f, 0.f, 0.f, 0.f};
    const int KT = K / BK, NG = nunits * KT;
    int lu = 0, lkt = 0, cu = 0, ckt = 0;
    u32x4 ra0[A_CH], rb0[B_CH], ra1[A_CH], rb1[B_CH];
#define S_LOAD(RA, RB) { int ao, bo; uoff(lu, ao, bo); ao += lkt * BK; bo += lkt * BK; \
                         _Pragma("unroll") for (int i = 0; i < A_CH; ++i) RA[i] = *(const u32x4*)(pa[i] + ao); \
                         _Pragma("unroll") for (int i = 0; i < B_CH; ++i) RB[i] = *(const u32x4*)(pb[i] + bo); \
                         if (++lkt == KT) { lkt = 0; ++lu; } }
#define S_WRITE(RA, RB, BUF) { _Pragma("unroll") for (int i = 0; i < A_CH; ++i) *(u32x4*)(lds + (BUF) * A_BYTES + offa[i]) = RA[i]; \
                               _Pragma("unroll") for (int i = 0; i < B_CH; ++i) if (vb[i]) *(u32x4*)(lds + (BUF) * B_BYTES + offb[i]) = RB[i]; }
#define S_COMPUTE(BUF) { const unsigned char* Ab = lds + (BUF) * A_BYTES + arow; const unsigned char* Bb = lds + 2 * A_BYTES + (BUF) * B_BYTES + brow; \
        _Pragma("unroll") for (int ks = 0; ks < BK / 32; ++ks) { const int co = ((ks * 4 + (lane >> 4)) ^ sw) << 4; bf16x8 af[MT], bfr[NT]; \
            _Pragma("unroll") for (int i = 0; i < MT; ++i) af[i] = *(const bf16x8*)(Ab + i * 16 * RB + co); \
            _Pragma("unroll") for (int j = 0; j < NT; ++j) bfr[j] = *(const bf16x8*)(Bb + j * 16 * RB + co); \
            _Pragma("unroll") for (int i = 0; i < MT; ++i) _Pragma("unroll") for (int j = 0; j < NT; ++j) \
                acc[i][j] = (j < NSWAP) ? __builtin_amdgcn_mfma_f32_16x16x32_bf16(bfr[j], af[i], acc[i][j], 0, 0, 0) \
                                        : __builtin_amdgcn_mfma_f32_16x16x32_bf16(af[i], bfr[j], acc[i][j], 0, 0, 0); } }
#define S_EPI { if (++ckt == KT) { epi(cu, acc); ckt = 0; ++cu; \
                _Pragma("unroll") for (int i = 0; i < MT; ++i) _Pragma("unroll") for (int j = 0; j < NT; ++j) acc[i][j] = (f32x4){0.f, 0.f, 0.f, 0.f}; } }
    const int sw = ((lane & 15) / R256) & (CPR - 1);
    const int arow = (wr * MT * 16 + (lane & 15)) * RB, brow = (wc * NT * 16 + (lane & 15)) * RB;
    S_LOAD(ra0, rb0)
    if (NG > 1) S_LOAD(ra1, rb1)
    __syncthreads();
    S_WRITE(ra0, rb0, 0)
    if (NG > 2) S_LOAD(ra0, rb0)
    __syncthreads();
#pragma unroll 1
    for (int g = 0; g < NG; g += 2) {
        S_COMPUTE(0)
        if (g + 1 < NG) { S_WRITE(ra1, rb1, 1) if (g + 3 < NG) S_LOAD(ra1, rb1) }
        S_EPI
        __syncthreads();
        if (g + 1 >= NG) break;
        S_COMPUTE(1)
        if (g + 2 < NG) { S_WRITE(ra0, rb0, 0) if (g + 4 < NG) S_LOAD(ra0, rb0) }
        S_EPI
        __syncthreads();
    }
#undef S_LOAD
#undef S_WRITE
#undef S_COMPUTE
#undef S_EPI
}

template <int NT, int BK, class AP>
DI void gemm_core(const AP ap, const bf16_t* __restrict__ Bt, const int ldb, const int K, f32x4 (&acc)[4][NT], unsigned char* lds) {
    gemm_tile<4, NT, 2, BK, NT>(ap, Bt, ldb, K, acc, lds);
}

template <int NT> DI void acc_to_lds(const f32x4 (&acc)[4][NT], float* tile, const int ld) {
    int t = threadIdx.x; LAUNDER(t);
    const int lane = t & 63, wid = t >> 6, wr = wid >> 1, wc = wid & 1;
#pragma unroll
    for (int i = 0; i < 4; ++i)
#pragma unroll
        for (int j = 0; j < NT; ++j) {
            const int row = wr * 64 + i * 16 + (lane & 15), col = wc * NT * 16 + j * 16 + (lane >> 4) * 4;
            *(f32x4*)(tile + row * ld + col) = acc[i][j];
        }
}

DI int map_win(int n) { return n < 384 ? n + 1696 : (n < 2080 ? n - 384 : (n < 2112 ? n : -1)); }
DI int map_gu(int n) { const int tile = n >> 7, w = n & 127, wc = w >> 6, j = (w >> 4) & 3, r = w & 15; const int a = tile * 64 + wc * 32 + (j >> 1) * 16 + r; return (j & 1) ? 256 + a : a; }

template <int MAP> DI void tconv_simple(const float* __restrict__ src, bf16_t* __restrict__ dst, int K, int Ns, int Nd, const float* __restrict__ scale, int gtid, int gthreads) {
    const int total = Nd * K;
    for (int idx = gtid; idx < total; idx += gthreads) {
        const int n = idx / K, k = idx - n * K;
        const int m = (MAP == 1) ? map_win(n) : (MAP == 2 ? map_gu(n) : n);
        float v = 0.f;
        if (m >= 0) { v = src[(size_t)k * Ns + m]; if (scale) v *= scale[k]; }
        dst[idx] = f2bf(v);
    }
}
template <int MAP> DI void tconv_tiled(const float* __restrict__ src, bf16_t* __restrict__ dst, int E, int K, int N, float* ldsf, int bid, int G) {
    const int tk = K / 64, tn = N / 64, per = tk * tn, total = E * per;
    const int t = threadIdx.x;
    for (int tile = bid; tile < total; tile += G) {
        const int e = tile / per, r = tile - e * per, kt = r / tn, nt = r - kt * tn;
        const float* s = src + (size_t)e * K * N + (size_t)(kt * 64) * N;
        __syncthreads();
        {
            const int nl = t & 63, n = nt * 64 + nl;
            const int m = (MAP == 2) ? map_gu(n) : n;
#pragma unroll
            for (int i = 0; i < 16; ++i) { const int kl = (t >> 6) + 4 * i; ldsf[kl * 65 + nl] = s[(size_t)kl * N + m]; }
        }
        __syncthreads();
        {
            const int nl = t >> 2, kc = (t & 3) * 16;
            unsigned w[8];
#pragma unroll
            for (int i = 0; i < 8; ++i) w[i] = pk2(ldsf[(kc + 2 * i) * 65 + nl], ldsf[(kc + 2 * i + 1) * 65 + nl]);
            bf16_t* d = dst + (size_t)e * K * N + (size_t)(nt * 64 + nl) * K + kt * 64 + kc;
            *(u32x4*)(d) = mk4(w[0], w[1], w[2], w[3]);
            *(u32x4*)(d + 8) = mk4(w[4], w[5], w[6], w[7]);
        }
    }
}

DI void phase0(const Params& p, unsigned char* lds, int bid, int G) {
    const int t = threadIdx.x;
    float* ldsf = (float*)lds;
    for (int item = bid; item < 384; item += G) {
        __syncthreads();
        for (int i = t; i < NB * DM; i += 256) { const float v = p.c[i]; ldsf[(i & (DM - 1)) * NB + (i >> 10)] = v * sigmoidf_(v); }
        __syncthreads();
        const int col = item * 16 + (t & 15), kp = t >> 4;
        float a[NB];
#pragma unroll
        for (int b = 0; b < NB; ++b) a[b] = 0.f;
#pragma unroll 1
        for (int k0 = kp * 64; k0 < kp * 64 + 64; k0 += 8) {
            float w[8];
#pragma unroll
            for (int u = 0; u < 8; ++u) w[u] = p.ada_w[(size_t)(k0 + u) * 6144 + col];
#pragma unroll
            for (int u = 0; u < 8; ++u) {
#pragma unroll
                for (int q = 0; q < 4; ++q) { const f32x4 cv = *(const f32x4*)(ldsf + (k0 + u) * NB + 4 * q); a[4 * q] += cv[0] * w[u]; a[4 * q + 1] += cv[1] * w[u]; a[4 * q + 2] += cv[2] * w[u]; a[4 * q + 3] += cv[3] * w[u]; }
            }
        }
        __syncthreads();
#pragma unroll
        for (int b = 0; b < NB; ++b) ldsf[(kp * NB + b) * 16 + (t & 15)] = a[b];
        __syncthreads();
        {
            const int b = t >> 4, cl = t & 15; float sacc = 0.f;
#pragma unroll
            for (int q = 0; q < 16; ++q) sacc += ldsf[(q * NB + b) * 16 + cl];
            p.mod[b * 6144 + item * 16 + cl] = sacc + p.ada_b[item * 16 + cl];
        }
    }
    __syncthreads();
    const int gtid = bid * 256 + t, gth = G * 256;
    tconv_simple<1>(p.w_in, p.win_t, 1024, 2112, LDU, nullptr, gtid, gth);
    tconv_simple<0>(p.w_q_b, p.wq_t, 256, 768, 768, p.q_a_norm, gtid, gth);
    tconv_simple<0>(p.w_kv_b, p.wkv_t, 128, 1024, 1024, p.kv_a_norm, gtid, gth);
    tconv_simple<0>(p.decay_up, p.wdec_t, 32, 512, 512, nullptr, gtid, gth);
    tconv_simple<0>(p.iclr_up, p.wiclr_t, 32, 512, 512, nullptr, gtid, gth);
    tconv_simple<0>(p.gate_up, p.wgate_t, 96, 512, 512, nullptr, gtid, gth);
    tconv_simple<0>(p.w_out, p.wout_t, 1024, 1024, 1024, nullptr, gtid, gth);
    tconv_simple<0>(p.w_router, p.wr_t, 1024, 256, 256, nullptr, gtid, gth);
    tconv_simple<2>(p.w_sh_gu, p.wsgu_t, 1024, 512, 512, nullptr, gtid, gth);
    tconv_simple<0>(p.w_sh_d, p.wsd_t, 256, 1024, 1024, nullptr, gtid, gth);
    tconv_tiled<2>(p.w_e_gu, p.wegu_t, NEXP, 1024, 512, ldsf, bid, G);
    tconv_tiled<0>(p.w_e_d, p.wed_t, NEXP, 256, 1024, ldsf, bid, G);
}

DI void phase1(const Params& p, int bid, int G) {
    const int lane = threadIdx.x & 63, gw = bid * 4 + (threadIdx.x >> 6), nw = G * 4;
    for (int row = gw; row < NTOK; row += nw) {
        const int b = row >> 12;
        const float* xr = p.x + (size_t)row * DM;
        f32x4 v[4]; float ss = 0.f;
#pragma unroll
        for (int i = 0; i < 4; ++i) { v[i] = *(const f32x4*)(xr + lane * 4 + 256 * i); ss += v[i][0] * v[i][0] + v[i][1] * v[i][1] + v[i][2] * v[i][2] + v[i][3] * v[i][3]; }
        ss = wave_sum(ss);
        const float rs = rsqrtf(ss * (1.0f / DM) + 1e-6f);
        const float* mod = p.mod + b * 6144;
#pragma unroll
        for (int i = 0; i < 4; ++i) {
            const int c = lane * 4 + 256 * i;
            const f32x4 g = *(const f32x4*)(p.norm_mix + c), sh = *(const f32x4*)(mod + c), sc = *(const f32x4*)(mod + 1024 + c);
            float o[4];
#pragma unroll
            for (int e = 0; e < 4; ++e) o[e] = v[i][e] * rs * g[e] * (1.0f + sc[e]) + sh[e];
            *(u32x2*)(p.H + (size_t)row * DM + c) = mk2(pk2(o[0], o[1]), pk2(o[2], o[3]));
        }
    }
    const double inv = exp(-(double)(lane & 15) * (9.210340371976184 / 16.0));
    for (int idx = gw * 64 + lane; idx < NTOK * 16; idx += nw * 64) {
        const int row = idx >> 4;
        const double ang = (double)p.positions[row] * inv;
        p.rope[(size_t)row * 32 + (lane & 15)] = (float)cos(ang);
        p.rope[(size_t)row * 32 + 16 + (lane & 15)] = (float)sin(ang);
    }
}

DI void phase2(const Params& p, unsigned char* lds, int bid, int G) {
    constexpr int NCT = LDU / 128;
    const int t = threadIdx.x, lane = t & 63, wid = t >> 6, wr = wid >> 1, wc = wid & 1;
    const int total = (NTOK / 128) * NCT;
    for (int L = bid; L < total; L += G) {
        const int xcd = L & 7, j = L >> 3, rt = 8 * (j / NCT) + xcd, ct = j % NCT;
        f32x4 acc[4][4];
        APlain ap{p.H + (size_t)rt * 128 * DM, DM};
        gemm_core<4, 64>(ap, p.win_t + (size_t)ct * 128 * DM, DM, DM, acc, lds);
        bf16_t* tile = (bf16_t*)lds;
#pragma unroll
        for (int i = 0; i < 4; ++i)
#pragma unroll
            for (int jj = 0; jj < 4; ++jj) {
                const int row = wr * 64 + i * 16 + (lane & 15), col = wc * 64 + jj * 16 + (lane >> 4) * 4;
                *(u32x2*)(tile + row * 136 + col) = mk2(pk2(acc[i][jj][0], acc[i][jj][1]), pk2(acc[i][jj][2], acc[i][jj][3]));
            }
        __syncthreads();
#pragma unroll
        for (int i = 0; i < 8; ++i) {
            const int c = t + 256 * i, row = c >> 4, chn = c & 15;
            *(u32x4*)(p.U + (size_t)(rt * 128 + row) * LDU + ct * 128 + chn * 8) = *(const u32x4*)(tile + row * 136 + chn * 8);
        }
    }
}

DI void unpack8(const u32x4 w, float (&f)[8]) { f[0] = lo2f(w.x); f[1] = hi2f(w.x); f[2] = lo2f(w.y); f[3] = hi2f(w.y); f[4] = lo2f(w.z); f[5] = hi2f(w.z); f[6] = lo2f(w.w); f[7] = hi2f(w.w); }
DI f32x4 unpack4(const u32x2 w) { return (f32x4){lo2f(w.x), hi2f(w.x), lo2f(w.y), hi2f(w.y)}; }
DI u32x2 pack4(const f32x4 v) { return mk2(pk2(v[0], v[1]), pk2(v[2], v[3])); }
DI f32x4 shifted4(const bf16_t* __restrict__ up, const bool has_prev, const f32x4 mu) {
    const f32x4 cur = unpack4(*(const u32x2*)up);
    f32x4 prev = (f32x4){0.f, 0.f, 0.f, 0.f};
    if (has_prev) prev = unpack4(*(const u32x2*)(up - LDU));
    return cur + (prev - cur) * mu;
}
DI void head96_finish(f32x4 (&v)[6], const int q, const float* __restrict__ gain, const float* __restrict__ ropeRow, const float scale, bf16_t* __restrict__ dstRow) {
    float ss = 0.f;
#pragma unroll
    for (int j = 0; j < 6; ++j) ss += v[j][0] * v[j][0] + v[j][1] * v[j][1] + v[j][2] * v[j][2] + v[j][3] * v[j][3];
    ss += __shfl_xor(ss, 16); ss += __shfl_xor(ss, 32);
    const float rs = rsqrtf(ss * (1.0f / 96.0f) + 1e-6f);
#pragma unroll
    for (int j = 0; j < 6; ++j) v[j] = v[j] * rs * *(const f32x4*)(gain + j * 16 + q * 4);
    const f32x4 cs = *(const f32x4*)(ropeRow + q * 4), sn = *(const f32x4*)(ropeRow + 16 + q * 4);
    const f32x4 x1 = v[4], x2 = v[5];
    v[4] = x1 * cs - x2 * sn; v[5] = x2 * cs + x1 * sn;
#pragma unroll
    for (int j = 0; j < 6; ++j) *(u32x2*)(dstRow + j * 16 + q * 4) = pack4(v[j] * scale);
}

DI void phase3(const Params& p, unsigned char* lds, int bid, int G) {
    const int t = threadIdx.x;
    float* rstd_q = (float*)(lds + 69632);
    float* rstd_kv = rstd_q + 128;
    bf16_t* lora = (bf16_t*)(p.bscr + (size_t)bid * BSCR_PER_BLOCK + 131072);
    for (int rt = bid; rt < NTOK / 128; rt += G) {
        __syncthreads();
        {
            int tl = t; LAUNDER(tl);
            const int row = tl >> 1, half = tl & 1, grow = rt * 128 + row;
            const bf16_t* urow = p.U + (size_t)grow * LDU;
            float s = 0.f;
#pragma unroll
            for (int c = 0; c < 16; ++c) { float f[8]; unpack8(*(const u32x4*)(urow + UQ + half * 128 + c * 8), f);
#pragma unroll
                for (int e = 0; e < 8; ++e) s += f[e] * f[e]; }
            s += __shfl_xor(s, 1);
            float s2 = 0.f;
#pragma unroll
            for (int c = 0; c < 8; ++c) { float f[8]; unpack8(*(const u32x4*)(urow + UKV + half * 64 + c * 8), f);
#pragma unroll
                for (int e = 0; e < 8; ++e) s2 += f[e] * f[e]; }
            s2 += __shfl_xor(s2, 1);
            if (half == 0) { rstd_q[row] = rsqrtf(s * (1.0f / 256.0f) + 1e-6f); rstd_kv[row] = rsqrtf(s2 * (1.0f / 128.0f) + 1e-6f); }
        }
#pragma unroll 1
        for (int i = 0; i < 10; ++i) {
            int tl = t; LAUNDER(tl);
            const int c = tl + 256 * i, row = c / 20, chn = c - row * 20, grow = rt * 128 + row;
            const bf16_t* up = p.U + (size_t)grow * LDU + UXW + chn * 8;
            float cur[8], prv[8];
            unpack8(*(const u32x4*)up, cur);
            if ((grow & 4095) > 0) unpack8(*(const u32x4*)(up - LDU), prv);
            else {
#pragma unroll
                for (int e = 0; e < 8; ++e) prv[e] = 0.f; }
            const f32x4 m0 = *(const f32x4*)(p.rwkv_mu + 1536 + chn * 8), m1 = *(const f32x4*)(p.rwkv_mu + 1536 + chn * 8 + 4);
            float o[8];
#pragma unroll
            for (int e = 0; e < 8; ++e) {
                const float x = cur[e] + (prv[e] - cur[e]) * (e < 4 ? m0[e & 3] : m1[e & 3]);
                o[e] = chn < 4 ? tanhf(x) : (chn < 8 ? x : sigmoidf_(x));
            }
            *(u32x4*)(lora + row * 160 + chn * 8) = mk4(pk2(o[0], o[1]), pk2(o[2], o[3]), pk2(o[4], o[5]), pk2(o[6], o[7]));
        }
        asm volatile("s_waitcnt vmcnt(0)" ::: "memory");
        __syncthreads();
        STAMP(17);
        {
            APlain ap{p.U + (size_t)rt * 128 * LDU + UQ, LDU};
            gemm_stream<2, 6, 4, 64, 6>(ap, p.wq_t, 256, 256, 8, [](int u, int& ao, int& bo) { ao = 0; bo = u * 96 * 256; },
                [&](const int h, f32x4 (&acc)[2][6]) {
                    int tl = t; LAUNDER(tl);
                    const int lane = tl & 63, w = tl >> 6, r = lane & 15, q = lane >> 4;
#pragma unroll
                    for (int i = 0; i < 2; ++i) {
                        const int row = 32 * w + 16 * i + r, grow = rt * 128 + row, b = grow >> 12, tt = grow & 4095;
                        const float rq = rstd_q[row];
                        f32x4 v[6];
#pragma unroll
                        for (int j = 0; j < 6; ++j) v[j] = acc[i][j] * rq;
                        head96_finish(v, q, p.q_norm, p.rope + (size_t)grow * 32, QSCALE, p.Q + ((size_t)(b * 8 + h) * NT_ + tt) * 96);
                    }
                }, lds);
        }
        STAMP(18);
        {
            APlain ap{p.U + (size_t)rt * 128 * LDU + UKV, LDU};
            gemm_stream<2, 8, 4, 64, 4>(ap, p.wkv_t, 128, 128, 8, [](int u, int& ao, int& bo) { ao = 0; bo = u * 128 * 128; },
                [&](const int h, f32x4 (&acc)[2][8]) {
                    int tl = t; LAUNDER(tl);
                    const int lane = tl & 63, w = tl >> 6, r = lane & 15, q = lane >> 4;
#pragma unroll
                    for (int i = 0; i < 2; ++i) {
                        const int row = 32 * w + 16 * i + r, grow = rt * 128 + row, b = grow >> 12, tt = grow & 4095;
                        const float rk = rstd_kv[row];
                        const bf16_t* urow = p.U + (size_t)grow * LDU;
                        f32x4 v[6];
#pragma unroll
                        for (int j = 0; j < 4; ++j) v[j] = acc[i][j] * rk;
                        v[4] = unpack4(*(const u32x2*)(urow + UPE + q * 4));
                        v[5] = unpack4(*(const u32x2*)(urow + UPE + 16 + q * 4));
                        head96_finish(v, q, p.k_norm, p.rope + (size_t)grow * 32, 1.0f, p.Kb + ((size_t)(b * 8 + h) * NT_ + tt) * 96);
                        const int tok0 = 32 * w + 16 * i + 4 * q;
                        const f32x4 rk4 = *(const f32x4*)(rstd_kv + tok0);
                        bf16_t* vd = p.Vt + ((size_t)((rt >> 5) * 8 + h) * 64) * NT_ + (rt & 31) * 128 + tok0;
#pragma unroll
                        for (int j = 4; j < 8; ++j) *(u32x2*)(vd + (size_t)((j - 4) * 16 + r) * NT_) = pack4(acc[i][j] * rk4);
                    }
                }, lds);
        }
        STAMP(19);
        bf16_t* abuf = (bf16_t*)(p.bscr + (size_t)bid * BSCR_PER_BLOCK);
        {
            APlain ap{lora, 160};
            gemm_stream<4, 4, 2, 32, 4>(ap, p.wdec_t, 32, 32, 4, [](int u, int& ao, int& bo) { ao = 0; bo = u * 128 * 32; },
                [&](const int ct, f32x4 (&acc)[4][4]) {
                    int tl = t; LAUNDER(tl);
                    const int lane = tl & 63, wid = tl >> 6, wr = wid >> 1, wc = wid & 1, r = lane & 15, q = lane >> 4, head = ct * 2 + wc;
#pragma unroll
                    for (int i = 0; i < 4; ++i) {
                        const int grow = rt * 128 + wr * 64 + i * 16 + r, b = grow >> 12, tt = grow & 4095;
                        bf16_t* sc = p.SC + ((size_t)(b * 8 + head) * NT_ + tt) * 384 + q * 4;
#pragma unroll
                        for (int j = 0; j < 4; ++j) {
                            const f32x4 w0 = *(const f32x4*)(p.decay_w0 + head * 64 + j * 16 + q * 4);
                            f32x4 o;
#pragma unroll
                            for (int e = 0; e < 4; ++e) o[e] = 1.0f - __expf(-0.6065306597f * sigmoidf_(w0[e] + acc[i][j][e]));
                            *(u32x2*)(sc + j * 16) = pack4(o);
                        }
                    }
                }, lds);
        }
        {
            APlain ap{lora + 32, 160};
            gemm_stream<4, 4, 2, 32, 4>(ap, p.wiclr_t, 32, 32, 4, [](int u, int& ao, int& bo) { ao = 0; bo = u * 128 * 32; },
                [&](const int ct, f32x4 (&acc)[4][4]) {
                    int tl = t; LAUNDER(tl);
                    const int lane = tl & 63, wid = tl >> 6, wr = wid >> 1, wc = wid & 1, r = lane & 15, q = lane >> 4, c0 = ct * 128 + wc * 64 + q * 4;
#pragma unroll
                    for (int i = 0; i < 4; ++i) {
                        bf16_t* ar = abuf + (wr * 64 + i * 16 + r) * 512 + c0;
#pragma unroll
                        for (int j = 0; j < 4; ++j) {
                            const f32x4 a0 = *(const f32x4*)(p.iclr_a0 + c0 + j * 16);
                            f32x4 o;
#pragma unroll
                            for (int e = 0; e < 4; ++e) o[e] = sigmoidf_(a0[e] + acc[i][j][e]);
                            *(u32x2*)(ar + j * 16) = pack4(o);
                        }
                    }
                }, lds);
        }
        {
            APlain ap{lora + 64, 160};
            gemm_stream<4, 4, 2, 32, 4>(ap, p.wgate_t, 96, 96, 4, [](int u, int& ao, int& bo) { ao = 0; bo = u * 128 * 96; },
                [&](const int ct, f32x4 (&acc)[4][4]) {
                    int tl = t; LAUNDER(tl);
                    const int lane = tl & 63, wid = tl >> 6, wr = wid >> 1, wc = wid & 1, r = lane & 15, q = lane >> 4, head = ct * 2 + wc;
#pragma unroll
                    for (int i = 0; i < 4; ++i) {
                        const int grow = rt * 128 + wr * 64 + i * 16 + r;
                        bf16_t* g = p.Gg + (size_t)grow * 512 + head * 64 + q * 4;
#pragma unroll
                        for (int j = 0; j < 4; ++j) *(u32x2*)(g + j * 16) = pack4(acc[i][j]);
                    }
                }, lds);
        }
        asm volatile("s_waitcnt vmcnt(0)" ::: "memory");
        __syncthreads();
#pragma unroll 1
        for (int it = 0; it < 16; ++it) {
            int tl = t; LAUNDER(tl);
            const int lane = tl & 63, w = tl >> 6, c8 = lane * 8;
#pragma unroll
            for (int u = 0; u < 2; ++u) {
                const int row = w + 4 * (it * 2 + u), grow = rt * 128 + row, b = grow >> 12, tt = grow & 4095;
                const bool hp = tt > 0;
                const bf16_t* urow = p.U + (size_t)grow * LDU + c8;
                float kc[8], kp_[8], vc[8], vp[8], rc[8], rp[8], av[8];
                unpack8(*(const u32x4*)(urow + UK), kc); unpack8(*(const u32x4*)(urow + UV), vc); unpack8(*(const u32x4*)(urow + UR), rc);
                unpack8(*(const u32x4*)(abuf + row * 512 + c8), av);
                if (hp) { unpack8(*(const u32x4*)(urow + UK - LDU), kp_); unpack8(*(const u32x4*)(urow + UV - LDU), vp); unpack8(*(const u32x4*)(urow + UR - LDU), rp); }
                else {
#pragma unroll
                    for (int e = 0; e < 8; ++e) { kp_[e] = 0.f; vp[e] = 0.f; rp[e] = 0.f; } }
                float mk[8], mv[8], mr[8], kkw[8], kaw[8];
                *(f32x4*)(mk) = *(const f32x4*)(p.rwkv_mu + 512 + c8); *(f32x4*)(mk + 4) = *(const f32x4*)(p.rwkv_mu + 512 + c8 + 4);
                *(f32x4*)(mv) = *(const f32x4*)(p.rwkv_mu + 1024 + c8); *(f32x4*)(mv + 4) = *(const f32x4*)(p.rwkv_mu + 1024 + c8 + 4);
                *(f32x4*)(mr) = *(const f32x4*)(p.rwkv_mu + c8); *(f32x4*)(mr + 4) = *(const f32x4*)(p.rwkv_mu + c8 + 4);
                *(f32x4*)(kkw) = *(const f32x4*)(p.k_k + c8); *(f32x4*)(kkw + 4) = *(const f32x4*)(p.k_k + c8 + 4);
                *(f32x4*)(kaw) = *(const f32x4*)(p.k_a + c8); *(f32x4*)(kaw + 4) = *(const f32x4*)(p.k_a + c8 + 4);
                float ks[8], kq[8], ssq = 0.f;
#pragma unroll
                for (int e = 0; e < 8; ++e) { ks[e] = kc[e] + (kp_[e] - kc[e]) * mk[e]; kq[e] = ks[e] * kkw[e]; ssq += kq[e] * kq[e]; }
                ssq = dpp_sum8(ssq);
                const float rn = rsqrtf(fmaxf(ssq, 1e-24f));
                float okk[8], obb[8], okp[8], ov[8], orr[8];
#pragma unroll
                for (int e = 0; e < 8; ++e) {
                    okk[e] = kq[e] * rn; obb[e] = av[e] * okk[e]; okp[e] = ks[e] * (1.0f + (av[e] - 1.0f) * kaw[e]);
                    ov[e] = vc[e] + (vp[e] - vc[e]) * mv[e]; orr[e] = rc[e] + (rp[e] - rc[e]) * mr[e];
                }
                bf16_t* sc = p.SC + ((size_t)(b * 8 + (lane >> 3)) * NT_ + tt) * 384 + (lane & 7) * 8;
                *(u32x4*)(sc + 64) = mk4(pk2(okk[0], okk[1]), pk2(okk[2], okk[3]), pk2(okk[4], okk[5]), pk2(okk[6], okk[7]));
                *(u32x4*)(sc + 128) = mk4(pk2(obb[0], obb[1]), pk2(obb[2], obb[3]), pk2(obb[4], obb[5]), pk2(obb[6], obb[7]));
                *(u32x4*)(sc + 192) = mk4(pk2(okp[0], okp[1]), pk2(okp[2], okp[3]), pk2(okp[4], okp[5]), pk2(okp[6], okp[7]));
                *(u32x4*)(sc + 256) = mk4(pk2(ov[0], ov[1]), pk2(ov[2], ov[3]), pk2(ov[4], ov[5]), pk2(ov[6], ov[7]));
                *(u32x4*)(sc + 320) = mk4(pk2(orr[0], orr[1]), pk2(orr[2], orr[3]), pk2(orr[4], orr[5]), pk2(orr[6], orr[7]));
            }
        }
    }
}

struct ScanOps { f32x2_t d[4], k[4], b[4], p[4], r[4]; float v; };
DI void scan_load(ScanOps& o, const float* __restrict__ q, const float* __restrict__ vp) {
    const f32x4 d0 = *(const f32x4*)(q), d1 = *(const f32x4*)(q + 4), k0 = *(const f32x4*)(q + 64), k1 = *(const f32x4*)(q + 68);
    const f32x4 b0 = *(const f32x4*)(q + 128), b1 = *(const f32x4*)(q + 132), p0 = *(const f32x4*)(q + 192), p1 = *(const f32x4*)(q + 196);
    const f32x4 r0 = *(const f32x4*)(q + 320), r1 = *(const f32x4*)(q + 324);
    o.d[0] = (f32x2_t){d0[0], d0[1]}; o.d[1] = (f32x2_t){d0[2], d0[3]}; o.d[2] = (f32x2_t){d1[0], d1[1]}; o.d[3] = (f32x2_t){d1[2], d1[3]};
    o.k[0] = (f32x2_t){k0[0], k0[1]}; o.k[1] = (f32x2_t){k0[2], k0[3]}; o.k[2] = (f32x2_t){k1[0], k1[1]}; o.k[3] = (f32x2_t){k1[2], k1[3]};
    o.b[0] = (f32x2_t){b0[0], b0[1]}; o.b[1] = (f32x2_t){b0[2], b0[3]}; o.b[2] = (f32x2_t){b1[0], b1[1]}; o.b[3] = (f32x2_t){b1[2], b1[3]};
    o.p[0] = (f32x2_t){p0[0], p0[1]}; o.p[1] = (f32x2_t){p0[2], p0[3]}; o.p[2] = (f32x2_t){p1[0], p1[1]}; o.p[3] = (f32x2_t){p1[2], p1[3]};
    o.r[0] = (f32x2_t){r0[0], r0[1]}; o.r[1] = (f32x2_t){r0[2], r0[3]}; o.r[2] = (f32x2_t){r1[0], r1[1]}; o.r[3] = (f32x2_t){r1[2], r1[3]};
    o.v = *vp;
}
DI void scan_task(const Params& p, unsigned char* lds, const int task) {
    constexpr int CS = 16;
    const int t = threadIdx.x, lane = t & 63, w = t >> 6;
    const int bh = task >> 1, hf = task & 1, b = bh >> 3, head = bh & 7;
    const int rloc = w * 8 + (lane >> 3), kseg = lane & 7;
    const int vrow = hf * 32 + rloc;
    float* stage = (float*)lds;
    float* ybuf = (float*)(lds + 49152);
    const bf16_t* src = p.SC + (size_t)bh * NT_ * 384;
    f32x2_t s2[4];
#pragma unroll
    for (int j = 0; j < 4; ++j) s2[j] = (f32x2_t){0.f, 0.f};
    u32x4 rg[3];
    __builtin_amdgcn_s_setprio(3);
    __syncthreads();
#pragma unroll
    for (int i = 0; i < 3; ++i) rg[i] = *(const u32x4*)(src + (size_t)(t + 256 * i) * 8);
#pragma unroll
    for (int i = 0; i < 3; ++i) { float* d = stage + (t + 256 * i) * 8;
        *(f32x4*)d = (f32x4){lo2f(rg[i].x), hi2f(rg[i].x), lo2f(rg[i].y), hi2f(rg[i].y)}; *(f32x4*)(d + 4) = (f32x4){lo2f(rg[i].z), hi2f(rg[i].z), lo2f(rg[i].w), hi2f(rg[i].w)}; }
    __syncthreads();
    constexpr int NCH = NT_ / CS;
    for (int c = 0; c < NCH; ++c) {
        const int cur = c & 1;
        if (c + 1 < NCH) {
#pragma unroll
            for (int i = 0; i < 3; ++i) rg[i] = *(const u32x4*)(src + (size_t)(c + 1) * CS * 384 + (size_t)(t + 256 * i) * 8);
        }
        if (c > 0) {
            const float* yb = ybuf + (cur ^ 1) * CS * 32;
            const int st = t >> 4, r2 = (t & 15) * 2;
            *(f32x2_t*)(p.yraw + ((size_t)(b * NT_ + (c - 1) * CS + st)) * 512 + head * 64 + hf * 32 + r2) = *(const f32x2_t*)(yb + st * 32 + r2);
        }
        const float* sb = stage + cur * CS * 384 + kseg * 8;
        float* yb = ybuf + cur * CS * 32;
        float yv[CS];
        ScanOps oc, on;
        scan_load(oc, sb, sb + 256 - kseg * 8 + vrow);
#pragma unroll
        for (int st = 0; st < CS; ++st) {
            if (st + 1 < CS) scan_load(on, sb + (st + 1) * 384, sb + (st + 1) * 384 + 256 - kseg * 8 + vrow);
            f32x2_t t0 = s2[0] * oc.k[0], t1 = s2[1] * oc.k[1];
            t0 = s2[2] * oc.k[2] + t0; t1 = s2[3] * oc.k[3] + t1;
            t0 = t0 + t1;
            float dot = dpp_sum8(t0.x + t0.y);
            const f32x2_t vv2 = {oc.v, oc.v}, nd2 = {-dot, -dot};
            f32x2_t u0, u1;
#pragma unroll
            for (int j = 0; j < 4; ++j) { f32x2_t tmp = s2[j] - s2[j] * oc.d[j]; tmp = vv2 * oc.p[j] + tmp; s2[j] = nd2 * oc.b[j] + tmp; }
            u0 = s2[0] * oc.r[0]; u1 = s2[1] * oc.r[1];
            u0 = s2[2] * oc.r[2] + u0; u1 = s2[3] * oc.r[3] + u1;
            u0 = u0 + u1;
            yv[st] = dpp_sum8(u0.x + u0.y);
            if (st + 1 < CS) oc = on;
        }
        if (kseg == 0) {
#pragma unroll
            for (int st = 0; st < CS; ++st) yb[st * 32 + rloc] = yv[st];
        }
        if (c + 1 < NCH) {
            float* dbase = stage + (cur ^ 1) * CS * 384;
#pragma unroll
            for (int i = 0; i < 3; ++i) { float* d = dbase + (t + 256 * i) * 8;
                *(f32x4*)d = (f32x4){lo2f(rg[i].x), hi2f(rg[i].x), lo2f(rg[i].y), hi2f(rg[i].y)}; *(f32x4*)(d + 4) = (f32x4){lo2f(rg[i].z), hi2f(rg[i].z), lo2f(rg[i].w), hi2f(rg[i].w)}; }
        }
        __syncthreads();
    }
    {
        const float* yb = ybuf + ((NCH - 1) & 1) * CS * 32;
        const int st = t >> 4, r2 = (t & 15) * 2;
        *(f32x2_t*)(p.yraw + ((size_t)(b * NT_ + (NCH - 1) * CS + st)) * 512 + head * 64 + hf * 32 + r2) = *(const f32x2_t*)(yb + st * 32 + r2);
    }
    __builtin_amdgcn_s_setprio(0);
}

DI void attn_item(const Params& p, unsigned char* lds, const int item) {
    constexpr int KROW = 208, VROW = 136, KB = 64 * KROW, BUF = KB + 64 * VROW;
    const int t = threadIdx.x, lane = t & 63, w = t >> 6, l31 = lane & 31, h = lane >> 5;
    const int qt = 31 - item / 128, bh = item % 128;
    const bf16_t* Kg = p.Kb + (size_t)bh * NT_ * 96;
    const bf16_t* Vg = p.Vt + (size_t)bh * 64 * NT_;
    const int q = qt * 128 + w * 32 + l31;
    bf16x8 qf[6];
    {
        const bf16_t* qrow = p.Q + ((size_t)bh * NT_ + q) * 96 + 8 * h;
#pragma unroll
        for (int s = 0; s < 6; ++s) qf[s] = *(const bf16x8*)(qrow + 16 * s);
    }
    f32x16 O[2];
#pragma unroll
    for (int i = 0; i < 16; ++i) { O[0][i] = 0.f; O[1][i] = 0.f; }
    float m = -INFINITY, l = 0.f;
    const int njt = 2 * qt + 2;
    int koff[3], kgo[3], voff[2], vgo[2];
#pragma unroll
    for (int i = 0; i < 3; ++i) { const int c = t + 256 * i, r = c / 12, ch = c - r * 12; koff[i] = r * KROW + ch * 16; kgo[i] = r * 96 + ch * 8; }
#pragma unroll
    for (int i = 0; i < 2; ++i) { const int c = t + 256 * i, dv = c >> 3, ch = c & 7; voff[i] = KB + dv * VROW + ch * 16; vgo[i] = dv * NT_ + ch * 8; }
    u32x4 rk0[3], rv0[2], rk1[3], rv1[2];
#define AT_LOAD(RK, RV, J) { _Pragma("unroll") for (int i = 0; i < 3; ++i) RK[i] = *(const u32x4*)(Kg + (size_t)(J) * 64 * 96 + kgo[i]); \
                             _Pragma("unroll") for (int i = 0; i < 2; ++i) RV[i] = *(const u32x4*)(Vg + (J) * 64 + vgo[i]); }
#define AT_WRITE(RK, RV, BUFI) { unsigned char* nb = lds + (BUFI) * BUF; _Pragma("unroll") for (int i = 0; i < 3; ++i) *(u32x4*)(nb + koff[i]) = RK[i]; \
                             _Pragma("unroll") for (int i = 0; i < 2; ++i) { *(u32x2*)(nb + voff[i]) = mk2(RV[i].x, RV[i].y); *(u32x2*)(nb + voff[i] + 8) = mk2(RV[i].z, RV[i].w); } }
    auto tile_compute = [&](const int cur, const int j) {
        const bool active = (j * 64) <= (qt * 128 + w * 32 + 31);
        if (active) {
            const unsigned char* Kt = lds + cur * BUF;
            const unsigned char* Vtile = Kt + KB;
            f32x16 S[2];
#pragma unroll
            for (int k2 = 0; k2 < 2; ++k2) {
#pragma unroll
                for (int i = 0; i < 16; ++i) S[k2][i] = 0.f;
#pragma unroll
                for (int s = 0; s < 6; ++s) {
                    const bf16x8 kf = *(const bf16x8*)(Kt + (k2 * 32 + l31) * KROW + s * 32 + h * 16);
                    S[k2] = __builtin_amdgcn_mfma_f32_32x32x16_bf16(kf, qf[s], S[k2], 0, 0, 0);
                }
            }
            if (j >= 2 * qt) {
#pragma unroll
                for (int k2 = 0; k2 < 2; ++k2)
#pragma unroll
                    for (int i = 0; i < 16; ++i) { const int key = j * 64 + k2 * 32 + (i & 3) + 8 * (i >> 2) + 4 * h; if (key > q) S[k2][i] = -INFINITY; }
            }
            float mx = S[0][0];
#pragma unroll
            for (int i = 1; i < 16; ++i) mx = fmaxf(mx, S[0][i]);
#pragma unroll
            for (int i = 0; i < 16; ++i) mx = fmaxf(mx, S[1][i]);
            mx = fmaxf(mx, __shfl_xor(mx, 32));
            if (__any(mx > m)) {
                const float mn = fmaxf(m, mx);
                const float alpha = __builtin_amdgcn_exp2f(m - mn);
                m = mn; l *= alpha;
#pragma unroll
                for (int i = 0; i < 16; ++i) { O[0][i] *= alpha; O[1][i] *= alpha; }
            }
            f32x2_t ps2 = {0.f, 0.f};
#pragma unroll
            for (int k2 = 0; k2 < 2; ++k2)
#pragma unroll
                for (int i = 0; i < 16; i += 2) {
                    const float e0 = __builtin_amdgcn_exp2f(S[k2][i] - m), e1 = __builtin_amdgcn_exp2f(S[k2][i + 1] - m);
                    S[k2][i] = e0; S[k2][i + 1] = e1; ps2 += (f32x2_t){e0, e1};
                }
            l += ps2.x + ps2.y;
#pragma unroll
            for (int k2 = 0; k2 < 2; ++k2)
#pragma unroll
                for (int s2 = 0; s2 < 2; ++s2) {
                    unsigned pw[4];
#pragma unroll
                    for (int e = 0; e < 4; ++e) pw[e] = pk2(S[k2][8 * s2 + 2 * e], S[k2][8 * s2 + 2 * e + 1]);
                    const bf16x8 pf = __builtin_bit_cast(bf16x8, mk4(pw[0], pw[1], pw[2], pw[3]));
#pragma unroll
                    for (int dt = 0; dt < 2; ++dt) {
                        const unsigned char* vp = Vtile + (dt * 32 + l31) * VROW + (k2 * 32 + s2 * 16 + 4 * h) * 2;
                        const u32x2 v0 = *(const u32x2*)(vp), v1 = *(const u32x2*)(vp + 16);
                        const bf16x8 vf = __builtin_bit_cast(bf16x8, mk4(v0.x, v0.y, v1.x, v1.y));
                        O[dt] = __builtin_amdgcn_mfma_f32_32x32x16_bf16(vf, pf, O[dt], 0, 0, 0);
                    }
                }
        }
    };
    AT_LOAD(rk0, rv0, 0)
    if (njt > 1) AT_LOAD(rk1, rv1, 1)
    __syncthreads();
    AT_WRITE(rk0, rv0, 0)
    if (njt > 2) AT_LOAD(rk0, rv0, 2)
    __syncthreads();
#pragma unroll 1
    for (int j = 0; j < njt; j += 2) {
        tile_compute(0, j);
        if (j + 1 < njt) { AT_WRITE(rk1, rv1, 1) if (j + 3 < njt) AT_LOAD(rk1, rv1, j + 3) }
        __syncthreads();
        if (j + 1 >= njt) break;
        tile_compute(1, j + 1);
        if (j + 2 < njt) { AT_WRITE(rk0, rv0, 0) if (j + 4 < njt) AT_LOAD(rk0, rv0, j + 4) }
        __syncthreads();
    }
#undef AT_LOAD
#undef AT_WRITE
    l += __shfl_xor(l, 32);
    const float inv = 1.0f / l;
    bf16_t* yrow = p.Y + ((size_t)((bh >> 3) * NT_ + q)) * DM + 512 + (bh & 7) * 64;
#pragma unroll
    for (int dt = 0; dt < 2; ++dt)
#pragma unroll
        for (int g = 0; g < 4; ++g)
            *(u32x2*)(yrow + dt * 32 + 8 * g + 4 * h) = mk2(pk2(O[dt][4 * g] * inv, O[dt][4 * g + 1] * inv), pk2(O[dt][4 * g + 2] * inv, O[dt][4 * g + 3] * inv));
}

DI void phase4(const Params& p, unsigned char* lds, int bid, int G) {
    int* sh_item = (int*)(lds + LDS_BYTES - 64);
    for (int task = bid; task < 256; task += G) scan_task(p, lds, task);
    STAMP(10);
    for (;;) {
        __syncthreads();
        if (threadIdx.x == 0) *sh_item = (int)atomicAdd(&p.ctrl[CTRL_ATTNQ], 1u);
        __syncthreads();
        const int item = *sh_item;
        if (item >= 4096) break;
        attn_item(p, lds, item);
    }
}

DI void phase5(const Params& p, unsigned char* lds, int bid, int G) {
    const int t = threadIdx.x, lane = t & 63, wid = t >> 6, wr = wid >> 1, wc = wid & 1;
    float* tile = (float*)lds;
    float* ssq = (float*)(lds + 69632);
    float* biasl = ssq + 128;
    int* lcnt = (int*)(lds + 65536);
    int* lbase = lcnt + 256;
    unsigned char* le = (unsigned char*)(lbase + 256);
    unsigned char* lp = le + 1024;
    __syncthreads();
    biasl[t] = p.router_bias[t];
    float* scores = (float*)(p.bscr + (size_t)bid * BSCR_PER_BLOCK);
    bf16_t* act = (bf16_t*)(p.bscr + (size_t)bid * BSCR_PER_BLOCK + 131072);
    for (int rt = bid; rt < NTOK / 128; rt += G) {
        const int b = rt >> 5;
        const float* mod = p.mod + b * 6144;
        __syncthreads();
        if (t < 128) ssq[t] = 0.f;
        lcnt[t] = 0;
#pragma unroll 2
        for (int it = 0; it < 16; ++it) {
            int tl = t; LAUNDER(tl);
            const int pr = (tl >> 2) + 64 * it;
            const int row = pr >> 3, head = pr & 7, part = tl & 3, grow = rt * 128 + row, tt = grow & 4095;
            const int ch = head * 64 + part * 16;
            const float* yr = p.yraw + (size_t)grow * 512 + ch;
            float y[16];
#pragma unroll
            for (int i = 0; i < 4; ++i) { const f32x4 v = *(const f32x4*)(yr + 4 * i); y[4 * i] = v[0]; y[4 * i + 1] = v[1]; y[4 * i + 2] = v[2]; y[4 * i + 3] = v[3]; }
            float sm = 0.f;
#pragma unroll
            for (int i = 0; i < 16; ++i) sm += y[i];
            sm += __shfl_xor(sm, 1); sm += __shfl_xor(sm, 2);
            const float mean = sm * (1.0f / 64.0f);
            float vr = 0.f;
#pragma unroll
            for (int i = 0; i < 16; ++i) { const float d = y[i] - mean; vr += d * d; }
            vr += __shfl_xor(vr, 1); vr += __shfl_xor(vr, 2);
            const float rs = rsqrtf(vr * (1.0f / 64.0f) + 64e-5f);
            const bf16_t* sc = p.SC + ((size_t)(b * 8 + head) * NT_ + tt) * 384 + part * 16;
            float kp[16], vv[16], rr[16];
#pragma unroll
            for (int i = 0; i < 2; ++i) {
                const u32x4 a = *(const u32x4*)(sc + 192 + 8 * i), c = *(const u32x4*)(sc + 256 + 8 * i), d = *(const u32x4*)(sc + 320 + 8 * i);
                kp[8 * i] = lo2f(a.x); kp[8 * i + 1] = hi2f(a.x); kp[8 * i + 2] = lo2f(a.y); kp[8 * i + 3] = hi2f(a.y); kp[8 * i + 4] = lo2f(a.z); kp[8 * i + 5] = hi2f(a.z); kp[8 * i + 6] = lo2f(a.w); kp[8 * i + 7] = hi2f(a.w);
                vv[8 * i] = lo2f(c.x); vv[8 * i + 1] = hi2f(c.x); vv[8 * i + 2] = lo2f(c.y); vv[8 * i + 3] = hi2f(c.y); vv[8 * i + 4] = lo2f(c.z); vv[8 * i + 5] = hi2f(c.z); vv[8 * i + 6] = lo2f(c.w); vv[8 * i + 7] = hi2f(c.w);
                rr[8 * i] = lo2f(d.x); rr[8 * i + 1] = hi2f(d.x); rr[8 * i + 2] = lo2f(d.y); rr[8 * i + 3] = hi2f(d.y); rr[8 * i + 4] = lo2f(d.z); rr[8 * i + 5] = hi2f(d.z); rr[8 * i + 6] = lo2f(d.w); rr[8 * i + 7] = hi2f(d.w);
            }
            float bn = 0.f;
#pragma unroll
            for (int i = 0; i < 16; ++i) bn += rr[i] * kp[i] * p.r_k[ch + i];
            bn += __shfl_xor(bn, 1); bn += __shfl_xor(bn, 2);
            const bf16_t* gg = p.Gg + (size_t)grow * 512 + ch;
            const u32x4 g0 = *(const u32x4*)(gg), g1 = *(const u32x4*)(gg + 8);
            float g[16] = {lo2f(g0.x), hi2f(g0.x), lo2f(g0.y), hi2f(g0.y), lo2f(g0.z), hi2f(g0.z), lo2f(g0.w), hi2f(g0.w), lo2f(g1.x), hi2f(g1.x), lo2f(g1.y), hi2f(g1.y), lo2f(g1.z), hi2f(g1.z), lo2f(g1.w), hi2f(g1.w)};
            float o[16];
#pragma unroll
            for (int i = 0; i < 16; ++i) o[i] = ((y[i] - mean) * rs * p.ln_w[ch + i] + p.ln_b[ch + i] + bn * vv[i]) * g[i];
            bf16_t* yd = p.Y + (size_t)grow * DM + ch;
            *(u32x4*)(yd) = mk4(pk2(o[0], o[1]), pk2(o[2], o[3]), pk2(o[4], o[5]), pk2(o[6], o[7]));
            *(u32x4*)(yd + 8) = mk4(pk2(o[8], o[9]), pk2(o[10], o[11]), pk2(o[12], o[13]), pk2(o[14], o[15]));
        }
        asm volatile("s_waitcnt vmcnt(0)" ::: "memory");
        __syncthreads();
        STAMP(11);
        {
            APlain ap{p.Y + (size_t)rt * 128 * DM, DM};
            gemm_stream<4, 4, 2, 64, 4>(ap, p.wout_t, DM, DM, 8, [](int u, int& ao, int& bo) { ao = 0; bo = u * 128 * DM; },
                [&](const int ct, f32x4 (&acc)[4][4]) {
                    int ll = lane; LAUNDER(ll);
#pragma unroll
                    for (int i = 0; i < 4; ++i) {
                        const int row = wr * 64 + i * 16 + (ll & 15), grow = rt * 128 + row;
                        float sq = 0.f;
#pragma unroll
                        for (int j = 0; j < 4; ++j) {
                            const int col = ct * 128 + wc * 64 + j * 16 + (ll >> 4) * 4;
                            const f32x4 xv = *(const f32x4*)(p.x + (size_t)grow * DM + col), ga = *(const f32x4*)(mod + 2048 + col);
                            f32x4 o;
#pragma unroll
                            for (int e = 0; e < 4; ++e) { o[e] = xv[e] + ga[e] * acc[i][j][e]; sq += o[e] * o[e]; }
                            *(f32x4*)(p.out + (size_t)grow * DM + col) = o;
                        }
                        sq += __shfl_xor(sq, 16); sq += __shfl_xor(sq, 32);
                        if ((ll >> 4) == 0) atomicAdd(&ssq[row], sq);
                    }
                }, lds);
        }
        asm volatile("s_waitcnt vmcnt(0)" ::: "memory");
        __syncthreads();
        STAMP(12);
#pragma unroll 1
        for (int mg = 0; mg < 8; ++mg) {
            int ll = lane; LAUNDER(ll);
            f32x4 xv[4][4];
#pragma unroll
            for (int u = 0; u < 4; ++u)
#pragma unroll
                for (int i = 0; i < 4; ++i) xv[u][i] = *(const f32x4*)(p.out + (size_t)(rt * 128 + wid + 4 * (mg * 4 + u)) * DM + ll * 4 + 256 * i);
#pragma unroll
            for (int u = 0; u < 4; ++u) {
                const int r = wid + 4 * (mg * 4 + u), grow = rt * 128 + r;
                const float rs = rsqrtf(ssq[r] * (1.0f / DM) + 1e-6f);
#pragma unroll
                for (int i = 0; i < 4; ++i) {
                    const int c = ll * 4 + 256 * i;
                    const f32x4 g = *(const f32x4*)(p.norm_ffn + c), sh = *(const f32x4*)(mod + 3072 + c), sc = *(const f32x4*)(mod + 4096 + c);
                    float o[4];
#pragma unroll
                    for (int e = 0; e < 4; ++e) o[e] = xv[u][i][e] * rs * g[e] * (1.0f + sc[e]) + sh[e];
                    *(u32x2*)(p.H + (size_t)grow * DM + c) = mk2(pk2(o[0], o[1]), pk2(o[2], o[3]));
                }
            }
        }
        asm volatile("s_waitcnt vmcnt(0)" ::: "memory");
        __syncthreads();
        STAMP(13);
        {
            APlain ap{p.H + (size_t)rt * 128 * DM, DM};
            gemm_stream<4, 4, 2, 64, 4>(ap, p.wr_t, DM, DM, 2, [](int u, int& ao, int& bo) { ao = 0; bo = u * 128 * DM; },
                [&](const int ct, f32x4 (&acc)[4][4]) {
                    int ll = lane; LAUNDER(ll);
#pragma unroll
                    for (int i = 0; i < 4; ++i)
#pragma unroll
                        for (int j = 0; j < 4; ++j) {
                            const int row = wr * 64 + i * 16 + (ll & 15), col = ct * 128 + wc * 64 + j * 16 + (ll >> 4) * 4;
#pragma unroll
                            for (int e = 0; e < 4; ++e) scores[(col + e) * 128 + row] = sigmoidf_(acc[i][j][e]);
                        }
                }, lds);
        }
        asm volatile("s_waitcnt vmcnt(0)" ::: "memory");
        __syncthreads();
        STAMP(14);
#pragma unroll 1
        for (int hh = 0; hh < 2; ++hh) {
            __syncthreads();
            {
                int tl = t; LAUNDER(tl);
                f32x4 rgs[16];
#pragma unroll
                for (int i = 0; i < 16; ++i) { const int c = tl + 256 * i; rgs[i] = *(const f32x4*)(scores + (c >> 4) * 128 + hh * 64 + (c & 15) * 4); }
#pragma unroll
                for (int i = 0; i < 16; ++i) *(f32x4*)(tile + (tl + 256 * i) * 4) = rgs[i];
            }
            __syncthreads();
            if (t < 64) {
                int tl = t; LAUNDER(tl);
                const int token = rt * 128 + hh * 64 + tl;
                const float* sc = tile + tl;
                float gs[8];
#pragma unroll
                for (int g = 0; g < 8; ++g) {
                    float m1 = -INFINITY, m2 = -INFINITY;
#pragma unroll 8
                    for (int i = 0; i < 32; ++i) { const float v = sc[(g * 32 + i) * 64] + biasl[g * 32 + i]; m2 = fmaxf(m2, fminf(m1, v)); m1 = fmaxf(m1, v); }
                    gs[g] = m1 + m2;
                }
                unsigned selmask = 0u;
#pragma unroll
                for (int g = 0; g < 8; ++g) {
                    int rank = 0;
#pragma unroll
                    for (int g2 = 0; g2 < 8; ++g2) rank += (gs[g2] > gs[g] || (gs[g2] == gs[g] && g2 < g)) ? 1 : 0;
                    selmask |= (rank < 4 ? 1u : 0u) << g;
                }
                float tv[8]; int ti[8];
#pragma unroll
                for (int k = 0; k < 8; ++k) { tv[k] = -INFINITY; ti[k] = 0; }
#pragma unroll 1
                for (int g = 0; g < 8; ++g) {
                    if ((selmask >> g) & 1u) {
#pragma unroll 4
                        for (int i = 0; i < 32; ++i) {
                            const int e = g * 32 + i;
                            const float v = sc[e * 64] + biasl[e];
                            if (v > tv[7]) {
#pragma unroll
                                for (int k = 7; k >= 1; --k) {
                                    if (v > tv[k - 1]) { tv[k] = tv[k - 1]; ti[k] = ti[k - 1]; }
                                    else if (v > tv[k]) { tv[k] = v; ti[k] = e; }
                                }
                                if (v > tv[0]) { tv[0] = v; ti[0] = e; }
                            }
                        }
                    }
                }
                float ws[8], wsum = 0.f;
#pragma unroll
                for (int k = 0; k < 8; ++k) { ws[k] = sc[ti[k] * 64]; wsum += ws[k]; }
                const float sc25 = 2.5f / wsum;
#pragma unroll
                for (int k = 0; k < 8; ++k) {
                    p.topk_idx[token * 8 + k] = ti[k];
                    p.topk_w[token * 8 + k] = ws[k] * sc25;
                    le[(hh * 64 + tl) * 8 + k] = (unsigned char)ti[k];
                    lp[(hh * 64 + tl) * 8 + k] = (unsigned char)atomicAdd(&lcnt[ti[k]], 1);
                }
            }
        }
        __syncthreads();
        { const int c = lcnt[t]; lbase[t] = c > 0 ? (int)atomicAdd(&p.ctrl[CTRL_ECNT + t * ECNT_STRIDE], (unsigned)c) : 0; }
        __syncthreads();
#pragma unroll
        for (int i = 0; i < 4; ++i) {
            const int a = t + 256 * i, e = le[a];
            p.elist[(size_t)e * NTOK + lbase[e] + lp[a]] = (rt * 128) * 8 + a;
        }
        STAMP(15);
        {
            APlain ap{p.H + (size_t)rt * 128 * DM, DM};
            gemm_stream<4, 4, 2, 64, 4>(ap, p.wsgu_t, DM, DM, 4, [](int u, int& ao, int& bo) { ao = 0; bo = u * 128 * DM; },
                [&](const int ct, f32x4 (&acc)[4][4]) {
                    int ll = lane; LAUNDER(ll);
#pragma unroll
                    for (int i = 0; i < 4; ++i) {
                        bf16_t* d = act + (wr * 64 + i * 16 + (ll & 15)) * 256 + ct * 64 + wc * 32 + (ll >> 4) * 4;
#pragma unroll
                        for (int m = 0; m < 2; ++m) {
                            f32x4 o;
#pragma unroll
                            for (int e = 0; e < 4; ++e) { const float g = acc[i][2 * m][e]; o[e] = g * sigmoidf_(g) * acc[i][2 * m + 1][e]; }
                            *(u32x2*)(d + m * 16) = pack4(o);
                        }
                    }
                }, lds);
        }
        asm volatile("s_waitcnt vmcnt(0)" ::: "memory");
        __syncthreads();
        STAMP(16);
        {
            APlain ap{act, 256};
            gemm_stream<4, 4, 2, 64, 4>(ap, p.wsd_t, 256, 256, 8, [](int u, int& ao, int& bo) { ao = 0; bo = u * 128 * 256; },
                [&](const int ct, f32x4 (&acc)[4][4]) {
                    int ll = lane; LAUNDER(ll);
#pragma unroll
                    for (int i = 0; i < 4; ++i)
#pragma unroll
                        for (int j = 0; j < 4; ++j) {
                            const int row = wr * 64 + i * 16 + (ll & 15), grow = rt * 128 + row, col = ct * 128 + wc * 64 + j * 16 + (ll >> 4) * 4;
                            const f32x4 xv = *(const f32x4*)(p.out + (size_t)grow * DM + col), gf = *(const f32x4*)(mod + 5120 + col);
                            f32x4 o;
#pragma unroll
                            for (int e = 0; e < 4; ++e) o[e] = xv[e] + gf[e] * acc[i][j][e];
                            *(f32x4*)(p.out + (size_t)grow * DM + col) = o;
                        }
                }, lds);
        }
    }
}

DI void phase6(const Params& p, unsigned char* lds, int bid, int G) {
    const int t = threadIdx.x, lane = t & 63, wid = t >> 6, wr = wid >> 1, wc = wid & 1;
    float* tile = (float*)lds;
    int* cpre = (int*)(lds + 69632);
    int* rowtok = (int*)(lds + 69632 + 1056);
    int* rowslot = rowtok + 128;
    float* roww = (float*)(rowslot + 128);
    int* sh_it = (int*)(roww + 128);
    bf16_t* act = (bf16_t*)(p.bscr + (size_t)bid * BSCR_PER_BLOCK + 131072);
    (void)G;
    __syncthreads();
    rowtok[t] = ((int)p.ctrl[CTRL_ECNT + t * ECNT_STRIDE] + 127) >> 7;
    __syncthreads();
    if (t < 8) { int sacc = 0; for (int k = 0; k < 32; ++k) { cpre[t * 33 + k] = sacc; sacc += rowtok[8 * k + t]; } cpre[t * 33 + 32] = sacc; }
    __syncthreads();
    const int hq = (int)(xb_xcc_id() & 7u);
    int attempt = 0;
    for (;;) {
        const int qc = (hq + attempt) & 7;
        __syncthreads();
        if (t == 0) sh_it[0] = (int)atomicAdd(&p.ctrl[CTRL_Q6 + qc * 64], 1u);
        __syncthreads();
        const int idx = sh_it[0];
        if (idx >= cpre[qc * 33 + 32]) { if (++attempt >= 8) break; continue; }
        int lo = 0, hi = 31;
        while (lo < hi) { const int mid = (lo + hi + 1) >> 1; if (cpre[qc * 33 + mid] <= idx) lo = mid; else hi = mid - 1; }
        const int e = 8 * lo + qc, tl = idx - cpre[qc * 33 + lo], cnt = (int)p.ctrl[CTRL_ECNT + e * ECNT_STRIDE];
        __syncthreads();
        if (t < 128) {
            const int r = tl * 128 + t;
            if (r < cnt) { const int ts = p.elist[(size_t)e * NTOK + r]; rowtok[t] = ts >> 3; rowslot[t] = ts; roww[t] = p.topk_w[ts]; }
            else { rowtok[t] = 0; rowslot[t] = -1; roww[t] = 0.f; }
        }
        __syncthreads();
        {
            AGather ap{p.H, rowtok};
            gemm_stream<4, 4, 2, 64, 4>(ap, p.wegu_t + (size_t)e * 512 * DM, DM, DM, 4, [](int u, int& ao, int& bo) { ao = 0; bo = u * 128 * DM; },
                [&](const int ct, f32x4 (&acc)[4][4]) {
                    int ll = lane; LAUNDER(ll);
#pragma unroll
                    for (int i = 0; i < 4; ++i) {
                        bf16_t* d = act + (wr * 64 + i * 16 + (ll & 15)) * 256 + ct * 64 + wc * 32 + (ll >> 4) * 4;
#pragma unroll
                        for (int m = 0; m < 2; ++m) {
                            f32x4 o;
#pragma unroll
                            for (int ee = 0; ee < 4; ++ee) { const float g = acc[i][2 * m][ee]; o[ee] = g * sigmoidf_(g) * acc[i][2 * m + 1][ee]; }
                            *(u32x2*)(d + m * 16) = pack4(o);
                        }
                    }
                }, lds);
        }
        asm volatile("s_waitcnt vmcnt(0)" ::: "memory");
        __syncthreads();
        {
            APlain ap{act, 256};
            gemm_stream<4, 4, 2, 64, 4>(ap, p.wed_t + (size_t)e * 1024 * 256, 256, 256, 8, [](int u, int& ao, int& bo) { ao = 0; bo = u * 128 * 256; },
                [&](const int ct, f32x4 (&acc)[4][4]) {
                    int ll = lane; LAUNDER(ll);
#pragma unroll
                    for (int i = 0; i < 4; ++i) {
                        const int row = wr * 64 + i * 16 + (ll & 15), srow = rowslot[row];
                        const float ww = roww[row];
                        if (srow >= 0) {
#pragma unroll
                            for (int j = 0; j < 4; ++j) {
                                const int col = ct * 128 + wc * 64 + j * 16 + (ll >> 4) * 4;
                                *(u32x2*)(p.slot + (size_t)srow * DM + col) = pack4(acc[i][j] * ww);
                            }
                        }
                    }
                }, lds);
        }
    }
}

DI void phase7(const Params& p, int bid, int G) {
    const int lane = threadIdx.x & 63, gw = bid * 4 + (threadIdx.x >> 6), nw = G * 4;
    for (int row = gw; row < NTOK; row += nw) {
        const float* mod = p.mod + (row >> 12) * 6144 + 5120;
#pragma unroll
        for (int i = 0; i < 4; ++i) {
            const int c = lane * 4 + 256 * i;
            float s[4] = {0.f, 0.f, 0.f, 0.f};
#pragma unroll
            for (int k = 0; k < 8; ++k) { const u32x2 w = *(const u32x2*)(p.slot + ((size_t)row * 8 + k) * DM + c); s[0] += lo2f(w.x); s[1] += hi2f(w.x); s[2] += lo2f(w.y); s[3] += hi2f(w.y); }
            const f32x4 gf = *(const f32x4*)(mod + c);
            f32x4 o = *(const f32x4*)(p.out + (size_t)row * DM + c);
#pragma unroll
            for (int e = 0; e < 4; ++e) o[e] += gf[e] * s[e];
            *(f32x4*)(p.out + (size_t)row * DM + c) = o;
        }
    }
}

extern __shared__ __attribute__((aligned(16))) unsigned char smem[];

template <int PH> DI void run_phase(const Params& p, unsigned char* lds, int bid, int G) {
    if (PH == 0) phase0(p, lds, bid, G);
    if (PH == 1) phase1(p, bid, G);
    if (PH == 2) phase2(p, lds, bid, G);
    if (PH == 3) phase3(p, lds, bid, G);
    if (PH == 4) phase4(p, lds, bid, G);
    if (PH == 5) phase5(p, lds, bid, G);
    if (PH == 6) phase6(p, lds, bid, G);
    if (PH == 7) phase7(p, bid, G);
}

#if !ONE_LAUNCH
template <int PH> __global__ void __launch_bounds__(256, 2) phase_kernel(Params p) { run_phase<PH>(p, smem, blockIdx.x, gridDim.x); }
#endif

#if ONE_LAUNCH
__global__ void __launch_bounds__(256, 2) mega_kernel(Params p) {
    volatile LAS unsigned* st = (volatile LAS unsigned*)(smem + LDS_BYTES - 16);
    if (threadIdx.x == 0) { st[0] = 0u; st[1] = 0u; st[2] = 0u; st[3] = 0u; }
    __syncthreads();
    XcdBarrier bar = xcd_barrier_post(p.ctrl, st);
    const int bid = blockIdx.x, G = gridDim.x;
    STAMP(0);
    run_phase<0>(p, smem, bid, G); xcd_barrier(bar); STAMP(1);
    run_phase<1>(p, smem, bid, G); xcd_barrier(bar); STAMP(2);
    run_phase<2>(p, smem, bid, G); xcd_barrier(bar); STAMP(3);
    run_phase<3>(p, smem, bid, G); xcd_barrier(bar); STAMP(4);
    run_phase<4>(p, smem, bid, G); xcd_barrier(bar); STAMP(5);
    run_phase<5>(p, smem, bid, G); xcd_barrier(bar); STAMP(6);
    run_phase<6>(p, smem, bid, G); xcd_barrier(bar); STAMP(7);
    run_phase<7>(p, smem, bid, G);
#ifdef PROBE_A
    xcd_barrier(bar); STAMP(8);
    xcd_barrier(bar);
    {
        const unsigned long long* sp = (const unsigned long long*)(p.ctrl + CTRL_STAMP);
        const unsigned long long ta = __hip_atomic_load(sp + PROBE_A, __ATOMIC_RELAXED, __HIP_MEMORY_SCOPE_AGENT), tb = __hip_atomic_load(sp + PROBE_B, __ATOMIC_RELAXED, __HIP_MEMORY_SCOPE_AGENT);
        const unsigned long long t0 = __builtin_amdgcn_s_memrealtime();
        while (__builtin_amdgcn_s_memrealtime() - t0 < tb - ta) __builtin_amdgcn_s_sleep(8);
    }
#endif
}
#define OCC_KERNEL mega_kernel
#else
#define OCC_KERNEL phase_kernel<5>
#endif

static inline size_t al256(size_t x) { return (x + 255) & ~(size_t)255; }

extern "C" void kernel_launch(void* const* d_in, const int* in_sizes, int n_in, void* d_out, int out_size, void* d_ws, size_t ws_size, hipStream_t stream) {
    (void)in_sizes; (void)n_in; (void)out_size;
    Params p{};
    p.x = (const float*)d_in[0]; p.c = (const float*)d_in[1]; p.positions = (const int*)d_in[2]; p.ada_w = (const float*)d_in[3]; p.ada_b = (const float*)d_in[4];
    p.norm_mix = (const float*)d_in[5]; p.w_in = (const float*)d_in[6]; p.rwkv_mu = (const float*)d_in[7]; p.decay_w0 = (const float*)d_in[8]; p.decay_up = (const float*)d_in[9];
    p.iclr_a0 = (const float*)d_in[10]; p.iclr_up = (const float*)d_in[11]; p.gate_up = (const float*)d_in[12]; p.k_k = (const float*)d_in[13]; p.k_a = (const float*)d_in[14];
    p.r_k = (const float*)d_in[15]; p.ln_w = (const float*)d_in[16]; p.ln_b = (const float*)d_in[17]; p.q_a_norm = (const float*)d_in[18]; p.w_q_b = (const float*)d_in[19];
    p.kv_a_norm = (const float*)d_in[20]; p.w_kv_b = (const float*)d_in[21]; p.q_norm = (const float*)d_in[22]; p.k_norm = (const float*)d_in[23]; p.w_out = (const float*)d_in[24];
    p.norm_ffn = (const float*)d_in[25]; p.w_router = (const float*)d_in[26]; p.router_bias = (const float*)d_in[27]; p.w_e_gu = (const float*)d_in[28]; p.w_e_d = (const float*)d_in[29];
    p.w_sh_gu = (const float*)d_in[30]; p.w_sh_d = (const float*)d_in[31];
    p.out = (float*)d_out;

    static int grid = 0;
    if (!grid) {
        int dev = 0, cus = 0, per_cu = 0;
        (void)hipGetDevice(&dev);
        (void)hipDeviceGetAttribute(&cus, hipDeviceAttributeMultiprocessorCount, dev);
#if ONE_LAUNCH
        (void)hipFuncSetAttribute((const void*)mega_kernel, hipFuncAttributeMaxDynamicSharedMemorySize, LDS_BYTES);
#endif
#if !ONE_LAUNCH
        (void)hipFuncSetAttribute((const void*)phase_kernel<0>, hipFuncAttributeMaxDynamicSharedMemorySize, LDS_BYTES);
#endif
#if !ONE_LAUNCH
        (void)hipFuncSetAttribute((const void*)phase_kernel<1>, hipFuncAttributeMaxDynamicSharedMemorySize, LDS_BYTES);
#endif
#if !ONE_LAUNCH
        (void)hipFuncSetAttribute((const void*)phase_kernel<2>, hipFuncAttributeMaxDynamicSharedMemorySize, LDS_BYTES);
#endif
#if !ONE_LAUNCH
        (void)hipFuncSetAttribute((const void*)phase_kernel<3>, hipFuncAttributeMaxDynamicSharedMemorySize, LDS_BYTES);
#endif
#if !ONE_LAUNCH
        (void)hipFuncSetAttribute((const void*)phase_kernel<4>, hipFuncAttributeMaxDynamicSharedMemorySize, LDS_BYTES);
#endif
#if !ONE_LAUNCH
        (void)hipFuncSetAttribute((const void*)phase_kernel<5>, hipFuncAttributeMaxDynamicSharedMemorySize, LDS_BYTES);
#endif
#if !ONE_LAUNCH
        (void)hipFuncSetAttribute((const void*)phase_kernel<6>, hipFuncAttributeMaxDynamicSharedMemorySize, LDS_BYTES);
#endif
#if !ONE_LAUNCH
        (void)hipFuncSetAttribute((const void*)phase_kernel<7>, hipFuncAttributeMaxDynamicSharedMemorySize, LDS_BYTES);
#endif
        (void)hipOccupancyMaxActiveBlocksPerMultiprocessor(&per_cu, (const void*)OCC_KERNEL, 256, LDS_BYTES);
        if (cus <= 0) cus = 256;
        if (per_cu < 1) per_cu = 1;
        grid = cus * (per_cu < 2 ? per_cu : 2);
    }
    unsigned char* w = (unsigned char*)d_ws; size_t o = 0;
    auto take = [&](size_t bytes) { unsigned char* r = w + o; o = al256(o + bytes); return r; };
    p.ctrl = (unsigned*)take(CTRL_WORDS * 4);
    p.mod = (float*)take((size_t)NB * 6144 * 4);
    p.rope = (float*)take((size_t)NTOK * 32 * 4);
    p.win_t = (bf16_t*)take((size_t)LDU * 1024 * 2);
    p.wq_t = (bf16_t*)take((size_t)768 * 256 * 2);
    p.wkv_t = (bf16_t*)take((size_t)1024 * 128 * 2);
    p.wdec_t = (bf16_t*)take((size_t)512 * 32 * 2);
    p.wiclr_t = (bf16_t*)take((size_t)512 * 32 * 2);
    p.wgate_t = (bf16_t*)take((size_t)512 * 96 * 2);
    p.wout_t = (bf16_t*)take((size_t)1024 * 1024 * 2);
    p.wr_t = (bf16_t*)take((size_t)256 * 1024 * 2);
    p.wsgu_t = (bf16_t*)take((size_t)512 * 1024 * 2);
    p.wsd_t = (bf16_t*)take((size_t)1024 * 256 * 2);
    p.wegu_t = (bf16_t*)take((size_t)NEXP * 512 * 1024 * 2);
    p.wed_t = (bf16_t*)take((size_t)NEXP * 1024 * 256 * 2);
    p.H = (bf16_t*)take((size_t)NTOK * DM * 2);
    p.topk_idx = (int*)take((size_t)NTOK * 8 * 4);
    p.topk_w = (float*)take((size_t)NTOK * 8 * 4);
    p.elist = (int*)take((size_t)NEXP * NTOK * 4);
    p.bscr = take((size_t)grid * BSCR_PER_BLOCK);
    const size_t ov = o;
    p.U = (bf16_t*)take((size_t)NTOK * LDU * 2);
    p.Q = (bf16_t*)take((size_t)NTOK * 8 * 96 * 2);
    p.Kb = (bf16_t*)take((size_t)NTOK * 8 * 96 * 2);
    p.Vt = (bf16_t*)take((size_t)NTOK * 8 * 64 * 2);
    p.SC = (bf16_t*)take((size_t)NTOK * 8 * 384 * 2);
    p.Gg = (bf16_t*)take((size_t)NTOK * 512 * 2);
    p.yraw = (float*)take((size_t)NTOK * 512 * 4);
    p.Y = (bf16_t*)take((size_t)NTOK * DM * 2);
    p.slot = (bf16_t*)(w + ov);
    const size_t need_slot = ov + (size_t)NTOK * 8 * DM * 2;
    if (o > ws_size || need_slot > ws_size) { fprintf(stderr, "workspace too small: need %zu / %zu, have %zu\n", o, need_slot, ws_size); return; }

    (void)hipMemsetAsync(p.ctrl, 0, CTRL_WORDS * 4, stream);
#if ONE_LAUNCH
    hipLaunchKernelGGL(mega_kernel, dim3(grid), dim3(256), LDS_BYTES, stream, p);
#else
    hipLaunchKernelGGL(phase_kernel<0>, dim3(grid), dim3(256), LDS_BYTES, stream, p);
    hipLaunchKernelGGL(phase_kernel<1>, dim3(grid), dim3(256), LDS_BYTES, stream, p);
    hipLaunchKernelGGL(phase_kernel<2>, dim3(grid), dim3(256), LDS_BYTES, stream, p);
    hipLaunchKernelGGL(phase_kernel<3>, dim3(grid), dim3(256), LDS_BYTES, stream, p);
    hipLaunchKernelGGL(phase_kernel<4>, dim3(grid), dim3(256), LDS_BYTES, stream, p);
    hipLaunchKernelGGL(phase_kernel<5>, dim3(grid), dim3(256), LDS_BYTES, stream, p);
    hipLaunchKernelGGL(phase_kernel<6>, dim3(grid), dim3(256), LDS_BYTES, stream, p);
    hipLaunchKernelGGL(phase_kernel<7>, dim3(grid), dim3(256), LDS_BYTES, stream, p);
#endif
}
```

```cpp
#include <hip/hip_runtime.h>
#include <stdint.h>
#include <stdio.h>
#define DI __device__ __forceinline__

#ifndef ONE_LAUNCH
#define ONE_LAUNCH 1
#endif

typedef unsigned short bf16_t;
typedef short bf16x8 __attribute__((ext_vector_type(8)));
typedef float f32x4 __attribute__((ext_vector_type(4)));
typedef float f32x16 __attribute__((ext_vector_type(16)));
typedef float f32x2_t __attribute__((ext_vector_type(2)));
typedef unsigned u32x4 __attribute__((ext_vector_type(4)));
typedef unsigned u32x2 __attribute__((ext_vector_type(2)));
#define LAUNDER(v) asm volatile("" : "+v"(v))
DI u32x4 mk4(unsigned a, unsigned b, unsigned c, unsigned d) { return (u32x4){a, b, c, d}; }
DI u32x2 mk2(unsigned a, unsigned b) { return (u32x2){a, b}; }

typedef __bf16 bf16x2_t __attribute__((ext_vector_type(2)));

constexpr int NB = 16, NT_ = 4096, DM = 1024, NTOK = NB * NT_;
constexpr int LDU = 2176;
constexpr int UQ = 0, UKV = 256, UR = 384, UK = 896, UV = 1408, UXW = 1920, UXA = 1952, UXG = 1984, UPE = 2080;
constexpr int NEXP = 256, TOPK = 8;
constexpr int LDS_BYTES = 73728;
constexpr float QSCALE = 0.14724444f;

#define XB_TMO      128
#define XB_XCNT(j)  (256  + 64 * (j))
#define XB_XSUB(j)  (1280 + 64 * (j))
#define XB_XGEN(j)  (2304 + 64 * (j))
#define XB_TOP      3328
#define XB_TOPGEN   3392
#define XCD_BAR_WORDS 3456
#define XB_SPIN_CAP (1u << 22)
#define LAS __attribute__((address_space(3)))
constexpr int CTRL_ATTNQ = 4096, CTRL_ECNT = 8192, ECNT_STRIDE = 64, CTRL_WORDS = 24576;
constexpr int CTRL_STAMP = 4160;
constexpr int CTRL_Q6 = 4608;
#ifdef PROBE_A
#define STAMP(id) do { if (blockIdx.x == 0 && threadIdx.x == 0) __hip_atomic_store((unsigned long long*)(p.ctrl + CTRL_STAMP) + (id), (unsigned long long)__builtin_amdgcn_s_memrealtime(), __ATOMIC_RELAXED, __HIP_MEMORY_SCOPE_AGENT); } while (0)
#else
#define STAMP(id)
#endif

DI unsigned xb_ld(unsigned* p)              { return __hip_atomic_load(p, __ATOMIC_RELAXED, __HIP_MEMORY_SCOPE_AGENT); }
DI unsigned xb_add(unsigned* p, unsigned v) { return __hip_atomic_fetch_add(p, v, __ATOMIC_RELAXED, __HIP_MEMORY_SCOPE_AGENT); }
DI unsigned xb_xcc_id() { return (unsigned)__builtin_amdgcn_s_getreg((3 << 11) | 20) & 0xFu; }
#define XB_SPIN(cond, bar) do { unsigned _sp = 0; while (cond) { __builtin_amdgcn_s_sleep(1); \
    if ((++_sp & 255u) == 0u) { if (xb_ld(&(bar)[XB_TMO])) break; if (_sp > XB_SPIN_CAP) { atomicAdd(&(bar)[XB_TMO], 1u); break; } } } } while (0)

struct XcdBarrier { unsigned* bar; unsigned x; volatile LAS unsigned* st; };

DI XcdBarrier xcd_barrier_post(unsigned* bar, volatile LAS unsigned* st) {
    XcdBarrier b; b.bar = bar; b.x = xb_xcc_id(); b.st = st;
    if (threadIdx.x == 0) (void)xb_add(&bar[XB_XCNT(b.x)], 1u);
    return b;
}
DI void xcd_barrier_complete(unsigned* bar, unsigned x, unsigned& nloc, unsigned& nx) {
    const unsigned G = gridDim.x * gridDim.y * gridDim.z;
    unsigned sum, cnt, mine, sp = 0u;
    for (;;) {
        sum = 0u; cnt = 0u; mine = 0u;
#pragma unroll
        for (unsigned j = 0; j < 16; ++j) { const unsigned c = xb_ld(&bar[XB_XCNT(j)]); sum += c; cnt += (c > 0u) ? 1u : 0u; mine = (j == x) ? c : mine; }
        if (sum == G) break;
        __builtin_amdgcn_s_sleep(1);
        if ((++sp & 255u) == 0u) { if (xb_ld(&bar[XB_TMO])) break; if (sp > XB_SPIN_CAP) { atomicAdd(&bar[XB_TMO], 1u); break; } }
    }
    nloc = mine > 0u ? mine : 1u; nx = cnt > 0u ? cnt : 1u;
}
DI void xcd_barrier(const XcdBarrier& b) {
    asm volatile("s_waitcnt vmcnt(0)" ::: "memory");
    __syncthreads();
    if (threadIdx.x == 0) {
        unsigned* bar = b.bar;
        __builtin_amdgcn_s_waitcnt(0);
        unsigned nloc = b.st[0], nx = b.st[1];
        if (nloc == 0u) { xcd_barrier_complete(bar, b.x, nloc, nx); b.st[0] = nloc; b.st[1] = nx; }
        const unsigned old = xb_add(&bar[XB_XSUB(b.x)], 1u);
        const unsigned gen = old / nloc;
        if (old + 1u == (gen + 1u) * nloc) {
            __builtin_amdgcn_fence(__ATOMIC_RELEASE, "agent");
            asm volatile("s_waitcnt vmcnt(0)" ::: "memory");
            const unsigned og = xb_add(&bar[XB_TOP], 1u);
            const unsigned tg = og / nx;
            if (og + 1u == (tg + 1u) * nx) xb_add(&bar[XB_TOPGEN], 1u);
            else XB_SPIN(xb_ld(&bar[XB_TOPGEN]) == tg, bar);
            __builtin_amdgcn_fence(__ATOMIC_ACQUIRE, "agent");
            xb_add(&bar[XB_XGEN(b.x)], 1u);
            asm volatile("s_waitcnt vmcnt(0)" ::: "memory");
        } else {
            XB_SPIN(xb_ld(&bar[XB_XGEN(b.x)]) == gen, bar);
            __builtin_amdgcn_fence(__ATOMIC_ACQUIRE, "agent");
            asm volatile("s_waitcnt vmcnt(0)" ::: "memory");
        }
    }
    __syncthreads();
}

struct Params {
    const float* x; const float* c; const int* positions; const float* ada_w; const float* ada_b; const float* norm_mix; const float* w_in;
    const float* rwkv_mu; const float* decay_w0; const float* decay_up; const float* iclr_a0; const float* iclr_up; const float* gate_up;
    const float* k_k; const float* k_a; const float* r_k; const float* ln_w; const float* ln_b;
    const float* q_a_norm; const float* w_q_b; const float* kv_a_norm; const float* w_kv_b; const float* q_norm; const float* k_norm;
    const float* w_out; const float* norm_ffn; const float* w_router; const float* router_bias;
    const float* w_e_gu; const float* w_e_d; const float* w_sh_gu; const float* w_sh_d;
    float* out;
    unsigned* ctrl; float* mod; float* rope;
    bf16_t* win_t; bf16_t* wq_t; bf16_t* wkv_t; bf16_t* wdec_t; bf16_t* wiclr_t; bf16_t* wgate_t; bf16_t* wout_t; bf16_t* wr_t; bf16_t* wsgu_t; bf16_t* wsd_t;
    bf16_t* wegu_t; bf16_t* wed_t;
    bf16_t* H; int* topk_idx; float* topk_w; int* elist; unsigned char* bscr;
    bf16_t* U; bf16_t* Q; bf16_t* Kb; bf16_t* Vt; bf16_t* SC; bf16_t* Gg; float* yraw; bf16_t* Y; bf16_t* slot;
};
constexpr size_t BSCR_PER_BLOCK = 196608;

DI float bf2f(bf16_t v) { return __uint_as_float(((unsigned)v) << 16); }
DI unsigned pk2(float a, float b) { f32x2_t f = {a, b}; bf16x2_t r = __builtin_convertvector(f, bf16x2_t); return __builtin_bit_cast(unsigned, r); }
DI bf16_t f2bf(float a) { return (bf16_t)(pk2(a, 0.f) & 0xffffu); }
DI float lo2f(unsigned w) { return __uint_as_float(w << 16); }
DI float hi2f(unsigned w) { return __uint_as_float(w & 0xffff0000u); }
DI float sigmoidf_(float x) { return 1.0f / (1.0f + __expf(-x)); }
DI float wave_sum(float v) {
#pragma unroll
    for (int o = 32; o > 0; o >>= 1) v += __shfl_xor(v, o);
    return v;
}
DI float dpp_sum8(float s) {
    s += __builtin_bit_cast(float, __builtin_amdgcn_update_dpp(0, __builtin_bit_cast(int, s), 0xB1, 0xf, 0xf, true));
    s += __builtin_bit_cast(float, __builtin_amdgcn_update_dpp(0, __builtin_bit_cast(int, s), 0x4E, 0xf, 0xf, true));
    s += __builtin_bit_cast(float, __builtin_amdgcn_update_dpp(0, __builtin_bit_cast(int, s), 0x141, 0xf, 0xf, true));
    return s;
}

struct APlain { const bf16_t* base; int ld; DI const bf16_t* row(int r) const { return base + (size_t)r * ld; } };
struct AGather { const bf16_t* base; const int* idx; DI const bf16_t* row(int r) const { return base + (size_t)idx[r] * DM; } };

template <int MT, int NT, int WR, int BK, int NSWAP, class AP>
DI void gemm_tile(const AP ap, const bf16_t* __restrict__ Bt, const int ldb, const int K, f32x4 (&acc)[MT][NT], unsigned char* lds) {
    constexpr int WC = 4 / WR, CPR = BK / 8, RB = BK * 2, R256 = 256 / RB, BN = WC * NT * 16;
    static_assert(WR * MT * 16 == 128, "tile is 128 rows");
    constexpr int A_BYTES = 128 * RB, B_BYTES = BN * RB;
    constexpr int A_CH = (128 * CPR) / 256, B_TOT = BN * CPR, B_CH = (B_TOT + 255) / 256, RSTEP = 256 / CPR;
    int t = threadIdx.x; LAUNDER(t);
    const int lane = t & 63, wid = t >> 6, wr = wid / WC, wc = wid % WC;
    const int ch = t % CPR, r0 = t / CPR;
    const bf16_t* pa[A_CH]; const bf16_t* pb[B_CH]; int offa[A_CH], offb[B_CH]; bool vb[B_CH];
#pragma unroll
    for (int i = 0; i < A_CH; ++i) { const int row = r0 + i * RSTEP; pa[i] = ap.row(row) + ch * 8; offa[i] = row * RB + ((ch ^ ((row / R256) & (CPR - 1))) << 4); }
#pragma unroll
    for (int i = 0; i < B_CH; ++i) { const int row = r0 + i * RSTEP; vb[i] = (B_TOT % 256 == 0) || (row < BN); const int rr = vb[i] ? row : 0; pb[i] = Bt + (size_t)rr * ldb + ch * 8; offb[i] = 2 * A_BYTES + rr * RB + ((ch ^ ((rr / R256) & (CPR - 1))) << 4); }
#pragma unroll
    for (int i = 0; i < MT; ++i)
#pragma unroll
        for (int j = 0; j < NT; ++j) acc[i][j] = (f32x4){0.f, 0.f, 0.f, 0.f};
    const int KT = K / BK;
    u32x4 ra0[A_CH], rb0[B_CH], ra1[A_CH], rb1[B_CH];
#define G_LOAD(RA, RB, KTI) { _Pragma("unroll") for (int i = 0; i < A_CH; ++i) RA[i] = *(const u32x4*)(pa[i] + (KTI) * BK); \
                              _Pragma("unroll") for (int i = 0; i < B_CH; ++i) RB[i] = *(const u32x4*)(pb[i] + (KTI) * BK); }
#define G_WRITE(RA, RB, BUF) { _Pragma("unroll") for (int i = 0; i < A_CH; ++i) *(u32x4*)(lds + (BUF) * A_BYTES + offa[i]) = RA[i]; \
                               _Pragma("unroll") for (int i = 0; i < B_CH; ++i) if (vb[i]) *(u32x4*)(lds + (BUF) * B_BYTES + offb[i]) = RB[i]; }
#define G_COMPUTE(BUF) { const unsigned char* Ab = lds + (BUF) * A_BYTES + arow; const unsigned char* Bb = lds + 2 * A_BYTES + (BUF) * B_BYTES + brow; \
        _Pragma("unroll") for (int ks = 0; ks < BK / 32; ++ks) { const int co = ((ks * 4 + (lane >> 4)) ^ sw) << 4; bf16x8 af[MT], bfr[NT]; \
            _Pragma("unroll") for (int i = 0; i < MT; ++i) af[i] = *(const bf16x8*)(Ab + i * 16 * RB + co); \
            _Pragma("unroll") for (int j = 0; j < NT; ++j) bfr[j] = *(const bf16x8*)(Bb + j * 16 * RB + co); \
            _Pragma("unroll") for (int i = 0; i < MT; ++i) _Pragma("unroll") for (int j = 0; j < NT; ++j) \
                acc[i][j] = (j < NSWAP) ? __builtin_amdgcn_mfma_f32_16x16x32_bf16(bfr[j], af[i], acc[i][j], 0, 0, 0) \
                                        : __builtin_amdgcn_mfma_f32_16x16x32_bf16(af[i], bfr[j], acc[i][j], 0, 0, 0); } }
    const int sw = ((lane & 15) / R256) & (CPR - 1);
    const int arow = (wr * MT * 16 + (lane & 15)) * RB, brow = (wc * NT * 16 + (lane & 15)) * RB;
    G_LOAD(ra0, rb0, 0)
    if (KT > 1) G_LOAD(ra1, rb1, 1)
    __syncthreads();
    G_WRITE(ra0, rb0, 0)
    if (KT > 2) G_LOAD(ra0, rb0, 2)
    __syncthreads();
    for (int kt = 0; kt < KT; kt += 2) {
        G_COMPUTE(0)
        if (kt + 1 < KT) { G_WRITE(ra1, rb1, 1) if (kt + 3 < KT) G_LOAD(ra1, rb1, kt + 3) }
        __syncthreads();
        if (kt + 1 >= KT) break;
        G_COMPUTE(1)
        if (kt + 2 < KT) { G_WRITE(ra0, rb0, 0) if (kt + 4 < KT) G_LOAD(ra0, rb0, kt + 4) }
        __syncthreads();
    }
#undef G_LOAD
#undef G_WRITE
#undef G_COMPUTE
}
template <int MT, int NT, int WR, int BK, int NSWAP, class AP, class UF, class EPI>
DI void gemm_stream(const AP ap, const bf16_t* __restrict__ Bt, const int ldb, const int K, const int nunits, const UF uoff, const EPI epi, unsigned char* lds) {
    constexpr int WC = 4 / WR, CPR = BK / 8, RB = BK * 2, R256 = 256 / RB, BN = WC * NT * 16;
    static_assert(WR * MT * 16 == 128, "tile is 128 rows");
    constexpr int A_BYTES = 128 * RB, B_BYTES = BN * RB;
    constexpr int A_CH = (128 * CPR) / 256, B_TOT = BN * CPR, B_CH = (B_TOT + 255) / 256, RSTEP = 256 / CPR;
    int t = threadIdx.x; LAUNDER(t);
    const int lane = t & 63, wid = t >> 6, wr = wid / WC, wc = wid % WC;
    const int ch = t % CPR, r0 = t / CPR;
    const bf16_t* pa[A_CH]; const bf16_t* pb[B_CH]; int offa[A_CH], offb[B_CH]; bool vb[B_CH];
#pragma unroll
    for (int i = 0; i < A_CH; ++i) { const int row = r0 + i * RSTEP; pa[i] = ap.row(row) + ch * 8; offa[i] = row * RB + ((ch ^ ((row / R256) & (CPR - 1))) << 4); }
#pragma unroll
    for (int i = 0; i < B_CH; ++i) { const int row = r0 + i * RSTEP; vb[i] = (B_TOT % 256 == 0) || (row < BN); const int rr = vb[i] ? row : 0; pb[i] = Bt + (size_t)rr * ldb + ch * 8; offb[i] = 2 * A_BYTES + rr * RB + ((ch ^ ((rr / R256) & (CPR - 1))) << 4); }
    f32x4 acc[MT][NT];
#pragma unroll
    for (int i = 0; i < MT; ++i)
#pragma unroll
        for (int j = 0; j < NT; ++j) acc[i][j] = (f32x4){0.f, 0.f, 0.f, 0.f};
    const int KT = K / BK, NG = nunits * KT;
    int lu = 0, lkt = 0, cu = 0, ckt = 0;
    u32x4 ra0[A_CH], rb0[B_CH], ra1[A_CH], rb1[B_CH];
#define S_LOAD(RA, RB) { int ao, bo; uoff(lu, ao, bo); ao += lkt * BK; bo += lkt * BK; \
                         _Pragma("unroll") for (int i = 0; i < A_CH; ++i) RA[i] = *(const u32x4*)(pa[i] + ao); \
                         _Pragma("unroll") for (int i = 0; i < B_CH; ++i) RB[i] = *(const u32x4*)(pb[i] + bo); \
                         if (++lkt == KT) { lkt = 0; ++lu; } }
#define S_WRITE(RA, RB, BUF) { _Pragma("unroll") for (int i = 0; i < A_CH; ++i) *(u32x4*)(lds + (BUF) * A_BYTES + offa[i]) = RA[i]; \
                               _Pragma("unroll") for (int i = 0; i < B_CH; ++i) if (vb[i]) *(u32x4*)(lds + (BUF) * B_BYTES + offb[i]) = RB[i]; }
#define S_COMPUTE(BUF) { const unsigned char* Ab = lds + (BUF) * A_BYTES + arow; const unsigned char* Bb = lds + 2 * A_BYTES + (BUF) * B_BYTES + brow; \
        _Pragma("unroll") for (int ks = 0; ks < BK / 32; ++ks) { const int co = ((ks * 4 + (lane >> 4)) ^ sw) << 4; bf16x8 af[MT], bfr[NT]; \
            _Pragma("unroll") for (int i = 0; i < MT; ++i) af[i] = *(const bf16x8*)(Ab + i * 16 * RB + co); \
            _Pragma("unroll") for (int j = 0; j < NT; ++j) bfr[j] = *(const bf16x8*)(Bb + j * 16 * RB + co); \
            __builtin_amdgcn_s_setprio(1); \
            _Pragma("unroll") for (int i = 0; i < MT; ++i) _Pragma("unroll") for (int j = 0; j < NT; ++j) \
                acc[i][j] = (j < NSWAP) ? __builtin_amdgcn_mfma_f32_16x16x32_bf16(bfr[j], af[i], acc[i][j], 0, 0, 0) \
                                        : __builtin_amdgcn_mfma_f32_16x16x32_bf16(af[i], bfr[j], acc[i][j], 0, 0, 0); \
            __builtin_amdgcn_s_setprio(0); } }
#define S_EPI { if (++ckt == KT) { epi(cu, acc); ckt = 0; ++cu; \
                _Pragma("unroll") for (int i = 0; i < MT; ++i) _Pragma("unroll") for (int j = 0; j < NT; ++j) acc[i][j] = (f32x4){0.f, 0.f, 0.f, 0.f}; } }
    const int sw = ((lane & 15) / R256) & (CPR - 1);
    const int arow = (wr * MT * 16 + (lane & 15)) * RB, brow = (wc * NT * 16 + (lane & 15)) * RB;
    S_LOAD(ra0, rb0)
    if (NG > 1) S_LOAD(ra1, rb1)
    __syncthreads();
    S_WRITE(ra0, rb0, 0)
    if (NG > 2) S_LOAD(ra0, rb0)
    __syncthreads();
#pragma unroll 1
    for (int g = 0; g < NG; g += 2) {
        S_COMPUTE(0)
        if (g + 1 < NG) { S_WRITE(ra1, rb1, 1) if (g + 3 < NG) S_LOAD(ra1, rb1) }
        S_EPI
        __syncthreads();
        if (g + 1 >= NG) break;
        S_COMPUTE(1)
        if (g + 2 < NG) { S_WRITE(ra0, rb0, 0) if (g + 4 < NG) S_LOAD(ra0, rb0) }
        S_EPI
        __syncthreads();
    }
#undef S_LOAD
#undef S_WRITE
#undef S_COMPUTE
#undef S_EPI
}

template <int NT, int BK, class AP>
DI void gemm_core(const AP ap, const bf16_t* __restrict__ Bt, const int ldb, const int K, f32x4 (&acc)[4][NT], unsigned char* lds) {
    gemm_tile<4, NT, 2, BK, NT>(ap, Bt, ldb, K, acc, lds);
}

template <int NT> DI void acc_to_lds(const f32x4 (&acc)[4][NT], float* tile, const int ld) {
    int t = threadIdx.x; LAUNDER(t);
    const int lane = t & 63, wid = t >> 6, wr = wid >> 1, wc = wid & 1;
#pragma unroll
    for (int i = 0; i < 4; ++i)
#pragma unroll
        for (int j = 0; j < NT; ++j) {
            const int row = wr * 64 + i * 16 + (lane & 15), col = wc * NT * 16 + j * 16 + (lane >> 4) * 4;
            *(f32x4*)(tile + row * ld + col) = acc[i][j];
        }
}

DI int map_win(int n) { return n < 384 ? n + 1696 : (n < 2080 ? n - 384 : (n < 2112 ? n : -1)); }
DI int map_gu(int n) { const int tile = n >> 7, w = n & 127, wc = w >> 6, j = (w >> 4) & 3, r = w & 15; const int a = tile * 64 + wc * 32 + (j >> 1) * 16 + r; return (j & 1) ? 256 + a : a; }

template <int MAP> DI void tconv_simple(const float* __restrict__ src, bf16_t* __restrict__ dst, int K, int Ns, int Nd, const float* __restrict__ scale, int gtid, int gthreads) {
    const int total = Nd * K;
    for (int idx = gtid; idx < total; idx += gthreads) {
        const int n = idx / K, k = idx - n * K;
        const int m = (MAP == 1) ? map_win(n) : (MAP == 2 ? map_gu(n) : n);
        float v = 0.f;
        if (m >= 0) { v = src[(size_t)k * Ns + m]; if (scale) v *= scale[k]; }
        dst[idx] = f2bf(v);
    }
}
template <int MAP> DI void tconv_tiled(const float* __restrict__ src, bf16_t* __restrict__ dst, int E, int K, int N, float* ldsf, int bid, int G) {
    const int tk = K / 64, tn = N / 64, per = tk * tn, total = E * per;
    const int t = threadIdx.x;
    for (int tile0 = 2 * bid; tile0 < total; tile0 += 2 * G) {
        float rg[2][16];
#pragma unroll
        for (int h = 0; h < 2; ++h) {
            const int tile = tile0 + h, e = tile / per, r = tile - e * per, kt = r / tn, nt = r - kt * tn;
            const float* s = src + (size_t)e * K * N + (size_t)(kt * 64) * N;
            const int nl = t & 63, n = nt * 64 + nl;
            const int m = (MAP == 2) ? map_gu(n) : n;
#pragma unroll
            for (int i = 0; i < 16; ++i) rg[h][i] = s[(size_t)((t >> 6) + 4 * i) * N + m];
        }
        __syncthreads();
#pragma unroll
        for (int h = 0; h < 2; ++h)
#pragma unroll
            for (int i = 0; i < 16; ++i) ldsf[h * 4160 + ((t >> 6) + 4 * i) * 65 + (t & 63)] = rg[h][i];
        __syncthreads();
#pragma unroll
        for (int h = 0; h < 2; ++h) {
            const int tile = tile0 + h, e = tile / per, r = tile - e * per, kt = r / tn, nt = r - kt * tn;
            const int nl = t >> 2, kc = (t & 3) * 16;
            unsigned w[8];
#pragma unroll
            for (int i = 0; i < 8; ++i) w[i] = pk2(ldsf[h * 4160 + (kc + 2 * i) * 65 + nl], ldsf[h * 4160 + (kc + 2 * i + 1) * 65 + nl]);
            bf16_t* d = dst + (size_t)e * K * N + (size_t)(nt * 64 + nl) * K + kt * 64 + kc;
            *(u32x4*)(d) = mk4(w[0], w[1], w[2], w[3]);
            *(u32x4*)(d + 8) = mk4(w[4], w[5], w[6], w[7]);
        }
    }
}
DI void phase0(const Params& p, unsigned char* lds, int bid, int G) {
    const int t = threadIdx.x;
    float* ldsf = (float*)lds;
    for (int item = bid; item < 384; item += G) {
        __syncthreads();
        for (int i = t; i < NB * DM; i += 256) { const float v = p.c[i]; ldsf[(i & (DM - 1)) * NB + (i >> 10)] = v * sigmoidf_(v); }
        __syncthreads();
        const int col = item * 16 + (t & 15), kp = t >> 4;
        float a[NB];
#pragma unroll
        for (int b = 0; b < NB; ++b) a[b] = 0.f;
#pragma unroll 1
        for (int k0 = kp * 64; k0 < kp * 64 + 64; k0 += 8) {
            float w[8];
#pragma unroll
            for (int u = 0; u < 8; ++u) w[u] = p.ada_w[(size_t)(k0 + u) * 6144 + col];
#pragma unroll
            for (int u = 0; u < 8; ++u) {
#pragma unroll
                for (int q = 0; q < 4; ++q) { const f32x4 cv = *(const f32x4*)(ldsf + (k0 + u) * NB + 4 * q); a[4 * q] += cv[0] * w[u]; a[4 * q + 1] += cv[1] * w[u]; a[4 * q + 2] += cv[2] * w[u]; a[4 * q + 3] += cv[3] * w[u]; }
            }
        }
        __syncthreads();
#pragma unroll
        for (int b = 0; b < NB; ++b) ldsf[(kp * NB + b) * 16 + (t & 15)] = a[b];
        __syncthreads();
        {
            const int b = t >> 4, cl = t & 15; float sacc = 0.f;
#pragma unroll
            for (int q = 0; q < 16; ++q) sacc += ldsf[(q * NB + b) * 16 + cl];
            p.mod[b * 6144 + item * 16 + cl] = sacc + p.ada_b[item * 16 + cl];
        }
    }
    __syncthreads();
    const int gtid = bid * 256 + t, gth = G * 256;
    tconv_simple<1>(p.w_in, p.win_t, 1024, 2112, LDU, nullptr, gtid, gth);
    tconv_simple<0>(p.w_q_b, p.wq_t, 256, 768, 768, p.q_a_norm, gtid, gth);
    tconv_simple<0>(p.w_kv_b, p.wkv_t, 128, 1024, 1024, p.kv_a_norm, gtid, gth);
    tconv_simple<0>(p.decay_up, p.wdec_t, 32, 512, 512, nullptr, gtid, gth);
    tconv_simple<0>(p.iclr_up, p.wiclr_t, 32, 512, 512, nullptr, gtid, gth);
    tconv_simple<0>(p.gate_up, p.wgate_t, 96, 512, 512, nullptr, gtid, gth);
    tconv_simple<0>(p.w_out, p.wout_t, 1024, 1024, 1024, nullptr, gtid, gth);
    tconv_simple<0>(p.w_router, p.wr_t, 1024, 256, 256, nullptr, gtid, gth);
    tconv_simple<2>(p.w_sh_gu, p.wsgu_t, 1024, 512, 512, nullptr, gtid, gth);
    tconv_simple<0>(p.w_sh_d, p.wsd_t, 256, 1024, 1024, nullptr, gtid, gth);
    tconv_tiled<2>(p.w_e_gu, p.wegu_t, NEXP, 1024, 512, ldsf, bid, G);
    tconv_tiled<0>(p.w_e_d, p.wed_t, NEXP, 256, 1024, ldsf, bid, G);
}

DI void phase1(const Params& p, int bid, int G) {
    const int lane = threadIdx.x & 63, gw = bid * 4 + (threadIdx.x >> 6), nw = G * 4;
    for (int row0 = gw * 2; row0 < NTOK; row0 += nw * 2) {
        f32x4 v[2][4]; float ss[2] = {0.f, 0.f};
#pragma unroll
        for (int u = 0; u < 2; ++u)
#pragma unroll
            for (int i = 0; i < 4; ++i) v[u][i] = *(const f32x4*)(p.x + (size_t)(row0 + u) * DM + lane * 4 + 256 * i);
#pragma unroll
        for (int u = 0; u < 2; ++u) {
#pragma unroll
            for (int i = 0; i < 4; ++i) ss[u] += v[u][i][0] * v[u][i][0] + v[u][i][1] * v[u][i][1] + v[u][i][2] * v[u][i][2] + v[u][i][3] * v[u][i][3];
            ss[u] = wave_sum(ss[u]);
        }
        const float* mod = p.mod + (row0 >> 12) * 6144;
#pragma unroll
        for (int i = 0; i < 4; ++i) {
            const int c = lane * 4 + 256 * i;
            const f32x4 g = *(const f32x4*)(p.norm_mix + c), sh = *(const f32x4*)(mod + c), sc = *(const f32x4*)(mod + 1024 + c);
#pragma unroll
            for (int u = 0; u < 2; ++u) {
                const float rs = rsqrtf(ss[u] * (1.0f / DM) + 1e-6f);
                float o[4];
#pragma unroll
                for (int e = 0; e < 4; ++e) o[e] = v[u][i][e] * rs * g[e] * (1.0f + sc[e]) + sh[e];
                *(u32x2*)(p.H + (size_t)(row0 + u) * DM + c) = mk2(pk2(o[0], o[1]), pk2(o[2], o[3]));
            }
        }
    }
    const double inv = exp(-(double)(lane & 15) * (9.210340371976184 / 16.0));
    for (int idx = gw * 64 + lane; idx < NTOK * 16; idx += nw * 64) {
        const int row = idx >> 4;
        const double ang = (double)p.positions[row] * inv;
        p.rope[(size_t)row * 32 + (lane & 15)] = (float)cos(ang);
        p.rope[(size_t)row * 32 + 16 + (lane & 15)] = (float)sin(ang);
    }
}

DI void phase2(const Params& p, unsigned char* lds, int bid, int G) {
    constexpr int NCT = LDU / 128;
    const int t = threadIdx.x, lane = t & 63, wid = t >> 6, wr = wid >> 1, wc = wid & 1;
    const int total = (NTOK / 128) * NCT;
    for (int L = bid; L < total; L += G) {
        const int xcd = L & 7, j = L >> 3, rt = 8 * (j / NCT) + xcd, ct = j % NCT;
        f32x4 acc[4][4];
        APlain ap{p.H + (size_t)rt * 128 * DM, DM};
        gemm_core<4, 64>(ap, p.win_t + (size_t)ct * 128 * DM, DM, DM, acc, lds);
        bf16_t* tile = (bf16_t*)lds;
#pragma unroll
        for (int i = 0; i < 4; ++i)
#pragma unroll
            for (int jj = 0; jj < 4; ++jj) {
                const int row = wr * 64 + i * 16 + (lane & 15), col = wc * 64 + jj * 16 + (lane >> 4) * 4;
                *(u32x2*)(tile + row * 136 + col) = mk2(pk2(acc[i][jj][0], acc[i][jj][1]), pk2(acc[i][jj][2], acc[i][jj][3]));
            }
        __syncthreads();
#pragma unroll
        for (int i = 0; i < 8; ++i) {
            const int c = t + 256 * i, row = c >> 4, chn = c & 15;
            *(u32x4*)(p.U + (size_t)(rt * 128 + row) * LDU + ct * 128 + chn * 8) = *(const u32x4*)(tile + row * 136 + chn * 8);
        }
    }
}

DI void unpack8(const u32x4 w, float (&f)[8]) { f[0] = lo2f(w.x); f[1] = hi2f(w.x); f[2] = lo2f(w.y); f[3] = hi2f(w.y); f[4] = lo2f(w.z); f[5] = hi2f(w.z); f[6] = lo2f(w.w); f[7] = hi2f(w.w); }
DI f32x4 unpack4(const u32x2 w) { return (f32x4){lo2f(w.x), hi2f(w.x), lo2f(w.y), hi2f(w.y)}; }
DI u32x2 pack4(const f32x4 v) { return mk2(pk2(v[0], v[1]), pk2(v[2], v[3])); }
DI f32x4 shifted4(const bf16_t* __restrict__ up, const bool has_prev, const f32x4 mu) {
    const f32x4 cur = unpack4(*(const u32x2*)up);
    f32x4 prev = (f32x4){0.f, 0.f, 0.f, 0.f};
    if (has_prev) prev = unpack4(*(const u32x2*)(up - LDU));
    return cur + (prev - cur) * mu;
}
DI void head96_finish(f32x4 (&v)[6], const int q, const float* __restrict__ gain, const float* __restrict__ ropeRow, const float scale, bf16_t* __restrict__ dstRow) {
    float ss = 0.f;
#pragma unroll
    for (int j = 0; j < 6; ++j) ss += v[j][0] * v[j][0] + v[j][1] * v[j][1] + v[j][2] * v[j][2] + v[j][3] * v[j][3];
    ss += __shfl_xor(ss, 16); ss += __shfl_xor(ss, 32);
    const float rs = rsqrtf(ss * (1.0f / 96.0f) + 1e-6f);
#pragma unroll
    for (int j = 0; j < 6; ++j) v[j] = v[j] * rs * *(const f32x4*)(gain + j * 16 + q * 4);
    const f32x4 cs = *(const f32x4*)(ropeRow + q * 4), sn = *(const f32x4*)(ropeRow + 16 + q * 4);
    const f32x4 x1 = v[4], x2 = v[5];
    v[4] = x1 * cs - x2 * sn; v[5] = x2 * cs + x1 * sn;
#pragma unroll
    for (int j = 0; j < 6; ++j) *(u32x2*)(dstRow + j * 16 + q * 4) = pack4(v[j] * scale);
}

DI void phase3(const Params& p, unsigned char* lds, int bid, int G) {
    const int t = threadIdx.x;
    float* rstd_q = (float*)(lds + 69632);
    float* rstd_kv = rstd_q + 128;
    bf16_t* lora = (bf16_t*)(p.bscr + (size_t)bid * BSCR_PER_BLOCK + 131072);
    for (int rt = bid; rt < NTOK / 128; rt += G) {
        __syncthreads();
        {
            int tl = t; LAUNDER(tl);
            const int row = tl >> 1, half = tl & 1, grow = rt * 128 + row;
            const bf16_t* urow = p.U + (size_t)grow * LDU;
            float s = 0.f;
#pragma unroll
            for (int c = 0; c < 16; ++c) { float f[8]; unpack8(*(const u32x4*)(urow + UQ + half * 128 + c * 8), f);
#pragma unroll
                for (int e = 0; e < 8; ++e) s += f[e] * f[e]; }
            s += __shfl_xor(s, 1);
            float s2 = 0.f;
#pragma unroll
            for (int c = 0; c < 8; ++c) { float f[8]; unpack8(*(const u32x4*)(urow + UKV + half * 64 + c * 8), f);
#pragma unroll
                for (int e = 0; e < 8; ++e) s2 += f[e] * f[e]; }
            s2 += __shfl_xor(s2, 1);
            if (half == 0) { rstd_q[row] = rsqrtf(s * (1.0f / 256.0f) + 1e-6f); rstd_kv[row] = rsqrtf(s2 * (1.0f / 128.0f) + 1e-6f); }
        }
#pragma unroll 1
        for (int i = 0; i < 10; ++i) {
            int tl = t; LAUNDER(tl);
            const int c = tl + 256 * i, row = c / 20, chn = c - row * 20, grow = rt * 128 + row;
            const bf16_t* up = p.U + (size_t)grow * LDU + UXW + chn * 8;
            float cur[8], prv[8];
            unpack8(*(const u32x4*)up, cur);
            if ((grow & 4095) > 0) unpack8(*(const u32x4*)(up - LDU), prv);
            else {
#pragma unroll
                for (int e = 0; e < 8; ++e) prv[e] = 0.f; }
            const f32x4 m0 = *(const f32x4*)(p.rwkv_mu + 1536 + chn * 8), m1 = *(const f32x4*)(p.rwkv_mu + 1536 + chn * 8 + 4);
            float o[8];
#pragma unroll
            for (int e = 0; e < 8; ++e) {
                const float x = cur[e] + (prv[e] - cur[e]) * (e < 4 ? m0[e & 3] : m1[e & 3]);
                o[e] = chn < 4 ? tanhf(x) : (chn < 8 ? x : sigmoidf_(x));
            }
            *(u32x4*)(lora + row * 160 + chn * 8) = mk4(pk2(o[0], o[1]), pk2(o[2], o[3]), pk2(o[4], o[5]), pk2(o[6], o[7]));
        }
        asm volatile("s_waitcnt vmcnt(0)" ::: "memory");
        __syncthreads();
        STAMP(17);
        {
            APlain ap{p.U + (size_t)rt * 128 * LDU + UQ, LDU};
            gemm_stream<2, 6, 4, 64, 6>(ap, p.wq_t, 256, 256, 8, [](int u, int& ao, int& bo) { ao = 0; bo = u * 96 * 256; },
                [&](const int h, f32x4 (&acc)[2][6]) {
                    int tl = t; LAUNDER(tl);
                    const int lane = tl & 63, w = tl >> 6, r = lane & 15, q = lane >> 4;
#pragma unroll
                    for (int i = 0; i < 2; ++i) {
                        const int row = 32 * w + 16 * i + r, grow = rt * 128 + row, b = grow >> 12, tt = grow & 4095;
                        const float rq = rstd_q[row];
                        f32x4 v[6];
#pragma unroll
                        for (int j = 0; j < 6; ++j) v[j] = acc[i][j] * rq;
                        head96_finish(v, q, p.q_norm, p.rope + (size_t)grow * 32, QSCALE, p.Q + ((size_t)(b * 8 + h) * NT_ + tt) * 96);
                    }
                }, lds);
        }
        STAMP(18);
        {
            APlain ap{p.U + (size_t)rt * 128 * LDU + UKV, LDU};
            gemm_stream<2, 8, 4, 64, 4>(ap, p.wkv_t, 128, 128, 8, [](int u, int& ao, int& bo) { ao = 0; bo = u * 128 * 128; },
                [&](const int h, f32x4 (&acc)[2][8]) {
                    int tl = t; LAUNDER(tl);
                    const int lane = tl & 63, w = tl >> 6, r = lane & 15, q = lane >> 4;
#pragma unroll
                    for (int i = 0; i < 2; ++i) {
                        const int row = 32 * w + 16 * i + r, grow = rt * 128 + row, b = grow >> 12, tt = grow & 4095;
                        const float rk = rstd_kv[row];
                        const bf16_t* urow = p.U + (size_t)grow * LDU;
                        f32x4 v[6];
#pragma unroll
                        for (int j = 0; j < 4; ++j) v[j] = acc[i][j] * rk;
                        v[4] = unpack4(*(const u32x2*)(urow + UPE + q * 4));
                        v[5] = unpack4(*(const u32x2*)(urow + UPE + 16 + q * 4));
                        head96_finish(v, q, p.k_norm, p.rope + (size_t)grow * 32, 1.0f, p.Kb + ((size_t)(b * 8 + h) * NT_ + tt) * 96);
                        const int tok0 = 32 * w + 16 * i + 4 * q;
                        const f32x4 rk4 = *(const f32x4*)(rstd_kv + tok0);
                        bf16_t* vd = p.Vt + ((size_t)((rt >> 5) * 8 + h) * 64) * NT_ + (rt & 31) * 128 + tok0;
#pragma unroll
                        for (int j = 4; j < 8; ++j) *(u32x2*)(vd + (size_t)((j - 4) * 16 + r) * NT_) = pack4(acc[i][j] * rk4);
                    }
                }, lds);
        }
        STAMP(19);
        bf16_t* abuf = (bf16_t*)(p.bscr + (size_t)bid * BSCR_PER_BLOCK);
        {
            APlain ap{lora, 160};
            gemm_stream<4, 4, 2, 32, 4>(ap, p.wdec_t, 32, 32, 4, [](int u, int& ao, int& bo) { ao = 0; bo = u * 128 * 32; },
                [&](const int ct, f32x4 (&acc)[4][4]) {
                    int tl = t; LAUNDER(tl);
                    const int lane = tl & 63, wid = tl >> 6, wr = wid >> 1, wc = wid & 1, r = lane & 15, q = lane >> 4, head = ct * 2 + wc;
#pragma unroll
                    for (int i = 0; i < 4; ++i) {
                        const int grow = rt * 128 + wr * 64 + i * 16 + r, b = grow >> 12, tt = grow & 4095;
                        bf16_t* sc = p.SC + ((size_t)(b * 8 + head) * NT_ + tt) * 384 + q * 4;
#pragma unroll
                        for (int j = 0; j < 4; ++j) {
                            const f32x4 w0 = *(const f32x4*)(p.decay_w0 + head * 64 + j * 16 + q * 4);
                            f32x4 o;
#pragma unroll
                            for (int e = 0; e < 4; ++e) o[e] = 1.0f - __expf(-0.6065306597f * sigmoidf_(w0[e] + acc[i][j][e]));
                            *(u32x2*)(sc + j * 16) = pack4(o);
                        }
                    }
                }, lds);
        }
        {
            APlain ap{lora + 32, 160};
            gemm_stream<4, 4, 2, 32, 4>(ap, p.wiclr_t, 32, 32, 4, [](int u, int& ao, int& bo) { ao = 0; bo = u * 128 * 32; },
                [&](const int ct, f32x4 (&acc)[4][4]) {
                    int tl = t; LAUNDER(tl);
                    const int lane = tl & 63, wid = tl >> 6, wr = wid >> 1, wc = wid & 1, r = lane & 15, q = lane >> 4, c0 = ct * 128 + wc * 64 + q * 4;
#pragma unroll
                    for (int i = 0; i < 4; ++i) {
                        bf16_t* ar = abuf + (wr * 64 + i * 16 + r) * 512 + c0;
#pragma unroll
                        for (int j = 0; j < 4; ++j) {
                            const f32x4 a0 = *(const f32x4*)(p.iclr_a0 + c0 + j * 16);
                            f32x4 o;
#pragma unroll
                            for (int e = 0; e < 4; ++e) o[e] = sigmoidf_(a0[e] + acc[i][j][e]);
                            *(u32x2*)(ar + j * 16) = pack4(o);
                        }
                    }
                }, lds);
        }
        {
            APlain ap{lora + 64, 160};
            gemm_stream<4, 4, 2, 32, 4>(ap, p.wgate_t, 96, 96, 4, [](int u, int& ao, int& bo) { ao = 0; bo = u * 128 * 96; },
                [&](const int ct, f32x4 (&acc)[4][4]) {
                    int tl = t; LAUNDER(tl);
                    const int lane = tl & 63, wid = tl >> 6, wr = wid >> 1, wc = wid & 1, r = lane & 15, q = lane >> 4, head = ct * 2 + wc;
#pragma unroll
                    for (int i = 0; i < 4; ++i) {
                        const int grow = rt * 128 + wr * 64 + i * 16 + r;
                        bf16_t* g = p.Gg + (size_t)grow * 512 + head * 64 + q * 4;
#pragma unroll
                        for (int j = 0; j < 4; ++j) *(u32x2*)(g + j * 16) = pack4(acc[i][j]);
                    }
                }, lds);
        }
        asm volatile("s_waitcnt vmcnt(0)" ::: "memory");
        __syncthreads();
#pragma unroll 1
        for (int it = 0; it < 16; ++it) {
            int tl = t; LAUNDER(tl);
            const int lane = tl & 63, w = tl >> 6, c8 = lane * 8;
#pragma unroll
            for (int u = 0; u < 2; ++u) {
                const int row = w + 4 * (it * 2 + u), grow = rt * 128 + row, b = grow >> 12, tt = grow & 4095;
                const bool hp = tt > 0;
                const bf16_t* urow = p.U + (size_t)grow * LDU + c8;
                float kc[8], kp_[8], vc[8], vp[8], rc[8], rp[8], av[8];
                unpack8(*(const u32x4*)(urow + UK), kc); unpack8(*(const u32x4*)(urow + UV), vc); unpack8(*(const u32x4*)(urow + UR), rc);
                unpack8(*(const u32x4*)(abuf + row * 512 + c8), av);
                if (hp) { unpack8(*(const u32x4*)(urow + UK - LDU), kp_); unpack8(*(const u32x4*)(urow + UV - LDU), vp); unpack8(*(const u32x4*)(urow + UR - LDU), rp); }
                else {
#pragma unroll
                    for (int e = 0; e < 8; ++e) { kp_[e] = 0.f; vp[e] = 0.f; rp[e] = 0.f; } }
                float mk[8], mv[8], mr[8], kkw[8], kaw[8];
                *(f32x4*)(mk) = *(const f32x4*)(p.rwkv_mu + 512 + c8); *(f32x4*)(mk + 4) = *(const f32x4*)(p.rwkv_mu + 512 + c8 + 4);
                *(f32x4*)(mv) = *(const f32x4*)(p.rwkv_mu + 1024 + c8); *(f32x4*)(mv + 4) = *(const f32x4*)(p.rwkv_mu + 1024 + c8 + 4);
                *(f32x4*)(mr) = *(const f32x4*)(p.rwkv_mu + c8); *(f32x4*)(mr + 4) = *(const f32x4*)(p.rwkv_mu + c8 + 4);
                *(f32x4*)(kkw) = *(const f32x4*)(p.k_k + c8); *(f32x4*)(kkw + 4) = *(const f32x4*)(p.k_k + c8 + 4);
                *(f32x4*)(kaw) = *(const f32x4*)(p.k_a + c8); *(f32x4*)(kaw + 4) = *(const f32x4*)(p.k_a + c8 + 4);
                float ks[8], kq[8], ssq = 0.f;
#pragma unroll
                for (int e = 0; e < 8; ++e) { ks[e] = kc[e] + (kp_[e] - kc[e]) * mk[e]; kq[e] = ks[e] * kkw[e]; ssq += kq[e] * kq[e]; }
                ssq = dpp_sum8(ssq);
                const float rn = rsqrtf(fmaxf(ssq, 1e-24f));
                float okk[8], obb[8], okp[8], ov[8], orr[8];
#pragma unroll
                for (int e = 0; e < 8; ++e) {
                    okk[e] = kq[e] * rn; obb[e] = av[e] * okk[e]; okp[e] = ks[e] * (1.0f + (av[e] - 1.0f) * kaw[e]);
                    ov[e] = vc[e] + (vp[e] - vc[e]) * mv[e]; orr[e] = rc[e] + (rp[e] - rc[e]) * mr[e];
                }
                bf16_t* sc = p.SC + ((size_t)(b * 8 + (lane >> 3)) * NT_ + tt) * 384 + (lane & 7) * 8;
                *(u32x4*)(sc + 64) = mk4(pk2(okk[0], okk[1]), pk2(okk[2], okk[3]), pk2(okk[4], okk[5]), pk2(okk[6], okk[7]));
                *(u32x4*)(sc + 128) = mk4(pk2(obb[0], obb[1]), pk2(obb[2], obb[3]), pk2(obb[4], obb[5]), pk2(obb[6], obb[7]));
                *(u32x4*)(sc + 192) = mk4(pk2(okp[0], okp[1]), pk2(okp[2], okp[3]), pk2(okp[4], okp[5]), pk2(okp[6], okp[7]));
                *(u32x4*)(sc + 256) = mk4(pk2(ov[0], ov[1]), pk2(ov[2], ov[3]), pk2(ov[4], ov[5]), pk2(ov[6], ov[7]));
                *(u32x4*)(sc + 320) = mk4(pk2(orr[0], orr[1]), pk2(orr[2], orr[3]), pk2(orr[4], orr[5]), pk2(orr[6], orr[7]));
            }
        }
    }
}

struct ScanOps { f32x2_t d[4], k[4], b[4], p[4], r[4]; float v; };
DI void scan_load(ScanOps& o, const float* __restrict__ q, const float* __restrict__ vp) {
    const f32x4 d0 = *(const f32x4*)(q), d1 = *(const f32x4*)(q + 4), k0 = *(const f32x4*)(q + 64), k1 = *(const f32x4*)(q + 68);
    const f32x4 b0 = *(const f32x4*)(q + 128), b1 = *(const f32x4*)(q + 132), p0 = *(const f32x4*)(q + 192), p1 = *(const f32x4*)(q + 196);
    const f32x4 r0 = *(const f32x4*)(q + 320), r1 = *(const f32x4*)(q + 324);
    o.d[0] = (f32x2_t){d0[0], d0[1]}; o.d[1] = (f32x2_t){d0[2], d0[3]}; o.d[2] = (f32x2_t){d1[0], d1[1]}; o.d[3] = (f32x2_t){d1[2], d1[3]};
    o.k[0] = (f32x2_t){k0[0], k0[1]}; o.k[1] = (f32x2_t){k0[2], k0[3]}; o.k[2] = (f32x2_t){k1[0], k1[1]}; o.k[3] = (f32x2_t){k1[2], k1[3]};
    o.b[0] = (f32x2_t){b0[0], b0[1]}; o.b[1] = (f32x2_t){b0[2], b0[3]}; o.b[2] = (f32x2_t){b1[0], b1[1]}; o.b[3] = (f32x2_t){b1[2], b1[3]};
    o.p[0] = (f32x2_t){p0[0], p0[1]}; o.p[1] = (f32x2_t){p0[2], p0[3]}; o.p[2] = (f32x2_t){p1[0], p1[1]}; o.p[3] = (f32x2_t){p1[2], p1[3]};
    o.r[0] = (f32x2_t){r0[0], r0[1]}; o.r[1] = (f32x2_t){r0[2], r0[3]}; o.r[2] = (f32x2_t){r1[0], r1[1]}; o.r[3] = (f32x2_t){r1[2], r1[3]};
    o.v = *vp;
}
DI void scan_task(const Params& p, unsigned char* lds, const int task) {
    constexpr int CS = 16;
    const int t = threadIdx.x, lane = t & 63, w = t >> 6;
    const int bh = task >> 1, hf = task & 1, b = bh >> 3, head = bh & 7;
    const int rloc = w * 8 + (lane >> 3), kseg = lane & 7;
    const int vrow = hf * 32 + rloc;
    float* stage = (float*)lds;
    float* ybuf = (float*)(lds + 49152);
    const bf16_t* src = p.SC + (size_t)bh * NT_ * 384;
    f32x2_t s2[4];
#pragma unroll
    for (int j = 0; j < 4; ++j) s2[j] = (f32x2_t){0.f, 0.f};
    u32x4 rg[3];
    __builtin_amdgcn_s_setprio(3);
    __syncthreads();
#pragma unroll
    for (int i = 0; i < 3; ++i) rg[i] = *(const u32x4*)(src + (size_t)(t + 256 * i) * 8);
#pragma unroll
    for (int i = 0; i < 3; ++i) { float* d = stage + (t + 256 * i) * 8;
        *(f32x4*)d = (f32x4){lo2f(rg[i].x), hi2f(rg[i].x), lo2f(rg[i].y), hi2f(rg[i].y)}; *(f32x4*)(d + 4) = (f32x4){lo2f(rg[i].z), hi2f(rg[i].z), lo2f(rg[i].w), hi2f(rg[i].w)}; }
    __syncthreads();
    constexpr int NCH = NT_ / CS;
    for (int c = 0; c < NCH; ++c) {
        const int cur = c & 1;
        if (c + 1 < NCH) {
#pragma unroll
            for (int i = 0; i < 3; ++i) rg[i] = *(const u32x4*)(src + (size_t)(c + 1) * CS * 384 + (size_t)(t + 256 * i) * 8);
        }
        if (c > 0) {
            const float* yb = ybuf + (cur ^ 1) * CS * 32;
            const int st = t >> 4, r2 = (t & 15) * 2;
            *(f32x2_t*)(p.yraw + ((size_t)(b * NT_ + (c - 1) * CS + st)) * 512 + head * 64 + hf * 32 + r2) = *(const f32x2_t*)(yb + st * 32 + r2);
        }
        const float* sb = stage + cur * CS * 384 + kseg * 8;
        float* yb = ybuf + cur * CS * 32;
        float yv[CS];
        ScanOps oc, on;
        scan_load(oc, sb, sb + 256 - kseg * 8 + vrow);
#pragma unroll
        for (int st = 0; st < CS; ++st) {
            if (st + 1 < CS) scan_load(on, sb + (st + 1) * 384, sb + (st + 1) * 384 + 256 - kseg * 8 + vrow);
            f32x2_t t0 = s2[0] * oc.k[0], t1 = s2[1] * oc.k[1];
            t0 = s2[2] * oc.k[2] + t0; t1 = s2[3] * oc.k[3] + t1;
            t0 = t0 + t1;
            float dot = dpp_sum8(t0.x + t0.y);
            const f32x2_t vv2 = {oc.v, oc.v}, nd2 = {-dot, -dot};
            f32x2_t u0, u1;
#pragma unroll
            for (int j = 0; j < 4; ++j) { f32x2_t tmp = s2[j] - s2[j] * oc.d[j]; tmp = vv2 * oc.p[j] + tmp; s2[j] = nd2 * oc.b[j] + tmp; }
            u0 = s2[0] * oc.r[0]; u1 = s2[1] * oc.r[1];
            u0 = s2[2] * oc.r[2] + u0; u1 = s2[3] * oc.r[3] + u1;
            u0 = u0 + u1;
            yv[st] = dpp_sum8(u0.x + u0.y);
            if (st + 1 < CS) oc = on;
        }
        if (kseg == 0) {
#pragma unroll
            for (int st = 0; st < CS; ++st) yb[st * 32 + rloc] = yv[st];
        }
        if (c + 1 < NCH) {
            float* dbase = stage + (cur ^ 1) * CS * 384;
#pragma unroll
            for (int i = 0; i < 3; ++i) { float* d = dbase + (t + 256 * i) * 8;
                *(f32x4*)d = (f32x4){lo2f(rg[i].x), hi2f(rg[i].x), lo2f(rg[i].y), hi2f(rg[i].y)}; *(f32x4*)(d + 4) = (f32x4){lo2f(rg[i].z), hi2f(rg[i].z), lo2f(rg[i].w), hi2f(rg[i].w)}; }
        }
        __syncthreads();
    }
    {
        const float* yb = ybuf + ((NCH - 1) & 1) * CS * 32;
        const int st = t >> 4, r2 = (t & 15) * 2;
        *(f32x2_t*)(p.yraw + ((size_t)(b * NT_ + (NCH - 1) * CS + st)) * 512 + head * 64 + hf * 32 + r2) = *(const f32x2_t*)(yb + st * 32 + r2);
    }
    __builtin_amdgcn_s_setprio(0);
}

DI void attn_item(const Params& p, unsigned char* lds, const int item) {
    constexpr int KROW = 208, VROW = 136, KB = 64 * KROW, BUF = KB + 64 * VROW;
    const int t = threadIdx.x, lane = t & 63, w = t >> 6, l31 = lane & 31, h = lane >> 5;
    const int qt = 31 - item / 128, bh = item % 128;
    const bf16_t* Kg = p.Kb + (size_t)bh * NT_ * 96;
    const bf16_t* Vg = p.Vt + (size_t)bh * 64 * NT_;
    const int q = qt * 128 + w * 32 + l31;
    bf16x8 qf[6];
    {
        const bf16_t* qrow = p.Q + ((size_t)bh * NT_ + q) * 96 + 8 * h;
#pragma unroll
        for (int s = 0; s < 6; ++s) qf[s] = *(const bf16x8*)(qrow + 16 * s);
    }
    f32x16 O[2];
#pragma unroll
    for (int i = 0; i < 16; ++i) { O[0][i] = 0.f; O[1][i] = 0.f; }
    float m = -INFINITY, l = 0.f;
    const int njt = 2 * qt + 2;
    int koff[3], kgo[3], voff[2], vgo[2];
#pragma unroll
    for (int i = 0; i < 3; ++i) { const int c = t + 256 * i, r = c / 12, ch = c - r * 12; koff[i] = r * KROW + ch * 16; kgo[i] = r * 96 + ch * 8; }
#pragma unroll
    for (int i = 0; i < 2; ++i) { const int c = t + 256 * i, dv = c >> 3, ch = c & 7; voff[i] = KB + dv * VROW + ch * 16; vgo[i] = dv * NT_ + ch * 8; }
    u32x4 rk0[3], rv0[2], rk1[3], rv1[2];
#define AT_LOAD(RK, RV, J) { _Pragma("unroll") for (int i = 0; i < 3; ++i) RK[i] = *(const u32x4*)(Kg + (size_t)(J) * 64 * 96 + kgo[i]); \
                             _Pragma("unroll") for (int i = 0; i < 2; ++i) RV[i] = *(const u32x4*)(Vg + (J) * 64 + vgo[i]); }
#define AT_WRITE(RK, RV, BUFI) { unsigned char* nb = lds + (BUFI) * BUF; _Pragma("unroll") for (int i = 0; i < 3; ++i) *(u32x4*)(nb + koff[i]) = RK[i]; \
                             _Pragma("unroll") for (int i = 0; i < 2; ++i) { *(u32x2*)(nb + voff[i]) = mk2(RV[i].x, RV[i].y); *(u32x2*)(nb + voff[i] + 8) = mk2(RV[i].z, RV[i].w); } }
    auto tile_compute = [&](const int cur, const int j) {
        const bool active = (j * 64) <= (qt * 128 + w * 32 + 31);
        if (active) {
            const unsigned char* Kt = lds + cur * BUF;
            const unsigned char* Vtile = Kt + KB;
            f32x16 S[2];
#pragma unroll
            for (int k2 = 0; k2 < 2; ++k2) {
#pragma unroll
                for (int i = 0; i < 16; ++i) S[k2][i] = 0.f;
#pragma unroll
                for (int s = 0; s < 6; ++s) {
                    const bf16x8 kf = *(const bf16x8*)(Kt + (k2 * 32 + l31) * KROW + s * 32 + h * 16);
                    S[k2] = __builtin_amdgcn_mfma_f32_32x32x16_bf16(kf, qf[s], S[k2], 0, 0, 0);
                }
            }
            if (j >= 2 * qt) {
#pragma unroll
                for (int k2 = 0; k2 < 2; ++k2)
#pragma unroll
                    for (int i = 0; i < 16; ++i) { const int key = j * 64 + k2 * 32 + (i & 3) + 8 * (i >> 2) + 4 * h; if (key > q) S[k2][i] = -INFINITY; }
            }
            float mx = S[0][0];
#pragma unroll
            for (int i = 1; i < 16; ++i) mx = fmaxf(mx, S[0][i]);
#pragma unroll
            for (int i = 0; i < 16; ++i) mx = fmaxf(mx, S[1][i]);
            mx = fmaxf(mx, __shfl_xor(mx, 32));
            if (__any(mx > m)) {
                const float mn = fmaxf(m, mx);
                const float alpha = __builtin_amdgcn_exp2f(m - mn);
                m = mn; l *= alpha;
#pragma unroll
                for (int i = 0; i < 16; ++i) { O[0][i] *= alpha; O[1][i] *= alpha; }
            }
            f32x2_t ps2 = {0.f, 0.f};
#pragma unroll
            for (int k2 = 0; k2 < 2; ++k2)
#pragma unroll
                for (int i = 0; i < 16; i += 2) {
                    const float e0 = __builtin_amdgcn_exp2f(S[k2][i] - m), e1 = __builtin_amdgcn_exp2f(S[k2][i + 1] - m);
                    S[k2][i] = e0; S[k2][i + 1] = e1; ps2 += (f32x2_t){e0, e1};
                }
            l += ps2.x + ps2.y;
#pragma unroll
            for (int k2 = 0; k2 < 2; ++k2)
#pragma unroll
                for (int s2 = 0; s2 < 2; ++s2) {
                    unsigned pw[4];
#pragma unroll
                    for (int e = 0; e < 4; ++e) pw[e] = pk2(S[k2][8 * s2 + 2 * e], S[k2][8 * s2 + 2 * e + 1]);
                    const bf16x8 pf = __builtin_bit_cast(bf16x8, mk4(pw[0], pw[1], pw[2], pw[3]));
#pragma unroll
                    for (int dt = 0; dt < 2; ++dt) {
                        const unsigned char* vp = Vtile + (dt * 32 + l31) * VROW + (k2 * 32 + s2 * 16 + 4 * h) * 2;
                        const u32x2 v0 = *(const u32x2*)(vp), v1 = *(const u32x2*)(vp + 16);
                        const bf16x8 vf = __builtin_bit_cast(bf16x8, mk4(v0.x, v0.y, v1.x, v1.y));
                        O[dt] = __builtin_amdgcn_mfma_f32_32x32x16_bf16(vf, pf, O[dt], 0, 0, 0);
                    }
                }
        }
    };
    AT_LOAD(rk0, rv0, 0)
    if (njt > 1) AT_LOAD(rk1, rv1, 1)
    __syncthreads();
    AT_WRITE(rk0, rv0, 0)
    if (njt > 2) AT_LOAD(rk0, rv0, 2)
    __syncthreads();
#pragma unroll 1
    for (int j = 0; j < njt; j += 2) {
        tile_compute(0, j);
        if (j + 1 < njt) { AT_WRITE(rk1, rv1, 1) if (j + 3 < njt) AT_LOAD(rk1, rv1, j + 3) }
        __syncthreads();
        if (j + 1 >= njt) break;
        tile_compute(1, j + 1);
        if (j + 2 < njt) { AT_WRITE(rk0, rv0, 0) if (j + 4 < njt) AT_LOAD(rk0, rv0, j + 4) }
        __syncthreads();
    }
#undef AT_LOAD
#undef AT_WRITE
    l += __shfl_xor(l, 32);
    const float inv = 1.0f / l;
    bf16_t* yrow = p.Y + ((size_t)((bh >> 3) * NT_ + q)) * DM + 512 + (bh & 7) * 64;
#pragma unroll
    for (int dt = 0; dt < 2; ++dt)
#pragma unroll
        for (int g = 0; g < 4; ++g)
            *(u32x2*)(yrow + dt * 32 + 8 * g + 4 * h) = mk2(pk2(O[dt][4 * g] * inv, O[dt][4 * g + 1] * inv), pk2(O[dt][4 * g + 2] * inv, O[dt][4 * g + 3] * inv));
}

DI void phase4(const Params& p, unsigned char* lds, int bid, int G) {
    int* sh_item = (int*)(lds + LDS_BYTES - 64);
    for (int task = bid; task < 256; task += G) scan_task(p, lds, task);
    STAMP(10);
    for (;;) {
        __syncthreads();
        if (threadIdx.x == 0) *sh_item = (int)atomicAdd(&p.ctrl[CTRL_ATTNQ], 1u);
        __syncthreads();
        const int item = *sh_item;
        if (item >= 4096) break;
        attn_item(p, lds, item);
    }
}

DI void phase5(const Params& p, unsigned char* lds, int bid, int G) {
    const int t = threadIdx.x, lane = t & 63, wid = t >> 6, wr = wid >> 1, wc = wid & 1;
    float* tile = (float*)lds;
    float* ssq = (float*)(lds + 69632);
    float* biasl = ssq + 128;
    int* lcnt = (int*)(lds + 65536);
    int* lbase = lcnt + 256;
    unsigned char* le = (unsigned char*)(lbase + 256);
    unsigned char* lp = le + 1024;
    __syncthreads();
    biasl[t] = p.router_bias[t];
    float* scores = (float*)(p.bscr + (size_t)bid * BSCR_PER_BLOCK);
    bf16_t* act = (bf16_t*)(p.bscr + (size_t)bid * BSCR_PER_BLOCK + 131072);
    for (int rt = bid; rt < NTOK / 128; rt += G) {
        const int b = rt >> 5;
        const float* mod = p.mod + b * 6144;
        __syncthreads();
        if (t < 128) ssq[t] = 0.f;
        lcnt[t] = 0;
#pragma unroll 2
        for (int it = 0; it < 16; ++it) {
            int tl = t; LAUNDER(tl);
            const int pr = (tl >> 2) + 64 * it;
            const int row = pr >> 3, head = pr & 7, part = tl & 3, grow = rt * 128 + row, tt = grow & 4095;
            const int ch = head * 64 + part * 16;
            const float* yr = p.yraw + (size_t)grow * 512 + ch;
            float y[16];
#pragma unroll
            for (int i = 0; i < 4; ++i) { const f32x4 v = *(const f32x4*)(yr + 4 * i); y[4 * i] = v[0]; y[4 * i + 1] = v[1]; y[4 * i + 2] = v[2]; y[4 * i + 3] = v[3]; }
            float sm = 0.f;
#pragma unroll
            for (int i = 0; i < 16; ++i) sm += y[i];
            sm += __shfl_xor(sm, 1); sm += __shfl_xor(sm, 2);
            const float mean = sm * (1.0f / 64.0f);
            float vr = 0.f;
#pragma unroll
            for (int i = 0; i < 16; ++i) { const float d = y[i] - mean; vr += d * d; }
            vr += __shfl_xor(vr, 1); vr += __shfl_xor(vr, 2);
            const float rs = rsqrtf(vr * (1.0f / 64.0f) + 64e-5f);
            const bf16_t* sc = p.SC + ((size_t)(b * 8 + head) * NT_ + tt) * 384 + part * 16;
            float kp[16], vv[16], rr[16];
#pragma unroll
            for (int i = 0; i < 2; ++i) {
                const u32x4 a = *(const u32x4*)(sc + 192 + 8 * i), c = *(const u32x4*)(sc + 256 + 8 * i), d = *(const u32x4*)(sc + 320 + 8 * i);
                kp[8 * i] = lo2f(a.x); kp[8 * i + 1] = hi2f(a.x); kp[8 * i + 2] = lo2f(a.y); kp[8 * i + 3] = hi2f(a.y); kp[8 * i + 4] = lo2f(a.z); kp[8 * i + 5] = hi2f(a.z); kp[8 * i + 6] = lo2f(a.w); kp[8 * i + 7] = hi2f(a.w);
                vv[8 * i] = lo2f(c.x); vv[8 * i + 1] = hi2f(c.x); vv[8 * i + 2] = lo2f(c.y); vv[8 * i + 3] = hi2f(c.y); vv[8 * i + 4] = lo2f(c.z); vv[8 * i + 5] = hi2f(c.z); vv[8 * i + 6] = lo2f(c.w); vv[8 * i + 7] = hi2f(c.w);
                rr[8 * i] = lo2f(d.x); rr[8 * i + 1] = hi2f(d.x); rr[8 * i + 2] = lo2f(d.y); rr[8 * i + 3] = hi2f(d.y); rr[8 * i + 4] = lo2f(d.z); rr[8 * i + 5] = hi2f(d.z); rr[8 * i + 6] = lo2f(d.w); rr[8 * i + 7] = hi2f(d.w);
            }
            float bn = 0.f;
#pragma unroll
            for (int i = 0; i < 16; ++i) bn += rr[i] * kp[i] * p.r_k[ch + i];
            bn += __shfl_xor(bn, 1); bn += __shfl_xor(bn, 2);
            const bf16_t* gg = p.Gg + (size_t)grow * 512 + ch;
            const u32x4 g0 = *(const u32x4*)(gg), g1 = *(const u32x4*)(gg + 8);
            float g[16] = {lo2f(g0.x), hi2f(g0.x), lo2f(g0.y), hi2f(g0.y), lo2f(g0.z), hi2f(g0.z), lo2f(g0.w), hi2f(g0.w), lo2f(g1.x), hi2f(g1.x), lo2f(g1.y), hi2f(g1.y), lo2f(g1.z), hi2f(g1.z), lo2f(g1.w), hi2f(g1.w)};
            float o[16];
#pragma unroll
            for (int i = 0; i < 16; ++i) o[i] = ((y[i] - mean) * rs * p.ln_w[ch + i] + p.ln_b[ch + i] + bn * vv[i]) * g[i];
            bf16_t* yd = p.Y + (size_t)grow * DM + ch;
            *(u32x4*)(yd) = mk4(pk2(o[0], o[1]), pk2(o[2], o[3]), pk2(o[4], o[5]), pk2(o[6], o[7]));
            *(u32x4*)(yd + 8) = mk4(pk2(o[8], o[9]), pk2(o[10], o[11]), pk2(o[12], o[13]), pk2(o[14], o[15]));
        }
        asm volatile("s_waitcnt vmcnt(0)" ::: "memory");
        __syncthreads();
        STAMP(11);
        {
            APlain ap{p.Y + (size_t)rt * 128 * DM, DM};
            gemm_stream<4, 4, 2, 64, 4>(ap, p.wout_t, DM, DM, 8, [](int u, int& ao, int& bo) { ao = 0; bo = u * 128 * DM; },
                [&](const int ct, f32x4 (&acc)[4][4]) {
                    int ll = lane; LAUNDER(ll);
#pragma unroll
                    for (int i = 0; i < 4; ++i) {
                        const int row = wr * 64 + i * 16 + (ll & 15), grow = rt * 128 + row;
                        float sq = 0.f;
#pragma unroll
                        for (int j = 0; j < 4; ++j) {
                            const int col = ct * 128 + wc * 64 + j * 16 + (ll >> 4) * 4;
                            const f32x4 xv = *(const f32x4*)(p.x + (size_t)grow * DM + col), ga = *(const f32x4*)(mod + 2048 + col);
                            f32x4 o;
#pragma unroll
                            for (int e = 0; e < 4; ++e) { o[e] = xv[e] + ga[e] * acc[i][j][e]; sq += o[e] * o[e]; }
                            *(f32x4*)(p.out + (size_t)grow * DM + col) = o;
                        }
                        sq += __shfl_xor(sq, 16); sq += __shfl_xor(sq, 32);
                        if ((ll >> 4) == 0) atomicAdd(&ssq[row], sq);
                    }
                }, lds);
        }
        asm volatile("s_waitcnt vmcnt(0)" ::: "memory");
        __syncthreads();
        STAMP(12);
#pragma unroll 1
        for (int mg = 0; mg < 8; ++mg) {
            int ll = lane; LAUNDER(ll);
            f32x4 xv[4][4];
#pragma unroll
            for (int u = 0; u < 4; ++u)
#pragma unroll
                for (int i = 0; i < 4; ++i) xv[u][i] = *(const f32x4*)(p.out + (size_t)(rt * 128 + wid + 4 * (mg * 4 + u)) * DM + ll * 4 + 256 * i);
#pragma unroll
            for (int u = 0; u < 4; ++u) {
                const int r = wid + 4 * (mg * 4 + u), grow = rt * 128 + r;
                const float rs = rsqrtf(ssq[r] * (1.0f / DM) + 1e-6f);
#pragma unroll
                for (int i = 0; i < 4; ++i) {
                    const int c = ll * 4 + 256 * i;
                    const f32x4 g = *(const f32x4*)(p.norm_ffn + c), sh = *(const f32x4*)(mod + 3072 + c), sc = *(const f32x4*)(mod + 4096 + c);
                    float o[4];
#pragma unroll
                    for (int e = 0; e < 4; ++e) o[e] = xv[u][i][e] * rs * g[e] * (1.0f + sc[e]) + sh[e];
                    *(u32x2*)(p.H + (size_t)grow * DM + c) = mk2(pk2(o[0], o[1]), pk2(o[2], o[3]));
                }
            }
        }
        asm volatile("s_waitcnt vmcnt(0)" ::: "memory");
        __syncthreads();
        STAMP(13);
        {
            APlain ap{p.H + (size_t)rt * 128 * DM, DM};
            gemm_stream<4, 4, 2, 64, 4>(ap, p.wr_t, DM, DM, 2, [](int u, int& ao, int& bo) { ao = 0; bo = u * 128 * DM; },
                [&](const int ct, f32x4 (&acc)[4][4]) {
                    int ll = lane; LAUNDER(ll);
#pragma unroll
                    for (int i = 0; i < 4; ++i)
#pragma unroll
                        for (int j = 0; j < 4; ++j) {
                            const int row = wr * 64 + i * 16 + (ll & 15), col = ct * 128 + wc * 64 + j * 16 + (ll >> 4) * 4;
#pragma unroll
                            for (int e = 0; e < 4; ++e) scores[(col + e) * 128 + row] = sigmoidf_(acc[i][j][e]);
                        }
                }, lds);
        }
        asm volatile("s_waitcnt vmcnt(0)" ::: "memory");
        __syncthreads();
        STAMP(14);
#pragma unroll 1
        for (int hh = 0; hh < 2; ++hh) {
            __syncthreads();
            {
                int tl = t; LAUNDER(tl);
                f32x4 rgs[16];
#pragma unroll
                for (int i = 0; i < 16; ++i) { const int c = tl + 256 * i; rgs[i] = *(const f32x4*)(scores + (c >> 4) * 128 + hh * 64 + (c & 15) * 4); }
#pragma unroll
                for (int i = 0; i < 16; ++i) *(f32x4*)(tile + (tl + 256 * i) * 4) = rgs[i];
            }
            __syncthreads();
            if (t < 64) {
                int tl = t; LAUNDER(tl);
                const int token = rt * 128 + hh * 64 + tl;
                const float* sc = tile + tl;
                float gs[8];
#pragma unroll
                for (int g = 0; g < 8; ++g) {
                    float m1 = -INFINITY, m2 = -INFINITY;
#pragma unroll 8
                    for (int i = 0; i < 32; ++i) { const float v = sc[(g * 32 + i) * 64] + biasl[g * 32 + i]; m2 = fmaxf(m2, fminf(m1, v)); m1 = fmaxf(m1, v); }
                    gs[g] = m1 + m2;
                }
                unsigned selmask = 0u;
#pragma unroll
                for (int g = 0; g < 8; ++g) {
                    int rank = 0;
#pragma unroll
                    for (int g2 = 0; g2 < 8; ++g2) rank += (gs[g2] > gs[g] || (gs[g2] == gs[g] && g2 < g)) ? 1 : 0;
                    selmask |= (rank < 4 ? 1u : 0u) << g;
                }
                float tv[8]; int ti[8];
#pragma unroll
                for (int k = 0; k < 8; ++k) { tv[k] = -INFINITY; ti[k] = 0; }
#pragma unroll 1
                for (int g = 0; g < 8; ++g) {
                    if ((selmask >> g) & 1u) {
#pragma unroll 4
                        for (int i = 0; i < 32; ++i) {
                            const int e = g * 32 + i;
                            const float v = sc[e * 64] + biasl[e];
                            if (v > tv[7]) {
#pragma unroll
                                for (int k = 7; k >= 1; --k) {
                                    if (v > tv[k - 1]) { tv[k] = tv[k - 1]; ti[k] = ti[k - 1]; }
                                    else if (v > tv[k]) { tv[k] = v; ti[k] = e; }
                                }
                                if (v > tv[0]) { tv[0] = v; ti[0] = e; }
                            }
                        }
                    }
                }
                float ws[8], wsum = 0.f;
#pragma unroll
                for (int k = 0; k < 8; ++k) { ws[k] = sc[ti[k] * 64]; wsum += ws[k]; }
                const float sc25 = 2.5f / wsum;
#pragma unroll
                for (int k = 0; k < 8; ++k) {
                    p.topk_idx[token * 8 + k] = ti[k];
                    p.topk_w[token * 8 + k] = ws[k] * sc25;
                    le[(hh * 64 + tl) * 8 + k] = (unsigned char)ti[k];
                    lp[(hh * 64 + tl) * 8 + k] = (unsigned char)atomicAdd(&lcnt[ti[k]], 1);
                }
            }
        }
        __syncthreads();
        { const int c = lcnt[t]; lbase[t] = c > 0 ? (int)atomicAdd(&p.ctrl[CTRL_ECNT + t * ECNT_STRIDE], (unsigned)c) : 0; }
        __syncthreads();
#pragma unroll
        for (int i = 0; i < 4; ++i) {
            const int a = t + 256 * i, e = le[a];
            p.elist[(size_t)e * NTOK + lbase[e] + lp[a]] = (rt * 128) * 8 + a;
        }
        STAMP(15);
        {
            APlain ap{p.H + (size_t)rt * 128 * DM, DM};
            gemm_stream<4, 4, 2, 64, 4>(ap, p.wsgu_t, DM, DM, 4, [](int u, int& ao, int& bo) { ao = 0; bo = u * 128 * DM; },
                [&](const int ct, f32x4 (&acc)[4][4]) {
                    int ll = lane; LAUNDER(ll);
#pragma unroll
                    for (int i = 0; i < 4; ++i) {
                        bf16_t* d = act + (wr * 64 + i * 16 + (ll & 15)) * 256 + ct * 64 + wc * 32 + (ll >> 4) * 4;
#pragma unroll
                        for (int m = 0; m < 2; ++m) {
                            f32x4 o;
#pragma unroll
                            for (int e = 0; e < 4; ++e) { const float g = acc[i][2 * m][e]; o[e] = g * sigmoidf_(g) * acc[i][2 * m + 1][e]; }
                            *(u32x2*)(d + m * 16) = pack4(o);
                        }
                    }
                }, lds);
        }
        asm volatile("s_waitcnt vmcnt(0)" ::: "memory");
        __syncthreads();
        STAMP(16);
        {
            APlain ap{act, 256};
            gemm_stream<4, 4, 2, 64, 4>(ap, p.wsd_t, 256, 256, 8, [](int u, int& ao, int& bo) { ao = 0; bo = u * 128 * 256; },
                [&](const int ct, f32x4 (&acc)[4][4]) {
                    int ll = lane; LAUNDER(ll);
#pragma unroll
                    for (int i = 0; i < 4; ++i)
#pragma unroll
                        for (int j = 0; j < 4; ++j) {
                            const int row = wr * 64 + i * 16 + (ll & 15), grow = rt * 128 + row, col = ct * 128 + wc * 64 + j * 16 + (ll >> 4) * 4;
                            const f32x4 xv = *(const f32x4*)(p.out + (size_t)grow * DM + col), gf = *(const f32x4*)(mod + 5120 + col);
                            f32x4 o;
#pragma unroll
                            for (int e = 0; e < 4; ++e) o[e] = xv[e] + gf[e] * acc[i][j][e];
                            *(f32x4*)(p.out + (size_t)grow * DM + col) = o;
                        }
                }, lds);
        }
    }
}

DI void phase6(const Params& p, unsigned char* lds, int bid, int G) {
    const int t = threadIdx.x, lane = t & 63, wid = t >> 6, wr = wid >> 1, wc = wid & 1;
    float* tile = (float*)lds;
    int* cpre = (int*)(lds + 69632);
    int* rowtok = (int*)(lds + 69632 + 1056);
    int* rowslot = rowtok + 128;
    float* roww = (float*)(rowslot + 128);
    int* sh_it = (int*)(roww + 128);
    bf16_t* act = (bf16_t*)(p.bscr + (size_t)bid * BSCR_PER_BLOCK + 131072);
    (void)G;
    __syncthreads();
    rowtok[t] = ((int)p.ctrl[CTRL_ECNT + t * ECNT_STRIDE] + 127) >> 7;
    __syncthreads();
    if (t < 8) { int sacc = 0; for (int k = 0; k < 32; ++k) { cpre[t * 33 + k] = sacc; sacc += rowtok[8 * k + t]; } cpre[t * 33 + 32] = sacc; }
    __syncthreads();
    const int hq = (int)(xb_xcc_id() & 7u);
    int attempt = 0;
    for (;;) {
        const int qc = (hq + attempt) & 7;
        __syncthreads();
        if (t == 0) sh_it[0] = (int)atomicAdd(&p.ctrl[CTRL_Q6 + qc * 64], 1u);
        __syncthreads();
        const int idx = sh_it[0];
        if (idx >= cpre[qc * 33 + 32]) { if (++attempt >= 8) break; continue; }
        int lo = 0, hi = 31;
        while (lo < hi) { const int mid = (lo + hi + 1) >> 1; if (cpre[qc * 33 + mid] <= idx) lo = mid; else hi = mid - 1; }
        const int e = 8 * lo + qc, tl = idx - cpre[qc * 33 + lo], cnt = (int)p.ctrl[CTRL_ECNT + e * ECNT_STRIDE];
        __syncthreads();
        if (t < 128) {
            const int r = tl * 128 + t;
            if (r < cnt) { const int ts = p.elist[(size_t)e * NTOK + r]; rowtok[t] = ts >> 3; rowslot[t] = ts; roww[t] = p.topk_w[ts]; }
            else { rowtok[t] = 0; rowslot[t] = -1; roww[t] = 0.f; }
        }
        __syncthreads();
        {
            AGather ap{p.H, rowtok};
            gemm_stream<4, 4, 2, 64, 4>(ap, p.wegu_t + (size_t)e * 512 * DM, DM, DM, 4, [](int u, int& ao, int& bo) { ao = 0; bo = u * 128 * DM; },
                [&](const int ct, f32x4 (&acc)[4][4]) {
                    int ll = lane; LAUNDER(ll);
#pragma unroll
                    for (int i = 0; i < 4; ++i) {
                        bf16_t* d = act + (wr * 64 + i * 16 + (ll & 15)) * 256 + ct * 64 + wc * 32 + (ll >> 4) * 4;
#pragma unroll
                        for (int m = 0; m < 2; ++m) {
                            f32x4 o;
#pragma unroll
                            for (int ee = 0; ee < 4; ++ee) { const float g = acc[i][2 * m][ee]; o[ee] = g * sigmoidf_(g) * acc[i][2 * m + 1][ee]; }
                            *(u32x2*)(d + m * 16) = pack4(o);
                        }
                    }
                }, lds);
        }
        asm volatile("s_waitcnt vmcnt(0)" ::: "memory");
        __syncthreads();
        {
            APlain ap{act, 256};
            gemm_stream<4, 4, 2, 64, 4>(ap, p.wed_t + (size_t)e * 1024 * 256, 256, 256, 8, [](int u, int& ao, int& bo) { ao = 0; bo = u * 128 * 256; },
                [&](const int ct, f32x4 (&acc)[4][4]) {
                    int ll = lane; LAUNDER(ll);
#pragma unroll
                    for (int i = 0; i < 4; ++i) {
                        const int row = wr * 64 + i * 16 + (ll & 15), srow = rowslot[row];
                        const float ww = roww[row];
                        if (srow >= 0) {
#pragma unroll
                            for (int j = 0; j < 4; ++j) {
                                const int col = ct * 128 + wc * 64 + j * 16 + (ll >> 4) * 4;
                                *(u32x2*)(p.slot + (size_t)srow * DM + col) = pack4(acc[i][j] * ww);
                            }
                        }
                    }
                }, lds);
        }
    }
}

DI void phase7(const Params& p, int bid, int G) {
    const int lane = threadIdx.x & 63, gw = bid * 4 + (threadIdx.x >> 6), nw = G * 4;
    for (int row = gw; row < NTOK; row += nw) {
        const float* mod = p.mod + (row >> 12) * 6144 + 5120;
#pragma unroll
        for (int i = 0; i < 4; ++i) {
            const int c = lane * 4 + 256 * i;
            float s[4] = {0.f, 0.f, 0.f, 0.f};
#pragma unroll
            for (int k = 0; k < 8; ++k) { const u32x2 w = *(const u32x2*)(p.slot + ((size_t)row * 8 + k) * DM + c); s[0] += lo2f(w.x); s[1] += hi2f(w.x); s[2] += lo2f(w.y); s[3] += hi2f(w.y); }
            const f32x4 gf = *(const f32x4*)(mod + c);
            f32x4 o = *(const f32x4*)(p.out + (size_t)row * DM + c);
#pragma unroll
            for (int e = 0; e < 4; ++e) o[e] += gf[e] * s[e];
            *(f32x4*)(p.out + (size_t)row * DM + c) = o;
        }
    }
}

extern __shared__ __attribute__((aligned(16))) unsigned char smem[];

template <int PH> DI void run_phase(const Params& p, unsigned char* lds, int bid, int G) {
    if (PH == 0) phase0(p, lds, bid, G);
    if (PH == 1) phase1(p, bid, G);
    if (PH == 2) phase2(p, lds, bid, G);
    if (PH == 3) phase3(p, lds, bid, G);
    if (PH == 4) phase4(p, lds, bid, G);
    if (PH == 5) phase5(p, lds, bid, G);
    if (PH == 6) phase6(p, lds, bid, G);
    if (PH == 7) phase7(p, bid, G);
}

#if !ONE_LAUNCH
template <int PH> __global__ void __launch_bounds__(256, 2) phase_kernel(Params p) { run_phase<PH>(p, smem, blockIdx.x, gridDim.x); }
#endif

#if ONE_LAUNCH
__global__ void __launch_bounds__(256, 2) mega_kernel(Params p) {
    volatile LAS unsigned* st = (volatile LAS unsigned*)(smem + LDS_BYTES - 16);
    if (threadIdx.x == 0) { st[0] = 0u; st[1] = 0u; st[2] = 0u; st[3] = 0u; }
    __syncthreads();
    XcdBarrier bar = xcd_barrier_post(p.ctrl, st);
    const int bid = blockIdx.x, G = gridDim.x;
    STAMP(0);
    run_phase<0>(p, smem, bid, G); xcd_barrier(bar); STAMP(1);
    run_phase<1>(p, smem, bid, G); xcd_barrier(bar); STAMP(2);
    run_phase<2>(p, smem, bid, G); xcd_barrier(bar); STAMP(3);
    run_phase<3>(p, smem, bid, G); xcd_barrier(bar); STAMP(4);
    run_phase<4>(p, smem, bid, G); xcd_barrier(bar); STAMP(5);
    run_phase<5>(p, smem, bid, G); xcd_barrier(bar); STAMP(6);
    run_phase<6>(p, smem, bid, G); xcd_barrier(bar); STAMP(7);
    run_phase<7>(p, smem, bid, G);
#ifdef PROBE_A
    xcd_barrier(bar); STAMP(8);
    xcd_barrier(bar);
    {
        const unsigned long long* sp = (const unsigned long long*)(p.ctrl + CTRL_STAMP);
        const unsigned long long ta = __hip_atomic_load(sp + PROBE_A, __ATOMIC_RELAXED, __HIP_MEMORY_SCOPE_AGENT), tb = __hip_atomic_load(sp + PROBE_B, __ATOMIC_RELAXED, __HIP_MEMORY_SCOPE_AGENT);
        const unsigned long long t0 = __builtin_amdgcn_s_memrealtime();
        while (__builtin_amdgcn_s_memrealtime() - t0 < tb - ta) __builtin_amdgcn_s_sleep(8);
    }
#endif
}
#define OCC_KERNEL mega_kernel
#else
#define OCC_KERNEL phase_kernel<5>
#endif

static inline size_t al256(size_t x) { return (x + 255) & ~(size_t)255; }

extern "C" void kernel_launch(void* const* d_in, const int* in_sizes, int n_in, void* d_out, int out_size, void* d_ws, size_t ws_size, hipStream_t stream) {
    (void)in_sizes; (void)n_in; (void)out_size;
    Params p{};
    p.x = (const float*)d_in[0]; p.c = (const float*)d_in[1]; p.positions = (const int*)d_in[2]; p.ada_w = (const float*)d_in[3]; p.ada_b = (const float*)d_in[4];
    p.norm_mix = (const float*)d_in[5]; p.w_in = (const float*)d_in[6]; p.rwkv_mu = (const float*)d_in[7]; p.decay_w0 = (const float*)d_in[8]; p.decay_up = (const float*)d_in[9];
    p.iclr_a0 = (const float*)d_in[10]; p.iclr_up = (const float*)d_in[11]; p.gate_up = (const float*)d_in[12]; p.k_k = (const float*)d_in[13]; p.k_a = (const float*)d_in[14];
    p.r_k = (const float*)d_in[15]; p.ln_w = (const float*)d_in[16]; p.ln_b = (const float*)d_in[17]; p.q_a_norm = (const float*)d_in[18]; p.w_q_b = (const float*)d_in[19];
    p.kv_a_norm = (const float*)d_in[20]; p.w_kv_b = (const float*)d_in[21]; p.q_norm = (const float*)d_in[22]; p.k_norm = (const float*)d_in[23]; p.w_out = (const float*)d_in[24];
    p.norm_ffn = (const float*)d_in[25]; p.w_router = (const float*)d_in[26]; p.router_bias = (const float*)d_in[27]; p.w_e_gu = (const float*)d_in[28]; p.w_e_d = (const float*)d_in[29];
    p.w_sh_gu = (const float*)d_in[30]; p.w_sh_d = (const float*)d_in[31];
    p.out = (float*)d_out;

    static int grid = 0;
    if (!grid) {
        int dev = 0, cus = 0, per_cu = 0;
        (void)hipGetDevice(&dev);
        (void)hipDeviceGetAttribute(&cus, hipDeviceAttributeMultiprocessorCount, dev);
#if ONE_LAUNCH
        (void)hipFuncSetAttribute((const void*)mega_kernel, hipFuncAttributeMaxDynamicSharedMemorySize, LDS_BYTES);
#endif
#if !ONE_LAUNCH
        (void)hipFuncSetAttribute((const void*)phase_kernel<0>, hipFuncAttributeMaxDynamicSharedMemorySize, LDS_BYTES);
#endif
#if !ONE_LAUNCH
        (void)hipFuncSetAttribute((const void*)phase_kernel<1>, hipFuncAttributeMaxDynamicSharedMemorySize, LDS_BYTES);
#endif
#if !ONE_LAUNCH
        (void)hipFuncSetAttribute((const void*)phase_kernel<2>, hipFuncAttributeMaxDynamicSharedMemorySize, LDS_BYTES);
#endif
#if !ONE_LAUNCH
        (void)hipFuncSetAttribute((const void*)phase_kernel<3>, hipFuncAttributeMaxDynamicSharedMemorySize, LDS_BYTES);
#endif
#if !ONE_LAUNCH
        (void)hipFuncSetAttribute((const void*)phase_kernel<4>, hipFuncAttributeMaxDynamicSharedMemorySize, LDS_BYTES);
#endif
#if !ONE_LAUNCH
        (void)hipFuncSetAttribute((const void*)phase_kernel<5>, hipFuncAttributeMaxDynamicSharedMemorySize, LDS_BYTES);
#endif
#if !ONE_LAUNCH
        (void)hipFuncSetAttribute((const void*)phase_kernel<6>, hipFuncAttributeMaxDynamicSharedMemorySize, LDS_BYTES);
#endif
#if !ONE_LAUNCH
        (void)hipFuncSetAttribute((const void*)phase_kernel<7>, hipFuncAttributeMaxDynamicSharedMemorySize, LDS_BYTES);
#endif
        (void)hipOccupancyMaxActiveBlocksPerMultiprocessor(&per_cu, (const void*)OCC_KERNEL, 256, LDS_BYTES);
        if (cus <= 0) cus = 256;
        if (per_cu < 1) per_cu = 1;
        grid = cus * (per_cu < 2 ? per_cu : 2);
    }
    unsigned char* w = (unsigned char*)d_ws; size_t o = 0;
    auto take = [&](size_t bytes) { unsigned char* r = w + o; o = al256(o + bytes); return r; };
    p.ctrl = (unsigned*)take(CTRL_WORDS * 4);
    p.mod = (float*)take((size_t)NB * 6144 * 4);
    p.rope = (float*)take((size_t)NTOK * 32 * 4);
    p.win_t = (bf16_t*)take((size_t)LDU * 1024 * 2);
    p.wq_t = (bf16_t*)take((size_t)768 * 256 * 2);
    p.wkv_t = (bf16_t*)take((size_t)1024 * 128 * 2);
    p.wdec_t = (bf16_t*)take((size_t)512 * 32 * 2);
    p.wiclr_t = (bf16_t*)take((size_t)512 * 32 * 2);
    p.wgate_t = (bf16_t*)take((size_t)512 * 96 * 2);
    p.wout_t = (bf16_t*)take((size_t)1024 * 1024 * 2);
    p.wr_t = (bf16_t*)take((size_t)256 * 1024 * 2);
    p.wsgu_t = (bf16_t*)take((size_t)512 * 1024 * 2);
    p.wsd_t = (bf16_t*)take((size_t)1024 * 256 * 2);
    p.wegu_t = (bf16_t*)take((size_t)NEXP * 512 * 1024 * 2);
    p.wed_t = (bf16_t*)take((size_t)NEXP * 1024 * 256 * 2);
    p.H = (bf16_t*)take((size_t)NTOK * DM * 2);
    p.topk_idx = (int*)take((size_t)NTOK * 8 * 4);
    p.topk_w = (float*)take((size_t)NTOK * 8 * 4);
    p.elist = (int*)take((size_t)NEXP * NTOK * 4);
    p.bscr = take((size_t)grid * BSCR_PER_BLOCK);
    const size_t ov = o;
    p.U = (bf16_t*)take((size_t)NTOK * LDU * 2);
    p.Q = (bf16_t*)take((size_t)NTOK * 8 * 96 * 2);
    p.Kb = (bf16_t*)take((size_t)NTOK * 8 * 96 * 2);
    p.Vt = (bf16_t*)take((size_t)NTOK * 8 * 64 * 2);
    p.SC = (bf16_t*)take((size_t)NTOK * 8 * 384 * 2);
    p.Gg = (bf16_t*)take((size_t)NTOK * 512 * 2);
    p.yraw = (float*)take((size_t)NTOK * 512 * 4);
    p.Y = (bf16_t*)take((size_t)NTOK * DM * 2);
    p.slot = (bf16_t*)(w + ov);
    const size_t need_slot = ov + (size_t)NTOK * 8 * DM * 2;
    if (o > ws_size || need_slot > ws_size) { fprintf(stderr, "workspace too small: need %zu / %zu, have %zu\n", o, need_slot, ws_size); return; }

    (void)hipMemsetAsync(p.ctrl, 0, CTRL_WORDS * 4, stream);
#if ONE_LAUNCH
    hipLaunchKernelGGL(mega_kernel, dim3(grid), dim3(256), LDS_BYTES, stream, p);
#else
    hipLaunchKernelGGL(phase_kernel<0>, dim3(grid), dim3(256), LDS_BYTES, stream, p);
    hipLaunchKernelGGL(phase_kernel<1>, dim3(grid), dim3(256), LDS_BYTES, stream, p);
    hipLaunchKernelGGL(phase_kernel<2>, dim3(grid), dim3(256), LDS_BYTES, stream, p);
    hipLaunchKernelGGL(phase_kernel<3>, dim3(grid), dim3(256), LDS_BYTES, stream, p);
    hipLaunchKernelGGL(phase_kernel<4>, dim3(grid), dim3(256), LDS_BYTES, stream, p);
    hipLaunchKernelGGL(phase_kernel<5>, dim3(grid), dim3(256), LDS_BYTES, stream, p);
    hipLaunchKernelGGL(phase_kernel<6>, dim3(grid), dim3(256), LDS_BYTES, stream, p);
    hipLaunchKernelGGL(phase_kernel<7>, dim3(grid), dim3(256), LDS_BYTES, stream, p);
#endif
}
```

```cpp
#include <hip/hip_runtime.h>
#include <stdint.h>
#include <stdio.h>
#define DI __device__ __forceinline__

#ifndef ONE_LAUNCH
#define ONE_LAUNCH 1
#endif

typedef unsigned short bf16_t;
typedef short bf16x8 __attribute__((ext_vector_type(8)));
typedef float f32x4 __attribute__((ext_vector_type(4)));
typedef float f32x16 __attribute__((ext_vector_type(16)));
typedef float f32x2_t __attribute__((ext_vector_type(2)));
typedef unsigned u32x4 __attribute__((ext_vector_type(4)));
typedef unsigned u32x2 __attribute__((ext_vector_type(2)));
#define LAUNDER(v) asm volatile("" : "+v"(v))
DI u32x4 mk4(unsigned a, unsigned b, unsigned c, unsigned d) { return (u32x4){a, b, c, d}; }
DI u32x2 mk2(unsigned a, unsigned b) { return (u32x2){a, b}; }

typedef __bf16 bf16x2_t __attribute__((ext_vector_type(2)));

constexpr int NB = 16, NT_ = 4096, DM = 1024, NTOK = NB * NT_;
constexpr int LDU = 2176;
constexpr int UQ = 0, UKV = 256, UR = 384, UK = 896, UV = 1408, UXW = 1920, UXA = 1952, UXG = 1984, UPE = 2080;
constexpr int NEXP = 256, TOPK = 8;
constexpr int LDS_BYTES = 73728;
constexpr float QSCALE = 0.14724444f;

#define XB_TMO      128
#define XB_XCNT(j)  (256  + 64 * (j))
#define XB_XSUB(j)  (1280 + 64 * (j))
#define XB_XGEN(j)  (2304 + 64 * (j))
#define XB_TOP      3328
#define XB_TOPGEN   3392
#define XCD_BAR_WORDS 3456
#define XB_SPIN_CAP (1u << 22)
#define LAS __attribute__((address_space(3)))
constexpr int CTRL_ATTNQ = 4096, CTRL_ECNT = 8192, ECNT_STRIDE = 64, CTRL_WORDS = 24576;
constexpr int CTRL_STAMP = 4160;
constexpr int CTRL_Q6 = 4608;
#ifdef PROBE_A
#define STAMP(id) do { if (blockIdx.x == 0 && threadIdx.x == 0) __hip_atomic_store((unsigned long long*)(p.ctrl + CTRL_STAMP) + (id), (unsigned long long)__builtin_amdgcn_s_memrealtime(), __ATOMIC_RELAXED, __HIP_MEMORY_SCOPE_AGENT); } while (0)
#else
#define STAMP(id)
#endif

DI unsigned xb_ld(unsigned* p)              { return __hip_atomic_load(p, __ATOMIC_RELAXED, __HIP_MEMORY_SCOPE_AGENT); }
DI unsigned xb_add(unsigned* p, unsigned v) { return __hip_atomic_fetch_add(p, v, __ATOMIC_RELAXED, __HIP_MEMORY_SCOPE_AGENT); }
DI unsigned xb_xcc_id() { return (unsigned)__builtin_amdgcn_s_getreg((3 << 11) | 20) & 0xFu; }
#define XB_SPIN(cond, bar) do { unsigned _sp = 0; while (cond) { __builtin_amdgcn_s_sleep(1); \
    if ((++_sp & 255u) == 0u) { if (xb_ld(&(bar)[XB_TMO])) break; if (_sp > XB_SPIN_CAP) { atomicAdd(&(bar)[XB_TMO], 1u); break; } } } } while (0)

struct XcdBarrier { unsigned* bar; unsigned x; volatile LAS unsigned* st; };

DI XcdBarrier xcd_barrier_post(unsigned* bar, volatile LAS unsigned* st) {
    XcdBarrier b; b.bar = bar; b.x = xb_xcc_id(); b.st = st;
    if (threadIdx.x == 0) (void)xb_add(&bar[XB_XCNT(b.x)], 1u);
    return b;
}
DI void xcd_barrier_complete(unsigned* bar, unsigned x, unsigned& nloc, unsigned& nx) {
    const unsigned G = gridDim.x * gridDim.y * gridDim.z;
    unsigned sum, cnt, mine, sp = 0u;
    for (;;) {
        sum = 0u; cnt = 0u; mine = 0u;
#pragma unroll
        for (unsigned j = 0; j < 16; ++j) { const unsigned c = xb_ld(&bar[XB_XCNT(j)]); sum += c; cnt += (c > 0u) ? 1u : 0u; mine = (j == x) ? c : mine; }
        if (sum == G) break;
        __builtin_amdgcn_s_sleep(1);
        if ((++sp & 255u) == 0u) { if (xb_ld(&bar[XB_TMO])) break; if (sp > XB_SPIN_CAP) { atomicAdd(&bar[XB_TMO], 1u); break; } }
    }
    nloc = mine > 0u ? mine : 1u; nx = cnt > 0u ? cnt : 1u;
}
DI void xcd_barrier(const XcdBarrier& b) {
    asm volatile("s_waitcnt vmcnt(0)" ::: "memory");
    __syncthreads();
    if (threadIdx.x == 0) {
        unsigned* bar = b.bar;
        __builtin_amdgcn_s_waitcnt(0);
        unsigned nloc = b.st[0], nx = b.st[1];
        if (nloc == 0u) { xcd_barrier_complete(bar, b.x, nloc, nx); b.st[0] = nloc; b.st[1] = nx; }
        const unsigned old = xb_add(&bar[XB_XSUB(b.x)], 1u);
        const unsigned gen = old / nloc;
        if (old + 1u == (gen + 1u) * nloc) {
            __builtin_amdgcn_fence(__ATOMIC_RELEASE, "agent");
            asm volatile("s_waitcnt vmcnt(0)" ::: "memory");
            const unsigned og = xb_add(&bar[XB_TOP], 1u);
            const unsigned tg = og / nx;
            if (og + 1u == (tg + 1u) * nx) xb_add(&bar[XB_TOPGEN], 1u);
            else XB_SPIN(xb_ld(&bar[XB_TOPGEN]) == tg, bar);
            __builtin_amdgcn_fence(__ATOMIC_ACQUIRE, "agent");
            xb_add(&bar[XB_XGEN(b.x)], 1u);
            asm volatile("s_waitcnt vmcnt(0)" ::: "memory");
        } else {
            XB_SPIN(xb_ld(&bar[XB_XGEN(b.x)]) == gen, bar);
            __builtin_amdgcn_fence(__ATOMIC_ACQUIRE, "agent");
            asm volatile("s_waitcnt vmcnt(0)" ::: "memory");
        }
    }
    __syncthreads();
}

struct Params {
    const float* x; const float* c; const int* positions; const float* ada_w; const float* ada_b; const float* norm_mix; const float* w_in;
    const float* rwkv_mu; const float* decay_w0; const float* decay_up; const float* iclr_a0; const float* iclr_up; const float* gate_up;
    const float* k_k; const float* k_a; const float* r_k; const float* ln_w; const float* ln_b;
    const float* q_a_norm; const float* w_q_b; const float* kv_a_norm; const float* w_kv_b; const float* q_norm; const float* k_norm;
    const float* w_out; const float* norm_ffn; const float* w_router; const float* router_bias;
    const float* w_e_gu; const float* w_e_d; const float* w_sh_gu; const float* w_sh_d;
    float* out;
    unsigned* ctrl; float* mod; float* rope;
    bf16_t* win_t; bf16_t* wq_t; bf16_t* wkv_t; bf16_t* wdec_t; bf16_t* wiclr_t; bf16_t* wgate_t; bf16_t* wout_t; bf16_t* wr_t; bf16_t* wsgu_t; bf16_t* wsd_t;
    bf16_t* wegu_t; bf16_t* wed_t;
    bf16_t* H; int* topk_idx; float* topk_w; int* elist; unsigned char* bscr;
    bf16_t* U; bf16_t* Q; bf16_t* Kb; bf16_t* Vt; bf16_t* SC; bf16_t* Gg; float* yraw; bf16_t* Y; bf16_t* slot;
};
constexpr size_t BSCR_PER_BLOCK = 196608;

DI float bf2f(bf16_t v) { return __uint_as_float(((unsigned)v) << 16); }
DI unsigned pk2(float a, float b) { f32x2_t f = {a, b}; bf16x2_t r = __builtin_convertvector(f, bf16x2_t); return __builtin_bit_cast(unsigned, r); }
DI bf16_t f2bf(float a) { return (bf16_t)(pk2(a, 0.f) & 0xffffu); }
DI float lo2f(unsigned w) { return __uint_as_float(w << 16); }
DI float hi2f(unsigned w) { return __uint_as_float(w & 0xffff0000u); }
DI float sigmoidf_(float x) { return 1.0f / (1.0f + __expf(-x)); }
DI float wave_sum(float v) {
#pragma unroll
    for (int o = 32; o > 0; o >>= 1) v += __shfl_xor(v, o);
    return v;
}
DI float dpp_sum8(float s) {
    s += __builtin_bit_cast(float, __builtin_amdgcn_update_dpp(0, __builtin_bit_cast(int, s), 0xB1, 0xf, 0xf, true));
    s += __builtin_bit_cast(float, __builtin_amdgcn_update_dpp(0, __builtin_bit_cast(int, s), 0x4E, 0xf, 0xf, true));
    s += __builtin_bit_cast(float, __builtin_amdgcn_update_dpp(0, __builtin_bit_cast(int, s), 0x141, 0xf, 0xf, true));
    return s;
}

struct APlain { const bf16_t* base; int ld; DI const bf16_t* row(int r) const { return base + (size_t)r * ld; } };
struct AGather { const bf16_t* base; const int* idx; DI const bf16_t* row(int r) const { return base + (size_t)idx[r] * DM; } };

template <int MT, int NT, int WR, int BK, int NSWAP, class AP>
DI void gemm_tile(const AP ap, const bf16_t* __restrict__ Bt, const int ldb, const int K, f32x4 (&acc)[MT][NT], unsigned char* lds) {
    constexpr int WC = 4 / WR, CPR = BK / 8, RB = BK * 2, R256 = 256 / RB, BN = WC * NT * 16;
    static_assert(WR * MT * 16 == 128, "tile is 128 rows");
    constexpr int A_BYTES = 128 * RB, B_BYTES = BN * RB;
    constexpr int A_CH = (128 * CPR) / 256, B_TOT = BN * CPR, B_CH = (B_TOT + 255) / 256, RSTEP = 256 / CPR;
    int t = threadIdx.x; LAUNDER(t);
    const int lane = t & 63, wid = t >> 6, wr = wid / WC, wc = wid % WC;
    const int ch = t % CPR, r0 = t / CPR;
    const bf16_t* pa[A_CH]; const bf16_t* pb[B_CH]; int offa[A_CH], offb[B_CH]; bool vb[B_CH];
#pragma unroll
    for (int i = 0; i < A_CH; ++i) { const int row = r0 + i * RSTEP; pa[i] = ap.row(row) + ch * 8; offa[i] = row * RB + ((ch ^ ((row / R256) & (CPR - 1))) << 4); }
#pragma unroll
    for (int i = 0; i < B_CH; ++i) { const int row = r0 + i * RSTEP; vb[i] = (B_TOT % 256 == 0) || (row < BN); const int rr = vb[i] ? row : 0; pb[i] = Bt + (size_t)rr * ldb + ch * 8; offb[i] = 2 * A_BYTES + rr * RB + ((ch ^ ((rr / R256) & (CPR - 1))) << 4); }
#pragma unroll
    for (int i = 0; i < MT; ++i)
#pragma unroll
        for (int j = 0; j < NT; ++j) acc[i][j] = (f32x4){0.f, 0.f, 0.f, 0.f};
    const int KT = K / BK;
    u32x4 ra0[A_CH], rb0[B_CH], ra1[A_CH], rb1[B_CH];
#define G_LOAD(RA, RB, KTI) { _Pragma("unroll") for (int i = 0; i < A_CH; ++i) RA[i] = *(const u32x4*)(pa[i] + (KTI) * BK); \
                              _Pragma("unroll") for (int i = 0; i < B_CH; ++i) RB[i] = *(const u32x4*)(pb[i] + (KTI) * BK); }
#define G_WRITE(RA, RB, BUF) { _Pragma("unroll") for (int i = 0; i < A_CH; ++i) *(u32x4*)(lds + (BUF) * A_BYTES + offa[i]) = RA[i]; \
                               _Pragma("unroll") for (int i = 0; i < B_CH; ++i) if (vb[i]) *(u32x4*)(lds + (BUF) * B_BYTES + offb[i]) = RB[i]; }
#define G_COMPUTE(BUF) { const unsigned char* Ab = lds + (BUF) * A_BYTES + arow; const unsigned char* Bb = lds + 2 * A_BYTES + (BUF) * B_BYTES + brow; \
        _Pragma("unroll") for (int ks = 0; ks < BK / 32; ++ks) { const int co = ((ks * 4 + (lane >> 4)) ^ sw) << 4; bf16x8 af[MT], bfr[NT]; \
            _Pragma("unroll") for (int i = 0; i < MT; ++i) af[i] = *(const bf16x8*)(Ab + i * 16 * RB + co); \
            _Pragma("unroll") for (int j = 0; j < NT; ++j) bfr[j] = *(const bf16x8*)(Bb + j * 16 * RB + co); \
            _Pragma("unroll") for (int i = 0; i < MT; ++i) _Pragma("unroll") for (int j = 0; j < NT; ++j) \
                acc[i][j] = (j < NSWAP) ? __builtin_amdgcn_mfma_f32_16x16x32_bf16(bfr[j], af[i], acc[i][j], 0, 0, 0) \
                                        : __builtin_amdgcn_mfma_f32_16x16x32_bf16(af[i], bfr[j], acc[i][j], 0, 0, 0); } }
    const int sw = ((lane & 15) / R256) & (CPR - 1);
    const int arow = (wr * MT * 16 + (lane & 15)) * RB, brow = (wc * NT * 16 + (lane & 15)) * RB;
    G_LOAD(ra0, rb0, 0)
    if (KT > 1) G_LOAD(ra1, rb1, 1)
    __syncthreads();
    G_WRITE(ra0, rb0, 0)
    if (KT > 2) G_LOAD(ra0, rb0, 2)
    __syncthreads();
    for (int kt = 0; kt < KT; kt += 2) {
        G_COMPUTE(0)
        if (kt + 1 < KT) { G_WRITE(ra1, rb1, 1) if (kt + 3 < KT) G_LOAD(ra1, rb1, kt + 3) }
        __syncthreads();
        if (kt + 1 >= KT) break;
        G_COMPUTE(1)
        if (kt + 2 < KT) { G_WRITE(ra0, rb0, 0) if (kt + 4 < KT) G_LOAD(ra0, rb0, kt + 4) }
        __syncthreads();
    }
#undef G_LOAD
#undef G_WRITE
#undef G_COMPUTE
}
template <int MT, int NT, int WR, int BK, int NSWAP, class AP, class UF, class EPI>
DI void gemm_stream(const AP ap, const bf16_t* __restrict__ Bt, const int ldb, const int K, const int nunits, const UF uoff, const EPI epi, unsigned char* lds) {
    constexpr int WC = 4 / WR, CPR = BK / 8, RB = BK * 2, R256 = 256 / RB, BN = WC * NT * 16, NTH = (NT > 6) ? NT / 2 : NT;
    static_assert(WR * MT * 16 == 128, "tile is 128 rows");
    constexpr int A_BYTES = 128 * RB, B_BYTES = BN * RB;
    constexpr int A_CH = (128 * CPR) / 256, B_TOT = BN * CPR, B_CH = (B_TOT + 255) / 256, RSTEP = 256 / CPR;
    int t = threadIdx.x; LAUNDER(t);
    const int lane = t & 63, wid = t >> 6, wr = wid / WC, wc = wid % WC;
    const int ch = t % CPR, r0 = t / CPR;
    const bf16_t* pa[A_CH]; const bf16_t* pb[B_CH]; int offa[A_CH], offb[B_CH]; bool vb[B_CH];
#pragma unroll
    for (int i = 0; i < A_CH; ++i) { const int row = r0 + i * RSTEP; pa[i] = ap.row(row) + ch * 8; offa[i] = row * RB + ((ch ^ ((row / R256) & (CPR - 1))) << 4); }
#pragma unroll
    for (int i = 0; i < B_CH; ++i) { const int row = r0 + i * RSTEP; vb[i] = (B_TOT % 256 == 0) || (row < BN); const int rr = vb[i] ? row : 0; pb[i] = Bt + (size_t)rr * ldb + ch * 8; offb[i] = 2 * A_BYTES + rr * RB + ((ch ^ ((rr / R256) & (CPR - 1))) << 4); }
    f32x4 acc[MT][NT];
#pragma unroll
    for (int i = 0; i < MT; ++i)
#pragma unroll
        for (int j = 0; j < NT; ++j) acc[i][j] = (f32x4){0.f, 0.f, 0.f, 0.f};
    const int KT = K / BK, NG = nunits * KT;
    int lu = 0, lkt = 0, cu = 0, ckt = 0;
    u32x4 ra0[A_CH], rb0[B_CH], ra1[A_CH], rb1[B_CH];
#define S_LOAD(RA, RB) { int ao, bo; uoff(lu, ao, bo); ao += lkt * BK; bo += lkt * BK; \
                         _Pragma("unroll") for (int i = 0; i < A_CH; ++i) RA[i] = *(const u32x4*)(pa[i] + ao); \
                         _Pragma("unroll") for (int i = 0; i < B_CH; ++i) RB[i] = *(const u32x4*)(pb[i] + bo); \
                         if (++lkt == KT) { lkt = 0; ++lu; } }
#define S_WRITE(RA, RB, BUF) { _Pragma("unroll") for (int i = 0; i < A_CH; ++i) *(u32x4*)(lds + (BUF) * A_BYTES + offa[i]) = RA[i]; \
                               _Pragma("unroll") for (int i = 0; i < B_CH; ++i) if (vb[i]) *(u32x4*)(lds + (BUF) * B_BYTES + offb[i]) = RB[i]; }
#define S_COMPUTE(BUF) { const unsigned char* Ab = lds + (BUF) * A_BYTES + arow; const unsigned char* Bb = lds + 2 * A_BYTES + (BUF) * B_BYTES + brow; \
        _Pragma("unroll") for (int ks = 0; ks < BK / 32; ++ks) { const int co = ((ks * 4 + (lane >> 4)) ^ sw) << 4; bf16x8 af[MT]; \
            _Pragma("unroll") for (int i = 0; i < MT; ++i) af[i] = *(const bf16x8*)(Ab + i * 16 * RB + co); \
            _Pragma("unroll") for (int jh = 0; jh < NT / NTH; ++jh) { bf16x8 bfr[NTH]; \
                _Pragma("unroll") for (int j = 0; j < NTH; ++j) bfr[j] = *(const bf16x8*)(Bb + (jh * NTH + j) * 16 * RB + co); \
                __builtin_amdgcn_s_setprio(1); \
                _Pragma("unroll") for (int i = 0; i < MT; ++i) _Pragma("unroll") for (int j = 0; j < NTH; ++j) \
                    acc[i][jh * NTH + j] = (jh * NTH + j < NSWAP) ? __builtin_amdgcn_mfma_f32_16x16x32_bf16(bfr[j], af[i], acc[i][jh * NTH + j], 0, 0, 0) \
                                                                : __builtin_amdgcn_mfma_f32_16x16x32_bf16(af[i], bfr[j], acc[i][jh * NTH + j], 0, 0, 0); \
                __builtin_amdgcn_s_setprio(0); } } }
#define S_EPI { if (++ckt == KT) { epi(cu, acc); ckt = 0; ++cu; \
                _Pragma("unroll") for (int i = 0; i < MT; ++i) _Pragma("unroll") for (int j = 0; j < NT; ++j) acc[i][j] = (f32x4){0.f, 0.f, 0.f, 0.f}; } }
    const int sw = ((lane & 15) / R256) & (CPR - 1);
    const int arow = (wr * MT * 16 + (lane & 15)) * RB, brow = (wc * NT * 16 + (lane & 15)) * RB;
    S_LOAD(ra0, rb0)
    if (NG > 1) S_LOAD(ra1, rb1)
    __syncthreads();
    S_WRITE(ra0, rb0, 0)
    if (NG > 2) S_LOAD(ra0, rb0)
    __syncthreads();
#pragma unroll 1
    for (int g = 0; g < NG; g += 2) {
        S_COMPUTE(0)
        if (g + 1 < NG) { S_WRITE(ra1, rb1, 1) if (g + 3 < NG) S_LOAD(ra1, rb1) }
        S_EPI
        __syncthreads();
        if (g + 1 >= NG) break;
        S_COMPUTE(1)
        if (g + 2 < NG) { S_WRITE(ra0, rb0, 0) if (g + 4 < NG) S_LOAD(ra0, rb0) }
        S_EPI
        __syncthreads();
    }
#undef S_LOAD
#undef S_WRITE
#undef S_COMPUTE
#undef S_EPI
}

template <int NT, int BK, class AP>
DI void gemm_core(const AP ap, const bf16_t* __restrict__ Bt, const int ldb, const int K, f32x4 (&acc)[4][NT], unsigned char* lds) {
    gemm_tile<4, NT, 2, BK, NT>(ap, Bt, ldb, K, acc, lds);
}

template <int NT> DI void acc_to_lds(const f32x4 (&acc)[4][NT], float* tile, const int ld) {
    int t = threadIdx.x; LAUNDER(t);
    const int lane = t & 63, wid = t >> 6, wr = wid >> 1, wc = wid & 1;
#pragma unroll
    for (int i = 0; i < 4; ++i)
#pragma unroll
        for (int j = 0; j < NT; ++j) {
            const int row = wr * 64 + i * 16 + (lane & 15), col = wc * NT * 16 + j * 16 + (lane >> 4) * 4;
            *(f32x4*)(tile + row * ld + col) = acc[i][j];
        }
}

DI int map_win(int n) { return n < 384 ? n + 1696 : (n < 2080 ? n - 384 : (n < 2112 ? n : -1)); }
DI int map_gu128(int n) { const int tile = n >> 7, w = n & 127, wc = w >> 6, j = (w >> 4) & 3, r = w & 15; const int a = tile * 64 + wc * 32 + (j >> 1) * 16 + r; return (j & 1) ? 256 + a : a; }
DI int map_gu(int n) { const int tile = n >> 8, w = n & 255, wc = w >> 7, j = (w >> 4) & 7, r = w & 15; const int a = tile * 128 + wc * 64 + (j >> 1) * 16 + r; return (j & 1) ? 256 + a : a; }

template <int MAP> DI void tconv_simple(const float* __restrict__ src, bf16_t* __restrict__ dst, int K, int Ns, int Nd, const float* __restrict__ scale, int gtid, int gthreads) {
    const int total = Nd * K;
    for (int idx = gtid; idx < total; idx += gthreads) {
        const int n = idx / K, k = idx - n * K;
        const int m = (MAP == 1) ? map_win(n) : (MAP == 2 ? map_gu(n) : (MAP == 3 ? map_gu128(n) : n));
        float v = 0.f;
        if (m >= 0) { v = src[(size_t)k * Ns + m]; if (scale) v *= scale[k]; }
        dst[idx] = f2bf(v);
    }
}
template <int MAP> DI void tconv_tiled(const float* __restrict__ src, bf16_t* __restrict__ dst, int E, int K, int N, float* ldsf, int bid, int G) {
    const int tk = K / 64, tn = N / 64, per = tk * tn, total = E * per;
    const int t = threadIdx.x;
    for (int tile0 = 2 * bid; tile0 < total; tile0 += 2 * G) {
        float rg[2][16];
#pragma unroll
        for (int h = 0; h < 2; ++h) {
            const int tile = tile0 + h, e = tile / per, r = tile - e * per, kt = r / tn, nt = r - kt * tn;
            const float* s = src + (size_t)e * K * N + (size_t)(kt * 64) * N;
            const int nl = t & 63, n = nt * 64 + nl;
            const int m = (MAP == 2) ? map_gu(n) : n;
#pragma unroll
            for (int i = 0; i < 16; ++i) rg[h][i] = s[(size_t)((t >> 6) + 4 * i) * N + m];
        }
        __syncthreads();
#pragma unroll
        for (int h = 0; h < 2; ++h)
#pragma unroll
            for (int i = 0; i < 16; ++i) ldsf[h * 4160 + ((t >> 6) + 4 * i) * 65 + (t & 63)] = rg[h][i];
        __syncthreads();
#pragma unroll
        for (int h = 0; h < 2; ++h) {
            const int tile = tile0 + h, e = tile / per, r = tile - e * per, kt = r / tn, nt = r - kt * tn;
            const int nl = t >> 2, kc = (t & 3) * 16;
            unsigned w[8];
#pragma unroll
            for (int i = 0; i < 8; ++i) w[i] = pk2(ldsf[h * 4160 + (kc + 2 * i) * 65 + nl], ldsf[h * 4160 + (kc + 2 * i + 1) * 65 + nl]);
            bf16_t* d = dst + (size_t)e * K * N + (size_t)(nt * 64 + nl) * K + kt * 64 + kc;
            *(u32x4*)(d) = mk4(w[0], w[1], w[2], w[3]);
            *(u32x4*)(d + 8) = mk4(w[4], w[5], w[6], w[7]);
        }
    }
}
DI void phase0(const Params& p, unsigned char* lds, int bid, int G) {
    const int t = threadIdx.x;
    float* ldsf = (float*)lds;
    for (int item = bid; item < 384; item += G) {
        __syncthreads();
        for (int i = t; i < NB * DM; i += 256) { const float v = p.c[i]; ldsf[(i & (DM - 1)) * NB + (i >> 10)] = v * sigmoidf_(v); }
        __syncthreads();
        const int col = item * 16 + (t & 15), kp = t >> 4;
        float a[NB];
#pragma unroll
        for (int b = 0; b < NB; ++b) a[b] = 0.f;
#pragma unroll 1
        for (int k0 = kp * 64; k0 < kp * 64 + 64; k0 += 8) {
            float w[8];
#pragma unroll
            for (int u = 0; u < 8; ++u) w[u] = p.ada_w[(size_t)(k0 + u) * 6144 + col];
#pragma unroll
            for (int u = 0; u < 8; ++u) {
#pragma unroll
                for (int q = 0; q < 4; ++q) { const f32x4 cv = *(const f32x4*)(ldsf + (k0 + u) * NB + 4 * q); a[4 * q] += cv[0] * w[u]; a[4 * q + 1] += cv[1] * w[u]; a[4 * q + 2] += cv[2] * w[u]; a[4 * q + 3] += cv[3] * w[u]; }
            }
        }
        __syncthreads();
#pragma unroll
        for (int b = 0; b < NB; ++b) ldsf[(kp * NB + b) * 16 + (t & 15)] = a[b];
        __syncthreads();
        {
            const int b = t >> 4, cl = t & 15; float sacc = 0.f;
#pragma unroll
            for (int q = 0; q < 16; ++q) sacc += ldsf[(q * NB + b) * 16 + cl];
            p.mod[b * 6144 + item * 16 + cl] = sacc + p.ada_b[item * 16 + cl];
        }
    }
    __syncthreads();
    const int gtid = bid * 256 + t, gth = G * 256;
    tconv_simple<1>(p.w_in, p.win_t, 1024, 2112, LDU, nullptr, gtid, gth);
    tconv_simple<0>(p.w_q_b, p.wq_t, 256, 768, 768, p.q_a_norm, gtid, gth);
    tconv_simple<0>(p.w_kv_b, p.wkv_t, 128, 1024, 1024, p.kv_a_norm, gtid, gth);
    tconv_simple<0>(p.decay_up, p.wdec_t, 32, 512, 512, nullptr, gtid, gth);
    tconv_simple<0>(p.iclr_up, p.wiclr_t, 32, 512, 512, nullptr, gtid, gth);
    tconv_simple<0>(p.gate_up, p.wgate_t, 96, 512, 512, nullptr, gtid, gth);
    tconv_simple<0>(p.w_out, p.wout_t, 1024, 1024, 1024, nullptr, gtid, gth);
    tconv_simple<0>(p.w_router, p.wr_t, 1024, 256, 256, nullptr, gtid, gth);
    tconv_simple<3>(p.w_sh_gu, p.wsgu_t, 1024, 512, 512, nullptr, gtid, gth);
    tconv_simple<0>(p.w_sh_d, p.wsd_t, 256, 1024, 1024, nullptr, gtid, gth);
    tconv_tiled<2>(p.w_e_gu, p.wegu_t, NEXP, 1024, 512, ldsf, bid, G);
    tconv_tiled<0>(p.w_e_d, p.wed_t, NEXP, 256, 1024, ldsf, bid, G);
}

DI void phase1(const Params& p, int bid, int G) {
    const int lane = threadIdx.x & 63, gw = bid * 4 + (threadIdx.x >> 6), nw = G * 4;
    for (int row0 = gw * 2; row0 < NTOK; row0 += nw * 2) {
        f32x4 v[2][4]; float ss[2] = {0.f, 0.f};
#pragma unroll
        for (int u = 0; u < 2; ++u)
#pragma unroll
            for (int i = 0; i < 4; ++i) v[u][i] = *(const f32x4*)(p.x + (size_t)(row0 + u) * DM + lane * 4 + 256 * i);
#pragma unroll
        for (int u = 0; u < 2; ++u) {
#pragma unroll
            for (int i = 0; i < 4; ++i) ss[u] += v[u][i][0] * v[u][i][0] + v[u][i][1] * v[u][i][1] + v[u][i][2] * v[u][i][2] + v[u][i][3] * v[u][i][3];
            ss[u] = wave_sum(ss[u]);
        }
        const float* mod = p.mod + (row0 >> 12) * 6144;
#pragma unroll
        for (int i = 0; i < 4; ++i) {
            const int c = lane * 4 + 256 * i;
            const f32x4 g = *(const f32x4*)(p.norm_mix + c), sh = *(const f32x4*)(mod + c), sc = *(const f32x4*)(mod + 1024 + c);
#pragma unroll
            for (int u = 0; u < 2; ++u) {
                const float rs = rsqrtf(ss[u] * (1.0f / DM) + 1e-6f);
                float o[4];
#pragma unroll
                for (int e = 0; e < 4; ++e) o[e] = v[u][i][e] * rs * g[e] * (1.0f + sc[e]) + sh[e];
                *(u32x2*)(p.H + (size_t)(row0 + u) * DM + c) = mk2(pk2(o[0], o[1]), pk2(o[2], o[3]));
            }
        }
    }
    const double inv = exp(-(double)(lane & 15) * (9.210340371976184 / 16.0));
    for (int idx = gw * 64 + lane; idx < NTOK * 16; idx += nw * 64) {
        const int row = idx >> 4;
        const double ang = (double)p.positions[row] * inv;
        p.rope[(size_t)row * 32 + (lane & 15)] = (float)cos(ang);
        p.rope[(size_t)row * 32 + 16 + (lane & 15)] = (float)sin(ang);
    }
}

DI void phase2(const Params& p, unsigned char* lds, int bid, int G) {
    constexpr int NCT = LDU / 128;
    const int t = threadIdx.x, lane = t & 63, wid = t >> 6, wr = wid >> 1, wc = wid & 1;
    const int total = (NTOK / 128) * NCT;
    for (int L = bid; L < total; L += G) {
        const int xcd = L & 7, j = L >> 3, rt = 8 * (j / NCT) + xcd, ct = j % NCT;
        f32x4 acc[4][4];
        APlain ap{p.H + (size_t)rt * 128 * DM, DM};
        gemm_core<4, 64>(ap, p.win_t + (size_t)ct * 128 * DM, DM, DM, acc, lds);
        bf16_t* tile = (bf16_t*)lds;
#pragma unroll
        for (int i = 0; i < 4; ++i)
#pragma unroll
            for (int jj = 0; jj < 4; ++jj) {
                const int row = wr * 64 + i * 16 + (lane & 15), col = wc * 64 + jj * 16 + (lane >> 4) * 4;
                *(u32x2*)(tile + row * 136 + col) = mk2(pk2(acc[i][jj][0], acc[i][jj][1]), pk2(acc[i][jj][2], acc[i][jj][3]));
            }
        __syncthreads();
#pragma unroll
        for (int i = 0; i < 8; ++i) {
            const int c = t + 256 * i, row = c >> 4, chn = c & 15;
            *(u32x4*)(p.U + (size_t)(rt * 128 + row) * LDU + ct * 128 + chn * 8) = *(const u32x4*)(tile + row * 136 + chn * 8);
        }
    }
}

DI void unpack8(const u32x4 w, float (&f)[8]) { f[0] = lo2f(w.x); f[1] = hi2f(w.x); f[2] = lo2f(w.y); f[3] = hi2f(w.y); f[4] = lo2f(w.z); f[5] = hi2f(w.z); f[6] = lo2f(w.w); f[7] = hi2f(w.w); }
DI f32x4 unpack4(const u32x2 w) { return (f32x4){lo2f(w.x), hi2f(w.x), lo2f(w.y), hi2f(w.y)}; }
DI u32x2 pack4(const f32x4 v) { return mk2(pk2(v[0], v[1]), pk2(v[2], v[3])); }
DI f32x4 shifted4(const bf16_t* __restrict__ up, const bool has_prev, const f32x4 mu) {
    const f32x4 cur = unpack4(*(const u32x2*)up);
    f32x4 prev = (f32x4){0.f, 0.f, 0.f, 0.f};
    if (has_prev) prev = unpack4(*(const u32x2*)(up - LDU));
    return cur + (prev - cur) * mu;
}
DI void head96_finish(f32x4 (&v)[6], const int q, const float* __restrict__ gain, const float* __restrict__ ropeRow, const float scale, bf16_t* __restrict__ dstRow) {
    float ss = 0.f;
#pragma unroll
    for (int j = 0; j < 6; ++j) ss += v[j][0] * v[j][0] + v[j][1] * v[j][1] + v[j][2] * v[j][2] + v[j][3] * v[j][3];
    ss += __shfl_xor(ss, 16); ss += __shfl_xor(ss, 32);
    const float rs = rsqrtf(ss * (1.0f / 96.0f) + 1e-6f);
#pragma unroll
    for (int j = 0; j < 6; ++j) v[j] = v[j] * rs * *(const f32x4*)(gain + j * 16 + q * 4);
    const f32x4 cs = *(const f32x4*)(ropeRow + q * 4), sn = *(const f32x4*)(ropeRow + 16 + q * 4);
    const f32x4 x1 = v[4], x2 = v[5];
    v[4] = x1 * cs - x2 * sn; v[5] = x2 * cs + x1 * sn;
#pragma unroll
    for (int j = 0; j < 6; ++j) *(u32x2*)(dstRow + j * 16 + q * 4) = pack4(v[j] * scale);
}

DI void phase3(const Params& p, unsigned char* lds, int bid, int G) {
    const int t = threadIdx.x;
    float* rstd_q = (float*)(lds + 69632);
    float* rstd_kv = rstd_q + 128;
    bf16_t* lora = (bf16_t*)(p.bscr + (size_t)bid * BSCR_PER_BLOCK + 131072);
    for (int rt = bid; rt < NTOK / 128; rt += G) {
        __syncthreads();
        {
            int tl = t; LAUNDER(tl);
            const int row = tl >> 1, half = tl & 1, grow = rt * 128 + row;
            const bf16_t* urow = p.U + (size_t)grow * LDU;
            float s = 0.f;
#pragma unroll
            for (int c = 0; c < 16; ++c) { float f[8]; unpack8(*(const u32x4*)(urow + UQ + half * 128 + c * 8), f);
#pragma unroll
                for (int e = 0; e < 8; ++e) s += f[e] * f[e]; }
            s += __shfl_xor(s, 1);
            float s2 = 0.f;
#pragma unroll
            for (int c = 0; c < 8; ++c) { float f[8]; unpack8(*(const u32x4*)(urow + UKV + half * 64 + c * 8), f);
#pragma unroll
                for (int e = 0; e < 8; ++e) s2 += f[e] * f[e]; }
            s2 += __shfl_xor(s2, 1);
            if (half == 0) { rstd_q[row] = rsqrtf(s * (1.0f / 256.0f) + 1e-6f); rstd_kv[row] = rsqrtf(s2 * (1.0f / 128.0f) + 1e-6f); }
        }
#pragma unroll 1
        for (int i = 0; i < 10; ++i) {
            int tl = t; LAUNDER(tl);
            const int c = tl + 256 * i, row = c / 20, chn = c - row * 20, grow = rt * 128 + row;
            const bf16_t* up = p.U + (size_t)grow * LDU + UXW + chn * 8;
            float cur[8], prv[8];
            unpack8(*(const u32x4*)up, cur);
            if ((grow & 4095) > 0) unpack8(*(const u32x4*)(up - LDU), prv);
            else {
#pragma unroll
                for (int e = 0; e < 8; ++e) prv[e] = 0.f; }
            const f32x4 m0 = *(const f32x4*)(p.rwkv_mu + 1536 + chn * 8), m1 = *(const f32x4*)(p.rwkv_mu + 1536 + chn * 8 + 4);
            float o[8];
#pragma unroll
            for (int e = 0; e < 8; ++e) {
                const float x = cur[e] + (prv[e] - cur[e]) * (e < 4 ? m0[e & 3] : m1[e & 3]);
                o[e] = chn < 4 ? tanhf(x) : (chn < 8 ? x : sigmoidf_(x));
            }
            *(u32x4*)(lora + row * 160 + chn * 8) = mk4(pk2(o[0], o[1]), pk2(o[2], o[3]), pk2(o[4], o[5]), pk2(o[6], o[7]));
        }
        asm volatile("s_waitcnt vmcnt(0)" ::: "memory");
        __syncthreads();
        STAMP(17);
        {
            APlain ap{p.U + (size_t)rt * 128 * LDU + UQ, LDU};
            gemm_stream<2, 6, 4, 64, 6>(ap, p.wq_t, 256, 256, 8, [](int u, int& ao, int& bo) { ao = 0; bo = u * 96 * 256; },
                [&](const int h, f32x4 (&acc)[2][6]) {
                    int tl = t; LAUNDER(tl);
                    const int lane = tl & 63, w = tl >> 6, r = lane & 15, q = lane >> 4;
#pragma unroll
                    for (int i = 0; i < 2; ++i) {
                        const int row = 32 * w + 16 * i + r, grow = rt * 128 + row, b = grow >> 12, tt = grow & 4095;
                        const float rq = rstd_q[row];
                        f32x4 v[6];
#pragma unroll
                        for (int j = 0; j < 6; ++j) v[j] = acc[i][j] * rq;
                        head96_finish(v, q, p.q_norm, p.rope + (size_t)grow * 32, QSCALE, p.Q + ((size_t)(b * 8 + h) * NT_ + tt) * 96);
                    }
                }, lds);
        }
        STAMP(18);
        {
            APlain ap{p.U + (size_t)rt * 128 * LDU + UKV, LDU};
            gemm_stream<2, 8, 4, 64, 4>(ap, p.wkv_t, 128, 128, 8, [](int u, int& ao, int& bo) { ao = 0; bo = u * 128 * 128; },
                [&](const int h, f32x4 (&acc)[2][8]) {
                    int tl = t; LAUNDER(tl);
                    const int lane = tl & 63, w = tl >> 6, r = lane & 15, q = lane >> 4;
#pragma unroll
                    for (int i = 0; i < 2; ++i) {
                        const int row = 32 * w + 16 * i + r, grow = rt * 128 + row, b = grow >> 12, tt = grow & 4095;
                        const float rk = rstd_kv[row];
                        const bf16_t* urow = p.U + (size_t)grow * LDU;
                        f32x4 v[6];
#pragma unroll
                        for (int j = 0; j < 4; ++j) v[j] = acc[i][j] * rk;
                        v[4] = unpack4(*(const u32x2*)(urow + UPE + q * 4));
                        v[5] = unpack4(*(const u32x2*)(urow + UPE + 16 + q * 4));
                        head96_finish(v, q, p.k_norm, p.rope + (size_t)grow * 32, 1.0f, p.Kb + ((size_t)(b * 8 + h) * NT_ + tt) * 96);
                        const int tok0 = 32 * w + 16 * i + 4 * q;
                        const f32x4 rk4 = *(const f32x4*)(rstd_kv + tok0);
                        bf16_t* vd = p.Vt + ((size_t)((rt >> 5) * 8 + h) * 64) * NT_ + (rt & 31) * 128 + tok0;
#pragma unroll
                        for (int j = 4; j < 8; ++j) *(u32x2*)(vd + (size_t)((j - 4) * 16 + r) * NT_) = pack4(acc[i][j] * rk4);
                    }
                }, lds);
        }
        STAMP(19);
        bf16_t* abuf = (bf16_t*)(p.bscr + (size_t)bid * BSCR_PER_BLOCK);
        {
            APlain ap{lora, 160};
            gemm_stream<4, 4, 2, 32, 4>(ap, p.wdec_t, 32, 32, 4, [](int u, int& ao, int& bo) { ao = 0; bo = u * 128 * 32; },
                [&](const int ct, f32x4 (&acc)[4][4]) {
                    int tl = t; LAUNDER(tl);
                    const int lane = tl & 63, wid = tl >> 6, wr = wid >> 1, wc = wid & 1, r = lane & 15, q = lane >> 4, head = ct * 2 + wc;
#pragma unroll
                    for (int i = 0; i < 4; ++i) {
                        const int grow = rt * 128 + wr * 64 + i * 16 + r, b = grow >> 12, tt = grow & 4095;
                        bf16_t* sc = p.SC + ((size_t)(b * 8 + head) * NT_ + tt) * 384 + q * 4;
#pragma unroll
                        for (int j = 0; j < 4; ++j) {
                            const f32x4 w0 = *(const f32x4*)(p.decay_w0 + head * 64 + j * 16 + q * 4);
                            f32x4 o;
#pragma unroll
                            for (int e = 0; e < 4; ++e) o[e] = 1.0f - __expf(-0.6065306597f * sigmoidf_(w0[e] + acc[i][j][e]));
                            *(u32x2*)(sc + j * 16) = pack4(o);
                        }
                    }
                }, lds);
        }
        {
            APlain ap{lora + 32, 160};
            gemm_stream<4, 4, 2, 32, 4>(ap, p.wiclr_t, 32, 32, 4, [](int u, int& ao, int& bo) { ao = 0; bo = u * 128 * 32; },
                [&](const int ct, f32x4 (&acc)[4][4]) {
                    int tl = t; LAUNDER(tl);
                    const int lane = tl & 63, wid = tl >> 6, wr = wid >> 1, wc = wid & 1, r = lane & 15, q = lane >> 4, c0 = ct * 128 + wc * 64 + q * 4;
#pragma unroll
                    for (int i = 0; i < 4; ++i) {
                        bf16_t* ar = abuf + (wr * 64 + i * 16 + r) * 512 + c0;
#pragma unroll
                        for (int j = 0; j < 4; ++j) {
                            const f32x4 a0 = *(const f32x4*)(p.iclr_a0 + c0 + j * 16);
                            f32x4 o;
#pragma unroll
                            for (int e = 0; e < 4; ++e) o[e] = sigmoidf_(a0[e] + acc[i][j][e]);
                            *(u32x2*)(ar + j * 16) = pack4(o);
                        }
                    }
                }, lds);
        }
        {
            APlain ap{lora + 64, 160};
            gemm_stream<4, 4, 2, 32, 4>(ap, p.wgate_t, 96, 96, 4, [](int u, int& ao, int& bo) { ao = 0; bo = u * 128 * 96; },
                [&](const int ct, f32x4 (&acc)[4][4]) {
                    int tl = t; LAUNDER(tl);
                    const int lane = tl & 63, wid = tl >> 6, wr = wid >> 1, wc = wid & 1, r = lane & 15, q = lane >> 4, head = ct * 2 + wc;
#pragma unroll
                    for (int i = 0; i < 4; ++i) {
                        const int grow = rt * 128 + wr * 64 + i * 16 + r;
                        bf16_t* g = p.Gg + (size_t)grow * 512 + head * 64 + q * 4;
#pragma unroll
                        for (int j = 0; j < 4; ++j) *(u32x2*)(g + j * 16) = pack4(acc[i][j]);
                    }
                }, lds);
        }
        asm volatile("s_waitcnt vmcnt(0)" ::: "memory");
        __syncthreads();
#pragma unroll 1
        for (int it = 0; it < 16; ++it) {
            int tl = t; LAUNDER(tl);
            const int lane = tl & 63, w = tl >> 6, c8 = lane * 8;
#pragma unroll
            for (int u = 0; u < 2; ++u) {
                const int row = w + 4 * (it * 2 + u), grow = rt * 128 + row, b = grow >> 12, tt = grow & 4095;
                const bool hp = tt > 0;
                const bf16_t* urow = p.U + (size_t)grow * LDU + c8;
                float kc[8], kp_[8], vc[8], vp[8], rc[8], rp[8], av[8];
                unpack8(*(const u32x4*)(urow + UK), kc); unpack8(*(const u32x4*)(urow + UV), vc); unpack8(*(const u32x4*)(urow + UR), rc);
                unpack8(*(const u32x4*)(abuf + row * 512 + c8), av);
                if (hp) { unpack8(*(const u32x4*)(urow + UK - LDU), kp_); unpack8(*(const u32x4*)(urow + UV - LDU), vp); unpack8(*(const u32x4*)(urow + UR - LDU), rp); }
                else {
#pragma unroll
                    for (int e = 0; e < 8; ++e) { kp_[e] = 0.f; vp[e] = 0.f; rp[e] = 0.f; } }
                float mk[8], mv[8], mr[8], kkw[8], kaw[8];
                *(f32x4*)(mk) = *(const f32x4*)(p.rwkv_mu + 512 + c8); *(f32x4*)(mk + 4) = *(const f32x4*)(p.rwkv_mu + 512 + c8 + 4);
                *(f32x4*)(mv) = *(const f32x4*)(p.rwkv_mu + 1024 + c8); *(f32x4*)(mv + 4) = *(const f32x4*)(p.rwkv_mu + 1024 + c8 + 4);
                *(f32x4*)(mr) = *(const f32x4*)(p.rwkv_mu + c8); *(f32x4*)(mr + 4) = *(const f32x4*)(p.rwkv_mu + c8 + 4);
                *(f32x4*)(kkw) = *(const f32x4*)(p.k_k + c8); *(f32x4*)(kkw + 4) = *(const f32x4*)(p.k_k + c8 + 4);
                *(f32x4*)(kaw) = *(const f32x4*)(p.k_a + c8); *(f32x4*)(kaw + 4) = *(const f32x4*)(p.k_a + c8 + 4);
                float ks[8], kq[8], ssq = 0.f;
#pragma unroll
                for (int e = 0; e < 8; ++e) { ks[e] = kc[e] + (kp_[e] - kc[e]) * mk[e]; kq[e] = ks[e] * kkw[e]; ssq += kq[e] * kq[e]; }
                ssq = dpp_sum8(ssq);
                const float rn = rsqrtf(fmaxf(ssq, 1e-24f));
                float okk[8], obb[8], okp[8], ov[8], orr[8];
#pragma unroll
                for (int e = 0; e < 8; ++e) {
                    okk[e] = kq[e] * rn; obb[e] = av[e] * okk[e]; okp[e] = ks[e] * (1.0f + (av[e] - 1.0f) * kaw[e]);
                    ov[e] = vc[e] + (vp[e] - vc[e]) * mv[e]; orr[e] = rc[e] + (rp[e] - rc[e]) * mr[e];
                }
                bf16_t* sc = p.SC + ((size_t)(b * 8 + (lane >> 3)) * NT_ + tt) * 384 + (lane & 7) * 8;
                *(u32x4*)(sc + 64) = mk4(pk2(okk[0], okk[1]), pk2(okk[2], okk[3]), pk2(okk[4], okk[5]), pk2(okk[6], okk[7]));
                *(u32x4*)(sc + 128) = mk4(pk2(obb[0], obb[1]), pk2(obb[2], obb[3]), pk2(obb[4], obb[5]), pk2(obb[6], obb[7]));
                *(u32x4*)(sc + 192) = mk4(pk2(okp[0], okp[1]), pk2(okp[2], okp[3]), pk2(okp[4], okp[5]), pk2(okp[6], okp[7]));
                *(u32x4*)(sc + 256) = mk4(pk2(ov[0], ov[1]), pk2(ov[2], ov[3]), pk2(ov[4], ov[5]), pk2(ov[6], ov[7]));
                *(u32x4*)(sc + 320) = mk4(pk2(orr[0], orr[1]), pk2(orr[2], orr[3]), pk2(orr[4], orr[5]), pk2(orr[6], orr[7]));
            }
        }
    }
}

struct ScanOps { f32x2_t d[4], k[4], b[4], p[4], r[4]; float v; };
DI void scan_load(ScanOps& o, const float* __restrict__ q, const float* __restrict__ vp) {
    const f32x4 d0 = *(const f32x4*)(q), d1 = *(const f32x4*)(q + 4), k0 = *(const f32x4*)(q + 64), k1 = *(const f32x4*)(q + 68);
    const f32x4 b0 = *(const f32x4*)(q + 128), b1 = *(const f32x4*)(q + 132), p0 = *(const f32x4*)(q + 192), p1 = *(const f32x4*)(q + 196);
    const f32x4 r0 = *(const f32x4*)(q + 320), r1 = *(const f32x4*)(q + 324);
    o.d[0] = (f32x2_t){d0[0], d0[1]}; o.d[1] = (f32x2_t){d0[2], d0[3]}; o.d[2] = (f32x2_t){d1[0], d1[1]}; o.d[3] = (f32x2_t){d1[2], d1[3]};
    o.k[0] = (f32x2_t){k0[0], k0[1]}; o.k[1] = (f32x2_t){k0[2], k0[3]}; o.k[2] = (f32x2_t){k1[0], k1[1]}; o.k[3] = (f32x2_t){k1[2], k1[3]};
    o.b[0] = (f32x2_t){b0[0], b0[1]}; o.b[1] = (f32x2_t){b0[2], b0[3]}; o.b[2] = (f32x2_t){b1[0], b1[1]}; o.b[3] = (f32x2_t){b1[2], b1[3]};
    o.p[0] = (f32x2_t){p0[0], p0[1]}; o.p[1] = (f32x2_t){p0[2], p0[3]}; o.p[2] = (f32x2_t){p1[0], p1[1]}; o.p[3] = (f32x2_t){p1[2], p1[3]};
    o.r[0] = (f32x2_t){r0[0], r0[1]}; o.r[1] = (f32x2_t){r0[2], r0[3]}; o.r[2] = (f32x2_t){r1[0], r1[1]}; o.r[3] = (f32x2_t){r1[2], r1[3]};
    o.v = *vp;
}
DI void scan_task(const Params& p, unsigned char* lds, const int task) {
    constexpr int CS = 16;
    const int t = threadIdx.x, lane = t & 63, w = t >> 6;
    const int bh = task >> 1, hf = task & 1, b = bh >> 3, head = bh & 7;
    const int rloc = w * 8 + (lane >> 3), kseg = lane & 7;
    const int vrow = hf * 32 + rloc;
    float* stage = (float*)lds;
    float* ybuf = (float*)(lds + 49152);
    const bf16_t* src = p.SC + (size_t)bh * NT_ * 384;
    f32x2_t s2[4];
#pragma unroll
    for (int j = 0; j < 4; ++j) s2[j] = (f32x2_t){0.f, 0.f};
    u32x4 rg[3];
    __builtin_amdgcn_s_setprio(3);
    __syncthreads();
#pragma unroll
    for (int i = 0; i < 3; ++i) rg[i] = *(const u32x4*)(src + (size_t)(t + 256 * i) * 8);
#pragma unroll
    for (int i = 0; i < 3; ++i) { float* d = stage + (t + 256 * i) * 8;
        *(f32x4*)d = (f32x4){lo2f(rg[i].x), hi2f(rg[i].x), lo2f(rg[i].y), hi2f(rg[i].y)}; *(f32x4*)(d + 4) = (f32x4){lo2f(rg[i].z), hi2f(rg[i].z), lo2f(rg[i].w), hi2f(rg[i].w)}; }
    __syncthreads();
    constexpr int NCH = NT_ / CS;
    for (int c = 0; c < NCH; ++c) {
        const int cur = c & 1;
        if (c + 1 < NCH) {
#pragma unroll
            for (int i = 0; i < 3; ++i) rg[i] = *(const u32x4*)(src + (size_t)(c + 1) * CS * 384 + (size_t)(t + 256 * i) * 8);
        }
        if (c > 0) {
            const float* yb = ybuf + (cur ^ 1) * CS * 32;
            const int st = t >> 4, r2 = (t & 15) * 2;
            *(f32x2_t*)(p.yraw + ((size_t)(b * NT_ + (c - 1) * CS + st)) * 512 + head * 64 + hf * 32 + r2) = *(const f32x2_t*)(yb + st * 32 + r2);
        }
        const float* sb = stage + cur * CS * 384 + kseg * 8;
        float* yb = ybuf + cur * CS * 32;
        float yv[CS];
        ScanOps oc, on;
        scan_load(oc, sb, sb + 256 - kseg * 8 + vrow);
#pragma unroll
        for (int st = 0; st < CS; ++st) {
            if (st + 1 < CS) scan_load(on, sb + (st + 1) * 384, sb + (st + 1) * 384 + 256 - kseg * 8 + vrow);
            f32x2_t t0 = s2[0] * oc.k[0], t1 = s2[1] * oc.k[1];
            t0 = s2[2] * oc.k[2] + t0; t1 = s2[3] * oc.k[3] + t1;
            t0 = t0 + t1;
            float dot = dpp_sum8(t0.x + t0.y);
            const f32x2_t vv2 = {oc.v, oc.v}, nd2 = {-dot, -dot};
            f32x2_t u0, u1;
#pragma unroll
            for (int j = 0; j < 4; ++j) { f32x2_t tmp = s2[j] - s2[j] * oc.d[j]; tmp = vv2 * oc.p[j] + tmp; s2[j] = nd2 * oc.b[j] + tmp; }
            u0 = s2[0] * oc.r[0]; u1 = s2[1] * oc.r[1];
            u0 = s2[2] * oc.r[2] + u0; u1 = s2[3] * oc.r[3] + u1;
            u0 = u0 + u1;
            yv[st] = dpp_sum8(u0.x + u0.y);
            if (st + 1 < CS) oc = on;
        }
        if (kseg == 0) {
#pragma unroll
            for (int st = 0; st < CS; ++st) yb[st * 32 + rloc] = yv[st];
        }
        if (c + 1 < NCH) {
            float* dbase = stage + (cur ^ 1) * CS * 384;
#pragma unroll
            for (int i = 0; i < 3; ++i) { float* d = dbase + (t + 256 * i) * 8;
                *(f32x4*)d = (f32x4){lo2f(rg[i].x), hi2f(rg[i].x), lo2f(rg[i].y), hi2f(rg[i].y)}; *(f32x4*)(d + 4) = (f32x4){lo2f(rg[i].z), hi2f(rg[i].z), lo2f(rg[i].w), hi2f(rg[i].w)}; }
        }
        __syncthreads();
    }
    {
        const float* yb = ybuf + ((NCH - 1) & 1) * CS * 32;
        const int st = t >> 4, r2 = (t & 15) * 2;
        *(f32x2_t*)(p.yraw + ((size_t)(b * NT_ + (NCH - 1) * CS + st)) * 512 + head * 64 + hf * 32 + r2) = *(const f32x2_t*)(yb + st * 32 + r2);
    }
    __builtin_amdgcn_s_setprio(0);
}

DI void attn_item(const Params& p, unsigned char* lds, const int item) {
    constexpr int KROW = 208, VROW = 136, KB = 64 * KROW, BUF = KB + 64 * VROW;
    const int t = threadIdx.x, lane = t & 63, w = t >> 6, l31 = lane & 31, h = lane >> 5;
    const int qt = 31 - item / 128, bh = item % 128;
    const bf16_t* Kg = p.Kb + (size_t)bh * NT_ * 96;
    const bf16_t* Vg = p.Vt + (size_t)bh * 64 * NT_;
    const int q = qt * 128 + w * 32 + l31;
    bf16x8 qf[6];
    {
        const bf16_t* qrow = p.Q + ((size_t)bh * NT_ + q) * 96 + 8 * h;
#pragma unroll
        for (int s = 0; s < 6; ++s) qf[s] = *(const bf16x8*)(qrow + 16 * s);
    }
    f32x16 O[2];
#pragma unroll
    for (int i = 0; i < 16; ++i) { O[0][i] = 0.f; O[1][i] = 0.f; }
    float m = -INFINITY, l = 0.f;
    const int njt = 2 * qt + 2;
    int koff[3], kgo[3], voff[2], vgo[2];
#pragma unroll
    for (int i = 0; i < 3; ++i) { const int c = t + 256 * i, r = c / 12, ch = c - r * 12; koff[i] = r * KROW + ch * 16; kgo[i] = r * 96 + ch * 8; }
#pragma unroll
    for (int i = 0; i < 2; ++i) { const int c = t + 256 * i, dv = c >> 3, ch = c & 7; voff[i] = KB + dv * VROW + ch * 16; vgo[i] = dv * NT_ + ch * 8; }
    u32x4 rk0[3], rv0[2], rk1[3], rv1[2];
#define AT_LOAD(RK, RV, J) { _Pragma("unroll") for (int i = 0; i < 3; ++i) RK[i] = *(const u32x4*)(Kg + (size_t)(J) * 64 * 96 + kgo[i]); \
                             _Pragma("unroll") for (int i = 0; i < 2; ++i) RV[i] = *(const u32x4*)(Vg + (J) * 64 + vgo[i]); }
#define AT_WRITE(RK, RV, BUFI) { unsigned char* nb = lds + (BUFI) * BUF; _Pragma("unroll") for (int i = 0; i < 3; ++i) *(u32x4*)(nb + koff[i]) = RK[i]; \
                             _Pragma("unroll") for (int i = 0; i < 2; ++i) { *(u32x2*)(nb + voff[i]) = mk2(RV[i].x, RV[i].y); *(u32x2*)(nb + voff[i] + 8) = mk2(RV[i].z, RV[i].w); } }
    auto tile_compute = [&](const int cur, const int j) {
        const bool active = (j * 64) <= (qt * 128 + w * 32 + 31);
        if (active) {
            const unsigned char* Kt = lds + cur * BUF;
            const unsigned char* Vtile = Kt + KB;
            f32x16 S[2];
#pragma unroll
            for (int k2 = 0; k2 < 2; ++k2) {
#pragma unroll
                for (int i = 0; i < 16; ++i) S[k2][i] = 0.f;
#pragma unroll
                for (int s = 0; s < 6; ++s) {
                    const bf16x8 kf = *(const bf16x8*)(Kt + (k2 * 32 + l31) * KROW + s * 32 + h * 16);
                    S[k2] = __builtin_amdgcn_mfma_f32_32x32x16_bf16(kf, qf[s], S[k2], 0, 0, 0);
                }
            }
            if (j >= 2 * qt) {
#pragma unroll
                for (int k2 = 0; k2 < 2; ++k2)
#pragma unroll
                    for (int i = 0; i < 16; ++i) { const int key = j * 64 + k2 * 32 + (i & 3) + 8 * (i >> 2) + 4 * h; if (key > q) S[k2][i] = -INFINITY; }
            }
            float mx = S[0][0];
#pragma unroll
            for (int i = 1; i < 16; ++i) mx = fmaxf(mx, S[0][i]);
#pragma unroll
            for (int i = 0; i < 16; ++i) mx = fmaxf(mx, S[1][i]);
            mx = fmaxf(mx, __shfl_xor(mx, 32));
            if (__any(mx > m)) {
                const float mn = fmaxf(m, mx);
                const float alpha = __builtin_amdgcn_exp2f(m - mn);
                m = mn; l *= alpha;
#pragma unroll
                for (int i = 0; i < 16; ++i) { O[0][i] *= alpha; O[1][i] *= alpha; }
            }
            f32x2_t ps2 = {0.f, 0.f};
#pragma unroll
            for (int k2 = 0; k2 < 2; ++k2)
#pragma unroll
                for (int i = 0; i < 16; i += 2) {
                    const float e0 = __builtin_amdgcn_exp2f(S[k2][i] - m), e1 = __builtin_amdgcn_exp2f(S[k2][i + 1] - m);
                    S[k2][i] = e0; S[k2][i + 1] = e1; ps2 += (f32x2_t){e0, e1};
                }
            l += ps2.x + ps2.y;
#pragma unroll
            for (int k2 = 0; k2 < 2; ++k2)
#pragma unroll
                for (int s2 = 0; s2 < 2; ++s2) {
                    unsigned pw[4];
#pragma unroll
                    for (int e = 0; e < 4; ++e) pw[e] = pk2(S[k2][8 * s2 + 2 * e], S[k2][8 * s2 + 2 * e + 1]);
                    const bf16x8 pf = __builtin_bit_cast(bf16x8, mk4(pw[0], pw[1], pw[2], pw[3]));
#pragma unroll
                    for (int dt = 0; dt < 2; ++dt) {
                        const unsigned char* vp = Vtile + (dt * 32 + l31) * VROW + (k2 * 32 + s2 * 16 + 4 * h) * 2;
                        const u32x2 v0 = *(const u32x2*)(vp), v1 = *(const u32x2*)(vp + 16);
                        const bf16x8 vf = __builtin_bit_cast(bf16x8, mk4(v0.x, v0.y, v1.x, v1.y));
                        O[dt] = __builtin_amdgcn_mfma_f32_32x32x16_bf16(vf, pf, O[dt], 0, 0, 0);
                    }
                }
        }
    };
    AT_LOAD(rk0, rv0, 0)
    if (njt > 1) AT_LOAD(rk1, rv1, 1)
    __syncthreads();
    AT_WRITE(rk0, rv0, 0)
    if (njt > 2) AT_LOAD(rk0, rv0, 2)
    __syncthreads();
#pragma unroll 1
    for (int j = 0; j < njt; j += 2) {
        tile_compute(0, j);
        if (j + 1 < njt) { AT_WRITE(rk1, rv1, 1) if (j + 3 < njt) AT_LOAD(rk1, rv1, j + 3) }
        __syncthreads();
        if (j + 1 >= njt) break;
        tile_compute(1, j + 1);
        if (j + 2 < njt) { AT_WRITE(rk0, rv0, 0) if (j + 4 < njt) AT_LOAD(rk0, rv0, j + 4) }
        __syncthreads();
    }
#undef AT_LOAD
#undef AT_WRITE
    l += __shfl_xor(l, 32);
    const float inv = 1.0f / l;
    bf16_t* yrow = p.Y + ((size_t)((bh >> 3) * NT_ + q)) * DM + 512 + (bh & 7) * 64;
#pragma unroll
    for (int dt = 0; dt < 2; ++dt)
#pragma unroll
        for (int g = 0; g < 4; ++g)
            *(u32x2*)(yrow + dt * 32 + 8 * g + 4 * h) = mk2(pk2(O[dt][4 * g] * inv, O[dt][4 * g + 1] * inv), pk2(O[dt][4 * g + 2] * inv, O[dt][4 * g + 3] * inv));
}

DI void phase4(const Params& p, unsigned char* lds, int bid, int G) {
    int* sh_item = (int*)(lds + LDS_BYTES - 64);
    for (int task = bid; task < 256; task += G) scan_task(p, lds, task);
    STAMP(10);
    for (;;) {
        __syncthreads();
        if (threadIdx.x == 0) *sh_item = (int)atomicAdd(&p.ctrl[CTRL_ATTNQ], 1u);
        __syncthreads();
        const int item = *sh_item;
        if (item >= 4096) break;
        attn_item(p, lds, item);
    }
}

DI void phase5(const Params& p, unsigned char* lds, int bid, int G) {
    const int t = threadIdx.x, lane = t & 63, wid = t >> 6, wr = wid >> 1, wc = wid & 1;
    float* tile = (float*)lds;
    float* ssq = (float*)(lds + 69632);
    float* biasl = ssq + 128;
    int* lcnt = (int*)(lds + 65536);
    int* lbase = lcnt + 256;
    unsigned char* le = (unsigned char*)(lbase + 256);
    unsigned char* lp = le + 1024;
    __syncthreads();
    biasl[t] = p.router_bias[t];
    float* scores = (float*)(p.bscr + (size_t)bid * BSCR_PER_BLOCK);
    bf16_t* act = (bf16_t*)(p.bscr + (size_t)bid * BSCR_PER_BLOCK + 131072);
    for (int rt = bid; rt < NTOK / 128; rt += G) {
        const int b = rt >> 5;
        const float* mod = p.mod + b * 6144;
        __syncthreads();
        if (t < 128) ssq[t] = 0.f;
        lcnt[t] = 0;
#pragma unroll 2
        for (int it = 0; it < 16; ++it) {
            int tl = t; LAUNDER(tl);
            const int pr = (tl >> 2) + 64 * it;
            const int row = pr >> 3, head = pr & 7, part = tl & 3, grow = rt * 128 + row, tt = grow & 4095;
            const int ch = head * 64 + part * 16;
            const float* yr = p.yraw + (size_t)grow * 512 + ch;
            float y[16];
#pragma unroll
            for (int i = 0; i < 4; ++i) { const f32x4 v = *(const f32x4*)(yr + 4 * i); y[4 * i] = v[0]; y[4 * i + 1] = v[1]; y[4 * i + 2] = v[2]; y[4 * i + 3] = v[3]; }
            float sm = 0.f;
#pragma unroll
            for (int i = 0; i < 16; ++i) sm += y[i];
            sm += __shfl_xor(sm, 1); sm += __shfl_xor(sm, 2);
            const float mean = sm * (1.0f / 64.0f);
            float vr = 0.f;
#pragma unroll
            for (int i = 0; i < 16; ++i) { const float d = y[i] - mean; vr += d * d; }
            vr += __shfl_xor(vr, 1); vr += __shfl_xor(vr, 2);
            const float rs = rsqrtf(vr * (1.0f / 64.0f) + 64e-5f);
            const bf16_t* sc = p.SC + ((size_t)(b * 8 + head) * NT_ + tt) * 384 + part * 16;
            float kp[16], vv[16], rr[16];
#pragma unroll
            for (int i = 0; i < 2; ++i) {
                const u32x4 a = *(const u32x4*)(sc + 192 + 8 * i), c = *(const u32x4*)(sc + 256 + 8 * i), d = *(const u32x4*)(sc + 320 + 8 * i);
                kp[8 * i] = lo2f(a.x); kp[8 * i + 1] = hi2f(a.x); kp[8 * i + 2] = lo2f(a.y); kp[8 * i + 3] = hi2f(a.y); kp[8 * i + 4] = lo2f(a.z); kp[8 * i + 5] = hi2f(a.z); kp[8 * i + 6] = lo2f(a.w); kp[8 * i + 7] = hi2f(a.w);
                vv[8 * i] = lo2f(c.x); vv[8 * i + 1] = hi2f(c.x); vv[8 * i + 2] = lo2f(c.y); vv[8 * i + 3] = hi2f(c.y); vv[8 * i + 4] = lo2f(c.z); vv[8 * i + 5] = hi2f(c.z); vv[8 * i + 6] = lo2f(c.w); vv[8 * i + 7] = hi2f(c.w);
                rr[8 * i] = lo2f(d.x); rr[8 * i + 1] = hi2f(d.x); rr[8 * i + 2] = lo2f(d.y); rr[8 * i + 3] = hi2f(d.y); rr[8 * i + 4] = lo2f(d.z); rr[8 * i + 5] = hi2f(d.z); rr[8 * i + 6] = lo2f(d.w); rr[8 * i + 7] = hi2f(d.w);
            }
            float bn = 0.f;
#pragma unroll
            for (int i = 0; i < 16; ++i) bn += rr[i] * kp[i] * p.r_k[ch + i];
            bn += __shfl_xor(bn, 1); bn += __shfl_xor(bn, 2);
            const bf16_t* gg = p.Gg + (size_t)grow * 512 + ch;
            const u32x4 g0 = *(const u32x4*)(gg), g1 = *(const u32x4*)(gg + 8);
            float g[16] = {lo2f(g0.x), hi2f(g0.x), lo2f(g0.y), hi2f(g0.y), lo2f(g0.z), hi2f(g0.z), lo2f(g0.w), hi2f(g0.w), lo2f(g1.x), hi2f(g1.x), lo2f(g1.y), hi2f(g1.y), lo2f(g1.z), hi2f(g1.z), lo2f(g1.w), hi2f(g1.w)};
            float o[16];
#pragma unroll
            for (int i = 0; i < 16; ++i) o[i] = ((y[i] - mean) * rs * p.ln_w[ch + i] + p.ln_b[ch + i] + bn * vv[i]) * g[i];
            bf16_t* yd = p.Y + (size_t)grow * DM + ch;
            *(u32x4*)(yd) = mk4(pk2(o[0], o[1]), pk2(o[2], o[3]), pk2(o[4], o[5]), pk2(o[6], o[7]));
            *(u32x4*)(yd + 8) = mk4(pk2(o[8], o[9]), pk2(o[10], o[11]), pk2(o[12], o[13]), pk2(o[14], o[15]));
        }
        asm volatile("s_waitcnt vmcnt(0)" ::: "memory");
        __syncthreads();
        STAMP(11);
        {
            APlain ap{p.Y + (size_t)rt * 128 * DM, DM};
            gemm_stream<4, 4, 2, 64, 4>(ap, p.wout_t, DM, DM, 8, [](int u, int& ao, int& bo) { ao = 0; bo = u * 128 * DM; },
                [&](const int ct, f32x4 (&acc)[4][4]) {
                    int ll = lane; LAUNDER(ll);
#pragma unroll
                    for (int i = 0; i < 4; ++i) {
                        const int row = wr * 64 + i * 16 + (ll & 15), grow = rt * 128 + row;
                        float sq = 0.f;
#pragma unroll
                        for (int j = 0; j < 4; ++j) {
                            const int col = ct * 128 + wc * 64 + j * 16 + (ll >> 4) * 4;
                            const f32x4 xv = *(const f32x4*)(p.x + (size_t)grow * DM + col), ga = *(const f32x4*)(mod + 2048 + col);
                            f32x4 o;
#pragma unroll
                            for (int e = 0; e < 4; ++e) { o[e] = xv[e] + ga[e] * acc[i][j][e]; sq += o[e] * o[e]; }
                            *(f32x4*)(p.out + (size_t)grow * DM + col) = o;
                        }
                        sq += __shfl_xor(sq, 16); sq += __shfl_xor(sq, 32);
                        if ((ll >> 4) == 0) atomicAdd(&ssq[row], sq);
                    }
                }, lds);
        }
        asm volatile("s_waitcnt vmcnt(0)" ::: "memory");
        __syncthreads();
        STAMP(12);
#pragma unroll 1
        for (int mg = 0; mg < 8; ++mg) {
            int ll = lane; LAUNDER(ll);
            f32x4 xv[4][4];
#pragma unroll
            for (int u = 0; u < 4; ++u)
#pragma unroll
                for (int i = 0; i < 4; ++i) xv[u][i] = *(const f32x4*)(p.out + (size_t)(rt * 128 + wid + 4 * (mg * 4 + u)) * DM + ll * 4 + 256 * i);
#pragma unroll
            for (int u = 0; u < 4; ++u) {
                const int r = wid + 4 * (mg * 4 + u), grow = rt * 128 + r;
                const float rs = rsqrtf(ssq[r] * (1.0f / DM) + 1e-6f);
#pragma unroll
                for (int i = 0; i < 4; ++i) {
                    const int c = ll * 4 + 256 * i;
                    const f32x4 g = *(const f32x4*)(p.norm_ffn + c), sh = *(const f32x4*)(mod + 3072 + c), sc = *(const f32x4*)(mod + 4096 + c);
                    float o[4];
#pragma unroll
                    for (int e = 0; e < 4; ++e) o[e] = xv[u][i][e] * rs * g[e] * (1.0f + sc[e]) + sh[e];
                    *(u32x2*)(p.H + (size_t)grow * DM + c) = mk2(pk2(o[0], o[1]), pk2(o[2], o[3]));
                }
            }
        }
        asm volatile("s_waitcnt vmcnt(0)" ::: "memory");
        __syncthreads();
        STAMP(13);
        {
            APlain ap{p.H + (size_t)rt * 128 * DM, DM};
            gemm_stream<4, 4, 2, 64, 4>(ap, p.wr_t, DM, DM, 2, [](int u, int& ao, int& bo) { ao = 0; bo = u * 128 * DM; },
                [&](const int ct, f32x4 (&acc)[4][4]) {
                    int ll = lane; LAUNDER(ll);
#pragma unroll
                    for (int i = 0; i < 4; ++i)
#pragma unroll
                        for (int j = 0; j < 4; ++j) {
                            const int row = wr * 64 + i * 16 + (ll & 15), col = ct * 128 + wc * 64 + j * 16 + (ll >> 4) * 4;
#pragma unroll
                            for (int e = 0; e < 4; ++e) scores[(col + e) * 128 + row] = sigmoidf_(acc[i][j][e]);
                        }
                }, lds);
        }
        asm volatile("s_waitcnt vmcnt(0)" ::: "memory");
        __syncthreads();
        STAMP(14);
#pragma unroll 1
        for (int hh = 0; hh < 2; ++hh) {
            __syncthreads();
            {
                int tl = t; LAUNDER(tl);
                f32x4 rgs[16];
#pragma unroll
                for (int i = 0; i < 16; ++i) { const int c = tl + 256 * i; rgs[i] = *(const f32x4*)(scores + (c >> 4) * 128 + hh * 64 + (c & 15) * 4); }
#pragma unroll
                for (int i = 0; i < 16; ++i) *(f32x4*)(tile + (tl + 256 * i) * 4) = rgs[i];
            }
            __syncthreads();
            if (t < 64) {
                int tl = t; LAUNDER(tl);
                const int token = rt * 128 + hh * 64 + tl;
                const float* sc = tile + tl;
                float gs[8];
#pragma unroll
                for (int g = 0; g < 8; ++g) {
                    float m1 = -INFINITY, m2 = -INFINITY;
#pragma unroll 8
                    for (int i = 0; i < 32; ++i) { const float v = sc[(g * 32 + i) * 64] + biasl[g * 32 + i]; m2 = fmaxf(m2, fminf(m1, v)); m1 = fmaxf(m1, v); }
                    gs[g] = m1 + m2;
                }
                unsigned selmask = 0u;
#pragma unroll
                for (int g = 0; g < 8; ++g) {
                    int rank = 0;
#pragma unroll
                    for (int g2 = 0; g2 < 8; ++g2) rank += (gs[g2] > gs[g] || (gs[g2] == gs[g] && g2 < g)) ? 1 : 0;
                    selmask |= (rank < 4 ? 1u : 0u) << g;
                }
                float tv[8]; int ti[8];
#pragma unroll
                for (int k = 0; k < 8; ++k) { tv[k] = -INFINITY; ti[k] = 0; }
#pragma unroll 1
                for (int g = 0; g < 8; ++g) {
                    if ((selmask >> g) & 1u) {
#pragma unroll 4
                        for (int i = 0; i < 32; ++i) {
                            const int e = g * 32 + i;
                            const float v = sc[e * 64] + biasl[e];
                            if (v > tv[7]) {
#pragma unroll
                                for (int k = 7; k >= 1; --k) {
                                    if (v > tv[k - 1]) { tv[k] = tv[k - 1]; ti[k] = ti[k - 1]; }
                                    else if (v > tv[k]) { tv[k] = v; ti[k] = e; }
                                }
                                if (v > tv[0]) { tv[0] = v; ti[0] = e; }
                            }
                        }
                    }
                }
                float ws[8], wsum = 0.f;
#pragma unroll
                for (int k = 0; k < 8; ++k) { ws[k] = sc[ti[k] * 64]; wsum += ws[k]; }
                const float sc25 = 2.5f / wsum;
#pragma unroll
                for (int k = 0; k < 8; ++k) {
                    p.topk_idx[token * 8 + k] = ti[k];
                    p.topk_w[token * 8 + k] = ws[k] * sc25;
                    le[(hh * 64 + tl) * 8 + k] = (unsigned char)ti[k];
                    lp[(hh * 64 + tl) * 8 + k] = (unsigned char)atomicAdd(&lcnt[ti[k]], 1);
                }
            }
        }
        __syncthreads();
        { const int c = lcnt[t]; lbase[t] = c > 0 ? (int)atomicAdd(&p.ctrl[CTRL_ECNT + t * ECNT_STRIDE], (unsigned)c) : 0; }
        __syncthreads();
#pragma unroll
        for (int i = 0; i < 4; ++i) {
            const int a = t + 256 * i, e = le[a];
            p.elist[(size_t)e * NTOK + lbase[e] + lp[a]] = (rt * 128) * 8 + a;
        }
        STAMP(15);
        {
            APlain ap{p.H + (size_t)rt * 128 * DM, DM};
            gemm_stream<4, 4, 2, 64, 4>(ap, p.wsgu_t, DM, DM, 4, [](int u, int& ao, int& bo) { ao = 0; bo = u * 128 * DM; },
                [&](const int ct, f32x4 (&acc)[4][4]) {
                    int ll = lane; LAUNDER(ll);
#pragma unroll
                    for (int i = 0; i < 4; ++i) {
                        bf16_t* d = act + (wr * 64 + i * 16 + (ll & 15)) * 256 + ct * 64 + wc * 32 + (ll >> 4) * 4;
#pragma unroll
                        for (int m = 0; m < 2; ++m) {
                            f32x4 o;
#pragma unroll
                            for (int e = 0; e < 4; ++e) { const float g = acc[i][2 * m][e]; o[e] = g * sigmoidf_(g) * acc[i][2 * m + 1][e]; }
                            *(u32x2*)(d + m * 16) = pack4(o);
                        }
                    }
                }, lds);
        }
        asm volatile("s_waitcnt vmcnt(0)" ::: "memory");
        __syncthreads();
        STAMP(16);
        {
            APlain ap{act, 256};
            gemm_stream<4, 4, 2, 64, 4>(ap, p.wsd_t, 256, 256, 8, [](int u, int& ao, int& bo) { ao = 0; bo = u * 128 * 256; },
                [&](const int ct, f32x4 (&acc)[4][4]) {
                    int ll = lane; LAUNDER(ll);
#pragma unroll
                    for (int i = 0; i < 4; ++i)
#pragma unroll
                        for (int j = 0; j < 4; ++j) {
                            const int row = wr * 64 + i * 16 + (ll & 15), grow = rt * 128 + row, col = ct * 128 + wc * 64 + j * 16 + (ll >> 4) * 4;
                            const f32x4 xv = *(const f32x4*)(p.out + (size_t)grow * DM + col), gf = *(const f32x4*)(mod + 5120 + col);
                            f32x4 o;
#pragma unroll
                            for (int e = 0; e < 4; ++e) o[e] = xv[e] + gf[e] * acc[i][j][e];
                            *(f32x4*)(p.out + (size_t)grow * DM + col) = o;
                        }
                }, lds);
        }
    }
}

DI void phase6(const Params& p, unsigned char* lds, int bid, int G) {
    const int t = threadIdx.x, lane = t & 63, wid = t >> 6, wr = wid >> 1, wc = wid & 1;
    float* tile = (float*)lds;
    int* cpre = (int*)(lds + 69632);
    int* rowtok = (int*)(lds + 69632 + 1056);
    int* rowslot = rowtok + 128;
    float* roww = (float*)(rowslot + 128);
    int* sh_it = (int*)(roww + 128);
    bf16_t* act = (bf16_t*)(p.bscr + (size_t)bid * BSCR_PER_BLOCK + 131072);
    (void)G;
    __syncthreads();
    rowtok[t] = ((int)p.ctrl[CTRL_ECNT + t * ECNT_STRIDE] + 127) >> 7;
    __syncthreads();
    if (t < 8) { int sacc = 0; for (int k = 0; k < 32; ++k) { cpre[t * 33 + k] = sacc; sacc += rowtok[8 * k + t]; } cpre[t * 33 + 32] = sacc; }
    __syncthreads();
    const int hq = (int)(xb_xcc_id() & 7u);
    int attempt = 0;
    for (;;) {
        const int qc = (hq + attempt) & 7;
        __syncthreads();
        if (t == 0) sh_it[0] = (int)atomicAdd(&p.ctrl[CTRL_Q6 + qc * 64], 1u);
        __syncthreads();
        const int idx = sh_it[0];
        if (idx >= cpre[qc * 33 + 32]) { if (++attempt >= 8) break; continue; }
        int lo = 0, hi = 31;
        while (lo < hi) { const int mid = (lo + hi + 1) >> 1; if (cpre[qc * 33 + mid] <= idx) lo = mid; else hi = mid - 1; }
        const int e = 8 * lo + qc, tl = idx - cpre[qc * 33 + lo], cnt = (int)p.ctrl[CTRL_ECNT + e * ECNT_STRIDE];
        __syncthreads();
        if (t < 128) {
            const int r = tl * 128 + t;
            if (r < cnt) { const int ts = p.elist[(size_t)e * NTOK + r]; rowtok[t] = ts >> 3; rowslot[t] = ts; roww[t] = p.topk_w[ts]; }
            else { rowtok[t] = 0; rowslot[t] = -1; roww[t] = 0.f; }
        }
        __syncthreads();
        {
            AGather ap{p.H, rowtok};
            gemm_stream<4, 8, 2, 32, 8>(ap, p.wegu_t + (size_t)e * 512 * DM, DM, DM, 2, [](int u, int& ao, int& bo) { ao = 0; bo = u * 256 * DM; },
                [&](const int ct, f32x4 (&acc)[4][8]) {
                    int ll = lane; LAUNDER(ll);
#pragma unroll
                    for (int i = 0; i < 4; ++i) {
                        bf16_t* d = act + (wr * 64 + i * 16 + (ll & 15)) * 256 + ct * 128 + wc * 64 + (ll >> 4) * 4;
#pragma unroll
                        for (int m = 0; m < 4; ++m) {
                            f32x4 o;
#pragma unroll
                            for (int ee = 0; ee < 4; ++ee) { const float g = acc[i][2 * m][ee]; o[ee] = g * sigmoidf_(g) * acc[i][2 * m + 1][ee]; }
                            *(u32x2*)(d + m * 16) = pack4(o);
                        }
                    }
                }, lds);
        }
        asm volatile("s_waitcnt vmcnt(0)" ::: "memory");
        __syncthreads();
        {
            APlain ap{act, 256};
            gemm_stream<4, 4, 2, 64, 4>(ap, p.wed_t + (size_t)e * 1024 * 256, 256, 256, 8, [](int u, int& ao, int& bo) { ao = 0; bo = u * 128 * 256; },
                [&](const int ct, f32x4 (&acc)[4][4]) {
                    int ll = lane; LAUNDER(ll);
#pragma unroll
                    for (int i = 0; i < 4; ++i) {
                        const int row = wr * 64 + i * 16 + (ll & 15), srow = rowslot[row];
                        const float ww = roww[row];
                        if (srow >= 0) {
#pragma unroll
                            for (int j = 0; j < 4; ++j) {
                                const int col = ct * 128 + wc * 64 + j * 16 + (ll >> 4) * 4;
                                *(u32x2*)(p.slot + (size_t)srow * DM + col) = pack4(acc[i][j] * ww);
                            }
                        }
                    }
                }, lds);
        }
    }
}

DI void phase7(const Params& p, int bid, int G) {
    const int lane = threadIdx.x & 63, gw = bid * 4 + (threadIdx.x >> 6), nw = G * 4;
    for (int row = gw; row < NTOK; row += nw) {
        const float* mod = p.mod + (row >> 12) * 6144 + 5120;
#pragma unroll
        for (int i = 0; i < 4; ++i) {
            const int c = lane * 4 + 256 * i;
            float s[4] = {0.f, 0.f, 0.f, 0.f};
#pragma unroll
            for (int k = 0; k < 8; ++k) { const u32x2 w = *(const u32x2*)(p.slot + ((size_t)row * 8 + k) * DM + c); s[0] += lo2f(w.x); s[1] += hi2f(w.x); s[2] += lo2f(w.y); s[3] += hi2f(w.y); }
            const f32x4 gf = *(const f32x4*)(mod + c);
            f32x4 o = *(const f32x4*)(p.out + (size_t)row * DM + c);
#pragma unroll
            for (int e = 0; e < 4; ++e) o[e] += gf[e] * s[e];
            *(f32x4*)(p.out + (size_t)row * DM + c) = o;
        }
    }
}

extern __shared__ __attribute__((aligned(16))) unsigned char smem[];

template <int PH> DI void run_phase(const Params& p, unsigned char* lds, int bid, int G) {
    if (PH == 0) phase0(p, lds, bid, G);
    if (PH == 1) phase1(p, bid, G);
    if (PH == 2) phase2(p, lds, bid, G);
    if (PH == 3) phase3(p, lds, bid, G);
    if (PH == 4) phase4(p, lds, bid, G);
    if (PH == 5) phase5(p, lds, bid, G);
    if (PH == 6) phase6(p, lds, bid, G);
    if (PH == 7) phase7(p, bid, G);
}

#if !ONE_LAUNCH
template <int PH> __global__ void __launch_bounds__(256, 2) phase_kernel(Params p) { run_phase<PH>(p, smem, blockIdx.x, gridDim.x); }
#endif

#if ONE_LAUNCH
__global__ void __launch_bounds__(256, 2) mega_kernel(Params p) {
    volatile LAS unsigned* st = (volatile LAS unsigned*)(smem + LDS_BYTES - 16);
    if (threadIdx.x == 0) { st[0] = 0u; st[1] = 0u; st[2] = 0u; st[3] = 0u; }
    __syncthreads();
    XcdBarrier bar = xcd_barrier_post(p.ctrl, st);
    const int bid = blockIdx.x, G = gridDim.x;
    STAMP(0);
    run_phase<0>(p, smem, bid, G); xcd_barrier(bar); STAMP(1);
    run_phase<1>(p, smem, bid, G); xcd_barrier(bar); STAMP(2);
    run_phase<2>(p, smem, bid, G); xcd_barrier(bar); STAMP(3);
    run_phase<3>(p, smem, bid, G); xcd_barrier(bar); STAMP(4);
    run_phase<4>(p, smem, bid, G); xcd_barrier(bar); STAMP(5);
    run_phase<5>(p, smem, bid, G); xcd_barrier(bar); STAMP(6);
    run_phase<6>(p, smem, bid, G); xcd_barrier(bar); STAMP(7);
    run_phase<7>(p, smem, bid, G);
#ifdef PROBE_A
    xcd_barrier(bar); STAMP(8);
    xcd_barrier(bar);
    {
        const unsigned long long* sp = (const unsigned long long*)(p.ctrl + CTRL_STAMP);
        const unsigned long long ta = __hip_atomic_load(sp + PROBE_A, __ATOMIC_RELAXED, __HIP_MEMORY_SCOPE_AGENT), tb = __hip_atomic_load(sp + PROBE_B, __ATOMIC_RELAXED, __HIP_MEMORY_SCOPE_AGENT);
        const unsigned long long t0 = __builtin_amdgcn_s_memrealtime();
        while (__builtin_amdgcn_s_memrealtime() - t0 < tb - ta) __builtin_amdgcn_s_sleep(8);
    }
#endif
}
#define OCC_KERNEL mega_kernel
#else
#define OCC_KERNEL phase_kernel<5>
#endif

static inline size_t al256(size_t x) { return (x + 255) & ~(size_t)255; }

extern "C" void kernel_launch(void* const* d_in, const int* in_sizes, int n_in, void* d_out, int out_size, void* d_ws, size_t ws_size, hipStream_t stream) {
    (void)in_sizes; (void)n_in; (void)out_size;
    Params p{};
    p.x = (const float*)d_in[0]; p.c = (const float*)d_in[1]; p.positions = (const int*)d_in[2]; p.ada_w = (const float*)d_in[3]; p.ada_b = (const float*)d_in[4];
    p.norm_mix = (const float*)d_in[5]; p.w_in = (const float*)d_in[6]; p.rwkv_mu = (const float*)d_in[7]; p.decay_w0 = (const float*)d_in[8]; p.decay_up = (const float*)d_in[9];
    p.iclr_a0 = (const float*)d_in[10]; p.iclr_up = (const float*)d_in[11]; p.gate_up = (const float*)d_in[12]; p.k_k = (const float*)d_in[13]; p.k_a = (const float*)d_in[14];
    p.r_k = (const float*)d_in[15]; p.ln_w = (const float*)d_in[16]; p.ln_b = (const float*)d_in[17]; p.q_a_norm = (const float*)d_in[18]; p.w_q_b = (const float*)d_in[19];
    p.kv_a_norm = (const float*)d_in[20]; p.w_kv_b = (const float*)d_in[21]; p.q_norm = (const float*)d_in[22]; p.k_norm = (const float*)d_in[23]; p.w_out = (const float*)d_in[24];
    p.norm_ffn = (const float*)d_in[25]; p.w_router = (const float*)d_in[26]; p.router_bias = (const float*)d_in[27]; p.w_e_gu = (const float*)d_in[28]; p.w_e_d = (const float*)d_in[29];
    p.w_sh_gu = (const float*)d_in[30]; p.w_sh_d = (const float*)d_in[31];
    p.out = (float*)d_out;

    static int grid = 0;
    if (!grid) {
        int dev = 0, cus = 0, per_cu = 0;
        (void)hipGetDevice(&dev);
        (void)hipDeviceGetAttribute(&cus, hipDeviceAttributeMultiprocessorCount, dev);
#if ONE_LAUNCH
        (void)hipFuncSetAttribute((const void*)mega_kernel, hipFuncAttributeMaxDynamicSharedMemorySize, LDS_BYTES);
#endif
#if !ONE_LAUNCH
        (void)hipFuncSetAttribute((const void*)phase_kernel<0>, hipFuncAttributeMaxDynamicSharedMemorySize, LDS_BYTES);
#endif
#if !ONE_LAUNCH
        (void)hipFuncSetAttribute((const void*)phase_kernel<1>, hipFuncAttributeMaxDynamicSharedMemorySize, LDS_BYTES);
#endif
#if !ONE_LAUNCH
        (void)hipFuncSetAttribute((const void*)phase_kernel<2>, hipFuncAttributeMaxDynamicSharedMemorySize, LDS_BYTES);
#endif
#if !ONE_LAUNCH
        (void)hipFuncSetAttribute((const void*)phase_kernel<3>, hipFuncAttributeMaxDynamicSharedMemorySize, LDS_BYTES);
#endif
#if !ONE_LAUNCH
        (void)hipFuncSetAttribute((const void*)phase_kernel<4>, hipFuncAttributeMaxDynamicSharedMemorySize, LDS_BYTES);
#endif
#if !ONE_LAUNCH
        (void)hipFuncSetAttribute((const void*)phase_kernel<5>, hipFuncAttributeMaxDynamicSharedMemorySize, LDS_BYTES);
#endif
#if !ONE_LAUNCH
        (void)hipFuncSetAttribute((const void*)phase_kernel<6>, hipFuncAttributeMaxDynamicSharedMemorySize, LDS_BYTES);
#endif
#if !ONE_LAUNCH
        (void)hipFuncSetAttribute((const void*)phase_kernel<7>, hipFuncAttributeMaxDynamicSharedMemorySize, LDS_BYTES);
#endif
        (void)hipOccupancyMaxActiveBlocksPerMultiprocessor(&per_cu, (const void*)OCC_KERNEL, 256, LDS_BYTES);
        if (cus <= 0) cus = 256;
        if (per_cu < 1) per_cu = 1;
        grid = cus * (per_cu < 2 ? per_cu : 2);
    }
    unsigned char* w = (unsigned char*)d_ws; size_t o = 0;
    auto take = [&](size_t bytes) { unsigned char* r = w + o; o = al256(o + bytes); return r; };
    p.ctrl = (unsigned*)take(CTRL_WORDS * 4);
    p.mod = (float*)take((size_t)NB * 6144 * 4);
    p.rope = (float*)take((size_t)NTOK * 32 * 4);
    p.win_t = (bf16_t*)take((size_t)LDU * 1024 * 2);
    p.wq_t = (bf16_t*)take((size_t)768 * 256 * 2);
    p.wkv_t = (bf16_t*)take((size_t)1024 * 128 * 2);
    p.wdec_t = (bf16_t*)take((size_t)512 * 32 * 2);
    p.wiclr_t = (bf16_t*)take((size_t)512 * 32 * 2);
    p.wgate_t = (bf16_t*)take((size_t)512 * 96 * 2);
    p.wout_t = (bf16_t*)take((size_t)1024 * 1024 * 2);
    p.wr_t = (bf16_t*)take((size_t)256 * 1024 * 2);
    p.wsgu_t = (bf16_t*)take((size_t)512 * 1024 * 2);
    p.wsd_t = (bf16_t*)take((size_t)1024 * 256 * 2);
    p.wegu_t = (bf16_t*)take((size_t)NEXP * 512 * 1024 * 2);
    p.wed_t = (bf16_t*)take((size_t)NEXP * 1024 * 256 * 2);
    p.H = (bf16_t*)take((size_t)NTOK * DM * 2);
    p.topk_idx = (int*)take((size_t)NTOK * 8 * 4);
    p.topk_w = (float*)take((size_t)NTOK * 8 * 4);
    p.elist = (int*)take((size_t)NEXP * NTOK * 4);
    p.bscr = take((size_t)grid * BSCR_PER_BLOCK);
    const size_t ov = o;
    p.U = (bf16_t*)take((size_t)NTOK * LDU * 2);
    p.Q = (bf16_t*)take((size_t)NTOK * 8 * 96 * 2);
    p.Kb = (bf16_t*)take((size_t)NTOK * 8 * 96 * 2);
    p.Vt = (bf16_t*)take((size_t)NTOK * 8 * 64 * 2);
    p.SC = (bf16_t*)take((size_t)NTOK * 8 * 384 * 2);
    p.Gg = (bf16_t*)take((size_t)NTOK * 512 * 2);
    p.yraw = (float*)take((size_t)NTOK * 512 * 4);
    p.Y = (bf16_t*)take((size_t)NTOK * DM * 2);
    p.slot = (bf16_t*)(w + ov);
    const size_t need_slot = ov + (size_t)NTOK * 8 * DM * 2;
    if (o > ws_size || need_slot > ws_size) { fprintf(stderr, "workspace too small: need %zu / %zu, have %zu\n", o, need_slot, ws_size); return; }

    (void)hipMemsetAsync(p.ctrl, 0, CTRL_WORDS * 4, stream);
#if ONE_LAUNCH
    hipLaunchKernelGGL(mega_kernel, dim3(grid), dim3(256), LDS_BYTES, stream, p);
#else
    hipLaunchKernelGGL(phase_kernel<0>, dim3(grid), dim3(256), LDS_BYTES, stream, p);
    hipLaunchKernelGGL(phase_kernel<1>, dim3(grid), dim3(256), LDS_BYTES, stream, p);
    hipLaunchKernelGGL(phase_kernel<2>, dim3(grid), dim3(256), LDS_BYTES, stream, p);
    hipLaunchKernelGGL(phase_kernel<3>, dim3(grid), dim3(256), LDS_BYTES, stream, p);
    hipLaunchKernelGGL(phase_kernel<4>, dim3(grid), dim3(256), LDS_BYTES, stream, p);
    hipLaunchKernelGGL(phase_kernel<5>, dim3(grid), dim3(256), LDS_BYTES, stream, p);
    hipLaunchKernelGGL(phase_kernel<6>, dim3(grid), dim3(256), LDS_BYTES, stream, p);
    hipLaunchKernelGGL(phase_kernel<7>, dim3(grid), dim3(256), LDS_BYTES, stream, p);
#endif
}
```

```cpp
#include <hip/hip_runtime.h>
#include <stdint.h>
#include <stdio.h>
#define DI __device__ __forceinline__

#ifndef SCAN_CHUNKED
#define SCAN_CHUNKED 1
#endif
#ifndef ONE_LAUNCH
#define ONE_LAUNCH 1
#endif

typedef unsigned short bf16_t;
typedef short bf16x8 __attribute__((ext_vector_type(8)));
typedef float f32x4 __attribute__((ext_vector_type(4)));
typedef float f32x16 __attribute__((ext_vector_type(16)));
typedef float f32x2_t __attribute__((ext_vector_type(2)));
typedef unsigned u32x4 __attribute__((ext_vector_type(4)));
typedef unsigned u32x2 __attribute__((ext_vector_type(2)));
#define LAUNDER(v) asm volatile("" : "+v"(v))
DI u32x4 mk4(unsigned a, unsigned b, unsigned c, unsigned d) { return (u32x4){a, b, c, d}; }
DI u32x2 mk2(unsigned a, unsigned b) { return (u32x2){a, b}; }

typedef __bf16 bf16x2_t __attribute__((ext_vector_type(2)));

constexpr int NB = 16, NT_ = 4096, DM = 1024, NTOK = NB * NT_;
constexpr int LDU = 2176;
constexpr int UQ = 0, UKV = 256, UR = 384, UK = 896, UV = 1408, UXW = 1920, UXA = 1952, UXG = 1984, UPE = 2080;
constexpr int NEXP = 256, TOPK = 8;
constexpr int LDS_BYTES = 73728;
constexpr float QSCALE = 0.14724444f;

#define XB_TMO      128
#define XB_XCNT(j)  (256  + 64 * (j))
#define XB_XSUB(j)  (1280 + 64 * (j))
#define XB_XGEN(j)  (2304 + 64 * (j))
#define XB_TOP      3328
#define XB_TOPGEN   3392
#define XCD_BAR_WORDS 3456
#define XB_SPIN_CAP (1u << 22)
#define LAS __attribute__((address_space(3)))
constexpr int CTRL_ATTNQ = 4096, CTRL_ECNT = 8192, ECNT_STRIDE = 64, CTRL_WORDS = 24576;
constexpr int CTRL_STAMP = 4160;
constexpr int CTRL_Q6 = 4608;
#ifdef PROBE_A
#define STAMP(id) do { if (blockIdx.x == 0 && threadIdx.x == 0) __hip_atomic_store((unsigned long long*)(p.ctrl + CTRL_STAMP) + (id), (unsigned long long)__builtin_amdgcn_s_memrealtime(), __ATOMIC_RELAXED, __HIP_MEMORY_SCOPE_AGENT); } while (0)
#else
#define STAMP(id)
#endif

DI unsigned xb_ld(unsigned* p)              { return __hip_atomic_load(p, __ATOMIC_RELAXED, __HIP_MEMORY_SCOPE_AGENT); }
DI unsigned xb_add(unsigned* p, unsigned v) { return __hip_atomic_fetch_add(p, v, __ATOMIC_RELAXED, __HIP_MEMORY_SCOPE_AGENT); }
DI unsigned xb_xcc_id() { return (unsigned)__builtin_amdgcn_s_getreg((3 << 11) | 20) & 0xFu; }
#define XB_SPIN(cond, bar) do { unsigned _sp = 0; while (cond) { __builtin_amdgcn_s_sleep(1); \
    if ((++_sp & 255u) == 0u) { if (xb_ld(&(bar)[XB_TMO])) break; if (_sp > XB_SPIN_CAP) { atomicAdd(&(bar)[XB_TMO], 1u); break; } } } } while (0)

struct XcdBarrier { unsigned* bar; unsigned x; volatile LAS unsigned* st; };

DI XcdBarrier xcd_barrier_post(unsigned* bar, volatile LAS unsigned* st) {
    XcdBarrier b; b.bar = bar; b.x = xb_xcc_id(); b.st = st;
    if (threadIdx.x == 0) (void)xb_add(&bar[XB_XCNT(b.x)], 1u);
    return b;
}
DI void xcd_barrier_complete(unsigned* bar, unsigned x, unsigned& nloc, unsigned& nx) {
    const unsigned G = gridDim.x * gridDim.y * gridDim.z;
    unsigned sum, cnt, mine, sp = 0u;
    for (;;) {
        sum = 0u; cnt = 0u; mine = 0u;
#pragma unroll
        for (unsigned j = 0; j < 16; ++j) { const unsigned c = xb_ld(&bar[XB_XCNT(j)]); sum += c; cnt += (c > 0u) ? 1u : 0u; mine = (j == x) ? c : mine; }
        if (sum == G) break;
        __builtin_amdgcn_s_sleep(1);
        if ((++sp & 255u) == 0u) { if (xb_ld(&bar[XB_TMO])) break; if (sp > XB_SPIN_CAP) { atomicAdd(&bar[XB_TMO], 1u); break; } }
    }
    nloc = mine > 0u ? mine : 1u; nx = cnt > 0u ? cnt : 1u;
}
DI void xcd_barrier(const XcdBarrier& b) {
    asm volatile("s_waitcnt vmcnt(0)" ::: "memory");
    __syncthreads();
    if (threadIdx.x == 0) {
        unsigned* bar = b.bar;
        __builtin_amdgcn_s_waitcnt(0);
        unsigned nloc = b.st[0], nx = b.st[1];
        if (nloc == 0u) { xcd_barrier_complete(bar, b.x, nloc, nx); b.st[0] = nloc; b.st[1] = nx; }
        const unsigned old = xb_add(&bar[XB_XSUB(b.x)], 1u);
        const unsigned gen = old / nloc;
        if (old + 1u == (gen + 1u) * nloc) {
            __builtin_amdgcn_fence(__ATOMIC_RELEASE, "agent");
            asm volatile("s_waitcnt vmcnt(0)" ::: "memory");
            const unsigned og = xb_add(&bar[XB_TOP], 1u);
            const unsigned tg = og / nx;
            if (og + 1u == (tg + 1u) * nx) xb_add(&bar[XB_TOPGEN], 1u);
            else XB_SPIN(xb_ld(&bar[XB_TOPGEN]) == tg, bar);
            __builtin_amdgcn_fence(__ATOMIC_ACQUIRE, "agent");
            xb_add(&bar[XB_XGEN(b.x)], 1u);
            asm volatile("s_waitcnt vmcnt(0)" ::: "memory");
        } else {
            XB_SPIN(xb_ld(&bar[XB_XGEN(b.x)]) == gen, bar);
            __builtin_amdgcn_fence(__ATOMIC_ACQUIRE, "agent");
            asm volatile("s_waitcnt vmcnt(0)" ::: "memory");
        }
    }
    __syncthreads();
}

struct Params {
    const float* x; const float* c; const int* positions; const float* ada_w; const float* ada_b; const float* norm_mix; const float* w_in;
    const float* rwkv_mu; const float* decay_w0; const float* decay_up; const float* iclr_a0; const float* iclr_up; const float* gate_up;
    const float* k_k; const float* k_a; const float* r_k; const float* ln_w; const float* ln_b;
    const float* q_a_norm; const float* w_q_b; const float* kv_a_norm; const float* w_kv_b; const float* q_norm; const float* k_norm;
    const float* w_out; const float* norm_ffn; const float* w_router; const float* router_bias;
    const float* w_e_gu; const float* w_e_d; const float* w_sh_gu; const float* w_sh_d;
    float* out;
    unsigned* ctrl; float* mod; float* rope;
    bf16_t* win_t; bf16_t* wq_t; bf16_t* wkv_t; bf16_t* wdec_t; bf16_t* wiclr_t; bf16_t* wgate_t; bf16_t* wout_t; bf16_t* wr_t; bf16_t* wsgu_t; bf16_t* wsd_t;
    bf16_t* wegu_t; bf16_t* wed_t;
    bf16_t* H; int* topk_idx; float* topk_w; int* elist; unsigned char* bscr;
    bf16_t* U; bf16_t* Q; bf16_t* Kb; bf16_t* Vt; bf16_t* SC; bf16_t* Gg; float* yraw; bf16_t* Y; bf16_t* slot;
};
constexpr size_t BSCR_PER_BLOCK = 196608;

DI float bf2f(bf16_t v) { return __uint_as_float(((unsigned)v) << 16); }
DI unsigned pk2(float a, float b) { f32x2_t f = {a, b}; bf16x2_t r = __builtin_convertvector(f, bf16x2_t); return __builtin_bit_cast(unsigned, r); }
DI bf16_t f2bf(float a) { return (bf16_t)(pk2(a, 0.f) & 0xffffu); }
DI float lo2f(unsigned w) { return __uint_as_float(w << 16); }
DI float hi2f(unsigned w) { return __uint_as_float(w & 0xffff0000u); }
DI float sigmoidf_(float x) { return 1.0f / (1.0f + __expf(-x)); }
DI float wave_sum(float v) {
#pragma unroll
    for (int o = 32; o > 0; o >>= 1) v += __shfl_xor(v, o);
    return v;
}
DI float dpp_sum8(float s) {
    s += __builtin_bit_cast(float, __builtin_amdgcn_update_dpp(0, __builtin_bit_cast(int, s), 0xB1, 0xf, 0xf, true));
    s += __builtin_bit_cast(float, __builtin_amdgcn_update_dpp(0, __builtin_bit_cast(int, s), 0x4E, 0xf, 0xf, true));
    s += __builtin_bit_cast(float, __builtin_amdgcn_update_dpp(0, __builtin_bit_cast(int, s), 0x141, 0xf, 0xf, true));
    return s;
}

struct APlain { const bf16_t* base; int ld; DI const bf16_t* row(int r) const { return base + (size_t)r * ld; } };
struct AGather { const bf16_t* base; const int* idx; DI const bf16_t* row(int r) const { return base + (size_t)idx[r] * DM; } };

template <int MT, int NT, int WR, int BK, int NSWAP, class AP>
DI void gemm_tile(const AP ap, const bf16_t* __restrict__ Bt, const int ldb, const int K, f32x4 (&acc)[MT][NT], unsigned char* lds) {
    constexpr int WC = 4 / WR, CPR = BK / 8, RB = BK * 2, R256 = 256 / RB, BN = WC * NT * 16;
    static_assert(WR * MT * 16 == 128, "tile is 128 rows");
    constexpr int A_BYTES = 128 * RB, B_BYTES = BN * RB;
    constexpr int A_CH = (128 * CPR) / 256, B_TOT = BN * CPR, B_CH = (B_TOT + 255) / 256, RSTEP = 256 / CPR;
    int t = threadIdx.x; LAUNDER(t);
    const int lane = t & 63, wid = t >> 6, wr = wid / WC, wc = wid % WC;
    const int ch = t % CPR, r0 = t / CPR;
    const bf16_t* pa[A_CH]; const bf16_t* pb[B_CH]; int offa[A_CH], offb[B_CH]; bool vb[B_CH];
#pragma unroll
    for (int i = 0; i < A_CH; ++i) { const int row = r0 + i * RSTEP; pa[i] = ap.row(row) + ch * 8; offa[i] = row * RB + ((ch ^ ((row / R256) & (CPR - 1))) << 4); }
#pragma unroll
    for (int i = 0; i < B_CH; ++i) { const int row = r0 + i * RSTEP; vb[i] = (B_TOT % 256 == 0) || (row < BN); const int rr = vb[i] ? row : 0; pb[i] = Bt + (size_t)rr * ldb + ch * 8; offb[i] = 2 * A_BYTES + rr * RB + ((ch ^ ((rr / R256) & (CPR - 1))) << 4); }
#pragma unroll
    for (int i = 0; i < MT; ++i)
#pragma unroll
        for (int j = 0; j < NT; ++j) acc[i][j] = (f32x4){0.f, 0.f, 0.f, 0.f};
    const int KT = K / BK;
    u32x4 ra0[A_CH], rb0[B_CH], ra1[A_CH], rb1[B_CH];
#define G_LOAD(RA, RB, KTI) { _Pragma("unroll") for (int i = 0; i < A_CH; ++i) RA[i] = *(const u32x4*)(pa[i] + (KTI) * BK); \
                              _Pragma("unroll") for (int i = 0; i < B_CH; ++i) RB[i] = *(const u32x4*)(pb[i] + (KTI) * BK); }
#define G_WRITE(RA, RB, BUF) { _Pragma("unroll") for (int i = 0; i < A_CH; ++i) *(u32x4*)(lds + (BUF) * A_BYTES + offa[i]) = RA[i]; \
                               _Pragma("unroll") for (int i = 0; i < B_CH; ++i) if (vb[i]) *(u32x4*)(lds + (BUF) * B_BYTES + offb[i]) = RB[i]; }
#define G_COMPUTE(BUF) { const unsigned char* Ab = lds + (BUF) * A_BYTES + arow; const unsigned char* Bb = lds + 2 * A_BYTES + (BUF) * B_BYTES + brow; \
        _Pragma("unroll") for (int ks = 0; ks < BK / 32; ++ks) { const int co = ((ks * 4 + (lane >> 4)) ^ sw) << 4; bf16x8 af[MT], bfr[NT]; \
            _Pragma("unroll") for (int i = 0; i < MT; ++i) af[i] = *(const bf16x8*)(Ab + i * 16 * RB + co); \
            _Pragma("unroll") for (int j = 0; j < NT; ++j) bfr[j] = *(const bf16x8*)(Bb + j * 16 * RB + co); \
            _Pragma("unroll") for (int i = 0; i < MT; ++i) _Pragma("unroll") for (int j = 0; j < NT; ++j) \
                acc[i][j] = (j < NSWAP) ? __builtin_amdgcn_mfma_f32_16x16x32_bf16(bfr[j], af[i], acc[i][j], 0, 0, 0) \
                                        : __builtin_amdgcn_mfma_f32_16x16x32_bf16(af[i], bfr[j], acc[i][j], 0, 0, 0); } }
    const int sw = ((lane & 15) / R256) & (CPR - 1);
    const int arow = (wr * MT * 16 + (lane & 15)) * RB, brow = (wc * NT * 16 + (lane & 15)) * RB;
    G_LOAD(ra0, rb0, 0)
    if (KT > 1) G_LOAD(ra1, rb1, 1)
    __syncthreads();
    G_WRITE(ra0, rb0, 0)
    if (KT > 2) G_LOAD(ra0, rb0, 2)
    __syncthreads();
    for (int kt = 0; kt < KT; kt += 2) {
        G_COMPUTE(0)
        if (kt + 1 < KT) { G_WRITE(ra1, rb1, 1) if (kt + 3 < KT) G_LOAD(ra1, rb1, kt + 3) }
        __syncthreads();
        if (kt + 1 >= KT) break;
        G_COMPUTE(1)
        if (kt + 2 < KT) { G_WRITE(ra0, rb0, 0) if (kt + 4 < KT) G_LOAD(ra0, rb0, kt + 4) }
        __syncthreads();
    }
#undef G_LOAD
#undef G_WRITE
#undef G_COMPUTE
}
template <int MT, int NT, int WR, int BK, int NSWAP, class AP, class UF, class EPI>
DI void gemm_stream(const AP ap, const bf16_t* __restrict__ Bt, const int ldb, const int K, const int nunits, const UF uoff, const EPI epi, unsigned char* lds) {
    constexpr int WC = 4 / WR, CPR = BK / 8, RB = BK * 2, R256 = 256 / RB, BN = WC * NT * 16, NTH = (NT > 6) ? NT / 2 : NT;
    static_assert(WR * MT * 16 == 128, "tile is 128 rows");
    constexpr int A_BYTES = 128 * RB, B_BYTES = BN * RB;
    constexpr int A_CH = (128 * CPR) / 256, B_TOT = BN * CPR, B_CH = (B_TOT + 255) / 256, RSTEP = 256 / CPR;
    int t = threadIdx.x; LAUNDER(t);
    const int lane = t & 63, wid = t >> 6, wr = wid / WC, wc = wid % WC;
    const int ch = t % CPR, r0 = t / CPR;
    const bf16_t* pa[A_CH]; const bf16_t* pb[B_CH]; int offa[A_CH], offb[B_CH]; bool vb[B_CH];
#pragma unroll
    for (int i = 0; i < A_CH; ++i) { const int row = r0 + i * RSTEP; pa[i] = ap.row(row) + ch * 8; offa[i] = row * RB + ((ch ^ ((row / R256) & (CPR - 1))) << 4); }
#pragma unroll
    for (int i = 0; i < B_CH; ++i) { const int row = r0 + i * RSTEP; vb[i] = (B_TOT % 256 == 0) || (row < BN); const int rr = vb[i] ? row : 0; pb[i] = Bt + (size_t)rr * ldb + ch * 8; offb[i] = 2 * A_BYTES + rr * RB + ((ch ^ ((rr / R256) & (CPR - 1))) << 4); }
    f32x4 acc[MT][NT];
#pragma unroll
    for (int i = 0; i < MT; ++i)
#pragma unroll
        for (int j = 0; j < NT; ++j) acc[i][j] = (f32x4){0.f, 0.f, 0.f, 0.f};
    const int KT = K / BK, NG = nunits * KT;
    int lu = 0, lkt = 0, cu = 0, ckt = 0;
    u32x4 ra0[A_CH], rb0[B_CH], ra1[A_CH], rb1[B_CH];
#define S_LOAD(RA, RB) { int ao, bo; uoff(lu, ao, bo); ao += lkt * BK; bo += lkt * BK; \
                         _Pragma("unroll") for (int i = 0; i < A_CH; ++i) RA[i] = *(const u32x4*)(pa[i] + ao); \
                         _Pragma("unroll") for (int i = 0; i < B_CH; ++i) RB[i] = *(const u32x4*)(pb[i] + bo); \
                         if (++lkt == KT) { lkt = 0; ++lu; } }
#define S_WRITE(RA, RB, BUF) { _Pragma("unroll") for (int i = 0; i < A_CH; ++i) *(u32x4*)(lds + (BUF) * A_BYTES + offa[i]) = RA[i]; \
                               _Pragma("unroll") for (int i = 0; i < B_CH; ++i) if (vb[i]) *(u32x4*)(lds + (BUF) * B_BYTES + offb[i]) = RB[i]; }
#define S_COMPUTE(BUF) { const unsigned char* Ab = lds + (BUF) * A_BYTES + arow; const unsigned char* Bb = lds + 2 * A_BYTES + (BUF) * B_BYTES + brow; \
        _Pragma("unroll") for (int ks = 0; ks < BK / 32; ++ks) { const int co = ((ks * 4 + (lane >> 4)) ^ sw) << 4; bf16x8 af[MT]; \
            _Pragma("unroll") for (int i = 0; i < MT; ++i) af[i] = *(const bf16x8*)(Ab + i * 16 * RB + co); \
            _Pragma("unroll") for (int jh = 0; jh < NT / NTH; ++jh) { bf16x8 bfr[NTH]; \
                _Pragma("unroll") for (int j = 0; j < NTH; ++j) bfr[j] = *(const bf16x8*)(Bb + (jh * NTH + j) * 16 * RB + co); \
                __builtin_amdgcn_s_setprio(1); \
                _Pragma("unroll") for (int i = 0; i < MT; ++i) _Pragma("unroll") for (int j = 0; j < NTH; ++j) \
                    acc[i][jh * NTH + j] = (jh * NTH + j < NSWAP) ? __builtin_amdgcn_mfma_f32_16x16x32_bf16(bfr[j], af[i], acc[i][jh * NTH + j], 0, 0, 0) \
                                                                : __builtin_amdgcn_mfma_f32_16x16x32_bf16(af[i], bfr[j], acc[i][jh * NTH + j], 0, 0, 0); \
                __builtin_amdgcn_s_setprio(0); } } }
#define S_EPI { if (++ckt == KT) { epi(cu, acc); ckt = 0; ++cu; \
                _Pragma("unroll") for (int i = 0; i < MT; ++i) _Pragma("unroll") for (int j = 0; j < NT; ++j) acc[i][j] = (f32x4){0.f, 0.f, 0.f, 0.f}; } }
    const int sw = ((lane & 15) / R256) & (CPR - 1);
    const int arow = (wr * MT * 16 + (lane & 15)) * RB, brow = (wc * NT * 16 + (lane & 15)) * RB;
    S_LOAD(ra0, rb0)
    if (NG > 1) S_LOAD(ra1, rb1)
    __syncthreads();
    S_WRITE(ra0, rb0, 0)
    if (NG > 2) S_LOAD(ra0, rb0)
    __syncthreads();
#pragma unroll 1
    for (int g = 0; g < NG; g += 2) {
        S_COMPUTE(0)
        if (g + 1 < NG) { S_WRITE(ra1, rb1, 1) if (g + 3 < NG) S_LOAD(ra1, rb1) }
        S_EPI
        __syncthreads();
        if (g + 1 >= NG) break;
        S_COMPUTE(1)
        if (g + 2 < NG) { S_WRITE(ra0, rb0, 0) if (g + 4 < NG) S_LOAD(ra0, rb0) }
        S_EPI
        __syncthreads();
    }
#undef S_LOAD
#undef S_WRITE
#undef S_COMPUTE
#undef S_EPI
}

template <int NT, int BK, class AP>
DI void gemm_core(const AP ap, const bf16_t* __restrict__ Bt, const int ldb, const int K, f32x4 (&acc)[4][NT], unsigned char* lds) {
    gemm_tile<4, NT, 2, BK, NT>(ap, Bt, ldb, K, acc, lds);
}

template <int NT> DI void acc_to_lds(const f32x4 (&acc)[4][NT], float* tile, const int ld) {
    int t = threadIdx.x; LAUNDER(t);
    const int lane = t & 63, wid = t >> 6, wr = wid >> 1, wc = wid & 1;
#pragma unroll
    for (int i = 0; i < 4; ++i)
#pragma unroll
        for (int j = 0; j < NT; ++j) {
            const int row = wr * 64 + i * 16 + (lane & 15), col = wc * NT * 16 + j * 16 + (lane >> 4) * 4;
            *(f32x4*)(tile + row * ld + col) = acc[i][j];
        }
}

DI int map_win(int n) { return n < 384 ? n + 1696 : (n < 2080 ? n - 384 : (n < 2112 ? n : -1)); }
DI int map_gu128(int n) { const int tile = n >> 7, w = n & 127, wc = w >> 6, j = (w >> 4) & 3, r = w & 15; const int a = tile * 64 + wc * 32 + (j >> 1) * 16 + r; return (j & 1) ? 256 + a : a; }
DI int map_gu(int n) { const int tile = n >> 8, w = n & 255, wc = w >> 7, j = (w >> 4) & 7, r = w & 15; const int a = tile * 128 + wc * 64 + (j >> 1) * 16 + r; return (j & 1) ? 256 + a : a; }

template <int MAP> DI void tconv_simple(const float* __restrict__ src, bf16_t* __restrict__ dst, int K, int Ns, int Nd, const float* __restrict__ scale, int gtid, int gthreads) {
    const int total = Nd * K;
    for (int idx = gtid; idx < total; idx += gthreads) {
        const int n = idx / K, k = idx - n * K;
        const int m = (MAP == 1) ? map_win(n) : (MAP == 2 ? map_gu(n) : (MAP == 3 ? map_gu128(n) : n));
        float v = 0.f;
        if (m >= 0) { v = src[(size_t)k * Ns + m]; if (scale) v *= scale[k]; }
        dst[idx] = f2bf(v);
    }
}
template <int MAP> DI void tconv_tiled(const float* __restrict__ src, bf16_t* __restrict__ dst, int E, int K, int N, float* ldsf, int bid, int G) {
    const int tk = K / 64, tn = N / 64, per = tk * tn, total = E * per;
    const int t = threadIdx.x;
    for (int tile0 = 2 * bid; tile0 < total; tile0 += 2 * G) {
        float rg[2][16];
#pragma unroll
        for (int h = 0; h < 2; ++h) {
            const int tile = tile0 + h, e = tile / per, r = tile - e * per, kt = r / tn, nt = r - kt * tn;
            const float* s = src + (size_t)e * K * N + (size_t)(kt * 64) * N;
            const int nl = t & 63, n = nt * 64 + nl;
            const int m = (MAP == 2) ? map_gu(n) : n;
#pragma unroll
            for (int i = 0; i < 16; ++i) rg[h][i] = s[(size_t)((t >> 6) + 4 * i) * N + m];
        }
        __syncthreads();
#pragma unroll
        for (int h = 0; h < 2; ++h)
#pragma unroll
            for (int i = 0; i < 16; ++i) ldsf[h * 4160 + ((t >> 6) + 4 * i) * 65 + (t & 63)] = rg[h][i];
        __syncthreads();
#pragma unroll
        for (int h = 0; h < 2; ++h) {
            const int tile = tile0 + h, e = tile / per, r = tile - e * per, kt = r / tn, nt = r - kt * tn;
            const int nl = t >> 2, kc = (t & 3) * 16;
            unsigned w[8];
#pragma unroll
            for (int i = 0; i < 8; ++i) w[i] = pk2(ldsf[h * 4160 + (kc + 2 * i) * 65 + nl], ldsf[h * 4160 + (kc + 2 * i + 1) * 65 + nl]);
            bf16_t* d = dst + (size_t)e * K * N + (size_t)(nt * 64 + nl) * K + kt * 64 + kc;
            *(u32x4*)(d) = mk4(w[0], w[1], w[2], w[3]);
            *(u32x4*)(d + 8) = mk4(w[4], w[5], w[6], w[7]);
        }
    }
}
DI void phase0(const Params& p, unsigned char* lds, int bid, int G) {
    const int t = threadIdx.x;
    float* ldsf = (float*)lds;
    for (int item = bid; item < 384; item += G) {
        __syncthreads();
        for (int i = t; i < NB * DM; i += 256) { const float v = p.c[i]; ldsf[(i & (DM - 1)) * NB + (i >> 10)] = v * sigmoidf_(v); }
        __syncthreads();
        const int col = item * 16 + (t & 15), kp = t >> 4;
        float a[NB];
#pragma unroll
        for (int b = 0; b < NB; ++b) a[b] = 0.f;
#pragma unroll 1
        for (int k0 = kp * 64; k0 < kp * 64 + 64; k0 += 8) {
            float w[8];
#pragma unroll
            for (int u = 0; u < 8; ++u) w[u] = p.ada_w[(size_t)(k0 + u) * 6144 + col];
#pragma unroll
            for (int u = 0; u < 8; ++u) {
#pragma unroll
                for (int q = 0; q < 4; ++q) { const f32x4 cv = *(const f32x4*)(ldsf + (k0 + u) * NB + 4 * q); a[4 * q] += cv[0] * w[u]; a[4 * q + 1] += cv[1] * w[u]; a[4 * q + 2] += cv[2] * w[u]; a[4 * q + 3] += cv[3] * w[u]; }
            }
        }
        __syncthreads();
#pragma unroll
        for (int b = 0; b < NB; ++b) ldsf[(kp * NB + b) * 16 + (t & 15)] = a[b];
        __syncthreads();
        {
            const int b = t >> 4, cl = t & 15; float sacc = 0.f;
#pragma unroll
            for (int q = 0; q < 16; ++q) sacc += ldsf[(q * NB + b) * 16 + cl];
            p.mod[b * 6144 + item * 16 + cl] = sacc + p.ada_b[item * 16 + cl];
        }
    }
    __syncthreads();
    const int gtid = bid * 256 + t, gth = G * 256;
    tconv_simple<1>(p.w_in, p.win_t, 1024, 2112, LDU, nullptr, gtid, gth);
    tconv_simple<0>(p.w_q_b, p.wq_t, 256, 768, 768, p.q_a_norm, gtid, gth);
    tconv_simple<0>(p.w_kv_b, p.wkv_t, 128, 1024, 1024, p.kv_a_norm, gtid, gth);
    tconv_simple<0>(p.decay_up, p.wdec_t, 32, 512, 512, nullptr, gtid, gth);
    tconv_simple<0>(p.iclr_up, p.wiclr_t, 32, 512, 512, nullptr, gtid, gth);
    tconv_simple<0>(p.gate_up, p.wgate_t, 96, 512, 512, nullptr, gtid, gth);
    tconv_simple<0>(p.w_out, p.wout_t, 1024, 1024, 1024, nullptr, gtid, gth);
    tconv_simple<0>(p.w_router, p.wr_t, 1024, 256, 256, nullptr, gtid, gth);
    tconv_simple<3>(p.w_sh_gu, p.wsgu_t, 1024, 512, 512, nullptr, gtid, gth);
    tconv_simple<0>(p.w_sh_d, p.wsd_t, 256, 1024, 1024, nullptr, gtid, gth);
    tconv_tiled<2>(p.w_e_gu, p.wegu_t, NEXP, 1024, 512, ldsf, bid, G);
    tconv_tiled<0>(p.w_e_d, p.wed_t, NEXP, 256, 1024, ldsf, bid, G);
}

DI void phase1(const Params& p, int bid, int G) {
    const int lane = threadIdx.x & 63, gw = bid * 4 + (threadIdx.x >> 6), nw = G * 4;
    for (int row0 = gw * 2; row0 < NTOK; row0 += nw * 2) {
        f32x4 v[2][4]; float ss[2] = {0.f, 0.f};
#pragma unroll
        for (int u = 0; u < 2; ++u)
#pragma unroll
            for (int i = 0; i < 4; ++i) v[u][i] = *(const f32x4*)(p.x + (size_t)(row0 + u) * DM + lane * 4 + 256 * i);
#pragma unroll
        for (int u = 0; u < 2; ++u) {
#pragma unroll
            for (int i = 0; i < 4; ++i) ss[u] += v[u][i][0] * v[u][i][0] + v[u][i][1] * v[u][i][1] + v[u][i][2] * v[u][i][2] + v[u][i][3] * v[u][i][3];
            ss[u] = wave_sum(ss[u]);
        }
        const float* mod = p.mod + (row0 >> 12) * 6144;
#pragma unroll
        for (int i = 0; i < 4; ++i) {
            const int c = lane * 4 + 256 * i;
            const f32x4 g = *(const f32x4*)(p.norm_mix + c), sh = *(const f32x4*)(mod + c), sc = *(const f32x4*)(mod + 1024 + c);
#pragma unroll
            for (int u = 0; u < 2; ++u) {
                const float rs = rsqrtf(ss[u] * (1.0f / DM) + 1e-6f);
                float o[4];
#pragma unroll
                for (int e = 0; e < 4; ++e) o[e] = v[u][i][e] * rs * g[e] * (1.0f + sc[e]) + sh[e];
                *(u32x2*)(p.H + (size_t)(row0 + u) * DM + c) = mk2(pk2(o[0], o[1]), pk2(o[2], o[3]));
            }
        }
    }
    const double inv = exp(-(double)(lane & 15) * (9.210340371976184 / 16.0));
    for (int idx = gw * 64 + lane; idx < NTOK * 16; idx += nw * 64) {
        const int row = idx >> 4;
        const double ang = (double)p.positions[row] * inv;
        p.rope[(size_t)row * 32 + (lane & 15)] = (float)cos(ang);
        p.rope[(size_t)row * 32 + 16 + (lane & 15)] = (float)sin(ang);
    }
}

DI void phase2(const Params& p, unsigned char* lds, int bid, int G) {
    constexpr int NCT = LDU / 128;
    const int t = threadIdx.x, lane = t & 63, wid = t >> 6, wr = wid >> 1, wc = wid & 1;
    const int total = (NTOK / 128) * NCT;
    for (int L = bid; L < total; L += G) {
        const int xcd = L & 7, j = L >> 3, rt = 8 * (j / NCT) + xcd, ct = j % NCT;
        f32x4 acc[4][4];
        APlain ap{p.H + (size_t)rt * 128 * DM, DM};
        gemm_core<4, 64>(ap, p.win_t + (size_t)ct * 128 * DM, DM, DM, acc, lds);
        bf16_t* tile = (bf16_t*)lds;
#pragma unroll
        for (int i = 0; i < 4; ++i)
#pragma unroll
            for (int jj = 0; jj < 4; ++jj) {
                const int row = wr * 64 + i * 16 + (lane & 15), col = wc * 64 + jj * 16 + (lane >> 4) * 4;
                *(u32x2*)(tile + row * 136 + col) = mk2(pk2(acc[i][jj][0], acc[i][jj][1]), pk2(acc[i][jj][2], acc[i][jj][3]));
            }
        __syncthreads();
#pragma unroll
        for (int i = 0; i < 8; ++i) {
            const int c = t + 256 * i, row = c >> 4, chn = c & 15;
            *(u32x4*)(p.U + (size_t)(rt * 128 + row) * LDU + ct * 128 + chn * 8) = *(const u32x4*)(tile + row * 136 + chn * 8);
        }
    }
}

DI void unpack8(const u32x4 w, float (&f)[8]) { f[0] = lo2f(w.x); f[1] = hi2f(w.x); f[2] = lo2f(w.y); f[3] = hi2f(w.y); f[4] = lo2f(w.z); f[5] = hi2f(w.z); f[6] = lo2f(w.w); f[7] = hi2f(w.w); }
DI f32x4 unpack4(const u32x2 w) { return (f32x4){lo2f(w.x), hi2f(w.x), lo2f(w.y), hi2f(w.y)}; }
DI u32x2 pack4(const f32x4 v) { return mk2(pk2(v[0], v[1]), pk2(v[2], v[3])); }
DI f32x4 shifted4(const bf16_t* __restrict__ up, const bool has_prev, const f32x4 mu) {
    const f32x4 cur = unpack4(*(const u32x2*)up);
    f32x4 prev = (f32x4){0.f, 0.f, 0.f, 0.f};
    if (has_prev) prev = unpack4(*(const u32x2*)(up - LDU));
    return cur + (prev - cur) * mu;
}
DI void head96_finish(f32x4 (&v)[6], const int q, const float* __restrict__ gain, const float* __restrict__ ropeRow, const float scale, bf16_t* __restrict__ dstRow) {
    float ss = 0.f;
#pragma unroll
    for (int j = 0; j < 6; ++j) ss += v[j][0] * v[j][0] + v[j][1] * v[j][1] + v[j][2] * v[j][2] + v[j][3] * v[j][3];
    ss += __shfl_xor(ss, 16); ss += __shfl_xor(ss, 32);
    const float rs = rsqrtf(ss * (1.0f / 96.0f) + 1e-6f);
#pragma unroll
    for (int j = 0; j < 6; ++j) v[j] = v[j] * rs * *(const f32x4*)(gain + j * 16 + q * 4);
    const f32x4 cs = *(const f32x4*)(ropeRow + q * 4), sn = *(const f32x4*)(ropeRow + 16 + q * 4);
    const f32x4 x1 = v[4], x2 = v[5];
    v[4] = x1 * cs - x2 * sn; v[5] = x2 * cs + x1 * sn;
#pragma unroll
    for (int j = 0; j < 6; ++j) *(u32x2*)(dstRow + j * 16 + q * 4) = pack4(v[j] * scale);
}

DI void phase3(const Params& p, unsigned char* lds, int bid, int G) {
    const int t = threadIdx.x;
    float* rstd_q = (float*)(lds + 69632);
    float* rstd_kv = rstd_q + 128;
    bf16_t* lora = (bf16_t*)(p.bscr + (size_t)bid * BSCR_PER_BLOCK + 131072);
    for (int rt = bid; rt < NTOK / 128; rt += G) {
        __syncthreads();
        {
            int tl = t; LAUNDER(tl);
            const int row = tl >> 1, half = tl & 1, grow = rt * 128 + row;
            const bf16_t* urow = p.U + (size_t)grow * LDU;
            float s = 0.f;
#pragma unroll
            for (int c = 0; c < 16; ++c) { float f[8]; unpack8(*(const u32x4*)(urow + UQ + half * 128 + c * 8), f);
#pragma unroll
                for (int e = 0; e < 8; ++e) s += f[e] * f[e]; }
            s += __shfl_xor(s, 1);
            float s2 = 0.f;
#pragma unroll
            for (int c = 0; c < 8; ++c) { float f[8]; unpack8(*(const u32x4*)(urow + UKV + half * 64 + c * 8), f);
#pragma unroll
                for (int e = 0; e < 8; ++e) s2 += f[e] * f[e]; }
            s2 += __shfl_xor(s2, 1);
            if (half == 0) { rstd_q[row] = rsqrtf(s * (1.0f / 256.0f) + 1e-6f); rstd_kv[row] = rsqrtf(s2 * (1.0f / 128.0f) + 1e-6f); }
        }
#pragma unroll 1
        for (int i = 0; i < 10; ++i) {
            int tl = t; LAUNDER(tl);
            const int c = tl + 256 * i, row = c / 20, chn = c - row * 20, grow = rt * 128 + row;
            const bf16_t* up = p.U + (size_t)grow * LDU + UXW + chn * 8;
            float cur[8], prv[8];
            unpack8(*(const u32x4*)up, cur);
            if ((grow & 4095) > 0) unpack8(*(const u32x4*)(up - LDU), prv);
            else {
#pragma unroll
                for (int e = 0; e < 8; ++e) prv[e] = 0.f; }
            const f32x4 m0 = *(const f32x4*)(p.rwkv_mu + 1536 + chn * 8), m1 = *(const f32x4*)(p.rwkv_mu + 1536 + chn * 8 + 4);
            float o[8];
#pragma unroll
            for (int e = 0; e < 8; ++e) {
                const float x = cur[e] + (prv[e] - cur[e]) * (e < 4 ? m0[e & 3] : m1[e & 3]);
                o[e] = chn < 4 ? tanhf(x) : (chn < 8 ? x : sigmoidf_(x));
            }
            *(u32x4*)(lora + row * 160 + chn * 8) = mk4(pk2(o[0], o[1]), pk2(o[2], o[3]), pk2(o[4], o[5]), pk2(o[6], o[7]));
        }
        asm volatile("s_waitcnt vmcnt(0)" ::: "memory");
        __syncthreads();
        STAMP(17);
        {
            APlain ap{p.U + (size_t)rt * 128 * LDU + UQ, LDU};
            gemm_stream<2, 6, 4, 64, 6>(ap, p.wq_t, 256, 256, 8, [](int u, int& ao, int& bo) { ao = 0; bo = u * 96 * 256; },
                [&](const int h, f32x4 (&acc)[2][6]) {
                    int tl = t; LAUNDER(tl);
                    const int lane = tl & 63, w = tl >> 6, r = lane & 15, q = lane >> 4;
#pragma unroll
                    for (int i = 0; i < 2; ++i) {
                        const int row = 32 * w + 16 * i + r, grow = rt * 128 + row, b = grow >> 12, tt = grow & 4095;
                        const float rq = rstd_q[row];
                        f32x4 v[6];
#pragma unroll
                        for (int j = 0; j < 6; ++j) v[j] = acc[i][j] * rq;
                        head96_finish(v, q, p.q_norm, p.rope + (size_t)grow * 32, QSCALE, p.Q + ((size_t)(b * 8 + h) * NT_ + tt) * 96);
                    }
                }, lds);
        }
        STAMP(18);
        {
            APlain ap{p.U + (size_t)rt * 128 * LDU + UKV, LDU};
            gemm_stream<2, 8, 4, 64, 4>(ap, p.wkv_t, 128, 128, 8, [](int u, int& ao, int& bo) { ao = 0; bo = u * 128 * 128; },
                [&](const int h, f32x4 (&acc)[2][8]) {
                    int tl = t; LAUNDER(tl);
                    const int lane = tl & 63, w = tl >> 6, r = lane & 15, q = lane >> 4;
#pragma unroll
                    for (int i = 0; i < 2; ++i) {
                        const int row = 32 * w + 16 * i + r, grow = rt * 128 + row, b = grow >> 12, tt = grow & 4095;
                        const float rk = rstd_kv[row];
                        const bf16_t* urow = p.U + (size_t)grow * LDU;
                        f32x4 v[6];
#pragma unroll
                        for (int j = 0; j < 4; ++j) v[j] = acc[i][j] * rk;
                        v[4] = unpack4(*(const u32x2*)(urow + UPE + q * 4));
                        v[5] = unpack4(*(const u32x2*)(urow + UPE + 16 + q * 4));
                        head96_finish(v, q, p.k_norm, p.rope + (size_t)grow * 32, 1.0f, p.Kb + ((size_t)(b * 8 + h) * NT_ + tt) * 96);
                        const int tok0 = 32 * w + 16 * i + 4 * q;
                        const f32x4 rk4 = *(const f32x4*)(rstd_kv + tok0);
                        bf16_t* vd = p.Vt + ((size_t)((rt >> 5) * 8 + h) * 64) * NT_ + (rt & 31) * 128 + tok0;
#pragma unroll
                        for (int j = 4; j < 8; ++j) *(u32x2*)(vd + (size_t)((j - 4) * 16 + r) * NT_) = pack4(acc[i][j] * rk4);
                    }
                }, lds);
        }
        STAMP(19);
        bf16_t* abuf = (bf16_t*)(p.bscr + (size_t)bid * BSCR_PER_BLOCK);
        {
            APlain ap{lora, 160};
            gemm_stream<4, 4, 2, 32, 4>(ap, p.wdec_t, 32, 32, 4, [](int u, int& ao, int& bo) { ao = 0; bo = u * 128 * 32; },
                [&](const int ct, f32x4 (&acc)[4][4]) {
                    int tl = t; LAUNDER(tl);
                    const int lane = tl & 63, wid = tl >> 6, wr = wid >> 1, wc = wid & 1, r = lane & 15, q = lane >> 4, head = ct * 2 + wc;
#pragma unroll
                    for (int i = 0; i < 4; ++i) {
                        const int grow = rt * 128 + wr * 64 + i * 16 + r, b = grow >> 12, tt = grow & 4095;
                        bf16_t* sc = p.SC + ((size_t)(b * 8 + head) * NT_ + tt) * 384 + q * 4;
#pragma unroll
                        for (int j = 0; j < 4; ++j) {
                            const f32x4 w0 = *(const f32x4*)(p.decay_w0 + head * 64 + j * 16 + q * 4);
                            f32x4 o;
#pragma unroll
                            for (int e = 0; e < 4; ++e) o[e] = 1.0f - __expf(-0.6065306597f * sigmoidf_(w0[e] + acc[i][j][e]));
                            *(u32x2*)(sc + j * 16) = pack4(o);
                        }
                    }
                }, lds);
        }
        {
            APlain ap{lora + 32, 160};
            gemm_stream<4, 4, 2, 32, 4>(ap, p.wiclr_t, 32, 32, 4, [](int u, int& ao, int& bo) { ao = 0; bo = u * 128 * 32; },
                [&](const int ct, f32x4 (&acc)[4][4]) {
                    int tl = t; LAUNDER(tl);
                    const int lane = tl & 63, wid = tl >> 6, wr = wid >> 1, wc = wid & 1, r = lane & 15, q = lane >> 4, c0 = ct * 128 + wc * 64 + q * 4;
#pragma unroll
                    for (int i = 0; i < 4; ++i) {
                        bf16_t* ar = abuf + (wr * 64 + i * 16 + r) * 512 + c0;
#pragma unroll
                        for (int j = 0; j < 4; ++j) {
                            const f32x4 a0 = *(const f32x4*)(p.iclr_a0 + c0 + j * 16);
                            f32x4 o;
#pragma unroll
                            for (int e = 0; e < 4; ++e) o[e] = sigmoidf_(a0[e] + acc[i][j][e]);
                            *(u32x2*)(ar + j * 16) = pack4(o);
                        }
                    }
                }, lds);
        }
        {
            APlain ap{lora + 64, 160};
            gemm_stream<4, 4, 2, 32, 4>(ap, p.wgate_t, 96, 96, 4, [](int u, int& ao, int& bo) { ao = 0; bo = u * 128 * 96; },
                [&](const int ct, f32x4 (&acc)[4][4]) {
                    int tl = t; LAUNDER(tl);
                    const int lane = tl & 63, wid = tl >> 6, wr = wid >> 1, wc = wid & 1, r = lane & 15, q = lane >> 4, head = ct * 2 + wc;
#pragma unroll
                    for (int i = 0; i < 4; ++i) {
                        const int grow = rt * 128 + wr * 64 + i * 16 + r;
                        bf16_t* g = p.Gg + (size_t)grow * 512 + head * 64 + q * 4;
#pragma unroll
                        for (int j = 0; j < 4; ++j) *(u32x2*)(g + j * 16) = pack4(acc[i][j]);
                    }
                }, lds);
        }
        asm volatile("s_waitcnt vmcnt(0)" ::: "memory");
        __syncthreads();
#pragma unroll 1
        for (int it = 0; it < 16; ++it) {
            int tl = t; LAUNDER(tl);
            const int lane = tl & 63, w = tl >> 6, c8 = lane * 8;
#pragma unroll
            for (int u = 0; u < 2; ++u) {
                const int row = w + 4 * (it * 2 + u), grow = rt * 128 + row, b = grow >> 12, tt = grow & 4095;
                const bool hp = tt > 0;
                const bf16_t* urow = p.U + (size_t)grow * LDU + c8;
                float kc[8], kp_[8], vc[8], vp[8], rc[8], rp[8], av[8];
                unpack8(*(const u32x4*)(urow + UK), kc); unpack8(*(const u32x4*)(urow + UV), vc); unpack8(*(const u32x4*)(urow + UR), rc);
                unpack8(*(const u32x4*)(abuf + row * 512 + c8), av);
                if (hp) { unpack8(*(const u32x4*)(urow + UK - LDU), kp_); unpack8(*(const u32x4*)(urow + UV - LDU), vp); unpack8(*(const u32x4*)(urow + UR - LDU), rp); }
                else {
#pragma unroll
                    for (int e = 0; e < 8; ++e) { kp_[e] = 0.f; vp[e] = 0.f; rp[e] = 0.f; } }
                float mk[8], mv[8], mr[8], kkw[8], kaw[8];
                *(f32x4*)(mk) = *(const f32x4*)(p.rwkv_mu + 512 + c8); *(f32x4*)(mk + 4) = *(const f32x4*)(p.rwkv_mu + 512 + c8 + 4);
                *(f32x4*)(mv) = *(const f32x4*)(p.rwkv_mu + 1024 + c8); *(f32x4*)(mv + 4) = *(const f32x4*)(p.rwkv_mu + 1024 + c8 + 4);
                *(f32x4*)(mr) = *(const f32x4*)(p.rwkv_mu + c8); *(f32x4*)(mr + 4) = *(const f32x4*)(p.rwkv_mu + c8 + 4);
                *(f32x4*)(kkw) = *(const f32x4*)(p.k_k + c8); *(f32x4*)(kkw + 4) = *(const f32x4*)(p.k_k + c8 + 4);
                *(f32x4*)(kaw) = *(const f32x4*)(p.k_a + c8); *(f32x4*)(kaw + 4) = *(const f32x4*)(p.k_a + c8 + 4);
                float ks[8], kq[8], ssq = 0.f;
#pragma unroll
                for (int e = 0; e < 8; ++e) { ks[e] = kc[e] + (kp_[e] - kc[e]) * mk[e]; kq[e] = ks[e] * kkw[e]; ssq += kq[e] * kq[e]; }
                ssq = dpp_sum8(ssq);
                const float rn = rsqrtf(fmaxf(ssq, 1e-24f));
                float okk[8], obb[8], okp[8], ov[8], orr[8];
#pragma unroll
                for (int e = 0; e < 8; ++e) {
                    okk[e] = kq[e] * rn; obb[e] = av[e] * okk[e]; okp[e] = ks[e] * (1.0f + (av[e] - 1.0f) * kaw[e]);
                    ov[e] = vc[e] + (vp[e] - vc[e]) * mv[e]; orr[e] = rc[e] + (rp[e] - rc[e]) * mr[e];
                }
                bf16_t* sc = p.SC + ((size_t)(b * 8 + (lane >> 3)) * NT_ + tt) * 384 + (lane & 7) * 8;
                *(u32x4*)(sc + 64) = mk4(pk2(okk[0], okk[1]), pk2(okk[2], okk[3]), pk2(okk[4], okk[5]), pk2(okk[6], okk[7]));
                *(u32x4*)(sc + 128) = mk4(pk2(obb[0], obb[1]), pk2(obb[2], obb[3]), pk2(obb[4], obb[5]), pk2(obb[6], obb[7]));
                *(u32x4*)(sc + 192) = mk4(pk2(okp[0], okp[1]), pk2(okp[2], okp[3]), pk2(okp[4], okp[5]), pk2(okp[6], okp[7]));
                *(u32x4*)(sc + 256) = mk4(pk2(ov[0], ov[1]), pk2(ov[2], ov[3]), pk2(ov[4], ov[5]), pk2(ov[6], ov[7]));
                *(u32x4*)(sc + 320) = mk4(pk2(orr[0], orr[1]), pk2(orr[2], orr[3]), pk2(orr[4], orr[5]), pk2(orr[6], orr[7]));
            }
        }
    }
}

struct ScanOps { f32x2_t d[4], k[4], b[4], p[4], r[4]; float v; };
DI void scan_load(ScanOps& o, const float* __restrict__ q, const float* __restrict__ vp) {
    const f32x4 d0 = *(const f32x4*)(q), d1 = *(const f32x4*)(q + 4), k0 = *(const f32x4*)(q + 64), k1 = *(const f32x4*)(q + 68);
    const f32x4 b0 = *(const f32x4*)(q + 128), b1 = *(const f32x4*)(q + 132), p0 = *(const f32x4*)(q + 192), p1 = *(const f32x4*)(q + 196);
    const f32x4 r0 = *(const f32x4*)(q + 320), r1 = *(const f32x4*)(q + 324);
    o.d[0] = (f32x2_t){d0[0], d0[1]}; o.d[1] = (f32x2_t){d0[2], d0[3]}; o.d[2] = (f32x2_t){d1[0], d1[1]}; o.d[3] = (f32x2_t){d1[2], d1[3]};
    o.k[0] = (f32x2_t){k0[0], k0[1]}; o.k[1] = (f32x2_t){k0[2], k0[3]}; o.k[2] = (f32x2_t){k1[0], k1[1]}; o.k[3] = (f32x2_t){k1[2], k1[3]};
    o.b[0] = (f32x2_t){b0[0], b0[1]}; o.b[1] = (f32x2_t){b0[2], b0[3]}; o.b[2] = (f32x2_t){b1[0], b1[1]}; o.b[3] = (f32x2_t){b1[2], b1[3]};
    o.p[0] = (f32x2_t){p0[0], p0[1]}; o.p[1] = (f32x2_t){p0[2], p0[3]}; o.p[2] = (f32x2_t){p1[0], p1[1]}; o.p[3] = (f32x2_t){p1[2], p1[3]};
    o.r[0] = (f32x2_t){r0[0], r0[1]}; o.r[1] = (f32x2_t){r0[2], r0[3]}; o.r[2] = (f32x2_t){r1[0], r1[1]}; o.r[3] = (f32x2_t){r1[2], r1[3]};
    o.v = *vp;
}
DI void scan_task(const Params& p, unsigned char* lds, const int task) {
    constexpr int CS = 16;
    const int t = threadIdx.x, lane = t & 63, w = t >> 6;
    const int bh = task >> 1, hf = task & 1, b = bh >> 3, head = bh & 7;
    const int rloc = w * 8 + (lane >> 3), kseg = lane & 7;
    const int vrow = hf * 32 + rloc;
    float* stage = (float*)lds;
    float* ybuf = (float*)(lds + 49152);
    const bf16_t* src = p.SC + (size_t)bh * NT_ * 384;
    f32x2_t s2[4];
#pragma unroll
    for (int j = 0; j < 4; ++j) s2[j] = (f32x2_t){0.f, 0.f};
    u32x4 rg[3];
    __builtin_amdgcn_s_setprio(3);
    __syncthreads();
#pragma unroll
    for (int i = 0; i < 3; ++i) rg[i] = *(const u32x4*)(src + (size_t)(t + 256 * i) * 8);
#pragma unroll
    for (int i = 0; i < 3; ++i) { float* d = stage + (t + 256 * i) * 8;
        *(f32x4*)d = (f32x4){lo2f(rg[i].x), hi2f(rg[i].x), lo2f(rg[i].y), hi2f(rg[i].y)}; *(f32x4*)(d + 4) = (f32x4){lo2f(rg[i].z), hi2f(rg[i].z), lo2f(rg[i].w), hi2f(rg[i].w)}; }
    __syncthreads();
    constexpr int NCH = NT_ / CS;
    for (int c = 0; c < NCH; ++c) {
        const int cur = c & 1;
        if (c + 1 < NCH) {
#pragma unroll
            for (int i = 0; i < 3; ++i) rg[i] = *(const u32x4*)(src + (size_t)(c + 1) * CS * 384 + (size_t)(t + 256 * i) * 8);
        }
        if (c > 0) {
            const float* yb = ybuf + (cur ^ 1) * CS * 32;
            const int st = t >> 4, r2 = (t & 15) * 2;
            *(f32x2_t*)(p.yraw + ((size_t)(b * NT_ + (c - 1) * CS + st)) * 512 + head * 64 + hf * 32 + r2) = *(const f32x2_t*)(yb + st * 32 + r2);
        }
        const float* sb = stage + cur * CS * 384 + kseg * 8;
        float* yb = ybuf + cur * CS * 32;
        float yv[CS];
        ScanOps oc, on;
        scan_load(oc, sb, sb + 256 - kseg * 8 + vrow);
#pragma unroll
        for (int st = 0; st < CS; ++st) {
            if (st + 1 < CS) scan_load(on, sb + (st + 1) * 384, sb + (st + 1) * 384 + 256 - kseg * 8 + vrow);
            f32x2_t t0 = s2[0] * oc.k[0], t1 = s2[1] * oc.k[1];
            t0 = s2[2] * oc.k[2] + t0; t1 = s2[3] * oc.k[3] + t1;
            t0 = t0 + t1;
            float dot = dpp_sum8(t0.x + t0.y);
            const f32x2_t vv2 = {oc.v, oc.v}, nd2 = {-dot, -dot};
            f32x2_t u0, u1;
#pragma unroll
            for (int j = 0; j < 4; ++j) { f32x2_t tmp = s2[j] - s2[j] * oc.d[j]; tmp = vv2 * oc.p[j] + tmp; s2[j] = nd2 * oc.b[j] + tmp; }
            u0 = s2[0] * oc.r[0]; u1 = s2[1] * oc.r[1];
            u0 = s2[2] * oc.r[2] + u0; u1 = s2[3] * oc.r[3] + u1;
            u0 = u0 + u1;
            yv[st] = dpp_sum8(u0.x + u0.y);
            if (st + 1 < CS) oc = on;
        }
        if (kseg == 0) {
#pragma unroll
            for (int st = 0; st < CS; ++st) yb[st * 32 + rloc] = yv[st];
        }
        if (c + 1 < NCH) {
            float* dbase = stage + (cur ^ 1) * CS * 384;
#pragma unroll
            for (int i = 0; i < 3; ++i) { float* d = dbase + (t + 256 * i) * 8;
                *(f32x4*)d = (f32x4){lo2f(rg[i].x), hi2f(rg[i].x), lo2f(rg[i].y), hi2f(rg[i].y)}; *(f32x4*)(d + 4) = (f32x4){lo2f(rg[i].z), hi2f(rg[i].z), lo2f(rg[i].w), hi2f(rg[i].w)}; }
        }
        __syncthreads();
    }
    {
        const float* yb = ybuf + ((NCH - 1) & 1) * CS * 32;
        const int st = t >> 4, r2 = (t & 15) * 2;
        *(f32x2_t*)(p.yraw + ((size_t)(b * NT_ + (NCH - 1) * CS + st)) * 512 + head * 64 + hf * 32 + r2) = *(const f32x2_t*)(yb + st * 32 + r2);
    }
    __builtin_amdgcn_s_setprio(0);
}

DI void attn_item(const Params& p, unsigned char* lds, const int item) {
    constexpr int KROW = 208, VROW = 136, KB = 64 * KROW, BUF = KB + 64 * VROW;
    const int t = threadIdx.x, lane = t & 63, w = t >> 6, l31 = lane & 31, h = lane >> 5;
    const int qt = 31 - item / 128, bh = item % 128;
    const bf16_t* Kg = p.Kb + (size_t)bh * NT_ * 96;
    const bf16_t* Vg = p.Vt + (size_t)bh * 64 * NT_;
    const int q = qt * 128 + w * 32 + l31;
    bf16x8 qf[6];
    {
        const bf16_t* qrow = p.Q + ((size_t)bh * NT_ + q) * 96 + 8 * h;
#pragma unroll
        for (int s = 0; s < 6; ++s) qf[s] = *(const bf16x8*)(qrow + 16 * s);
    }
    f32x16 O[2];
#pragma unroll
    for (int i = 0; i < 16; ++i) { O[0][i] = 0.f; O[1][i] = 0.f; }
    float m = -INFINITY, l = 0.f;
    const int njt = 2 * qt + 2;
    int koff[3], kgo[3], voff[2], vgo[2];
#pragma unroll
    for (int i = 0; i < 3; ++i) { const int c = t + 256 * i, r = c / 12, ch = c - r * 12; koff[i] = r * KROW + ch * 16; kgo[i] = r * 96 + ch * 8; }
#pragma unroll
    for (int i = 0; i < 2; ++i) { const int c = t + 256 * i, dv = c >> 3, ch = c & 7; voff[i] = KB + dv * VROW + ch * 16; vgo[i] = dv * NT_ + ch * 8; }
    u32x4 rk0[3], rv0[2], rk1[3], rv1[2];
#define AT_LOAD(RK, RV, J) { _Pragma("unroll") for (int i = 0; i < 3; ++i) RK[i] = *(const u32x4*)(Kg + (size_t)(J) * 64 * 96 + kgo[i]); \
                             _Pragma("unroll") for (int i = 0; i < 2; ++i) RV[i] = *(const u32x4*)(Vg + (J) * 64 + vgo[i]); }
#define AT_WRITE(RK, RV, BUFI) { unsigned char* nb = lds + (BUFI) * BUF; _Pragma("unroll") for (int i = 0; i < 3; ++i) *(u32x4*)(nb + koff[i]) = RK[i]; \
                             _Pragma("unroll") for (int i = 0; i < 2; ++i) { *(u32x2*)(nb + voff[i]) = mk2(RV[i].x, RV[i].y); *(u32x2*)(nb + voff[i] + 8) = mk2(RV[i].z, RV[i].w); } }
    auto tile_compute = [&](const int cur, const int j) {
        const bool active = (j * 64) <= (qt * 128 + w * 32 + 31);
        if (active) {
            const unsigned char* Kt = lds + cur * BUF;
            const unsigned char* Vtile = Kt + KB;
            f32x16 S[2];
#pragma unroll
            for (int k2 = 0; k2 < 2; ++k2) {
#pragma unroll
                for (int i = 0; i < 16; ++i) S[k2][i] = 0.f;
#pragma unroll
                for (int s = 0; s < 6; ++s) {
                    const bf16x8 kf = *(const bf16x8*)(Kt + (k2 * 32 + l31) * KROW + s * 32 + h * 16);
                    S[k2] = __builtin_amdgcn_mfma_f32_32x32x16_bf16(kf, qf[s], S[k2], 0, 0, 0);
                }
            }
            if (j >= 2 * qt) {
#pragma unroll
                for (int k2 = 0; k2 < 2; ++k2)
#pragma unroll
                    for (int i = 0; i < 16; ++i) { const int key = j * 64 + k2 * 32 + (i & 3) + 8 * (i >> 2) + 4 * h; if (key > q) S[k2][i] = -INFINITY; }
            }
            float mx = S[0][0];
#pragma unroll
            for (int i = 1; i < 16; ++i) mx = fmaxf(mx, S[0][i]);
#pragma unroll
            for (int i = 0; i < 16; ++i) mx = fmaxf(mx, S[1][i]);
            mx = fmaxf(mx, __shfl_xor(mx, 32));
            if (__any(mx > m)) {
                const float mn = fmaxf(m, mx);
                const float alpha = __builtin_amdgcn_exp2f(m - mn);
                m = mn; l *= alpha;
#pragma unroll
                for (int i = 0; i < 16; ++i) { O[0][i] *= alpha; O[1][i] *= alpha; }
            }
            f32x2_t ps2 = {0.f, 0.f};
#pragma unroll
            for (int k2 = 0; k2 < 2; ++k2)
#pragma unroll
                for (int i = 0; i < 16; i += 2) {
                    const float e0 = __builtin_amdgcn_exp2f(S[k2][i] - m), e1 = __builtin_amdgcn_exp2f(S[k2][i + 1] - m);
                    S[k2][i] = e0; S[k2][i + 1] = e1; ps2 += (f32x2_t){e0, e1};
                }
            l += ps2.x + ps2.y;
#pragma unroll
            for (int k2 = 0; k2 < 2; ++k2)
#pragma unroll
                for (int s2 = 0; s2 < 2; ++s2) {
                    unsigned pw[4];
#pragma unroll
                    for (int e = 0; e < 4; ++e) pw[e] = pk2(S[k2][8 * s2 + 2 * e], S[k2][8 * s2 + 2 * e + 1]);
                    const bf16x8 pf = __builtin_bit_cast(bf16x8, mk4(pw[0], pw[1], pw[2], pw[3]));
#pragma unroll
                    for (int dt = 0; dt < 2; ++dt) {
                        const unsigned char* vp = Vtile + (dt * 32 + l31) * VROW + (k2 * 32 + s2 * 16 + 4 * h) * 2;
                        const u32x2 v0 = *(const u32x2*)(vp), v1 = *(const u32x2*)(vp + 16);
                        const bf16x8 vf = __builtin_bit_cast(bf16x8, mk4(v0.x, v0.y, v1.x, v1.y));
                        O[dt] = __builtin_amdgcn_mfma_f32_32x32x16_bf16(vf, pf, O[dt], 0, 0, 0);
                    }
                }
        }
    };
    AT_LOAD(rk0, rv0, 0)
    if (njt > 1) AT_LOAD(rk1, rv1, 1)
    __syncthreads();
    AT_WRITE(rk0, rv0, 0)
    if (njt > 2) AT_LOAD(rk0, rv0, 2)
    __syncthreads();
#pragma unroll 1
    for (int j = 0; j < njt; j += 2) {
        tile_compute(0, j);
        if (j + 1 < njt) { AT_WRITE(rk1, rv1, 1) if (j + 3 < njt) AT_LOAD(rk1, rv1, j + 3) }
        __syncthreads();
        if (j + 1 >= njt) break;
        tile_compute(1, j + 1);
        if (j + 2 < njt) { AT_WRITE(rk0, rv0, 0) if (j + 4 < njt) AT_LOAD(rk0, rv0, j + 4) }
        __syncthreads();
    }
#undef AT_LOAD
#undef AT_WRITE
    l += __shfl_xor(l, 32);
    const float inv = 1.0f / l;
    bf16_t* yrow = p.Y + ((size_t)((bh >> 3) * NT_ + q)) * DM + 512 + (bh & 7) * 64;
#pragma unroll
    for (int dt = 0; dt < 2; ++dt)
#pragma unroll
        for (int g = 0; g < 4; ++g)
            *(u32x2*)(yrow + dt * 32 + 8 * g + 4 * h) = mk2(pk2(O[dt][4 * g] * inv, O[dt][4 * g + 1] * inv), pk2(O[dt][4 * g + 2] * inv, O[dt][4 * g + 3] * inv));
}

constexpr int REC_BYTES = 12544;
typedef short s16x4 __attribute__((ext_vector_type(4)));
DI f32x4 mfma16(const s16x4 a, const s16x4 b, const f32x4 c) { return __builtin_amdgcn_mfma_f32_16x16x16bf16_1k(a, b, c, 0, 0, 0); }
DI s16x4 cvt4(const f32x4 v) { return __builtin_bit_cast(s16x4, mk2(pk2(v[0], v[1]), pk2(v[2], v[3]))); }
DI void scan_fused(const Params& p, unsigned char* lds, const int bh) {
    int t = threadIdx.x; LAUNDER(t);
    const int lane = t & 63, w = t >> 6, r = lane & 15, g = lane >> 4;
    const int b = bh >> 3, head = bh & 7;
    unsigned char* slot = lds + w * REC_BYTES;
    unsigned char* scr = lds + 4 * REC_BYTES + w * 5120;
    float* AT = (float*)(scr + 4096);
    const bf16_t* scbase = p.SC + (size_t)bh * NT_ * 384;
    f32x4 St[4];
#pragma unroll
    for (int m = 0; m < 4; ++m) St[m] = (f32x4){0.f, 0.f, 0.f, 0.f};
    u32x4 raw[12];
    {
        const u32x4* src = (const u32x4*)(scbase + (size_t)w * 16 * 384);
#pragma unroll
        for (int i = 0; i < 12; ++i) raw[i] = src[lane + 64 * i];
    }
    const int offk = (lane >> 4) * 512 + ((lane >> 2) & 3) * 128 + (lane & 3) * 2;
    const int offt = (lane >> 4) * 512 + (lane & 15) * 8;
    __syncthreads();
#pragma unroll 1
    for (int rd = 0; rd < 64; ++rd) {
#pragma unroll
        for (int i = 0; i < 12; ++i) *(u32x4*)(slot + (lane + 64 * i) * 16) = raw[i];
        if (rd + 1 < 64) {
            const u32x4* src = (const u32x4*)(scbase + (size_t)(4 * (rd + 1) + w) * 16 * 384);
#pragma unroll
            for (int i = 0; i < 12; ++i) raw[i] = src[lane + 64 * i];
        }
        {
            const bf16_t* rawl = (const bf16_t*)slot + lane;
            bf16_t vkap[16], vbet[16], vkt[16], vrt[16], vv[16];
            float L = 0.f;
#pragma unroll
            for (int j = 0; j < 16; ++j) {
                const float d = bf2f(rawl[j * 384]), kap = bf2f(rawl[j * 384 + 64]), bet = bf2f(rawl[j * 384 + 128]), kk = bf2f(rawl[j * 384 + 192]), rr = bf2f(rawl[j * 384 + 320]);
                vv[j] = rawl[j * 384 + 256];
                const float ex = __expf(L);
                L += __logf(1.0f - d);
                const float el = __expf(L), ei = __expf(-L);
                vkap[j] = f2bf(kap * ex); vbet[j] = f2bf(bet * ei); vkt[j] = f2bf(kk * ei); vrt[j] = f2bf(rr * el);
            }
            const float gam = __expf(L);
#pragma unroll
            for (int j = 0; j < 16; ++j) {
                *(bf16_t*)(slot + offk + j * 8) = vkap[j];
                *(bf16_t*)(slot + 2048 + offk + j * 8) = vrt[j];
                *(bf16_t*)(slot + 4096 + offt + (j >> 2) * 128 + (j & 3) * 2) = vkt[j];
                *(bf16_t*)(slot + 6144 + offt + (j >> 2) * 128 + (j & 3) * 2) = (bf16_t)(vbet[j] ^ 0x8000u);
                *(bf16_t*)(scr + offk + j * 8) = vkt[j];
                *(bf16_t*)(scr + 2048 + offk + j * 8) = vbet[j];
            }
            unsigned vw[8];
#pragma unroll
            for (int i = 0; i < 8; ++i) vw[i] = (unsigned)vv[2 * i] | ((unsigned)vv[2 * i + 1] << 16);
            *(u32x4*)(slot + 10240 + lane * 32) = mk4(vw[0], vw[1], vw[2], vw[3]);
            *(u32x4*)(slot + 10240 + lane * 32 + 16) = mk4(vw[4], vw[5], vw[6], vw[7]);
            *(float*)(slot + 12288 + lane * 4) = gam;
        }
        {
            f32x4 dB = {0.f, 0.f, 0.f, 0.f}, dE = dB, dF = dB, dA = dB;
#pragma unroll
            for (int m = 0; m < 4; ++m) {
                const s16x4 fk = *(const s16x4*)(slot + m * 512 + lane * 8), fr = *(const s16x4*)(slot + 2048 + m * 512 + lane * 8);
                const s16x4 ft = *(const s16x4*)(scr + m * 512 + lane * 8), fb = *(const s16x4*)(scr + 2048 + m * 512 + lane * 8);
                dB = mfma16(ft, fk, dB); dE = mfma16(ft, fr, dE); dF = mfma16(fb, fr, dF); dA = mfma16(fb, fk, dA);
            }
            f32x4 oB, oE, oF;
#pragma unroll
            for (int jj = 0; jj < 4; ++jj) {
                const int i = 4 * g + jj;
                oB[jj] = i < r ? dB[jj] : 0.f; oE[jj] = i <= r ? dE[jj] : 0.f; oF[jj] = i <= r ? -dF[jj] : 0.f;
                AT[i * 16 + r] = i < r ? dA[jj] : 0.f;
            }
            *(s16x4*)(slot + 16 * 512 + lane * 8) = cvt4(oB);
            *(s16x4*)(slot + 18 * 512 + lane * 8) = cvt4(oE);
            *(s16x4*)(slot + 19 * 512 + lane * 8) = cvt4(oF);
            float T[16];
#pragma unroll
            for (int i = 15; i >= 0; --i) {
                float a = (i == r) ? 1.f : 0.f;
#pragma unroll
                for (int m = i + 1; m < 16; ++m) a -= AT[i * 16 + m] * T[m];
                T[i] = (i <= r) ? a : 0.f;
            }
            f32x4 oT;
#pragma unroll
            for (int jj = 0; jj < 4; ++jj) oT[jj] = g == 0 ? T[jj] : (g == 1 ? T[4 + jj] : (g == 2 ? T[8 + jj] : T[12 + jj]));
            *(s16x4*)(slot + 17 * 512 + lane * 8) = cvt4(oT);
        }
        __syncthreads();
#pragma unroll 1
        for (int cc = 0; cc < 4; ++cc) {
            const unsigned char* buf = lds + cc * REC_BYTES;
            s16x4 fr[20];
#pragma unroll
            for (int f = 0; f < 20; ++f) fr[f] = *(const s16x4*)(buf + f * 512 + lane * 8);
            const s16x4 vf = *(const s16x4*)(buf + 10240 + (16 * w + r) * 32 + g * 8);
            s16x4 sb[4];
#pragma unroll
            for (int m = 0; m < 4; ++m) sb[m] = cvt4(St[m]);
            f32x4 X = {0.f, 0.f, 0.f, 0.f}, Yv = X;
#pragma unroll
            for (int m = 0; m < 4; ++m) { X = mfma16(fr[m], sb[m], X); Yv = mfma16(fr[4 + m], sb[m], Yv); }
            X = mfma16(fr[16], vf, X); Yv = mfma16(fr[18], vf, Yv);
            const s16x4 xb = cvt4(X);
            const f32x4 P = mfma16(fr[17], xb, (f32x4){0.f, 0.f, 0.f, 0.f});
            const s16x4 pb = cvt4(P);
            Yv = mfma16(fr[19], pb, Yv);
#pragma unroll
            for (int m = 0; m < 4; ++m) {
                St[m] = mfma16(fr[8 + m], vf, St[m]);
                St[m] = mfma16(fr[12 + m], pb, St[m]);
                St[m] = St[m] * *(const f32x4*)(buf + 12288 + (16 * m + 4 * g) * 4);
            }
            float* yo = p.yraw + ((size_t)(b * NT_ + (4 * rd + cc) * 16 + 4 * g)) * 512 + head * 64 + 16 * w + r;
#pragma unroll
            for (int jj = 0; jj < 4; ++jj) yo[jj * 512] = Yv[jj];
        }
        __syncthreads();
    }
}

DI void phase4(const Params& p, unsigned char* lds, int bid, int G) {
    int* sh_item = (int*)(lds + LDS_BYTES - 64);
#if SCAN_CHUNKED
    for (int bh = bid; bh < 128; bh += G) scan_fused(p, lds, bh);
#else
    for (int task = bid; task < 256; task += G) scan_task(p, lds, task);
#endif
    STAMP(10);
    for (;;) {
        __syncthreads();
        if (threadIdx.x == 0) *sh_item = (int)atomicAdd(&p.ctrl[CTRL_ATTNQ], 1u);
        __syncthreads();
        const int item = *sh_item;
        if (item >= 4096) break;
        attn_item(p, lds, item);
    }
}

DI void phase5(const Params& p, unsigned char* lds, int bid, int G) {
    const int t = threadIdx.x, lane = t & 63, wid = t >> 6, wr = wid >> 1, wc = wid & 1;
    float* tile = (float*)lds;
    float* ssq = (float*)(lds + 69632);
    float* biasl = ssq + 128;
    int* lcnt = (int*)(lds + 65536);
    int* lbase = lcnt + 256;
    unsigned char* le = (unsigned char*)(lbase + 256);
    unsigned char* lp = le + 1024;
    __syncthreads();
    biasl[t] = p.router_bias[t];
    float* scores = (float*)(p.bscr + (size_t)bid * BSCR_PER_BLOCK);
    bf16_t* act = (bf16_t*)(p.bscr + (size_t)bid * BSCR_PER_BLOCK + 131072);
    for (int rt = bid; rt < NTOK / 128; rt += G) {
        const int b = rt >> 5;
        const float* mod = p.mod + b * 6144;
        __syncthreads();
        if (t < 128) ssq[t] = 0.f;
        lcnt[t] = 0;
#pragma unroll 2
        for (int it = 0; it < 16; ++it) {
            int tl = t; LAUNDER(tl);
            const int pr = (tl >> 2) + 64 * it;
            const int row = pr >> 3, head = pr & 7, part = tl & 3, grow = rt * 128 + row, tt = grow & 4095;
            const int ch = head * 64 + part * 16;
            const float* yr = p.yraw + (size_t)grow * 512 + ch;
            float y[16];
#pragma unroll
            for (int i = 0; i < 4; ++i) { const f32x4 v = *(const f32x4*)(yr + 4 * i); y[4 * i] = v[0]; y[4 * i + 1] = v[1]; y[4 * i + 2] = v[2]; y[4 * i + 3] = v[3]; }
            float sm = 0.f;
#pragma unroll
            for (int i = 0; i < 16; ++i) sm += y[i];
            sm += __shfl_xor(sm, 1); sm += __shfl_xor(sm, 2);
            const float mean = sm * (1.0f / 64.0f);
            float vr = 0.f;
#pragma unroll
            for (int i = 0; i < 16; ++i) { const float d = y[i] - mean; vr += d * d; }
            vr += __shfl_xor(vr, 1); vr += __shfl_xor(vr, 2);
            const float rs = rsqrtf(vr * (1.0f / 64.0f) + 64e-5f);
            const bf16_t* sc = p.SC + ((size_t)(b * 8 + head) * NT_ + tt) * 384 + part * 16;
            float kp[16], vv[16], rr[16];
#pragma unroll
            for (int i = 0; i < 2; ++i) {
                const u32x4 a = *(const u32x4*)(sc + 192 + 8 * i), c = *(const u32x4*)(sc + 256 + 8 * i), d = *(const u32x4*)(sc + 320 + 8 * i);
                kp[8 * i] = lo2f(a.x); kp[8 * i + 1] = hi2f(a.x); kp[8 * i + 2] = lo2f(a.y); kp[8 * i + 3] = hi2f(a.y); kp[8 * i + 4] = lo2f(a.z); kp[8 * i + 5] = hi2f(a.z); kp[8 * i + 6] = lo2f(a.w); kp[8 * i + 7] = hi2f(a.w);
                vv[8 * i] = lo2f(c.x); vv[8 * i + 1] = hi2f(c.x); vv[8 * i + 2] = lo2f(c.y); vv[8 * i + 3] = hi2f(c.y); vv[8 * i + 4] = lo2f(c.z); vv[8 * i + 5] = hi2f(c.z); vv[8 * i + 6] = lo2f(c.w); vv[8 * i + 7] = hi2f(c.w);
                rr[8 * i] = lo2f(d.x); rr[8 * i + 1] = hi2f(d.x); rr[8 * i + 2] = lo2f(d.y); rr[8 * i + 3] = hi2f(d.y); rr[8 * i + 4] = lo2f(d.z); rr[8 * i + 5] = hi2f(d.z); rr[8 * i + 6] = lo2f(d.w); rr[8 * i + 7] = hi2f(d.w);
            }
            float bn = 0.f;
#pragma unroll
            for (int i = 0; i < 16; ++i) bn += rr[i] * kp[i] * p.r_k[ch + i];
            bn += __shfl_xor(bn, 1); bn += __shfl_xor(bn, 2);
            const bf16_t* gg = p.Gg + (size_t)grow * 512 + ch;
            const u32x4 g0 = *(const u32x4*)(gg), g1 = *(const u32x4*)(gg + 8);
            float g[16] = {lo2f(g0.x), hi2f(g0.x), lo2f(g0.y), hi2f(g0.y), lo2f(g0.z), hi2f(g0.z), lo2f(g0.w), hi2f(g0.w), lo2f(g1.x), hi2f(g1.x), lo2f(g1.y), hi2f(g1.y), lo2f(g1.z), hi2f(g1.z), lo2f(g1.w), hi2f(g1.w)};
            float o[16];
#pragma unroll
            for (int i = 0; i < 16; ++i) o[i] = ((y[i] - mean) * rs * p.ln_w[ch + i] + p.ln_b[ch + i] + bn * vv[i]) * g[i];
            bf16_t* yd = p.Y + (size_t)grow * DM + ch;
            *(u32x4*)(yd) = mk4(pk2(o[0], o[1]), pk2(o[2], o[3]), pk2(o[4], o[5]), pk2(o[6], o[7]));
            *(u32x4*)(yd + 8) = mk4(pk2(o[8], o[9]), pk2(o[10], o[11]), pk2(o[12], o[13]), pk2(o[14], o[15]));
        }
        asm volatile("s_waitcnt vmcnt(0)" ::: "memory");
        __syncthreads();
        STAMP(11);
        {
            APlain ap{p.Y + (size_t)rt * 128 * DM, DM};
            gemm_stream<4, 4, 2, 64, 4>(ap, p.wout_t, DM, DM, 8, [](int u, int& ao, int& bo) { ao = 0; bo = u * 128 * DM; },
                [&](const int ct, f32x4 (&acc)[4][4]) {
                    int ll = lane; LAUNDER(ll);
#pragma unroll
                    for (int i = 0; i < 4; ++i) {
                        const int row = wr * 64 + i * 16 + (ll & 15), grow = rt * 128 + row;
                        float sq = 0.f;
#pragma unroll
                        for (int j = 0; j < 4; ++j) {
                            const int col = ct * 128 + wc * 64 + j * 16 + (ll >> 4) * 4;
                            const f32x4 xv = *(const f32x4*)(p.x + (size_t)grow * DM + col), ga = *(const f32x4*)(mod + 2048 + col);
                            f32x4 o;
#pragma unroll
                            for (int e = 0; e < 4; ++e) { o[e] = xv[e] + ga[e] * acc[i][j][e]; sq += o[e] * o[e]; }
                            *(f32x4*)(p.out + (size_t)grow * DM + col) = o;
                        }
                        sq += __shfl_xor(sq, 16); sq += __shfl_xor(sq, 32);
                        if ((ll >> 4) == 0) atomicAdd(&ssq[row], sq);
                    }
                }, lds);
        }
        asm volatile("s_waitcnt vmcnt(0)" ::: "memory");
        __syncthreads();
        STAMP(12);
#pragma unroll 1
        for (int mg = 0; mg < 8; ++mg) {
            int ll = lane; LAUNDER(ll);
            f32x4 xv[4][4];
#pragma unroll
            for (int u = 0; u < 4; ++u)
#pragma unroll
                for (int i = 0; i < 4; ++i) xv[u][i] = *(const f32x4*)(p.out + (size_t)(rt * 128 + wid + 4 * (mg * 4 + u)) * DM + ll * 4 + 256 * i);
#pragma unroll
            for (int u = 0; u < 4; ++u) {
                const int r = wid + 4 * (mg * 4 + u), grow = rt * 128 + r;
                const float rs = rsqrtf(ssq[r] * (1.0f / DM) + 1e-6f);
#pragma unroll
                for (int i = 0; i < 4; ++i) {
                    const int c = ll * 4 + 256 * i;
                    const f32x4 g = *(const f32x4*)(p.norm_ffn + c), sh = *(const f32x4*)(mod + 3072 + c), sc = *(const f32x4*)(mod + 4096 + c);
                    float o[4];
#pragma unroll
                    for (int e = 0; e < 4; ++e) o[e] = xv[u][i][e] * rs * g[e] * (1.0f + sc[e]) + sh[e];
                    *(u32x2*)(p.H + (size_t)grow * DM + c) = mk2(pk2(o[0], o[1]), pk2(o[2], o[3]));
                }
            }
        }
        asm volatile("s_waitcnt vmcnt(0)" ::: "memory");
        __syncthreads();
        STAMP(13);
        {
            APlain ap{p.H + (size_t)rt * 128 * DM, DM};
            gemm_stream<4, 4, 2, 64, 4>(ap, p.wr_t, DM, DM, 2, [](int u, int& ao, int& bo) { ao = 0; bo = u * 128 * DM; },
                [&](const int ct, f32x4 (&acc)[4][4]) {
                    int ll = lane; LAUNDER(ll);
#pragma unroll
                    for (int i = 0; i < 4; ++i)
#pragma unroll
                        for (int j = 0; j < 4; ++j) {
                            const int row = wr * 64 + i * 16 + (ll & 15), col = ct * 128 + wc * 64 + j * 16 + (ll >> 4) * 4;
#pragma unroll
                            for (int e = 0; e < 4; ++e) scores[(col + e) * 128 + row] = sigmoidf_(acc[i][j][e]);
                        }
                }, lds);
        }
        asm volatile("s_waitcnt vmcnt(0)" ::: "memory");
        __syncthreads();
        STAMP(14);
#pragma unroll 1
        for (int hh = 0; hh < 2; ++hh) {
            __syncthreads();
            {
                int tl = t; LAUNDER(tl);
                f32x4 rgs[16];
#pragma unroll
                for (int i = 0; i < 16; ++i) { const int c = tl + 256 * i; rgs[i] = *(const f32x4*)(scores + (c >> 4) * 128 + hh * 64 + (c & 15) * 4); }
#pragma unroll
                for (int i = 0; i < 16; ++i) *(f32x4*)(tile + (tl + 256 * i) * 4) = rgs[i];
            }
            __syncthreads();
            if (t < 64) {
                int tl = t; LAUNDER(tl);
                const int token = rt * 128 + hh * 64 + tl;
                const float* sc = tile + tl;
                float gs[8];
#pragma unroll
                for (int g = 0; g < 8; ++g) {
                    float m1 = -INFINITY, m2 = -INFINITY;
#pragma unroll 8
                    for (int i = 0; i < 32; ++i) { const float v = sc[(g * 32 + i) * 64] + biasl[g * 32 + i]; m2 = fmaxf(m2, fminf(m1, v)); m1 = fmaxf(m1, v); }
                    gs[g] = m1 + m2;
                }
                unsigned selmask = 0u;
#pragma unroll
                for (int g = 0; g < 8; ++g) {
                    int rank = 0;
#pragma unroll
                    for (int g2 = 0; g2 < 8; ++g2) rank += (gs[g2] > gs[g] || (gs[g2] == gs[g] && g2 < g)) ? 1 : 0;
                    selmask |= (rank < 4 ? 1u : 0u) << g;
                }
                float tv[8]; int ti[8];
#pragma unroll
                for (int k = 0; k < 8; ++k) { tv[k] = -INFINITY; ti[k] = 0; }
#pragma unroll 1
                for (int g = 0; g < 8; ++g) {
                    if ((selmask >> g) & 1u) {
#pragma unroll 4
                        for (int i = 0; i < 32; ++i) {
                            const int e = g * 32 + i;
                            const float v = sc[e * 64] + biasl[e];
                            if (v > tv[7]) {
#pragma unroll
                                for (int k = 7; k >= 1; --k) {
                                    if (v > tv[k - 1]) { tv[k] = tv[k - 1]; ti[k] = ti[k - 1]; }
                                    else if (v > tv[k]) { tv[k] = v; ti[k] = e; }
                                }
                                if (v > tv[0]) { tv[0] = v; ti[0] = e; }
                            }
                        }
                    }
                }
                float ws[8], wsum = 0.f;
#pragma unroll
                for (int k = 0; k < 8; ++k) { ws[k] = sc[ti[k] * 64]; wsum += ws[k]; }
                const float sc25 = 2.5f / wsum;
#pragma unroll
                for (int k = 0; k < 8; ++k) {
                    p.topk_idx[token * 8 + k] = ti[k];
                    p.topk_w[token * 8 + k] = ws[k] * sc25;
                    le[(hh * 64 + tl) * 8 + k] = (unsigned char)ti[k];
                    lp[(hh * 64 + tl) * 8 + k] = (unsigned char)atomicAdd(&lcnt[ti[k]], 1);
                }
            }
        }
        __syncthreads();
        { const int c = lcnt[t]; lbase[t] = c > 0 ? (int)atomicAdd(&p.ctrl[CTRL_ECNT + t * ECNT_STRIDE], (unsigned)c) : 0; }
        __syncthreads();
#pragma unroll
        for (int i = 0; i < 4; ++i) {
            const int a = t + 256 * i, e = le[a];
            p.elist[(size_t)e * NTOK + lbase[e] + lp[a]] = (rt * 128) * 8 + a;
        }
        STAMP(15);
        {
            APlain ap{p.H + (size_t)rt * 128 * DM, DM};
            gemm_stream<4, 4, 2, 64, 4>(ap, p.wsgu_t, DM, DM, 4, [](int u, int& ao, int& bo) { ao = 0; bo = u * 128 * DM; },
                [&](const int ct, f32x4 (&acc)[4][4]) {
                    int ll = lane; LAUNDER(ll);
#pragma unroll
                    for (int i = 0; i < 4; ++i) {
                        bf16_t* d = act + (wr * 64 + i * 16 + (ll & 15)) * 256 + ct * 64 + wc * 32 + (ll >> 4) * 4;
#pragma unroll
                        for (int m = 0; m < 2; ++m) {
                            f32x4 o;
#pragma unroll
                            for (int e = 0; e < 4; ++e) { const float g = acc[i][2 * m][e]; o[e] = g * sigmoidf_(g) * acc[i][2 * m + 1][e]; }
                            *(u32x2*)(d + m * 16) = pack4(o);
                        }
                    }
                }, lds);
        }
        asm volatile("s_waitcnt vmcnt(0)" ::: "memory");
        __syncthreads();
        STAMP(16);
        {
            APlain ap{act, 256};
            gemm_stream<4, 4, 2, 64, 4>(ap, p.wsd_t, 256, 256, 8, [](int u, int& ao, int& bo) { ao = 0; bo = u * 128 * 256; },
                [&](const int ct, f32x4 (&acc)[4][4]) {
                    int ll = lane; LAUNDER(ll);
#pragma unroll
                    for (int i = 0; i < 4; ++i)
#pragma unroll
                        for (int j = 0; j < 4; ++j) {
                            const int row = wr * 64 + i * 16 + (ll & 15), grow = rt * 128 + row, col = ct * 128 + wc * 64 + j * 16 + (ll >> 4) * 4;
                            const f32x4 xv = *(const f32x4*)(p.out + (size_t)grow * DM + col), gf = *(const f32x4*)(mod + 5120 + col);
                            f32x4 o;
#pragma unroll
                            for (int e = 0; e < 4; ++e) o[e] = xv[e] + gf[e] * acc[i][j][e];
                            *(f32x4*)(p.out + (size_t)grow * DM + col) = o;
                        }
                }, lds);
        }
    }
}

DI void phase6(const Params& p, unsigned char* lds, int bid, int G) {
    const int t = threadIdx.x, lane = t & 63, wid = t >> 6, wr = wid >> 1, wc = wid & 1;
    float* tile = (float*)lds;
    int* cpre = (int*)(lds + 69632);
    int* rowtok = (int*)(lds + 69632 + 1056);
    int* rowslot = rowtok + 128;
    float* roww = (float*)(rowslot + 128);
    int* sh_it = (int*)(roww + 128);
    bf16_t* act = (bf16_t*)(p.bscr + (size_t)bid * BSCR_PER_BLOCK + 131072);
    (void)G;
    __syncthreads();
    rowtok[t] = ((int)p.ctrl[CTRL_ECNT + t * ECNT_STRIDE] + 127) >> 7;
    __syncthreads();
    if (t < 8) { int sacc = 0; for (int k = 0; k < 32; ++k) { cpre[t * 33 + k] = sacc; sacc += rowtok[8 * k + t]; } cpre[t * 33 + 32] = sacc; }
    __syncthreads();
    const int hq = (int)(xb_xcc_id() & 7u);
    int attempt = 0;
    for (;;) {
        const int qc = (hq + attempt) & 7;
        __syncthreads();
        if (t == 0) sh_it[0] = (int)atomicAdd(&p.ctrl[CTRL_Q6 + qc * 64], 1u);
        __syncthreads();
        const int idx = sh_it[0];
        if (idx >= cpre[qc * 33 + 32]) { if (++attempt >= 8) break; continue; }
        int lo = 0, hi = 31;
        while (lo < hi) { const int mid = (lo + hi + 1) >> 1; if (cpre[qc * 33 + mid] <= idx) lo = mid; else hi = mid - 1; }
        const int e = 8 * lo + qc, tl = idx - cpre[qc * 33 + lo], cnt = (int)p.ctrl[CTRL_ECNT + e * ECNT_STRIDE];
        __syncthreads();
        if (t < 128) {
            const int r = tl * 128 + t;
            if (r < cnt) { const int ts = p.elist[(size_t)e * NTOK + r]; rowtok[t] = ts >> 3; rowslot[t] = ts; roww[t] = p.topk_w[ts]; }
            else { rowtok[t] = 0; rowslot[t] = -1; roww[t] = 0.f; }
        }
        __syncthreads();
        {
            AGather ap{p.H, rowtok};
            gemm_stream<4, 8, 2, 32, 8>(ap, p.wegu_t + (size_t)e * 512 * DM, DM, DM, 2, [](int u, int& ao, int& bo) { ao = 0; bo = u * 256 * DM; },
                [&](const int ct, f32x4 (&acc)[4][8]) {
                    int ll = lane; LAUNDER(ll);
#pragma unroll
                    for (int i = 0; i < 4; ++i) {
                        bf16_t* d = act + (wr * 64 + i * 16 + (ll & 15)) * 256 + ct * 128 + wc * 64 + (ll >> 4) * 4;
#pragma unroll
                        for (int m = 0; m < 4; ++m) {
                            f32x4 o;
#pragma unroll
                            for (int ee = 0; ee < 4; ++ee) { const float g = acc[i][2 * m][ee]; o[ee] = g * sigmoidf_(g) * acc[i][2 * m + 1][ee]; }
                            *(u32x2*)(d + m * 16) = pack4(o);
                        }
                    }
                }, lds);
        }
        asm volatile("s_waitcnt vmcnt(0)" ::: "memory");
        __syncthreads();
        {
            APlain ap{act, 256};
            gemm_stream<4, 4, 2, 64, 4>(ap, p.wed_t + (size_t)e * 1024 * 256, 256, 256, 8, [](int u, int& ao, int& bo) { ao = 0; bo = u * 128 * 256; },
                [&](const int ct, f32x4 (&acc)[4][4]) {
                    int ll = lane; LAUNDER(ll);
#pragma unroll
                    for (int i = 0; i < 4; ++i) {
                        const int row = wr * 64 + i * 16 + (ll & 15), srow = rowslot[row];
                        const float ww = roww[row];
                        if (srow >= 0) {
#pragma unroll
                            for (int j = 0; j < 4; ++j) {
                                const int col = ct * 128 + wc * 64 + j * 16 + (ll >> 4) * 4;
                                *(u32x2*)(p.slot + (size_t)srow * DM + col) = pack4(acc[i][j] * ww);
                            }
                        }
                    }
                }, lds);
        }
    }
}

DI void phase7(const Params& p, int bid, int G) {
    const int lane = threadIdx.x & 63, gw = bid * 4 + (threadIdx.x >> 6), nw = G * 4;
    for (int row = gw; row < NTOK; row += nw) {
        const float* mod = p.mod + (row >> 12) * 6144 + 5120;
#pragma unroll
        for (int i = 0; i < 4; ++i) {
            const int c = lane * 4 + 256 * i;
            float s[4] = {0.f, 0.f, 0.f, 0.f};
#pragma unroll
            for (int k = 0; k < 8; ++k) { const u32x2 w = *(const u32x2*)(p.slot + ((size_t)row * 8 + k) * DM + c); s[0] += lo2f(w.x); s[1] += hi2f(w.x); s[2] += lo2f(w.y); s[3] += hi2f(w.y); }
            const f32x4 gf = *(const f32x4*)(mod + c);
            f32x4 o = *(const f32x4*)(p.out + (size_t)row * DM + c);
#pragma unroll
            for (int e = 0; e < 4; ++e) o[e] += gf[e] * s[e];
            *(f32x4*)(p.out + (size_t)row * DM + c) = o;
        }
    }
}

extern __shared__ __attribute__((aligned(16))) unsigned char smem[];

template <int PH> DI void run_phase(const Params& p, unsigned char* lds, int bid, int G) {
    if (PH == 0) phase0(p, lds, bid, G);
    if (PH == 1) phase1(p, bid, G);
    if (PH == 2) phase2(p, lds, bid, G);
    if (PH == 3) phase3(p, lds, bid, G);
    if (PH == 4) phase4(p, lds, bid, G);
    if (PH == 5) phase5(p, lds, bid, G);
    if (PH == 6) phase6(p, lds, bid, G);
    if (PH == 7) phase7(p, bid, G);
}

#if !ONE_LAUNCH
template <int PH> __global__ void __launch_bounds__(256, 2) phase_kernel(Params p) { run_phase<PH>(p, smem, blockIdx.x, gridDim.x); }
#endif

#if ONE_LAUNCH
__global__ void __launch_bounds__(256, 2) mega_kernel(Params p) {
    volatile LAS unsigned* st = (volatile LAS unsigned*)(smem + LDS_BYTES - 16);
    if (threadIdx.x == 0) { st[0] = 0u; st[1] = 0u; st[2] = 0u; st[3] = 0u; }
    __syncthreads();
    XcdBarrier bar = xcd_barrier_post(p.ctrl, st);
    const int bid = blockIdx.x, G = gridDim.x;
    STAMP(0);
    run_phase<0>(p, smem, bid, G); xcd_barrier(bar); STAMP(1);
    run_phase<1>(p, smem, bid, G); xcd_barrier(bar); STAMP(2);
    run_phase<2>(p, smem, bid, G); xcd_barrier(bar); STAMP(3);
    run_phase<3>(p, smem, bid, G); xcd_barrier(bar); STAMP(4);
    run_phase<4>(p, smem, bid, G); xcd_barrier(bar); STAMP(5);
    run_phase<5>(p, smem, bid, G); xcd_barrier(bar); STAMP(6);
    run_phase<6>(p, smem, bid, G); xcd_barrier(bar); STAMP(7);
    run_phase<7>(p, smem, bid, G);
#ifdef PROBE_A
    xcd_barrier(bar); STAMP(8);
    xcd_barrier(bar);
    {
        const unsigned long long* sp = (const unsigned long long*)(p.ctrl + CTRL_STAMP);
        const unsigned long long ta = __hip_atomic_load(sp + PROBE_A, __ATOMIC_RELAXED, __HIP_MEMORY_SCOPE_AGENT), tb = __hip_atomic_load(sp + PROBE_B, __ATOMIC_RELAXED, __HIP_MEMORY_SCOPE_AGENT);
        const unsigned long long t0 = __builtin_amdgcn_s_memrealtime();
        while (__builtin_amdgcn_s_memrealtime() - t0 < tb - ta) __builtin_amdgcn_s_sleep(8);
    }
#endif
}
#define OCC_KERNEL mega_kernel
#else
#define OCC_KERNEL phase_kernel<5>
#endif

static inline size_t al256(size_t x) { return (x + 255) & ~(size_t)255; }

extern "C" void kernel_launch(void* const* d_in, const int* in_sizes, int n_in, void* d_out, int out_size, void* d_ws, size_t ws_size, hipStream_t stream) {
    (void)in_sizes; (void)n_in; (void)out_size;
    Params p{};
    p.x = (const float*)d_in[0]; p.c = (const float*)d_in[1]; p.positions = (const int*)d_in[2]; p.ada_w = (const float*)d_in[3]; p.ada_b = (const float*)d_in[4];
    p.norm_mix = (const float*)d_in[5]; p.w_in = (const float*)d_in[6]; p.rwkv_mu = (const float*)d_in[7]; p.decay_w0 = (const float*)d_in[8]; p.decay_up = (const float*)d_in[9];
    p.iclr_a0 = (const float*)d_in[10]; p.iclr_up = (const float*)d_in[11]; p.gate_up = (const float*)d_in[12]; p.k_k = (const float*)d_in[13]; p.k_a = (const float*)d_in[14];
    p.r_k = (const float*)d_in[15]; p.ln_w = (const float*)d_in[16]; p.ln_b = (const float*)d_in[17]; p.q_a_norm = (const float*)d_in[18]; p.w_q_b = (const float*)d_in[19];
    p.kv_a_norm = (const float*)d_in[20]; p.w_kv_b = (const float*)d_in[21]; p.q_norm = (const float*)d_in[22]; p.k_norm = (const float*)d_in[23]; p.w_out = (const float*)d_in[24];
    p.norm_ffn = (const float*)d_in[25]; p.w_router = (const float*)d_in[26]; p.router_bias = (const float*)d_in[27]; p.w_e_gu = (const float*)d_in[28]; p.w_e_d = (const float*)d_in[29];
    p.w_sh_gu = (const float*)d_in[30]; p.w_sh_d = (const float*)d_in[31];
    p.out = (float*)d_out;

    static int grid = 0;
    if (!grid) {
        int dev = 0, cus = 0, per_cu = 0;
        (void)hipGetDevice(&dev);
        (void)hipDeviceGetAttribute(&cus, hipDeviceAttributeMultiprocessorCount, dev);
#if ONE_LAUNCH
        (void)hipFuncSetAttribute((const void*)mega_kernel, hipFuncAttributeMaxDynamicSharedMemorySize, LDS_BYTES);
#endif
#if !ONE_LAUNCH
        (void)hipFuncSetAttribute((const void*)phase_kernel<0>, hipFuncAttributeMaxDynamicSharedMemorySize, LDS_BYTES);
#endif
#if !ONE_LAUNCH
        (void)hipFuncSetAttribute((const void*)phase_kernel<1>, hipFuncAttributeMaxDynamicSharedMemorySize, LDS_BYTES);
#endif
#if !ONE_LAUNCH
        (void)hipFuncSetAttribute((const void*)phase_kernel<2>, hipFuncAttributeMaxDynamicSharedMemorySize, LDS_BYTES);
#endif
#if !ONE_LAUNCH
        (void)hipFuncSetAttribute((const void*)phase_kernel<3>, hipFuncAttributeMaxDynamicSharedMemorySize, LDS_BYTES);
#endif
#if !ONE_LAUNCH
        (void)hipFuncSetAttribute((const void*)phase_kernel<4>, hipFuncAttributeMaxDynamicSharedMemorySize, LDS_BYTES);
#endif
#if !ONE_LAUNCH
        (void)hipFuncSetAttribute((const void*)phase_kernel<5>, hipFuncAttributeMaxDynamicSharedMemorySize, LDS_BYTES);
#endif
#if !ONE_LAUNCH
        (void)hipFuncSetAttribute((const void*)phase_kernel<6>, hipFuncAttributeMaxDynamicSharedMemorySize, LDS_BYTES);
#endif
#if !ONE_LAUNCH
        (void)hipFuncSetAttribute((const void*)phase_kernel<7>, hipFuncAttributeMaxDynamicSharedMemorySize, LDS_BYTES);
#endif
        (void)hipOccupancyMaxActiveBlocksPerMultiprocessor(&per_cu, (const void*)OCC_KERNEL, 256, LDS_BYTES);
        if (cus <= 0) cus = 256;
        if (per_cu < 1) per_cu = 1;
        grid = cus * (per_cu < 2 ? per_cu : 2);
    }
    unsigned char* w = (unsigned char*)d_ws; size_t o = 0;
    auto take = [&](size_t bytes) { unsigned char* r = w + o; o = al256(o + bytes); return r; };
    p.ctrl = (unsigned*)take(CTRL_WORDS * 4);
    p.mod = (float*)take((size_t)NB * 6144 * 4);
    p.rope = (float*)take((size_t)NTOK * 32 * 4);
    p.win_t = (bf16_t*)take((size_t)LDU * 1024 * 2);
    p.wq_t = (bf16_t*)take((size_t)768 * 256 * 2);
    p.wkv_t = (bf16_t*)take((size_t)1024 * 128 * 2);
    p.wdec_t = (bf16_t*)take((size_t)512 * 32 * 2);
    p.wiclr_t = (bf16_t*)take((size_t)512 * 32 * 2);
    p.wgate_t = (bf16_t*)take((size_t)512 * 96 * 2);
    p.wout_t = (bf16_t*)take((size_t)1024 * 1024 * 2);
    p.wr_t = (bf16_t*)take((size_t)256 * 1024 * 2);
    p.wsgu_t = (bf16_t*)take((size_t)512 * 1024 * 2);
    p.wsd_t = (bf16_t*)take((size_t)1024 * 256 * 2);
    p.wegu_t = (bf16_t*)take((size_t)NEXP * 512 * 1024 * 2);
    p.wed_t = (bf16_t*)take((size_t)NEXP * 1024 * 256 * 2);
    p.H = (bf16_t*)take((size_t)NTOK * DM * 2);
    p.topk_idx = (int*)take((size_t)NTOK * 8 * 4);
    p.topk_w = (float*)take((size_t)NTOK * 8 * 4);
    p.elist = (int*)take((size_t)NEXP * NTOK * 4);
    p.bscr = take((size_t)grid * BSCR_PER_BLOCK);
    const size_t ov = o;
    p.U = (bf16_t*)take((size_t)NTOK * LDU * 2);
    p.Q = (bf16_t*)take((size_t)NTOK * 8 * 96 * 2);
    p.Kb = (bf16_t*)take((size_t)NTOK * 8 * 96 * 2);
    p.Vt = (bf16_t*)take((size_t)NTOK * 8 * 64 * 2);
    p.SC = (bf16_t*)take((size_t)NTOK * 8 * 384 * 2);
    p.Gg = (bf16_t*)take((size_t)NTOK * 512 * 2);
    p.yraw = (float*)take((size_t)NTOK * 512 * 4);
    p.Y = (bf16_t*)take((size_t)NTOK * DM * 2);
    p.slot = (bf16_t*)(w + ov);
    const size_t need_slot = ov + (size_t)NTOK * 8 * DM * 2;
    if (o > ws_size || need_slot > ws_size) { fprintf(stderr, "workspace too small: need %zu / %zu, have %zu\n", o, need_slot, ws_size); return; }

    (void)hipMemsetAsync(p.ctrl, 0, CTRL_WORDS * 4, stream);
#if ONE_LAUNCH
    hipLaunchKernelGGL(mega_kernel, dim3(grid), dim3(256), LDS_BYTES, stream, p);
#else
    hipLaunchKernelGGL(phase_kernel<0>, dim3(grid), dim3(256), LDS_BYTES, stream, p);
    hipLaunchKernelGGL(phase_kernel<1>, dim3(grid), dim3(256), LDS_BYTES, stream, p);
    hipLaunchKernelGGL(phase_kernel<2>, dim3(grid), dim3(256), LDS_BYTES, stream, p);
    hipLaunchKernelGGL(phase_kernel<3>, dim3(grid), dim3(256), LDS_BYTES, stream, p);
    hipLaunchKernelGGL(phase_kernel<4>, dim3(grid), dim3(256), LDS_BYTES, stream, p);
    hipLaunchKernelGGL(phase_kernel<5>, dim3(grid), dim3(256), LDS_BYTES, stream, p);
    hipLaunchKernelGGL(phase_kernel<6>, dim3(grid), dim3(256), LDS_BYTES, stream, p);
    hipLaunchKernelGGL(phase_kernel<7>, dim3(grid), dim3(256), LDS_BYTES, stream, p);
#endif
}
```

```cpp
#include <hip/hip_runtime.h>
#include <stdint.h>
#include <stdio.h>
#define DI __device__ __forceinline__

#ifndef SCAN_CHUNKED
#define SCAN_CHUNKED 1
#endif
#ifndef ONE_LAUNCH
#define ONE_LAUNCH 1
#endif

typedef unsigned short bf16_t;
typedef short bf16x8 __attribute__((ext_vector_type(8)));
typedef float f32x4 __attribute__((ext_vector_type(4)));
typedef float f32x16 __attribute__((ext_vector_type(16)));
typedef float f32x2_t __attribute__((ext_vector_type(2)));
typedef unsigned u32x4 __attribute__((ext_vector_type(4)));
typedef unsigned u32x2 __attribute__((ext_vector_type(2)));
#define LAUNDER(v) asm volatile("" : "+v"(v))
DI u32x4 mk4(unsigned a, unsigned b, unsigned c, unsigned d) { return (u32x4){a, b, c, d}; }
DI u32x2 mk2(unsigned a, unsigned b) { return (u32x2){a, b}; }

typedef __bf16 bf16x2_t __attribute__((ext_vector_type(2)));

constexpr int NB = 16, NT_ = 4096, DM = 1024, NTOK = NB * NT_;
constexpr int LDU = 2176;
constexpr int UQ = 0, UKV = 256, UR = 384, UK = 896, UV = 1408, UXW = 1920, UXA = 1952, UXG = 1984, UPE = 2080;
constexpr int NEXP = 256, TOPK = 8;
constexpr int LDS_BYTES = 73728;
constexpr float QSCALE = 0.14724444f;

#define XB_TMO      128
#define XB_XCNT(j)  (256  + 64 * (j))
#define XB_XSUB(j)  (1280 + 64 * (j))
#define XB_XGEN(j)  (2304 + 64 * (j))
#define XB_TOP      3328
#define XB_TOPGEN   3392
#define XCD_BAR_WORDS 3456
#define XB_SPIN_CAP (1u << 22)
#define LAS __attribute__((address_space(3)))
constexpr int CTRL_ATTNQ = 4096, CTRL_ECNT = 8192, ECNT_STRIDE = 64, CTRL_WORDS = 24576;
constexpr int CTRL_STAMP = 4160;
constexpr int CTRL_Q6 = 4608;
#ifdef PROBE_A
#define STAMP(id) do { if (blockIdx.x == 0 && threadIdx.x == 0) __hip_atomic_store((unsigned long long*)(p.ctrl + CTRL_STAMP) + (id), (unsigned long long)__builtin_amdgcn_s_memrealtime(), __ATOMIC_RELAXED, __HIP_MEMORY_SCOPE_AGENT); } while (0)
#else
#define STAMP(id)
#endif

DI unsigned xb_ld(unsigned* p)              { return __hip_atomic_load(p, __ATOMIC_RELAXED, __HIP_MEMORY_SCOPE_AGENT); }
DI unsigned xb_add(unsigned* p, unsigned v) { return __hip_atomic_fetch_add(p, v, __ATOMIC_RELAXED, __HIP_MEMORY_SCOPE_AGENT); }
DI unsigned xb_xcc_id() { return (unsigned)__builtin_amdgcn_s_getreg((3 << 11) | 20) & 0xFu; }
#define XB_SPIN(cond, bar) do { unsigned _sp = 0; while (cond) { __builtin_amdgcn_s_sleep(1); \
    if ((++_sp & 255u) == 0u) { if (xb_ld(&(bar)[XB_TMO])) break; if (_sp > XB_SPIN_CAP) { atomicAdd(&(bar)[XB_TMO], 1u); break; } } } } while (0)

struct XcdBarrier { unsigned* bar; unsigned x; volatile LAS unsigned* st; };

DI XcdBarrier xcd_barrier_post(unsigned* bar, volatile LAS unsigned* st) {
    XcdBarrier b; b.bar = bar; b.x = xb_xcc_id(); b.st = st;
    if (threadIdx.x == 0) (void)xb_add(&bar[XB_XCNT(b.x)], 1u);
    return b;
}
DI void xcd_barrier_complete(unsigned* bar, unsigned x, unsigned& nloc, unsigned& nx) {
    const unsigned G = gridDim.x * gridDim.y * gridDim.z;
    unsigned sum, cnt, mine, sp = 0u;
    for (;;) {
        sum = 0u; cnt = 0u; mine = 0u;
#pragma unroll
        for (unsigned j = 0; j < 16; ++j) { const unsigned c = xb_ld(&bar[XB_XCNT(j)]); sum += c; cnt += (c > 0u) ? 1u : 0u; mine = (j == x) ? c : mine; }
        if (sum == G) break;
        __builtin_amdgcn_s_sleep(1);
        if ((++sp & 255u) == 0u) { if (xb_ld(&bar[XB_TMO])) break; if (sp > XB_SPIN_CAP) { atomicAdd(&bar[XB_TMO], 1u); break; } }
    }
    nloc = mine > 0u ? mine : 1u; nx = cnt > 0u ? cnt : 1u;
}
DI void xcd_barrier(const XcdBarrier& b) {
    asm volatile("s_waitcnt vmcnt(0)" ::: "memory");
    __syncthreads();
    if (threadIdx.x == 0) {
        unsigned* bar = b.bar;
        __builtin_amdgcn_s_waitcnt(0);
        unsigned nloc = b.st[0], nx = b.st[1];
        if (nloc == 0u) { xcd_barrier_complete(bar, b.x, nloc, nx); b.st[0] = nloc; b.st[1] = nx; }
        const unsigned old = xb_add(&bar[XB_XSUB(b.x)], 1u);
        const unsigned gen = old / nloc;
        if (old + 1u == (gen + 1u) * nloc) {
            __builtin_amdgcn_fence(__ATOMIC_RELEASE, "agent");
            asm volatile("s_waitcnt vmcnt(0)" ::: "memory");
            const unsigned og = xb_add(&bar[XB_TOP], 1u);
            const unsigned tg = og / nx;
            if (og + 1u == (tg + 1u) * nx) xb_add(&bar[XB_TOPGEN], 1u);
            else XB_SPIN(xb_ld(&bar[XB_TOPGEN]) == tg, bar);
            __builtin_amdgcn_fence(__ATOMIC_ACQUIRE, "agent");
            xb_add(&bar[XB_XGEN(b.x)], 1u);
            asm volatile("s_waitcnt vmcnt(0)" ::: "memory");
        } else {
            XB_SPIN(xb_ld(&bar[XB_XGEN(b.x)]) == gen, bar);
            __builtin_amdgcn_fence(__ATOMIC_ACQUIRE, "agent");
            asm volatile("s_waitcnt vmcnt(0)" ::: "memory");
        }
    }
    __syncthreads();
}

struct Params {
    const float* x; const float* c; const int* positions; const float* ada_w; const float* ada_b; const float* norm_mix; const float* w_in;
    const float* rwkv_mu; const float* decay_w0; const float* decay_up; const float* iclr_a0; const float* iclr_up; const float* gate_up;
    const float* k_k; const float* k_a; const float* r_k; const float* ln_w; const float* ln_b;
    const float* q_a_norm; const float* w_q_b; const float* kv_a_norm; const float* w_kv_b; const float* q_norm; const float* k_norm;
    const float* w_out; const float* norm_ffn; const float* w_router; const float* router_bias;
    const float* w_e_gu; const float* w_e_d; const float* w_sh_gu; const float* w_sh_d;
    float* out;
    unsigned* ctrl; float* mod; float* rope;
    bf16_t* win_t; bf16_t* wq_t; bf16_t* wkv_t; bf16_t* wdec_t; bf16_t* wiclr_t; bf16_t* wgate_t; bf16_t* wout_t; bf16_t* wr_t; bf16_t* wsgu_t; bf16_t* wsd_t;
    bf16_t* wegu_t; bf16_t* wed_t;
    bf16_t* H; int* topk_idx; float* topk_w; int* elist; unsigned char* bscr;
    bf16_t* U; bf16_t* Q; bf16_t* Kb; bf16_t* Vt; bf16_t* SC; bf16_t* Gg; float* yraw; bf16_t* Y; bf16_t* slot;
};
constexpr size_t BSCR_PER_BLOCK = 196608;

DI float bf2f(bf16_t v) { return __uint_as_float(((unsigned)v) << 16); }
DI unsigned pk2(float a, float b) { f32x2_t f = {a, b}; bf16x2_t r = __builtin_convertvector(f, bf16x2_t); return __builtin_bit_cast(unsigned, r); }
DI bf16_t f2bf(float a) { return (bf16_t)(pk2(a, 0.f) & 0xffffu); }
DI float lo2f(unsigned w) { return __uint_as_float(w << 16); }
DI float hi2f(unsigned w) { return __uint_as_float(w & 0xffff0000u); }
DI float sigmoidf_(float x) { return 1.0f / (1.0f + __expf(-x)); }
DI float wave_sum(float v) {
#pragma unroll
    for (int o = 32; o > 0; o >>= 1) v += __shfl_xor(v, o);
    return v;
}
DI float dpp_sum8(float s) {
    s += __builtin_bit_cast(float, __builtin_amdgcn_update_dpp(0, __builtin_bit_cast(int, s), 0xB1, 0xf, 0xf, true));
    s += __builtin_bit_cast(float, __builtin_amdgcn_update_dpp(0, __builtin_bit_cast(int, s), 0x4E, 0xf, 0xf, true));
    s += __builtin_bit_cast(float, __builtin_amdgcn_update_dpp(0, __builtin_bit_cast(int, s), 0x141, 0xf, 0xf, true));
    return s;
}

struct APlain { const bf16_t* base; int ld; DI const bf16_t* row(int r) const { return base + (size_t)r * ld; } };
struct AGather { const bf16_t* base; const int* idx; DI const bf16_t* row(int r) const { return base + (size_t)idx[r] * DM; } };

template <int MT, int NT, int WR, int BK, int NSWAP, class AP>
DI void gemm_tile(const AP ap, const bf16_t* __restrict__ Bt, const int ldb, const int K, f32x4 (&acc)[MT][NT], unsigned char* lds) {
    constexpr int WC = 4 / WR, CPR = BK / 8, RB = BK * 2, R256 = 256 / RB, BN = WC * NT * 16;
    static_assert(WR * MT * 16 == 128, "tile is 128 rows");
    constexpr int A_BYTES = 128 * RB, B_BYTES = BN * RB;
    constexpr int A_CH = (128 * CPR) / 256, B_TOT = BN * CPR, B_CH = (B_TOT + 255) / 256, RSTEP = 256 / CPR;
    int t = threadIdx.x; LAUNDER(t);
    const int lane = t & 63, wid = t >> 6, wr = wid / WC, wc = wid % WC;
    const int ch = t % CPR, r0 = t / CPR;
    const bf16_t* pa[A_CH]; const bf16_t* pb[B_CH]; int offa[A_CH], offb[B_CH]; bool vb[B_CH];
#pragma unroll
    for (int i = 0; i < A_CH; ++i) { const int row = r0 + i * RSTEP; pa[i] = ap.row(row) + ch * 8; offa[i] = row * RB + ((ch ^ ((row / R256) & (CPR - 1))) << 4); }
#pragma unroll
    for (int i = 0; i < B_CH; ++i) { const int row = r0 + i * RSTEP; vb[i] = (B_TOT % 256 == 0) || (row < BN); const int rr = vb[i] ? row : 0; pb[i] = Bt + (size_t)rr * ldb + ch * 8; offb[i] = 2 * A_BYTES + rr * RB + ((ch ^ ((rr / R256) & (CPR - 1))) << 4); }
#pragma unroll
    for (int i = 0; i < MT; ++i)
#pragma unroll
        for (int j = 0; j < NT; ++j) acc[i][j] = (f32x4){0.f, 0.f, 0.f, 0.f};
    const int KT = K / BK;
    u32x4 ra0[A_CH], rb0[B_CH], ra1[A_CH], rb1[B_CH];
#define G_LOAD(RA, RB, KTI) { _Pragma("unroll") for (int i = 0; i < A_CH; ++i) RA[i] = *(const u32x4*)(pa[i] + (KTI) * BK); \
                              _Pragma("unroll") for (int i = 0; i < B_CH; ++i) RB[i] = *(const u32x4*)(pb[i] + (KTI) * BK); }
#define G_WRITE(RA, RB, BUF) { _Pragma("unroll") for (int i = 0; i < A_CH; ++i) *(u32x4*)(lds + (BUF) * A_BYTES + offa[i]) = RA[i]; \
                               _Pragma("unroll") for (int i = 0; i < B_CH; ++i) if (vb[i]) *(u32x4*)(lds + (BUF) * B_BYTES + offb[i]) = RB[i]; }
#define G_COMPUTE(BUF) { const unsigned char* Ab = lds + (BUF) * A_BYTES + arow; const unsigned char* Bb = lds + 2 * A_BYTES + (BUF) * B_BYTES + brow; \
        _Pragma("unroll") for (int ks = 0; ks < BK / 32; ++ks) { const int co = ((ks * 4 + (lane >> 4)) ^ sw) << 4; bf16x8 af[MT], bfr[NT]; \
            _Pragma("unroll") for (int i = 0; i < MT; ++i) af[i] = *(const bf16x8*)(Ab + i * 16 * RB + co); \
            _Pragma("unroll") for (int j = 0; j < NT; ++j) bfr[j] = *(const bf16x8*)(Bb + j * 16 * RB + co); \
            _Pragma("unroll") for (int i = 0; i < MT; ++i) _Pragma("unroll") for (int j = 0; j < NT; ++j) \
                acc[i][j] = (j < NSWAP) ? __builtin_amdgcn_mfma_f32_16x16x32_bf16(bfr[j], af[i], acc[i][j], 0, 0, 0) \
                                        : __builtin_amdgcn_mfma_f32_16x16x32_bf16(af[i], bfr[j], acc[i][j], 0, 0, 0); } }
    const int sw = ((lane & 15) / R256) & (CPR - 1);
    const int arow = (wr * MT * 16 + (lane & 15)) * RB, brow = (wc * NT * 16 + (lane & 15)) * RB;
    G_LOAD(ra0, rb0, 0)
    if (KT > 1) G_LOAD(ra1, rb1, 1)
    __syncthreads();
    G_WRITE(ra0, rb0, 0)
    if (KT > 2) G_LOAD(ra0, rb0, 2)
    __syncthreads();
    for (int kt = 0; kt < KT; kt += 2) {
        G_COMPUTE(0)
        if (kt + 1 < KT) { G_WRITE(ra1, rb1, 1) if (kt + 3 < KT) G_LOAD(ra1, rb1, kt + 3) }
        __syncthreads();
        if (kt + 1 >= KT) break;
        G_COMPUTE(1)
        if (kt + 2 < KT) { G_WRITE(ra0, rb0, 0) if (kt + 4 < KT) G_LOAD(ra0, rb0, kt + 4) }
        __syncthreads();
    }
#undef G_LOAD
#undef G_WRITE
#undef G_COMPUTE
}
template <int MT, int NT, int WR, int BK, int NSWAP, class AP, class UF, class EPI>
DI void gemm_stream(const AP ap, const bf16_t* __restrict__ Bt, const int ldb, const int K, const int nunits, const UF uoff, const EPI epi, unsigned char* lds) {
    constexpr int WC = 4 / WR, CPR = BK / 8, RB = BK * 2, R256 = 256 / RB, BN = WC * NT * 16, NTH = (NT > 6) ? NT / 2 : NT;
    static_assert(WR * MT * 16 == 128, "tile is 128 rows");
    constexpr int A_BYTES = 128 * RB, B_BYTES = BN * RB;
    constexpr int A_CH = (128 * CPR) / 256, B_TOT = BN * CPR, B_CH = (B_TOT + 255) / 256, RSTEP = 256 / CPR;
    int t = threadIdx.x; LAUNDER(t);
    const int lane = t & 63, wid = t >> 6, wr = wid / WC, wc = wid % WC;
    const int ch = t % CPR, r0 = t / CPR;
    const bf16_t* pa[A_CH]; const bf16_t* pb[B_CH]; int offa[A_CH], offb[B_CH]; bool vb[B_CH];
#pragma unroll
    for (int i = 0; i < A_CH; ++i) { const int row = r0 + i * RSTEP; pa[i] = ap.row(row) + ch * 8; offa[i] = row * RB + ((ch ^ ((row / R256) & (CPR - 1))) << 4); }
#pragma unroll
    for (int i = 0; i < B_CH; ++i) { const int row = r0 + i * RSTEP; vb[i] = (B_TOT % 256 == 0) || (row < BN); const int rr = vb[i] ? row : 0; pb[i] = Bt + (size_t)rr * ldb + ch * 8; offb[i] = 2 * A_BYTES + rr * RB + ((ch ^ ((rr / R256) & (CPR - 1))) << 4); }
    f32x4 acc[MT][NT];
#pragma unroll
    for (int i = 0; i < MT; ++i)
#pragma unroll
        for (int j = 0; j < NT; ++j) acc[i][j] = (f32x4){0.f, 0.f, 0.f, 0.f};
    const int KT = K / BK, NG = nunits * KT;
    int lu = 0, lkt = 0, cu = 0, ckt = 0;
    u32x4 ra0[A_CH], rb0[B_CH], ra1[A_CH], rb1[B_CH];
#define S_LOAD(RA, RB) { int ao, bo; uoff(lu, ao, bo); ao += lkt * BK; bo += lkt * BK; \
                         _Pragma("unroll") for (int i = 0; i < A_CH; ++i) RA[i] = *(const u32x4*)(pa[i] + ao); \
                         _Pragma("unroll") for (int i = 0; i < B_CH; ++i) RB[i] = *(const u32x4*)(pb[i] + bo); \
                         if (++lkt == KT) { lkt = 0; ++lu; } }
#define S_WRITE(RA, RB, BUF) { _Pragma("unroll") for (int i = 0; i < A_CH; ++i) *(u32x4*)(lds + (BUF) * A_BYTES + offa[i]) = RA[i]; \
                               _Pragma("unroll") for (int i = 0; i < B_CH; ++i) if (vb[i]) *(u32x4*)(lds + (BUF) * B_BYTES + offb[i]) = RB[i]; }
#define S_COMPUTE(BUF) { const unsigned char* Ab = lds + (BUF) * A_BYTES + arow; const unsigned char* Bb = lds + 2 * A_BYTES + (BUF) * B_BYTES + brow; \
        _Pragma("unroll") for (int ks = 0; ks < BK / 32; ++ks) { const int co = ((ks * 4 + (lane >> 4)) ^ sw) << 4; bf16x8 af[MT]; \
            _Pragma("unroll") for (int i = 0; i < MT; ++i) af[i] = *(const bf16x8*)(Ab + i * 16 * RB + co); \
            _Pragma("unroll") for (int jh = 0; jh < NT / NTH; ++jh) { bf16x8 bfr[NTH]; \
                _Pragma("unroll") for (int j = 0; j < NTH; ++j) bfr[j] = *(const bf16x8*)(Bb + (jh * NTH + j) * 16 * RB + co); \
                __builtin_amdgcn_s_setprio(1); \
                _Pragma("unroll") for (int i = 0; i < MT; ++i) _Pragma("unroll") for (int j = 0; j < NTH; ++j) \
                    acc[i][jh * NTH + j] = (jh * NTH + j < NSWAP) ? __builtin_amdgcn_mfma_f32_16x16x32_bf16(bfr[j], af[i], acc[i][jh * NTH + j], 0, 0, 0) \
                                                                : __builtin_amdgcn_mfma_f32_16x16x32_bf16(af[i], bfr[j], acc[i][jh * NTH + j], 0, 0, 0); \
                __builtin_amdgcn_s_setprio(0); } } }
#define S_EPI { if (++ckt == KT) { epi(cu, acc); ckt = 0; ++cu; \
                _Pragma("unroll") for (int i = 0; i < MT; ++i) _Pragma("unroll") for (int j = 0; j < NT; ++j) acc[i][j] = (f32x4){0.f, 0.f, 0.f, 0.f}; } }
    const int sw = ((lane & 15) / R256) & (CPR - 1);
    const int arow = (wr * MT * 16 + (lane & 15)) * RB, brow = (wc * NT * 16 + (lane & 15)) * RB;
    S_LOAD(ra0, rb0)
    if (NG > 1) S_LOAD(ra1, rb1)
    __syncthreads();
    S_WRITE(ra0, rb0, 0)
    if (NG > 2) S_LOAD(ra0, rb0)
    __syncthreads();
#pragma unroll 1
    for (int g = 0; g < NG; g += 2) {
        S_COMPUTE(0)
        if (g + 1 < NG) { S_WRITE(ra1, rb1, 1) if (g + 3 < NG) S_LOAD(ra1, rb1) }
        S_EPI
        __syncthreads();
        if (g + 1 >= NG) break;
        S_COMPUTE(1)
        if (g + 2 < NG) { S_WRITE(ra0, rb0, 0) if (g + 4 < NG) S_LOAD(ra0, rb0) }
        S_EPI
        __syncthreads();
    }
#undef S_LOAD
#undef S_WRITE
#undef S_COMPUTE
#undef S_EPI
}

template <int NT, int BK, class AP>
DI void gemm_core(const AP ap, const bf16_t* __restrict__ Bt, const int ldb, const int K, f32x4 (&acc)[4][NT], unsigned char* lds) {
    gemm_tile<4, NT, 2, BK, NT>(ap, Bt, ldb, K, acc, lds);
}

template <int NT> DI void acc_to_lds(const f32x4 (&acc)[4][NT], float* tile, const int ld) {
    int t = threadIdx.x; LAUNDER(t);
    const int lane = t & 63, wid = t >> 6, wr = wid >> 1, wc = wid & 1;
#pragma unroll
    for (int i = 0; i < 4; ++i)
#pragma unroll
        for (int j = 0; j < NT; ++j) {
            const int row = wr * 64 + i * 16 + (lane & 15), col = wc * NT * 16 + j * 16 + (lane >> 4) * 4;
            *(f32x4*)(tile + row * ld + col) = acc[i][j];
        }
}

DI int map_win(int n) { return n < 384 ? n + 1696 : (n < 2080 ? n - 384 : (n < 2112 ? n : -1)); }
DI int map_gu128(int n) { const int tile = n >> 7, w = n & 127, wc = w >> 6, j = (w >> 4) & 3, r = w & 15; const int a = tile * 64 + wc * 32 + (j >> 1) * 16 + r; return (j & 1) ? 256 + a : a; }
DI int map_gu(int n) { const int tile = n >> 8, w = n & 255, wc = w >> 7, j = (w >> 4) & 7, r = w & 15; const int a = tile * 128 + wc * 64 + (j >> 1) * 16 + r; return (j & 1) ? 256 + a : a; }

template <int MAP> DI void tconv_simple(const float* __restrict__ src, bf16_t* __restrict__ dst, int K, int Ns, int Nd, const float* __restrict__ scale, int gtid, int gthreads) {
    const int total = Nd * K;
    for (int idx = gtid; idx < total; idx += gthreads) {
        const int n = idx / K, k = idx - n * K;
        const int m = (MAP == 1) ? map_win(n) : (MAP == 2 ? map_gu(n) : (MAP == 3 ? map_gu128(n) : n));
        float v = 0.f;
        if (m >= 0) { v = src[(size_t)k * Ns + m]; if (scale) v *= scale[k]; }
        dst[idx] = f2bf(v);
    }
}
template <int MAP> DI void tconv_tiled(const float* __restrict__ src, bf16_t* __restrict__ dst, int E, int K, int N, float* ldsf, int bid, int G) {
    const int tk = K / 64, tn = N / 64, per = tk * tn, total = E * per;
    const int t = threadIdx.x;
    for (int tile0 = 2 * bid; tile0 < total; tile0 += 2 * G) {
        float rg[2][16];
#pragma unroll
        for (int h = 0; h < 2; ++h) {
            const int tile = tile0 + h, e = tile / per, r = tile - e * per, kt = r / tn, nt = r - kt * tn;
            const float* s = src + (size_t)e * K * N + (size_t)(kt * 64) * N;
            const int nl = t & 63, n = nt * 64 + nl;
            const int m = (MAP == 2) ? map_gu(n) : n;
#pragma unroll
            for (int i = 0; i < 16; ++i) rg[h][i] = s[(size_t)((t >> 6) + 4 * i) * N + m];
        }
        __syncthreads();
#pragma unroll
        for (int h = 0; h < 2; ++h)
#pragma unroll
            for (int i = 0; i < 16; ++i) ldsf[h * 4160 + ((t >> 6) + 4 * i) * 65 + (t & 63)] = rg[h][i];
        __syncthreads();
#pragma unroll
        for (int h = 0; h < 2; ++h) {
            const int tile = tile0 + h, e = tile / per, r = tile - e * per, kt = r / tn, nt = r - kt * tn;
            const int nl = t >> 2, kc = (t & 3) * 16;
            unsigned w[8];
#pragma unroll
            for (int i = 0; i < 8; ++i) w[i] = pk2(ldsf[h * 4160 + (kc + 2 * i) * 65 + nl], ldsf[h * 4160 + (kc + 2 * i + 1) * 65 + nl]);
            bf16_t* d = dst + (size_t)e * K * N + (size_t)(nt * 64 + nl) * K + kt * 64 + kc;
            *(u32x4*)(d) = mk4(w[0], w[1], w[2], w[3]);
            *(u32x4*)(d + 8) = mk4(w[4], w[5], w[6], w[7]);
        }
    }
}
DI void phase0(const Params& p, unsigned char* lds, int bid, int G) {
    const int t = threadIdx.x;
    float* ldsf = (float*)lds;
    for (int item = bid; item < 384; item += G) {
        __syncthreads();
        for (int i = t; i < NB * DM; i += 256) { const float v = p.c[i]; ldsf[(i & (DM - 1)) * NB + (i >> 10)] = v * sigmoidf_(v); }
        __syncthreads();
        const int col = item * 16 + (t & 15), kp = t >> 4;
        float a[NB];
#pragma unroll
        for (int b = 0; b < NB; ++b) a[b] = 0.f;
#pragma unroll 1
        for (int k0 = kp * 64; k0 < kp * 64 + 64; k0 += 8) {
            float w[8];
#pragma unroll
            for (int u = 0; u < 8; ++u) w[u] = p.ada_w[(size_t)(k0 + u) * 6144 + col];
#pragma unroll
            for (int u = 0; u < 8; ++u) {
#pragma unroll
                for (int q = 0; q < 4; ++q) { const f32x4 cv = *(const f32x4*)(ldsf + (k0 + u) * NB + 4 * q); a[4 * q] += cv[0] * w[u]; a[4 * q + 1] += cv[1] * w[u]; a[4 * q + 2] += cv[2] * w[u]; a[4 * q + 3] += cv[3] * w[u]; }
            }
        }
        __syncthreads();
#pragma unroll
        for (int b = 0; b < NB; ++b) ldsf[(kp * NB + b) * 16 + (t & 15)] = a[b];
        __syncthreads();
        {
            const int b = t >> 4, cl = t & 15; float sacc = 0.f;
#pragma unroll
            for (int q = 0; q < 16; ++q) sacc += ldsf[(q * NB + b) * 16 + cl];
            p.mod[b * 6144 + item * 16 + cl] = sacc + p.ada_b[item * 16 + cl];
        }
    }
    __syncthreads();
    const int gtid = bid * 256 + t, gth = G * 256;
    tconv_simple<1>(p.w_in, p.win_t, 1024, 2112, LDU, nullptr, gtid, gth);
    tconv_simple<0>(p.w_q_b, p.wq_t, 256, 768, 768, p.q_a_norm, gtid, gth);
    tconv_simple<0>(p.w_kv_b, p.wkv_t, 128, 1024, 1024, p.kv_a_norm, gtid, gth);
    tconv_simple<0>(p.decay_up, p.wdec_t, 32, 512, 512, nullptr, gtid, gth);
    tconv_simple<0>(p.iclr_up, p.wiclr_t, 32, 512, 512, nullptr, gtid, gth);
    tconv_simple<0>(p.gate_up, p.wgate_t, 96, 512, 512, nullptr, gtid, gth);
    tconv_simple<0>(p.w_out, p.wout_t, 1024, 1024, 1024, nullptr, gtid, gth);
    tconv_simple<0>(p.w_router, p.wr_t, 1024, 256, 256, nullptr, gtid, gth);
    tconv_simple<3>(p.w_sh_gu, p.wsgu_t, 1024, 512, 512, nullptr, gtid, gth);
    tconv_simple<0>(p.w_sh_d, p.wsd_t, 256, 1024, 1024, nullptr, gtid, gth);
    tconv_tiled<2>(p.w_e_gu, p.wegu_t, NEXP, 1024, 512, ldsf, bid, G);
    tconv_tiled<0>(p.w_e_d, p.wed_t, NEXP, 256, 1024, ldsf, bid, G);
}

DI void phase1(const Params& p, int bid, int G) {
    const int lane = threadIdx.x & 63, gw = bid * 4 + (threadIdx.x >> 6), nw = G * 4;
    for (int row0 = gw * 2; row0 < NTOK; row0 += nw * 2) {
        f32x4 v[2][4]; float ss[2] = {0.f, 0.f};
#pragma unroll
        for (int u = 0; u < 2; ++u)
#pragma unroll
            for (int i = 0; i < 4; ++i) v[u][i] = *(const f32x4*)(p.x + (size_t)(row0 + u) * DM + lane * 4 + 256 * i);
#pragma unroll
        for (int u = 0; u < 2; ++u) {
#pragma unroll
            for (int i = 0; i < 4; ++i) ss[u] += v[u][i][0] * v[u][i][0] + v[u][i][1] * v[u][i][1] + v[u][i][2] * v[u][i][2] + v[u][i][3] * v[u][i][3];
            ss[u] = wave_sum(ss[u]);
        }
        const float* mod = p.mod + (row0 >> 12) * 6144;
#pragma unroll
        for (int i = 0; i < 4; ++i) {
            const int c = lane * 4 + 256 * i;
            const f32x4 g = *(const f32x4*)(p.norm_mix + c), sh = *(const f32x4*)(mod + c), sc = *(const f32x4*)(mod + 1024 + c);
#pragma unroll
            for (int u = 0; u < 2; ++u) {
                const float rs = rsqrtf(ss[u] * (1.0f / DM) + 1e-6f);
                float o[4];
#pragma unroll
                for (int e = 0; e < 4; ++e) o[e] = v[u][i][e] * rs * g[e] * (1.0f + sc[e]) + sh[e];
                *(u32x2*)(p.H + (size_t)(row0 + u) * DM + c) = mk2(pk2(o[0], o[1]), pk2(o[2], o[3]));
            }
        }
    }
    const double inv = exp(-(double)(lane & 15) * (9.210340371976184 / 16.0));
    for (int idx = gw * 64 + lane; idx < NTOK * 16; idx += nw * 64) {
        const int row = idx >> 4;
        const double ang = (double)p.positions[row] * inv;
        p.rope[(size_t)row * 32 + (lane & 15)] = (float)cos(ang);
        p.rope[(size_t)row * 32 + 16 + (lane & 15)] = (float)sin(ang);
    }
}

DI void phase2(const Params& p, unsigned char* lds, int bid, int G) {
    constexpr int NCT = LDU / 128;
    const int t = threadIdx.x, lane = t & 63, wid = t >> 6, wr = wid >> 1, wc = wid & 1;
    const int total = (NTOK / 128) * NCT;
    for (int L = bid; L < total; L += G) {
        const int xcd = L & 7, j = L >> 3, rt = 8 * (j / NCT) + xcd, ct = j % NCT;
        f32x4 acc[4][4];
        APlain ap{p.H + (size_t)rt * 128 * DM, DM};
        gemm_core<4, 64>(ap, p.win_t + (size_t)ct * 128 * DM, DM, DM, acc, lds);
        bf16_t* tile = (bf16_t*)lds;
#pragma unroll
        for (int i = 0; i < 4; ++i)
#pragma unroll
            for (int jj = 0; jj < 4; ++jj) {
                const int row = wr * 64 + i * 16 + (lane & 15), col = wc * 64 + jj * 16 + (lane >> 4) * 4;
                *(u32x2*)(tile + row * 136 + col) = mk2(pk2(acc[i][jj][0], acc[i][jj][1]), pk2(acc[i][jj][2], acc[i][jj][3]));
            }
        __syncthreads();
#pragma unroll
        for (int i = 0; i < 8; ++i) {
            const int c = t + 256 * i, row = c >> 4, chn = c & 15;
            *(u32x4*)(p.U + (size_t)(rt * 128 + row) * LDU + ct * 128 + chn * 8) = *(const u32x4*)(tile + row * 136 + chn * 8);
        }
    }
}

DI void unpack8(const u32x4 w, float (&f)[8]) { f[0] = lo2f(w.x); f[1] = hi2f(w.x); f[2] = lo2f(w.y); f[3] = hi2f(w.y); f[4] = lo2f(w.z); f[5] = hi2f(w.z); f[6] = lo2f(w.w); f[7] = hi2f(w.w); }
DI f32x4 unpack4(const u32x2 w) { return (f32x4){lo2f(w.x), hi2f(w.x), lo2f(w.y), hi2f(w.y)}; }
DI u32x2 pack4(const f32x4 v) { return mk2(pk2(v[0], v[1]), pk2(v[2], v[3])); }
DI f32x4 shifted4(const bf16_t* __restrict__ up, const bool has_prev, const f32x4 mu) {
    const f32x4 cur = unpack4(*(const u32x2*)up);
    f32x4 prev = (f32x4){0.f, 0.f, 0.f, 0.f};
    if (has_prev) prev = unpack4(*(const u32x2*)(up - LDU));
    return cur + (prev - cur) * mu;
}
DI void head96_finish(f32x4 (&v)[6], const int q, const float* __restrict__ gain, const float* __restrict__ ropeRow, const float scale, bf16_t* __restrict__ dstRow) {
    float ss = 0.f;
#pragma unroll
    for (int j = 0; j < 6; ++j) ss += v[j][0] * v[j][0] + v[j][1] * v[j][1] + v[j][2] * v[j][2] + v[j][3] * v[j][3];
    ss += __shfl_xor(ss, 16); ss += __shfl_xor(ss, 32);
    const float rs = rsqrtf(ss * (1.0f / 96.0f) + 1e-6f);
#pragma unroll
    for (int j = 0; j < 6; ++j) v[j] = v[j] * rs * *(const f32x4*)(gain + j * 16 + q * 4);
    const f32x4 cs = *(const f32x4*)(ropeRow + q * 4), sn = *(const f32x4*)(ropeRow + 16 + q * 4);
    const f32x4 x1 = v[4], x2 = v[5];
    v[4] = x1 * cs - x2 * sn; v[5] = x2 * cs + x1 * sn;
#pragma unroll
    for (int j = 0; j < 6; ++j) *(u32x2*)(dstRow + j * 16 + q * 4) = pack4(v[j] * scale);
}

DI void phase3(const Params& p, unsigned char* lds, int bid, int G) {
    const int t = threadIdx.x;
    float* rstd_q = (float*)(lds + 69632);
    float* rstd_kv = rstd_q + 128;
    bf16_t* lora = (bf16_t*)(p.bscr + (size_t)bid * BSCR_PER_BLOCK + 131072);
    for (int rt = bid; rt < NTOK / 128; rt += G) {
        __syncthreads();
        {
            int tl = t; LAUNDER(tl);
            const int row = tl >> 1, half = tl & 1, grow = rt * 128 + row;
            const bf16_t* urow = p.U + (size_t)grow * LDU;
            float s = 0.f;
#pragma unroll
            for (int c = 0; c < 16; ++c) { float f[8]; unpack8(*(const u32x4*)(urow + UQ + half * 128 + c * 8), f);
#pragma unroll
                for (int e = 0; e < 8; ++e) s += f[e] * f[e]; }
            s += __shfl_xor(s, 1);
            float s2 = 0.f;
#pragma unroll
            for (int c = 0; c < 8; ++c) { float f[8]; unpack8(*(const u32x4*)(urow + UKV + half * 64 + c * 8), f);
#pragma unroll
                for (int e = 0; e < 8; ++e) s2 += f[e] * f[e]; }
            s2 += __shfl_xor(s2, 1);
            if (half == 0) { rstd_q[row] = rsqrtf(s * (1.0f / 256.0f) + 1e-6f); rstd_kv[row] = rsqrtf(s2 * (1.0f / 128.0f) + 1e-6f); }
        }
#pragma unroll 1
        for (int i = 0; i < 10; ++i) {
            int tl = t; LAUNDER(tl);
            const int c = tl + 256 * i, row = c / 20, chn = c - row * 20, grow = rt * 128 + row;
            const bf16_t* up = p.U + (size_t)grow * LDU + UXW + chn * 8;
            float cur[8], prv[8];
            unpack8(*(const u32x4*)up, cur);
            if ((grow & 4095) > 0) unpack8(*(const u32x4*)(up - LDU), prv);
            else {
#pragma unroll
                for (int e = 0; e < 8; ++e) prv[e] = 0.f; }
            const f32x4 m0 = *(const f32x4*)(p.rwkv_mu + 1536 + chn * 8), m1 = *(const f32x4*)(p.rwkv_mu + 1536 + chn * 8 + 4);
            float o[8];
#pragma unroll
            for (int e = 0; e < 8; ++e) {
                const float x = cur[e] + (prv[e] - cur[e]) * (e < 4 ? m0[e & 3] : m1[e & 3]);
                o[e] = chn < 4 ? tanhf(x) : (chn < 8 ? x : sigmoidf_(x));
            }
            *(u32x4*)(lora + row * 160 + chn * 8) = mk4(pk2(o[0], o[1]), pk2(o[2], o[3]), pk2(o[4], o[5]), pk2(o[6], o[7]));
        }
        asm volatile("s_waitcnt vmcnt(0)" ::: "memory");
        __syncthreads();
        STAMP(17);
        {
            APlain ap{p.U + (size_t)rt * 128 * LDU + UQ, LDU};
            gemm_stream<2, 6, 4, 64, 6>(ap, p.wq_t, 256, 256, 8, [](int u, int& ao, int& bo) { ao = 0; bo = u * 96 * 256; },
                [&](const int h, f32x4 (&acc)[2][6]) {
                    int tl = t; LAUNDER(tl);
                    const int lane = tl & 63, w = tl >> 6, r = lane & 15, q = lane >> 4;
#pragma unroll
                    for (int i = 0; i < 2; ++i) {
                        const int row = 32 * w + 16 * i + r, grow = rt * 128 + row, b = grow >> 12, tt = grow & 4095;
                        const float rq = rstd_q[row];
                        f32x4 v[6];
#pragma unroll
                        for (int j = 0; j < 6; ++j) v[j] = acc[i][j] * rq;
                        head96_finish(v, q, p.q_norm, p.rope + (size_t)grow * 32, QSCALE, p.Q + ((size_t)(b * 8 + h) * NT_ + tt) * 96);
                    }
                }, lds);
        }
        STAMP(18);
        {
            APlain ap{p.U + (size_t)rt * 128 * LDU + UKV, LDU};
            gemm_stream<2, 8, 4, 64, 4>(ap, p.wkv_t, 128, 128, 8, [](int u, int& ao, int& bo) { ao = 0; bo = u * 128 * 128; },
                [&](const int h, f32x4 (&acc)[2][8]) {
                    int tl = t; LAUNDER(tl);
                    const int lane = tl & 63, w = tl >> 6, r = lane & 15, q = lane >> 4;
#pragma unroll
                    for (int i = 0; i < 2; ++i) {
                        const int row = 32 * w + 16 * i + r, grow = rt * 128 + row, b = grow >> 12, tt = grow & 4095;
                        const float rk = rstd_kv[row];
                        const bf16_t* urow = p.U + (size_t)grow * LDU;
                        f32x4 v[6];
#pragma unroll
                        for (int j = 0; j < 4; ++j) v[j] = acc[i][j] * rk;
                        v[4] = unpack4(*(const u32x2*)(urow + UPE + q * 4));
                        v[5] = unpack4(*(const u32x2*)(urow + UPE + 16 + q * 4));
                        head96_finish(v, q, p.k_norm, p.rope + (size_t)grow * 32, 1.0f, p.Kb + ((size_t)(b * 8 + h) * NT_ + tt) * 96);
                        const int tok0 = 32 * w + 16 * i + 4 * q;
                        const f32x4 rk4 = *(const f32x4*)(rstd_kv + tok0);
                        bf16_t* vd = p.Vt + ((size_t)((rt >> 5) * 8 + h) * 64) * NT_ + (rt & 31) * 128 + tok0;
#pragma unroll
                        for (int j = 4; j < 8; ++j) *(u32x2*)(vd + (size_t)((j - 4) * 16 + r) * NT_) = pack4(acc[i][j] * rk4);
                    }
                }, lds);
        }
        STAMP(19);
        bf16_t* abuf = (bf16_t*)(p.bscr + (size_t)bid * BSCR_PER_BLOCK);
        {
            APlain ap{lora, 160};
            gemm_stream<4, 4, 2, 32, 4>(ap, p.wdec_t, 32, 32, 4, [](int u, int& ao, int& bo) { ao = 0; bo = u * 128 * 32; },
                [&](const int ct, f32x4 (&acc)[4][4]) {
                    int tl = t; LAUNDER(tl);
                    const int lane = tl & 63, wid = tl >> 6, wr = wid >> 1, wc = wid & 1, r = lane & 15, q = lane >> 4, head = ct * 2 + wc;
#pragma unroll
                    for (int i = 0; i < 4; ++i) {
                        const int grow = rt * 128 + wr * 64 + i * 16 + r, b = grow >> 12, tt = grow & 4095;
                        bf16_t* sc = p.SC + ((size_t)(b * 8 + head) * NT_ + tt) * 384 + q * 4;
#pragma unroll
                        for (int j = 0; j < 4; ++j) {
                            const f32x4 w0 = *(const f32x4*)(p.decay_w0 + head * 64 + j * 16 + q * 4);
                            f32x4 o;
#pragma unroll
                            for (int e = 0; e < 4; ++e) o[e] = 1.0f - __expf(-0.6065306597f * sigmoidf_(w0[e] + acc[i][j][e]));
                            *(u32x2*)(sc + j * 16) = pack4(o);
                        }
                    }
                }, lds);
        }
        {
            APlain ap{lora + 32, 160};
            gemm_stream<4, 4, 2, 32, 4>(ap, p.wiclr_t, 32, 32, 4, [](int u, int& ao, int& bo) { ao = 0; bo = u * 128 * 32; },
                [&](const int ct, f32x4 (&acc)[4][4]) {
                    int tl = t; LAUNDER(tl);
                    const int lane = tl & 63, wid = tl >> 6, wr = wid >> 1, wc = wid & 1, r = lane & 15, q = lane >> 4, c0 = ct * 128 + wc * 64 + q * 4;
#pragma unroll
                    for (int i = 0; i < 4; ++i) {
                        bf16_t* ar = abuf + (wr * 64 + i * 16 + r) * 512 + c0;
#pragma unroll
                        for (int j = 0; j < 4; ++j) {
                            const f32x4 a0 = *(const f32x4*)(p.iclr_a0 + c0 + j * 16);
                            f32x4 o;
#pragma unroll
                            for (int e = 0; e < 4; ++e) o[e] = sigmoidf_(a0[e] + acc[i][j][e]);
                            *(u32x2*)(ar + j * 16) = pack4(o);
                        }
                    }
                }, lds);
        }
        {
            APlain ap{lora + 64, 160};
            gemm_stream<4, 4, 2, 32, 4>(ap, p.wgate_t, 96, 96, 4, [](int u, int& ao, int& bo) { ao = 0; bo = u * 128 * 96; },
                [&](const int ct, f32x4 (&acc)[4][4]) {
                    int tl = t; LAUNDER(tl);
                    const int lane = tl & 63, wid = tl >> 6, wr = wid >> 1, wc = wid & 1, r = lane & 15, q = lane >> 4, head = ct * 2 + wc;
#pragma unroll
                    for (int i = 0; i < 4; ++i) {
                        const int grow = rt * 128 + wr * 64 + i * 16 + r;
                        bf16_t* g = p.Gg + (size_t)grow * 512 + head * 64 + q * 4;
#pragma unroll
                        for (int j = 0; j < 4; ++j) *(u32x2*)(g + j * 16) = pack4(acc[i][j]);
                    }
                }, lds);
        }
        asm volatile("s_waitcnt vmcnt(0)" ::: "memory");
        __syncthreads();
#pragma unroll 1
        for (int it = 0; it < 16; ++it) {
            int tl = t; LAUNDER(tl);
            const int lane = tl & 63, w = tl >> 6, c8 = lane * 8;
#pragma unroll
            for (int u = 0; u < 2; ++u) {
                const int row = w + 4 * (it * 2 + u), grow = rt * 128 + row, b = grow >> 12, tt = grow & 4095;
                const bool hp = tt > 0;
                const bf16_t* urow = p.U + (size_t)grow * LDU + c8;
                float kc[8], kp_[8], vc[8], vp[8], rc[8], rp[8], av[8];
                unpack8(*(const u32x4*)(urow + UK), kc); unpack8(*(const u32x4*)(urow + UV), vc); unpack8(*(const u32x4*)(urow + UR), rc);
                unpack8(*(const u32x4*)(abuf + row * 512 + c8), av);
                if (hp) { unpack8(*(const u32x4*)(urow + UK - LDU), kp_); unpack8(*(const u32x4*)(urow + UV - LDU), vp); unpack8(*(const u32x4*)(urow + UR - LDU), rp); }
                else {
#pragma unroll
                    for (int e = 0; e < 8; ++e) { kp_[e] = 0.f; vp[e] = 0.f; rp[e] = 0.f; } }
                float mk[8], mv[8], mr[8], kkw[8], kaw[8];
                *(f32x4*)(mk) = *(const f32x4*)(p.rwkv_mu + 512 + c8); *(f32x4*)(mk + 4) = *(const f32x4*)(p.rwkv_mu + 512 + c8 + 4);
                *(f32x4*)(mv) = *(const f32x4*)(p.rwkv_mu + 1024 + c8); *(f32x4*)(mv + 4) = *(const f32x4*)(p.rwkv_mu + 1024 + c8 + 4);
                *(f32x4*)(mr) = *(const f32x4*)(p.rwkv_mu + c8); *(f32x4*)(mr + 4) = *(const f32x4*)(p.rwkv_mu + c8 + 4);
                *(f32x4*)(kkw) = *(const f32x4*)(p.k_k + c8); *(f32x4*)(kkw + 4) = *(const f32x4*)(p.k_k + c8 + 4);
                *(f32x4*)(kaw) = *(const f32x4*)(p.k_a + c8); *(f32x4*)(kaw + 4) = *(const f32x4*)(p.k_a + c8 + 4);
                float ks[8], kq[8], ssq = 0.f;
#pragma unroll
                for (int e = 0; e < 8; ++e) { ks[e] = kc[e] + (kp_[e] - kc[e]) * mk[e]; kq[e] = ks[e] * kkw[e]; ssq += kq[e] * kq[e]; }
                ssq = dpp_sum8(ssq);
                const float rn = rsqrtf(fmaxf(ssq, 1e-24f));
                float okk[8], obb[8], okp[8], ov[8], orr[8];
#pragma unroll
                for (int e = 0; e < 8; ++e) {
                    okk[e] = kq[e] * rn; obb[e] = av[e] * okk[e]; okp[e] = ks[e] * (1.0f + (av[e] - 1.0f) * kaw[e]);
                    ov[e] = vc[e] + (vp[e] - vc[e]) * mv[e]; orr[e] = rc[e] + (rp[e] - rc[e]) * mr[e];
                }
                bf16_t* sc = p.SC + ((size_t)(b * 8 + (lane >> 3)) * NT_ + tt) * 384 + (lane & 7) * 8;
                *(u32x4*)(sc + 64) = mk4(pk2(okk[0], okk[1]), pk2(okk[2], okk[3]), pk2(okk[4], okk[5]), pk2(okk[6], okk[7]));
                *(u32x4*)(sc + 128) = mk4(pk2(obb[0], obb[1]), pk2(obb[2], obb[3]), pk2(obb[4], obb[5]), pk2(obb[6], obb[7]));
                *(u32x4*)(sc + 192) = mk4(pk2(okp[0], okp[1]), pk2(okp[2], okp[3]), pk2(okp[4], okp[5]), pk2(okp[6], okp[7]));
                *(u32x4*)(sc + 256) = mk4(pk2(ov[0], ov[1]), pk2(ov[2], ov[3]), pk2(ov[4], ov[5]), pk2(ov[6], ov[7]));
                *(u32x4*)(sc + 320) = mk4(pk2(orr[0], orr[1]), pk2(orr[2], orr[3]), pk2(orr[4], orr[5]), pk2(orr[6], orr[7]));
            }
        }
    }
}

struct ScanOps { f32x2_t d[4], k[4], b[4], p[4], r[4]; float v; };
DI void scan_load(ScanOps& o, const float* __restrict__ q, const float* __restrict__ vp) {
    const f32x4 d0 = *(const f32x4*)(q), d1 = *(const f32x4*)(q + 4), k0 = *(const f32x4*)(q + 64), k1 = *(const f32x4*)(q + 68);
    const f32x4 b0 = *(const f32x4*)(q + 128), b1 = *(const f32x4*)(q + 132), p0 = *(const f32x4*)(q + 192), p1 = *(const f32x4*)(q + 196);
    const f32x4 r0 = *(const f32x4*)(q + 320), r1 = *(const f32x4*)(q + 324);
    o.d[0] = (f32x2_t){d0[0], d0[1]}; o.d[1] = (f32x2_t){d0[2], d0[3]}; o.d[2] = (f32x2_t){d1[0], d1[1]}; o.d[3] = (f32x2_t){d1[2], d1[3]};
    o.k[0] = (f32x2_t){k0[0], k0[1]}; o.k[1] = (f32x2_t){k0[2], k0[3]}; o.k[2] = (f32x2_t){k1[0], k1[1]}; o.k[3] = (f32x2_t){k1[2], k1[3]};
    o.b[0] = (f32x2_t){b0[0], b0[1]}; o.b[1] = (f32x2_t){b0[2], b0[3]}; o.b[2] = (f32x2_t){b1[0], b1[1]}; o.b[3] = (f32x2_t){b1[2], b1[3]};
    o.p[0] = (f32x2_t){p0[0], p0[1]}; o.p[1] = (f32x2_t){p0[2], p0[3]}; o.p[2] = (f32x2_t){p1[0], p1[1]}; o.p[3] = (f32x2_t){p1[2], p1[3]};
    o.r[0] = (f32x2_t){r0[0], r0[1]}; o.r[1] = (f32x2_t){r0[2], r0[3]}; o.r[2] = (f32x2_t){r1[0], r1[1]}; o.r[3] = (f32x2_t){r1[2], r1[3]};
    o.v = *vp;
}
DI void scan_task(const Params& p, unsigned char* lds, const int task) {
    constexpr int CS = 16;
    const int t = threadIdx.x, lane = t & 63, w = t >> 6;
    const int bh = task >> 1, hf = task & 1, b = bh >> 3, head = bh & 7;
    const int rloc = w * 8 + (lane >> 3), kseg = lane & 7;
    const int vrow = hf * 32 + rloc;
    float* stage = (float*)lds;
    float* ybuf = (float*)(lds + 49152);
    const bf16_t* src = p.SC + (size_t)bh * NT_ * 384;
    f32x2_t s2[4];
#pragma unroll
    for (int j = 0; j < 4; ++j) s2[j] = (f32x2_t){0.f, 0.f};
    u32x4 rg[3];
    __builtin_amdgcn_s_setprio(3);
    __syncthreads();
#pragma unroll
    for (int i = 0; i < 3; ++i) rg[i] = *(const u32x4*)(src + (size_t)(t + 256 * i) * 8);
#pragma unroll
    for (int i = 0; i < 3; ++i) { float* d = stage + (t + 256 * i) * 8;
        *(f32x4*)d = (f32x4){lo2f(rg[i].x), hi2f(rg[i].x), lo2f(rg[i].y), hi2f(rg[i].y)}; *(f32x4*)(d + 4) = (f32x4){lo2f(rg[i].z), hi2f(rg[i].z), lo2f(rg[i].w), hi2f(rg[i].w)}; }
    __syncthreads();
    constexpr int NCH = NT_ / CS;
    for (int c = 0; c < NCH; ++c) {
        const int cur = c & 1;
        if (c + 1 < NCH) {
#pragma unroll
            for (int i = 0; i < 3; ++i) rg[i] = *(const u32x4*)(src + (size_t)(c + 1) * CS * 384 + (size_t)(t + 256 * i) * 8);
        }
        if (c > 0) {
            const float* yb = ybuf + (cur ^ 1) * CS * 32;
            const int st = t >> 4, r2 = (t & 15) * 2;
            *(f32x2_t*)(p.yraw + ((size_t)(b * NT_ + (c - 1) * CS + st)) * 512 + head * 64 + hf * 32 + r2) = *(const f32x2_t*)(yb + st * 32 + r2);
        }
        const float* sb = stage + cur * CS * 384 + kseg * 8;
        float* yb = ybuf + cur * CS * 32;
        float yv[CS];
        ScanOps oc, on;
        scan_load(oc, sb, sb + 256 - kseg * 8 + vrow);
#pragma unroll
        for (int st = 0; st < CS; ++st) {
            if (st + 1 < CS) scan_load(on, sb + (st + 1) * 384, sb + (st + 1) * 384 + 256 - kseg * 8 + vrow);
            f32x2_t t0 = s2[0] * oc.k[0], t1 = s2[1] * oc.k[1];
            t0 = s2[2] * oc.k[2] + t0; t1 = s2[3] * oc.k[3] + t1;
            t0 = t0 + t1;
            float dot = dpp_sum8(t0.x + t0.y);
            const f32x2_t vv2 = {oc.v, oc.v}, nd2 = {-dot, -dot};
            f32x2_t u0, u1;
#pragma unroll
            for (int j = 0; j < 4; ++j) { f32x2_t tmp = s2[j] - s2[j] * oc.d[j]; tmp = vv2 * oc.p[j] + tmp; s2[j] = nd2 * oc.b[j] + tmp; }
            u0 = s2[0] * oc.r[0]; u1 = s2[1] * oc.r[1];
            u0 = s2[2] * oc.r[2] + u0; u1 = s2[3] * oc.r[3] + u1;
            u0 = u0 + u1;
            yv[st] = dpp_sum8(u0.x + u0.y);
            if (st + 1 < CS) oc = on;
        }
        if (kseg == 0) {
#pragma unroll
            for (int st = 0; st < CS; ++st) yb[st * 32 + rloc] = yv[st];
        }
        if (c + 1 < NCH) {
            float* dbase = stage + (cur ^ 1) * CS * 384;
#pragma unroll
            for (int i = 0; i < 3; ++i) { float* d = dbase + (t + 256 * i) * 8;
                *(f32x4*)d = (f32x4){lo2f(rg[i].x), hi2f(rg[i].x), lo2f(rg[i].y), hi2f(rg[i].y)}; *(f32x4*)(d + 4) = (f32x4){lo2f(rg[i].z), hi2f(rg[i].z), lo2f(rg[i].w), hi2f(rg[i].w)}; }
        }
        __syncthreads();
    }
    {
        const float* yb = ybuf + ((NCH - 1) & 1) * CS * 32;
        const int st = t >> 4, r2 = (t & 15) * 2;
        *(f32x2_t*)(p.yraw + ((size_t)(b * NT_ + (NCH - 1) * CS + st)) * 512 + head * 64 + hf * 32 + r2) = *(const f32x2_t*)(yb + st * 32 + r2);
    }
    __builtin_amdgcn_s_setprio(0);
}

DI void attn_item(const Params& p, unsigned char* lds, const int item) {
    constexpr int KROW = 208, VROW = 136, KB = 64 * KROW, BUF = KB + 64 * VROW;
    const int t = threadIdx.x, lane = t & 63, w = t >> 6, l31 = lane & 31, h = lane >> 5;
    const int qt = 31 - item / 128, bh = item % 128;
    const bf16_t* Kg = p.Kb + (size_t)bh * NT_ * 96;
    const bf16_t* Vg = p.Vt + (size_t)bh * 64 * NT_;
    const int q = qt * 128 + w * 32 + l31;
    bf16x8 qf[6];
    {
        const bf16_t* qrow = p.Q + ((size_t)bh * NT_ + q) * 96 + 8 * h;
#pragma unroll
        for (int s = 0; s < 6; ++s) qf[s] = *(const bf16x8*)(qrow + 16 * s);
    }
    f32x16 O[2];
#pragma unroll
    for (int i = 0; i < 16; ++i) { O[0][i] = 0.f; O[1][i] = 0.f; }
    float m = -INFINITY, l = 0.f;
    const int njt = 2 * qt + 2;
    int koff[3], kgo[3], voff[2], vgo[2];
#pragma unroll
    for (int i = 0; i < 3; ++i) { const int c = t + 256 * i, r = c / 12, ch = c - r * 12; koff[i] = r * KROW + ch * 16; kgo[i] = r * 96 + ch * 8; }
#pragma unroll
    for (int i = 0; i < 2; ++i) { const int c = t + 256 * i, dv = c >> 3, ch = c & 7; voff[i] = KB + dv * VROW + ch * 16; vgo[i] = dv * NT_ + ch * 8; }
    u32x4 rk0[3], rv0[2], rk1[3], rv1[2];
#define AT_LOAD(RK, RV, J) { _Pragma("unroll") for (int i = 0; i < 3; ++i) RK[i] = *(const u32x4*)(Kg + (size_t)(J) * 64 * 96 + kgo[i]); \
                             _Pragma("unroll") for (int i = 0; i < 2; ++i) RV[i] = *(const u32x4*)(Vg + (J) * 64 + vgo[i]); }
#define AT_WRITE(RK, RV, BUFI) { unsigned char* nb = lds + (BUFI) * BUF; _Pragma("unroll") for (int i = 0; i < 3; ++i) *(u32x4*)(nb + koff[i]) = RK[i]; \
                             _Pragma("unroll") for (int i = 0; i < 2; ++i) { *(u32x2*)(nb + voff[i]) = mk2(RV[i].x, RV[i].y); *(u32x2*)(nb + voff[i] + 8) = mk2(RV[i].z, RV[i].w); } }
    auto tile_compute = [&](const int cur, const int j) {
        const bool active = (j * 64) <= (qt * 128 + w * 32 + 31);
        if (active) {
            const unsigned char* Kt = lds + cur * BUF;
            const unsigned char* Vtile = Kt + KB;
            f32x16 S[2];
#pragma unroll
            for (int k2 = 0; k2 < 2; ++k2) {
#pragma unroll
                for (int i = 0; i < 16; ++i) S[k2][i] = 0.f;
#pragma unroll
                for (int s = 0; s < 6; ++s) {
                    const bf16x8 kf = *(const bf16x8*)(Kt + (k2 * 32 + l31) * KROW + s * 32 + h * 16);
                    S[k2] = __builtin_amdgcn_mfma_f32_32x32x16_bf16(kf, qf[s], S[k2], 0, 0, 0);
                }
            }
            if (j >= 2 * qt) {
#pragma unroll
                for (int k2 = 0; k2 < 2; ++k2)
#pragma unroll
                    for (int i = 0; i < 16; ++i) { const int key = j * 64 + k2 * 32 + (i & 3) + 8 * (i >> 2) + 4 * h; if (key > q) S[k2][i] = -INFINITY; }
            }
            float mx = S[0][0];
#pragma unroll
            for (int i = 1; i < 16; ++i) mx = fmaxf(mx, S[0][i]);
#pragma unroll
            for (int i = 0; i < 16; ++i) mx = fmaxf(mx, S[1][i]);
            mx = fmaxf(mx, __shfl_xor(mx, 32));
            if (__any(mx > m)) {
                const float mn = fmaxf(m, mx);
                const float alpha = __builtin_amdgcn_exp2f(m - mn);
                m = mn; l *= alpha;
#pragma unroll
                for (int i = 0; i < 16; ++i) { O[0][i] *= alpha; O[1][i] *= alpha; }
            }
            f32x2_t ps2 = {0.f, 0.f};
#pragma unroll
            for (int k2 = 0; k2 < 2; ++k2)
#pragma unroll
                for (int i = 0; i < 16; i += 2) {
                    const float e0 = __builtin_amdgcn_exp2f(S[k2][i] - m), e1 = __builtin_amdgcn_exp2f(S[k2][i + 1] - m);
                    S[k2][i] = e0; S[k2][i + 1] = e1; ps2 += (f32x2_t){e0, e1};
                }
            l += ps2.x + ps2.y;
#pragma unroll
            for (int k2 = 0; k2 < 2; ++k2)
#pragma unroll
                for (int s2 = 0; s2 < 2; ++s2) {
                    unsigned pw[4];
#pragma unroll
                    for (int e = 0; e < 4; ++e) pw[e] = pk2(S[k2][8 * s2 + 2 * e], S[k2][8 * s2 + 2 * e + 1]);
                    const bf16x8 pf = __builtin_bit_cast(bf16x8, mk4(pw[0], pw[1], pw[2], pw[3]));
#pragma unroll
                    for (int dt = 0; dt < 2; ++dt) {
                        const unsigned char* vp = Vtile + (dt * 32 + l31) * VROW + (k2 * 32 + s2 * 16 + 4 * h) * 2;
                        const u32x2 v0 = *(const u32x2*)(vp), v1 = *(const u32x2*)(vp + 16);
                        const bf16x8 vf = __builtin_bit_cast(bf16x8, mk4(v0.x, v0.y, v1.x, v1.y));
                        O[dt] = __builtin_amdgcn_mfma_f32_32x32x16_bf16(vf, pf, O[dt], 0, 0, 0);
                    }
                }
        }
    };
    AT_LOAD(rk0, rv0, 0)
    if (njt > 1) AT_LOAD(rk1, rv1, 1)
    __syncthreads();
    AT_WRITE(rk0, rv0, 0)
    if (njt > 2) AT_LOAD(rk0, rv0, 2)
    __syncthreads();
#pragma unroll 1
    for (int j = 0; j < njt; j += 2) {
        tile_compute(0, j);
        if (j + 1 < njt) { AT_WRITE(rk1, rv1, 1) if (j + 3 < njt) AT_LOAD(rk1, rv1, j + 3) }
        __syncthreads();
        if (j + 1 >= njt) break;
        tile_compute(1, j + 1);
        if (j + 2 < njt) { AT_WRITE(rk0, rv0, 0) if (j + 4 < njt) AT_LOAD(rk0, rv0, j + 4) }
        __syncthreads();
    }
#undef AT_LOAD
#undef AT_WRITE
    l += __shfl_xor(l, 32);
    const float inv = 1.0f / l;
    bf16_t* yrow = p.Y + ((size_t)((bh >> 3) * NT_ + q)) * DM + 512 + (bh & 7) * 64;
#pragma unroll
    for (int dt = 0; dt < 2; ++dt)
#pragma unroll
        for (int g = 0; g < 4; ++g)
            *(u32x2*)(yrow + dt * 32 + 8 * g + 4 * h) = mk2(pk2(O[dt][4 * g] * inv, O[dt][4 * g + 1] * inv), pk2(O[dt][4 * g + 2] * inv, O[dt][4 * g + 3] * inv));
}

constexpr int REC_BYTES = 12544;
typedef short s16x4 __attribute__((ext_vector_type(4)));
DI f32x4 mfma16(const s16x4 a, const s16x4 b, const f32x4 c) { return __builtin_amdgcn_mfma_f32_16x16x16bf16_1k(a, b, c, 0, 0, 0); }
DI s16x4 cvt4(const f32x4 v) { return __builtin_bit_cast(s16x4, mk2(pk2(v[0], v[1]), pk2(v[2], v[3]))); }
DI void scan_fused(const Params& p, unsigned char* lds, const int bh) {
    int t = threadIdx.x; LAUNDER(t);
    const int lane = t & 63, w = t >> 6, r = lane & 15, g = lane >> 4;
    const int b = bh >> 3, head = bh & 7;
    unsigned char* slot = lds + w * REC_BYTES;
    unsigned char* scr = lds + 4 * REC_BYTES + w * 5120;
    float* AT = (float*)(scr + 4096);
    const bf16_t* scbase = p.SC + (size_t)bh * NT_ * 384;
    f32x4 St[4];
#pragma unroll
    for (int m = 0; m < 4; ++m) St[m] = (f32x4){0.f, 0.f, 0.f, 0.f};
    u32x4 raw[12];
    {
        const u32x4* src = (const u32x4*)(scbase + (size_t)w * 16 * 384);
#pragma unroll
        for (int i = 0; i < 12; ++i) raw[i] = src[lane + 64 * i];
    }
    const int offk = (lane >> 4) * 512 + ((lane >> 2) & 3) * 128 + (lane & 3) * 2;
    const int offt = (lane >> 4) * 512 + (lane & 15) * 8;
    __builtin_amdgcn_s_setprio(3);
    __syncthreads();
#pragma unroll 1
    for (int rd = 0; rd < 64; ++rd) {
#pragma unroll
        for (int i = 0; i < 12; ++i) *(u32x4*)(slot + (lane + 64 * i) * 16) = raw[i];
        if (rd + 1 < 64) {
            const u32x4* src = (const u32x4*)(scbase + (size_t)(4 * (rd + 1) + w) * 16 * 384);
#pragma unroll
            for (int i = 0; i < 12; ++i) raw[i] = src[lane + 64 * i];
        }
        {
            const bf16_t* rawl = (const bf16_t*)slot + lane;
            bf16_t vkap[16], vbet[16], vkt[16], vrt[16], vv[16];
            float L = 0.f, ex = 1.f;
#pragma unroll
            for (int j = 0; j < 16; ++j) {
                const float d = bf2f(rawl[j * 384]), kap = bf2f(rawl[j * 384 + 64]), bet = bf2f(rawl[j * 384 + 128]), kk = bf2f(rawl[j * 384 + 192]), rr = bf2f(rawl[j * 384 + 320]);
                vv[j] = rawl[j * 384 + 256];
                L += __logf(1.0f - d);
                const float el = __expf(L), ei = __expf(-L);
                vkap[j] = f2bf(kap * ex); vbet[j] = f2bf(bet * ei); vkt[j] = f2bf(kk * ei); vrt[j] = f2bf(rr * el);
                ex = el;
            }
            const float gam = ex;
#pragma unroll
            for (int j = 0; j < 16; ++j) {
                *(bf16_t*)(slot + offk + j * 8) = vkap[j];
                *(bf16_t*)(slot + 2048 + offk + j * 8) = vrt[j];
                *(bf16_t*)(slot + 4096 + offt + (j >> 2) * 128 + (j & 3) * 2) = vkt[j];
                *(bf16_t*)(slot + 6144 + offt + (j >> 2) * 128 + (j & 3) * 2) = (bf16_t)(vbet[j] ^ 0x8000u);
                *(bf16_t*)(scr + offk + j * 8) = vkt[j];
                *(bf16_t*)(scr + 2048 + offk + j * 8) = vbet[j];
            }
            unsigned vw[8];
#pragma unroll
            for (int i = 0; i < 8; ++i) vw[i] = (unsigned)vv[2 * i] | ((unsigned)vv[2 * i + 1] << 16);
            *(u32x4*)(slot + 10240 + lane * 32) = mk4(vw[0], vw[1], vw[2], vw[3]);
            *(u32x4*)(slot + 10240 + lane * 32 + 16) = mk4(vw[4], vw[5], vw[6], vw[7]);
            *(float*)(slot + 12288 + lane * 4) = gam;
        }
        {
            f32x4 dB = {0.f, 0.f, 0.f, 0.f}, dE = dB, dF = dB, dA = dB;
#pragma unroll
            for (int m = 0; m < 4; ++m) {
                const s16x4 fk = *(const s16x4*)(slot + m * 512 + lane * 8), fr = *(const s16x4*)(slot + 2048 + m * 512 + lane * 8);
                const s16x4 ft = *(const s16x4*)(scr + m * 512 + lane * 8), fb = *(const s16x4*)(scr + 2048 + m * 512 + lane * 8);
                dB = mfma16(ft, fk, dB); dE = mfma16(ft, fr, dE); dF = mfma16(fb, fr, dF); dA = mfma16(fb, fk, dA);
            }
            f32x4 oB, oE, oF;
#pragma unroll
            for (int jj = 0; jj < 4; ++jj) {
                const int i = 4 * g + jj;
                oB[jj] = i < r ? dB[jj] : 0.f; oE[jj] = i <= r ? dE[jj] : 0.f; oF[jj] = i <= r ? -dF[jj] : 0.f;
                AT[i * 16 + r] = i < r ? dA[jj] : 0.f;
            }
            *(s16x4*)(slot + 16 * 512 + lane * 8) = cvt4(oB);
            *(s16x4*)(slot + 18 * 512 + lane * 8) = cvt4(oE);
            *(s16x4*)(slot + 19 * 512 + lane * 8) = cvt4(oF);
            float T[16];
#pragma unroll
            for (int i = 15; i >= 0; --i) {
                float a0 = (i == r) ? 1.f : 0.f, a1 = 0.f;
#pragma unroll
                for (int q4 = (i + 1) >> 2; q4 < 4; ++q4) {
                    const f32x4 av = *(const f32x4*)(AT + i * 16 + q4 * 4);
#pragma unroll
                    for (int e = 0; e < 4; ++e) { const int m = q4 * 4 + e; if (m > i) { if (e & 1) a1 -= av[e] * T[m]; else a0 -= av[e] * T[m]; } }
                }
                T[i] = (i <= r) ? a0 + a1 : 0.f;
            }
            f32x4 oT;
#pragma unroll
            for (int jj = 0; jj < 4; ++jj) oT[jj] = g == 0 ? T[jj] : (g == 1 ? T[4 + jj] : (g == 2 ? T[8 + jj] : T[12 + jj]));
            *(s16x4*)(slot + 17 * 512 + lane * 8) = cvt4(oT);
        }
        __syncthreads();
#pragma unroll 1
        for (int cc = 0; cc < 4; ++cc) {
            const unsigned char* buf = lds + cc * REC_BYTES;
            s16x4 fr[20];
#pragma unroll
            for (int f = 0; f < 20; ++f) fr[f] = *(const s16x4*)(buf + f * 512 + lane * 8);
            const s16x4 vf = *(const s16x4*)(buf + 10240 + (16 * w + r) * 32 + g * 8);
            s16x4 sb[4];
#pragma unroll
            for (int m = 0; m < 4; ++m) sb[m] = cvt4(St[m]);
            f32x4 X = {0.f, 0.f, 0.f, 0.f}, Yv = X;
#pragma unroll
            for (int m = 0; m < 4; ++m) { X = mfma16(fr[m], sb[m], X); Yv = mfma16(fr[4 + m], sb[m], Yv); }
            X = mfma16(fr[16], vf, X); Yv = mfma16(fr[18], vf, Yv);
            const s16x4 xb = cvt4(X);
            const f32x4 P = mfma16(fr[17], xb, (f32x4){0.f, 0.f, 0.f, 0.f});
            const s16x4 pb = cvt4(P);
            Yv = mfma16(fr[19], pb, Yv);
#pragma unroll
            for (int m = 0; m < 4; ++m) {
                St[m] = mfma16(fr[8 + m], vf, St[m]);
                St[m] = mfma16(fr[12 + m], pb, St[m]);
                St[m] = St[m] * *(const f32x4*)(buf + 12288 + (16 * m + 4 * g) * 4);
            }
            float* yo = p.yraw + ((size_t)(b * NT_ + (4 * rd + cc) * 16 + 4 * g)) * 512 + head * 64 + 16 * w + r;
#pragma unroll
            for (int jj = 0; jj < 4; ++jj) yo[jj * 512] = Yv[jj];
        }
        __syncthreads();
    }
    __builtin_amdgcn_s_setprio(0);
}

DI void phase4(const Params& p, unsigned char* lds, int bid, int G) {
    int* sh_item = (int*)(lds + LDS_BYTES - 64);
#if SCAN_CHUNKED
    for (int bh = bid; bh < 128; bh += G) scan_fused(p, lds, bh);
#else
    for (int task = bid; task < 256; task += G) scan_task(p, lds, task);
#endif
    STAMP(10);
    for (;;) {
        __syncthreads();
        if (threadIdx.x == 0) *sh_item = (int)atomicAdd(&p.ctrl[CTRL_ATTNQ], 1u);
        __syncthreads();
        const int item = *sh_item;
        if (item >= 4096) break;
        attn_item(p, lds, item);
    }
}

DI void phase5(const Params& p, unsigned char* lds, int bid, int G) {
    const int t = threadIdx.x, lane = t & 63, wid = t >> 6, wr = wid >> 1, wc = wid & 1;
    float* tile = (float*)lds;
    float* ssq = (float*)(lds + 69632);
    float* biasl = ssq + 128;
    int* lcnt = (int*)(lds + 65536);
    int* lbase = lcnt + 256;
    unsigned char* le = (unsigned char*)(lbase + 256);
    unsigned char* lp = le + 1024;
    __syncthreads();
    biasl[t] = p.router_bias[t];
    float* scores = (float*)(p.bscr + (size_t)bid * BSCR_PER_BLOCK);
    bf16_t* act = (bf16_t*)(p.bscr + (size_t)bid * BSCR_PER_BLOCK + 131072);
    for (int rt = bid; rt < NTOK / 128; rt += G) {
        const int b = rt >> 5;
        const float* mod = p.mod + b * 6144;
        __syncthreads();
        if (t < 128) ssq[t] = 0.f;
        lcnt[t] = 0;
#pragma unroll 2
        for (int it = 0; it < 16; ++it) {
            int tl = t; LAUNDER(tl);
            const int pr = (tl >> 2) + 64 * it;
            const int row = pr >> 3, head = pr & 7, part = tl & 3, grow = rt * 128 + row, tt = grow & 4095;
            const int ch = head * 64 + part * 16;
            const float* yr = p.yraw + (size_t)grow * 512 + ch;
            float y[16];
#pragma unroll
            for (int i = 0; i < 4; ++i) { const f32x4 v = *(const f32x4*)(yr + 4 * i); y[4 * i] = v[0]; y[4 * i + 1] = v[1]; y[4 * i + 2] = v[2]; y[4 * i + 3] = v[3]; }
            float sm = 0.f;
#pragma unroll
            for (int i = 0; i < 16; ++i) sm += y[i];
            sm += __shfl_xor(sm, 1); sm += __shfl_xor(sm, 2);
            const float mean = sm * (1.0f / 64.0f);
            float vr = 0.f;
#pragma unroll
            for (int i = 0; i < 16; ++i) { const float d = y[i] - mean; vr += d * d; }
            vr += __shfl_xor(vr, 1); vr += __shfl_xor(vr, 2);
            const float rs = rsqrtf(vr * (1.0f / 64.0f) + 64e-5f);
            const bf16_t* sc = p.SC + ((size_t)(b * 8 + head) * NT_ + tt) * 384 + part * 16;
            float kp[16], vv[16], rr[16];
#pragma unroll
            for (int i = 0; i < 2; ++i) {
                const u32x4 a = *(const u32x4*)(sc + 192 + 8 * i), c = *(const u32x4*)(sc + 256 + 8 * i), d = *(const u32x4*)(sc + 320 + 8 * i);
                kp[8 * i] = lo2f(a.x); kp[8 * i + 1] = hi2f(a.x); kp[8 * i + 2] = lo2f(a.y); kp[8 * i + 3] = hi2f(a.y); kp[8 * i + 4] = lo2f(a.z); kp[8 * i + 5] = hi2f(a.z); kp[8 * i + 6] = lo2f(a.w); kp[8 * i + 7] = hi2f(a.w);
                vv[8 * i] = lo2f(c.x); vv[8 * i + 1] = hi2f(c.x); vv[8 * i + 2] = lo2f(c.y); vv[8 * i + 3] = hi2f(c.y); vv[8 * i + 4] = lo2f(c.z); vv[8 * i + 5] = hi2f(c.z); vv[8 * i + 6] = lo2f(c.w); vv[8 * i + 7] = hi2f(c.w);
                rr[8 * i] = lo2f(d.x); rr[8 * i + 1] = hi2f(d.x); rr[8 * i + 2] = lo2f(d.y); rr[8 * i + 3] = hi2f(d.y); rr[8 * i + 4] = lo2f(d.z); rr[8 * i + 5] = hi2f(d.z); rr[8 * i + 6] = lo2f(d.w); rr[8 * i + 7] = hi2f(d.w);
            }
            float bn = 0.f;
#pragma unroll
            for (int i = 0; i < 16; ++i) bn += rr[i] * kp[i] * p.r_k[ch + i];
            bn += __shfl_xor(bn, 1); bn += __shfl_xor(bn, 2);
            const bf16_t* gg = p.Gg + (size_t)grow * 512 + ch;
            const u32x4 g0 = *(const u32x4*)(gg), g1 = *(const u32x4*)(gg + 8);
            float g[16] = {lo2f(g0.x), hi2f(g0.x), lo2f(g0.y), hi2f(g0.y), lo2f(g0.z), hi2f(g0.z), lo2f(g0.w), hi2f(g0.w), lo2f(g1.x), hi2f(g1.x), lo2f(g1.y), hi2f(g1.y), lo2f(g1.z), hi2f(g1.z), lo2f(g1.w), hi2f(g1.w)};
            float o[16];
#pragma unroll
            for (int i = 0; i < 16; ++i) o[i] = ((y[i] - mean) * rs * p.ln_w[ch + i] + p.ln_b[ch + i] + bn * vv[i]) * g[i];
            bf16_t* yd = p.Y + (size_t)grow * DM + ch;
            *(u32x4*)(yd) = mk4(pk2(o[0], o[1]), pk2(o[2], o[3]), pk2(o[4], o[5]), pk2(o[6], o[7]));
            *(u32x4*)(yd + 8) = mk4(pk2(o[8], o[9]), pk2(o[10], o[11]), pk2(o[12], o[13]), pk2(o[14], o[15]));
        }
        asm volatile("s_waitcnt vmcnt(0)" ::: "memory");
        __syncthreads();
        STAMP(11);
        {
            APlain ap{p.Y + (size_t)rt * 128 * DM, DM};
            gemm_stream<4, 4, 2, 64, 4>(ap, p.wout_t, DM, DM, 8, [](int u, int& ao, int& bo) { ao = 0; bo = u * 128 * DM; },
                [&](const int ct, f32x4 (&acc)[4][4]) {
                    int ll = lane; LAUNDER(ll);
#pragma unroll
                    for (int i = 0; i < 4; ++i) {
                        const int row = wr * 64 + i * 16 + (ll & 15), grow = rt * 128 + row;
                        float sq = 0.f;
#pragma unroll
                        for (int j = 0; j < 4; ++j) {
                            const int col = ct * 128 + wc * 64 + j * 16 + (ll >> 4) * 4;
                            const f32x4 xv = *(const f32x4*)(p.x + (size_t)grow * DM + col), ga = *(const f32x4*)(mod + 2048 + col);
                            f32x4 o;
#pragma unroll
                            for (int e = 0; e < 4; ++e) { o[e] = xv[e] + ga[e] * acc[i][j][e]; sq += o[e] * o[e]; }
                            *(f32x4*)(p.out + (size_t)grow * DM + col) = o;
                        }
                        sq += __shfl_xor(sq, 16); sq += __shfl_xor(sq, 32);
                        if ((ll >> 4) == 0) atomicAdd(&ssq[row], sq);
                    }
                }, lds);
        }
        asm volatile("s_waitcnt vmcnt(0)" ::: "memory");
        __syncthreads();
        STAMP(12);
#pragma unroll 1
        for (int mg = 0; mg < 8; ++mg) {
            int ll = lane; LAUNDER(ll);
            f32x4 xv[4][4];
#pragma unroll
            for (int u = 0; u < 4; ++u)
#pragma unroll
                for (int i = 0; i < 4; ++i) xv[u][i] = *(const f32x4*)(p.out + (size_t)(rt * 128 + wid + 4 * (mg * 4 + u)) * DM + ll * 4 + 256 * i);
#pragma unroll
            for (int u = 0; u < 4; ++u) {
                const int r = wid + 4 * (mg * 4 + u), grow = rt * 128 + r;
                const float rs = rsqrtf(ssq[r] * (1.0f / DM) + 1e-6f);
#pragma unroll
                for (int i = 0; i < 4; ++i) {
                    const int c = ll * 4 + 256 * i;
                    const f32x4 g = *(const f32x4*)(p.norm_ffn + c), sh = *(const f32x4*)(mod + 3072 + c), sc = *(const f32x4*)(mod + 4096 + c);
                    float o[4];
#pragma unroll
                    for (int e = 0; e < 4; ++e) o[e] = xv[u][i][e] * rs * g[e] * (1.0f + sc[e]) + sh[e];
                    *(u32x2*)(p.H + (size_t)grow * DM + c) = mk2(pk2(o[0], o[1]), pk2(o[2], o[3]));
                }
            }
        }
        asm volatile("s_waitcnt vmcnt(0)" ::: "memory");
        __syncthreads();
        STAMP(13);
        {
            APlain ap{p.H + (size_t)rt * 128 * DM, DM};
            gemm_stream<4, 4, 2, 64, 4>(ap, p.wr_t, DM, DM, 2, [](int u, int& ao, int& bo) { ao = 0; bo = u * 128 * DM; },
                [&](const int ct, f32x4 (&acc)[4][4]) {
                    int ll = lane; LAUNDER(ll);
#pragma unroll
                    for (int i = 0; i < 4; ++i)
#pragma unroll
                        for (int j = 0; j < 4; ++j) {
                            const int row = wr * 64 + i * 16 + (ll & 15), col = ct * 128 + wc * 64 + j * 16 + (ll >> 4) * 4;
#pragma unroll
                            for (int e = 0; e < 4; ++e) scores[(col + e) * 128 + row] = sigmoidf_(acc[i][j][e]);
                        }
                }, lds);
        }
        asm volatile("s_waitcnt vmcnt(0)" ::: "memory");
        __syncthreads();
        STAMP(14);
#pragma unroll 1
        for (int hh = 0; hh < 2; ++hh) {
            __syncthreads();
            {
                int tl = t; LAUNDER(tl);
                f32x4 rgs[16];
#pragma unroll
                for (int i = 0; i < 16; ++i) { const int c = tl + 256 * i; rgs[i] = *(const f32x4*)(scores + (c >> 4) * 128 + hh * 64 + (c & 15) * 4); }
#pragma unroll
                for (int i = 0; i < 16; ++i) *(f32x4*)(tile + (tl + 256 * i) * 4) = rgs[i];
            }
            __syncthreads();
            if (t < 64) {
                int tl = t; LAUNDER(tl);
                const int token = rt * 128 + hh * 64 + tl;
                const float* sc = tile + tl;
                float gs[8];
#pragma unroll
                for (int g = 0; g < 8; ++g) {
                    float m1 = -INFINITY, m2 = -INFINITY;
#pragma unroll 8
                    for (int i = 0; i < 32; ++i) { const float v = sc[(g * 32 + i) * 64] + biasl[g * 32 + i]; m2 = fmaxf(m2, fminf(m1, v)); m1 = fmaxf(m1, v); }
                    gs[g] = m1 + m2;
                }
                unsigned selmask = 0u;
#pragma unroll
                for (int g = 0; g < 8; ++g) {
                    int rank = 0;
#pragma unroll
                    for (int g2 = 0; g2 < 8; ++g2) rank += (gs[g2] > gs[g] || (gs[g2] == gs[g] && g2 < g)) ? 1 : 0;
                    selmask |= (rank < 4 ? 1u : 0u) << g;
                }
                float tv[8]; int ti[8];
#pragma unroll
                for (int k = 0; k < 8; ++k) { tv[k] = -INFINITY; ti[k] = 0; }
#pragma unroll 1
                for (int g = 0; g < 8; ++g) {
                    if ((selmask >> g) & 1u) {
#pragma unroll 4
                        for (int i = 0; i < 32; ++i) {
                            const int e = g * 32 + i;
                            const float v = sc[e * 64] + biasl[e];
                            if (v > tv[7]) {
#pragma unroll
                                for (int k = 7; k >= 1; --k) {
                                    if (v > tv[k - 1]) { tv[k] = tv[k - 1]; ti[k] = ti[k - 1]; }
                                    else if (v > tv[k]) { tv[k] = v; ti[k] = e; }
                                }
                                if (v > tv[0]) { tv[0] = v; ti[0] = e; }
                            }
                        }
                    }
                }
                float ws[8], wsum = 0.f;
#pragma unroll
                for (int k = 0; k < 8; ++k) { ws[k] = sc[ti[k] * 64]; wsum += ws[k]; }
                const float sc25 = 2.5f / wsum;
#pragma unroll
                for (int k = 0; k < 8; ++k) {
                    p.topk_idx[token * 8 + k] = ti[k];
                    p.topk_w[token * 8 + k] = ws[k] * sc25;
                    le[(hh * 64 + tl) * 8 + k] = (unsigned char)ti[k];
                    lp[(hh * 64 + tl) * 8 + k] = (unsigned char)atomicAdd(&lcnt[ti[k]], 1);
                }
            }
        }
        __syncthreads();
        { const int c = lcnt[t]; lbase[t] = c > 0 ? (int)atomicAdd(&p.ctrl[CTRL_ECNT + t * ECNT_STRIDE], (unsigned)c) : 0; }
        __syncthreads();
#pragma unroll
        for (int i = 0; i < 4; ++i) {
            const int a = t + 256 * i, e = le[a];
            p.elist[(size_t)e * NTOK + lbase[e] + lp[a]] = (rt * 128) * 8 + a;
        }
        STAMP(15);
        {
            APlain ap{p.H + (size_t)rt * 128 * DM, DM};
            gemm_stream<4, 4, 2, 64, 4>(ap, p.wsgu_t, DM, DM, 4, [](int u, int& ao, int& bo) { ao = 0; bo = u * 128 * DM; },
                [&](const int ct, f32x4 (&acc)[4][4]) {
                    int ll = lane; LAUNDER(ll);
#pragma unroll
                    for (int i = 0; i < 4; ++i) {
                        bf16_t* d = act + (wr * 64 + i * 16 + (ll & 15)) * 256 + ct * 64 + wc * 32 + (ll >> 4) * 4;
#pragma unroll
                        for (int m = 0; m < 2; ++m) {
                            f32x4 o;
#pragma unroll
                            for (int e = 0; e < 4; ++e) { const float g = acc[i][2 * m][e]; o[e] = g * sigmoidf_(g) * acc[i][2 * m + 1][e]; }
                            *(u32x2*)(d + m * 16) = pack4(o);
                        }
                    }
                }, lds);
        }
        asm volatile("s_waitcnt vmcnt(0)" ::: "memory");
        __syncthreads();
        STAMP(16);
        {
            APlain ap{act, 256};
            gemm_stream<4, 4, 2, 64, 4>(ap, p.wsd_t, 256, 256, 8, [](int u, int& ao, int& bo) { ao = 0; bo = u * 128 * 256; },
                [&](const int ct, f32x4 (&acc)[4][4]) {
                    int ll = lane; LAUNDER(ll);
#pragma unroll
                    for (int i = 0; i < 4; ++i)
#pragma unroll
                        for (int j = 0; j < 4; ++j) {
                            const int row = wr * 64 + i * 16 + (ll & 15), grow = rt * 128 + row, col = ct * 128 + wc * 64 + j * 16 + (ll >> 4) * 4;
                            const f32x4 xv = *(const f32x4*)(p.out + (size_t)grow * DM + col), gf = *(const f32x4*)(mod + 5120 + col);
                            f32x4 o;
#pragma unroll
                            for (int e = 0; e < 4; ++e) o[e] = xv[e] + gf[e] * acc[i][j][e];
                            *(f32x4*)(p.out + (size_t)grow * DM + col) = o;
                        }
                }, lds);
        }
    }
}

DI void phase6(const Params& p, unsigned char* lds, int bid, int G) {
    const int t = threadIdx.x, lane = t & 63, wid = t >> 6, wr = wid >> 1, wc = wid & 1;
    float* tile = (float*)lds;
    int* cpre = (int*)(lds + 69632);
    int* rowtok = (int*)(lds + 69632 + 1056);
    int* rowslot = rowtok + 128;
    float* roww = (float*)(rowslot + 128);
    int* sh_it = (int*)(roww + 128);
    bf16_t* act = (bf16_t*)(p.bscr + (size_t)bid * BSCR_PER_BLOCK + 131072);
    (void)G;
    __syncthreads();
    rowtok[t] = ((int)p.ctrl[CTRL_ECNT + t * ECNT_STRIDE] + 127) >> 7;
    __syncthreads();
    if (t < 8) { int sacc = 0; for (int k = 0; k < 32; ++k) { cpre[t * 33 + k] = sacc; sacc += rowtok[8 * k + t]; } cpre[t * 33 + 32] = sacc; }
    __syncthreads();
    const int hq = (int)(xb_xcc_id() & 7u);
    int attempt = 0;
    for (;;) {
        const int qc = (hq + attempt) & 7;
        __syncthreads();
        if (t == 0) sh_it[0] = (int)atomicAdd(&p.ctrl[CTRL_Q6 + qc * 64], 1u);
        __syncthreads();
        const int idx = sh_it[0];
        if (idx >= cpre[qc * 33 + 32]) { if (++attempt >= 8) break; continue; }
        int lo = 0, hi = 31;
        while (lo < hi) { const int mid = (lo + hi + 1) >> 1; if (cpre[qc * 33 + mid] <= idx) lo = mid; else hi = mid - 1; }
        const int e = 8 * lo + qc, tl = idx - cpre[qc * 33 + lo], cnt = (int)p.ctrl[CTRL_ECNT + e * ECNT_STRIDE];
        __syncthreads();
        if (t < 128) {
            const int r = tl * 128 + t;
            if (r < cnt) { const int ts = p.elist[(size_t)e * NTOK + r]; rowtok[t] = ts >> 3; rowslot[t] = ts; roww[t] = p.topk_w[ts]; }
            else { rowtok[t] = 0; rowslot[t] = -1; roww[t] = 0.f; }
        }
        __syncthreads();
        {
            AGather ap{p.H, rowtok};
            gemm_stream<4, 8, 2, 32, 8>(ap, p.wegu_t + (size_t)e * 512 * DM, DM, DM, 2, [](int u, int& ao, int& bo) { ao = 0; bo = u * 256 * DM; },
                [&](const int ct, f32x4 (&acc)[4][8]) {
                    int ll = lane; LAUNDER(ll);
#pragma unroll
                    for (int i = 0; i < 4; ++i) {
                        bf16_t* d = act + (wr * 64 + i * 16 + (ll & 15)) * 256 + ct * 128 + wc * 64 + (ll >> 4) * 4;
#pragma unroll
                        for (int m = 0; m < 4; ++m) {
                            f32x4 o;
#pragma unroll
                            for (int ee = 0; ee < 4; ++ee) { const float g = acc[i][2 * m][ee]; o[ee] = g * sigmoidf_(g) * acc[i][2 * m + 1][ee]; }
                            *(u32x2*)(d + m * 16) = pack4(o);
                        }
                    }
                }, lds);
        }
        asm volatile("s_waitcnt vmcnt(0)" ::: "memory");
        __syncthreads();
        {
            APlain ap{act, 256};
            gemm_stream<4, 4, 2, 64, 4>(ap, p.wed_t + (size_t)e * 1024 * 256, 256, 256, 8, [](int u, int& ao, int& bo) { ao = 0; bo = u * 128 * 256; },
                [&](const int ct, f32x4 (&acc)[4][4]) {
                    int ll = lane; LAUNDER(ll);
#pragma unroll
                    for (int i = 0; i < 4; ++i) {
                        const int row = wr * 64 + i * 16 + (ll & 15), srow = rowslot[row];
                        const float ww = roww[row];
                        if (srow >= 0) {
#pragma unroll
                            for (int j = 0; j < 4; ++j) {
                                const int col = ct * 128 + wc * 64 + j * 16 + (ll >> 4) * 4;
                                *(u32x2*)(p.slot + (size_t)srow * DM + col) = pack4(acc[i][j] * ww);
                            }
                        }
                    }
                }, lds);
        }
    }
}

DI void phase7(const Params& p, int bid, int G) {
    const int lane = threadIdx.x & 63, gw = bid * 4 + (threadIdx.x >> 6), nw = G * 4;
    for (int row = gw; row < NTOK; row += nw) {
        const float* mod = p.mod + (row >> 12) * 6144 + 5120;
#pragma unroll
        for (int i = 0; i < 4; ++i) {
            const int c = lane * 4 + 256 * i;
            float s[4] = {0.f, 0.f, 0.f, 0.f};
#pragma unroll
            for (int k = 0; k < 8; ++k) { const u32x2 w = *(const u32x2*)(p.slot + ((size_t)row * 8 + k) * DM + c); s[0] += lo2f(w.x); s[1] += hi2f(w.x); s[2] += lo2f(w.y); s[3] += hi2f(w.y); }
            const f32x4 gf = *(const f32x4*)(mod + c);
            f32x4 o = *(const f32x4*)(p.out + (size_t)row * DM + c);
#pragma unroll
            for (int e = 0; e < 4; ++e) o[e] += gf[e] * s[e];
            *(f32x4*)(p.out + (size_t)row * DM + c) = o;
        }
    }
}

extern __shared__ __attribute__((aligned(16))) unsigned char smem[];

template <int PH> DI void run_phase(const Params& p, unsigned char* lds, int bid, int G) {
    if (PH == 0) phase0(p, lds, bid, G);
    if (PH == 1) phase1(p, bid, G);
    if (PH == 2) phase2(p, lds, bid, G);
    if (PH == 3) phase3(p, lds, bid, G);
    if (PH == 4) phase4(p, lds, bid, G);
    if (PH == 5) phase5(p, lds, bid, G);
    if (PH == 6) phase6(p, lds, bid, G);
    if (PH == 7) phase7(p, bid, G);
}

#if !ONE_LAUNCH
template <int PH> __global__ void __launch_bounds__(256, 2) phase_kernel(Params p) { run_phase<PH>(p, smem, blockIdx.x, gridDim.x); }
#endif

#if ONE_LAUNCH
__global__ void __launch_bounds__(256, 2) mega_kernel(Params p) {
    volatile LAS unsigned* st = (volatile LAS unsigned*)(smem + LDS_BYTES - 16);
    if (threadIdx.x == 0) { st[0] = 0u; st[1] = 0u; st[2] = 0u; st[3] = 0u; }
    __syncthreads();
    XcdBarrier bar = xcd_barrier_post(p.ctrl, st);
    const int bid = blockIdx.x, G = gridDim.x;
    STAMP(0);
    run_phase<0>(p, smem, bid, G); xcd_barrier(bar); STAMP(1);
    run_phase<1>(p, smem, bid, G); xcd_barrier(bar); STAMP(2);
    run_phase<2>(p, smem, bid, G); xcd_barrier(bar); STAMP(3);
    run_phase<3>(p, smem, bid, G); xcd_barrier(bar); STAMP(4);
    run_phase<4>(p, smem, bid, G); xcd_barrier(bar); STAMP(5);
    run_phase<5>(p, smem, bid, G); xcd_barrier(bar); STAMP(6);
    run_phase<6>(p, smem, bid, G); xcd_barrier(bar); STAMP(7);
    run_phase<7>(p, smem, bid, G);
#ifdef PROBE_A
    xcd_barrier(bar); STAMP(8);
    xcd_barrier(bar);
    {
        const unsigned long long* sp = (const unsigned long long*)(p.ctrl + CTRL_STAMP);
        const unsigned long long ta = __hip_atomic_load(sp + PROBE_A, __ATOMIC_RELAXED, __HIP_MEMORY_SCOPE_AGENT), tb = __hip_atomic_load(sp + PROBE_B, __ATOMIC_RELAXED, __HIP_MEMORY_SCOPE_AGENT);
        const unsigned long long t0 = __builtin_amdgcn_s_memrealtime();
        while (__builtin_amdgcn_s_memrealtime() - t0 < tb - ta) __builtin_amdgcn_s_sleep(8);
    }
#endif
}
#define OCC_KERNEL mega_kernel
#else
#define OCC_KERNEL phase_kernel<5>
#endif

static inline size_t al256(size_t x) { return (x + 255) & ~(size_t)255; }

extern "C" void kernel_launch(void* const* d_in, const int* in_sizes, int n_in, void* d_out, int out_size, void* d_ws, size_t ws_size, hipStream_t stream) {
    (void)in_sizes; (void)n_in; (void)out_size;
    Params p{};
    p.x = (const float*)d_in[0]; p.c = (const float*)d_in[1]; p.positions = (const int*)d_in[2]; p.ada_w = (const float*)d_in[3]; p.ada_b = (const float*)d_in[4];
    p.norm_mix = (const float*)d_in[5]; p.w_in = (const float*)d_in[6]; p.rwkv_mu = (const float*)d_in[7]; p.decay_w0 = (const float*)d_in[8]; p.decay_up = (const float*)d_in[9];
    p.iclr_a0 = (const float*)d_in[10]; p.iclr_up = (const float*)d_in[11]; p.gate_up = (const float*)d_in[12]; p.k_k = (const float*)d_in[13]; p.k_a = (const float*)d_in[14];
    p.r_k = (const float*)d_in[15]; p.ln_w = (const float*)d_in[16]; p.ln_b = (const float*)d_in[17]; p.q_a_norm = (const float*)d_in[18]; p.w_q_b = (const float*)d_in[19];
    p.kv_a_norm = (const float*)d_in[20]; p.w_kv_b = (const float*)d_in[21]; p.q_norm = (const float*)d_in[22]; p.k_norm = (const float*)d_in[23]; p.w_out = (const float*)d_in[24];
    p.norm_ffn = (const float*)d_in[25]; p.w_router = (const float*)d_in[26]; p.router_bias = (const float*)d_in[27]; p.w_e_gu = (const float*)d_in[28]; p.w_e_d = (const float*)d_in[29];
    p.w_sh_gu = (const float*)d_in[30]; p.w_sh_d = (const float*)d_in[31];
    p.out = (float*)d_out;

    static int grid = 0;
    if (!grid) {
        int dev = 0, cus = 0, per_cu = 0;
        (void)hipGetDevice(&dev);
        (void)hipDeviceGetAttribute(&cus, hipDeviceAttributeMultiprocessorCount, dev);
#if ONE_LAUNCH
        (void)hipFuncSetAttribute((const void*)mega_kernel, hipFuncAttributeMaxDynamicSharedMemorySize, LDS_BYTES);
#endif
#if !ONE_LAUNCH
        (void)hipFuncSetAttribute((const void*)phase_kernel<0>, hipFuncAttributeMaxDynamicSharedMemorySize, LDS_BYTES);
#endif
#if !ONE_LAUNCH
        (void)hipFuncSetAttribute((const void*)phase_kernel<1>, hipFuncAttributeMaxDynamicSharedMemorySize, LDS_BYTES);
#endif
#if !ONE_LAUNCH
        (void)hipFuncSetAttribute((const void*)phase_kernel<2>, hipFuncAttributeMaxDynamicSharedMemorySize, LDS_BYTES);
#endif
#if !ONE_LAUNCH
        (void)hipFuncSetAttribute((const void*)phase_kernel<3>, hipFuncAttributeMaxDynamicSharedMemorySize, LDS_BYTES);
#endif
#if !ONE_LAUNCH
        (void)hipFuncSetAttribute((const void*)phase_kernel<4>, hipFuncAttributeMaxDynamicSharedMemorySize, LDS_BYTES);
#endif
#if !ONE_LAUNCH
        (void)hipFuncSetAttribute((const void*)phase_kernel<5>, hipFuncAttributeMaxDynamicSharedMemorySize, LDS_BYTES);
#endif
#if !ONE_LAUNCH
        (void)hipFuncSetAttribute((const void*)phase_kernel<6>, hipFuncAttributeMaxDynamicSharedMemorySize, LDS_BYTES);
#endif
#if !ONE_LAUNCH
        (void)hipFuncSetAttribute((const void*)phase_kernel<7>, hipFuncAttributeMaxDynamicSharedMemorySize, LDS_BYTES);
#endif
        (void)hipOccupancyMaxActiveBlocksPerMultiprocessor(&per_cu, (const void*)OCC_KERNEL, 256, LDS_BYTES);
        if (cus <= 0) cus = 256;
        if (per_cu < 1) per_cu = 1;
        grid = cus * (per_cu < 2 ? per_cu : 2);
    }
    unsigned char* w = (unsigned char*)d_ws; size_t o = 0;
    auto take = [&](size_t bytes) { unsigned char* r = w + o; o = al256(o + bytes); return r; };
    p.ctrl = (unsigned*)take(CTRL_WORDS * 4);
    p.mod = (float*)take((size_t)NB * 6144 * 4);
    p.rope = (float*)take((size_t)NTOK * 32 * 4);
    p.win_t = (bf16_t*)take((size_t)LDU * 1024 * 2);
    p.wq_t = (bf16_t*)take((size_t)768 * 256 * 2);
    p.wkv_t = (bf16_t*)take((size_t)1024 * 128 * 2);
    p.wdec_t = (bf16_t*)take((size_t)512 * 32 * 2);
    p.wiclr_t = (bf16_t*)take((size_t)512 * 32 * 2);
    p.wgate_t = (bf16_t*)take((size_t)512 * 96 * 2);
    p.wout_t = (bf16_t*)take((size_t)1024 * 1024 * 2);
    p.wr_t = (bf16_t*)take((size_t)256 * 1024 * 2);
    p.wsgu_t = (bf16_t*)take((size_t)512 * 1024 * 2);
    p.wsd_t = (bf16_t*)take((size_t)1024 * 256 * 2);
    p.wegu_t = (bf16_t*)take((size_t)NEXP * 512 * 1024 * 2);
    p.wed_t = (bf16_t*)take((size_t)NEXP * 1024 * 256 * 2);
    p.H = (bf16_t*)take((size_t)NTOK * DM * 2);
    p.topk_idx = (int*)take((size_t)NTOK * 8 * 4);
    p.topk_w = (float*)take((size_t)NTOK * 8 * 4);
    p.elist = (int*)take((size_t)NEXP * NTOK * 4);
    p.bscr = take((size_t)grid * BSCR_PER_BLOCK);
    const size_t ov = o;
    p.U = (bf16_t*)take((size_t)NTOK * LDU * 2);
    p.Q = (bf16_t*)take((size_t)NTOK * 8 * 96 * 2);
    p.Kb = (bf16_t*)take((size_t)NTOK * 8 * 96 * 2);
    p.Vt = (bf16_t*)take((size_t)NTOK * 8 * 64 * 2);
    p.SC = (bf16_t*)take((size_t)NTOK * 8 * 384 * 2);
    p.Gg = (bf16_t*)take((size_t)NTOK * 512 * 2);
    p.yraw = (float*)take((size_t)NTOK * 512 * 4);
    p.Y = (bf16_t*)take((size_t)NTOK * DM * 2);
    p.slot = (bf16_t*)(w + ov);
    const size_t need_slot = ov + (size_t)NTOK * 8 * DM * 2;
    if (o > ws_size || need_slot > ws_size) { fprintf(stderr, "workspace too small: need %zu / %zu, have %zu\n", o, need_slot, ws_size); return; }

    (void)hipMemsetAsync(p.ctrl, 0, CTRL_WORDS * 4, stream);
#if ONE_LAUNCH
    hipLaunchKernelGGL(mega_kernel, dim3(grid), dim3(256), LDS_BYTES, stream, p);
#else
    hipLaunchKernelGGL(phase_kernel<0>, dim3(grid), dim3(256), LDS_BYTES, stream, p);
    hipLaunchKernelGGL(phase_kernel<1>, dim3(grid), dim3(256), LDS_BYTES, stream, p);
    hipLaunchKernelGGL(phase_kernel<2>, dim3(grid), dim3(256), LDS_BYTES, stream, p);
    hipLaunchKernelGGL(phase_kernel<3>, dim3(grid), dim3(256), LDS_BYTES, stream, p);
    hipLaunchKernelGGL(phase_kernel<4>, dim3(grid), dim3(256), LDS_BYTES, stream, p);
    hipLaunchKernelGGL(phase_kernel<5>, dim3(grid), dim3(256), LDS_BYTES, stream, p);
    hipLaunchKernelGGL(phase_kernel<6>, dim3(grid), dim3(256), LDS_BYTES, stream, p);
    hipLaunchKernelGGL(phase_kernel<7>, dim3(grid), dim3(256), LDS_BYTES, stream, p);
#endif
}
```

```cpp
#include <hip/hip_runtime.h>
#include <stdint.h>
#include <stdio.h>
#define DI __device__ __forceinline__

#ifndef SCAN_CHUNKED
#define SCAN_CHUNKED 1
#endif
#ifndef ONE_LAUNCH
#define ONE_LAUNCH 1
#endif

typedef unsigned short bf16_t;
typedef short bf16x8 __attribute__((ext_vector_type(8)));
typedef float f32x4 __attribute__((ext_vector_type(4)));
typedef float f32x16 __attribute__((ext_vector_type(16)));
typedef float f32x2_t __attribute__((ext_vector_type(2)));
typedef unsigned u32x4 __attribute__((ext_vector_type(4)));
typedef unsigned u32x2 __attribute__((ext_vector_type(2)));
#define LAUNDER(v) asm volatile("" : "+v"(v))
DI u32x4 mk4(unsigned a, unsigned b, unsigned c, unsigned d) { return (u32x4){a, b, c, d}; }
DI u32x2 mk2(unsigned a, unsigned b) { return (u32x2){a, b}; }

typedef __bf16 bf16x2_t __attribute__((ext_vector_type(2)));

constexpr int NB = 16, NT_ = 4096, DM = 1024, NTOK = NB * NT_;
constexpr int LDU = 2304;
constexpr int UQ = 0, UKV = 256, UR = 384, UK = 896, UV = 1408, UXW = 1920, UXA = 1952, UXG = 1984, UPE = 2080;
constexpr int NEXP = 256, TOPK = 8;
constexpr int LDS_BYTES = 73728;
__device__ __forceinline__ int tid_fresh() { int x = (int)(threadIdx.x & 255u); asm volatile("" : "+v"(x)); return x; }
__device__ __forceinline__ int half_fresh() { int x = (int)(threadIdx.x >> 8); asm volatile("" : "+v"(x)); return __builtin_amdgcn_readfirstlane(x); }
#define TID tid_fresh()
#define HALF_ID half_fresh()
extern __shared__ __attribute__((aligned(16))) unsigned char smem[];
constexpr int SH_PAIR_OFF = 2 * LDS_BYTES + 16;
constexpr float QSCALE = 0.14724444f;

#define XB_TMO      128
#define XB_XCNT(j)  (256  + 64 * (j))
#define XB_XSUB(j)  (1280 + 64 * (j))
#define XB_XGEN(j)  (2304 + 64 * (j))
#define XB_TOP      3328
#define XB_TOPGEN   3392
#define XCD_BAR_WORDS 3456
#define XB_SPIN_CAP (1u << 22)
#define LAS __attribute__((address_space(3)))
constexpr int CTRL_ATTNQ = 4096, CTRL_ECNT = 8192, ECNT_STRIDE = 64, CTRL_WORDS = 24576;
constexpr int CTRL_STAMP = 4160;
constexpr int CTRL_Q6 = 4608;
#ifdef PROBE_A
#define STAMP(id) do { if (blockIdx.x == 0 && threadIdx.x == 0) __hip_atomic_store((unsigned long long*)(p.ctrl + CTRL_STAMP) + (id), (unsigned long long)__builtin_amdgcn_s_memrealtime(), __ATOMIC_RELAXED, __HIP_MEMORY_SCOPE_AGENT); } while (0)
#else
#define STAMP(id)
#endif

DI unsigned xb_ld(unsigned* p)              { return __hip_atomic_load(p, __ATOMIC_RELAXED, __HIP_MEMORY_SCOPE_AGENT); }
DI unsigned xb_add(unsigned* p, unsigned v) { return __hip_atomic_fetch_add(p, v, __ATOMIC_RELAXED, __HIP_MEMORY_SCOPE_AGENT); }
DI unsigned xb_xcc_id() { return (unsigned)__builtin_amdgcn_s_getreg((3 << 11) | 20) & 0xFu; }
#define XB_SPIN(cond, bar) do { unsigned _sp = 0; while (cond) { __builtin_amdgcn_s_sleep(1); \
    if ((++_sp & 255u) == 0u) { if (xb_ld(&(bar)[XB_TMO])) break; if (_sp > XB_SPIN_CAP) { atomicAdd(&(bar)[XB_TMO], 1u); break; } } } } while (0)

struct XcdBarrier { unsigned* bar; unsigned x; volatile LAS unsigned* st; };

DI XcdBarrier xcd_barrier_post(unsigned* bar, volatile LAS unsigned* st) {
    XcdBarrier b; b.bar = bar; b.x = xb_xcc_id(); b.st = st;
    if (threadIdx.x == 0) (void)xb_add(&bar[XB_XCNT(b.x)], 1u);
    return b;
}
DI void xcd_barrier_complete(unsigned* bar, unsigned x, unsigned& nloc, unsigned& nx) {
    const unsigned G = gridDim.x * gridDim.y * gridDim.z;
    unsigned sum, cnt, mine, sp = 0u;
    for (;;) {
        sum = 0u; cnt = 0u; mine = 0u;
#pragma unroll
        for (unsigned j = 0; j < 16; ++j) { const unsigned c = xb_ld(&bar[XB_XCNT(j)]); sum += c; cnt += (c > 0u) ? 1u : 0u; mine = (j == x) ? c : mine; }
        if (sum == G) break;
        __builtin_amdgcn_s_sleep(1);
        if ((++sp & 255u) == 0u) { if (xb_ld(&bar[XB_TMO])) break; if (sp > XB_SPIN_CAP) { atomicAdd(&bar[XB_TMO], 1u); break; } }
    }
    nloc = mine > 0u ? mine : 1u; nx = cnt > 0u ? cnt : 1u;
}
DI void xcd_barrier(const XcdBarrier& b) {
    asm volatile("s_waitcnt vmcnt(0)" ::: "memory");
    __syncthreads();
    if (threadIdx.x == 0) {
        unsigned* bar = b.bar;
        __builtin_amdgcn_s_waitcnt(0);
        unsigned nloc = b.st[0], nx = b.st[1];
        if (nloc == 0u) { xcd_barrier_complete(bar, b.x, nloc, nx); b.st[0] = nloc; b.st[1] = nx; }
        const unsigned old = xb_add(&bar[XB_XSUB(b.x)], 1u);
        const unsigned gen = old / nloc;
        if (old + 1u == (gen + 1u) * nloc) {
            __builtin_amdgcn_fence(__ATOMIC_RELEASE, "agent");
            asm volatile("s_waitcnt vmcnt(0)" ::: "memory");
            const unsigned og = xb_add(&bar[XB_TOP], 1u);
            const unsigned tg = og / nx;
            if (og + 1u == (tg + 1u) * nx) xb_add(&bar[XB_TOPGEN], 1u);
            else XB_SPIN(xb_ld(&bar[XB_TOPGEN]) == tg, bar);
            __builtin_amdgcn_fence(__ATOMIC_ACQUIRE, "agent");
            xb_add(&bar[XB_XGEN(b.x)], 1u);
            asm volatile("s_waitcnt vmcnt(0)" ::: "memory");
        } else {
            XB_SPIN(xb_ld(&bar[XB_XGEN(b.x)]) == gen, bar);
            __builtin_amdgcn_fence(__ATOMIC_ACQUIRE, "agent");
            asm volatile("s_waitcnt vmcnt(0)" ::: "memory");
        }
    }
    __syncthreads();
}

struct Params {
    const float* x; const float* c; const int* positions; const float* ada_w; const float* ada_b; const float* norm_mix; const float* w_in;
    const float* rwkv_mu; const float* decay_w0; const float* decay_up; const float* iclr_a0; const float* iclr_up; const float* gate_up;
    const float* k_k; const float* k_a; const float* r_k; const float* ln_w; const float* ln_b;
    const float* q_a_norm; const float* w_q_b; const float* kv_a_norm; const float* w_kv_b; const float* q_norm; const float* k_norm;
    const float* w_out; const float* norm_ffn; const float* w_router; const float* router_bias;
    const float* w_e_gu; const float* w_e_d; const float* w_sh_gu; const float* w_sh_d;
    float* out;
    unsigned* ctrl; float* mod; float* rope;
    bf16_t* win_t; bf16_t* wq_t; bf16_t* wkv_t; bf16_t* wdec_t; bf16_t* wiclr_t; bf16_t* wgate_t; bf16_t* wout_t; bf16_t* wr_t; bf16_t* wsgu_t; bf16_t* wsd_t;
    bf16_t* wegu_t; bf16_t* wed_t;
    bf16_t* H; int* topk_idx; float* topk_w; int* elist; unsigned char* bscr;
    bf16_t* U; bf16_t* Q; bf16_t* Kb; bf16_t* Vt; bf16_t* SC; bf16_t* Gg; float* yraw; bf16_t* Y; bf16_t* slot;
};
constexpr size_t BSCR_PER_BLOCK = 196608;

DI float bf2f(bf16_t v) { return __uint_as_float(((unsigned)v) << 16); }
DI unsigned pk2(float a, float b) { f32x2_t f = {a, b}; bf16x2_t r = __builtin_convertvector(f, bf16x2_t); return __builtin_bit_cast(unsigned, r); }
DI bf16_t f2bf(float a) { return (bf16_t)(pk2(a, 0.f) & 0xffffu); }
DI float lo2f(unsigned w) { return __uint_as_float(w << 16); }
DI float hi2f(unsigned w) { return __uint_as_float(w & 0xffff0000u); }
DI float sigmoidf_(float x) { return 1.0f / (1.0f + __expf(-x)); }
DI float wave_sum(float v) {
#pragma unroll
    for (int o = 32; o > 0; o >>= 1) v += __shfl_xor(v, o);
    return v;
}
DI float dpp_sum8(float s) {
    s += __builtin_bit_cast(float, __builtin_amdgcn_update_dpp(0, __builtin_bit_cast(int, s), 0xB1, 0xf, 0xf, true));
    s += __builtin_bit_cast(float, __builtin_amdgcn_update_dpp(0, __builtin_bit_cast(int, s), 0x4E, 0xf, 0xf, true));
    s += __builtin_bit_cast(float, __builtin_amdgcn_update_dpp(0, __builtin_bit_cast(int, s), 0x141, 0xf, 0xf, true));
    return s;
}

struct APlain { const bf16_t* base; int ld; DI const bf16_t* row(int r) const { return base + (size_t)r * ld; } };
struct AGather { const bf16_t* base; const int* idx; DI const bf16_t* row(int r) const { return base + (size_t)idx[r] * DM; } };

template <int MT, int NT, int WR, int BK, int NSWAP, class AP>
DI void gemm_tile(const AP ap, const bf16_t* __restrict__ Bt, const int ldb, const int K, f32x4 (&acc)[MT][NT], unsigned char* lds) {
    constexpr int WC = 4 / WR, CPR = BK / 8, RB = BK * 2, R256 = 256 / RB, BN = WC * NT * 16;
    static_assert(WR * MT * 16 == 128, "tile is 128 rows");
    constexpr int A_BYTES = 128 * RB, B_BYTES = BN * RB;
    constexpr int A_CH = (128 * CPR) / 256, B_TOT = BN * CPR, B_CH = (B_TOT + 255) / 256, RSTEP = 256 / CPR;
    int t = TID; LAUNDER(t);
    const int lane = t & 63, wid = t >> 6, wr = wid / WC, wc = wid % WC;
    const int ch = t % CPR, r0 = t / CPR;
    const bf16_t* pa[A_CH]; const bf16_t* pb[B_CH]; int offa[A_CH], offb[B_CH]; bool vb[B_CH];
#pragma unroll
    for (int i = 0; i < A_CH; ++i) { const int row = r0 + i * RSTEP; pa[i] = ap.row(row) + ch * 8; offa[i] = row * RB + ((ch ^ ((row / R256) & (CPR - 1))) << 4); }
#pragma unroll
    for (int i = 0; i < B_CH; ++i) { const int row = r0 + i * RSTEP; vb[i] = (B_TOT % 256 == 0) || (row < BN); const int rr = vb[i] ? row : 0; pb[i] = Bt + (size_t)rr * ldb + ch * 8; offb[i] = 2 * A_BYTES + rr * RB + ((ch ^ ((rr / R256) & (CPR - 1))) << 4); }
#pragma unroll
    for (int i = 0; i < MT; ++i)
#pragma unroll
        for (int j = 0; j < NT; ++j) acc[i][j] = (f32x4){0.f, 0.f, 0.f, 0.f};
    const int KT = K / BK;
    u32x4 ra0[A_CH], rb0[B_CH], ra1[A_CH], rb1[B_CH];
#define G_LOAD(RA, RB, KTI) { _Pragma("unroll") for (int i = 0; i < A_CH; ++i) RA[i] = *(const u32x4*)(pa[i] + (KTI) * BK); \
                              _Pragma("unroll") for (int i = 0; i < B_CH; ++i) RB[i] = *(const u32x4*)(pb[i] + (KTI) * BK); }
#define G_WRITE(RA, RB, BUF) { _Pragma("unroll") for (int i = 0; i < A_CH; ++i) *(u32x4*)(lds + (BUF) * A_BYTES + offa[i]) = RA[i]; \
                               _Pragma("unroll") for (int i = 0; i < B_CH; ++i) if (vb[i]) *(u32x4*)(lds + (BUF) * B_BYTES + offb[i]) = RB[i]; }
#define G_COMPUTE(BUF) { const unsigned char* Ab = lds + (BUF) * A_BYTES + arow; const unsigned char* Bb = lds + 2 * A_BYTES + (BUF) * B_BYTES + brow; \
        _Pragma("unroll") for (int ks = 0; ks < BK / 32; ++ks) { const int co = ((ks * 4 + (lane >> 4)) ^ sw) << 4; bf16x8 af[MT], bfr[NT]; \
            _Pragma("unroll") for (int i = 0; i < MT; ++i) af[i] = *(const bf16x8*)(Ab + i * 16 * RB + co); \
            _Pragma("unroll") for (int j = 0; j < NT; ++j) bfr[j] = *(const bf16x8*)(Bb + j * 16 * RB + co); \
            _Pragma("unroll") for (int i = 0; i < MT; ++i) _Pragma("unroll") for (int j = 0; j < NT; ++j) \
                acc[i][j] = (j < NSWAP) ? __builtin_amdgcn_mfma_f32_16x16x32_bf16(bfr[j], af[i], acc[i][j], 0, 0, 0) \
                                        : __builtin_amdgcn_mfma_f32_16x16x32_bf16(af[i], bfr[j], acc[i][j], 0, 0, 0); } }
    const int sw = ((lane & 15) / R256) & (CPR - 1);
    const int arow = (wr * MT * 16 + (lane & 15)) * RB, brow = (wc * NT * 16 + (lane & 15)) * RB;
    G_LOAD(ra0, rb0, 0)
    if (KT > 1) G_LOAD(ra1, rb1, 1)
    __syncthreads();
    G_WRITE(ra0, rb0, 0)
    if (KT > 2) G_LOAD(ra0, rb0, 2)
    __syncthreads();
    for (int kt = 0; kt < KT; kt += 2) {
        G_COMPUTE(0)
        if (kt + 1 < KT) { G_WRITE(ra1, rb1, 1) if (kt + 3 < KT) G_LOAD(ra1, rb1, kt + 3) }
        __syncthreads();
        if (kt + 1 >= KT) break;
        G_COMPUTE(1)
        if (kt + 2 < KT) { G_WRITE(ra0, rb0, 0) if (kt + 4 < KT) G_LOAD(ra0, rb0, kt + 4) }
        __syncthreads();
    }
#undef G_LOAD
#undef G_WRITE
#undef G_COMPUTE
}
template <int MT, int NT, int WR, int BK, int NSWAP, class AP, class UF, class EPI>
DI void gemm_stream(const AP ap, const bf16_t* __restrict__ Bt, const int ldb, const int K, const int nunits, const UF uoff, const EPI epi, unsigned char* lds) {
    constexpr int WC = 4 / WR, CPR = BK / 8, RB = BK * 2, R256 = 256 / RB, BN = WC * NT * 16, NTH = (NT > 6) ? NT / 2 : NT;
    static_assert(WR * MT * 16 == 128, "tile is 128 rows");
    constexpr int A_BYTES = 128 * RB, B_BYTES = BN * RB;
    constexpr int A_CH = (128 * CPR) / 256, B_TOT = BN * CPR, B_CH = (B_TOT + 255) / 256, RSTEP = 256 / CPR;
    int t = TID; LAUNDER(t);
    const int lane = t & 63, wid = t >> 6, wr = wid / WC, wc = wid % WC;
    const int ch = t % CPR, r0 = t / CPR;
    const bf16_t* pa[A_CH]; const bf16_t* pb[B_CH]; int offa[A_CH], offb[B_CH]; bool vb[B_CH];
#pragma unroll
    for (int i = 0; i < A_CH; ++i) { const int row = r0 + i * RSTEP; pa[i] = ap.row(row) + ch * 8; offa[i] = row * RB + ((ch ^ ((row / R256) & (CPR - 1))) << 4); }
#pragma unroll
    for (int i = 0; i < B_CH; ++i) { const int row = r0 + i * RSTEP; vb[i] = (B_TOT % 256 == 0) || (row < BN); const int rr = vb[i] ? row : 0; pb[i] = Bt + (size_t)rr * ldb + ch * 8; offb[i] = 2 * A_BYTES + rr * RB + ((ch ^ ((rr / R256) & (CPR - 1))) << 4); }
    f32x4 acc[MT][NT];
#pragma unroll
    for (int i = 0; i < MT; ++i)
#pragma unroll
        for (int j = 0; j < NT; ++j) acc[i][j] = (f32x4){0.f, 0.f, 0.f, 0.f};
    const int KT = K / BK, NG = nunits * KT;
    int lu = 0, lkt = 0, cu = 0, ckt = 0;
    u32x4 ra0[A_CH], rb0[B_CH], ra1[A_CH], rb1[B_CH];
#define S_LOAD(RA, RB) { int ao, bo; uoff(lu, ao, bo); ao += lkt * BK; bo += lkt * BK; \
                         _Pragma("unroll") for (int i = 0; i < A_CH; ++i) RA[i] = *(const u32x4*)(pa[i] + ao); \
                         _Pragma("unroll") for (int i = 0; i < B_CH; ++i) RB[i] = *(const u32x4*)(pb[i] + bo); \
                         if (++lkt == KT) { lkt = 0; ++lu; } }
#define S_WRITE(RA, RB, BUF) { _Pragma("unroll") for (int i = 0; i < A_CH; ++i) *(u32x4*)(lds + (BUF) * A_BYTES + offa[i]) = RA[i]; \
                               _Pragma("unroll") for (int i = 0; i < B_CH; ++i) if (vb[i]) *(u32x4*)(lds + (BUF) * B_BYTES + offb[i]) = RB[i]; }
#define S_COMPUTE(BUF) { const unsigned char* Ab = lds + (BUF) * A_BYTES + arow; const unsigned char* Bb = lds + 2 * A_BYTES + (BUF) * B_BYTES + brow; \
        _Pragma("unroll") for (int ks = 0; ks < BK / 32; ++ks) { const int co = ((ks * 4 + (lane >> 4)) ^ sw) << 4; bf16x8 af[MT]; \
            _Pragma("unroll") for (int i = 0; i < MT; ++i) af[i] = *(const bf16x8*)(Ab + i * 16 * RB + co); \
            _Pragma("unroll") for (int jh = 0; jh < NT / NTH; ++jh) { bf16x8 bfr[NTH]; \
                _Pragma("unroll") for (int j = 0; j < NTH; ++j) bfr[j] = *(const bf16x8*)(Bb + (jh * NTH + j) * 16 * RB + co); \
                __builtin_amdgcn_s_setprio(1); \
                _Pragma("unroll") for (int i = 0; i < MT; ++i) _Pragma("unroll") for (int j = 0; j < NTH; ++j) \
                    acc[i][jh * NTH + j] = (jh * NTH + j < NSWAP) ? __builtin_amdgcn_mfma_f32_16x16x32_bf16(bfr[j], af[i], acc[i][jh * NTH + j], 0, 0, 0) \
                                                                : __builtin_amdgcn_mfma_f32_16x16x32_bf16(af[i], bfr[j], acc[i][jh * NTH + j], 0, 0, 0); \
                __builtin_amdgcn_s_setprio(0); } } }
#define S_EPI { if (++ckt == KT) { epi(cu, acc); ckt = 0; ++cu; \
                _Pragma("unroll") for (int i = 0; i < MT; ++i) _Pragma("unroll") for (int j = 0; j < NT; ++j) acc[i][j] = (f32x4){0.f, 0.f, 0.f, 0.f}; } }
    const int sw = ((lane & 15) / R256) & (CPR - 1);
    const int arow = (wr * MT * 16 + (lane & 15)) * RB, brow = (wc * NT * 16 + (lane & 15)) * RB;
    S_LOAD(ra0, rb0)
    if (NG > 1) S_LOAD(ra1, rb1)
    __syncthreads();
    S_WRITE(ra0, rb0, 0)
    if (NG > 2) S_LOAD(ra0, rb0)
    __syncthreads();
#pragma unroll 1
    for (int g = 0; g < NG; g += 2) {
        S_COMPUTE(0)
        if (g + 1 < NG) { S_WRITE(ra1, rb1, 1) if (g + 3 < NG) S_LOAD(ra1, rb1) }
        S_EPI
        __syncthreads();
        if (g + 1 >= NG) break;
        S_COMPUTE(1)
        if (g + 2 < NG) { S_WRITE(ra0, rb0, 0) if (g + 4 < NG) S_LOAD(ra0, rb0) }
        S_EPI
        __syncthreads();
    }
#undef S_LOAD
#undef S_WRITE
#undef S_COMPUTE
#undef S_EPI
}

template <int NT, int BK, class AP>
DI void gemm_core(const AP ap, const bf16_t* __restrict__ Bt, const int ldb, const int K, f32x4 (&acc)[4][NT], unsigned char* lds) {
    gemm_tile<4, NT, 2, BK, NT>(ap, Bt, ldb, K, acc, lds);
}

template <int NT> DI void acc_to_lds(const f32x4 (&acc)[4][NT], float* tile, const int ld) {
    int t = TID; LAUNDER(t);
    const int lane = t & 63, wid = t >> 6, wr = wid >> 1, wc = wid & 1;
#pragma unroll
    for (int i = 0; i < 4; ++i)
#pragma unroll
        for (int j = 0; j < NT; ++j) {
            const int row = wr * 64 + i * 16 + (lane & 15), col = wc * NT * 16 + j * 16 + (lane >> 4) * 4;
            *(f32x4*)(tile + row * ld + col) = acc[i][j];
        }
}

namespace pg8 {
#define PG8_LAS __attribute__((address_space(3)))
typedef unsigned short bf16_t;
typedef short bf16x8 __attribute__((ext_vector_type(8)));
typedef float f32x4 __attribute__((ext_vector_type(4)));
typedef unsigned u32x4 __attribute__((ext_vector_type(4)));
constexpr int BM = 256, BK = 64, HALF = 128, HTB = HALF * BK * 2  , STAGE_BYTES = 8 * HTB, NXCD = 8, WGM = 8;

__host__ __device__ __forceinline__ int lds_byte(int r, int c) { const int st = (r >> 4) * 2 + (c >> 5), rr = r & 15, cc = c & 31, ob = rr * 64 + cc * 2; return st * 1024 + (ob ^ (((ob >> 9) & 1) << 5)); }
__host__ __device__ __forceinline__ void stage_rc(int b, int& R, int& C) { const int st = b / 1024, sb = b % 1024, swz = sb ^ (((sb >> 9) & 1) << 5); R = (st >> 1) * 16 + swz / 64; C = (st & 1) * 32 + (swz % 64) / 2; }
__host__ __device__ __forceinline__ int perm32(int rho) { const int n = rho >> 4, i = rho & 15; return 8 * (i >> 2) + 4 * n + (i & 3); }

struct Unit { int pm, pn; };
struct Gemm { const bf16_t* A; const bf16_t* Bt; int M, N, K; };

struct StaticOrder {
    int nM, nN, nwg, G, c;
    __host__ __device__ void init(int M, int N, int G_, int c_) { nM = M / BM; nN = N / BM; nwg = nM * nN; G = G_; c = c_; }
    __host__ __device__ bool next(int i, Unit& u) const {
        const long L = (long)i * G + c; if (L >= nwg) return false;
        int wgid = (int)L; { const int q = nwg / NXCD, r = nwg % NXCD, xcd = wgid % NXCD, off = wgid / NXCD; wgid = (xcd < r ? xcd * (q + 1) : r * (q + 1) + (xcd - r) * q) + off; }
        const int nig = WGM * nN, gid = wgid / nig, fm = gid * WGM, gsz = (nM - fm) < WGM ? (nM - fm) : WGM;
        u.pm = fm + ((wgid % nig) % gsz); u.pn = (wgid % nig) / gsz; return true;
    }
    __device__ __forceinline__ void a_ready(const Unit&) const {}
    __device__ __forceinline__ void done(const Unit&) const {}
};


__device__ __forceinline__ unsigned pk2_(float a, float b) { typedef float f2 __attribute__((ext_vector_type(2))); typedef __bf16 b2 __attribute__((ext_vector_type(2))); f2 f = {a, b}; b2 r = __builtin_convertvector(f, b2); return __builtin_bit_cast(unsigned, r); }
typedef unsigned u32x2_ __attribute__((ext_vector_type(2)));
struct EpiStoreBf16 {
    static constexpr bool PERM = false, AFTER_DRAIN = false;
    bf16_t* O; int ldc;
    __device__ __forceinline__ void operator()(const f32x4 (&acc)[2][2][4][2], const Unit& u, int wr, int wc, int fr, int fq) const {
        { int l_ = (int)(threadIdx.x & 63u); asm volatile("" : "+v"(l_)); fr = l_ & 15; fq = l_ >> 4; }
#pragma unroll
        for (int ai = 0; ai < 2; ++ai)
#pragma unroll
            for (int m = 0; m < 4; ++m) { bf16_t* rowp = O + (size_t)(u.pm * BM + ai * HALF + wr * 64 + m * 16 + fr) * ldc + u.pn * BM + wc * 32 + 4 * fq;
#pragma unroll
                for (int bj = 0; bj < 2; ++bj)
#pragma unroll
                    for (int n = 0; n < 2; ++n) { const f32x4 v = acc[ai][bj][m][n]; u32x2_ w; w.x = pk2_(v[0], v[1]); w.y = pk2_(v[2], v[3]); *(u32x2_*)(rowp + bj * HALF + n * 16) = w; } }
    }
};
struct EpiSwiglu {
    static constexpr bool PERM = false, AFTER_DRAIN = false;
    bf16_t* act;
    __device__ __forceinline__ void operator()(const f32x4 (&acc)[2][2][4][2], const Unit& u, int wr, int wc, int fr, int fq) const {
        { int l_ = (int)(threadIdx.x & 63u); asm volatile("" : "+v"(l_)); fr = l_ & 15; fq = l_ >> 4; }
#pragma unroll
        for (int ai = 0; ai < 2; ++ai)
#pragma unroll
            for (int m = 0; m < 4; ++m) { bf16_t* rowp = act + (ai * HALF + wr * 64 + m * 16 + fr) * 256 + u.pn * 128 + wc * 16 + 4 * fq;
#pragma unroll
                for (int bj = 0; bj < 2; ++bj) { const f32x4 gg = acc[ai][bj][m][0], uu = acc[ai][bj][m][1]; float o[4];
#pragma unroll
                    for (int e = 0; e < 4; ++e) o[e] = gg[e] / (1.0f + __expf(-gg[e])) * uu[e];
                    u32x2_ w; w.x = pk2_(o[0], o[1]); w.y = pk2_(o[2], o[3]); *(u32x2_*)(rowp + bj * 64) = w; } }
    }
};
struct EpiSlot {
    static constexpr bool PERM = false, AFTER_DRAIN = false;
    bf16_t* slot;
    __device__ __forceinline__ void operator()(const f32x4 (&acc)[2][2][4][2], const Unit& u, int wr, int wc, int fr, int fq) const {
        const int* rowslot = (const int*)(smem + 131072 + 4096); const float* roww = (const float*)(rowslot + 256);
        { int l_ = (int)(threadIdx.x & 63u); asm volatile("" : "+v"(l_)); fr = l_ & 15; fq = l_ >> 4; }
#pragma unroll
        for (int ai = 0; ai < 2; ++ai)
#pragma unroll
            for (int m = 0; m < 4; ++m) { const int row = ai * HALF + wr * 64 + m * 16 + fr, srow = rowslot[row]; const float ww = roww[row];
                if (srow >= 0) { bf16_t* rowp = slot + (size_t)srow * 1024 + u.pn * BM + wc * 32 + 4 * fq;
#pragma unroll
                    for (int bj = 0; bj < 2; ++bj)
#pragma unroll
                        for (int n = 0; n < 2; ++n) { const f32x4 v = acc[ai][bj][m][n] * ww; u32x2_ w; w.x = pk2_(v[0], v[1]); w.y = pk2_(v[2], v[3]); *(u32x2_*)(rowp + bj * HALF + n * 16) = w; } } }
    }
};
struct PanelOrder {
    int nun;
    __device__ __forceinline__ bool next(int i, Unit& u) const { if (i >= nun) return false; int z = 0, pn = i; asm volatile("" : "+s"(z), "+s"(pn)); u.pm = z; u.pn = pn; return true; }
    __device__ __forceinline__ void a_ready(const Unit&) const {}
    __device__ __forceinline__ void done(const Unit&) const {}
};

template <class Epi, class Sched, bool ALIGN_EPI = false, bool SP2 = false, bool GATHER = false>
__device__ __forceinline__ void gemm_phase(PG8_LAS unsigned char* lds, const Gemm g, const Sched& S, const Epi& E, const unsigned (&gv)[2][2]) {
    int tid = threadIdx.x; asm volatile("" : "+v"(tid));
    const int wid = __builtin_amdgcn_readfirstlane(tid >> 6), lane = tid & 63, wr = wid >> 2, wc = wid & 3, fr = lane & 15, fq = lane >> 4;
    const int K = g.K, nt = K / BK;
    unsigned voffA[2], voffB[2];
#pragma unroll
    for (int i = 0; i < 2; ++i) { int R, C; stage_rc(tid * 16 + i * 8192, R, C); const int Rb = Epi::PERM ? ((R & ~31) + perm32(R & 31)) : R;
        voffA[i] = (unsigned)(R * K + C) * 2u; voffB[i] = (unsigned)(Rb * K + C) * 2u; }
    unsigned voffA0[2], voffA1[2];
#pragma unroll
    for (int i = 0; i < 2; ++i) { voffA0[i] = GATHER ? gv[0][i] : voffA[i]; voffA1[i] = GATHER ? gv[1][i] : 0u; }
    const size_t kstep = (size_t)(BK * 2);
    const size_t hstep = (size_t)HALF * K * 2;
    const size_t tstep = 2 * hstep;
    const unsigned ldsw = (unsigned)wid * 1024u;
    const int aoff = lds_byte(wr * 64 + fr, fq * 8), boff = lds_byte(wc * 32 + fr, fq * 8);
#define PG8_SA(b, h) (((b) * 2 + (h)) * HTB)
#define PG8_SB(b, h) ((4 + (b) * 2 + (h)) * HTB)
#define PG8_STAGE(bufoff, gbase, voff) do { _Pragma("unroll") for (int _i = 0; _i < 2; ++_i) \
        __builtin_amdgcn_global_load_lds((const unsigned*)((const char*)(gbase) + (voff)[_i]), (PG8_LAS unsigned*)(lds + (bufoff) + ldsw + _i * 8192), 16, 0, 0); } while (0)
#define PG8_LDA(dst, b, h) do { _Pragma("unroll") for (int m = 0; m < 4; ++m) _Pragma("unroll") for (int k = 0; k < 2; ++k) dst[m][k] = *(const PG8_LAS bf16x8*)(lds + PG8_SA(b, h) + aoff + m * 2048 + k * 1024); } while (0)
#define PG8_LDB(dst, b, h) do { _Pragma("unroll") for (int n = 0; n < 2; ++n) _Pragma("unroll") for (int k = 0; k < 2; ++k) dst[n][k] = *(const PG8_LAS bf16x8*)(lds + PG8_SB(b, h) + boff + n * 2048 + k * 1024); } while (0)
#define PG8_MMA(ai, bj, At, Bt) do { __builtin_amdgcn_s_setprio(1); _Pragma("unroll") for (int m = 0; m < 4; ++m) _Pragma("unroll") for (int n = 0; n < 2; ++n) _Pragma("unroll") for (int k = 0; k < 2; ++k) \
        acc[ai][bj][m][n] = __builtin_amdgcn_mfma_f32_16x16x32_bf16(Bt[n][k], At[m][k], acc[ai][bj][m][n], 0, 0, 0); __builtin_amdgcn_s_setprio(0); } while (0)
#define PG8_WAIT_V(n) asm volatile("s_waitcnt vmcnt(" #n ")" ::: "memory")
#define PG8_WAIT_L(n) asm volatile("s_waitcnt lgkmcnt(" #n ")" ::: "memory")
#define PG8_BAR __builtin_amdgcn_s_barrier()
#define PG8_SCHED __builtin_amdgcn_sched_barrier(0)
    Unit cur, nxt; int ui = 0;
    if (!S.next(0, cur)) return;
    f32x4 acc[2][2][4][2];
#pragma unroll
    for (int a = 0; a < 2; ++a)
#pragma unroll
        for (int b = 0; b < 2; ++b)
#pragma unroll
            for (int m = 0; m < 4; ++m)
#pragma unroll
                for (int n = 0; n < 2; ++n) acc[a][b][m][n] = (f32x4){0.f, 0.f, 0.f, 0.f};
    bf16x8 At[4][2], B0[2][2], B1[2][2];
    const char* cA = (const char*)g.A + (size_t)cur.pm * tstep; const char* cB = (const char*)g.Bt + (size_t)cur.pn * tstep;
    S.a_ready(cur);
    if constexpr (SP2) {
        PG8_STAGE(PG8_SB(0, 0), cB, voffB); PG8_STAGE(PG8_SB(0, 1), cB + hstep, voffB); PG8_STAGE(PG8_SA(0, 0), cA, voffA0); PG8_STAGE(PG8_SA(0, 1), (cA) + (GATHER ? (size_t)0 : hstep), GATHER ? voffA1 : voffA0);
        if (wr == 1) PG8_BAR;
        PG8_WAIT_V(2); PG8_BAR;
        PG8_STAGE(PG8_SB(1, 0), cB + kstep, voffB); PG8_STAGE(PG8_SA(1, 0), cA + kstep, voffA0); PG8_STAGE(PG8_SB(1, 1), cB + hstep + kstep, voffB);
        PG8_WAIT_V(6); PG8_BAR;
    } else {
        PG8_STAGE(PG8_SB(0, 0), cB, voffB); PG8_STAGE(PG8_SA(0, 0), cA, voffA0); PG8_STAGE(PG8_SB(0, 1), cB + hstep, voffB); PG8_STAGE(PG8_SA(0, 1), (cA) + (GATHER ? (size_t)0 : hstep), GATHER ? voffA1 : voffA0);
        if (wr == 1) PG8_BAR;
        PG8_WAIT_V(4); PG8_BAR;
        PG8_STAGE(PG8_SB(1, 0), cB + kstep, voffB); PG8_STAGE(PG8_SA(1, 0), cA + kstep, voffA0); PG8_STAGE(PG8_SB(1, 1), cB + hstep + kstep, voffB);
        PG8_WAIT_V(6); PG8_BAR;
    }
    for (;;) {
        const bool has_next = S.next(ui + 1, nxt);
        const char* nA = has_next ? (const char*)g.A + (size_t)nxt.pm * tstep : cA; const char* nB = has_next ? (const char*)g.Bt + (size_t)nxt.pn * tstep : cB;
        for (int t = 0; t < nt; t += 2) {
            const bool last = (t == nt - 2);
            const char* a1 = cA + (size_t)(t + 1) * kstep;
            const char* a2 = last ? nA : cA + (size_t)(t + 2) * kstep; const char* b2 = last ? nB : cB + (size_t)(t + 2) * kstep;
            const char* a3 = a2 + kstep; const char* b3 = b2 + kstep;
            if (last && has_next) S.a_ready(nxt);
            if constexpr (SP2) {
            PG8_LDB(B0, 0, 0); PG8_LDB(B1, 0, 1); PG8_SCHED; PG8_LDA(At, 0, 0); PG8_STAGE(PG8_SA(1, 1), (a1) + (GATHER ? (size_t)0 : hstep), GATHER ? voffA1 : voffA0);
            PG8_WAIT_V(8); PG8_WAIT_L(0); PG8_BAR; PG8_MMA(0, 0, At, B0); PG8_MMA(0, 1, At, B1); PG8_BAR; PG8_SCHED;
            PG8_LDA(At, 0, 1); PG8_STAGE(PG8_SB(0, 0), b2, voffB); PG8_STAGE(PG8_SB(0, 1), b2 + hstep, voffB); PG8_STAGE(PG8_SA(0, 0), a2, voffA0);
            PG8_WAIT_V(8); PG8_WAIT_L(0); PG8_BAR; PG8_MMA(1, 0, At, B0); PG8_MMA(1, 1, At, B1); PG8_BAR; PG8_SCHED;
            PG8_LDB(B0, 1, 0); PG8_LDB(B1, 1, 1); PG8_SCHED; PG8_LDA(At, 1, 0); PG8_STAGE(PG8_SA(0, 1), (a2) + (GATHER ? (size_t)0 : hstep), GATHER ? voffA1 : voffA0);
            PG8_WAIT_V(8); PG8_WAIT_L(0); PG8_BAR; PG8_MMA(0, 0, At, B0); PG8_MMA(0, 1, At, B1); PG8_BAR; PG8_SCHED;
            PG8_LDA(At, 1, 1); PG8_STAGE(PG8_SB(1, 0), b3, voffB); PG8_STAGE(PG8_SB(1, 1), b3 + hstep, voffB); PG8_STAGE(PG8_SA(1, 0), a3, voffA0);
            PG8_WAIT_V(8); PG8_WAIT_L(0); PG8_BAR; PG8_MMA(1, 0, At, B0); PG8_MMA(1, 1, At, B1); PG8_BAR; PG8_SCHED;
            } else {
            PG8_LDB(B0, 0, 0); PG8_SCHED; PG8_LDA(At, 0, 0); PG8_STAGE(PG8_SA(1, 1), (a1) + (GATHER ? (size_t)0 : hstep), GATHER ? voffA1 : voffA0);
            PG8_WAIT_L(8); PG8_BAR; PG8_WAIT_L(0); PG8_MMA(0, 0, At, B0); PG8_BAR; PG8_SCHED;
            PG8_LDB(B1, 0, 1); PG8_STAGE(PG8_SB(0, 0), b2, voffB);
            PG8_BAR; PG8_WAIT_L(0); PG8_MMA(0, 1, At, B1); PG8_BAR;
            PG8_LDA(At, 0, 1); PG8_STAGE(PG8_SA(0, 0), a2, voffA0);
            PG8_BAR; PG8_WAIT_L(0); PG8_MMA(1, 0, At, B0); PG8_BAR; PG8_SCHED;
            PG8_STAGE(PG8_SB(0, 1), b2 + hstep, voffB);
            PG8_WAIT_V(6); PG8_BAR; PG8_MMA(1, 1, At, B1); PG8_BAR;
            PG8_LDB(B0, 1, 0); PG8_SCHED; PG8_LDA(At, 1, 0); PG8_STAGE(PG8_SA(0, 1), (a2) + (GATHER ? (size_t)0 : hstep), GATHER ? voffA1 : voffA0);
            PG8_WAIT_L(8); PG8_BAR; PG8_WAIT_L(0); PG8_MMA(0, 0, At, B0); PG8_BAR; PG8_SCHED;
            PG8_LDB(B1, 1, 1); PG8_STAGE(PG8_SB(1, 0), b3, voffB);
            PG8_BAR; PG8_WAIT_L(0); PG8_MMA(0, 1, At, B1); PG8_BAR;
            PG8_LDA(At, 1, 1); PG8_STAGE(PG8_SA(1, 0), a3, voffA0);
            PG8_BAR; PG8_WAIT_L(0); PG8_MMA(1, 0, At, B0); PG8_BAR; PG8_SCHED;
            PG8_STAGE(PG8_SB(1, 1), b3 + hstep, voffB);
            PG8_WAIT_V(6); PG8_BAR; PG8_MMA(1, 1, At, B1); PG8_BAR;
            }
        }
        if constexpr (ALIGN_EPI) { if (wr == 0) PG8_BAR; }
        if constexpr (!Epi::AFTER_DRAIN) { E(acc, cur, wr, wc, fr, fq); S.done(cur); }
        if (!has_next) break;
#pragma unroll
        for (int a = 0; a < 2; ++a)
#pragma unroll
            for (int b = 0; b < 2; ++b)
#pragma unroll
                for (int m = 0; m < 4; ++m)
#pragma unroll
                    for (int n = 0; n < 2; ++n) acc[a][b][m][n] = (f32x4){0.f, 0.f, 0.f, 0.f};
        cur = nxt; cA = nA; cB = nB; ++ui;
        if constexpr (ALIGN_EPI) { if (wr == 1) PG8_BAR; }
    }
    PG8_WAIT_V(0);
    if constexpr (!ALIGN_EPI) { if (wr == 0) PG8_BAR; }
    PG8_BAR;
    if constexpr (Epi::AFTER_DRAIN) { E.fused(acc, cur, wr, wc, fr, fq, lds, wid, lane); S.done(cur); }
#undef PG8_SA
#undef PG8_SB
#undef PG8_STAGE
#undef PG8_LDA
#undef PG8_LDB
#undef PG8_MMA
#undef PG8_WAIT_V
#undef PG8_WAIT_L
#undef PG8_BAR
#undef PG8_SCHED
}
}

DI int map_win(int n) { return n < 384 ? n + 1696 : (n < 2080 ? n - 384 : (n < 2112 ? n : -1)); }
DI int map_gu32(int n) { const int g32 = n >> 5, w = n & 31, a = g32 * 16 + (w & 15); return (w >> 4) ? 256 + a : a; }
DI int map_gu128(int n) { const int tile = n >> 7, w = n & 127, wc = w >> 6, j = (w >> 4) & 3, r = w & 15; const int a = tile * 64 + wc * 32 + (j >> 1) * 16 + r; return (j & 1) ? 256 + a : a; }
DI int map_gu(int n) { const int tile = n >> 8, w = n & 255, wc = w >> 7, j = (w >> 4) & 7, r = w & 15; const int a = tile * 128 + wc * 64 + (j >> 1) * 16 + r; return (j & 1) ? 256 + a : a; }

template <int MAP> DI void tconv_simple(const float* __restrict__ src, bf16_t* __restrict__ dst, int K, int Ns, int Nd, const float* __restrict__ scale, int gtid, int gthreads) {
    const int total = Nd * K;
    for (int idx = gtid; idx < total; idx += gthreads) {
        const int n = idx / K, k = idx - n * K;
        const int m = (MAP == 1) ? map_win(n) : (MAP == 2 ? map_gu(n) : (MAP == 3 ? map_gu128(n) : n));
        float v = 0.f;
        if (m >= 0) { v = src[(size_t)k * Ns + m]; if (scale) v *= scale[k]; }
        dst[idx] = f2bf(v);
    }
}
template <int MAP> DI void tconv_tiled(const float* __restrict__ src, bf16_t* __restrict__ dst, int E, int K, int N, float* ldsf, int bid, int G) {
    const int tk = K / 64, tn = N / 64, per = tk * tn, total = E * per;
    const int t = TID;
    for (int tile0 = 2 * bid; tile0 < total; tile0 += 2 * G) {
        float rg[2][16];
#pragma unroll
        for (int h = 0; h < 2; ++h) {
            const int tile = tile0 + h, e = tile / per, r = tile - e * per, kt = r / tn, nt = r - kt * tn;
            const float* s = src + (size_t)e * K * N + (size_t)(kt * 64) * N;
            const int nl = t & 63, n = nt * 64 + nl;
            const int m = (MAP == 2) ? map_gu32(n) : n;
#pragma unroll
            for (int i = 0; i < 16; ++i) rg[h][i] = s[(size_t)((t >> 6) + 4 * i) * N + m];
        }
        __syncthreads();
#pragma unroll
        for (int h = 0; h < 2; ++h)
#pragma unroll
            for (int i = 0; i < 16; ++i) ldsf[h * 4160 + ((t >> 6) + 4 * i) * 65 + (t & 63)] = rg[h][i];
        __syncthreads();
#pragma unroll
        for (int h = 0; h < 2; ++h) {
            const int tile = tile0 + h, e = tile / per, r = tile - e * per, kt = r / tn, nt = r - kt * tn;
            const int nl = t >> 2, kc = (t & 3) * 16;
            unsigned w[8];
#pragma unroll
            for (int i = 0; i < 8; ++i) w[i] = pk2(ldsf[h * 4160 + (kc + 2 * i) * 65 + nl], ldsf[h * 4160 + (kc + 2 * i + 1) * 65 + nl]);
            bf16_t* d = dst + (size_t)e * K * N + (size_t)(nt * 64 + nl) * K + kt * 64 + kc;
            *(u32x4*)(d) = mk4(w[0], w[1], w[2], w[3]);
            *(u32x4*)(d + 8) = mk4(w[4], w[5], w[6], w[7]);
        }
    }
}
DI void phase0(const Params& p, unsigned char* lds, int bid, int G) {
    const int t = TID;
    float* ldsf = (float*)lds;
    for (int item = bid; item < 384; item += G) {
        __syncthreads();
        for (int i = t; i < NB * DM; i += 256) { const float v = p.c[i]; ldsf[(i & (DM - 1)) * NB + (i >> 10)] = v * sigmoidf_(v); }
        __syncthreads();
        const int col = item * 16 + (t & 15), kp = t >> 4;
        float a[NB];
#pragma unroll
        for (int b = 0; b < NB; ++b) a[b] = 0.f;
#pragma unroll 1
        for (int k0 = kp * 64; k0 < kp * 64 + 64; k0 += 8) {
            float w[8];
#pragma unroll
            for (int u = 0; u < 8; ++u) w[u] = p.ada_w[(size_t)(k0 + u) * 6144 + col];
#pragma unroll
            for (int u = 0; u < 8; ++u) {
#pragma unroll
                for (int q = 0; q < 4; ++q) { const f32x4 cv = *(const f32x4*)(ldsf + (k0 + u) * NB + 4 * q); a[4 * q] += cv[0] * w[u]; a[4 * q + 1] += cv[1] * w[u]; a[4 * q + 2] += cv[2] * w[u]; a[4 * q + 3] += cv[3] * w[u]; }
            }
        }
        __syncthreads();
#pragma unroll
        for (int b = 0; b < NB; ++b) ldsf[(kp * NB + b) * 16 + (t & 15)] = a[b];
        __syncthreads();
        {
            const int b = t >> 4, cl = t & 15; float sacc = 0.f;
#pragma unroll
            for (int q = 0; q < 16; ++q) sacc += ldsf[(q * NB + b) * 16 + cl];
            p.mod[b * 6144 + item * 16 + cl] = sacc + p.ada_b[item * 16 + cl];
        }
    }
    __syncthreads();
    const int gtid = bid * 256 + t, gth = G * 256;
    tconv_simple<1>(p.w_in, p.win_t, 1024, 2112, LDU, nullptr, gtid, gth);
    tconv_simple<0>(p.w_q_b, p.wq_t, 256, 768, 768, p.q_a_norm, gtid, gth);
    tconv_simple<0>(p.w_kv_b, p.wkv_t, 128, 1024, 1024, p.kv_a_norm, gtid, gth);
    tconv_simple<0>(p.decay_up, p.wdec_t, 32, 512, 512, nullptr, gtid, gth);
    tconv_simple<0>(p.iclr_up, p.wiclr_t, 32, 512, 512, nullptr, gtid, gth);
    tconv_simple<0>(p.gate_up, p.wgate_t, 96, 512, 512, nullptr, gtid, gth);
    tconv_simple<0>(p.w_out, p.wout_t, 1024, 1024, 1024, nullptr, gtid, gth);
    tconv_simple<0>(p.w_router, p.wr_t, 1024, 256, 256, nullptr, gtid, gth);
    tconv_simple<3>(p.w_sh_gu, p.wsgu_t, 1024, 512, 512, nullptr, gtid, gth);
    tconv_simple<0>(p.w_sh_d, p.wsd_t, 256, 1024, 1024, nullptr, gtid, gth);
    tconv_tiled<2>(p.w_e_gu, p.wegu_t, NEXP, 1024, 512, ldsf, bid, G);
    tconv_tiled<0>(p.w_e_d, p.wed_t, NEXP, 256, 1024, ldsf, bid, G);
}

DI void phase1(const Params& p, int bid, int G) {
    const int lane = TID & 63, gw = bid * 4 + (TID >> 6), nw = G * 4;
    for (int row0 = gw * 2; row0 < NTOK; row0 += nw * 2) {
        f32x4 v[2][4]; float ss[2] = {0.f, 0.f};
#pragma unroll
        for (int u = 0; u < 2; ++u)
#pragma unroll
            for (int i = 0; i < 4; ++i) v[u][i] = *(const f32x4*)(p.x + (size_t)(row0 + u) * DM + lane * 4 + 256 * i);
#pragma unroll
        for (int u = 0; u < 2; ++u) {
#pragma unroll
            for (int i = 0; i < 4; ++i) ss[u] += v[u][i][0] * v[u][i][0] + v[u][i][1] * v[u][i][1] + v[u][i][2] * v[u][i][2] + v[u][i][3] * v[u][i][3];
            ss[u] = wave_sum(ss[u]);
        }
        const float* mod = p.mod + (row0 >> 12) * 6144;
#pragma unroll
        for (int i = 0; i < 4; ++i) {
            const int c = lane * 4 + 256 * i;
            const f32x4 g = *(const f32x4*)(p.norm_mix + c), sh = *(const f32x4*)(mod + c), sc = *(const f32x4*)(mod + 1024 + c);
#pragma unroll
            for (int u = 0; u < 2; ++u) {
                const float rs = rsqrtf(ss[u] * (1.0f / DM) + 1e-6f);
                float o[4];
#pragma unroll
                for (int e = 0; e < 4; ++e) o[e] = v[u][i][e] * rs * g[e] * (1.0f + sc[e]) + sh[e];
                *(u32x2*)(p.H + (size_t)(row0 + u) * DM + c) = mk2(pk2(o[0], o[1]), pk2(o[2], o[3]));
            }
        }
    }
    const double inv = exp(-(double)(lane & 15) * (9.210340371976184 / 16.0));
    for (int idx = gw * 64 + lane; idx < NTOK * 16; idx += nw * 64) {
        const int row = idx >> 4;
        const double ang = (double)p.positions[row] * inv;
        p.rope[(size_t)row * 32 + (lane & 15)] = (float)cos(ang);
        p.rope[(size_t)row * 32 + 16 + (lane & 15)] = (float)sin(ang);
    }
}

DI void phase2_coop(const Params& p) {
    pg8::Gemm g{p.H, p.win_t, NTOK, LDU, DM};
    pg8::StaticOrder S; S.init(NTOK, LDU, (int)gridDim.x, (int)blockIdx.x);
    pg8::EpiStoreBf16 E{p.U, LDU};
    const unsigned nog[2][2] = {{0u, 0u}, {0u, 0u}};
    pg8::gemm_phase<pg8::EpiStoreBf16, pg8::StaticOrder, true, true, false>((PG8_LAS unsigned char*)smem, g, S, E, nog);
}

DI void unpack8(const u32x4 w, float (&f)[8]) { f[0] = lo2f(w.x); f[1] = hi2f(w.x); f[2] = lo2f(w.y); f[3] = hi2f(w.y); f[4] = lo2f(w.z); f[5] = hi2f(w.z); f[6] = lo2f(w.w); f[7] = hi2f(w.w); }
DI f32x4 unpack4(const u32x2 w) { return (f32x4){lo2f(w.x), hi2f(w.x), lo2f(w.y), hi2f(w.y)}; }
DI u32x2 pack4(const f32x4 v) { return mk2(pk2(v[0], v[1]), pk2(v[2], v[3])); }
DI f32x4 shifted4(const bf16_t* __restrict__ up, const bool has_prev, const f32x4 mu) {
    const f32x4 cur = unpack4(*(const u32x2*)up);
    f32x4 prev = (f32x4){0.f, 0.f, 0.f, 0.f};
    if (has_prev) prev = unpack4(*(const u32x2*)(up - LDU));
    return cur + (prev - cur) * mu;
}
DI void head96_finish(f32x4 (&v)[6], const int q, const float* __restrict__ gain, const float* __restrict__ ropeRow, const float scale, bf16_t* __restrict__ dstRow) {
    float ss = 0.f;
#pragma unroll
    for (int j = 0; j < 6; ++j) ss += v[j][0] * v[j][0] + v[j][1] * v[j][1] + v[j][2] * v[j][2] + v[j][3] * v[j][3];
    ss += __shfl_xor(ss, 16); ss += __shfl_xor(ss, 32);
    const float rs = rsqrtf(ss * (1.0f / 96.0f) + 1e-6f);
#pragma unroll
    for (int j = 0; j < 6; ++j) v[j] = v[j] * rs * *(const f32x4*)(gain + j * 16 + q * 4);
    const f32x4 cs = *(const f32x4*)(ropeRow + q * 4), sn = *(const f32x4*)(ropeRow + 16 + q * 4);
    const f32x4 x1 = v[4], x2 = v[5];
    v[4] = x1 * cs - x2 * sn; v[5] = x2 * cs + x1 * sn;
#pragma unroll
    for (int j = 0; j < 6; ++j) *(u32x2*)(dstRow + j * 16 + q * 4) = pack4(v[j] * scale);
}

DI void phase3(const Params& p, unsigned char* lds, int bid, int G) {
    const int t = TID;
    float* rstd_q = (float*)(lds + 69632);
    float* rstd_kv = rstd_q + 128;
    bf16_t* lora = (bf16_t*)(p.bscr + (size_t)bid * BSCR_PER_BLOCK + 131072);
    for (int rt = bid; rt < NTOK / 128; rt += G) {
        __syncthreads();
        {
            int tl = t; LAUNDER(tl);
            const int row = tl >> 1, half = tl & 1, grow = rt * 128 + row;
            const bf16_t* urow = p.U + (size_t)grow * LDU;
            float s = 0.f;
#pragma unroll
            for (int c = 0; c < 16; ++c) { float f[8]; unpack8(*(const u32x4*)(urow + UQ + half * 128 + c * 8), f);
#pragma unroll
                for (int e = 0; e < 8; ++e) s += f[e] * f[e]; }
            s += __shfl_xor(s, 1);
            float s2 = 0.f;
#pragma unroll
            for (int c = 0; c < 8; ++c) { float f[8]; unpack8(*(const u32x4*)(urow + UKV + half * 64 + c * 8), f);
#pragma unroll
                for (int e = 0; e < 8; ++e) s2 += f[e] * f[e]; }
            s2 += __shfl_xor(s2, 1);
            if (half == 0) { rstd_q[row] = rsqrtf(s * (1.0f / 256.0f) + 1e-6f); rstd_kv[row] = rsqrtf(s2 * (1.0f / 128.0f) + 1e-6f); }
        }
#pragma unroll 1
        for (int i = 0; i < 10; ++i) {
            int tl = t; LAUNDER(tl);
            const int c = tl + 256 * i, row = c / 20, chn = c - row * 20, grow = rt * 128 + row;
            const bf16_t* up = p.U + (size_t)grow * LDU + UXW + chn * 8;
            float cur[8], prv[8];
            unpack8(*(const u32x4*)up, cur);
            if ((grow & 4095) > 0) unpack8(*(const u32x4*)(up - LDU), prv);
            else {
#pragma unroll
                for (int e = 0; e < 8; ++e) prv[e] = 0.f; }
            const f32x4 m0 = *(const f32x4*)(p.rwkv_mu + 1536 + chn * 8), m1 = *(const f32x4*)(p.rwkv_mu + 1536 + chn * 8 + 4);
            float o[8];
#pragma unroll
            for (int e = 0; e < 8; ++e) {
                const float x = cur[e] + (prv[e] - cur[e]) * (e < 4 ? m0[e & 3] : m1[e & 3]);
                o[e] = chn < 4 ? tanhf(x) : (chn < 8 ? x : sigmoidf_(x));
            }
            *(u32x4*)(lora + row * 160 + chn * 8) = mk4(pk2(o[0], o[1]), pk2(o[2], o[3]), pk2(o[4], o[5]), pk2(o[6], o[7]));
        }
        asm volatile("s_waitcnt vmcnt(0)" ::: "memory");
        __syncthreads();
        STAMP(17);
        {
            APlain ap{p.U + (size_t)rt * 128 * LDU + UQ, LDU};
            gemm_stream<2, 6, 4, 64, 6>(ap, p.wq_t, 256, 256, 8, [](int u, int& ao, int& bo) { ao = 0; bo = u * 96 * 256; },
                [&](const int h, f32x4 (&acc)[2][6]) {
                    int tl = t; LAUNDER(tl);
                    const int lane = tl & 63, w = tl >> 6, r = lane & 15, q = lane >> 4;
#pragma unroll
                    for (int i = 0; i < 2; ++i) {
                        const int row = 32 * w + 16 * i + r, grow = rt * 128 + row, b = grow >> 12, tt = grow & 4095;
                        const float rq = rstd_q[row];
                        f32x4 v[6];
#pragma unroll
                        for (int j = 0; j < 6; ++j) v[j] = acc[i][j] * rq;
                        head96_finish(v, q, p.q_norm, p.rope + (size_t)grow * 32, QSCALE, p.Q + ((size_t)(b * 8 + h) * NT_ + tt) * 96);
                    }
                }, lds);
        }
        STAMP(18);
        {
            APlain ap{p.U + (size_t)rt * 128 * LDU + UKV, LDU};
            gemm_stream<2, 8, 4, 64, 4>(ap, p.wkv_t, 128, 128, 8, [](int u, int& ao, int& bo) { ao = 0; bo = u * 128 * 128; },
                [&](const int h, f32x4 (&acc)[2][8]) {
                    int tl = t; LAUNDER(tl);
                    const int lane = tl & 63, w = tl >> 6, r = lane & 15, q = lane >> 4;
#pragma unroll
                    for (int i = 0; i < 2; ++i) {
                        const int row = 32 * w + 16 * i + r, grow = rt * 128 + row, b = grow >> 12, tt = grow & 4095;
                        const float rk = rstd_kv[row];
                        const bf16_t* urow = p.U + (size_t)grow * LDU;
                        f32x4 v[6];
#pragma unroll
                        for (int j = 0; j < 4; ++j) v[j] = acc[i][j] * rk;
                        v[4] = unpack4(*(const u32x2*)(urow + UPE + q * 4));
                        v[5] = unpack4(*(const u32x2*)(urow + UPE + 16 + q * 4));
                        head96_finish(v, q, p.k_norm, p.rope + (size_t)grow * 32, 1.0f, p.Kb + ((size_t)(b * 8 + h) * NT_ + tt) * 96);
                        const int tok0 = 32 * w + 16 * i + 4 * q;
                        const f32x4 rk4 = *(const f32x4*)(rstd_kv + tok0);
                        bf16_t* vd = p.Vt + ((size_t)((rt >> 5) * 8 + h) * 64) * NT_ + (rt & 31) * 128 + tok0;
#pragma unroll
                        for (int j = 4; j < 8; ++j) *(u32x2*)(vd + (size_t)((j - 4) * 16 + r) * NT_) = pack4(acc[i][j] * rk4);
                    }
                }, lds);
        }
        STAMP(19);
        bf16_t* abuf = (bf16_t*)(p.bscr + (size_t)bid * BSCR_PER_BLOCK);
        {
            APlain ap{lora, 160};
            gemm_stream<4, 4, 2, 32, 4>(ap, p.wdec_t, 32, 32, 4, [](int u, int& ao, int& bo) { ao = 0; bo = u * 128 * 32; },
                [&](const int ct, f32x4 (&acc)[4][4]) {
                    int tl = t; LAUNDER(tl);
                    const int lane = tl & 63, wid = tl >> 6, wr = wid >> 1, wc = wid & 1, r = lane & 15, q = lane >> 4, head = ct * 2 + wc;
#pragma unroll
                    for (int i = 0; i < 4; ++i) {
                        const int grow = rt * 128 + wr * 64 + i * 16 + r, b = grow >> 12, tt = grow & 4095;
                        bf16_t* sc = p.SC + ((size_t)(b * 8 + head) * NT_ + tt) * 384 + q * 4;
#pragma unroll
                        for (int j = 0; j < 4; ++j) {
                            const f32x4 w0 = *(const f32x4*)(p.decay_w0 + head * 64 + j * 16 + q * 4);
                            f32x4 o;
#pragma unroll
                            for (int e = 0; e < 4; ++e) o[e] = 1.0f - __expf(-0.6065306597f * sigmoidf_(w0[e] + acc[i][j][e]));
                            *(u32x2*)(sc + j * 16) = pack4(o);
                        }
                    }
                }, lds);
        }
        {
            APlain ap{lora + 32, 160};
            gemm_stream<4, 4, 2, 32, 4>(ap, p.wiclr_t, 32, 32, 4, [](int u, int& ao, int& bo) { ao = 0; bo = u * 128 * 32; },
                [&](const int ct, f32x4 (&acc)[4][4]) {
                    int tl = t; LAUNDER(tl);
                    const int lane = tl & 63, wid = tl >> 6, wr = wid >> 1, wc = wid & 1, r = lane & 15, q = lane >> 4, c0 = ct * 128 + wc * 64 + q * 4;
#pragma unroll
                    for (int i = 0; i < 4; ++i) {
                        bf16_t* ar = abuf + (wr * 64 + i * 16 + r) * 512 + c0;
#pragma unroll
                        for (int j = 0; j < 4; ++j) {
                            const f32x4 a0 = *(const f32x4*)(p.iclr_a0 + c0 + j * 16);
                            f32x4 o;
#pragma unroll
                            for (int e = 0; e < 4; ++e) o[e] = sigmoidf_(a0[e] + acc[i][j][e]);
                            *(u32x2*)(ar + j * 16) = pack4(o);
                        }
                    }
                }, lds);
        }
        {
            APlain ap{lora + 64, 160};
            gemm_stream<4, 4, 2, 32, 4>(ap, p.wgate_t, 96, 96, 4, [](int u, int& ao, int& bo) { ao = 0; bo = u * 128 * 96; },
                [&](const int ct, f32x4 (&acc)[4][4]) {
                    int tl = t; LAUNDER(tl);
                    const int lane = tl & 63, wid = tl >> 6, wr = wid >> 1, wc = wid & 1, r = lane & 15, q = lane >> 4, head = ct * 2 + wc;
#pragma unroll
                    for (int i = 0; i < 4; ++i) {
                        const int grow = rt * 128 + wr * 64 + i * 16 + r;
                        bf16_t* g = p.Gg + (size_t)grow * 512 + head * 64 + q * 4;
#pragma unroll
                        for (int j = 0; j < 4; ++j) *(u32x2*)(g + j * 16) = pack4(acc[i][j]);
                    }
                }, lds);
        }
        asm volatile("s_waitcnt vmcnt(0)" ::: "memory");
        __syncthreads();
#pragma unroll 1
        for (int it = 0; it < 16; ++it) {
            int tl = t; LAUNDER(tl);
            const int lane = tl & 63, w = tl >> 6, c8 = lane * 8;
#pragma unroll
            for (int u = 0; u < 2; ++u) {
                const int row = w + 4 * (it * 2 + u), grow = rt * 128 + row, b = grow >> 12, tt = grow & 4095;
                const bool hp = tt > 0;
                const bf16_t* urow = p.U + (size_t)grow * LDU + c8;
                float kc[8], kp_[8], vc[8], vp[8], rc[8], rp[8], av[8];
                unpack8(*(const u32x4*)(urow + UK), kc); unpack8(*(const u32x4*)(urow + UV), vc); unpack8(*(const u32x4*)(urow + UR), rc);
                unpack8(*(const u32x4*)(abuf + row * 512 + c8), av);
                if (hp) { unpack8(*(const u32x4*)(urow + UK - LDU), kp_); unpack8(*(const u32x4*)(urow + UV - LDU), vp); unpack8(*(const u32x4*)(urow + UR - LDU), rp); }
                else {
#pragma unroll
                    for (int e = 0; e < 8; ++e) { kp_[e] = 0.f; vp[e] = 0.f; rp[e] = 0.f; } }
                float mk[8], mv[8], mr[8], kkw[8], kaw[8];
                *(f32x4*)(mk) = *(const f32x4*)(p.rwkv_mu + 512 + c8); *(f32x4*)(mk + 4) = *(const f32x4*)(p.rwkv_mu + 512 + c8 + 4);
                *(f32x4*)(mv) = *(const f32x4*)(p.rwkv_mu + 1024 + c8); *(f32x4*)(mv + 4) = *(const f32x4*)(p.rwkv_mu + 1024 + c8 + 4);
                *(f32x4*)(mr) = *(const f32x4*)(p.rwkv_mu + c8); *(f32x4*)(mr + 4) = *(const f32x4*)(p.rwkv_mu + c8 + 4);
                *(f32x4*)(kkw) = *(const f32x4*)(p.k_k + c8); *(f32x4*)(kkw + 4) = *(const f32x4*)(p.k_k + c8 + 4);
                *(f32x4*)(kaw) = *(const f32x4*)(p.k_a + c8); *(f32x4*)(kaw + 4) = *(const f32x4*)(p.k_a + c8 + 4);
                float ks[8], kq[8], ssq = 0.f;
#pragma unroll
                for (int e = 0; e < 8; ++e) { ks[e] = kc[e] + (kp_[e] - kc[e]) * mk[e]; kq[e] = ks[e] * kkw[e]; ssq += kq[e] * kq[e]; }
                ssq = dpp_sum8(ssq);
                const float rn = rsqrtf(fmaxf(ssq, 1e-24f));
                float okk[8], obb[8], okp[8], ov[8], orr[8];
#pragma unroll
                for (int e = 0; e < 8; ++e) {
                    okk[e] = kq[e] * rn; obb[e] = av[e] * okk[e]; okp[e] = ks[e] * (1.0f + (av[e] - 1.0f) * kaw[e]);
                    ov[e] = vc[e] + (vp[e] - vc[e]) * mv[e]; orr[e] = rc[e] + (rp[e] - rc[e]) * mr[e];
                }
                bf16_t* sc = p.SC + ((size_t)(b * 8 + (lane >> 3)) * NT_ + tt) * 384 + (lane & 7) * 8;
                *(u32x4*)(sc + 64) = mk4(pk2(okk[0], okk[1]), pk2(okk[2], okk[3]), pk2(okk[4], okk[5]), pk2(okk[6], okk[7]));
                *(u32x4*)(sc + 128) = mk4(pk2(obb[0], obb[1]), pk2(obb[2], obb[3]), pk2(obb[4], obb[5]), pk2(obb[6], obb[7]));
                *(u32x4*)(sc + 192) = mk4(pk2(okp[0], okp[1]), pk2(okp[2], okp[3]), pk2(okp[4], okp[5]), pk2(okp[6], okp[7]));
                *(u32x4*)(sc + 256) = mk4(pk2(ov[0], ov[1]), pk2(ov[2], ov[3]), pk2(ov[4], ov[5]), pk2(ov[6], ov[7]));
                *(u32x4*)(sc + 320) = mk4(pk2(orr[0], orr[1]), pk2(orr[2], orr[3]), pk2(orr[4], orr[5]), pk2(orr[6], orr[7]));
            }
        }
    }
}

struct ScanOps { f32x2_t d[4], k[4], b[4], p[4], r[4]; float v; };
DI void scan_load(ScanOps& o, const float* __restrict__ q, const float* __restrict__ vp) {
    const f32x4 d0 = *(const f32x4*)(q), d1 = *(const f32x4*)(q + 4), k0 = *(const f32x4*)(q + 64), k1 = *(const f32x4*)(q + 68);
    const f32x4 b0 = *(const f32x4*)(q + 128), b1 = *(const f32x4*)(q + 132), p0 = *(const f32x4*)(q + 192), p1 = *(const f32x4*)(q + 196);
    const f32x4 r0 = *(const f32x4*)(q + 320), r1 = *(const f32x4*)(q + 324);
    o.d[0] = (f32x2_t){d0[0], d0[1]}; o.d[1] = (f32x2_t){d0[2], d0[3]}; o.d[2] = (f32x2_t){d1[0], d1[1]}; o.d[3] = (f32x2_t){d1[2], d1[3]};
    o.k[0] = (f32x2_t){k0[0], k0[1]}; o.k[1] = (f32x2_t){k0[2], k0[3]}; o.k[2] = (f32x2_t){k1[0], k1[1]}; o.k[3] = (f32x2_t){k1[2], k1[3]};
    o.b[0] = (f32x2_t){b0[0], b0[1]}; o.b[1] = (f32x2_t){b0[2], b0[3]}; o.b[2] = (f32x2_t){b1[0], b1[1]}; o.b[3] = (f32x2_t){b1[2], b1[3]};
    o.p[0] = (f32x2_t){p0[0], p0[1]}; o.p[1] = (f32x2_t){p0[2], p0[3]}; o.p[2] = (f32x2_t){p1[0], p1[1]}; o.p[3] = (f32x2_t){p1[2], p1[3]};
    o.r[0] = (f32x2_t){r0[0], r0[1]}; o.r[1] = (f32x2_t){r0[2], r0[3]}; o.r[2] = (f32x2_t){r1[0], r1[1]}; o.r[3] = (f32x2_t){r1[2], r1[3]};
    o.v = *vp;
}
DI void scan_task(const Params& p, unsigned char* lds, const int task) {
    constexpr int CS = 16;
    const int t = TID, lane = t & 63, w = t >> 6;
    const int bh = task >> 1, hf = task & 1, b = bh >> 3, head = bh & 7;
    const int rloc = w * 8 + (lane >> 3), kseg = lane & 7;
    const int vrow = hf * 32 + rloc;
    float* stage = (float*)lds;
    float* ybuf = (float*)(lds + 49152);
    const bf16_t* src = p.SC + (size_t)bh * NT_ * 384;
    f32x2_t s2[4];
#pragma unroll
    for (int j = 0; j < 4; ++j) s2[j] = (f32x2_t){0.f, 0.f};
    u32x4 rg[3];
    __builtin_amdgcn_s_setprio(3);
    __syncthreads();
#pragma unroll
    for (int i = 0; i < 3; ++i) rg[i] = *(const u32x4*)(src + (size_t)(t + 256 * i) * 8);
#pragma unroll
    for (int i = 0; i < 3; ++i) { float* d = stage + (t + 256 * i) * 8;
        *(f32x4*)d = (f32x4){lo2f(rg[i].x), hi2f(rg[i].x), lo2f(rg[i].y), hi2f(rg[i].y)}; *(f32x4*)(d + 4) = (f32x4){lo2f(rg[i].z), hi2f(rg[i].z), lo2f(rg[i].w), hi2f(rg[i].w)}; }
    __syncthreads();
    constexpr int NCH = NT_ / CS;
    for (int c = 0; c < NCH; ++c) {
        const int cur = c & 1;
        if (c + 1 < NCH) {
#pragma unroll
            for (int i = 0; i < 3; ++i) rg[i] = *(const u32x4*)(src + (size_t)(c + 1) * CS * 384 + (size_t)(t + 256 * i) * 8);
        }
        if (c > 0) {
            const float* yb = ybuf + (cur ^ 1) * CS * 32;
            const int st = t >> 4, r2 = (t & 15) * 2;
            *(f32x2_t*)(p.yraw + ((size_t)(b * NT_ + (c - 1) * CS + st)) * 512 + head * 64 + hf * 32 + r2) = *(const f32x2_t*)(yb + st * 32 + r2);
        }
        const float* sb = stage + cur * CS * 384 + kseg * 8;
        float* yb = ybuf + cur * CS * 32;
        float yv[CS];
        ScanOps oc, on;
        scan_load(oc, sb, sb + 256 - kseg * 8 + vrow);
#pragma unroll
        for (int st = 0; st < CS; ++st) {
            if (st + 1 < CS) scan_load(on, sb + (st + 1) * 384, sb + (st + 1) * 384 + 256 - kseg * 8 + vrow);
            f32x2_t t0 = s2[0] * oc.k[0], t1 = s2[1] * oc.k[1];
            t0 = s2[2] * oc.k[2] + t0; t1 = s2[3] * oc.k[3] + t1;
            t0 = t0 + t1;
            float dot = dpp_sum8(t0.x + t0.y);
            const f32x2_t vv2 = {oc.v, oc.v}, nd2 = {-dot, -dot};
            f32x2_t u0, u1;
#pragma unroll
            for (int j = 0; j < 4; ++j) { f32x2_t tmp = s2[j] - s2[j] * oc.d[j]; tmp = vv2 * oc.p[j] + tmp; s2[j] = nd2 * oc.b[j] + tmp; }
            u0 = s2[0] * oc.r[0]; u1 = s2[1] * oc.r[1];
            u0 = s2[2] * oc.r[2] + u0; u1 = s2[3] * oc.r[3] + u1;
            u0 = u0 + u1;
            yv[st] = dpp_sum8(u0.x + u0.y);
            if (st + 1 < CS) oc = on;
        }
        if (kseg == 0) {
#pragma unroll
            for (int st = 0; st < CS; ++st) yb[st * 32 + rloc] = yv[st];
        }
        if (c + 1 < NCH) {
            float* dbase = stage + (cur ^ 1) * CS * 384;
#pragma unroll
            for (int i = 0; i < 3; ++i) { float* d = dbase + (t + 256 * i) * 8;
                *(f32x4*)d = (f32x4){lo2f(rg[i].x), hi2f(rg[i].x), lo2f(rg[i].y), hi2f(rg[i].y)}; *(f32x4*)(d + 4) = (f32x4){lo2f(rg[i].z), hi2f(rg[i].z), lo2f(rg[i].w), hi2f(rg[i].w)}; }
        }
        __syncthreads();
    }
    {
        const float* yb = ybuf + ((NCH - 1) & 1) * CS * 32;
        const int st = t >> 4, r2 = (t & 15) * 2;
        *(f32x2_t*)(p.yraw + ((size_t)(b * NT_ + (NCH - 1) * CS + st)) * 512 + head * 64 + hf * 32 + r2) = *(const f32x2_t*)(yb + st * 32 + r2);
    }
    __builtin_amdgcn_s_setprio(0);
}

DI void attn_item(const Params& p, unsigned char* lds, const int item) {
    constexpr int KROW = 208, VROW = 136, KB = 64 * KROW, BUF = KB + 64 * VROW;
    const int t = TID, lane = t & 63, w = t >> 6, l31 = lane & 31, h = lane >> 5;
    const int qt = 31 - item / 128, bh = item % 128;
    const bf16_t* Kg = p.Kb + (size_t)bh * NT_ * 96;
    const bf16_t* Vg = p.Vt + (size_t)bh * 64 * NT_;
    const int q = qt * 128 + w * 32 + l31;
    bf16x8 qf[6];
    {
        const bf16_t* qrow = p.Q + ((size_t)bh * NT_ + q) * 96 + 8 * h;
#pragma unroll
        for (int s = 0; s < 6; ++s) qf[s] = *(const bf16x8*)(qrow + 16 * s);
    }
    f32x16 O[2];
#pragma unroll
    for (int i = 0; i < 16; ++i) { O[0][i] = 0.f; O[1][i] = 0.f; }
    float m = -INFINITY, l = 0.f;
    const int njt = 2 * qt + 2;
    int koff[3], kgo[3], voff[2], vgo[2];
#pragma unroll
    for (int i = 0; i < 3; ++i) { const int c = t + 256 * i, r = c / 12, ch = c - r * 12; koff[i] = r * KROW + ch * 16; kgo[i] = r * 96 + ch * 8; }
#pragma unroll
    for (int i = 0; i < 2; ++i) { const int c = t + 256 * i, dv = c >> 3, ch = c & 7; voff[i] = KB + dv * VROW + ch * 16; vgo[i] = dv * NT_ + ch * 8; }
    u32x4 rk0[3], rv0[2], rk1[3], rv1[2];
#define AT_LOAD(RK, RV, J) { _Pragma("unroll") for (int i = 0; i < 3; ++i) RK[i] = *(const u32x4*)(Kg + (size_t)(J) * 64 * 96 + kgo[i]); \
                             _Pragma("unroll") for (int i = 0; i < 2; ++i) RV[i] = *(const u32x4*)(Vg + (J) * 64 + vgo[i]); }
#define AT_WRITE(RK, RV, BUFI) { unsigned char* nb = lds + (BUFI) * BUF; _Pragma("unroll") for (int i = 0; i < 3; ++i) *(u32x4*)(nb + koff[i]) = RK[i]; \
                             _Pragma("unroll") for (int i = 0; i < 2; ++i) { *(u32x2*)(nb + voff[i]) = mk2(RV[i].x, RV[i].y); *(u32x2*)(nb + voff[i] + 8) = mk2(RV[i].z, RV[i].w); } }
    auto tile_compute = [&](const int cur, const int j) {
        const bool active = (j * 64) <= (qt * 128 + w * 32 + 31);
        if (active) {
            const unsigned char* Kt = lds + cur * BUF;
            const unsigned char* Vtile = Kt + KB;
            f32x16 S[2];
#pragma unroll
            for (int k2 = 0; k2 < 2; ++k2) {
#pragma unroll
                for (int i = 0; i < 16; ++i) S[k2][i] = 0.f;
#pragma unroll
                for (int s = 0; s < 6; ++s) {
                    const bf16x8 kf = *(const bf16x8*)(Kt + (k2 * 32 + l31) * KROW + s * 32 + h * 16);
                    S[k2] = __builtin_amdgcn_mfma_f32_32x32x16_bf16(kf, qf[s], S[k2], 0, 0, 0);
                }
            }
            if (j >= 2 * qt) {
#pragma unroll
                for (int k2 = 0; k2 < 2; ++k2)
#pragma unroll
                    for (int i = 0; i < 16; ++i) { const int key = j * 64 + k2 * 32 + (i & 3) + 8 * (i >> 2) + 4 * h; if (key > q) S[k2][i] = -INFINITY; }
            }
            float mx = S[0][0];
#pragma unroll
            for (int i = 1; i < 16; ++i) mx = fmaxf(mx, S[0][i]);
#pragma unroll
            for (int i = 0; i < 16; ++i) mx = fmaxf(mx, S[1][i]);
            mx = fmaxf(mx, __shfl_xor(mx, 32));
            if (__any(mx > m)) {
                const float mn = fmaxf(m, mx);
                const float alpha = __builtin_amdgcn_exp2f(m - mn);
                m = mn; l *= alpha;
#pragma unroll
                for (int i = 0; i < 16; ++i) { O[0][i] *= alpha; O[1][i] *= alpha; }
            }
            f32x2_t ps2 = {0.f, 0.f};
#pragma unroll
            for (int k2 = 0; k2 < 2; ++k2)
#pragma unroll
                for (int i = 0; i < 16; i += 2) {
                    const float e0 = __builtin_amdgcn_exp2f(S[k2][i] - m), e1 = __builtin_amdgcn_exp2f(S[k2][i + 1] - m);
                    S[k2][i] = e0; S[k2][i + 1] = e1; ps2 += (f32x2_t){e0, e1};
                }
            l += ps2.x + ps2.y;
#pragma unroll
            for (int k2 = 0; k2 < 2; ++k2)
#pragma unroll
                for (int s2 = 0; s2 < 2; ++s2) {
                    unsigned pw[4];
#pragma unroll
                    for (int e = 0; e < 4; ++e) pw[e] = pk2(S[k2][8 * s2 + 2 * e], S[k2][8 * s2 + 2 * e + 1]);
                    const bf16x8 pf = __builtin_bit_cast(bf16x8, mk4(pw[0], pw[1], pw[2], pw[3]));
#pragma unroll
                    for (int dt = 0; dt < 2; ++dt) {
                        const unsigned char* vp = Vtile + (dt * 32 + l31) * VROW + (k2 * 32 + s2 * 16 + 4 * h) * 2;
                        const u32x2 v0 = *(const u32x2*)(vp), v1 = *(const u32x2*)(vp + 16);
                        const bf16x8 vf = __builtin_bit_cast(bf16x8, mk4(v0.x, v0.y, v1.x, v1.y));
                        O[dt] = __builtin_amdgcn_mfma_f32_32x32x16_bf16(vf, pf, O[dt], 0, 0, 0);
                    }
                }
        }
    };
    AT_LOAD(rk0, rv0, 0)
    if (njt > 1) AT_LOAD(rk1, rv1, 1)
    __syncthreads();
    AT_WRITE(rk0, rv0, 0)
    if (njt > 2) AT_LOAD(rk0, rv0, 2)
    __syncthreads();
#pragma unroll 1
    for (int j = 0; j < njt; j += 2) {
        tile_compute(0, j);
        if (j + 1 < njt) { AT_WRITE(rk1, rv1, 1) if (j + 3 < njt) AT_LOAD(rk1, rv1, j + 3) }
        __syncthreads();
        if (j + 1 >= njt) break;
        tile_compute(1, j + 1);
        if (j + 2 < njt) { AT_WRITE(rk0, rv0, 0) if (j + 4 < njt) AT_LOAD(rk0, rv0, j + 4) }
        __syncthreads();
    }
#undef AT_LOAD
#undef AT_WRITE
    l += __shfl_xor(l, 32);
    const float inv = 1.0f / l;
    bf16_t* yrow = p.Y + ((size_t)((bh >> 3) * NT_ + q)) * DM + 512 + (bh & 7) * 64;
#pragma unroll
    for (int dt = 0; dt < 2; ++dt)
#pragma unroll
        for (int g = 0; g < 4; ++g)
            *(u32x2*)(yrow + dt * 32 + 8 * g + 4 * h) = mk2(pk2(O[dt][4 * g] * inv, O[dt][4 * g + 1] * inv), pk2(O[dt][4 * g + 2] * inv, O[dt][4 * g + 3] * inv));
}

constexpr int REC_BYTES = 12544;
typedef short s16x4 __attribute__((ext_vector_type(4)));
DI f32x4 mfma16(const s16x4 a, const s16x4 b, const f32x4 c) { return __builtin_amdgcn_mfma_f32_16x16x16bf16_1k(a, b, c, 0, 0, 0); }
DI s16x4 cvt4(const f32x4 v) { return __builtin_bit_cast(s16x4, mk2(pk2(v[0], v[1]), pk2(v[2], v[3]))); }
DI void scan_fused(const Params& p, unsigned char* lds, const int bh) {
    int t = TID; LAUNDER(t);
    const int lane = t & 63, w = t >> 6, r = lane & 15, g = lane >> 4;
    const int b = bh >> 3, head = bh & 7;
    unsigned char* slot = lds + w * REC_BYTES;
    unsigned char* scr = lds + 4 * REC_BYTES + w * 5120;
    float* AT = (float*)(scr + 4096);
    const bf16_t* scbase = p.SC + (size_t)bh * NT_ * 384;
    f32x4 St[4];
#pragma unroll
    for (int m = 0; m < 4; ++m) St[m] = (f32x4){0.f, 0.f, 0.f, 0.f};
    u32x4 raw[12];
    {
        const u32x4* src = (const u32x4*)(scbase + (size_t)w * 16 * 384);
#pragma unroll
        for (int i = 0; i < 12; ++i) raw[i] = src[lane + 64 * i];
    }
    const int offk = (lane >> 4) * 512 + ((lane >> 2) & 3) * 128 + (lane & 3) * 2;
    const int offt = (lane >> 4) * 512 + (lane & 15) * 8;
    __builtin_amdgcn_s_setprio(3);
    __syncthreads();
#pragma unroll 1
    for (int rd = 0; rd < 64; ++rd) {
#pragma unroll
        for (int i = 0; i < 12; ++i) *(u32x4*)(slot + (lane + 64 * i) * 16) = raw[i];
        if (rd + 1 < 64) {
            const u32x4* src = (const u32x4*)(scbase + (size_t)(4 * (rd + 1) + w) * 16 * 384);
#pragma unroll
            for (int i = 0; i < 12; ++i) raw[i] = src[lane + 64 * i];
        }
        {
            const bf16_t* rawl = (const bf16_t*)slot + lane;
            bf16_t vkap[16], vbet[16], vkt[16], vrt[16], vv[16];
            float L = 0.f, ex = 1.f;
#pragma unroll
            for (int j = 0; j < 16; ++j) {
                const float d = bf2f(rawl[j * 384]), kap = bf2f(rawl[j * 384 + 64]), bet = bf2f(rawl[j * 384 + 128]), kk = bf2f(rawl[j * 384 + 192]), rr = bf2f(rawl[j * 384 + 320]);
                vv[j] = rawl[j * 384 + 256];
                L += __logf(1.0f - d);
                const float el = __expf(L), ei = __expf(-L);
                vkap[j] = f2bf(kap * ex); vbet[j] = f2bf(bet * ei); vkt[j] = f2bf(kk * ei); vrt[j] = f2bf(rr * el);
                ex = el;
            }
            const float gam = ex;
#pragma unroll
            for (int j = 0; j < 16; ++j) {
                *(bf16_t*)(slot + offk + j * 8) = vkap[j];
                *(bf16_t*)(slot + 2048 + offk + j * 8) = vrt[j];
                *(bf16_t*)(slot + 4096 + offt + (j >> 2) * 128 + (j & 3) * 2) = vkt[j];
                *(bf16_t*)(slot + 6144 + offt + (j >> 2) * 128 + (j & 3) * 2) = (bf16_t)(vbet[j] ^ 0x8000u);
                *(bf16_t*)(scr + offk + j * 8) = vkt[j];
                *(bf16_t*)(scr + 2048 + offk + j * 8) = vbet[j];
            }
            unsigned vw[8];
#pragma unroll
            for (int i = 0; i < 8; ++i) vw[i] = (unsigned)vv[2 * i] | ((unsigned)vv[2 * i + 1] << 16);
            *(u32x4*)(slot + 10240 + lane * 32) = mk4(vw[0], vw[1], vw[2], vw[3]);
            *(u32x4*)(slot + 10240 + lane * 32 + 16) = mk4(vw[4], vw[5], vw[6], vw[7]);
            *(float*)(slot + 12288 + lane * 4) = gam;
        }
        {
            f32x4 dB = {0.f, 0.f, 0.f, 0.f}, dE = dB, dF = dB, dA = dB;
#pragma unroll
            for (int m = 0; m < 4; ++m) {
                const s16x4 fk = *(const s16x4*)(slot + m * 512 + lane * 8), fr = *(const s16x4*)(slot + 2048 + m * 512 + lane * 8);
                const s16x4 ft = *(const s16x4*)(scr + m * 512 + lane * 8), fb = *(const s16x4*)(scr + 2048 + m * 512 + lane * 8);
                dB = mfma16(ft, fk, dB); dE = mfma16(ft, fr, dE); dF = mfma16(fb, fr, dF); dA = mfma16(fb, fk, dA);
            }
            f32x4 oB, oE, oF;
#pragma unroll
            for (int jj = 0; jj < 4; ++jj) {
                const int i = 4 * g + jj;
                oB[jj] = i < r ? dB[jj] : 0.f; oE[jj] = i <= r ? dE[jj] : 0.f; oF[jj] = i <= r ? -dF[jj] : 0.f;
                AT[i * 16 + r] = i < r ? dA[jj] : 0.f;
            }
            *(s16x4*)(slot + 16 * 512 + lane * 8) = cvt4(oB);
            *(s16x4*)(slot + 18 * 512 + lane * 8) = cvt4(oE);
            *(s16x4*)(slot + 19 * 512 + lane * 8) = cvt4(oF);
            float T[16];
#pragma unroll
            for (int i = 15; i >= 0; --i) {
                float a0 = (i == r) ? 1.f : 0.f, a1 = 0.f;
#pragma unroll
                for (int q4 = (i + 1) >> 2; q4 < 4; ++q4) {
                    const f32x4 av = *(const f32x4*)(AT + i * 16 + q4 * 4);
#pragma unroll
                    for (int e = 0; e < 4; ++e) { const int m = q4 * 4 + e; if (m > i) { if (e & 1) a1 -= av[e] * T[m]; else a0 -= av[e] * T[m]; } }
                }
                T[i] = (i <= r) ? a0 + a1 : 0.f;
            }
            f32x4 oT;
#pragma unroll
            for (int jj = 0; jj < 4; ++jj) oT[jj] = g == 0 ? T[jj] : (g == 1 ? T[4 + jj] : (g == 2 ? T[8 + jj] : T[12 + jj]));
            *(s16x4*)(slot + 17 * 512 + lane * 8) = cvt4(oT);
        }
        __syncthreads();
#pragma unroll 1
        for (int cc = 0; cc < 4; ++cc) {
            const unsigned char* buf = lds + cc * REC_BYTES;
            s16x4 fr[20];
#pragma unroll
            for (int f = 0; f < 20; ++f) fr[f] = *(const s16x4*)(buf + f * 512 + lane * 8);
            const s16x4 vf = *(const s16x4*)(buf + 10240 + (16 * w + r) * 32 + g * 8);
            s16x4 sb[4];
#pragma unroll
            for (int m = 0; m < 4; ++m) sb[m] = cvt4(St[m]);
            f32x4 X = {0.f, 0.f, 0.f, 0.f}, Yv = X;
#pragma unroll
            for (int m = 0; m < 4; ++m) { X = mfma16(fr[m], sb[m], X); Yv = mfma16(fr[4 + m], sb[m], Yv); }
            X = mfma16(fr[16], vf, X); Yv = mfma16(fr[18], vf, Yv);
            const s16x4 xb = cvt4(X);
            const f32x4 P = mfma16(fr[17], xb, (f32x4){0.f, 0.f, 0.f, 0.f});
            const s16x4 pb = cvt4(P);
            Yv = mfma16(fr[19], pb, Yv);
#pragma unroll
            for (int m = 0; m < 4; ++m) {
                St[m] = mfma16(fr[8 + m], vf, St[m]);
                St[m] = mfma16(fr[12 + m], pb, St[m]);
                St[m] = St[m] * *(const f32x4*)(buf + 12288 + (16 * m + 4 * g) * 4);
            }
            float* yo = p.yraw + ((size_t)(b * NT_ + (4 * rd + cc) * 16 + 4 * g)) * 512 + head * 64 + 16 * w + r;
#pragma unroll
            for (int jj = 0; jj < 4; ++jj) yo[jj * 512] = Yv[jj];
        }
        __syncthreads();
    }
    __builtin_amdgcn_s_setprio(0);
}

DI void phase4(const Params& p, unsigned char* lds, int bid, int G) {
#if SCAN_CHUNKED
    for (int bh = bid; bh < 128; bh += G) scan_fused(p, lds, bh);
#else
    for (int task = bid; task < 256; task += G) scan_task(p, lds, task);
#endif
    STAMP(10);
    int* sh_pair = (int*)(smem + SH_PAIR_OFF);
    for (;;) {
        __syncthreads();
        if (threadIdx.x == 0) *sh_pair = (int)atomicAdd(&p.ctrl[CTRL_ATTNQ], 1u);
        __syncthreads();
        const int k = *sh_pair;
        if (k >= 2048) break;
        attn_item(p, lds, 2 * k + HALF_ID);
    }
}

DI void phase5(const Params& p, unsigned char* lds, int bid, int G) {
    const int t = TID, lane = t & 63, wid = t >> 6, wr = wid >> 1, wc = wid & 1;
    float* tile = (float*)lds;
    float* ssq = (float*)(lds + 69632);
    float* biasl = ssq + 128;
    int* lcnt = (int*)(lds + 65536);
    int* lbase = lcnt + 256;
    unsigned char* le = (unsigned char*)(lbase + 256);
    unsigned char* lp = le + 1024;
    __syncthreads();
    biasl[t] = p.router_bias[t];
    float* scores = (float*)(p.bscr + (size_t)bid * BSCR_PER_BLOCK);
    bf16_t* act = (bf16_t*)(p.bscr + (size_t)bid * BSCR_PER_BLOCK + 131072);
    for (int rt = bid; rt < NTOK / 128; rt += G) {
        const int b = rt >> 5;
        const float* mod = p.mod + b * 6144;
        __syncthreads();
        if (t < 128) ssq[t] = 0.f;
        lcnt[t] = 0;
#pragma unroll 2
        for (int it = 0; it < 16; ++it) {
            int tl = t; LAUNDER(tl);
            const int pr = (tl >> 2) + 64 * it;
            const int row = pr >> 3, head = pr & 7, part = tl & 3, grow = rt * 128 + row, tt = grow & 4095;
            const int ch = head * 64 + part * 16;
            const float* yr = p.yraw + (size_t)grow * 512 + ch;
            float y[16];
#pragma unroll
            for (int i = 0; i < 4; ++i) { const f32x4 v = *(const f32x4*)(yr + 4 * i); y[4 * i] = v[0]; y[4 * i + 1] = v[1]; y[4 * i + 2] = v[2]; y[4 * i + 3] = v[3]; }
            float sm = 0.f;
#pragma unroll
            for (int i = 0; i < 16; ++i) sm += y[i];
            sm += __shfl_xor(sm, 1); sm += __shfl_xor(sm, 2);
            const float mean = sm * (1.0f / 64.0f);
            float vr = 0.f;
#pragma unroll
            for (int i = 0; i < 16; ++i) { const float d = y[i] - mean; vr += d * d; }
            vr += __shfl_xor(vr, 1); vr += __shfl_xor(vr, 2);
            const float rs = rsqrtf(vr * (1.0f / 64.0f) + 64e-5f);
            const bf16_t* sc = p.SC + ((size_t)(b * 8 + head) * NT_ + tt) * 384 + part * 16;
            float kp[16], vv[16], rr[16];
#pragma unroll
            for (int i = 0; i < 2; ++i) {
                const u32x4 a = *(const u32x4*)(sc + 192 + 8 * i), c = *(const u32x4*)(sc + 256 + 8 * i), d = *(const u32x4*)(sc + 320 + 8 * i);
                kp[8 * i] = lo2f(a.x); kp[8 * i + 1] = hi2f(a.x); kp[8 * i + 2] = lo2f(a.y); kp[8 * i + 3] = hi2f(a.y); kp[8 * i + 4] = lo2f(a.z); kp[8 * i + 5] = hi2f(a.z); kp[8 * i + 6] = lo2f(a.w); kp[8 * i + 7] = hi2f(a.w);
                vv[8 * i] = lo2f(c.x); vv[8 * i + 1] = hi2f(c.x); vv[8 * i + 2] = lo2f(c.y); vv[8 * i + 3] = hi2f(c.y); vv[8 * i + 4] = lo2f(c.z); vv[8 * i + 5] = hi2f(c.z); vv[8 * i + 6] = lo2f(c.w); vv[8 * i + 7] = hi2f(c.w);
                rr[8 * i] = lo2f(d.x); rr[8 * i + 1] = hi2f(d.x); rr[8 * i + 2] = lo2f(d.y); rr[8 * i + 3] = hi2f(d.y); rr[8 * i + 4] = lo2f(d.z); rr[8 * i + 5] = hi2f(d.z); rr[8 * i + 6] = lo2f(d.w); rr[8 * i + 7] = hi2f(d.w);
            }
            float bn = 0.f;
#pragma unroll
            for (int i = 0; i < 16; ++i) bn += rr[i] * kp[i] * p.r_k[ch + i];
            bn += __shfl_xor(bn, 1); bn += __shfl_xor(bn, 2);
            const bf16_t* gg = p.Gg + (size_t)grow * 512 + ch;
            const u32x4 g0 = *(const u32x4*)(gg), g1 = *(const u32x4*)(gg + 8);
            float g[16] = {lo2f(g0.x), hi2f(g0.x), lo2f(g0.y), hi2f(g0.y), lo2f(g0.z), hi2f(g0.z), lo2f(g0.w), hi2f(g0.w), lo2f(g1.x), hi2f(g1.x), lo2f(g1.y), hi2f(g1.y), lo2f(g1.z), hi2f(g1.z), lo2f(g1.w), hi2f(g1.w)};
            float o[16];
#pragma unroll
            for (int i = 0; i < 16; ++i) o[i] = ((y[i] - mean) * rs * p.ln_w[ch + i] + p.ln_b[ch + i] + bn * vv[i]) * g[i];
            bf16_t* yd = p.Y + (size_t)grow * DM + ch;
            *(u32x4*)(yd) = mk4(pk2(o[0], o[1]), pk2(o[2], o[3]), pk2(o[4], o[5]), pk2(o[6], o[7]));
            *(u32x4*)(yd + 8) = mk4(pk2(o[8], o[9]), pk2(o[10], o[11]), pk2(o[12], o[13]), pk2(o[14], o[15]));
        }
        asm volatile("s_waitcnt vmcnt(0)" ::: "memory");
        __syncthreads();
        STAMP(11);
        {
            APlain ap{p.Y + (size_t)rt * 128 * DM, DM};
            gemm_stream<4, 4, 2, 64, 4>(ap, p.wout_t, DM, DM, 8, [](int u, int& ao, int& bo) { ao = 0; bo = u * 128 * DM; },
                [&](const int ct, f32x4 (&acc)[4][4]) {
                    int ll = lane; LAUNDER(ll);
#pragma unroll
                    for (int i = 0; i < 4; ++i) {
                        const int row = wr * 64 + i * 16 + (ll & 15), grow = rt * 128 + row;
                        float sq = 0.f;
#pragma unroll
                        for (int j = 0; j < 4; ++j) {
                            const int col = ct * 128 + wc * 64 + j * 16 + (ll >> 4) * 4;
                            const f32x4 xv = *(const f32x4*)(p.x + (size_t)grow * DM + col), ga = *(const f32x4*)(mod + 2048 + col);
                            f32x4 o;
#pragma unroll
                            for (int e = 0; e < 4; ++e) { o[e] = xv[e] + ga[e] * acc[i][j][e]; sq += o[e] * o[e]; }
                            *(f32x4*)(p.out + (size_t)grow * DM + col) = o;
                        }
                        sq += __shfl_xor(sq, 16); sq += __shfl_xor(sq, 32);
                        if ((ll >> 4) == 0) atomicAdd(&ssq[row], sq);
                    }
                }, lds);
        }
        asm volatile("s_waitcnt vmcnt(0)" ::: "memory");
        __syncthreads();
        STAMP(12);
#pragma unroll 1
        for (int mg = 0; mg < 8; ++mg) {
            int ll = lane; LAUNDER(ll);
            f32x4 xv[4][4];
#pragma unroll
            for (int u = 0; u < 4; ++u)
#pragma unroll
                for (int i = 0; i < 4; ++i) xv[u][i] = *(const f32x4*)(p.out + (size_t)(rt * 128 + wid + 4 * (mg * 4 + u)) * DM + ll * 4 + 256 * i);
#pragma unroll
            for (int u = 0; u < 4; ++u) {
                const int r = wid + 4 * (mg * 4 + u), grow = rt * 128 + r;
                const float rs = rsqrtf(ssq[r] * (1.0f / DM) + 1e-6f);
#pragma unroll
                for (int i = 0; i < 4; ++i) {
                    const int c = ll * 4 + 256 * i;
                    const f32x4 g = *(const f32x4*)(p.norm_ffn + c), sh = *(const f32x4*)(mod + 3072 + c), sc = *(const f32x4*)(mod + 4096 + c);
                    float o[4];
#pragma unroll
                    for (int e = 0; e < 4; ++e) o[e] = xv[u][i][e] * rs * g[e] * (1.0f + sc[e]) + sh[e];
                    *(u32x2*)(p.H + (size_t)grow * DM + c) = mk2(pk2(o[0], o[1]), pk2(o[2], o[3]));
                }
            }
        }
        asm volatile("s_waitcnt vmcnt(0)" ::: "memory");
        __syncthreads();
        STAMP(13);
        {
            APlain ap{p.H + (size_t)rt * 128 * DM, DM};
            gemm_stream<4, 4, 2, 64, 4>(ap, p.wr_t, DM, DM, 2, [](int u, int& ao, int& bo) { ao = 0; bo = u * 128 * DM; },
                [&](const int ct, f32x4 (&acc)[4][4]) {
                    int ll = lane; LAUNDER(ll);
#pragma unroll
                    for (int i = 0; i < 4; ++i)
#pragma unroll
                        for (int j = 0; j < 4; ++j) {
                            const int row = wr * 64 + i * 16 + (ll & 15), col = ct * 128 + wc * 64 + j * 16 + (ll >> 4) * 4;
#pragma unroll
                            for (int e = 0; e < 4; ++e) scores[(col + e) * 128 + row] = sigmoidf_(acc[i][j][e]);
                        }
                }, lds);
        }
        asm volatile("s_waitcnt vmcnt(0)" ::: "memory");
        __syncthreads();
        STAMP(14);
#pragma unroll 1
        for (int hh = 0; hh < 2; ++hh) {
            __syncthreads();
            {
                int tl = t; LAUNDER(tl);
                f32x4 rgs[16];
#pragma unroll
                for (int i = 0; i < 16; ++i) { const int c = tl + 256 * i; rgs[i] = *(const f32x4*)(scores + (c >> 4) * 128 + hh * 64 + (c & 15) * 4); }
#pragma unroll
                for (int i = 0; i < 16; ++i) *(f32x4*)(tile + (tl + 256 * i) * 4) = rgs[i];
            }
            __syncthreads();
            if (t < 64) {
                int tl = t; LAUNDER(tl);
                const int token = rt * 128 + hh * 64 + tl;
                const float* sc = tile + tl;
                float gs[8];
#pragma unroll
                for (int g = 0; g < 8; ++g) {
                    float m1 = -INFINITY, m2 = -INFINITY;
#pragma unroll 8
                    for (int i = 0; i < 32; ++i) { const float v = sc[(g * 32 + i) * 64] + biasl[g * 32 + i]; m2 = fmaxf(m2, fminf(m1, v)); m1 = fmaxf(m1, v); }
                    gs[g] = m1 + m2;
                }
                unsigned selmask = 0u;
#pragma unroll
                for (int g = 0; g < 8; ++g) {
                    int rank = 0;
#pragma unroll
                    for (int g2 = 0; g2 < 8; ++g2) rank += (gs[g2] > gs[g] || (gs[g2] == gs[g] && g2 < g)) ? 1 : 0;
                    selmask |= (rank < 4 ? 1u : 0u) << g;
                }
                float tv[8]; int ti[8];
#pragma unroll
                for (int k = 0; k < 8; ++k) { tv[k] = -INFINITY; ti[k] = 0; }
#pragma unroll 1
                for (int g = 0; g < 8; ++g) {
                    if ((selmask >> g) & 1u) {
#pragma unroll 4
                        for (int i = 0; i < 32; ++i) {
                            const int e = g * 32 + i;
                            const float v = sc[e * 64] + biasl[e];
                            if (v > tv[7]) {
#pragma unroll
                                for (int k = 7; k >= 1; --k) {
                                    if (v > tv[k - 1]) { tv[k] = tv[k - 1]; ti[k] = ti[k - 1]; }
                                    else if (v > tv[k]) { tv[k] = v; ti[k] = e; }
                                }
                                if (v > tv[0]) { tv[0] = v; ti[0] = e; }
                            }
                        }
                    }
                }
                float ws[8], wsum = 0.f;
#pragma unroll
                for (int k = 0; k < 8; ++k) { ws[k] = sc[ti[k] * 64]; wsum += ws[k]; }
                const float sc25 = 2.5f / wsum;
#pragma unroll
                for (int k = 0; k < 8; ++k) {
                    p.topk_idx[token * 8 + k] = ti[k];
                    p.topk_w[token * 8 + k] = ws[k] * sc25;
                    le[(hh * 64 + tl) * 8 + k] = (unsigned char)ti[k];
                    lp[(hh * 64 + tl) * 8 + k] = (unsigned char)atomicAdd(&lcnt[ti[k]], 1);
                }
            }
        }
        __syncthreads();
        { const int c = lcnt[t]; lbase[t] = c > 0 ? (int)atomicAdd(&p.ctrl[CTRL_ECNT + t * ECNT_STRIDE], (unsigned)c) : 0; }
        __syncthreads();
#pragma unroll
        for (int i = 0; i < 4; ++i) {
            const int a = t + 256 * i, e = le[a];
            p.elist[(size_t)e * NTOK + lbase[e] + lp[a]] = (rt * 128) * 8 + a;
        }
        STAMP(15);
        {
            APlain ap{p.H + (size_t)rt * 128 * DM, DM};
            gemm_stream<4, 4, 2, 64, 4>(ap, p.wsgu_t, DM, DM, 4, [](int u, int& ao, int& bo) { ao = 0; bo = u * 128 * DM; },
                [&](const int ct, f32x4 (&acc)[4][4]) {
                    int ll = lane; LAUNDER(ll);
#pragma unroll
                    for (int i = 0; i < 4; ++i) {
                        bf16_t* d = act + (wr * 64 + i * 16 + (ll & 15)) * 256 + ct * 64 + wc * 32 + (ll >> 4) * 4;
#pragma unroll
                        for (int m = 0; m < 2; ++m) {
                            f32x4 o;
#pragma unroll
                            for (int e = 0; e < 4; ++e) { const float g = acc[i][2 * m][e]; o[e] = g * sigmoidf_(g) * acc[i][2 * m + 1][e]; }
                            *(u32x2*)(d + m * 16) = pack4(o);
                        }
                    }
                }, lds);
        }
        asm volatile("s_waitcnt vmcnt(0)" ::: "memory");
        __syncthreads();
        STAMP(16);
        {
            APlain ap{act, 256};
            gemm_stream<4, 4, 2, 64, 4>(ap, p.wsd_t, 256, 256, 8, [](int u, int& ao, int& bo) { ao = 0; bo = u * 128 * 256; },
                [&](const int ct, f32x4 (&acc)[4][4]) {
                    int ll = lane; LAUNDER(ll);
#pragma unroll
                    for (int i = 0; i < 4; ++i)
#pragma unroll
                        for (int j = 0; j < 4; ++j) {
                            const int row = wr * 64 + i * 16 + (ll & 15), grow = rt * 128 + row, col = ct * 128 + wc * 64 + j * 16 + (ll >> 4) * 4;
                            const f32x4 xv = *(const f32x4*)(p.out + (size_t)grow * DM + col), gf = *(const f32x4*)(mod + 5120 + col);
                            f32x4 o;
#pragma unroll
                            for (int e = 0; e < 4; ++e) o[e] = xv[e] + gf[e] * acc[i][j][e];
                            *(f32x4*)(p.out + (size_t)grow * DM + col) = o;
                        }
                }, lds);
        }
    }
}

DI void phase6_coop(const Params& p) {
    const int tid0 = (int)threadIdx.x;
    int* cpre = (int*)(smem + 131072);
    int* tmp = cpre + 264;
    int* rowslot = (int*)(smem + 131072 + 4096);
    float* roww = (float*)(rowslot + 256);
    int* sh = (int*)(smem + SH_PAIR_OFF);
    bf16_t* act = (bf16_t*)(p.bscr + (size_t)blockIdx.x * 2 * BSCR_PER_BLOCK);
    __syncthreads();
    if (tid0 < 256) tmp[tid0] = ((int)p.ctrl[CTRL_ECNT + tid0 * ECNT_STRIDE] + 255) >> 8;
    __syncthreads();
    if (tid0 < 8) { int sacc = 0; for (int k = 0; k < 32; ++k) { cpre[tid0 * 33 + k] = sacc; sacc += tmp[8 * k + tid0]; } cpre[tid0 * 33 + 32] = sacc; }
    __syncthreads();
    const int hq = (int)(xb_xcc_id() & 7u);
    int attempt = 0;
    for (;;) {
        const int qc = (hq + attempt) & 7;
        int tid = (int)threadIdx.x; LAUNDER(tid);
        __syncthreads();
        if (tid == 0) *sh = (int)atomicAdd(&p.ctrl[CTRL_Q6 + qc * 64], 1u);
        __syncthreads();
        const int idx = __builtin_amdgcn_readfirstlane(*sh);
        if (idx >= __builtin_amdgcn_readfirstlane(cpre[qc * 33 + 32])) { if (++attempt >= 8) break; continue; }
        int lo = 0, hi = 31;
        while (lo < hi) { const int mid = (lo + hi + 1) >> 1; if (__builtin_amdgcn_readfirstlane(cpre[qc * 33 + mid]) <= idx) lo = mid; else hi = mid - 1; }
        const int e = 8 * lo + qc, tl = idx - __builtin_amdgcn_readfirstlane(cpre[qc * 33 + lo]), cnt = __builtin_amdgcn_readfirstlane((int)p.ctrl[CTRL_ECNT + e * ECNT_STRIDE]);
        const int* el = p.elist + (size_t)e * NTOK + tl * 256;
        const int nvalid = cnt - tl * 256;
        if (tid < 256) {
            if (tid < nvalid) { const int ts = el[tid]; rowslot[tid] = ts; roww[tid] = p.topk_w[ts]; }
            else { rowslot[tid] = -1; roww[tid] = 0.f; }
        }
        unsigned gv[2][2];
        {
            int tl2 = tid; LAUNDER(tl2);
#pragma unroll
            for (int i = 0; i < 2; ++i) {
                int R, C; pg8::stage_rc(tl2 * 16 + i * 8192, R, C);
#pragma unroll
                for (int h = 0; h < 2; ++h) { const int r = h * 128 + R; const int tok = r < nvalid ? (el[r] >> 3) : 0; gv[h][i] = (unsigned)tok * 2048u + (unsigned)C * 2u; }
            }
        }
        __syncthreads();
        {
            pg8::Gemm g{p.H, p.wegu_t + (size_t)e * 512 * DM, 256, 512, DM};
            int nu = 2; asm volatile("" : "+s"(nu));
            pg8::PanelOrder S{nu};
            pg8::EpiSwiglu E{act};
            pg8::gemm_phase<pg8::EpiSwiglu, pg8::PanelOrder, true, true, true>((PG8_LAS unsigned char*)smem, g, S, E, gv);
        }
        asm volatile("s_waitcnt vmcnt(0)" ::: "memory");
        __syncthreads();
        {
            pg8::Gemm g{act, p.wed_t + (size_t)e * 1024 * 256, 256, 1024, 256};
            int nu = 4; asm volatile("" : "+s"(nu));
            pg8::PanelOrder S{nu};
            pg8::EpiSlot E{p.slot};
            pg8::gemm_phase<pg8::EpiSlot, pg8::PanelOrder, true, true, false>((PG8_LAS unsigned char*)smem, g, S, E, gv);
        }
    }
}

DI void phase7(const Params& p, int bid, int G) {
    const int lane = TID & 63, gw = bid * 4 + (TID >> 6), nw = G * 4;
    for (int row = gw; row < NTOK; row += nw) {
        const float* mod = p.mod + (row >> 12) * 6144 + 5120;
#pragma unroll
        for (int i = 0; i < 4; ++i) {
            const int c = lane * 4 + 256 * i;
            float s[4] = {0.f, 0.f, 0.f, 0.f};
#pragma unroll
            for (int k = 0; k < 8; ++k) { const u32x2 w = *(const u32x2*)(p.slot + ((size_t)row * 8 + k) * DM + c); s[0] += lo2f(w.x); s[1] += hi2f(w.x); s[2] += lo2f(w.y); s[3] += hi2f(w.y); }
            const f32x4 gf = *(const f32x4*)(mod + c);
            f32x4 o = *(const f32x4*)(p.out + (size_t)row * DM + c);
#pragma unroll
            for (int e = 0; e < 4; ++e) o[e] += gf[e] * s[e];
            *(f32x4*)(p.out + (size_t)row * DM + c) = o;
        }
    }
}

template <int PH> DI void run_phase(const Params& p, unsigned char* lds, int bid, int G) {
    if (PH == 0) phase0(p, lds, bid, G);
    if (PH == 1) phase1(p, bid, G);
    if (PH == 3) phase3(p, lds, bid, G);
    if (PH == 4) phase4(p, lds, bid, G);
    if (PH == 5) phase5(p, lds, bid, G);
    if (PH == 7) phase7(p, bid, G);
}

#if !ONE_LAUNCH
template <int PH> __global__ void __launch_bounds__(256, 2) phase_kernel(Params p) { run_phase<PH>(p, smem, blockIdx.x, gridDim.x); }
#endif

#if ONE_LAUNCH
__global__ void __launch_bounds__(512, 2) mega_kernel(Params p) {
    volatile LAS unsigned* st = (volatile LAS unsigned*)(smem + 2 * LDS_BYTES);
    if (threadIdx.x == 0) { st[0] = 0u; st[1] = 0u; st[2] = 0u; st[3] = 0u; }
    __syncthreads();
    XcdBarrier bar = xcd_barrier_post(p.ctrl, st);
    const int bid = blockIdx.x * 2 + HALF_ID, G = gridDim.x * 2;
    unsigned char* const lds_half = smem + HALF_ID * LDS_BYTES;
    STAMP(0);
    run_phase<0>(p, lds_half, bid, G); xcd_barrier(bar); STAMP(1);
    run_phase<1>(p, lds_half, bid, G); xcd_barrier(bar); STAMP(2);
    phase2_coop(p); xcd_barrier(bar); STAMP(3);
    run_phase<3>(p, lds_half, bid, G); xcd_barrier(bar); STAMP(4);
    run_phase<4>(p, lds_half, bid, G); xcd_barrier(bar); STAMP(5);
    run_phase<5>(p, lds_half, bid, G); xcd_barrier(bar); STAMP(6);
    phase6_coop(p); xcd_barrier(bar); STAMP(7);
    run_phase<7>(p, lds_half, bid, G);
#ifdef PROBE_A
    xcd_barrier(bar); STAMP(8);
    xcd_barrier(bar);
    {
        const unsigned long long* sp = (const unsigned long long*)(p.ctrl + CTRL_STAMP);
        const unsigned long long ta = __hip_atomic_load(sp + PROBE_A, __ATOMIC_RELAXED, __HIP_MEMORY_SCOPE_AGENT), tb = __hip_atomic_load(sp + PROBE_B, __ATOMIC_RELAXED, __HIP_MEMORY_SCOPE_AGENT);
        const unsigned long long t0 = __builtin_amdgcn_s_memrealtime();
        while (__builtin_amdgcn_s_memrealtime() - t0 < tb - ta) __builtin_amdgcn_s_sleep(8);
    }
#endif
}
#define OCC_KERNEL mega_kernel
#else
#define OCC_KERNEL phase_kernel<5>
#endif

static inline size_t al256(size_t x) { return (x + 255) & ~(size_t)255; }

extern "C" void kernel_launch(void* const* d_in, const int* in_sizes, int n_in, void* d_out, int out_size, void* d_ws, size_t ws_size, hipStream_t stream) {
    (void)in_sizes; (void)n_in; (void)out_size;
    Params p{};
    p.x = (const float*)d_in[0]; p.c = (const float*)d_in[1]; p.positions = (const int*)d_in[2]; p.ada_w = (const float*)d_in[3]; p.ada_b = (const float*)d_in[4];
    p.norm_mix = (const float*)d_in[5]; p.w_in = (const float*)d_in[6]; p.rwkv_mu = (const float*)d_in[7]; p.decay_w0 = (const float*)d_in[8]; p.decay_up = (const float*)d_in[9];
    p.iclr_a0 = (const float*)d_in[10]; p.iclr_up = (const float*)d_in[11]; p.gate_up = (const float*)d_in[12]; p.k_k = (const float*)d_in[13]; p.k_a = (const float*)d_in[14];
    p.r_k = (const float*)d_in[15]; p.ln_w = (const float*)d_in[16]; p.ln_b = (const float*)d_in[17]; p.q_a_norm = (const float*)d_in[18]; p.w_q_b = (const float*)d_in[19];
    p.kv_a_norm = (const float*)d_in[20]; p.w_kv_b = (const float*)d_in[21]; p.q_norm = (const float*)d_in[22]; p.k_norm = (const float*)d_in[23]; p.w_out = (const float*)d_in[24];
    p.norm_ffn = (const float*)d_in[25]; p.w_router = (const float*)d_in[26]; p.router_bias = (const float*)d_in[27]; p.w_e_gu = (const float*)d_in[28]; p.w_e_d = (const float*)d_in[29];
    p.w_sh_gu = (const float*)d_in[30]; p.w_sh_d = (const float*)d_in[31];
    p.out = (float*)d_out;

    constexpr int DYN_LDS = 2 * LDS_BYTES + 64;
    static int grid = 0;
    if (!grid) {
        int dev = 0, cus = 0, per_cu = 0;
        (void)hipGetDevice(&dev);
        (void)hipDeviceGetAttribute(&cus, hipDeviceAttributeMultiprocessorCount, dev);
#if ONE_LAUNCH
        (void)hipFuncSetAttribute((const void*)mega_kernel, hipFuncAttributeMaxDynamicSharedMemorySize, DYN_LDS);
#endif
#if !ONE_LAUNCH
        (void)hipFuncSetAttribute((const void*)phase_kernel<0>, hipFuncAttributeMaxDynamicSharedMemorySize, LDS_BYTES);
#endif
#if !ONE_LAUNCH
        (void)hipFuncSetAttribute((const void*)phase_kernel<1>, hipFuncAttributeMaxDynamicSharedMemorySize, LDS_BYTES);
#endif
#if !ONE_LAUNCH
        (void)hipFuncSetAttribute((const void*)phase_kernel<2>, hipFuncAttributeMaxDynamicSharedMemorySize, LDS_BYTES);
#endif
#if !ONE_LAUNCH
        (void)hipFuncSetAttribute((const void*)phase_kernel<3>, hipFuncAttributeMaxDynamicSharedMemorySize, LDS_BYTES);
#endif
#if !ONE_LAUNCH
        (void)hipFuncSetAttribute((const void*)phase_kernel<4>, hipFuncAttributeMaxDynamicSharedMemorySize, LDS_BYTES);
#endif
#if !ONE_LAUNCH
        (void)hipFuncSetAttribute((const void*)phase_kernel<5>, hipFuncAttributeMaxDynamicSharedMemorySize, LDS_BYTES);
#endif
#if !ONE_LAUNCH
        (void)hipFuncSetAttribute((const void*)phase_kernel<6>, hipFuncAttributeMaxDynamicSharedMemorySize, LDS_BYTES);
#endif
#if !ONE_LAUNCH
        (void)hipFuncSetAttribute((const void*)phase_kernel<7>, hipFuncAttributeMaxDynamicSharedMemorySize, LDS_BYTES);
#endif
        (void)hipOccupancyMaxActiveBlocksPerMultiprocessor(&per_cu, (const void*)OCC_KERNEL, 512, DYN_LDS);
        if (cus <= 0) cus = 256;
        if (per_cu < 1) per_cu = 1;
        grid = cus;
    }
    unsigned char* w = (unsigned char*)d_ws; size_t o = 0;
    auto take = [&](size_t bytes) { unsigned char* r = w + o; o = al256(o + bytes); return r; };
    p.ctrl = (unsigned*)take(CTRL_WORDS * 4);
    p.mod = (float*)take((size_t)NB * 6144 * 4);
    p.rope = (float*)take((size_t)NTOK * 32 * 4);
    p.win_t = (bf16_t*)take((size_t)LDU * 1024 * 2);
    p.wq_t = (bf16_t*)take((size_t)768 * 256 * 2);
    p.wkv_t = (bf16_t*)take((size_t)1024 * 128 * 2);
    p.wdec_t = (bf16_t*)take((size_t)512 * 32 * 2);
    p.wiclr_t = (bf16_t*)take((size_t)512 * 32 * 2);
    p.wgate_t = (bf16_t*)take((size_t)512 * 96 * 2);
    p.wout_t = (bf16_t*)take((size_t)1024 * 1024 * 2);
    p.wr_t = (bf16_t*)take((size_t)256 * 1024 * 2);
    p.wsgu_t = (bf16_t*)take((size_t)512 * 1024 * 2);
    p.wsd_t = (bf16_t*)take((size_t)1024 * 256 * 2);
    p.wegu_t = (bf16_t*)take((size_t)NEXP * 512 * 1024 * 2);
    p.wed_t = (bf16_t*)take((size_t)NEXP * 1024 * 256 * 2);
    p.H = (bf16_t*)take((size_t)NTOK * DM * 2);
    p.topk_idx = (int*)take((size_t)NTOK * 8 * 4);
    p.topk_w = (float*)take((size_t)NTOK * 8 * 4);
    p.elist = (int*)take((size_t)NEXP * NTOK * 4);
    p.bscr = take((size_t)grid * 2 * BSCR_PER_BLOCK);
    const size_t ov = o;
    p.U = (bf16_t*)take((size_t)NTOK * LDU * 2);
    p.Q = (bf16_t*)take((size_t)NTOK * 8 * 96 * 2);
    p.Kb = (bf16_t*)take((size_t)NTOK * 8 * 96 * 2);
    p.Vt = (bf16_t*)take((size_t)NTOK * 8 * 64 * 2);
    p.SC = (bf16_t*)take((size_t)NTOK * 8 * 384 * 2);
    p.Gg = (bf16_t*)take((size_t)NTOK * 512 * 2);
    p.yraw = (float*)take((size_t)NTOK * 512 * 4);
    p.Y = (bf16_t*)take((size_t)NTOK * DM * 2);
    p.slot = (bf16_t*)(w + ov);
    const size_t need_slot = ov + (size_t)NTOK * 8 * DM * 2;
    if (o > ws_size || need_slot > ws_size) { fprintf(stderr, "workspace too small: need %zu / %zu, have %zu\n", o, need_slot, ws_size); return; }

    (void)hipMemsetAsync(p.ctrl, 0, CTRL_WORDS * 4, stream);
#if ONE_LAUNCH
    hipLaunchKernelGGL(mega_kernel, dim3(grid), dim3(512), DYN_LDS, stream, p);
#else
    hipLaunchKernelGGL(phase_kernel<0>, dim3(grid), dim3(256), LDS_BYTES, stream, p);
    hipLaunchKernelGGL(phase_kernel<1>, dim3(grid), dim3(256), LDS_BYTES, stream, p);
    hipLaunchKernelGGL(phase_kernel<2>, dim3(grid), dim3(256), LDS_BYTES, stream, p);
    hipLaunchKernelGGL(phase_kernel<3>, dim3(grid), dim3(256), LDS_BYTES, stream, p);
    hipLaunchKernelGGL(phase_kernel<4>, dim3(grid), dim3(256), LDS_BYTES, stream, p);
    hipLaunchKernelGGL(phase_kernel<5>, dim3(grid), dim3(256), LDS_BYTES, stream, p);
    hipLaunchKernelGGL(phase_kernel<6>, dim3(grid), dim3(256), LDS_BYTES, stream, p);
    hipLaunchKernelGGL(phase_kernel<7>, dim3(grid), dim3(256), LDS_BYTES, stream, p);
#endif
}
```

```cpp
#include <hip/hip_runtime.h>
#include <stdint.h>
#include <stdio.h>
#define DI __device__ __forceinline__

#ifndef SCAN_CHUNKED
#define SCAN_CHUNKED 1
#endif
#ifndef ONE_LAUNCH
#define ONE_LAUNCH 1
#endif

typedef unsigned short bf16_t;
typedef short bf16x8 __attribute__((ext_vector_type(8)));
typedef float f32x4 __attribute__((ext_vector_type(4)));
typedef float f32x16 __attribute__((ext_vector_type(16)));
typedef float f32x2_t __attribute__((ext_vector_type(2)));
typedef unsigned u32x4 __attribute__((ext_vector_type(4)));
typedef unsigned u32x2 __attribute__((ext_vector_type(2)));
#define LAUNDER(v) asm volatile("" : "+v"(v))
DI u32x4 mk4(unsigned a, unsigned b, unsigned c, unsigned d) { return (u32x4){a, b, c, d}; }
DI u32x2 mk2(unsigned a, unsigned b) { return (u32x2){a, b}; }

typedef __bf16 bf16x2_t __attribute__((ext_vector_type(2)));

constexpr int NB = 16, NT_ = 4096, DM = 1024, NTOK = NB * NT_;
constexpr int LDU = 2304;
constexpr int UQ = 0, UKV = 256, UR = 384, UK = 896, UV = 1408, UXW = 1920, UXA = 1952, UXG = 1984, UPE = 2080;
constexpr int NEXP = 256, TOPK = 8;
constexpr int LDS_BYTES = 73728;
__device__ __forceinline__ int tid_fresh() { int x = (int)threadIdx.x; asm volatile("" : "+v"(x)); return x & 255; }
__device__ __forceinline__ int half_fresh() { int x = (int)threadIdx.x; asm volatile("" : "+v"(x)); return __builtin_amdgcn_readfirstlane(x >> 8); }
#define TID tid_fresh()
#define HALF_ID half_fresh()
extern __shared__ __attribute__((aligned(16))) unsigned char smem[];
constexpr int SH_PAIR_OFF = 2 * LDS_BYTES + 16;
constexpr float QSCALE = 0.14724444f;

#define XB_TMO      128
#define XB_XCNT(j)  (256  + 64 * (j))
#define XB_XSUB(j)  (1280 + 64 * (j))
#define XB_XGEN(j)  (2304 + 64 * (j))
#define XB_TOP      3328
#define XB_TOPGEN   3392
#define XCD_BAR_WORDS 3456
#define XB_SPIN_CAP (1u << 22)
#define LAS __attribute__((address_space(3)))
constexpr int CTRL_ATTNQ = 4096, CTRL_ECNT = 8192, ECNT_STRIDE = 64, CTRL_WORDS = 24576;
constexpr int CTRL_STAMP = 4160;
constexpr int CTRL_Q6 = 4608;
#ifdef PROBE_A
#define STAMP(id) do { if (blockIdx.x == 0 && threadIdx.x == 0) __hip_atomic_store((unsigned long long*)(p.ctrl + CTRL_STAMP) + (id), (unsigned long long)__builtin_amdgcn_s_memrealtime(), __ATOMIC_RELAXED, __HIP_MEMORY_SCOPE_AGENT); } while (0)
#else
#define STAMP(id)
#endif

DI unsigned xb_ld(unsigned* p)              { return __hip_atomic_load(p, __ATOMIC_RELAXED, __HIP_MEMORY_SCOPE_AGENT); }
DI unsigned xb_add(unsigned* p, unsigned v) { return __hip_atomic_fetch_add(p, v, __ATOMIC_RELAXED, __HIP_MEMORY_SCOPE_AGENT); }
DI unsigned xb_xcc_id() { return (unsigned)__builtin_amdgcn_s_getreg((3 << 11) | 20) & 0xFu; }
#define XB_SPIN(cond, bar) do { unsigned _sp = 0; while (cond) { __builtin_amdgcn_s_sleep(1); \
    if ((++_sp & 255u) == 0u) { if (xb_ld(&(bar)[XB_TMO])) break; if (_sp > XB_SPIN_CAP) { atomicAdd(&(bar)[XB_TMO], 1u); break; } } } } while (0)

struct XcdBarrier { unsigned* bar; unsigned x; volatile LAS unsigned* st; };

DI XcdBarrier xcd_barrier_post(unsigned* bar, volatile LAS unsigned* st) {
    XcdBarrier b; b.bar = bar; b.x = xb_xcc_id(); b.st = st;
    if (threadIdx.x == 0) (void)xb_add(&bar[XB_XCNT(b.x)], 1u);
    return b;
}
DI void xcd_barrier_complete(unsigned* bar, unsigned x, unsigned& nloc, unsigned& nx) {
    const unsigned G = gridDim.x * gridDim.y * gridDim.z;
    unsigned sum, cnt, mine, sp = 0u;
    for (;;) {
        sum = 0u; cnt = 0u; mine = 0u;
#pragma unroll
        for (unsigned j = 0; j < 16; ++j) { const unsigned c = xb_ld(&bar[XB_XCNT(j)]); sum += c; cnt += (c > 0u) ? 1u : 0u; mine = (j == x) ? c : mine; }
        if (sum == G) break;
        __builtin_amdgcn_s_sleep(1);
        if ((++sp & 255u) == 0u) { if (xb_ld(&bar[XB_TMO])) break; if (sp > XB_SPIN_CAP) { atomicAdd(&bar[XB_TMO], 1u); break; } }
    }
    nloc = mine > 0u ? mine : 1u; nx = cnt > 0u ? cnt : 1u;
}
DI void xcd_barrier(const XcdBarrier& b) {
    asm volatile("s_waitcnt vmcnt(0)" ::: "memory");
    __syncthreads();
    if (threadIdx.x == 0) {
        unsigned* bar = b.bar;
        __builtin_amdgcn_s_waitcnt(0);
        unsigned nloc = b.st[0], nx = b.st[1];
        if (nloc == 0u) { xcd_barrier_complete(bar, b.x, nloc, nx); b.st[0] = nloc; b.st[1] = nx; }
        const unsigned old = xb_add(&bar[XB_XSUB(b.x)], 1u);
        const unsigned gen = old / nloc;
        if (old + 1u == (gen + 1u) * nloc) {
            __builtin_amdgcn_fence(__ATOMIC_RELEASE, "agent");
            asm volatile("s_waitcnt vmcnt(0)" ::: "memory");
            const unsigned og = xb_add(&bar[XB_TOP], 1u);
            const unsigned tg = og / nx;
            if (og + 1u == (tg + 1u) * nx) xb_add(&bar[XB_TOPGEN], 1u);
            else XB_SPIN(xb_ld(&bar[XB_TOPGEN]) == tg, bar);
            __builtin_amdgcn_fence(__ATOMIC_ACQUIRE, "agent");
            xb_add(&bar[XB_XGEN(b.x)], 1u);
            asm volatile("s_waitcnt vmcnt(0)" ::: "memory");
        } else {
            XB_SPIN(xb_ld(&bar[XB_XGEN(b.x)]) == gen, bar);
            __builtin_amdgcn_fence(__ATOMIC_ACQUIRE, "agent");
            asm volatile("s_waitcnt vmcnt(0)" ::: "memory");
        }
    }
    __syncthreads();
}

struct Params {
    const float* x; const float* c; const int* positions; const float* ada_w; const float* ada_b; const float* norm_mix; const float* w_in;
    const float* rwkv_mu; const float* decay_w0; const float* decay_up; const float* iclr_a0; const float* iclr_up; const float* gate_up;
    const float* k_k; const float* k_a; const float* r_k; const float* ln_w; const float* ln_b;
    const float* q_a_norm; const float* w_q_b; const float* kv_a_norm; const float* w_kv_b; const float* q_norm; const float* k_norm;
    const float* w_out; const float* norm_ffn; const float* w_router; const float* router_bias;
    const float* w_e_gu; const float* w_e_d; const float* w_sh_gu; const float* w_sh_d;
    float* out;
    unsigned* ctrl; float* mod; float* rope;
    bf16_t* win_t; bf16_t* wq_t; bf16_t* wkv_t; bf16_t* wdec_t; bf16_t* wiclr_t; bf16_t* wgate_t; bf16_t* wout_t; bf16_t* wr_t; bf16_t* wsgu_t; bf16_t* wsd_t;
    bf16_t* wegu_t; bf16_t* wed_t;
    bf16_t* H; int* topk_idx; float* topk_w; int* elist; unsigned char* bscr;
    bf16_t* U; bf16_t* Q; bf16_t* Kb; bf16_t* Vt; bf16_t* SC; bf16_t* Gg; float* yraw; bf16_t* Y; bf16_t* slot;
};
constexpr size_t BSCR_PER_BLOCK = 196608;

DI float bf2f(bf16_t v) { return __uint_as_float(((unsigned)v) << 16); }
DI unsigned pk2(float a, float b) { f32x2_t f = {a, b}; bf16x2_t r = __builtin_convertvector(f, bf16x2_t); return __builtin_bit_cast(unsigned, r); }
DI bf16_t f2bf(float a) { return (bf16_t)(pk2(a, 0.f) & 0xffffu); }
DI float lo2f(unsigned w) { return __uint_as_float(w << 16); }
DI float hi2f(unsigned w) { return __uint_as_float(w & 0xffff0000u); }
DI float sigmoidf_(float x) { return 1.0f / (1.0f + __expf(-x)); }
DI float wave_sum(float v) {
#pragma unroll
    for (int o = 32; o > 0; o >>= 1) v += __shfl_xor(v, o);
    return v;
}
DI float dpp_sum8(float s) {
    s += __builtin_bit_cast(float, __builtin_amdgcn_update_dpp(0, __builtin_bit_cast(int, s), 0xB1, 0xf, 0xf, true));
    s += __builtin_bit_cast(float, __builtin_amdgcn_update_dpp(0, __builtin_bit_cast(int, s), 0x4E, 0xf, 0xf, true));
    s += __builtin_bit_cast(float, __builtin_amdgcn_update_dpp(0, __builtin_bit_cast(int, s), 0x141, 0xf, 0xf, true));
    return s;
}

struct APlain { const bf16_t* base; int ld; DI const bf16_t* row(int r) const { return base + (size_t)r * ld; } };
struct AGather { const bf16_t* base; const int* idx; DI const bf16_t* row(int r) const { return base + (size_t)idx[r] * DM; } };

template <int MT, int NT, int WR, int BK, int NSWAP, class AP>
DI void gemm_tile(const AP ap, const bf16_t* __restrict__ Bt, const int ldb, const int K, f32x4 (&acc)[MT][NT], unsigned char* lds) {
    constexpr int WC = 4 / WR, CPR = BK / 8, RB = BK * 2, R256 = 256 / RB, BN = WC * NT * 16;
    static_assert(WR * MT * 16 == 128, "tile is 128 rows");
    constexpr int A_BYTES = 128 * RB, B_BYTES = BN * RB;
    constexpr int A_CH = (128 * CPR) / 256, B_TOT = BN * CPR, B_CH = (B_TOT + 255) / 256, RSTEP = 256 / CPR;
    int t = TID; LAUNDER(t);
    const int lane = t & 63, wid = t >> 6, wr = wid / WC, wc = wid % WC;
    const int ch = t % CPR, r0 = t / CPR;
    const bf16_t* pa[A_CH]; const bf16_t* pb[B_CH]; int offa[A_CH], offb[B_CH]; bool vb[B_CH];
#pragma unroll
    for (int i = 0; i < A_CH; ++i) { const int row = r0 + i * RSTEP; pa[i] = ap.row(row) + ch * 8; offa[i] = row * RB + ((ch ^ ((row / R256) & (CPR - 1))) << 4); }
#pragma unroll
    for (int i = 0; i < B_CH; ++i) { const int row = r0 + i * RSTEP; vb[i] = (B_TOT % 256 == 0) || (row < BN); const int rr = vb[i] ? row : 0; pb[i] = Bt + (size_t)rr * ldb + ch * 8; offb[i] = 2 * A_BYTES + rr * RB + ((ch ^ ((rr / R256) & (CPR - 1))) << 4); }
#pragma unroll
    for (int i = 0; i < MT; ++i)
#pragma unroll
        for (int j = 0; j < NT; ++j) acc[i][j] = (f32x4){0.f, 0.f, 0.f, 0.f};
    const int KT = K / BK;
    u32x4 ra0[A_CH], rb0[B_CH], ra1[A_CH], rb1[B_CH];
#define G_LOAD(RA, RB, KTI) { _Pragma("unroll") for (int i = 0; i < A_CH; ++i) RA[i] = *(const u32x4*)(pa[i] + (KTI) * BK); \
                              _Pragma("unroll") for (int i = 0; i < B_CH; ++i) RB[i] = *(const u32x4*)(pb[i] + (KTI) * BK); }
#define G_WRITE(RA, RB, BUF) { _Pragma("unroll") for (int i = 0; i < A_CH; ++i) *(u32x4*)(lds + (BUF) * A_BYTES + offa[i]) = RA[i]; \
                               _Pragma("unroll") for (int i = 0; i < B_CH; ++i) if (vb[i]) *(u32x4*)(lds + (BUF) * B_BYTES + offb[i]) = RB[i]; }
#define G_COMPUTE(BUF) { const unsigned char* Ab = lds + (BUF) * A_BYTES + arow; const unsigned char* Bb = lds + 2 * A_BYTES + (BUF) * B_BYTES + brow; \
        _Pragma("unroll") for (int ks = 0; ks < BK / 32; ++ks) { const int co = ((ks * 4 + (lane >> 4)) ^ sw) << 4; bf16x8 af[MT], bfr[NT]; \
            _Pragma("unroll") for (int i = 0; i < MT; ++i) af[i] = *(const bf16x8*)(Ab + i * 16 * RB + co); \
            _Pragma("unroll") for (int j = 0; j < NT; ++j) bfr[j] = *(const bf16x8*)(Bb + j * 16 * RB + co); \
            _Pragma("unroll") for (int i = 0; i < MT; ++i) _Pragma("unroll") for (int j = 0; j < NT; ++j) \
                acc[i][j] = (j < NSWAP) ? __builtin_amdgcn_mfma_f32_16x16x32_bf16(bfr[j], af[i], acc[i][j], 0, 0, 0) \
                                        : __builtin_amdgcn_mfma_f32_16x16x32_bf16(af[i], bfr[j], acc[i][j], 0, 0, 0); } }
    const int sw = ((lane & 15) / R256) & (CPR - 1);
    const int arow = (wr * MT * 16 + (lane & 15)) * RB, brow = (wc * NT * 16 + (lane & 15)) * RB;
    G_LOAD(ra0, rb0, 0)
    if (KT > 1) G_LOAD(ra1, rb1, 1)
    __syncthreads();
    G_WRITE(ra0, rb0, 0)
    if (KT > 2) G_LOAD(ra0, rb0, 2)
    __syncthreads();
    for (int kt = 0; kt < KT; kt += 2) {
        G_COMPUTE(0)
        if (kt + 1 < KT) { G_WRITE(ra1, rb1, 1) if (kt + 3 < KT) G_LOAD(ra1, rb1, kt + 3) }
        __syncthreads();
        if (kt + 1 >= KT) break;
        G_COMPUTE(1)
        if (kt + 2 < KT) { G_WRITE(ra0, rb0, 0) if (kt + 4 < KT) G_LOAD(ra0, rb0, kt + 4) }
        __syncthreads();
    }
#undef G_LOAD
#undef G_WRITE
#undef G_COMPUTE
}
template <int MT, int NT, int WR, int BK, int NSWAP, class AP, class UF, class EPI>
DI void gemm_stream(const AP ap, const bf16_t* __restrict__ Bt, const int ldb, const int K, const int nunits, const UF uoff, const EPI epi, unsigned char* lds) {
    constexpr int WC = 4 / WR, CPR = BK / 8, RB = BK * 2, R256 = 256 / RB, BN = WC * NT * 16, NTH = (NT > 6) ? NT / 2 : NT;
    static_assert(WR * MT * 16 == 128, "tile is 128 rows");
    constexpr int A_BYTES = 128 * RB, B_BYTES = BN * RB;
    constexpr int A_CH = (128 * CPR) / 256, B_TOT = BN * CPR, B_CH = (B_TOT + 255) / 256, RSTEP = 256 / CPR;
    int t = TID; LAUNDER(t);
    const int lane = t & 63, wid = t >> 6, wr = wid / WC, wc = wid % WC;
    const int ch = t % CPR, r0 = t / CPR;
    const bf16_t* pa[A_CH]; const bf16_t* pb[B_CH]; int offa[A_CH], offb[B_CH]; bool vb[B_CH];
#pragma unroll
    for (int i = 0; i < A_CH; ++i) { const int row = r0 + i * RSTEP; pa[i] = ap.row(row) + ch * 8; offa[i] = row * RB + ((ch ^ ((row / R256) & (CPR - 1))) << 4); }
#pragma unroll
    for (int i = 0; i < B_CH; ++i) { const int row = r0 + i * RSTEP; vb[i] = (B_TOT % 256 == 0) || (row < BN); const int rr = vb[i] ? row : 0; pb[i] = Bt + (size_t)rr * ldb + ch * 8; offb[i] = 2 * A_BYTES + rr * RB + ((ch ^ ((rr / R256) & (CPR - 1))) << 4); }
    f32x4 acc[MT][NT];
#pragma unroll
    for (int i = 0; i < MT; ++i)
#pragma unroll
        for (int j = 0; j < NT; ++j) acc[i][j] = (f32x4){0.f, 0.f, 0.f, 0.f};
    const int KT = K / BK, NG = nunits * KT;
    int lu = 0, lkt = 0, cu = 0, ckt = 0;
    u32x4 ra0[A_CH], rb0[B_CH], ra1[A_CH], rb1[B_CH];
#define S_LOAD(RA, RB) { int ao, bo; uoff(lu, ao, bo); ao += lkt * BK; bo += lkt * BK; \
                         _Pragma("unroll") for (int i = 0; i < A_CH; ++i) RA[i] = *(const u32x4*)(pa[i] + ao); \
                         _Pragma("unroll") for (int i = 0; i < B_CH; ++i) RB[i] = *(const u32x4*)(pb[i] + bo); \
                         if (++lkt == KT) { lkt = 0; ++lu; } }
#define S_WRITE(RA, RB, BUF) { _Pragma("unroll") for (int i = 0; i < A_CH; ++i) *(u32x4*)(lds + (BUF) * A_BYTES + offa[i]) = RA[i]; \
                               _Pragma("unroll") for (int i = 0; i < B_CH; ++i) if (vb[i]) *(u32x4*)(lds + (BUF) * B_BYTES + offb[i]) = RB[i]; }
#define S_COMPUTE(BUF) { const unsigned char* Ab = lds + (BUF) * A_BYTES + arow; const unsigned char* Bb = lds + 2 * A_BYTES + (BUF) * B_BYTES + brow; \
        _Pragma("unroll") for (int ks = 0; ks < BK / 32; ++ks) { const int co = ((ks * 4 + (lane >> 4)) ^ sw) << 4; bf16x8 af[MT]; \
            _Pragma("unroll") for (int i = 0; i < MT; ++i) af[i] = *(const bf16x8*)(Ab + i * 16 * RB + co); \
            _Pragma("unroll") for (int jh = 0; jh < NT / NTH; ++jh) { bf16x8 bfr[NTH]; \
                _Pragma("unroll") for (int j = 0; j < NTH; ++j) bfr[j] = *(const bf16x8*)(Bb + (jh * NTH + j) * 16 * RB + co); \
                __builtin_amdgcn_s_setprio(1); \
                _Pragma("unroll") for (int i = 0; i < MT; ++i) _Pragma("unroll") for (int j = 0; j < NTH; ++j) \
                    acc[i][jh * NTH + j] = (jh * NTH + j < NSWAP) ? __builtin_amdgcn_mfma_f32_16x16x32_bf16(bfr[j], af[i], acc[i][jh * NTH + j], 0, 0, 0) \
                                                                : __builtin_amdgcn_mfma_f32_16x16x32_bf16(af[i], bfr[j], acc[i][jh * NTH + j], 0, 0, 0); \
                __builtin_amdgcn_s_setprio(0); } } }
#define S_EPI { if (++ckt == KT) { epi(cu, acc); ckt = 0; ++cu; \
                _Pragma("unroll") for (int i = 0; i < MT; ++i) _Pragma("unroll") for (int j = 0; j < NT; ++j) acc[i][j] = (f32x4){0.f, 0.f, 0.f, 0.f}; } }
    const int sw = ((lane & 15) / R256) & (CPR - 1);
    const int arow = (wr * MT * 16 + (lane & 15)) * RB, brow = (wc * NT * 16 + (lane & 15)) * RB;
    S_LOAD(ra0, rb0)
    if (NG > 1) S_LOAD(ra1, rb1)
    __syncthreads();
    S_WRITE(ra0, rb0, 0)
    if (NG > 2) S_LOAD(ra0, rb0)
    __syncthreads();
#pragma unroll 1
    for (int g = 0; g < NG; g += 2) {
        S_COMPUTE(0)
        if (g + 1 < NG) { S_WRITE(ra1, rb1, 1) if (g + 3 < NG) S_LOAD(ra1, rb1) }
        S_EPI
        __syncthreads();
        if (g + 1 >= NG) break;
        S_COMPUTE(1)
        if (g + 2 < NG) { S_WRITE(ra0, rb0, 0) if (g + 4 < NG) S_LOAD(ra0, rb0) }
        S_EPI
        __syncthreads();
    }
#undef S_LOAD
#undef S_WRITE
#undef S_COMPUTE
#undef S_EPI
}

template <int NT, int BK, class AP>
DI void gemm_core(const AP ap, const bf16_t* __restrict__ Bt, const int ldb, const int K, f32x4 (&acc)[4][NT], unsigned char* lds) {
    gemm_tile<4, NT, 2, BK, NT>(ap, Bt, ldb, K, acc, lds);
}

template <int NT> DI void acc_to_lds(const f32x4 (&acc)[4][NT], float* tile, const int ld) {
    int t = TID; LAUNDER(t);
    const int lane = t & 63, wid = t >> 6, wr = wid >> 1, wc = wid & 1;
#pragma unroll
    for (int i = 0; i < 4; ++i)
#pragma unroll
        for (int j = 0; j < NT; ++j) {
            const int row = wr * 64 + i * 16 + (lane & 15), col = wc * NT * 16 + j * 16 + (lane >> 4) * 4;
            *(f32x4*)(tile + row * ld + col) = acc[i][j];
        }
}

namespace pg8 {
#define PG8_LAS __attribute__((address_space(3)))
typedef unsigned short bf16_t;
typedef short bf16x8 __attribute__((ext_vector_type(8)));
typedef float f32x4 __attribute__((ext_vector_type(4)));
typedef unsigned u32x4 __attribute__((ext_vector_type(4)));
constexpr int BM = 256, BK = 64, HALF = 128, HTB = HALF * BK * 2  , STAGE_BYTES = 8 * HTB, NXCD = 8, WGM = 8;

__host__ __device__ __forceinline__ int lds_byte(int r, int c) { const int st = (r >> 4) * 2 + (c >> 5), rr = r & 15, cc = c & 31, ob = rr * 64 + cc * 2; return st * 1024 + (ob ^ (((ob >> 9) & 1) << 5)); }
__host__ __device__ __forceinline__ void stage_rc(int b, int& R, int& C) { const int st = b / 1024, sb = b % 1024, swz = sb ^ (((sb >> 9) & 1) << 5); R = (st >> 1) * 16 + swz / 64; C = (st & 1) * 32 + (swz % 64) / 2; }
__host__ __device__ __forceinline__ int perm32(int rho) { const int n = rho >> 4, i = rho & 15; return 8 * (i >> 2) + 4 * n + (i & 3); }

struct Unit { int pm, pn; };
struct Gemm { const bf16_t* A; const bf16_t* Bt; int M, N, K; };

struct StaticOrder {
    int nM, nN, nwg, G, c;
    __host__ __device__ void init(int M, int N, int G_, int c_) { nM = M / BM; nN = N / BM; nwg = nM * nN; G = G_; c = c_; }
    __host__ __device__ bool next(int i, Unit& u) const {
        const long L = (long)i * G + c; if (L >= nwg) return false;
        int wgid = (int)L; { const int q = nwg / NXCD, r = nwg % NXCD, xcd = wgid % NXCD, off = wgid / NXCD; wgid = (xcd < r ? xcd * (q + 1) : r * (q + 1) + (xcd - r) * q) + off; }
        const int nig = WGM * nN, gid = wgid / nig, fm = gid * WGM, gsz = (nM - fm) < WGM ? (nM - fm) : WGM;
        u.pm = fm + ((wgid % nig) % gsz); u.pn = (wgid % nig) / gsz; return true;
    }
    __device__ __forceinline__ void a_ready(const Unit&) const {}
    __device__ __forceinline__ void done(const Unit&) const {}
};


__device__ __forceinline__ unsigned pk2_(float a, float b) { typedef float f2 __attribute__((ext_vector_type(2))); typedef __bf16 b2 __attribute__((ext_vector_type(2))); f2 f = {a, b}; b2 r = __builtin_convertvector(f, b2); return __builtin_bit_cast(unsigned, r); }
typedef unsigned u32x2_ __attribute__((ext_vector_type(2)));
struct EpiStoreBf16 {
    static constexpr bool PERM = false, AFTER_DRAIN = false;
    bf16_t* O; int ldc;
    __device__ __forceinline__ void operator()(const f32x4 (&acc)[2][2][4][2], const Unit& u, int wr, int wc, int fr, int fq) const {
        { int l_ = (int)(threadIdx.x & 63u); asm volatile("" : "+v"(l_)); fr = l_ & 15; fq = l_ >> 4; }
#pragma unroll
        for (int ai = 0; ai < 2; ++ai)
#pragma unroll
            for (int m = 0; m < 4; ++m) { bf16_t* rowp = O + (size_t)(u.pm * BM + ai * HALF + wr * 64 + m * 16 + fr) * ldc + u.pn * BM + wc * 32 + 4 * fq;
#pragma unroll
                for (int bj = 0; bj < 2; ++bj)
#pragma unroll
                    for (int n = 0; n < 2; ++n) { const f32x4 v = acc[ai][bj][m][n]; u32x2_ w; w.x = pk2_(v[0], v[1]); w.y = pk2_(v[2], v[3]); *(u32x2_*)(rowp + bj * HALF + n * 16) = w; } }
    }
};
struct EpiSwiglu {
    static constexpr bool PERM = false, AFTER_DRAIN = false;
    bf16_t* act;
    __device__ __forceinline__ void operator()(const f32x4 (&acc)[2][2][4][2], const Unit& u, int wr, int wc, int fr, int fq) const {
        { int l_ = (int)(threadIdx.x & 63u); asm volatile("" : "+v"(l_)); fr = l_ & 15; fq = l_ >> 4; }
#pragma unroll
        for (int ai = 0; ai < 2; ++ai)
#pragma unroll
            for (int m = 0; m < 4; ++m) { bf16_t* rowp = act + (ai * HALF + wr * 64 + m * 16 + fr) * 256 + u.pn * 128 + wc * 16 + 4 * fq;
#pragma unroll
                for (int bj = 0; bj < 2; ++bj) { const f32x4 gg = acc[ai][bj][m][0], uu = acc[ai][bj][m][1]; float o[4];
#pragma unroll
                    for (int e = 0; e < 4; ++e) o[e] = gg[e] / (1.0f + __expf(-gg[e])) * uu[e];
                    u32x2_ w; w.x = pk2_(o[0], o[1]); w.y = pk2_(o[2], o[3]); *(u32x2_*)(rowp + bj * 64) = w; } }
    }
};
struct EpiSlot {
    static constexpr bool PERM = false, AFTER_DRAIN = false;
    bf16_t* slot;
    __device__ __forceinline__ void operator()(const f32x4 (&acc)[2][2][4][2], const Unit& u, int wr, int wc, int fr, int fq) const {
        const int* rowslot = (const int*)(smem + 131072 + 4096); const float* roww = (const float*)(rowslot + 256);
        { int l_ = (int)(threadIdx.x & 63u); asm volatile("" : "+v"(l_)); fr = l_ & 15; fq = l_ >> 4; }
#pragma unroll
        for (int ai = 0; ai < 2; ++ai)
#pragma unroll
            for (int m = 0; m < 4; ++m) { const int row = ai * HALF + wr * 64 + m * 16 + fr, srow = rowslot[row]; const float ww = roww[row];
                if (srow >= 0) { bf16_t* rowp = slot + (size_t)srow * 1024 + u.pn * BM + wc * 32 + 4 * fq;
#pragma unroll
                    for (int bj = 0; bj < 2; ++bj)
#pragma unroll
                        for (int n = 0; n < 2; ++n) { const f32x4 v = acc[ai][bj][m][n] * ww; u32x2_ w; w.x = pk2_(v[0], v[1]); w.y = pk2_(v[2], v[3]); *(u32x2_*)(rowp + bj * HALF + n * 16) = w; } } }
    }
};
struct EpiX2 {
    static constexpr bool PERM = false, AFTER_DRAIN = false;
    const float* x; float* out; const float* mod;
    __device__ __forceinline__ void operator()(const f32x4 (&acc)[2][2][4][2], const Unit& u, int wr, int wc, int fr, int fq) const {
        { int l_ = (int)(threadIdx.x & 63u); asm volatile("" : "+v"(l_)); fr = l_ & 15; fq = l_ >> 4; }
        float* ssq = (float*)(smem + 137216);
#pragma unroll
        for (int ai = 0; ai < 2; ++ai)
#pragma unroll
            for (int m = 0; m < 4; ++m) { const int rl = ai * HALF + wr * 64 + m * 16 + fr; const size_t ro = (size_t)(u.pm * BM + rl) * 1024 + u.pn * BM + wc * 32 + 4 * fq; float sq = 0.f;
#pragma unroll
                for (int bj = 0; bj < 2; ++bj)
#pragma unroll
                    for (int n = 0; n < 2; ++n) { const int co = bj * HALF + n * 16; const f32x4 xv = *(const f32x4*)(x + ro + co), ga = *(const f32x4*)(mod + 2048 + u.pn * BM + wc * 32 + 4 * fq + co); f32x4 o;
#pragma unroll
                        for (int e = 0; e < 4; ++e) { o[e] = xv[e] + ga[e] * acc[ai][bj][m][n][e]; sq += o[e] * o[e]; }
                        *(f32x4*)(out + ro + co) = o; }
                sq += __shfl_xor(sq, 16); sq += __shfl_xor(sq, 32);
                if (fq == 0) atomicAdd(&ssq[rl], sq); }
    }
};
struct EpiRouterGu {
    static constexpr bool PERM = false, AFTER_DRAIN = false;
    float* scores; bf16_t* act;
    __device__ __forceinline__ void operator()(const f32x4 (&acc)[2][2][4][2], const Unit& u, int wr, int wc, int fr, int fq) const {
        { int l_ = (int)(threadIdx.x & 63u); asm volatile("" : "+v"(l_)); fr = l_ & 15; fq = l_ >> 4; }
        if (u.pn == 0) {
#pragma unroll
            for (int ai = 0; ai < 2; ++ai)
#pragma unroll
                for (int m = 0; m < 4; ++m) { float* sp = scores + ai * 32768 + wr * 64 + m * 16 + fr;
#pragma unroll
                    for (int bj = 0; bj < 2; ++bj)
#pragma unroll
                        for (int n = 0; n < 2; ++n) { const int col = bj * HALF + wc * 32 + n * 16 + 4 * fq;
#pragma unroll
                            for (int e = 0; e < 4; ++e) sp[(col + e) * 128] = 1.0f / (1.0f + __expf(-acc[ai][bj][m][n][e])); } }
        } else {
#pragma unroll
            for (int ai = 0; ai < 2; ++ai)
#pragma unroll
                for (int m = 0; m < 4; ++m) { bf16_t* rowp = act + (ai * HALF + wr * 64 + m * 16 + fr) * 256 + (u.pn - 1) * 128 + wc * 16 + 4 * fq;
#pragma unroll
                    for (int bj = 0; bj < 2; ++bj) { const f32x4 gg = acc[ai][bj][m][0], uu = acc[ai][bj][m][1]; float o[4];
#pragma unroll
                        for (int e = 0; e < 4; ++e) o[e] = gg[e] / (1.0f + __expf(-gg[e])) * uu[e];
                        u32x2_ w; w.x = pk2_(o[0], o[1]); w.y = pk2_(o[2], o[3]); *(u32x2_*)(rowp + bj * 64) = w; } }
        }
    }
};
struct EpiDown {
    static constexpr bool PERM = false, AFTER_DRAIN = false;
    float* out; const float* mod; int rowbase;
    __device__ __forceinline__ void operator()(const f32x4 (&acc)[2][2][4][2], const Unit& u, int wr, int wc, int fr, int fq) const {
        { int l_ = (int)(threadIdx.x & 63u); asm volatile("" : "+v"(l_)); fr = l_ & 15; fq = l_ >> 4; }
#pragma unroll
        for (int ai = 0; ai < 2; ++ai)
#pragma unroll
            for (int m = 0; m < 4; ++m) { const size_t ro = (size_t)(rowbase + ai * HALF + wr * 64 + m * 16 + fr) * 1024 + u.pn * BM + wc * 32 + 4 * fq;
#pragma unroll
                for (int bj = 0; bj < 2; ++bj)
#pragma unroll
                    for (int n = 0; n < 2; ++n) { const int co = bj * HALF + n * 16; const f32x4 xv = *(const f32x4*)(out + ro + co), gf = *(const f32x4*)(mod + 5120 + u.pn * BM + wc * 32 + 4 * fq + co);
                        *(f32x4*)(out + ro + co) = xv + gf * acc[ai][bj][m][n]; } }
    }
};
struct PanelOrder {
    int pm, nun;
    __device__ __forceinline__ bool next(int i, Unit& u) const { if (i >= nun) return false; int z = pm, pn = i; asm volatile("" : "+s"(z), "+s"(pn)); u.pm = z; u.pn = pn; return true; }
    __device__ __forceinline__ void a_ready(const Unit&) const {}
    __device__ __forceinline__ void done(const Unit&) const {}
};

template <class Epi, class Sched, bool ALIGN_EPI = false, bool SP2 = false, bool GATHER = false>
__device__ __forceinline__ void gemm_phase(PG8_LAS unsigned char* lds, const Gemm g, const Sched& S, const Epi& E, const unsigned (&gv)[2][2]) {
    int tid = threadIdx.x; asm volatile("" : "+v"(tid));
    const int wid = __builtin_amdgcn_readfirstlane(tid >> 6), lane = tid & 63, wr = wid >> 2, wc = wid & 3, fr = lane & 15, fq = lane >> 4;
    const int K = g.K, nt = K / BK;
    unsigned voffA[2], voffB[2];
#pragma unroll
    for (int i = 0; i < 2; ++i) { int R, C; stage_rc(tid * 16 + i * 8192, R, C); const int Rb = Epi::PERM ? ((R & ~31) + perm32(R & 31)) : R;
        voffA[i] = (unsigned)(R * K + C) * 2u; voffB[i] = (unsigned)(Rb * K + C) * 2u; }
    unsigned voffA0[2], voffA1[2];
#pragma unroll
    for (int i = 0; i < 2; ++i) { voffA0[i] = GATHER ? gv[0][i] : voffA[i]; voffA1[i] = GATHER ? gv[1][i] : 0u; }
    const size_t kstep = (size_t)(BK * 2);
    const size_t hstep = (size_t)HALF * K * 2;
    const size_t tstep = 2 * hstep;
    const unsigned ldsw = (unsigned)wid * 1024u;
    const int aoff = lds_byte(wr * 64 + fr, fq * 8), boff = lds_byte(wc * 32 + fr, fq * 8);
#define PG8_SA(b, h) (((b) * 2 + (h)) * HTB)
#define PG8_SB(b, h) ((4 + (b) * 2 + (h)) * HTB)
#define PG8_STAGE(bufoff, gbase, voff) do { _Pragma("unroll") for (int _i = 0; _i < 2; ++_i) \
        __builtin_amdgcn_global_load_lds((const unsigned*)((const char*)(gbase) + (voff)[_i]), (PG8_LAS unsigned*)(lds + (bufoff) + ldsw + _i * 8192), 16, 0, 0); } while (0)
#define PG8_LDA(dst, b, h) do { _Pragma("unroll") for (int m = 0; m < 4; ++m) _Pragma("unroll") for (int k = 0; k < 2; ++k) dst[m][k] = *(const PG8_LAS bf16x8*)(lds + PG8_SA(b, h) + aoff + m * 2048 + k * 1024); } while (0)
#define PG8_LDB(dst, b, h) do { _Pragma("unroll") for (int n = 0; n < 2; ++n) _Pragma("unroll") for (int k = 0; k < 2; ++k) dst[n][k] = *(const PG8_LAS bf16x8*)(lds + PG8_SB(b, h) + boff + n * 2048 + k * 1024); } while (0)
#define PG8_MMA(ai, bj, At, Bt) do { __builtin_amdgcn_s_setprio(1); _Pragma("unroll") for (int m = 0; m < 4; ++m) _Pragma("unroll") for (int n = 0; n < 2; ++n) _Pragma("unroll") for (int k = 0; k < 2; ++k) \
        acc[ai][bj][m][n] = __builtin_amdgcn_mfma_f32_16x16x32_bf16(Bt[n][k], At[m][k], acc[ai][bj][m][n], 0, 0, 0); __builtin_amdgcn_s_setprio(0); } while (0)
#define PG8_WAIT_V(n) asm volatile("s_waitcnt vmcnt(" #n ")" ::: "memory")
#define PG8_WAIT_L(n) asm volatile("s_waitcnt lgkmcnt(" #n ")" ::: "memory")
#define PG8_BAR __builtin_amdgcn_s_barrier()
#define PG8_SCHED __builtin_amdgcn_sched_barrier(0)
    Unit cur, nxt; int ui = 0;
    if (!S.next(0, cur)) return;
    f32x4 acc[2][2][4][2];
#pragma unroll
    for (int a = 0; a < 2; ++a)
#pragma unroll
        for (int b = 0; b < 2; ++b)
#pragma unroll
            for (int m = 0; m < 4; ++m)
#pragma unroll
                for (int n = 0; n < 2; ++n) acc[a][b][m][n] = (f32x4){0.f, 0.f, 0.f, 0.f};
    bf16x8 At[4][2], B0[2][2], B1[2][2];
    const char* cA = (const char*)g.A + (size_t)cur.pm * tstep; const char* cB = (const char*)g.Bt + (size_t)cur.pn * tstep;
    S.a_ready(cur);
    if constexpr (SP2) {
        PG8_STAGE(PG8_SB(0, 0), cB, voffB); PG8_STAGE(PG8_SB(0, 1), cB + hstep, voffB); PG8_STAGE(PG8_SA(0, 0), cA, voffA0); PG8_STAGE(PG8_SA(0, 1), (cA) + (GATHER ? (size_t)0 : hstep), GATHER ? voffA1 : voffA0);
        if (wr == 1) PG8_BAR;
        PG8_WAIT_V(2); PG8_BAR;
        PG8_STAGE(PG8_SB(1, 0), cB + kstep, voffB); PG8_STAGE(PG8_SA(1, 0), cA + kstep, voffA0); PG8_STAGE(PG8_SB(1, 1), cB + hstep + kstep, voffB);
        PG8_WAIT_V(6); PG8_BAR;
    } else {
        PG8_STAGE(PG8_SB(0, 0), cB, voffB); PG8_STAGE(PG8_SA(0, 0), cA, voffA0); PG8_STAGE(PG8_SB(0, 1), cB + hstep, voffB); PG8_STAGE(PG8_SA(0, 1), (cA) + (GATHER ? (size_t)0 : hstep), GATHER ? voffA1 : voffA0);
        if (wr == 1) PG8_BAR;
        PG8_WAIT_V(4); PG8_BAR;
        PG8_STAGE(PG8_SB(1, 0), cB + kstep, voffB); PG8_STAGE(PG8_SA(1, 0), cA + kstep, voffA0); PG8_STAGE(PG8_SB(1, 1), cB + hstep + kstep, voffB);
        PG8_WAIT_V(6); PG8_BAR;
    }
    for (;;) {
        const bool has_next = S.next(ui + 1, nxt);
        const char* nA = has_next ? (const char*)g.A + (size_t)nxt.pm * tstep : cA; const char* nB = has_next ? (const char*)g.Bt + (size_t)nxt.pn * tstep : cB;
        for (int t = 0; t < nt; t += 2) {
            const bool last = (t == nt - 2);
            const char* a1 = cA + (size_t)(t + 1) * kstep;
            const char* a2 = last ? nA : cA + (size_t)(t + 2) * kstep; const char* b2 = last ? nB : cB + (size_t)(t + 2) * kstep;
            const char* a3 = a2 + kstep; const char* b3 = b2 + kstep;
            if (last && has_next) S.a_ready(nxt);
            if constexpr (SP2) {
            PG8_LDB(B0, 0, 0); PG8_LDB(B1, 0, 1); PG8_SCHED; PG8_LDA(At, 0, 0); PG8_STAGE(PG8_SA(1, 1), (a1) + (GATHER ? (size_t)0 : hstep), GATHER ? voffA1 : voffA0);
            PG8_WAIT_V(8); PG8_WAIT_L(0); PG8_BAR; PG8_MMA(0, 0, At, B0); PG8_MMA(0, 1, At, B1); PG8_BAR; PG8_SCHED;
            PG8_LDA(At, 0, 1); PG8_STAGE(PG8_SB(0, 0), b2, voffB); PG8_STAGE(PG8_SB(0, 1), b2 + hstep, voffB); PG8_STAGE(PG8_SA(0, 0), a2, voffA0);
            PG8_WAIT_V(8); PG8_WAIT_L(0); PG8_BAR; PG8_MMA(1, 0, At, B0); PG8_MMA(1, 1, At, B1); PG8_BAR; PG8_SCHED;
            PG8_LDB(B0, 1, 0); PG8_LDB(B1, 1, 1); PG8_SCHED; PG8_LDA(At, 1, 0); PG8_STAGE(PG8_SA(0, 1), (a2) + (GATHER ? (size_t)0 : hstep), GATHER ? voffA1 : voffA0);
            PG8_WAIT_V(8); PG8_WAIT_L(0); PG8_BAR; PG8_MMA(0, 0, At, B0); PG8_MMA(0, 1, At, B1); PG8_BAR; PG8_SCHED;
            PG8_LDA(At, 1, 1); PG8_STAGE(PG8_SB(1, 0), b3, voffB); PG8_STAGE(PG8_SB(1, 1), b3 + hstep, voffB); PG8_STAGE(PG8_SA(1, 0), a3, voffA0);
            PG8_WAIT_V(8); PG8_WAIT_L(0); PG8_BAR; PG8_MMA(1, 0, At, B0); PG8_MMA(1, 1, At, B1); PG8_BAR; PG8_SCHED;
            } else {
            PG8_LDB(B0, 0, 0); PG8_SCHED; PG8_LDA(At, 0, 0); PG8_STAGE(PG8_SA(1, 1), (a1) + (GATHER ? (size_t)0 : hstep), GATHER ? voffA1 : voffA0);
            PG8_WAIT_L(8); PG8_BAR; PG8_WAIT_L(0); PG8_MMA(0, 0, At, B0); PG8_BAR; PG8_SCHED;
            PG8_LDB(B1, 0, 1); PG8_STAGE(PG8_SB(0, 0), b2, voffB);
            PG8_BAR; PG8_WAIT_L(0); PG8_MMA(0, 1, At, B1); PG8_BAR;
            PG8_LDA(At, 0, 1); PG8_STAGE(PG8_SA(0, 0), a2, voffA0);
            PG8_BAR; PG8_WAIT_L(0); PG8_MMA(1, 0, At, B0); PG8_BAR; PG8_SCHED;
            PG8_STAGE(PG8_SB(0, 1), b2 + hstep, voffB);
            PG8_WAIT_V(6); PG8_BAR; PG8_MMA(1, 1, At, B1); PG8_BAR;
            PG8_LDB(B0, 1, 0); PG8_SCHED; PG8_LDA(At, 1, 0); PG8_STAGE(PG8_SA(0, 1), (a2) + (GATHER ? (size_t)0 : hstep), GATHER ? voffA1 : voffA0);
            PG8_WAIT_L(8); PG8_BAR; PG8_WAIT_L(0); PG8_MMA(0, 0, At, B0); PG8_BAR; PG8_SCHED;
            PG8_LDB(B1, 1, 1); PG8_STAGE(PG8_SB(1, 0), b3, voffB);
            PG8_BAR; PG8_WAIT_L(0); PG8_MMA(0, 1, At, B1); PG8_BAR;
            PG8_LDA(At, 1, 1); PG8_STAGE(PG8_SA(1, 0), a3, voffA0);
            PG8_BAR; PG8_WAIT_L(0); PG8_MMA(1, 0, At, B0); PG8_BAR; PG8_SCHED;
            PG8_STAGE(PG8_SB(1, 1), b3 + hstep, voffB);
            PG8_WAIT_V(6); PG8_BAR; PG8_MMA(1, 1, At, B1); PG8_BAR;
            }
        }
        if constexpr (ALIGN_EPI) { if (wr == 0) PG8_BAR; }
        if constexpr (!Epi::AFTER_DRAIN) { E(acc, cur, wr, wc, fr, fq); S.done(cur); }
        if (!has_next) break;
#pragma unroll
        for (int a = 0; a < 2; ++a)
#pragma unroll
            for (int b = 0; b < 2; ++b)
#pragma unroll
                for (int m = 0; m < 4; ++m)
#pragma unroll
                    for (int n = 0; n < 2; ++n) acc[a][b][m][n] = (f32x4){0.f, 0.f, 0.f, 0.f};
        cur = nxt; cA = nA; cB = nB; ++ui;
        if constexpr (ALIGN_EPI) { if (wr == 1) PG8_BAR; }
    }
    PG8_WAIT_V(0);
    if constexpr (!ALIGN_EPI) { if (wr == 0) PG8_BAR; }
    PG8_BAR;
    if constexpr (Epi::AFTER_DRAIN) { E.fused(acc, cur, wr, wc, fr, fq, lds, wid, lane); S.done(cur); }
#undef PG8_SA
#undef PG8_SB
#undef PG8_STAGE
#undef PG8_LDA
#undef PG8_LDB
#undef PG8_MMA
#undef PG8_WAIT_V
#undef PG8_WAIT_L
#undef PG8_BAR
#undef PG8_SCHED
}
}

DI int map_win(int n) { return n < 384 ? n + 1696 : (n < 2080 ? n - 384 : (n < 2112 ? n : -1)); }
DI int map_gu32(int n) { const int g32 = n >> 5, w = n & 31, a = g32 * 16 + (w & 15); return (w >> 4) ? 256 + a : a; }
DI int map_gu128(int n) { const int tile = n >> 7, w = n & 127, wc = w >> 6, j = (w >> 4) & 3, r = w & 15; const int a = tile * 64 + wc * 32 + (j >> 1) * 16 + r; return (j & 1) ? 256 + a : a; }
DI int map_gu(int n) { const int tile = n >> 8, w = n & 255, wc = w >> 7, j = (w >> 4) & 7, r = w & 15; const int a = tile * 128 + wc * 64 + (j >> 1) * 16 + r; return (j & 1) ? 256 + a : a; }

template <int MAP> DI void tconv_simple(const float* __restrict__ src, bf16_t* __restrict__ dst, int K, int Ns, int Nd, const float* __restrict__ scale, int gtid, int gthreads) {
    const int total = Nd * K;
    for (int idx = gtid; idx < total; idx += gthreads) {
        const int n = idx / K, k = idx - n * K;
        const int m = (MAP == 1) ? map_win(n) : (MAP == 2 ? map_gu(n) : (MAP == 3 ? map_gu32(n) : n));
        float v = 0.f;
        if (m >= 0) { v = src[(size_t)k * Ns + m]; if (scale) v *= scale[k]; }
        dst[idx] = f2bf(v);
    }
}
template <int MAP> DI void tconv_tiled(const float* __restrict__ src, bf16_t* __restrict__ dst, int E, int K, int N, float* ldsf, int bid, int G) {
    const int tk = K / 64, tn = N / 64, per = tk * tn, total = E * per;
    const int t = TID;
    for (int tile0 = 2 * bid; tile0 < total; tile0 += 2 * G) {
        float rg[2][16];
#pragma unroll
        for (int h = 0; h < 2; ++h) {
            const int tile = tile0 + h, e = tile / per, r = tile - e * per, kt = r / tn, nt = r - kt * tn;
            const float* s = src + (size_t)e * K * N + (size_t)(kt * 64) * N;
            const int nl = t & 63, n = nt * 64 + nl;
            const int m = (MAP == 2) ? map_gu32(n) : n;
#pragma unroll
            for (int i = 0; i < 16; ++i) rg[h][i] = s[(size_t)((t >> 6) + 4 * i) * N + m];
        }
        __syncthreads();
#pragma unroll
        for (int h = 0; h < 2; ++h)
#pragma unroll
            for (int i = 0; i < 16; ++i) ldsf[h * 4160 + ((t >> 6) + 4 * i) * 65 + (t & 63)] = rg[h][i];
        __syncthreads();
#pragma unroll
        for (int h = 0; h < 2; ++h) {
            const int tile = tile0 + h, e = tile / per, r = tile - e * per, kt = r / tn, nt = r - kt * tn;
            const int nl = t >> 2, kc = (t & 3) * 16;
            unsigned w[8];
#pragma unroll
            for (int i = 0; i < 8; ++i) w[i] = pk2(ldsf[h * 4160 + (kc + 2 * i) * 65 + nl], ldsf[h * 4160 + (kc + 2 * i + 1) * 65 + nl]);
            bf16_t* d = dst + (size_t)e * K * N + (size_t)(nt * 64 + nl) * K + kt * 64 + kc;
            *(u32x4*)(d) = mk4(w[0], w[1], w[2], w[3]);
            *(u32x4*)(d + 8) = mk4(w[4], w[5], w[6], w[7]);
        }
    }
}
DI void phase0(const Params& p, unsigned char* lds, int bid, int G) {
    const int t = TID;
    float* ldsf = (float*)lds;
    for (int item = bid; item < 384; item += G) {
        __syncthreads();
        for (int i = t; i < NB * DM; i += 256) { const float v = p.c[i]; ldsf[(i & (DM - 1)) * NB + (i >> 10)] = v * sigmoidf_(v); }
        __syncthreads();
        const int col = item * 16 + (t & 15), kp = t >> 4;
        float a[NB];
#pragma unroll
        for (int b = 0; b < NB; ++b) a[b] = 0.f;
#pragma unroll 1
        for (int k0 = kp * 64; k0 < kp * 64 + 64; k0 += 8) {
            float w[8];
#pragma unroll
            for (int u = 0; u < 8; ++u) w[u] = p.ada_w[(size_t)(k0 + u) * 6144 + col];
#pragma unroll
            for (int u = 0; u < 8; ++u) {
#pragma unroll
                for (int q = 0; q < 4; ++q) { const f32x4 cv = *(const f32x4*)(ldsf + (k0 + u) * NB + 4 * q); a[4 * q] += cv[0] * w[u]; a[4 * q + 1] += cv[1] * w[u]; a[4 * q + 2] += cv[2] * w[u]; a[4 * q + 3] += cv[3] * w[u]; }
            }
        }
        __syncthreads();
#pragma unroll
        for (int b = 0; b < NB; ++b) ldsf[(kp * NB + b) * 16 + (t & 15)] = a[b];
        __syncthreads();
        {
            const int b = t >> 4, cl = t & 15; float sacc = 0.f;
#pragma unroll
            for (int q = 0; q < 16; ++q) sacc += ldsf[(q * NB + b) * 16 + cl];
            p.mod[b * 6144 + item * 16 + cl] = sacc + p.ada_b[item * 16 + cl];
        }
    }
    __syncthreads();
    const int gtid = bid * 256 + t, gth = G * 256;
    tconv_simple<1>(p.w_in, p.win_t, 1024, 2112, LDU, nullptr, gtid, gth);
    tconv_simple<0>(p.w_q_b, p.wq_t, 256, 768, 768, p.q_a_norm, gtid, gth);
    tconv_simple<0>(p.w_kv_b, p.wkv_t, 128, 1024, 1024, p.kv_a_norm, gtid, gth);
    tconv_simple<0>(p.decay_up, p.wdec_t, 32, 512, 512, nullptr, gtid, gth);
    tconv_simple<0>(p.iclr_up, p.wiclr_t, 32, 512, 512, nullptr, gtid, gth);
    tconv_simple<0>(p.gate_up, p.wgate_t, 96, 512, 512, nullptr, gtid, gth);
    tconv_simple<0>(p.w_out, p.wout_t, 1024, 1024, 1024, nullptr, gtid, gth);
    tconv_simple<0>(p.w_router, p.wr_t, 1024, 256, 256, nullptr, gtid, gth);
    tconv_simple<3>(p.w_sh_gu, p.wsgu_t, 1024, 512, 512, nullptr, gtid, gth);
    tconv_simple<0>(p.w_sh_d, p.wsd_t, 256, 1024, 1024, nullptr, gtid, gth);
    tconv_tiled<2>(p.w_e_gu, p.wegu_t, NEXP, 1024, 512, ldsf, bid, G);
    tconv_tiled<0>(p.w_e_d, p.wed_t, NEXP, 256, 1024, ldsf, bid, G);
}

DI void phase1(const Params& p, int bid, int G) {
    const int lane = TID & 63, gw = bid * 4 + (TID >> 6), nw = G * 4;
    for (int row0 = gw * 2; row0 < NTOK; row0 += nw * 2) {
        f32x4 v[2][4]; float ss[2] = {0.f, 0.f};
#pragma unroll
        for (int u = 0; u < 2; ++u)
#pragma unroll
            for (int i = 0; i < 4; ++i) v[u][i] = *(const f32x4*)(p.x + (size_t)(row0 + u) * DM + lane * 4 + 256 * i);
#pragma unroll
        for (int u = 0; u < 2; ++u) {
#pragma unroll
            for (int i = 0; i < 4; ++i) ss[u] += v[u][i][0] * v[u][i][0] + v[u][i][1] * v[u][i][1] + v[u][i][2] * v[u][i][2] + v[u][i][3] * v[u][i][3];
            ss[u] = wave_sum(ss[u]);
        }
        const float* mod = p.mod + (row0 >> 12) * 6144;
#pragma unroll
        for (int i = 0; i < 4; ++i) {
            const int c = lane * 4 + 256 * i;
            const f32x4 g = *(const f32x4*)(p.norm_mix + c), sh = *(const f32x4*)(mod + c), sc = *(const f32x4*)(mod + 1024 + c);
#pragma unroll
            for (int u = 0; u < 2; ++u) {
                const float rs = rsqrtf(ss[u] * (1.0f / DM) + 1e-6f);
                float o[4];
#pragma unroll
                for (int e = 0; e < 4; ++e) o[e] = v[u][i][e] * rs * g[e] * (1.0f + sc[e]) + sh[e];
                *(u32x2*)(p.H + (size_t)(row0 + u) * DM + c) = mk2(pk2(o[0], o[1]), pk2(o[2], o[3]));
            }
        }
    }
    const double inv = exp(-(double)(lane & 15) * (9.210340371976184 / 16.0));
    for (int idx = gw * 64 + lane; idx < NTOK * 16; idx += nw * 64) {
        const int row = idx >> 4;
        const double ang = (double)p.positions[row] * inv;
        p.rope[(size_t)row * 32 + (lane & 15)] = (float)cos(ang);
        p.rope[(size_t)row * 32 + 16 + (lane & 15)] = (float)sin(ang);
    }
}

DI void phase2_coop(const Params& p) {
    pg8::Gemm g{p.H, p.win_t, NTOK, LDU, DM};
    pg8::StaticOrder S; S.init(NTOK, LDU, (int)gridDim.x, (int)blockIdx.x);
    pg8::EpiStoreBf16 E{p.U, LDU};
    const unsigned nog[2][2] = {{0u, 0u}, {0u, 0u}};
    pg8::gemm_phase<pg8::EpiStoreBf16, pg8::StaticOrder, true, true, false>((PG8_LAS unsigned char*)smem, g, S, E, nog);
}

DI void unpack8(const u32x4 w, float (&f)[8]) { f[0] = lo2f(w.x); f[1] = hi2f(w.x); f[2] = lo2f(w.y); f[3] = hi2f(w.y); f[4] = lo2f(w.z); f[5] = hi2f(w.z); f[6] = lo2f(w.w); f[7] = hi2f(w.w); }
DI f32x4 unpack4(const u32x2 w) { return (f32x4){lo2f(w.x), hi2f(w.x), lo2f(w.y), hi2f(w.y)}; }
DI u32x2 pack4(const f32x4 v) { return mk2(pk2(v[0], v[1]), pk2(v[2], v[3])); }
DI f32x4 shifted4(const bf16_t* __restrict__ up, const bool has_prev, const f32x4 mu) {
    const f32x4 cur = unpack4(*(const u32x2*)up);
    f32x4 prev = (f32x4){0.f, 0.f, 0.f, 0.f};
    if (has_prev) prev = unpack4(*(const u32x2*)(up - LDU));
    return cur + (prev - cur) * mu;
}
DI void head96_finish(f32x4 (&v)[6], const int q, const float* __restrict__ gain, const float* __restrict__ ropeRow, const float scale, bf16_t* __restrict__ dstRow) {
    float ss = 0.f;
#pragma unroll
    for (int j = 0; j < 6; ++j) ss += v[j][0] * v[j][0] + v[j][1] * v[j][1] + v[j][2] * v[j][2] + v[j][3] * v[j][3];
    ss += __shfl_xor(ss, 16); ss += __shfl_xor(ss, 32);
    const float rs = rsqrtf(ss * (1.0f / 96.0f) + 1e-6f);
#pragma unroll
    for (int j = 0; j < 6; ++j) v[j] = v[j] * rs * *(const f32x4*)(gain + j * 16 + q * 4);
    const f32x4 cs = *(const f32x4*)(ropeRow + q * 4), sn = *(const f32x4*)(ropeRow + 16 + q * 4);
    const f32x4 x1 = v[4], x2 = v[5];
    v[4] = x1 * cs - x2 * sn; v[5] = x2 * cs + x1 * sn;
#pragma unroll
    for (int j = 0; j < 6; ++j) *(u32x2*)(dstRow + j * 16 + q * 4) = pack4(v[j] * scale);
}

DI void phase3(const Params& p, unsigned char* lds, int bid, int G) {
    const int t = TID;
    float* rstd_q = (float*)(lds + 69632);
    float* rstd_kv = rstd_q + 128;
    bf16_t* lora = (bf16_t*)(p.bscr + (size_t)bid * BSCR_PER_BLOCK + 131072);
    for (int rt = bid; rt < NTOK / 128; rt += G) {
        __syncthreads();
        {
            int tl = t; LAUNDER(tl);
            const int row = tl >> 1, half = tl & 1, grow = rt * 128 + row;
            const bf16_t* urow = p.U + (size_t)grow * LDU;
            float s = 0.f;
#pragma unroll
            for (int c = 0; c < 16; ++c) { float f[8]; unpack8(*(const u32x4*)(urow + UQ + half * 128 + c * 8), f);
#pragma unroll
                for (int e = 0; e < 8; ++e) s += f[e] * f[e]; }
            s += __shfl_xor(s, 1);
            float s2 = 0.f;
#pragma unroll
            for (int c = 0; c < 8; ++c) { float f[8]; unpack8(*(const u32x4*)(urow + UKV + half * 64 + c * 8), f);
#pragma unroll
                for (int e = 0; e < 8; ++e) s2 += f[e] * f[e]; }
            s2 += __shfl_xor(s2, 1);
            if (half == 0) { rstd_q[row] = rsqrtf(s * (1.0f / 256.0f) + 1e-6f); rstd_kv[row] = rsqrtf(s2 * (1.0f / 128.0f) + 1e-6f); }
        }
#pragma unroll 1
        for (int i = 0; i < 10; ++i) {
            int tl = t; LAUNDER(tl);
            const int c = tl + 256 * i, row = c / 20, chn = c - row * 20, grow = rt * 128 + row;
            const bf16_t* up = p.U + (size_t)grow * LDU + UXW + chn * 8;
            float cur[8], prv[8];
            unpack8(*(const u32x4*)up, cur);
            if ((grow & 4095) > 0) unpack8(*(const u32x4*)(up - LDU), prv);
            else {
#pragma unroll
                for (int e = 0; e < 8; ++e) prv[e] = 0.f; }
            const f32x4 m0 = *(const f32x4*)(p.rwkv_mu + 1536 + chn * 8), m1 = *(const f32x4*)(p.rwkv_mu + 1536 + chn * 8 + 4);
            float o[8];
#pragma unroll
            for (int e = 0; e < 8; ++e) {
                const float x = cur[e] + (prv[e] - cur[e]) * (e < 4 ? m0[e & 3] : m1[e & 3]);
                o[e] = chn < 4 ? tanhf(x) : (chn < 8 ? x : sigmoidf_(x));
            }
            *(u32x4*)(lora + row * 160 + chn * 8) = mk4(pk2(o[0], o[1]), pk2(o[2], o[3]), pk2(o[4], o[5]), pk2(o[6], o[7]));
        }
        asm volatile("s_waitcnt vmcnt(0)" ::: "memory");
        __syncthreads();
        STAMP(17);
        {
            APlain ap{p.U + (size_t)rt * 128 * LDU + UQ, LDU};
            gemm_stream<2, 6, 4, 64, 6>(ap, p.wq_t, 256, 256, 8, [](int u, int& ao, int& bo) { ao = 0; bo = u * 96 * 256; },
                [&](const int h, f32x4 (&acc)[2][6]) {
                    int tl = t; LAUNDER(tl);
                    const int lane = tl & 63, w = tl >> 6, r = lane & 15, q = lane >> 4;
#pragma unroll
                    for (int i = 0; i < 2; ++i) {
                        const int row = 32 * w + 16 * i + r, grow = rt * 128 + row, b = grow >> 12, tt = grow & 4095;
                        const float rq = rstd_q[row];
                        f32x4 v[6];
#pragma unroll
                        for (int j = 0; j < 6; ++j) v[j] = acc[i][j] * rq;
                        head96_finish(v, q, p.q_norm, p.rope + (size_t)grow * 32, QSCALE, p.Q + ((size_t)(b * 8 + h) * NT_ + tt) * 96);
                    }
                }, lds);
        }
        STAMP(18);
        {
            APlain ap{p.U + (size_t)rt * 128 * LDU + UKV, LDU};
            gemm_stream<2, 8, 4, 64, 4>(ap, p.wkv_t, 128, 128, 8, [](int u, int& ao, int& bo) { ao = 0; bo = u * 128 * 128; },
                [&](const int h, f32x4 (&acc)[2][8]) {
                    int tl = t; LAUNDER(tl);
                    const int lane = tl & 63, w = tl >> 6, r = lane & 15, q = lane >> 4;
#pragma unroll
                    for (int i = 0; i < 2; ++i) {
                        const int row = 32 * w + 16 * i + r, grow = rt * 128 + row, b = grow >> 12, tt = grow & 4095;
                        const float rk = rstd_kv[row];
                        const bf16_t* urow = p.U + (size_t)grow * LDU;
                        f32x4 v[6];
#pragma unroll
                        for (int j = 0; j < 4; ++j) v[j] = acc[i][j] * rk;
                        v[4] = unpack4(*(const u32x2*)(urow + UPE + q * 4));
                        v[5] = unpack4(*(const u32x2*)(urow + UPE + 16 + q * 4));
                        head96_finish(v, q, p.k_norm, p.rope + (size_t)grow * 32, 1.0f, p.Kb + ((size_t)(b * 8 + h) * NT_ + tt) * 96);
                        const int tok0 = 32 * w + 16 * i + 4 * q;
                        const f32x4 rk4 = *(const f32x4*)(rstd_kv + tok0);
                        bf16_t* vd = p.Vt + ((size_t)((rt >> 5) * 8 + h) * 64) * NT_ + (rt & 31) * 128 + tok0;
#pragma unroll
                        for (int j = 4; j < 8; ++j) *(u32x2*)(vd + (size_t)((j - 4) * 16 + r) * NT_) = pack4(acc[i][j] * rk4);
                    }
                }, lds);
        }
        STAMP(19);
        bf16_t* abuf = (bf16_t*)(p.bscr + (size_t)bid * BSCR_PER_BLOCK);
        {
            APlain ap{lora, 160};
            gemm_stream<4, 4, 2, 32, 4>(ap, p.wdec_t, 32, 32, 4, [](int u, int& ao, int& bo) { ao = 0; bo = u * 128 * 32; },
                [&](const int ct, f32x4 (&acc)[4][4]) {
                    int tl = t; LAUNDER(tl);
                    const int lane = tl & 63, wid = tl >> 6, wr = wid >> 1, wc = wid & 1, r = lane & 15, q = lane >> 4, head = ct * 2 + wc;
#pragma unroll
                    for (int i = 0; i < 4; ++i) {
                        const int grow = rt * 128 + wr * 64 + i * 16 + r, b = grow >> 12, tt = grow & 4095;
                        bf16_t* sc = p.SC + ((size_t)(b * 8 + head) * NT_ + tt) * 384 + q * 4;
#pragma unroll
                        for (int j = 0; j < 4; ++j) {
                            const f32x4 w0 = *(const f32x4*)(p.decay_w0 + head * 64 + j * 16 + q * 4);
                            f32x4 o;
#pragma unroll
                            for (int e = 0; e < 4; ++e) o[e] = 1.0f - __expf(-0.6065306597f * sigmoidf_(w0[e] + acc[i][j][e]));
                            *(u32x2*)(sc + j * 16) = pack4(o);
                        }
                    }
                }, lds);
        }
        {
            APlain ap{lora + 32, 160};
            gemm_stream<4, 4, 2, 32, 4>(ap, p.wiclr_t, 32, 32, 4, [](int u, int& ao, int& bo) { ao = 0; bo = u * 128 * 32; },
                [&](const int ct, f32x4 (&acc)[4][4]) {
                    int tl = t; LAUNDER(tl);
                    const int lane = tl & 63, wid = tl >> 6, wr = wid >> 1, wc = wid & 1, r = lane & 15, q = lane >> 4, c0 = ct * 128 + wc * 64 + q * 4;
#pragma unroll
                    for (int i = 0; i < 4; ++i) {
                        bf16_t* ar = abuf + (wr * 64 + i * 16 + r) * 512 + c0;
#pragma unroll
                        for (int j = 0; j < 4; ++j) {
                            const f32x4 a0 = *(const f32x4*)(p.iclr_a0 + c0 + j * 16);
                            f32x4 o;
#pragma unroll
                            for (int e = 0; e < 4; ++e) o[e] = sigmoidf_(a0[e] + acc[i][j][e]);
                            *(u32x2*)(ar + j * 16) = pack4(o);
                        }
                    }
                }, lds);
        }
        {
            APlain ap{lora + 64, 160};
            gemm_stream<4, 4, 2, 32, 4>(ap, p.wgate_t, 96, 96, 4, [](int u, int& ao, int& bo) { ao = 0; bo = u * 128 * 96; },
                [&](const int ct, f32x4 (&acc)[4][4]) {
                    int tl = t; LAUNDER(tl);
                    const int lane = tl & 63, wid = tl >> 6, wr = wid >> 1, wc = wid & 1, r = lane & 15, q = lane >> 4, head = ct * 2 + wc;
#pragma unroll
                    for (int i = 0; i < 4; ++i) {
                        const int grow = rt * 128 + wr * 64 + i * 16 + r;
                        bf16_t* g = p.Gg + (size_t)grow * 512 + head * 64 + q * 4;
#pragma unroll
                        for (int j = 0; j < 4; ++j) *(u32x2*)(g + j * 16) = pack4(acc[i][j]);
                    }
                }, lds);
        }
        asm volatile("s_waitcnt vmcnt(0)" ::: "memory");
        __syncthreads();
#pragma unroll 1
        for (int it = 0; it < 16; ++it) {
            int tl = t; LAUNDER(tl);
            const int lane = tl & 63, w = tl >> 6, c8 = lane * 8;
#pragma unroll
            for (int u = 0; u < 2; ++u) {
                const int row = w + 4 * (it * 2 + u), grow = rt * 128 + row, b = grow >> 12, tt = grow & 4095;
                const bool hp = tt > 0;
                const bf16_t* urow = p.U + (size_t)grow * LDU + c8;
                float kc[8], kp_[8], vc[8], vp[8], rc[8], rp[8], av[8];
                unpack8(*(const u32x4*)(urow + UK), kc); unpack8(*(const u32x4*)(urow + UV), vc); unpack8(*(const u32x4*)(urow + UR), rc);
                unpack8(*(const u32x4*)(abuf + row * 512 + c8), av);
                if (hp) { unpack8(*(const u32x4*)(urow + UK - LDU), kp_); unpack8(*(const u32x4*)(urow + UV - LDU), vp); unpack8(*(const u32x4*)(urow + UR - LDU), rp); }
                else {
#pragma unroll
                    for (int e = 0; e < 8; ++e) { kp_[e] = 0.f; vp[e] = 0.f; rp[e] = 0.f; } }
                float mk[8], mv[8], mr[8], kkw[8], kaw[8];
                *(f32x4*)(mk) = *(const f32x4*)(p.rwkv_mu + 512 + c8); *(f32x4*)(mk + 4) = *(const f32x4*)(p.rwkv_mu + 512 + c8 + 4);
                *(f32x4*)(mv) = *(const f32x4*)(p.rwkv_mu + 1024 + c8); *(f32x4*)(mv + 4) = *(const f32x4*)(p.rwkv_mu + 1024 + c8 + 4);
                *(f32x4*)(mr) = *(const f32x4*)(p.rwkv_mu + c8); *(f32x4*)(mr + 4) = *(const f32x4*)(p.rwkv_mu + c8 + 4);
                *(f32x4*)(kkw) = *(const f32x4*)(p.k_k + c8); *(f32x4*)(kkw + 4) = *(const f32x4*)(p.k_k + c8 + 4);
                *(f32x4*)(kaw) = *(const f32x4*)(p.k_a + c8); *(f32x4*)(kaw + 4) = *(const f32x4*)(p.k_a + c8 + 4);
                float ks[8], kq[8], ssq = 0.f;
#pragma unroll
                for (int e = 0; e < 8; ++e) { ks[e] = kc[e] + (kp_[e] - kc[e]) * mk[e]; kq[e] = ks[e] * kkw[e]; ssq += kq[e] * kq[e]; }
                ssq = dpp_sum8(ssq);
                const float rn = rsqrtf(fmaxf(ssq, 1e-24f));
                float okk[8], obb[8], okp[8], ov[8], orr[8];
#pragma unroll
                for (int e = 0; e < 8; ++e) {
                    okk[e] = kq[e] * rn; obb[e] = av[e] * okk[e]; okp[e] = ks[e] * (1.0f + (av[e] - 1.0f) * kaw[e]);
                    ov[e] = vc[e] + (vp[e] - vc[e]) * mv[e]; orr[e] = rc[e] + (rp[e] - rc[e]) * mr[e];
                }
                bf16_t* sc = p.SC + ((size_t)(b * 8 + (lane >> 3)) * NT_ + tt) * 384 + (lane & 7) * 8;
                *(u32x4*)(sc + 64) = mk4(pk2(okk[0], okk[1]), pk2(okk[2], okk[3]), pk2(okk[4], okk[5]), pk2(okk[6], okk[7]));
                *(u32x4*)(sc + 128) = mk4(pk2(obb[0], obb[1]), pk2(obb[2], obb[3]), pk2(obb[4], obb[5]), pk2(obb[6], obb[7]));
                *(u32x4*)(sc + 192) = mk4(pk2(okp[0], okp[1]), pk2(okp[2], okp[3]), pk2(okp[4], okp[5]), pk2(okp[6], okp[7]));
                *(u32x4*)(sc + 256) = mk4(pk2(ov[0], ov[1]), pk2(ov[2], ov[3]), pk2(ov[4], ov[5]), pk2(ov[6], ov[7]));
                *(u32x4*)(sc + 320) = mk4(pk2(orr[0], orr[1]), pk2(orr[2], orr[3]), pk2(orr[4], orr[5]), pk2(orr[6], orr[7]));
            }
        }
    }
}

struct ScanOps { f32x2_t d[4], k[4], b[4], p[4], r[4]; float v; };
DI void scan_load(ScanOps& o, const float* __restrict__ q, const float* __restrict__ vp) {
    const f32x4 d0 = *(const f32x4*)(q), d1 = *(const f32x4*)(q + 4), k0 = *(const f32x4*)(q + 64), k1 = *(const f32x4*)(q + 68);
    const f32x4 b0 = *(const f32x4*)(q + 128), b1 = *(const f32x4*)(q + 132), p0 = *(const f32x4*)(q + 192), p1 = *(const f32x4*)(q + 196);
    const f32x4 r0 = *(const f32x4*)(q + 320), r1 = *(const f32x4*)(q + 324);
    o.d[0] = (f32x2_t){d0[0], d0[1]}; o.d[1] = (f32x2_t){d0[2], d0[3]}; o.d[2] = (f32x2_t){d1[0], d1[1]}; o.d[3] = (f32x2_t){d1[2], d1[3]};
    o.k[0] = (f32x2_t){k0[0], k0[1]}; o.k[1] = (f32x2_t){k0[2], k0[3]}; o.k[2] = (f32x2_t){k1[0], k1[1]}; o.k[3] = (f32x2_t){k1[2], k1[3]};
    o.b[0] = (f32x2_t){b0[0], b0[1]}; o.b[1] = (f32x2_t){b0[2], b0[3]}; o.b[2] = (f32x2_t){b1[0], b1[1]}; o.b[3] = (f32x2_t){b1[2], b1[3]};
    o.p[0] = (f32x2_t){p0[0], p0[1]}; o.p[1] = (f32x2_t){p0[2], p0[3]}; o.p[2] = (f32x2_t){p1[0], p1[1]}; o.p[3] = (f32x2_t){p1[2], p1[3]};
    o.r[0] = (f32x2_t){r0[0], r0[1]}; o.r[1] = (f32x2_t){r0[2], r0[3]}; o.r[2] = (f32x2_t){r1[0], r1[1]}; o.r[3] = (f32x2_t){r1[2], r1[3]};
    o.v = *vp;
}
DI void scan_task(const Params& p, unsigned char* lds, const int task) {
    constexpr int CS = 16;
    const int t = TID, lane = t & 63, w = t >> 6;
    const int bh = task >> 1, hf = task & 1, b = bh >> 3, head = bh & 7;
    const int rloc = w * 8 + (lane >> 3), kseg = lane & 7;
    const int vrow = hf * 32 + rloc;
    float* stage = (float*)lds;
    float* ybuf = (float*)(lds + 49152);
    const bf16_t* src = p.SC + (size_t)bh * NT_ * 384;
    f32x2_t s2[4];
#pragma unroll
    for (int j = 0; j < 4; ++j) s2[j] = (f32x2_t){0.f, 0.f};
    u32x4 rg[3];
    __builtin_amdgcn_s_setprio(3);
    __syncthreads();
#pragma unroll
    for (int i = 0; i < 3; ++i) rg[i] = *(const u32x4*)(src + (size_t)(t + 256 * i) * 8);
#pragma unroll
    for (int i = 0; i < 3; ++i) { float* d = stage + (t + 256 * i) * 8;
        *(f32x4*)d = (f32x4){lo2f(rg[i].x), hi2f(rg[i].x), lo2f(rg[i].y), hi2f(rg[i].y)}; *(f32x4*)(d + 4) = (f32x4){lo2f(rg[i].z), hi2f(rg[i].z), lo2f(rg[i].w), hi2f(rg[i].w)}; }
    __syncthreads();
    constexpr int NCH = NT_ / CS;
    for (int c = 0; c < NCH; ++c) {
        const int cur = c & 1;
        if (c + 1 < NCH) {
#pragma unroll
            for (int i = 0; i < 3; ++i) rg[i] = *(const u32x4*)(src + (size_t)(c + 1) * CS * 384 + (size_t)(t + 256 * i) * 8);
        }
        if (c > 0) {
            const float* yb = ybuf + (cur ^ 1) * CS * 32;
            const int st = t >> 4, r2 = (t & 15) * 2;
            *(f32x2_t*)(p.yraw + ((size_t)(b * NT_ + (c - 1) * CS + st)) * 512 + head * 64 + hf * 32 + r2) = *(const f32x2_t*)(yb + st * 32 + r2);
        }
        const float* sb = stage + cur * CS * 384 + kseg * 8;
        float* yb = ybuf + cur * CS * 32;
        float yv[CS];
        ScanOps oc, on;
        scan_load(oc, sb, sb + 256 - kseg * 8 + vrow);
#pragma unroll
        for (int st = 0; st < CS; ++st) {
            if (st + 1 < CS) scan_load(on, sb + (st + 1) * 384, sb + (st + 1) * 384 + 256 - kseg * 8 + vrow);
            f32x2_t t0 = s2[0] * oc.k[0], t1 = s2[1] * oc.k[1];
            t0 = s2[2] * oc.k[2] + t0; t1 = s2[3] * oc.k[3] + t1;
            t0 = t0 + t1;
            float dot = dpp_sum8(t0.x + t0.y);
            const f32x2_t vv2 = {oc.v, oc.v}, nd2 = {-dot, -dot};
            f32x2_t u0, u1;
#pragma unroll
            for (int j = 0; j < 4; ++j) { f32x2_t tmp = s2[j] - s2[j] * oc.d[j]; tmp = vv2 * oc.p[j] + tmp; s2[j] = nd2 * oc.b[j] + tmp; }
            u0 = s2[0] * oc.r[0]; u1 = s2[1] * oc.r[1];
            u0 = s2[2] * oc.r[2] + u0; u1 = s2[3] * oc.r[3] + u1;
            u0 = u0 + u1;
            yv[st] = dpp_sum8(u0.x + u0.y);
            if (st + 1 < CS) oc = on;
        }
        if (kseg == 0) {
#pragma unroll
            for (int st = 0; st < CS; ++st) yb[st * 32 + rloc] = yv[st];
        }
        if (c + 1 < NCH) {
            float* dbase = stage + (cur ^ 1) * CS * 384;
#pragma unroll
            for (int i = 0; i < 3; ++i) { float* d = dbase + (t + 256 * i) * 8;
                *(f32x4*)d = (f32x4){lo2f(rg[i].x), hi2f(rg[i].x), lo2f(rg[i].y), hi2f(rg[i].y)}; *(f32x4*)(d + 4) = (f32x4){lo2f(rg[i].z), hi2f(rg[i].z), lo2f(rg[i].w), hi2f(rg[i].w)}; }
        }
        __syncthreads();
    }
    {
        const float* yb = ybuf + ((NCH - 1) & 1) * CS * 32;
        const int st = t >> 4, r2 = (t & 15) * 2;
        *(f32x2_t*)(p.yraw + ((size_t)(b * NT_ + (NCH - 1) * CS + st)) * 512 + head * 64 + hf * 32 + r2) = *(const f32x2_t*)(yb + st * 32 + r2);
    }
    __builtin_amdgcn_s_setprio(0);
}

DI void attn_item(const Params& p, unsigned char* lds, const int item) {
    constexpr int KROW = 208, VROW = 136, KB = 64 * KROW, BUF = KB + 64 * VROW;
    const int t = TID, lane = t & 63, w = t >> 6, l31 = lane & 31, h = lane >> 5;
    const int qt = 31 - item / 128, bh = item % 128;
    const bf16_t* Kg = p.Kb + (size_t)bh * NT_ * 96;
    const bf16_t* Vg = p.Vt + (size_t)bh * 64 * NT_;
    const int q = qt * 128 + w * 32 + l31;
    bf16x8 qf[6];
    {
        const bf16_t* qrow = p.Q + ((size_t)bh * NT_ + q) * 96 + 8 * h;
#pragma unroll
        for (int s = 0; s < 6; ++s) qf[s] = *(const bf16x8*)(qrow + 16 * s);
    }
    f32x16 O[2];
#pragma unroll
    for (int i = 0; i < 16; ++i) { O[0][i] = 0.f; O[1][i] = 0.f; }
    float m = -INFINITY, l = 0.f;
    const int njt = 2 * qt + 2;
    int koff[3], kgo[3], voff[2], vgo[2];
#pragma unroll
    for (int i = 0; i < 3; ++i) { const int c = t + 256 * i, r = c / 12, ch = c - r * 12; koff[i] = r * KROW + ch * 16; kgo[i] = r * 96 + ch * 8; }
#pragma unroll
    for (int i = 0; i < 2; ++i) { const int c = t + 256 * i, dv = c >> 3, ch = c & 7; voff[i] = KB + dv * VROW + ch * 16; vgo[i] = dv * NT_ + ch * 8; }
    u32x4 rk0[3], rv0[2], rk1[3], rv1[2];
#define AT_LOAD(RK, RV, J) { _Pragma("unroll") for (int i = 0; i < 3; ++i) RK[i] = *(const u32x4*)(Kg + (size_t)(J) * 64 * 96 + kgo[i]); \
                             _Pragma("unroll") for (int i = 0; i < 2; ++i) RV[i] = *(const u32x4*)(Vg + (J) * 64 + vgo[i]); }
#define AT_WRITE(RK, RV, BUFI) { unsigned char* nb = lds + (BUFI) * BUF; _Pragma("unroll") for (int i = 0; i < 3; ++i) *(u32x4*)(nb + koff[i]) = RK[i]; \
                             _Pragma("unroll") for (int i = 0; i < 2; ++i) { *(u32x2*)(nb + voff[i]) = mk2(RV[i].x, RV[i].y); *(u32x2*)(nb + voff[i] + 8) = mk2(RV[i].z, RV[i].w); } }
    auto tile_compute = [&](const int cur, const int j) {
        const bool active = (j * 64) <= (qt * 128 + w * 32 + 31);
        if (active) {
            const unsigned char* Kt = lds + cur * BUF;
            const unsigned char* Vtile = Kt + KB;
            f32x16 S[2];
#pragma unroll
            for (int k2 = 0; k2 < 2; ++k2) {
#pragma unroll
                for (int i = 0; i < 16; ++i) S[k2][i] = 0.f;
#pragma unroll
                for (int s = 0; s < 6; ++s) {
                    const bf16x8 kf = *(const bf16x8*)(Kt + (k2 * 32 + l31) * KROW + s * 32 + h * 16);
                    S[k2] = __builtin_amdgcn_mfma_f32_32x32x16_bf16(kf, qf[s], S[k2], 0, 0, 0);
                }
            }
            if (j >= 2 * qt) {
#pragma unroll
                for (int k2 = 0; k2 < 2; ++k2)
#pragma unroll
                    for (int i = 0; i < 16; ++i) { const int key = j * 64 + k2 * 32 + (i & 3) + 8 * (i >> 2) + 4 * h; if (key > q) S[k2][i] = -INFINITY; }
            }
            float mx = S[0][0];
#pragma unroll
            for (int i = 1; i < 16; ++i) mx = fmaxf(mx, S[0][i]);
#pragma unroll
            for (int i = 0; i < 16; ++i) mx = fmaxf(mx, S[1][i]);
            mx = fmaxf(mx, __shfl_xor(mx, 32));
            if (__any(mx > m)) {
                const float mn = fmaxf(m, mx);
                const float alpha = __builtin_amdgcn_exp2f(m - mn);
                m = mn; l *= alpha;
#pragma unroll
                for (int i = 0; i < 16; ++i) { O[0][i] *= alpha; O[1][i] *= alpha; }
            }
            f32x2_t ps2 = {0.f, 0.f};
#pragma unroll
            for (int k2 = 0; k2 < 2; ++k2)
#pragma unroll
                for (int i = 0; i < 16; i += 2) {
                    const float e0 = __builtin_amdgcn_exp2f(S[k2][i] - m), e1 = __builtin_amdgcn_exp2f(S[k2][i + 1] - m);
                    S[k2][i] = e0; S[k2][i + 1] = e1; ps2 += (f32x2_t){e0, e1};
                }
            l += ps2.x + ps2.y;
#pragma unroll
            for (int k2 = 0; k2 < 2; ++k2)
#pragma unroll
                for (int s2 = 0; s2 < 2; ++s2) {
                    unsigned pw[4];
#pragma unroll
                    for (int e = 0; e < 4; ++e) pw[e] = pk2(S[k2][8 * s2 + 2 * e], S[k2][8 * s2 + 2 * e + 1]);
                    const bf16x8 pf = __builtin_bit_cast(bf16x8, mk4(pw[0], pw[1], pw[2], pw[3]));
#pragma unroll
                    for (int dt = 0; dt < 2; ++dt) {
                        const unsigned char* vp = Vtile + (dt * 32 + l31) * VROW + (k2 * 32 + s2 * 16 + 4 * h) * 2;
                        const u32x2 v0 = *(const u32x2*)(vp), v1 = *(const u32x2*)(vp + 16);
                        const bf16x8 vf = __builtin_bit_cast(bf16x8, mk4(v0.x, v0.y, v1.x, v1.y));
                        O[dt] = __builtin_amdgcn_mfma_f32_32x32x16_bf16(vf, pf, O[dt], 0, 0, 0);
                    }
                }
        }
    };
    AT_LOAD(rk0, rv0, 0)
    if (njt > 1) AT_LOAD(rk1, rv1, 1)
    __syncthreads();
    AT_WRITE(rk0, rv0, 0)
    if (njt > 2) AT_LOAD(rk0, rv0, 2)
    __syncthreads();
#pragma unroll 1
    for (int j = 0; j < njt; j += 2) {
        tile_compute(0, j);
        if (j + 1 < njt) { AT_WRITE(rk1, rv1, 1) if (j + 3 < njt) AT_LOAD(rk1, rv1, j + 3) }
        __syncthreads();
        if (j + 1 >= njt) break;
        tile_compute(1, j + 1);
        if (j + 2 < njt) { AT_WRITE(rk0, rv0, 0) if (j + 4 < njt) AT_LOAD(rk0, rv0, j + 4) }
        __syncthreads();
    }
#undef AT_LOAD
#undef AT_WRITE
    l += __shfl_xor(l, 32);
    const float inv = 1.0f / l;
    bf16_t* yrow = p.Y + ((size_t)((bh >> 3) * NT_ + q)) * DM + 512 + (bh & 7) * 64;
#pragma unroll
    for (int dt = 0; dt < 2; ++dt)
#pragma unroll
        for (int g = 0; g < 4; ++g)
            *(u32x2*)(yrow + dt * 32 + 8 * g + 4 * h) = mk2(pk2(O[dt][4 * g] * inv, O[dt][4 * g + 1] * inv), pk2(O[dt][4 * g + 2] * inv, O[dt][4 * g + 3] * inv));
}

constexpr int REC_BYTES = 12544;
typedef short s16x4 __attribute__((ext_vector_type(4)));
DI f32x4 mfma16(const s16x4 a, const s16x4 b, const f32x4 c) { return __builtin_amdgcn_mfma_f32_16x16x16bf16_1k(a, b, c, 0, 0, 0); }
DI s16x4 cvt4(const f32x4 v) { return __builtin_bit_cast(s16x4, mk2(pk2(v[0], v[1]), pk2(v[2], v[3]))); }
DI void scan_fused(const Params& p, unsigned char* lds, const int bh) {
    int t = TID; LAUNDER(t);
    const int lane = t & 63, w = t >> 6, r = lane & 15, g = lane >> 4;
    const int b = bh >> 3, head = bh & 7;
    unsigned char* slot = lds + w * REC_BYTES;
    unsigned char* scr = lds + 4 * REC_BYTES + w * 5120;
    float* AT = (float*)(scr + 4096);
    const bf16_t* scbase = p.SC + (size_t)bh * NT_ * 384;
    f32x4 St[4];
#pragma unroll
    for (int m = 0; m < 4; ++m) St[m] = (f32x4){0.f, 0.f, 0.f, 0.f};
    u32x4 raw[12];
    {
        const u32x4* src = (const u32x4*)(scbase + (size_t)w * 16 * 384);
#pragma unroll
        for (int i = 0; i < 12; ++i) raw[i] = src[lane + 64 * i];
    }
    const int offk = (lane >> 4) * 512 + ((lane >> 2) & 3) * 128 + (lane & 3) * 2;
    const int offt = (lane >> 4) * 512 + (lane & 15) * 8;
    __builtin_amdgcn_s_setprio(3);
    __syncthreads();
#pragma unroll 1
    for (int rd = 0; rd < 64; ++rd) {
#pragma unroll
        for (int i = 0; i < 12; ++i) *(u32x4*)(slot + (lane + 64 * i) * 16) = raw[i];
        if (rd + 1 < 64) {
            const u32x4* src = (const u32x4*)(scbase + (size_t)(4 * (rd + 1) + w) * 16 * 384);
#pragma unroll
            for (int i = 0; i < 12; ++i) raw[i] = src[lane + 64 * i];
        }
        {
            const bf16_t* rawl = (const bf16_t*)slot + lane;
            bf16_t vkap[16], vbet[16], vkt[16], vrt[16], vv[16];
            float L = 0.f, ex = 1.f;
#pragma unroll
            for (int j = 0; j < 16; ++j) {
                const float d = bf2f(rawl[j * 384]), kap = bf2f(rawl[j * 384 + 64]), bet = bf2f(rawl[j * 384 + 128]), kk = bf2f(rawl[j * 384 + 192]), rr = bf2f(rawl[j * 384 + 320]);
                vv[j] = rawl[j * 384 + 256];
                L += __logf(1.0f - d);
                const float el = __expf(L), ei = __expf(-L);
                vkap[j] = f2bf(kap * ex); vbet[j] = f2bf(bet * ei); vkt[j] = f2bf(kk * ei); vrt[j] = f2bf(rr * el);
                ex = el;
            }
            const float gam = ex;
#pragma unroll
            for (int j = 0; j < 16; ++j) {
                *(bf16_t*)(slot + offk + j * 8) = vkap[j];
                *(bf16_t*)(slot + 2048 + offk + j * 8) = vrt[j];
                *(bf16_t*)(slot + 4096 + offt + (j >> 2) * 128 + (j & 3) * 2) = vkt[j];
                *(bf16_t*)(slot + 6144 + offt + (j >> 2) * 128 + (j & 3) * 2) = (bf16_t)(vbet[j] ^ 0x8000u);
                *(bf16_t*)(scr + offk + j * 8) = vkt[j];
                *(bf16_t*)(scr + 2048 + offk + j * 8) = vbet[j];
            }
            unsigned vw[8];
#pragma unroll
            for (int i = 0; i < 8; ++i) vw[i] = (unsigned)vv[2 * i] | ((unsigned)vv[2 * i + 1] << 16);
            *(u32x4*)(slot + 10240 + lane * 32) = mk4(vw[0], vw[1], vw[2], vw[3]);
            *(u32x4*)(slot + 10240 + lane * 32 + 16) = mk4(vw[4], vw[5], vw[6], vw[7]);
            *(float*)(slot + 12288 + lane * 4) = gam;
        }
        {
            f32x4 dB = {0.f, 0.f, 0.f, 0.f}, dE = dB, dF = dB, dA = dB;
#pragma unroll
            for (int m = 0; m < 4; ++m) {
                const s16x4 fk = *(const s16x4*)(slot + m * 512 + lane * 8), fr = *(const s16x4*)(slot + 2048 + m * 512 + lane * 8);
                const s16x4 ft = *(const s16x4*)(scr + m * 512 + lane * 8), fb = *(const s16x4*)(scr + 2048 + m * 512 + lane * 8);
                dB = mfma16(ft, fk, dB); dE = mfma16(ft, fr, dE); dF = mfma16(fb, fr, dF); dA = mfma16(fb, fk, dA);
            }
            f32x4 oB, oE, oF;
#pragma unroll
            for (int jj = 0; jj < 4; ++jj) {
                const int i = 4 * g + jj;
                oB[jj] = i < r ? dB[jj] : 0.f; oE[jj] = i <= r ? dE[jj] : 0.f; oF[jj] = i <= r ? -dF[jj] : 0.f;
                AT[i * 16 + r] = i < r ? dA[jj] : 0.f;
            }
            *(s16x4*)(slot + 16 * 512 + lane * 8) = cvt4(oB);
            *(s16x4*)(slot + 18 * 512 + lane * 8) = cvt4(oE);
            *(s16x4*)(slot + 19 * 512 + lane * 8) = cvt4(oF);
            float T[16];
#pragma unroll
            for (int i = 15; i >= 0; --i) {
                float a0 = (i == r) ? 1.f : 0.f, a1 = 0.f;
#pragma unroll
                for (int q4 = (i + 1) >> 2; q4 < 4; ++q4) {
                    const f32x4 av = *(const f32x4*)(AT + i * 16 + q4 * 4);
#pragma unroll
                    for (int e = 0; e < 4; ++e) { const int m = q4 * 4 + e; if (m > i) { if (e & 1) a1 -= av[e] * T[m]; else a0 -= av[e] * T[m]; } }
                }
                T[i] = (i <= r) ? a0 + a1 : 0.f;
            }
            f32x4 oT;
#pragma unroll
            for (int jj = 0; jj < 4; ++jj) oT[jj] = g == 0 ? T[jj] : (g == 1 ? T[4 + jj] : (g == 2 ? T[8 + jj] : T[12 + jj]));
            *(s16x4*)(slot + 17 * 512 + lane * 8) = cvt4(oT);
        }
        __syncthreads();
#pragma unroll 1
        for (int cc = 0; cc < 4; ++cc) {
            const unsigned char* buf = lds + cc * REC_BYTES;
            s16x4 fr[20];
#pragma unroll
            for (int f = 0; f < 20; ++f) fr[f] = *(const s16x4*)(buf + f * 512 + lane * 8);
            const s16x4 vf = *(const s16x4*)(buf + 10240 + (16 * w + r) * 32 + g * 8);
            s16x4 sb[4];
#pragma unroll
            for (int m = 0; m < 4; ++m) sb[m] = cvt4(St[m]);
            f32x4 X = {0.f, 0.f, 0.f, 0.f}, Yv = X;
#pragma unroll
            for (int m = 0; m < 4; ++m) { X = mfma16(fr[m], sb[m], X); Yv = mfma16(fr[4 + m], sb[m], Yv); }
            X = mfma16(fr[16], vf, X); Yv = mfma16(fr[18], vf, Yv);
            const s16x4 xb = cvt4(X);
            const f32x4 P = mfma16(fr[17], xb, (f32x4){0.f, 0.f, 0.f, 0.f});
            const s16x4 pb = cvt4(P);
            Yv = mfma16(fr[19], pb, Yv);
#pragma unroll
            for (int m = 0; m < 4; ++m) {
                St[m] = mfma16(fr[8 + m], vf, St[m]);
                St[m] = mfma16(fr[12 + m], pb, St[m]);
                St[m] = St[m] * *(const f32x4*)(buf + 12288 + (16 * m + 4 * g) * 4);
            }
            float* yo = p.yraw + ((size_t)(b * NT_ + (4 * rd + cc) * 16 + 4 * g)) * 512 + head * 64 + 16 * w + r;
#pragma unroll
            for (int jj = 0; jj < 4; ++jj) yo[jj * 512] = Yv[jj];
        }
        __syncthreads();
    }
    __builtin_amdgcn_s_setprio(0);
}

DI void phase4(const Params& p, unsigned char* lds, int bid, int G) {
#if SCAN_CHUNKED
    for (int bh = bid; bh < 128; bh += G) scan_fused(p, lds, bh);
#else
    for (int task = bid; task < 256; task += G) scan_task(p, lds, task);
#endif
    STAMP(10);
    int* sh_pair = (int*)(smem + SH_PAIR_OFF);
    for (;;) {
        __syncthreads();
        if (threadIdx.x == 0) *sh_pair = (int)atomicAdd(&p.ctrl[CTRL_ATTNQ], 1u);
        __syncthreads();
        const int k = *sh_pair;
        if (k >= 2048) break;
        attn_item(p, lds, 2 * k + HALF_ID);
    }
}

DI void phase5(const Params& p, unsigned char* lds, int bid, int G) {
    float* tile = (float*)lds;
#define P5_SSQ ((float*)(smem + 137216) + HALF_ID * 128)
    float* biasl = (float*)(lds + 69632) + 128;
    int* lcnt = (int*)(lds + 65536);
    int* lbase = lcnt + 256;
    unsigned char* le = (unsigned char*)(lbase + 256);
    unsigned char* lp = le + 1024;
    unsigned char* pscr = p.bscr + (size_t)blockIdx.x * 2 * BSCR_PER_BLOCK;
    float* scoresP = (float*)pscr;
    float* scores = scoresP + HALF_ID * 32768;
    bf16_t* actP = (bf16_t*)(pscr + 262144);
    const unsigned nog[2][2] = {{0u, 0u}, {0u, 0u}};
    for (int rt = bid; rt < NTOK / 128; rt += G) {
        const int b = rt >> 5;
        const float* mod = p.mod + b * 6144;
        __syncthreads();
        { const int t = TID;
        if (t < 128) P5_SSQ[t] = 0.f;
#pragma unroll 2
        for (int it = 0; it < 16; ++it) {
            int tl = t; LAUNDER(tl);
            const int pr = (tl >> 2) + 64 * it;
            const int row = pr >> 3, head = pr & 7, part = tl & 3, grow = rt * 128 + row, tt = grow & 4095;
            const int ch = head * 64 + part * 16;
            const float* yr = p.yraw + (size_t)grow * 512 + ch;
            float y[16];
#pragma unroll
            for (int i = 0; i < 4; ++i) { const f32x4 v = *(const f32x4*)(yr + 4 * i); y[4 * i] = v[0]; y[4 * i + 1] = v[1]; y[4 * i + 2] = v[2]; y[4 * i + 3] = v[3]; }
            float sm = 0.f;
#pragma unroll
            for (int i = 0; i < 16; ++i) sm += y[i];
            sm += __shfl_xor(sm, 1); sm += __shfl_xor(sm, 2);
            const float mean = sm * (1.0f / 64.0f);
            float vr = 0.f;
#pragma unroll
            for (int i = 0; i < 16; ++i) { const float d = y[i] - mean; vr += d * d; }
            vr += __shfl_xor(vr, 1); vr += __shfl_xor(vr, 2);
            const float rs = rsqrtf(vr * (1.0f / 64.0f) + 64e-5f);
            const bf16_t* sc = p.SC + ((size_t)(b * 8 + head) * NT_ + tt) * 384 + part * 16;
            float kp[16], vv[16], rr[16];
#pragma unroll
            for (int i = 0; i < 2; ++i) {
                const u32x4 a = *(const u32x4*)(sc + 192 + 8 * i), c = *(const u32x4*)(sc + 256 + 8 * i), d = *(const u32x4*)(sc + 320 + 8 * i);
                kp[8 * i] = lo2f(a.x); kp[8 * i + 1] = hi2f(a.x); kp[8 * i + 2] = lo2f(a.y); kp[8 * i + 3] = hi2f(a.y); kp[8 * i + 4] = lo2f(a.z); kp[8 * i + 5] = hi2f(a.z); kp[8 * i + 6] = lo2f(a.w); kp[8 * i + 7] = hi2f(a.w);
                vv[8 * i] = lo2f(c.x); vv[8 * i + 1] = hi2f(c.x); vv[8 * i + 2] = lo2f(c.y); vv[8 * i + 3] = hi2f(c.y); vv[8 * i + 4] = lo2f(c.z); vv[8 * i + 5] = hi2f(c.z); vv[8 * i + 6] = lo2f(c.w); vv[8 * i + 7] = hi2f(c.w);
                rr[8 * i] = lo2f(d.x); rr[8 * i + 1] = hi2f(d.x); rr[8 * i + 2] = lo2f(d.y); rr[8 * i + 3] = hi2f(d.y); rr[8 * i + 4] = lo2f(d.z); rr[8 * i + 5] = hi2f(d.z); rr[8 * i + 6] = lo2f(d.w); rr[8 * i + 7] = hi2f(d.w);
            }
            float bn = 0.f;
#pragma unroll
            for (int i = 0; i < 16; ++i) bn += rr[i] * kp[i] * p.r_k[ch + i];
            bn += __shfl_xor(bn, 1); bn += __shfl_xor(bn, 2);
            const bf16_t* gg = p.Gg + (size_t)grow * 512 + ch;
            const u32x4 g0 = *(const u32x4*)(gg), g1 = *(const u32x4*)(gg + 8);
            float g[16] = {lo2f(g0.x), hi2f(g0.x), lo2f(g0.y), hi2f(g0.y), lo2f(g0.z), hi2f(g0.z), lo2f(g0.w), hi2f(g0.w), lo2f(g1.x), hi2f(g1.x), lo2f(g1.y), hi2f(g1.y), lo2f(g1.z), hi2f(g1.z), lo2f(g1.w), hi2f(g1.w)};
            float o[16];
#pragma unroll
            for (int i = 0; i < 16; ++i) o[i] = ((y[i] - mean) * rs * p.ln_w[ch + i] + p.ln_b[ch + i] + bn * vv[i]) * g[i];
            bf16_t* yd = p.Y + (size_t)grow * DM + ch;
            *(u32x4*)(yd) = mk4(pk2(o[0], o[1]), pk2(o[2], o[3]), pk2(o[4], o[5]), pk2(o[6], o[7]));
            *(u32x4*)(yd + 8) = mk4(pk2(o[8], o[9]), pk2(o[10], o[11]), pk2(o[12], o[13]), pk2(o[14], o[15]));
        }
        asm volatile("s_waitcnt vmcnt(0)" ::: "memory");
        __syncthreads();
        }
        STAMP(11);
        {
            pg8::Gemm g{p.Y, p.wout_t, NTOK, DM, DM};
            int nu = 4; asm volatile("" : "+s"(nu));
            pg8::PanelOrder S{(int)blockIdx.x, nu};
            pg8::EpiX2 E{p.x, p.out, mod};
            pg8::gemm_phase<pg8::EpiX2, pg8::PanelOrder, true, true, false>((PG8_LAS unsigned char*)smem, g, S, E, nog);
        }
        asm volatile("s_waitcnt vmcnt(0)" ::: "memory");
        __syncthreads();
        STAMP(12);
        { const int t = TID, lane = t & 63, wid = t >> 6; (void)t;
#pragma unroll 1
        for (int mg = 0; mg < 8; ++mg) {
            int ll = lane; LAUNDER(ll);
            f32x4 xv[4][4];
#pragma unroll
            for (int u = 0; u < 4; ++u)
#pragma unroll
                for (int i = 0; i < 4; ++i) xv[u][i] = *(const f32x4*)(p.out + (size_t)(rt * 128 + wid + 4 * (mg * 4 + u)) * DM + ll * 4 + 256 * i);
#pragma unroll
            for (int u = 0; u < 4; ++u) {
                const int r = wid + 4 * (mg * 4 + u), grow = rt * 128 + r;
                const float rs = rsqrtf(P5_SSQ[r] * (1.0f / DM) + 1e-6f);
#pragma unroll
                for (int i = 0; i < 4; ++i) {
                    const int c = ll * 4 + 256 * i;
                    const f32x4 g = *(const f32x4*)(p.norm_ffn + c), sh = *(const f32x4*)(mod + 3072 + c), sc = *(const f32x4*)(mod + 4096 + c);
                    float o[4];
#pragma unroll
                    for (int e = 0; e < 4; ++e) o[e] = xv[u][i][e] * rs * g[e] * (1.0f + sc[e]) + sh[e];
                    *(u32x2*)(p.H + (size_t)grow * DM + c) = mk2(pk2(o[0], o[1]), pk2(o[2], o[3]));
                }
            }
        }
        asm volatile("s_waitcnt vmcnt(0)" ::: "memory");
        __syncthreads();
        }
        STAMP(13);
        {
            pg8::Gemm g{p.H, p.wr_t, NTOK, 768, DM};
            int nu = 3; asm volatile("" : "+s"(nu));
            pg8::PanelOrder S{(int)blockIdx.x, nu};
            pg8::EpiRouterGu E{scoresP, actP};
            pg8::gemm_phase<pg8::EpiRouterGu, pg8::PanelOrder, true, true, false>((PG8_LAS unsigned char*)smem, g, S, E, nog);
        }
        asm volatile("s_waitcnt vmcnt(0)" ::: "memory");
        __syncthreads();
        STAMP(14);
        { const int t = TID;
        biasl[t] = p.router_bias[t];
        lcnt[t] = 0;
#pragma unroll 1
        for (int hh = 0; hh < 2; ++hh) {
            __syncthreads();
            {
                int tl = t; LAUNDER(tl);
                f32x4 rgs[16];
#pragma unroll
                for (int i = 0; i < 16; ++i) { const int c = tl + 256 * i; rgs[i] = *(const f32x4*)(scores + (c >> 4) * 128 + hh * 64 + (c & 15) * 4); }
#pragma unroll
                for (int i = 0; i < 16; ++i) *(f32x4*)(tile + (tl + 256 * i) * 4) = rgs[i];
            }
            __syncthreads();
            if (t < 64) {
                int tl = t; LAUNDER(tl);
                const int token = rt * 128 + hh * 64 + tl;
                const float* sc = tile + tl;
                float gs[8];
#pragma unroll
                for (int g = 0; g < 8; ++g) {
                    float m1 = -INFINITY, m2 = -INFINITY;
#pragma unroll 8
                    for (int i = 0; i < 32; ++i) { const float v = sc[(g * 32 + i) * 64] + biasl[g * 32 + i]; m2 = fmaxf(m2, fminf(m1, v)); m1 = fmaxf(m1, v); }
                    gs[g] = m1 + m2;
                }
                unsigned selmask = 0u;
#pragma unroll
                for (int g = 0; g < 8; ++g) {
                    int rank = 0;
#pragma unroll
                    for (int g2 = 0; g2 < 8; ++g2) rank += (gs[g2] > gs[g] || (gs[g2] == gs[g] && g2 < g)) ? 1 : 0;
                    selmask |= (rank < 4 ? 1u : 0u) << g;
                }
                float tv[8]; int ti[8];
#pragma unroll
                for (int k = 0; k < 8; ++k) { tv[k] = -INFINITY; ti[k] = 0; }
#pragma unroll 1
                for (int g = 0; g < 8; ++g) {
                    if ((selmask >> g) & 1u) {
#pragma unroll 4
                        for (int i = 0; i < 32; ++i) {
                            const int e = g * 32 + i;
                            const float v = sc[e * 64] + biasl[e];
                            if (v > tv[7]) {
#pragma unroll
                                for (int k = 7; k >= 1; --k) {
                                    if (v > tv[k - 1]) { tv[k] = tv[k - 1]; ti[k] = ti[k - 1]; }
                                    else if (v > tv[k]) { tv[k] = v; ti[k] = e; }
                                }
                                if (v > tv[0]) { tv[0] = v; ti[0] = e; }
                            }
                        }
                    }
                }
                float ws[8], wsum = 0.f;
#pragma unroll
                for (int k = 0; k < 8; ++k) { ws[k] = sc[ti[k] * 64]; wsum += ws[k]; }
                const float sc25 = 2.5f / wsum;
#pragma unroll
                for (int k = 0; k < 8; ++k) {
                    p.topk_idx[token * 8 + k] = ti[k];
                    p.topk_w[token * 8 + k] = ws[k] * sc25;
                    le[(hh * 64 + tl) * 8 + k] = (unsigned char)ti[k];
                    lp[(hh * 64 + tl) * 8 + k] = (unsigned char)atomicAdd(&lcnt[ti[k]], 1);
                }
            }
        }
        __syncthreads();
        { const int c = lcnt[t]; lbase[t] = c > 0 ? (int)atomicAdd(&p.ctrl[CTRL_ECNT + t * ECNT_STRIDE], (unsigned)c) : 0; }
        __syncthreads();
#pragma unroll
        for (int i = 0; i < 4; ++i) {
            const int a = t + 256 * i, e = le[a];
            p.elist[(size_t)e * NTOK + lbase[e] + lp[a]] = (rt * 128) * 8 + a;
        }
        }
        STAMP(15);
        asm volatile("s_waitcnt vmcnt(0)" ::: "memory");
        __syncthreads();
        STAMP(16);
        {
            pg8::Gemm g{actP, p.wsd_t, 256, DM, 256};
            int nu = 4; asm volatile("" : "+s"(nu));
            pg8::PanelOrder S{0, nu};
            pg8::EpiDown E{p.out, mod, (int)blockIdx.x * 256};
            pg8::gemm_phase<pg8::EpiDown, pg8::PanelOrder, true, true, false>((PG8_LAS unsigned char*)smem, g, S, E, nog);
        }
    }
}

DI void phase6_coop(const Params& p) {
    const int tid0 = (int)threadIdx.x;
    int* cpre = (int*)(smem + 131072);
    int* tmp = cpre + 264;
    int* rowslot = (int*)(smem + 131072 + 4096);
    float* roww = (float*)(rowslot + 256);
    int* sh = (int*)(smem + SH_PAIR_OFF);
    bf16_t* act = (bf16_t*)(p.bscr + (size_t)blockIdx.x * 2 * BSCR_PER_BLOCK);
    __syncthreads();
    if (tid0 < 256) tmp[tid0] = ((int)p.ctrl[CTRL_ECNT + tid0 * ECNT_STRIDE] + 255) >> 8;
    __syncthreads();
    if (tid0 < 8) { int sacc = 0; for (int k = 0; k < 32; ++k) { cpre[tid0 * 33 + k] = sacc; sacc += tmp[8 * k + tid0]; } cpre[tid0 * 33 + 32] = sacc; }
    __syncthreads();
    const int hq = (int)(xb_xcc_id() & 7u);
    int attempt = 0;
    for (;;) {
        const int qc = (hq + attempt) & 7;
        int tid = (int)threadIdx.x; LAUNDER(tid);
        __syncthreads();
        if (tid == 0) *sh = (int)atomicAdd(&p.ctrl[CTRL_Q6 + qc * 64], 1u);
        __syncthreads();
        const int idx = __builtin_amdgcn_readfirstlane(*sh);
        if (idx >= __builtin_amdgcn_readfirstlane(cpre[qc * 33 + 32])) { if (++attempt >= 8) break; continue; }
        int lo = 0, hi = 31;
        while (lo < hi) { const int mid = (lo + hi + 1) >> 1; if (__builtin_amdgcn_readfirstlane(cpre[qc * 33 + mid]) <= idx) lo = mid; else hi = mid - 1; }
        const int e = 8 * lo + qc, tl = idx - __builtin_amdgcn_readfirstlane(cpre[qc * 33 + lo]), cnt = __builtin_amdgcn_readfirstlane((int)p.ctrl[CTRL_ECNT + e * ECNT_STRIDE]);
        const int* el = p.elist + (size_t)e * NTOK + tl * 256;
        const int nvalid = cnt - tl * 256;
        if (tid < 256) {
            if (tid < nvalid) { const int ts = el[tid]; rowslot[tid] = ts; roww[tid] = p.topk_w[ts]; }
            else { rowslot[tid] = -1; roww[tid] = 0.f; }
        }
        unsigned gv[2][2];
        {
            int tl2 = tid; LAUNDER(tl2);
#pragma unroll
            for (int i = 0; i < 2; ++i) {
                int R, C; pg8::stage_rc(tl2 * 16 + i * 8192, R, C);
#pragma unroll
                for (int h = 0; h < 2; ++h) { const int r = h * 128 + R; const int tok = r < nvalid ? (el[r] >> 3) : 0; gv[h][i] = (unsigned)tok * 2048u + (unsigned)C * 2u; }
            }
        }
        __syncthreads();
        {
            pg8::Gemm g{p.H, p.wegu_t + (size_t)e * 512 * DM, 256, 512, DM};
            int nu = 2; asm volatile("" : "+s"(nu));
            pg8::PanelOrder S{0, nu};
            pg8::EpiSwiglu E{act};
            pg8::gemm_phase<pg8::EpiSwiglu, pg8::PanelOrder, true, true, true>((PG8_LAS unsigned char*)smem, g, S, E, gv);
        }
        asm volatile("s_waitcnt vmcnt(0)" ::: "memory");
        __syncthreads();
        {
            pg8::Gemm g{act, p.wed_t + (size_t)e * 1024 * 256, 256, 1024, 256};
            int nu = 4; asm volatile("" : "+s"(nu));
            pg8::PanelOrder S{0, nu};
            pg8::EpiSlot E{p.slot};
            pg8::gemm_phase<pg8::EpiSlot, pg8::PanelOrder, true, true, false>((PG8_LAS unsigned char*)smem, g, S, E, gv);
        }
    }
}

DI void phase7(const Params& p, int bid, int G) {
    const int lane = TID & 63, gw = bid * 4 + (TID >> 6), nw = G * 4;
    for (int row = gw; row < NTOK; row += nw) {
        const float* mod = p.mod + (row >> 12) * 6144 + 5120;
#pragma unroll
        for (int i = 0; i < 4; ++i) {
            const int c = lane * 4 + 256 * i;
            float s[4] = {0.f, 0.f, 0.f, 0.f};
#pragma unroll
            for (int k = 0; k < 8; ++k) { const u32x2 w = *(const u32x2*)(p.slot + ((size_t)row * 8 + k) * DM + c); s[0] += lo2f(w.x); s[1] += hi2f(w.x); s[2] += lo2f(w.y); s[3] += hi2f(w.y); }
            const f32x4 gf = *(const f32x4*)(mod + c);
            f32x4 o = *(const f32x4*)(p.out + (size_t)row * DM + c);
#pragma unroll
            for (int e = 0; e < 4; ++e) o[e] += gf[e] * s[e];
            *(f32x4*)(p.out + (size_t)row * DM + c) = o;
        }
    }
}

template <int PH> DI void run_phase(const Params& p, unsigned char* lds, int bid, int G) {
    if (PH == 0) phase0(p, lds, bid, G);
    if (PH == 1) phase1(p, bid, G);
    if (PH == 3) phase3(p, lds, bid, G);
    if (PH == 4) phase4(p, lds, bid, G);
    if (PH == 5) phase5(p, lds, bid, G);
    if (PH == 7) phase7(p, bid, G);
}

#if !ONE_LAUNCH
template <int PH> __global__ void __launch_bounds__(256, 2) phase_kernel(Params p) { run_phase<PH>(p, smem, blockIdx.x, gridDim.x); }
#endif

#if ONE_LAUNCH
__global__ void __launch_bounds__(512, 2) mega_kernel(Params p) {
    volatile LAS unsigned* st = (volatile LAS unsigned*)(smem + 2 * LDS_BYTES);
    if (threadIdx.x == 0) { st[0] = 0u; st[1] = 0u; st[2] = 0u; st[3] = 0u; }
    __syncthreads();
    XcdBarrier bar = xcd_barrier_post(p.ctrl, st);
    const int bid = blockIdx.x * 2 + HALF_ID, G = gridDim.x * 2;
    unsigned char* const lds_half = smem + HALF_ID * LDS_BYTES;
    STAMP(0);
    run_phase<0>(p, lds_half, bid, G); xcd_barrier(bar); STAMP(1);
    run_phase<1>(p, lds_half, bid, G); xcd_barrier(bar); STAMP(2);
    phase2_coop(p); xcd_barrier(bar); STAMP(3);
    run_phase<3>(p, lds_half, bid, G); xcd_barrier(bar); STAMP(4);
    run_phase<4>(p, lds_half, bid, G); xcd_barrier(bar); STAMP(5);
    run_phase<5>(p, lds_half, bid, G); xcd_barrier(bar); STAMP(6);
    phase6_coop(p); xcd_barrier(bar); STAMP(7);
    run_phase<7>(p, lds_half, bid, G);
#ifdef PROBE_A
    xcd_barrier(bar); STAMP(8);
    xcd_barrier(bar);
    {
        const unsigned long long* sp = (const unsigned long long*)(p.ctrl + CTRL_STAMP);
        const unsigned long long ta = __hip_atomic_load(sp + PROBE_A, __ATOMIC_RELAXED, __HIP_MEMORY_SCOPE_AGENT), tb = __hip_atomic_load(sp + PROBE_B, __ATOMIC_RELAXED, __HIP_MEMORY_SCOPE_AGENT);
        const unsigned long long t0 = __builtin_amdgcn_s_memrealtime();
        while (__builtin_amdgcn_s_memrealtime() - t0 < tb - ta) __builtin_amdgcn_s_sleep(8);
    }
#endif
}
#define OCC_KERNEL mega_kernel
#else
#define OCC_KERNEL phase_kernel<5>
#endif

static inline size_t al256(size_t x) { return (x + 255) & ~(size_t)255; }

extern "C" void kernel_launch(void* const* d_in, const int* in_sizes, int n_in, void* d_out, int out_size, void* d_ws, size_t ws_size, hipStream_t stream) {
    (void)in_sizes; (void)n_in; (void)out_size;
    Params p{};
    p.x = (const float*)d_in[0]; p.c = (const float*)d_in[1]; p.positions = (const int*)d_in[2]; p.ada_w = (const float*)d_in[3]; p.ada_b = (const float*)d_in[4];
    p.norm_mix = (const float*)d_in[5]; p.w_in = (const float*)d_in[6]; p.rwkv_mu = (const float*)d_in[7]; p.decay_w0 = (const float*)d_in[8]; p.decay_up = (const float*)d_in[9];
    p.iclr_a0 = (const float*)d_in[10]; p.iclr_up = (const float*)d_in[11]; p.gate_up = (const float*)d_in[12]; p.k_k = (const float*)d_in[13]; p.k_a = (const float*)d_in[14];
    p.r_k = (const float*)d_in[15]; p.ln_w = (const float*)d_in[16]; p.ln_b = (const float*)d_in[17]; p.q_a_norm = (const float*)d_in[18]; p.w_q_b = (const float*)d_in[19];
    p.kv_a_norm = (const float*)d_in[20]; p.w_kv_b = (const float*)d_in[21]; p.q_norm = (const float*)d_in[22]; p.k_norm = (const float*)d_in[23]; p.w_out = (const float*)d_in[24];
    p.norm_ffn = (const float*)d_in[25]; p.w_router = (const float*)d_in[26]; p.router_bias = (const float*)d_in[27]; p.w_e_gu = (const float*)d_in[28]; p.w_e_d = (const float*)d_in[29];
    p.w_sh_gu = (const float*)d_in[30]; p.w_sh_d = (const float*)d_in[31];
    p.out = (float*)d_out;

    constexpr int DYN_LDS = 2 * LDS_BYTES + 64;
    static int grid = 0;
    if (!grid) {
        int dev = 0, cus = 0, per_cu = 0;
        (void)hipGetDevice(&dev);
        (void)hipDeviceGetAttribute(&cus, hipDeviceAttributeMultiprocessorCount, dev);
#if ONE_LAUNCH
        (void)hipFuncSetAttribute((const void*)mega_kernel, hipFuncAttributeMaxDynamicSharedMemorySize, DYN_LDS);
#endif
#if !ONE_LAUNCH
        (void)hipFuncSetAttribute((const void*)phase_kernel<0>, hipFuncAttributeMaxDynamicSharedMemorySize, LDS_BYTES);
#endif
#if !ONE_LAUNCH
        (void)hipFuncSetAttribute((const void*)phase_kernel<1>, hipFuncAttributeMaxDynamicSharedMemorySize, LDS_BYTES);
#endif
#if !ONE_LAUNCH
        (void)hipFuncSetAttribute((const void*)phase_kernel<2>, hipFuncAttributeMaxDynamicSharedMemorySize, LDS_BYTES);
#endif
#if !ONE_LAUNCH
        (void)hipFuncSetAttribute((const void*)phase_kernel<3>, hipFuncAttributeMaxDynamicSharedMemorySize, LDS_BYTES);
#endif
#if !ONE_LAUNCH
        (void)hipFuncSetAttribute((const void*)phase_kernel<4>, hipFuncAttributeMaxDynamicSharedMemorySize, LDS_BYTES);
#endif
#if !ONE_LAUNCH
        (void)hipFuncSetAttribute((const void*)phase_kernel<5>, hipFuncAttributeMaxDynamicSharedMemorySize, LDS_BYTES);
#endif
#if !ONE_LAUNCH
        (void)hipFuncSetAttribute((const void*)phase_kernel<6>, hipFuncAttributeMaxDynamicSharedMemorySize, LDS_BYTES);
#endif
#if !ONE_LAUNCH
        (void)hipFuncSetAttribute((const void*)phase_kernel<7>, hipFuncAttributeMaxDynamicSharedMemorySize, LDS_BYTES);
#endif
        (void)hipOccupancyMaxActiveBlocksPerMultiprocessor(&per_cu, (const void*)OCC_KERNEL, 512, DYN_LDS);
        if (cus <= 0) cus = 256;
        if (per_cu < 1) per_cu = 1;
        grid = cus;
    }
    unsigned char* w = (unsigned char*)d_ws; size_t o = 0;
    auto take = [&](size_t bytes) { unsigned char* r = w + o; o = al256(o + bytes); return r; };
    p.ctrl = (unsigned*)take(CTRL_WORDS * 4);
    p.mod = (float*)take((size_t)NB * 6144 * 4);
    p.rope = (float*)take((size_t)NTOK * 32 * 4);
    p.win_t = (bf16_t*)take((size_t)LDU * 1024 * 2);
    p.wq_t = (bf16_t*)take((size_t)768 * 256 * 2);
    p.wkv_t = (bf16_t*)take((size_t)1024 * 128 * 2);
    p.wdec_t = (bf16_t*)take((size_t)512 * 32 * 2);
    p.wiclr_t = (bf16_t*)take((size_t)512 * 32 * 2);
    p.wgate_t = (bf16_t*)take((size_t)512 * 96 * 2);
    p.wout_t = (bf16_t*)take((size_t)1024 * 1024 * 2);
    p.wr_t = (bf16_t*)take((size_t)256 * 1024 * 2);
    p.wsgu_t = (bf16_t*)take((size_t)512 * 1024 * 2);
    p.wsd_t = (bf16_t*)take((size_t)1024 * 256 * 2);
    p.wegu_t = (bf16_t*)take((size_t)NEXP * 512 * 1024 * 2);
    p.wed_t = (bf16_t*)take((size_t)NEXP * 1024 * 256 * 2);
    p.H = (bf16_t*)take((size_t)NTOK * DM * 2);
    p.topk_idx = (int*)take((size_t)NTOK * 8 * 4);
    p.topk_w = (float*)take((size_t)NTOK * 8 * 4);
    p.elist = (int*)take((size_t)NEXP * NTOK * 4);
    p.bscr = take((size_t)grid * 2 * BSCR_PER_BLOCK);
    const size_t ov = o;
    p.U = (bf16_t*)take((size_t)NTOK * LDU * 2);
    p.Q = (bf16_t*)take((size_t)NTOK * 8 * 96 * 2);
    p.Kb = (bf16_t*)take((size_t)NTOK * 8 * 96 * 2);
    p.Vt = (bf16_t*)take((size_t)NTOK * 8 * 64 * 2);
    p.SC = (bf16_t*)take((size_t)NTOK * 8 * 384 * 2);
    p.Gg = (bf16_t*)take((size_t)NTOK * 512 * 2);
    p.yraw = (float*)take((size_t)NTOK * 512 * 4);
    p.Y = (bf16_t*)take((size_t)NTOK * DM * 2);
    p.slot = (bf16_t*)(w + ov);
    const size_t need_slot = ov + (size_t)NTOK * 8 * DM * 2;
    if (o > ws_size || need_slot > ws_size) { fprintf(stderr, "workspace too small: need %zu / %zu, have %zu\n", o, need_slot, ws_size); return; }

    (void)hipMemsetAsync(p.ctrl, 0, CTRL_WORDS * 4, stream);
#if ONE_LAUNCH
    hipLaunchKernelGGL(mega_kernel, dim3(grid), dim3(512), DYN_LDS, stream, p);
#else
    hipLaunchKernelGGL(phase_kernel<0>, dim3(grid), dim3(256), LDS_BYTES, stream, p);
    hipLaunchKernelGGL(phase_kernel<1>, dim3(grid), dim3(256), LDS_BYTES, stream, p);
    hipLaunchKernelGGL(phase_kernel<2>, dim3(grid), dim3(256), LDS_BYTES, stream, p);
    hipLaunchKernelGGL(phase_kernel<3>, dim3(grid), dim3(256), LDS_BYTES, stream, p);
    hipLaunchKernelGGL(phase_kernel<4>, dim3(grid), dim3(256), LDS_BYTES, stream, p);
    hipLaunchKernelGGL(phase_kernel<5>, dim3(grid), dim3(256), LDS_BYTES, stream, p);
    hipLaunchKernelGGL(phase_kernel<6>, dim3(grid), dim3(256), LDS_BYTES, stream, p);
    hipLaunchKernelGGL(phase_kernel<7>, dim3(grid), dim3(256), LDS_BYTES, stream, p);
#endif
}
```

```cpp
#include <hip/hip_runtime.h>
#include <stdint.h>
#include <stdio.h>
#define DI __device__ __forceinline__

#ifndef SCAN_CHUNKED
#define SCAN_CHUNKED 1
#endif
#ifndef ONE_LAUNCH
#define ONE_LAUNCH 1
#endif

typedef unsigned short bf16_t;
typedef short bf16x8 __attribute__((ext_vector_type(8)));
typedef float f32x4 __attribute__((ext_vector_type(4)));
typedef float f32x16 __attribute__((ext_vector_type(16)));
typedef float f32x2_t __attribute__((ext_vector_type(2)));
typedef unsigned u32x4 __attribute__((ext_vector_type(4)));
typedef unsigned u32x2 __attribute__((ext_vector_type(2)));
#define LAUNDER(v) asm volatile("" : "+v"(v))
DI u32x4 mk4(unsigned a, unsigned b, unsigned c, unsigned d) { return (u32x4){a, b, c, d}; }
DI u32x2 mk2(unsigned a, unsigned b) { return (u32x2){a, b}; }

typedef __bf16 bf16x2_t __attribute__((ext_vector_type(2)));

constexpr int NB = 16, NT_ = 4096, DM = 1024, NTOK = NB * NT_;
constexpr int LDU = 2304;
constexpr int UQ = 0, UKV = 256, UR = 384, UK = 896, UV = 1408, UXW = 1920, UXA = 1952, UXG = 1984, UPE = 2080;
constexpr int NEXP = 256, TOPK = 8;
constexpr int LDS_BYTES = 73728;
__device__ __forceinline__ int tid_fresh() { int x = (int)threadIdx.x; asm volatile("" : "+v"(x)); return x & 255; }
__device__ __forceinline__ int half_fresh() { int x = (int)threadIdx.x; asm volatile("" : "+v"(x)); return __builtin_amdgcn_readfirstlane(x >> 8); }
#define TID tid_fresh()
#define HALF_ID half_fresh()
extern __shared__ __attribute__((aligned(16))) unsigned char smem[];
constexpr int SH_PAIR_OFF = 2 * LDS_BYTES + 16;
constexpr float QSCALE = 0.14724444f;

#define XB_TMO      128
#define XB_XCNT(j)  (256  + 64 * (j))
#define XB_XSUB(j)  (1280 + 64 * (j))
#define XB_XGEN(j)  (2304 + 64 * (j))
#define XB_TOP      3328
#define XB_TOPGEN   3392
#define XCD_BAR_WORDS 3456
#define XB_SPIN_CAP (1u << 22)
#define LAS __attribute__((address_space(3)))
constexpr int CTRL_ATTNQ = 4096, CTRL_ECNT = 8192, ECNT_STRIDE = 64, CTRL_WORDS = 24576;
constexpr int CTRL_STAMP = 4160;
constexpr int CTRL_ATTNQ8 = 5120;
constexpr int CTRL_Q6 = 4608;
#ifdef PROBE_A
#define STAMP(id) do { if (blockIdx.x == 0 && threadIdx.x == 0) __hip_atomic_store((unsigned long long*)(p.ctrl + CTRL_STAMP) + (id), (unsigned long long)__builtin_amdgcn_s_memrealtime(), __ATOMIC_RELAXED, __HIP_MEMORY_SCOPE_AGENT); } while (0)
#else
#define STAMP(id)
#endif

DI unsigned xb_ld(unsigned* p)              { return __hip_atomic_load(p, __ATOMIC_RELAXED, __HIP_MEMORY_SCOPE_AGENT); }
DI unsigned xb_add(unsigned* p, unsigned v) { return __hip_atomic_fetch_add(p, v, __ATOMIC_RELAXED, __HIP_MEMORY_SCOPE_AGENT); }
DI unsigned xb_xcc_id() { return (unsigned)__builtin_amdgcn_s_getreg((3 << 11) | 20) & 0xFu; }
#define XB_SPIN(cond, bar) do { unsigned _sp = 0; while (cond) { __builtin_amdgcn_s_sleep(1); \
    if ((++_sp & 255u) == 0u) { if (xb_ld(&(bar)[XB_TMO])) break; if (_sp > XB_SPIN_CAP) { atomicAdd(&(bar)[XB_TMO], 1u); break; } } } } while (0)

struct XcdBarrier { unsigned* bar; unsigned x; volatile LAS unsigned* st; };

DI XcdBarrier xcd_barrier_post(unsigned* bar, volatile LAS unsigned* st) {
    XcdBarrier b; b.bar = bar; b.x = xb_xcc_id(); b.st = st;
    if (threadIdx.x == 0) (void)xb_add(&bar[XB_XCNT(b.x)], 1u);
    return b;
}
DI void xcd_barrier_complete(unsigned* bar, unsigned x, unsigned& nloc, unsigned& nx) {
    const unsigned G = gridDim.x * gridDim.y * gridDim.z;
    unsigned sum, cnt, mine, sp = 0u;
    for (;;) {
        sum = 0u; cnt = 0u; mine = 0u;
#pragma unroll
        for (unsigned j = 0; j < 16; ++j) { const unsigned c = xb_ld(&bar[XB_XCNT(j)]); sum += c; cnt += (c > 0u) ? 1u : 0u; mine = (j == x) ? c : mine; }
        if (sum == G) break;
        __builtin_amdgcn_s_sleep(1);
        if ((++sp & 255u) == 0u) { if (xb_ld(&bar[XB_TMO])) break; if (sp > XB_SPIN_CAP) { atomicAdd(&bar[XB_TMO], 1u); break; } }
    }
    nloc = mine > 0u ? mine : 1u; nx = cnt > 0u ? cnt : 1u;
}
DI void xcd_barrier(const XcdBarrier& b) {
    asm volatile("s_waitcnt vmcnt(0)" ::: "memory");
    __syncthreads();
    if (threadIdx.x == 0) {
        unsigned* bar = b.bar;
        __builtin_amdgcn_s_waitcnt(0);
        unsigned nloc = b.st[0], nx = b.st[1];
        if (nloc == 0u) { xcd_barrier_complete(bar, b.x, nloc, nx); b.st[0] = nloc; b.st[1] = nx; }
        const unsigned old = xb_add(&bar[XB_XSUB(b.x)], 1u);
        const unsigned gen = old / nloc;
        if (old + 1u == (gen + 1u) * nloc) {
            __builtin_amdgcn_fence(__ATOMIC_RELEASE, "agent");
            asm volatile("s_waitcnt vmcnt(0)" ::: "memory");
            const unsigned og = xb_add(&bar[XB_TOP], 1u);
            const unsigned tg = og / nx;
            if (og + 1u == (tg + 1u) * nx) xb_add(&bar[XB_TOPGEN], 1u);
            else XB_SPIN(xb_ld(&bar[XB_TOPGEN]) == tg, bar);
            __builtin_amdgcn_fence(__ATOMIC_ACQUIRE, "agent");
            xb_add(&bar[XB_XGEN(b.x)], 1u);
            asm volatile("s_waitcnt vmcnt(0)" ::: "memory");
        } else {
            XB_SPIN(xb_ld(&bar[XB_XGEN(b.x)]) == gen, bar);
            __builtin_amdgcn_fence(__ATOMIC_ACQUIRE, "agent");
            asm volatile("s_waitcnt vmcnt(0)" ::: "memory");
        }
    }
    __syncthreads();
}

struct Params {
    const float* x; const float* c; const int* positions; const float* ada_w; const float* ada_b; const float* norm_mix; const float* w_in;
    const float* rwkv_mu; const float* decay_w0; const float* decay_up; const float* iclr_a0; const float* iclr_up; const float* gate_up;
    const float* k_k; const float* k_a; const float* r_k; const float* ln_w; const float* ln_b;
    const float* q_a_norm; const float* w_q_b; const float* kv_a_norm; const float* w_kv_b; const float* q_norm; const float* k_norm;
    const float* w_out; const float* norm_ffn; const float* w_router; const float* router_bias;
    const float* w_e_gu; const float* w_e_d; const float* w_sh_gu; const float* w_sh_d;
    float* out;
    unsigned* ctrl; float* mod; float* rope;
    bf16_t* win_t; bf16_t* wq_t; bf16_t* wkv_t; bf16_t* wdec_t; bf16_t* wiclr_t; bf16_t* wgate_t; bf16_t* wout_t; bf16_t* wr_t; bf16_t* wsgu_t; bf16_t* wsd_t;
    bf16_t* wegu_t; bf16_t* wed_t;
    bf16_t* H; int* posmap; float* topk_w; int* elist; unsigned char* bscr;
    bf16_t* U; bf16_t* Q; bf16_t* Kb; bf16_t* Vt; bf16_t* SC; bf16_t* Gg; float* yraw; bf16_t* Y; bf16_t* slot; bf16_t* shslot; float* bonus;
};
constexpr size_t BSCR_PER_BLOCK = 196608;

DI float bf2f(bf16_t v) { return __uint_as_float(((unsigned)v) << 16); }
DI unsigned pk2(float a, float b) { f32x2_t f = {a, b}; bf16x2_t r = __builtin_convertvector(f, bf16x2_t); return __builtin_bit_cast(unsigned, r); }
DI bf16_t f2bf(float a) { return (bf16_t)(pk2(a, 0.f) & 0xffffu); }
DI float lo2f(unsigned w) { return __uint_as_float(w << 16); }
DI float hi2f(unsigned w) { return __uint_as_float(w & 0xffff0000u); }
DI float sigmoidf_(float x) { return __builtin_amdgcn_rcpf(1.0f + __builtin_amdgcn_exp2f(x * -1.44269504f)); }
DI float wave_sum(float v) {
#pragma unroll
    for (int o = 32; o > 0; o >>= 1) v += __shfl_xor(v, o);
    return v;
}
DI float dpp_sum8(float s) {
    s += __builtin_bit_cast(float, __builtin_amdgcn_update_dpp(0, __builtin_bit_cast(int, s), 0xB1, 0xf, 0xf, true));
    s += __builtin_bit_cast(float, __builtin_amdgcn_update_dpp(0, __builtin_bit_cast(int, s), 0x4E, 0xf, 0xf, true));
    s += __builtin_bit_cast(float, __builtin_amdgcn_update_dpp(0, __builtin_bit_cast(int, s), 0x141, 0xf, 0xf, true));
    return s;
}

struct APlain { const bf16_t* base; int ld; DI const bf16_t* row(int r) const { return base + (size_t)r * ld; } };
struct AGather { const bf16_t* base; const int* idx; DI const bf16_t* row(int r) const { return base + (size_t)idx[r] * DM; } };

template <int MT, int NT, int WR, int BK, int NSWAP, class AP>
DI void gemm_tile(const AP ap, const bf16_t* __restrict__ Bt, const int ldb, const int K, f32x4 (&acc)[MT][NT], unsigned char* lds) {
    constexpr int WC = 4 / WR, CPR = BK / 8, RB = BK * 2, R256 = 256 / RB, BN = WC * NT * 16;
    static_assert(WR * MT * 16 == 128, "tile is 128 rows");
    constexpr int A_BYTES = 128 * RB, B_BYTES = BN * RB;
    constexpr int A_CH = (128 * CPR) / 256, B_TOT = BN * CPR, B_CH = (B_TOT + 255) / 256, RSTEP = 256 / CPR;
    int t = TID; LAUNDER(t);
    const int lane = t & 63, wid = t >> 6, wr = wid / WC, wc = wid % WC;
    const int ch = t % CPR, r0 = t / CPR;
    const bf16_t* pa[A_CH]; const bf16_t* pb[B_CH]; int offa[A_CH], offb[B_CH]; bool vb[B_CH];
#pragma unroll
    for (int i = 0; i < A_CH; ++i) { const int row = r0 + i * RSTEP; pa[i] = ap.row(row) + ch * 8; offa[i] = row * RB + ((ch ^ ((row / R256) & (CPR - 1))) << 4); }
#pragma unroll
    for (int i = 0; i < B_CH; ++i) { const int row = r0 + i * RSTEP; vb[i] = (B_TOT % 256 == 0) || (row < BN); const int rr = vb[i] ? row : 0; pb[i] = Bt + (size_t)rr * ldb + ch * 8; offb[i] = 2 * A_BYTES + rr * RB + ((ch ^ ((rr / R256) & (CPR - 1))) << 4); }
#pragma unroll
    for (int i = 0; i < MT; ++i)
#pragma unroll
        for (int j = 0; j < NT; ++j) acc[i][j] = (f32x4){0.f, 0.f, 0.f, 0.f};
    const int KT = K / BK;
    u32x4 ra0[A_CH], rb0[B_CH], ra1[A_CH], rb1[B_CH];
#define G_LOAD(RA, RB, KTI) { _Pragma("unroll") for (int i = 0; i < A_CH; ++i) RA[i] = *(const u32x4*)(pa[i] + (KTI) * BK); \
                              _Pragma("unroll") for (int i = 0; i < B_CH; ++i) RB[i] = *(const u32x4*)(pb[i] + (KTI) * BK); }
#define G_WRITE(RA, RB, BUF) { _Pragma("unroll") for (int i = 0; i < A_CH; ++i) *(u32x4*)(lds + (BUF) * A_BYTES + offa[i]) = RA[i]; \
                               _Pragma("unroll") for (int i = 0; i < B_CH; ++i) if (vb[i]) *(u32x4*)(lds + (BUF) * B_BYTES + offb[i]) = RB[i]; }
#define G_COMPUTE(BUF) { const unsigned char* Ab = lds + (BUF) * A_BYTES + arow; const unsigned char* Bb = lds + 2 * A_BYTES + (BUF) * B_BYTES + brow; \
        _Pragma("unroll") for (int ks = 0; ks < BK / 32; ++ks) { const int co = ((ks * 4 + (lane >> 4)) ^ sw) << 4; bf16x8 af[MT], bfr[NT]; \
            _Pragma("unroll") for (int i = 0; i < MT; ++i) af[i] = *(const bf16x8*)(Ab + i * 16 * RB + co); \
            _Pragma("unroll") for (int j = 0; j < NT; ++j) bfr[j] = *(const bf16x8*)(Bb + j * 16 * RB + co); \
            _Pragma("unroll") for (int i = 0; i < MT; ++i) _Pragma("unroll") for (int j = 0; j < NT; ++j) \
                acc[i][j] = (j < NSWAP) ? __builtin_amdgcn_mfma_f32_16x16x32_bf16(bfr[j], af[i], acc[i][j], 0, 0, 0) \
                                        : __builtin_amdgcn_mfma_f32_16x16x32_bf16(af[i], bfr[j], acc[i][j], 0, 0, 0); } }
    const int sw = ((lane & 15) / R256) & (CPR - 1);
    const int arow = (wr * MT * 16 + (lane & 15)) * RB, brow = (wc * NT * 16 + (lane & 15)) * RB;
    G_LOAD(ra0, rb0, 0)
    if (KT > 1) G_LOAD(ra1, rb1, 1)
    __syncthreads();
    G_WRITE(ra0, rb0, 0)
    if (KT > 2) G_LOAD(ra0, rb0, 2)
    __syncthreads();
    for (int kt = 0; kt < KT; kt += 2) {
        G_COMPUTE(0)
        if (kt + 1 < KT) { G_WRITE(ra1, rb1, 1) if (kt + 3 < KT) G_LOAD(ra1, rb1, kt + 3) }
        __syncthreads();
        if (kt + 1 >= KT) break;
        G_COMPUTE(1)
        if (kt + 2 < KT) { G_WRITE(ra0, rb0, 0) if (kt + 4 < KT) G_LOAD(ra0, rb0, kt + 4) }
        __syncthreads();
    }
#undef G_LOAD
#undef G_WRITE
#undef G_COMPUTE
}
template <int MT, int NT, int WR, int BK, int NSWAP, class AP, class UF, class EPI>
DI void gemm_stream(const AP ap, const bf16_t* __restrict__ Bt, const int ldb, const int K, const int nunits, const UF uoff, const EPI epi, unsigned char* lds) {
    constexpr int WC = 4 / WR, CPR = BK / 8, RB = BK * 2, R256 = 256 / RB, BN = WC * NT * 16, NTH = (NT > 6) ? NT / 2 : NT;
    static_assert(WR * MT * 16 == 128, "tile is 128 rows");
    constexpr int A_BYTES = 128 * RB, B_BYTES = BN * RB;
    constexpr int A_CH = (128 * CPR) / 256, B_TOT = BN * CPR, B_CH = (B_TOT + 255) / 256, RSTEP = 256 / CPR;
    int t = TID; LAUNDER(t);
    const int lane = t & 63, wid = t >> 6, wr = wid / WC, wc = wid % WC;
    const int ch = t % CPR, r0 = t / CPR;
    const bf16_t* pa[A_CH]; const bf16_t* pb[B_CH]; int offa[A_CH], offb[B_CH]; bool vb[B_CH];
#pragma unroll
    for (int i = 0; i < A_CH; ++i) { const int row = r0 + i * RSTEP; pa[i] = ap.row(row) + ch * 8; offa[i] = row * RB + ((ch ^ ((row / R256) & (CPR - 1))) << 4); }
#pragma unroll
    for (int i = 0; i < B_CH; ++i) { const int row = r0 + i * RSTEP; vb[i] = (B_TOT % 256 == 0) || (row < BN); const int rr = vb[i] ? row : 0; pb[i] = Bt + (size_t)rr * ldb + ch * 8; offb[i] = 2 * A_BYTES + rr * RB + ((ch ^ ((rr / R256) & (CPR - 1))) << 4); }
    f32x4 acc[MT][NT];
#pragma unroll
    for (int i = 0; i < MT; ++i)
#pragma unroll
        for (int j = 0; j < NT; ++j) acc[i][j] = (f32x4){0.f, 0.f, 0.f, 0.f};
    const int KT = K / BK, NG = nunits * KT;
    int lu = 0, lkt = 0, cu = 0, ckt = 0;
    u32x4 ra0[A_CH], rb0[B_CH], ra1[A_CH], rb1[B_CH];
#define S_LOAD(RA, RB) { int ao, bo; uoff(lu, ao, bo); ao += lkt * BK; bo += lkt * BK; \
                         _Pragma("unroll") for (int i = 0; i < A_CH; ++i) RA[i] = *(const u32x4*)(pa[i] + ao); \
                         _Pragma("unroll") for (int i = 0; i < B_CH; ++i) RB[i] = *(const u32x4*)(pb[i] + bo); \
                         if (++lkt == KT) { lkt = 0; ++lu; } }
#define S_WRITE(RA, RB, BUF) { _Pragma("unroll") for (int i = 0; i < A_CH; ++i) *(u32x4*)(lds + (BUF) * A_BYTES + offa[i]) = RA[i]; \
                               _Pragma("unroll") for (int i = 0; i < B_CH; ++i) if (vb[i]) *(u32x4*)(lds + (BUF) * B_BYTES + offb[i]) = RB[i]; }
#define S_COMPUTE(BUF) { const unsigned char* Ab = lds + (BUF) * A_BYTES + arow; const unsigned char* Bb = lds + 2 * A_BYTES + (BUF) * B_BYTES + brow; \
        _Pragma("unroll") for (int ks = 0; ks < BK / 32; ++ks) { const int co = ((ks * 4 + (lane >> 4)) ^ sw) << 4; bf16x8 af[MT]; \
            _Pragma("unroll") for (int i = 0; i < MT; ++i) af[i] = *(const bf16x8*)(Ab + i * 16 * RB + co); \
            _Pragma("unroll") for (int jh = 0; jh < NT / NTH; ++jh) { bf16x8 bfr[NTH]; \
                _Pragma("unroll") for (int j = 0; j < NTH; ++j) bfr[j] = *(const bf16x8*)(Bb + (jh * NTH + j) * 16 * RB + co); \
                __builtin_amdgcn_s_setprio(1); \
                _Pragma("unroll") for (int i = 0; i < MT; ++i) _Pragma("unroll") for (int j = 0; j < NTH; ++j) \
                    acc[i][jh * NTH + j] = (jh * NTH + j < NSWAP) ? __builtin_amdgcn_mfma_f32_16x16x32_bf16(bfr[j], af[i], acc[i][jh * NTH + j], 0, 0, 0) \
                                                                : __builtin_amdgcn_mfma_f32_16x16x32_bf16(af[i], bfr[j], acc[i][jh * NTH + j], 0, 0, 0); \
                __builtin_amdgcn_s_setprio(0); } } }
#define S_EPI { if (++ckt == KT) { epi(cu, acc); ckt = 0; ++cu; \
                _Pragma("unroll") for (int i = 0; i < MT; ++i) _Pragma("unroll") for (int j = 0; j < NT; ++j) acc[i][j] = (f32x4){0.f, 0.f, 0.f, 0.f}; } }
    const int sw = ((lane & 15) / R256) & (CPR - 1);
    const int arow = (wr * MT * 16 + (lane & 15)) * RB, brow = (wc * NT * 16 + (lane & 15)) * RB;
    S_LOAD(ra0, rb0)
    if (NG > 1) S_LOAD(ra1, rb1)
    __syncthreads();
    S_WRITE(ra0, rb0, 0)
    if (NG > 2) S_LOAD(ra0, rb0)
    __syncthreads();
#pragma unroll 1
    for (int g = 0; g < NG; g += 2) {
        S_COMPUTE(0)
        if (g + 1 < NG) { S_WRITE(ra1, rb1, 1) if (g + 3 < NG) S_LOAD(ra1, rb1) }
        S_EPI
        __syncthreads();
        if (g + 1 >= NG) break;
        S_COMPUTE(1)
        if (g + 2 < NG) { S_WRITE(ra0, rb0, 0) if (g + 4 < NG) S_LOAD(ra0, rb0) }
        S_EPI
        __syncthreads();
    }
#undef S_LOAD
#undef S_WRITE
#undef S_COMPUTE
#undef S_EPI
}

template <int NT, int BK, class AP>
DI void gemm_core(const AP ap, const bf16_t* __restrict__ Bt, const int ldb, const int K, f32x4 (&acc)[4][NT], unsigned char* lds) {
    gemm_tile<4, NT, 2, BK, NT>(ap, Bt, ldb, K, acc, lds);
}

template <int NT> DI void acc_to_lds(const f32x4 (&acc)[4][NT], float* tile, const int ld) {
    int t = TID; LAUNDER(t);
    const int lane = t & 63, wid = t >> 6, wr = wid >> 1, wc = wid & 1;
#pragma unroll
    for (int i = 0; i < 4; ++i)
#pragma unroll
        for (int j = 0; j < NT; ++j) {
            const int row = wr * 64 + i * 16 + (lane & 15), col = wc * NT * 16 + j * 16 + (lane >> 4) * 4;
            *(f32x4*)(tile + row * ld + col) = acc[i][j];
        }
}

namespace pg8 {
#define PG8_LAS __attribute__((address_space(3)))
typedef unsigned short bf16_t;
typedef short bf16x8 __attribute__((ext_vector_type(8)));
typedef float f32x4 __attribute__((ext_vector_type(4)));
typedef unsigned u32x4 __attribute__((ext_vector_type(4)));
constexpr int BM = 256, BK = 64, HALF = 128, HTB = HALF * BK * 2  , STAGE_BYTES = 8 * HTB, NXCD = 8, WGM = 8;

__host__ __device__ __forceinline__ int lds_byte(int r, int c) { const int st = (r >> 4) * 2 + (c >> 5), rr = r & 15, cc = c & 31, ob = rr * 64 + cc * 2; return st * 1024 + (ob ^ (((ob >> 9) & 1) << 5)); }
__host__ __device__ __forceinline__ void stage_rc(int b, int& R, int& C) { const int st = b / 1024, sb = b % 1024, swz = sb ^ (((sb >> 9) & 1) << 5); R = (st >> 1) * 16 + swz / 64; C = (st & 1) * 32 + (swz % 64) / 2; }
__host__ __device__ __forceinline__ int perm32(int rho) { const int n = rho >> 4, i = rho & 15; return 8 * (i >> 2) + 4 * n + (i & 3); }

struct Unit { int pm, pn; };
struct Gemm { const bf16_t* A; const bf16_t* Bt; int M, N, K; };

struct StaticOrder {
    int nM, nN, nwg, G, c;
    __host__ __device__ void init(int M, int N, int G_, int c_) { nM = M / BM; nN = N / BM; nwg = nM * nN; G = G_; c = c_; }
    __host__ __device__ bool next(int i, Unit& u) const {
        const long L = (long)i * G + c; if (L >= nwg) return false;
        int wgid = (int)L; { const int q = nwg / NXCD, r = nwg % NXCD, xcd = wgid % NXCD, off = wgid / NXCD; wgid = (xcd < r ? xcd * (q + 1) : r * (q + 1) + (xcd - r) * q) + off; }
        const int nig = WGM * nN, gid = wgid / nig, fm = gid * WGM, gsz = (nM - fm) < WGM ? (nM - fm) : WGM;
        u.pm = fm + ((wgid % nig) % gsz); u.pn = (wgid % nig) / gsz; return true;
    }
    __device__ __forceinline__ void a_ready(const Unit&) const {}
    __device__ __forceinline__ void done(const Unit&) const {}
};


__device__ __forceinline__ unsigned pk2_(float a, float b) { typedef float f2 __attribute__((ext_vector_type(2))); typedef __bf16 b2 __attribute__((ext_vector_type(2))); f2 f = {a, b}; b2 r = __builtin_convertvector(f, b2); return __builtin_bit_cast(unsigned, r); }
typedef unsigned u32x2_ __attribute__((ext_vector_type(2)));
typedef unsigned u32x4_ __attribute__((ext_vector_type(4)));
struct EpiStoreBf16 {
    static constexpr bool PERM = true, AFTER_DRAIN = false;
    bf16_t* O; int ldc;
    __device__ __forceinline__ void operator()(const f32x4 (&acc)[2][2][4][2], const Unit& u, int wr, int wc, int fr, int fq) const {
        int l_ = (int)(threadIdx.x & 63u); asm volatile("" : "+v"(l_));
        const int srca = ((l_ & 3) * 16 + (l_ >> 2)) * 4;
#pragma unroll
        for (int ai = 0; ai < 2; ++ai)
#pragma unroll
            for (int m = 0; m < 4; ++m) { char* rowp = (char*)O + ((unsigned)(u.pm * BM + ai * HALF + wr * 64 + m * 16 + (l_ >> 2)) * (unsigned)ldc + (unsigned)(u.pn * BM + wc * 32 + 8 * (l_ & 3))) * 2u;
#pragma unroll
                for (int bj = 0; bj < 2; ++bj) { const f32x4 v0 = acc[ai][bj][m][0], v1 = acc[ai][bj][m][1]; u32x4_ w;
                    w.x = (unsigned)__builtin_amdgcn_ds_bpermute(srca, (int)pk2_(v0[0], v0[1])); w.y = (unsigned)__builtin_amdgcn_ds_bpermute(srca, (int)pk2_(v0[2], v0[3]));
                    w.z = (unsigned)__builtin_amdgcn_ds_bpermute(srca, (int)pk2_(v1[0], v1[1])); w.w = (unsigned)__builtin_amdgcn_ds_bpermute(srca, (int)pk2_(v1[2], v1[3]));
                    *(u32x4_*)(rowp + bj * (HALF * 2)) = w; } }
    }
};
struct EpiPlainBf16 {
    static constexpr bool PERM = true, AFTER_DRAIN = false;
    bf16_t* O; int ldc;
    __device__ __forceinline__ void operator()(const f32x4 (&acc)[2][2][4][2], const Unit& u, int wr, int wc, int fr, int fq) const {
        { int l_ = (int)(threadIdx.x & 63u); asm volatile("" : "+v"(l_)); fr = l_ & 15; fq = l_ >> 4; }
#pragma unroll
        for (int ai = 0; ai < 2; ++ai)
#pragma unroll
            for (int m = 0; m < 4; ++m) { char* rowp = (char*)O + ((unsigned)(u.pm * BM + ai * HALF + wr * 64 + m * 16 + fr) * (unsigned)ldc + (unsigned)(u.pn * BM + wc * 32 + 8 * fq)) * 2u;
#pragma unroll
                for (int bj = 0; bj < 2; ++bj) { const f32x4 v0 = acc[ai][bj][m][0], v1 = acc[ai][bj][m][1]; u32x4_ w; w.x = pk2_(v0[0], v0[1]); w.y = pk2_(v0[2], v0[3]); w.z = pk2_(v1[0], v1[1]); w.w = pk2_(v1[2], v1[3]);
                    *(u32x4_*)(rowp + bj * (HALF * 2)) = w; } }
    }
};
struct EpiSwiglu {
    static constexpr bool PERM = false, AFTER_DRAIN = false;
    bf16_t* act;
    __device__ __forceinline__ void operator()(const f32x4 (&acc)[2][2][4][2], const Unit& u, int wr, int wc, int fr, int fq) const {
        int l_ = (int)(threadIdx.x & 63u); asm volatile("" : "+v"(l_));
        const int srca = ((l_ & 3) * 16 + (l_ >> 2)) * 4;
        bf16_t* dst = act + (wr * 64 + (l_ >> 2)) * 256 + u.pn * 128 + wc * 32 + 8 * (l_ & 3);
#pragma unroll
        for (int ai = 0; ai < 2; ++ai)
#pragma unroll
            for (int m = 0; m < 4; ++m) { float o[2][4];
#pragma unroll
                for (int bj = 0; bj < 2; ++bj) { const f32x4 gg = acc[ai][bj][m][0], uu = acc[ai][bj][m][1];
#pragma unroll
                    for (int e = 0; e < 4; ++e) o[bj][e] = gg[e] * __builtin_amdgcn_rcpf(1.0f + __builtin_amdgcn_exp2f(gg[e] * -1.44269504f)) * uu[e]; }
                u32x4_ w; w.x = (unsigned)__builtin_amdgcn_ds_bpermute(srca, (int)pk2_(o[0][0], o[0][1])); w.y = (unsigned)__builtin_amdgcn_ds_bpermute(srca, (int)pk2_(o[0][2], o[0][3]));
                w.z = (unsigned)__builtin_amdgcn_ds_bpermute(srca, (int)pk2_(o[1][0], o[1][1])); w.w = (unsigned)__builtin_amdgcn_ds_bpermute(srca, (int)pk2_(o[1][2], o[1][3]));
                *(u32x4_*)(dst + (ai * HALF + m * 16) * 256) = w; }
    }
};
struct EpiSlot {
    static constexpr bool PERM = true, AFTER_DRAIN = false;
    bf16_t* slot;
    __device__ __forceinline__ void operator()(const f32x4 (&acc)[2][2][4][2], const Unit& u, int wr, int wc, int fr, int fq) const {
        const int* rowslot = (const int*)(smem + 131072 + 4096); const float* roww = (const float*)(rowslot + 256);
        int l_ = (int)(threadIdx.x & 63u); asm volatile("" : "+v"(l_)); fr = l_ & 15;
        const int srca = ((l_ & 3) * 16 + (l_ >> 2)) * 4, drow = l_ >> 2;
        const unsigned colb = (unsigned)(u.pn * BM + wc * 32 + 8 * (l_ & 3)) * 2u;
#pragma unroll
        for (int ai = 0; ai < 2; ++ai)
#pragma unroll
            for (int m = 0; m < 4; ++m) { const int rb = ai * HALF + wr * 64 + m * 16; const float ww = roww[rb + fr]; const int srow = rowslot[rb + drow];
#pragma unroll
                for (int bj = 0; bj < 2; ++bj) { const f32x4 v0 = acc[ai][bj][m][0] * ww, v1 = acc[ai][bj][m][1] * ww; u32x4_ w;
                    w.x = (unsigned)__builtin_amdgcn_ds_bpermute(srca, (int)pk2_(v0[0], v0[1])); w.y = (unsigned)__builtin_amdgcn_ds_bpermute(srca, (int)pk2_(v0[2], v0[3]));
                    w.z = (unsigned)__builtin_amdgcn_ds_bpermute(srca, (int)pk2_(v1[0], v1[1])); w.w = (unsigned)__builtin_amdgcn_ds_bpermute(srca, (int)pk2_(v1[2], v1[3]));
                    if (srow >= 0) *(u32x4_*)((char*)slot + ((unsigned)srow * 2048u + colb + (unsigned)(bj * HALF * 2))) = w; } }
    }
};
struct EpiX2 {
    static constexpr bool PERM = true, AFTER_DRAIN = false;
    const float* x; float* out; const float* mod;
    __device__ __forceinline__ void operator()(const f32x4 (&acc)[2][2][4][2], const Unit& u, int wr, int wc, int fr, int fq) const {
        { int l_ = (int)(threadIdx.x & 63u); asm volatile("" : "+v"(l_)); fr = l_ & 15; fq = l_ >> 4; }
        float* ssq = (float*)(smem + 137216);
#pragma unroll
        for (int ai = 0; ai < 2; ++ai)
#pragma unroll
            for (int m = 0; m < 4; ++m) { const int rl = ai * HALF + wr * 64 + m * 16 + fr; const unsigned grow = (unsigned)(u.pm * BM + rl), c0 = (unsigned)(u.pn * BM + wc * 32 + 8 * fq); float sq = 0.f;
#pragma unroll
                for (int bj = 0; bj < 2; ++bj) { const unsigned c = c0 + (unsigned)(bj * HALF); const char* xp = (const char*)x + (grow * 1024u + c) * 4u;
                    const f32x4 x0 = *(const f32x4*)xp, x1 = *(const f32x4*)(xp + 16), g0 = *(const f32x4*)(mod + 2048 + c), g1 = *(const f32x4*)(mod + 2048 + c + 4);
                    const f32x4 o0 = x0 + g0 * acc[ai][bj][m][0], o1 = x1 + g1 * acc[ai][bj][m][1];
#pragma unroll
                    for (int e = 0; e < 4; ++e) sq += o0[e] * o0[e] + o1[e] * o1[e];
                    u32x4_ w; w.x = pk2_(o0[0], o0[1]); w.y = pk2_(o0[2], o0[3]); w.z = pk2_(o1[0], o1[1]); w.w = pk2_(o1[2], o1[3]);
                    *(u32x4_*)((char*)out + (grow * 4096u + 2048u + c * 2u)) = w; }
                sq += __shfl_xor(sq, 16); sq += __shfl_xor(sq, 32);
                if (fq == 0) atomicAdd(&ssq[rl], sq); }
    }
};
struct EpiRouterGu {
    static constexpr bool PERM = false, AFTER_DRAIN = false;
    float* scores; bf16_t* act;
    __device__ __forceinline__ void operator()(const f32x4 (&acc)[2][2][4][2], const Unit& u, int wr, int wc, int fr, int fq) const {
        { int l_ = (int)(threadIdx.x & 63u); asm volatile("" : "+v"(l_)); fr = l_ & 15; fq = l_ >> 4; }
        if (u.pn == 0) {
#pragma unroll
            for (int ai = 0; ai < 2; ++ai)
#pragma unroll
                for (int m = 0; m < 4; ++m) { float* sp = scores + ai * 32768 + wr * 64 + m * 16 + fr;
#pragma unroll
                    for (int bj = 0; bj < 2; ++bj)
#pragma unroll
                        for (int n = 0; n < 2; ++n) { const int col = bj * HALF + wc * 32 + n * 16 + 4 * fq;
#pragma unroll
                            for (int e = 0; e < 4; ++e) sp[(col + e) * 128] = __builtin_amdgcn_rcpf(1.0f + __builtin_amdgcn_exp2f(acc[ai][bj][m][n][e] * -1.44269504f)); } }
        } else {
#pragma unroll
            for (int ai = 0; ai < 2; ++ai)
#pragma unroll
                for (int m = 0; m < 4; ++m) { float o[2][4];
#pragma unroll
                    for (int bj = 0; bj < 2; ++bj) { const f32x4 gg = acc[ai][bj][m][0], uu = acc[ai][bj][m][1];
#pragma unroll
                        for (int e = 0; e < 4; ++e) o[bj][e] = gg[e] * __builtin_amdgcn_rcpf(1.0f + __builtin_amdgcn_exp2f(gg[e] * -1.44269504f)) * uu[e]; }
                    const int l_ = fq * 16 + fr, srca = ((l_ & 3) * 16 + (l_ >> 2)) * 4;
                    u32x4_ w; w.x = (unsigned)__builtin_amdgcn_ds_bpermute(srca, (int)pk2_(o[0][0], o[0][1])); w.y = (unsigned)__builtin_amdgcn_ds_bpermute(srca, (int)pk2_(o[0][2], o[0][3]));
                    w.z = (unsigned)__builtin_amdgcn_ds_bpermute(srca, (int)pk2_(o[1][0], o[1][1])); w.w = (unsigned)__builtin_amdgcn_ds_bpermute(srca, (int)pk2_(o[1][2], o[1][3]));
                    *(u32x4_*)(act + (ai * HALF + wr * 64 + m * 16 + (l_ >> 2)) * 256 + (u.pn - 1) * 128 + wc * 32 + 8 * (l_ & 3)) = w; }
        }
    }
};
struct EpiDown {
    static constexpr bool PERM = false, AFTER_DRAIN = false;
    float* out; const float* mod; int rowbase;
    __device__ __forceinline__ void operator()(const f32x4 (&acc)[2][2][4][2], const Unit& u, int wr, int wc, int fr, int fq) const {
        { int l_ = (int)(threadIdx.x & 63u); asm volatile("" : "+v"(l_)); fr = l_ & 15; fq = l_ >> 4; }
#pragma unroll
        for (int ai = 0; ai < 2; ++ai)
#pragma unroll
            for (int m = 0; m < 4; ++m) { const size_t ro = (size_t)(rowbase + ai * HALF + wr * 64 + m * 16 + fr) * 1024 + u.pn * BM + wc * 32 + 4 * fq;
#pragma unroll
                for (int bj = 0; bj < 2; ++bj)
#pragma unroll
                    for (int n = 0; n < 2; ++n) { const int co = bj * HALF + n * 16; const f32x4 xv = *(const f32x4*)(out + ro + co), gf = *(const f32x4*)(mod + 5120 + u.pn * BM + wc * 32 + 4 * fq + co);
                        *(f32x4*)(out + ro + co) = xv + gf * acc[ai][bj][m][n]; } }
    }
};
struct PanelOrder {
    int pm, nun;
    __device__ __forceinline__ bool next(int i, Unit& u) const { if (i >= nun) return false; int z = pm, pn = i; asm volatile("" : "+s"(z), "+s"(pn)); u.pm = z; u.pn = pn; return true; }
    __device__ __forceinline__ void a_ready(const Unit&) const {}
    __device__ __forceinline__ void done(const Unit&) const {}
};

template <class Epi, class Sched, bool ALIGN_EPI = false, bool SP2 = false, bool GATHER = false>
__device__ __forceinline__ void gemm_phase(PG8_LAS unsigned char* lds, const Gemm g, const Sched& S, const Epi& E, const unsigned (&gv)[2][2]) {
    int tid = threadIdx.x; asm volatile("" : "+v"(tid));
    const int wid = __builtin_amdgcn_readfirstlane(tid >> 6), lane = tid & 63, wr = wid >> 2, wc = wid & 3, fr = lane & 15, fq = lane >> 4;
    const int K = g.K, nt = K / BK;
    unsigned voffA[2], voffB[2];
#pragma unroll
    for (int i = 0; i < 2; ++i) { int R, C; stage_rc(tid * 16 + i * 8192, R, C); const int Rb = Epi::PERM ? ((R & ~31) + perm32(R & 31)) : R;
        voffA[i] = (unsigned)(R * K + C) * 2u; voffB[i] = (unsigned)(Rb * K + C) * 2u; }
    unsigned voffA0[2], voffA1[2];
#pragma unroll
    for (int i = 0; i < 2; ++i) { voffA0[i] = GATHER ? gv[0][i] : voffA[i]; voffA1[i] = GATHER ? gv[1][i] : 0u; }
    const size_t kstep = (size_t)(BK * 2);
    const size_t hstep = (size_t)HALF * K * 2;
    const size_t tstep = 2 * hstep;
    const unsigned ldsw = (unsigned)wid * 1024u;
    const int aoff = lds_byte(wr * 64 + fr, fq * 8), boff = lds_byte(wc * 32 + fr, fq * 8);
#define PG8_SA(b, h) (((b) * 2 + (h)) * HTB)
#define PG8_SB(b, h) ((4 + (b) * 2 + (h)) * HTB)
#define PG8_STAGE(bufoff, gbase, voff) do { _Pragma("unroll") for (int _i = 0; _i < 2; ++_i) \
        __builtin_amdgcn_global_load_lds((const unsigned*)((const char*)(gbase) + (voff)[_i]), (PG8_LAS unsigned*)(lds + (bufoff) + ldsw + _i * 8192), 16, 0, 0); } while (0)
#define PG8_LDA(dst, b, h) do { _Pragma("unroll") for (int m = 0; m < 4; ++m) _Pragma("unroll") for (int k = 0; k < 2; ++k) dst[m][k] = *(const PG8_LAS bf16x8*)(lds + PG8_SA(b, h) + aoff + m * 2048 + k * 1024); } while (0)
#define PG8_LDB(dst, b, h) do { _Pragma("unroll") for (int n = 0; n < 2; ++n) _Pragma("unroll") for (int k = 0; k < 2; ++k) dst[n][k] = *(const PG8_LAS bf16x8*)(lds + PG8_SB(b, h) + boff + n * 2048 + k * 1024); } while (0)
#define PG8_MMA(ai, bj, At, Bt) do { __builtin_amdgcn_s_setprio(1); _Pragma("unroll") for (int m = 0; m < 4; ++m) _Pragma("unroll") for (int n = 0; n < 2; ++n) _Pragma("unroll") for (int k = 0; k < 2; ++k) \
        acc[ai][bj][m][n] = __builtin_amdgcn_mfma_f32_16x16x32_bf16(Bt[n][k], At[m][k], acc[ai][bj][m][n], 0, 0, 0); __builtin_amdgcn_s_setprio(0); } while (0)
#define PG8_WAIT_V(n) asm volatile("s_waitcnt vmcnt(" #n ")" ::: "memory")
#define PG8_WAIT_L(n) asm volatile("s_waitcnt lgkmcnt(" #n ")" ::: "memory")
#define PG8_BAR __builtin_amdgcn_s_barrier()
#define PG8_SCHED __builtin_amdgcn_sched_barrier(0)
    Unit cur, nxt; int ui = 0;
    if (!S.next(0, cur)) return;
    f32x4 acc[2][2][4][2];
#pragma unroll
    for (int a = 0; a < 2; ++a)
#pragma unroll
        for (int b = 0; b < 2; ++b)
#pragma unroll
            for (int m = 0; m < 4; ++m)
#pragma unroll
                for (int n = 0; n < 2; ++n) acc[a][b][m][n] = (f32x4){0.f, 0.f, 0.f, 0.f};
    bf16x8 At[4][2], B0[2][2], B1[2][2];
    const char* cA = (const char*)g.A + (size_t)cur.pm * tstep; const char* cB = (const char*)g.Bt + (size_t)cur.pn * tstep;
    S.a_ready(cur);
    if constexpr (SP2) {
        PG8_STAGE(PG8_SB(0, 0), cB, voffB); PG8_STAGE(PG8_SB(0, 1), cB + hstep, voffB); PG8_STAGE(PG8_SA(0, 0), cA, voffA0); PG8_STAGE(PG8_SA(0, 1), (cA) + (GATHER ? (size_t)0 : hstep), GATHER ? voffA1 : voffA0);
        if (wr == 1) PG8_BAR;
        PG8_WAIT_V(2); PG8_BAR;
        PG8_STAGE(PG8_SB(1, 0), cB + kstep, voffB); PG8_STAGE(PG8_SA(1, 0), cA + kstep, voffA0); PG8_STAGE(PG8_SB(1, 1), cB + hstep + kstep, voffB);
        PG8_WAIT_V(6); PG8_BAR;
    } else {
        PG8_STAGE(PG8_SB(0, 0), cB, voffB); PG8_STAGE(PG8_SA(0, 0), cA, voffA0); PG8_STAGE(PG8_SB(0, 1), cB + hstep, voffB); PG8_STAGE(PG8_SA(0, 1), (cA) + (GATHER ? (size_t)0 : hstep), GATHER ? voffA1 : voffA0);
        if (wr == 1) PG8_BAR;
        PG8_WAIT_V(4); PG8_BAR;
        PG8_STAGE(PG8_SB(1, 0), cB + kstep, voffB); PG8_STAGE(PG8_SA(1, 0), cA + kstep, voffA0); PG8_STAGE(PG8_SB(1, 1), cB + hstep + kstep, voffB);
        PG8_WAIT_V(6); PG8_BAR;
    }
    for (;;) {
        const bool has_next = S.next(ui + 1, nxt);
        const char* nA = has_next ? (const char*)g.A + (size_t)nxt.pm * tstep : cA; const char* nB = has_next ? (const char*)g.Bt + (size_t)nxt.pn * tstep : cB;
        for (int t = 0; t < nt; t += 2) {
            const bool last = (t == nt - 2);
            const char* a1 = cA + (size_t)(t + 1) * kstep;
            const char* a2 = last ? nA : cA + (size_t)(t + 2) * kstep; const char* b2 = last ? nB : cB + (size_t)(t + 2) * kstep;
            const char* a3 = a2 + kstep; const char* b3 = b2 + kstep;
            if (last && has_next) S.a_ready(nxt);
            if constexpr (SP2) {
            PG8_LDB(B0, 0, 0); PG8_LDB(B1, 0, 1); PG8_SCHED; PG8_LDA(At, 0, 0); PG8_STAGE(PG8_SA(1, 1), (a1) + (GATHER ? (size_t)0 : hstep), GATHER ? voffA1 : voffA0);
            PG8_WAIT_V(8); PG8_WAIT_L(0); PG8_BAR; PG8_MMA(0, 0, At, B0); PG8_MMA(0, 1, At, B1); PG8_BAR; PG8_SCHED;
            PG8_LDA(At, 0, 1); PG8_STAGE(PG8_SB(0, 0), b2, voffB); PG8_STAGE(PG8_SB(0, 1), b2 + hstep, voffB); PG8_STAGE(PG8_SA(0, 0), a2, voffA0);
            PG8_WAIT_V(8); PG8_WAIT_L(0); PG8_BAR; PG8_MMA(1, 0, At, B0); PG8_MMA(1, 1, At, B1); PG8_BAR; PG8_SCHED;
            PG8_LDB(B0, 1, 0); PG8_LDB(B1, 1, 1); PG8_SCHED; PG8_LDA(At, 1, 0); PG8_STAGE(PG8_SA(0, 1), (a2) + (GATHER ? (size_t)0 : hstep), GATHER ? voffA1 : voffA0);
            PG8_WAIT_V(8); PG8_WAIT_L(0); PG8_BAR; PG8_MMA(0, 0, At, B0); PG8_MMA(0, 1, At, B1); PG8_BAR; PG8_SCHED;
            PG8_LDA(At, 1, 1); PG8_STAGE(PG8_SB(1, 0), b3, voffB); PG8_STAGE(PG8_SB(1, 1), b3 + hstep, voffB); PG8_STAGE(PG8_SA(1, 0), a3, voffA0);
            PG8_WAIT_V(8); PG8_WAIT_L(0); PG8_BAR; PG8_MMA(1, 0, At, B0); PG8_MMA(1, 1, At, B1); PG8_BAR; PG8_SCHED;
            } else {
            PG8_LDB(B0, 0, 0); PG8_SCHED; PG8_LDA(At, 0, 0); PG8_STAGE(PG8_SA(1, 1), (a1) + (GATHER ? (size_t)0 : hstep), GATHER ? voffA1 : voffA0);
            PG8_WAIT_L(8); PG8_BAR; PG8_WAIT_L(0); PG8_MMA(0, 0, At, B0); PG8_BAR; PG8_SCHED;
            PG8_LDB(B1, 0, 1); PG8_STAGE(PG8_SB(0, 0), b2, voffB);
            PG8_BAR; PG8_WAIT_L(0); PG8_MMA(0, 1, At, B1); PG8_BAR;
            PG8_LDA(At, 0, 1); PG8_STAGE(PG8_SA(0, 0), a2, voffA0);
            PG8_BAR; PG8_WAIT_L(0); PG8_MMA(1, 0, At, B0); PG8_BAR; PG8_SCHED;
            PG8_STAGE(PG8_SB(0, 1), b2 + hstep, voffB);
            PG8_WAIT_V(6); PG8_BAR; PG8_MMA(1, 1, At, B1); PG8_BAR;
            PG8_LDB(B0, 1, 0); PG8_SCHED; PG8_LDA(At, 1, 0); PG8_STAGE(PG8_SA(0, 1), (a2) + (GATHER ? (size_t)0 : hstep), GATHER ? voffA1 : voffA0);
            PG8_WAIT_L(8); PG8_BAR; PG8_WAIT_L(0); PG8_MMA(0, 0, At, B0); PG8_BAR; PG8_SCHED;
            PG8_LDB(B1, 1, 1); PG8_STAGE(PG8_SB(1, 0), b3, voffB);
            PG8_BAR; PG8_WAIT_L(0); PG8_MMA(0, 1, At, B1); PG8_BAR;
            PG8_LDA(At, 1, 1); PG8_STAGE(PG8_SA(1, 0), a3, voffA0);
            PG8_BAR; PG8_WAIT_L(0); PG8_MMA(1, 0, At, B0); PG8_BAR; PG8_SCHED;
            PG8_STAGE(PG8_SB(1, 1), b3 + hstep, voffB);
            PG8_WAIT_V(6); PG8_BAR; PG8_MMA(1, 1, At, B1); PG8_BAR;
            }
        }
        if constexpr (ALIGN_EPI) { if (wr == 0) PG8_BAR; }
        if constexpr (!Epi::AFTER_DRAIN) { E(acc, cur, wr, wc, fr, fq); S.done(cur); }
        if (!has_next) break;
#pragma unroll
        for (int a = 0; a < 2; ++a)
#pragma unroll
            for (int b = 0; b < 2; ++b)
#pragma unroll
                for (int m = 0; m < 4; ++m)
#pragma unroll
                    for (int n = 0; n < 2; ++n) acc[a][b][m][n] = (f32x4){0.f, 0.f, 0.f, 0.f};
        cur = nxt; cA = nA; cB = nB; ++ui;
        if constexpr (ALIGN_EPI) { if (wr == 1) PG8_BAR; }
    }
    PG8_WAIT_V(0);
    if constexpr (!ALIGN_EPI) { if (wr == 0) PG8_BAR; }
    PG8_BAR;
    if constexpr (Epi::AFTER_DRAIN) { E.fused(acc, cur, wr, wc, fr, fq, lds, wid, lane); S.done(cur); }
#undef PG8_SA
#undef PG8_SB
#undef PG8_STAGE
#undef PG8_LDA
#undef PG8_LDB
#undef PG8_MMA
#undef PG8_WAIT_V
#undef PG8_WAIT_L
#undef PG8_BAR
#undef PG8_SCHED
}
}

DI int map_win(int n) { return n < 384 ? n + 1696 : (n < 2080 ? n - 384 : (n < 2112 ? n : -1)); }
DI int map_gu16(int r) { const int pn = r >> 8, bj = (r >> 7) & 1, wc = (r >> 5) & 3, n = (r >> 4) & 1, fq = (r >> 2) & 3, e = r & 3; return (n ? 256 : 0) + 128 * pn + 32 * wc + 8 * fq + 4 * bj + e; }
DI int inv_gu16(int m) { const int n = m >> 8, a = m & 255, pn = a >> 7, wc = (a >> 5) & 3, fq = (a >> 3) & 3, bj = (a >> 2) & 1, e = a & 3; return 256 * pn + 128 * bj + 32 * wc + 16 * n + 4 * fq + e; }
DI int map_gu32(int n) { const int g32 = n >> 5, w = n & 31, a = g32 * 16 + (w & 15); return (w >> 4) ? 256 + a : a; }
DI int map_gu128(int n) { const int tile = n >> 7, w = n & 127, wc = w >> 6, j = (w >> 4) & 3, r = w & 15; const int a = tile * 64 + wc * 32 + (j >> 1) * 16 + r; return (j & 1) ? 256 + a : a; }
DI int map_gu(int n) { const int tile = n >> 8, w = n & 255, wc = w >> 7, j = (w >> 4) & 7, r = w & 15; const int a = tile * 128 + wc * 64 + (j >> 1) * 16 + r; return (j & 1) ? 256 + a : a; }

template <int MAP> DI void tconv_simple(const float* __restrict__ src, bf16_t* __restrict__ dst, int K, int Ns, int Nd, const float* __restrict__ scale, int gtid, int gthreads) {
    const int total = Nd * K;
    for (int idx = gtid; idx < total; idx += gthreads) {
        const int n = idx / K, k = idx - n * K;
        const int m = (MAP == 1) ? map_win(n) : (MAP == 2 ? map_gu(n) : (MAP == 3 ? map_gu16(n) : n));
        float v = 0.f;
        if (m >= 0) { v = src[(size_t)k * Ns + m]; if (scale) v *= scale[k]; }
        dst[idx] = f2bf(v);
    }
}
template <int MAP> DI void tconv_tiled(const float* __restrict__ src, bf16_t* __restrict__ dst, int E, int K, int N, float* ldsf, int bid, int G) {
    const int tk = K / 64, tn = N / 64, per = tk * tn, total = E * per;
    const int t = TID;
    for (int tile0 = 2 * bid; tile0 < total; tile0 += 2 * G) {
        float rg[2][16];
#pragma unroll
        for (int h = 0; h < 2; ++h) {
            const int tile = tile0 + h, e = tile / per, r = tile - e * per, kt = r / tn, nt = r - kt * tn;
            const float* s = src + (size_t)e * K * N + (size_t)(kt * 64) * N;
            const int nl = t & 63, n = nt * 64 + nl;
            const int m = n;
#pragma unroll
            for (int i = 0; i < 16; ++i) rg[h][i] = s[(size_t)((t >> 6) + 4 * i) * N + m];
        }
        __syncthreads();
#pragma unroll
        for (int h = 0; h < 2; ++h)
#pragma unroll
            for (int i = 0; i < 16; ++i) ldsf[h * 4160 + ((t >> 6) + 4 * i) * 65 + (t & 63)] = rg[h][i];
        __syncthreads();
#pragma unroll
        for (int h = 0; h < 2; ++h) {
            const int tile = tile0 + h, e = tile / per, r = tile - e * per, kt = r / tn, nt = r - kt * tn;
            const int kc = (t & 7) * 8;
#pragma unroll
            for (int ps = 0; ps < 2; ++ps) {
                const int nl = (t >> 3) + 32 * ps;
                unsigned w[4];
#pragma unroll
                for (int i = 0; i < 4; ++i) w[i] = pk2(ldsf[h * 4160 + (kc + 2 * i) * 65 + nl], ldsf[h * 4160 + (kc + 2 * i + 1) * 65 + nl]);
                *(u32x4*)(dst + (size_t)e * K * N + (size_t)(MAP == 2 ? inv_gu16(nt * 64 + nl) : nt * 64 + nl) * K + kt * 64 + kc) = mk4(w[0], w[1], w[2], w[3]);
            }
        }
    }
}
DI void phase0(const Params& p, unsigned char* lds, int bid, int G) {
    const int t = TID;
    float* ldsf = (float*)lds;
    for (int item = bid; item < 384; item += G) {
        __syncthreads();
        for (int i = t; i < NB * DM; i += 256) { const float v = p.c[i]; ldsf[(i & (DM - 1)) * NB + (i >> 10)] = v * sigmoidf_(v); }
        __syncthreads();
        const int col = item * 16 + (t & 15), kp = t >> 4;
        float a[NB];
#pragma unroll
        for (int b = 0; b < NB; ++b) a[b] = 0.f;
#pragma unroll 1
        for (int k0 = kp * 64; k0 < kp * 64 + 64; k0 += 8) {
            float w[8];
#pragma unroll
            for (int u = 0; u < 8; ++u) w[u] = p.ada_w[(size_t)(k0 + u) * 6144 + col];
#pragma unroll
            for (int u = 0; u < 8; ++u) {
#pragma unroll
                for (int q = 0; q < 4; ++q) { const f32x4 cv = *(const f32x4*)(ldsf + (k0 + u) * NB + 4 * q); a[4 * q] += cv[0] * w[u]; a[4 * q + 1] += cv[1] * w[u]; a[4 * q + 2] += cv[2] * w[u]; a[4 * q + 3] += cv[3] * w[u]; }
            }
        }
        __syncthreads();
#pragma unroll
        for (int b = 0; b < NB; ++b) ldsf[(kp * NB + b) * 16 + (t & 15)] = a[b];
        __syncthreads();
        {
            const int b = t >> 4, cl = t & 15; float sacc = 0.f;
#pragma unroll
            for (int q = 0; q < 16; ++q) sacc += ldsf[(q * NB + b) * 16 + cl];
            p.mod[b * 6144 + item * 16 + cl] = sacc + p.ada_b[item * 16 + cl];
        }
    }
    __syncthreads();
    const int gtid = bid * 256 + t, gth = G * 256;
    tconv_simple<1>(p.w_in, p.win_t, 1024, 2112, LDU, nullptr, gtid, gth);
    tconv_simple<0>(p.w_q_b, p.wq_t, 256, 768, 768, p.q_a_norm, gtid, gth);
    tconv_simple<0>(p.w_kv_b, p.wkv_t, 128, 1024, 1024, p.kv_a_norm, gtid, gth);
    tconv_simple<0>(p.decay_up, p.wdec_t, 32, 512, 512, nullptr, gtid, gth);
    tconv_simple<0>(p.iclr_up, p.wiclr_t, 32, 512, 512, nullptr, gtid, gth);
    tconv_simple<0>(p.gate_up, p.wgate_t, 96, 512, 512, nullptr, gtid, gth);
    tconv_simple<0>(p.w_out, p.wout_t, 1024, 1024, 1024, nullptr, gtid, gth);
    tconv_simple<0>(p.w_router, p.wr_t, 1024, 256, 256, nullptr, gtid, gth);
    tconv_simple<3>(p.w_sh_gu, p.wsgu_t, 1024, 512, 512, nullptr, gtid, gth);
    tconv_simple<0>(p.w_sh_d, p.wsd_t, 256, 1024, 1024, nullptr, gtid, gth);
    tconv_tiled<2>(p.w_e_gu, p.wegu_t, NEXP, 1024, 512, ldsf, bid, G);
    tconv_tiled<0>(p.w_e_d, p.wed_t, NEXP, 256, 1024, ldsf, bid, G);
}

DI void phase1(const Params& p, int bid, int G) {
    const int lane = TID & 63, gw = bid * 4 + (TID >> 6), nw = G * 4;
    for (int row0 = gw * 2; row0 < NTOK; row0 += nw * 2) {
        f32x4 v[2][4]; float ss[2] = {0.f, 0.f};
#pragma unroll
        for (int u = 0; u < 2; ++u)
#pragma unroll
            for (int i = 0; i < 4; ++i) v[u][i] = *(const f32x4*)(p.x + (size_t)(row0 + u) * DM + lane * 4 + 256 * i);
#pragma unroll
        for (int u = 0; u < 2; ++u) {
#pragma unroll
            for (int i = 0; i < 4; ++i) ss[u] += v[u][i][0] * v[u][i][0] + v[u][i][1] * v[u][i][1] + v[u][i][2] * v[u][i][2] + v[u][i][3] * v[u][i][3];
            ss[u] = wave_sum(ss[u]);
        }
        const float* mod = p.mod + (row0 >> 12) * 6144;
#pragma unroll
        for (int i = 0; i < 4; ++i) {
            const int c = lane * 4 + 256 * i;
            const f32x4 g = *(const f32x4*)(p.norm_mix + c), sh = *(const f32x4*)(mod + c), sc = *(const f32x4*)(mod + 1024 + c);
#pragma unroll
            for (int u = 0; u < 2; ++u) {
                const float rs = rsqrtf(ss[u] * (1.0f / DM) + 1e-6f);
                float o[4];
#pragma unroll
                for (int e = 0; e < 4; ++e) o[e] = v[u][i][e] * rs * g[e] * (1.0f + sc[e]) + sh[e];
                *(u32x2*)(p.H + (size_t)(row0 + u) * DM + c) = mk2(pk2(o[0], o[1]), pk2(o[2], o[3]));
            }
        }
    }
    const double invr = exp(-(double)(lane & 15) * (9.210340371976184 / 16.0)) * 0.15915494309189535;
    for (int idx = gw * 64 + lane; idx < NTOK * 16; idx += nw * 64) {
        const int row = idx >> 4;
        double rv = (double)p.positions[row] * invr;
        rv -= floor(rv);
        const float rf = (float)rv;
        p.rope[(size_t)row * 32 + (lane & 15)] = __builtin_amdgcn_cosf(rf);
        p.rope[(size_t)row * 32 + 16 + (lane & 15)] = __builtin_amdgcn_sinf(rf);
    }
}

DI void phase2_coop(const Params& p) {
    pg8::Gemm g{p.H, p.win_t, NTOK, LDU, DM};
    pg8::StaticOrder S; S.init(NTOK, LDU, (int)gridDim.x, (int)blockIdx.x);
    pg8::EpiStoreBf16 E{p.U, LDU};
    const unsigned nog[2][2] = {{0u, 0u}, {0u, 0u}};
    pg8::gemm_phase<pg8::EpiStoreBf16, pg8::StaticOrder, true, true, false>((PG8_LAS unsigned char*)smem, g, S, E, nog);
}

DI void unpack8(const u32x4 w, float (&f)[8]) { f[0] = lo2f(w.x); f[1] = hi2f(w.x); f[2] = lo2f(w.y); f[3] = hi2f(w.y); f[4] = lo2f(w.z); f[5] = hi2f(w.z); f[6] = lo2f(w.w); f[7] = hi2f(w.w); }
DI f32x4 unpack4(const u32x2 w) { return (f32x4){lo2f(w.x), hi2f(w.x), lo2f(w.y), hi2f(w.y)}; }
DI u32x2 pack4(const f32x4 v) { return mk2(pk2(v[0], v[1]), pk2(v[2], v[3])); }
DI f32x4 shifted4(const bf16_t* __restrict__ up, const bool has_prev, const f32x4 mu) {
    const f32x4 cur = unpack4(*(const u32x2*)up);
    f32x4 prev = (f32x4){0.f, 0.f, 0.f, 0.f};
    if (has_prev) prev = unpack4(*(const u32x2*)(up - LDU));
    return cur + (prev - cur) * mu;
}
template <int NP> DI void store_tile16(const u32x2 (&P)[2 * NP], bf16_t* rowp, const int rstride, const int lane) {
    const int r = lane & 15, rr = lane >> 3, jj = (lane >> 2) & 1, qd = lane & 3;
    bf16_t* base = rowp + (rr - r) * rstride + 16 * jj + 4 * qd;
#pragma unroll
    for (int hf = 0; hf < 2; ++hf) {
        const int src = (qd * 16 + rr + 8 * hf) * 4;
#pragma unroll
        for (int jp = 0; jp < NP; ++jp) {
            const unsigned a0 = (unsigned)__builtin_amdgcn_ds_bpermute(src, (int)P[2 * jp].x), a1 = (unsigned)__builtin_amdgcn_ds_bpermute(src, (int)P[2 * jp].y);
            const unsigned b0 = (unsigned)__builtin_amdgcn_ds_bpermute(src, (int)P[2 * jp + 1].x), b1 = (unsigned)__builtin_amdgcn_ds_bpermute(src, (int)P[2 * jp + 1].y);
            *(u32x2*)(base + 8 * hf * rstride + 32 * jp) = jj ? mk2(b0, b1) : mk2(a0, a1);
        }
    }
}
DI void head96_finish(f32x4 (&v)[6], const int q, const int r, const float* __restrict__ gain, const float* __restrict__ ropeRow, const float scale, bf16_t* __restrict__ dstRow) {
    float ss = 0.f;
#pragma unroll
    for (int j = 0; j < 6; ++j) ss += v[j][0] * v[j][0] + v[j][1] * v[j][1] + v[j][2] * v[j][2] + v[j][3] * v[j][3];
    ss += __shfl_xor(ss, 16); ss += __shfl_xor(ss, 32);
    const float rs = rsqrtf(ss * (1.0f / 96.0f) + 1e-6f);
#pragma unroll
    for (int j = 0; j < 6; ++j) v[j] = v[j] * rs * *(const f32x4*)(gain + j * 16 + q * 4);
    const f32x4 cs = *(const f32x4*)(ropeRow + q * 4), sn = *(const f32x4*)(ropeRow + 16 + q * 4);
    const f32x4 x1 = v[4], x2 = v[5];
    v[4] = x1 * cs - x2 * sn; v[5] = x2 * cs + x1 * sn;
    u32x2 P[6];
#pragma unroll
    for (int j = 0; j < 6; ++j) P[j] = pack4(v[j] * scale);
    store_tile16<3>(P, dstRow, 96, q * 16 + r);
}

DI void phase3(const Params& p, unsigned char* lds, int bid, int G) {
    const int t = TID;
    float* rstd_q = (float*)(lds + 69632);
    float* rstd_kv = rstd_q + 128;
    bf16_t* lora = (bf16_t*)(p.bscr + (size_t)bid * BSCR_PER_BLOCK + 131072);
    for (int rt = bid; rt < NTOK / 128; rt += G) {
        __syncthreads();
        {
            int tl = t; LAUNDER(tl);
            const int row = tl >> 1, half = tl & 1, grow = rt * 128 + row;
            const bf16_t* urow = p.U + (size_t)grow * LDU;
            float s = 0.f;
#pragma unroll
            for (int c = 0; c < 16; ++c) { float f[8]; unpack8(*(const u32x4*)(urow + UQ + half * 128 + c * 8), f);
#pragma unroll
                for (int e = 0; e < 8; ++e) s += f[e] * f[e]; }
            s += __shfl_xor(s, 1);
            float s2 = 0.f;
#pragma unroll
            for (int c = 0; c < 8; ++c) { float f[8]; unpack8(*(const u32x4*)(urow + UKV + half * 64 + c * 8), f);
#pragma unroll
                for (int e = 0; e < 8; ++e) s2 += f[e] * f[e]; }
            s2 += __shfl_xor(s2, 1);
            if (half == 0) { rstd_q[row] = rsqrtf(s * (1.0f / 256.0f) + 1e-6f); rstd_kv[row] = rsqrtf(s2 * (1.0f / 128.0f) + 1e-6f); }
        }
#pragma unroll 1
        for (int i = 0; i < 10; ++i) {
            int tl = t; LAUNDER(tl);
            const int c = tl + 256 * i, row = c / 20, chn = c - row * 20, grow = rt * 128 + row;
            const bf16_t* up = p.U + (size_t)grow * LDU + UXW + chn * 8;
            float cur[8], prv[8];
            unpack8(*(const u32x4*)up, cur);
            if ((grow & 4095) > 0) unpack8(*(const u32x4*)(up - LDU), prv);
            else {
#pragma unroll
                for (int e = 0; e < 8; ++e) prv[e] = 0.f; }
            const f32x4 m0 = *(const f32x4*)(p.rwkv_mu + 1536 + chn * 8), m1 = *(const f32x4*)(p.rwkv_mu + 1536 + chn * 8 + 4);
            float o[8];
#pragma unroll
            for (int e = 0; e < 8; ++e) {
                const float x = cur[e] + (prv[e] - cur[e]) * (e < 4 ? m0[e & 3] : m1[e & 3]);
                o[e] = chn < 4 ? 1.0f - 2.0f * sigmoidf_(-2.0f * x) : (chn < 8 ? x : sigmoidf_(x));
            }
            *(u32x4*)(lora + row * 160 + chn * 8) = mk4(pk2(o[0], o[1]), pk2(o[2], o[3]), pk2(o[4], o[5]), pk2(o[6], o[7]));
        }
        asm volatile("s_waitcnt vmcnt(0)" ::: "memory");
        __syncthreads();
        STAMP(17);
        {
            APlain ap{p.U + (size_t)rt * 128 * LDU + UQ, LDU};
            gemm_stream<2, 6, 4, 64, 6>(ap, p.wq_t, 256, 256, 8, [](int u, int& ao, int& bo) { ao = 0; bo = u * 96 * 256; },
                [&](const int h, f32x4 (&acc)[2][6]) {
                    int tl = t; LAUNDER(tl);
                    const int lane = tl & 63, w = tl >> 6, r = lane & 15, q = lane >> 4;
#pragma unroll
                    for (int i = 0; i < 2; ++i) {
                        const int row = 32 * w + 16 * i + r, grow = rt * 128 + row, b = grow >> 12, tt = grow & 4095;
                        const float rq = rstd_q[row];
                        f32x4 v[6];
#pragma unroll
                        for (int j = 0; j < 6; ++j) v[j] = acc[i][j] * rq;
                        head96_finish(v, q, r, p.q_norm, p.rope + (size_t)grow * 32, QSCALE, p.Q + ((size_t)(b * 8 + h) * NT_ + tt) * 96);
                    }
                }, lds);
        }
        STAMP(18);
        {
            APlain ap{p.U + (size_t)rt * 128 * LDU + UKV, LDU};
            gemm_stream<2, 8, 4, 64, 4>(ap, p.wkv_t, 128, 128, 8, [](int u, int& ao, int& bo) { ao = 0; bo = u * 128 * 128; },
                [&](const int h, f32x4 (&acc)[2][8]) {
                    int tl = t; LAUNDER(tl);
                    const int lane = tl & 63, w = tl >> 6, r = lane & 15, q = lane >> 4;
#pragma unroll
                    for (int i = 0; i < 2; ++i) {
                        const int row = 32 * w + 16 * i + r, grow = rt * 128 + row, b = grow >> 12, tt = grow & 4095;
                        const float rk = rstd_kv[row];
                        const bf16_t* urow = p.U + (size_t)grow * LDU;
                        f32x4 v[6];
#pragma unroll
                        for (int j = 0; j < 4; ++j) v[j] = acc[i][j] * rk;
                        v[4] = unpack4(*(const u32x2*)(urow + UPE + q * 4));
                        v[5] = unpack4(*(const u32x2*)(urow + UPE + 16 + q * 4));
                        head96_finish(v, q, r, p.k_norm, p.rope + (size_t)grow * 32, 1.0f, p.Kb + ((size_t)(b * 8 + h) * NT_ + tt) * 96);
                        const int tok0 = 32 * w + 16 * i + 4 * q;
                        const f32x4 rk4 = *(const f32x4*)(rstd_kv + tok0);
                        bf16_t* vd = p.Vt + ((size_t)((rt >> 5) * 8 + h) * 64) * NT_ + (rt & 31) * 128 + tok0;
#pragma unroll
                        for (int j = 4; j < 8; ++j) *(u32x2*)(vd + (size_t)((j - 4) * 16 + r) * NT_) = pack4(acc[i][j] * rk4);
                    }
                }, lds);
        }
        STAMP(19);
        bf16_t* abuf = (bf16_t*)(p.bscr + (size_t)bid * BSCR_PER_BLOCK);
        {
            APlain ap{lora, 160};
            gemm_stream<4, 4, 2, 32, 4>(ap, p.wdec_t, 32, 32, 4, [](int u, int& ao, int& bo) { ao = 0; bo = u * 128 * 32; },
                [&](const int ct, f32x4 (&acc)[4][4]) {
                    int tl = t; LAUNDER(tl);
                    const int lane = tl & 63, wid = tl >> 6, wr = wid >> 1, wc = wid & 1, r = lane & 15, q = lane >> 4, head = ct * 2 + wc;
#pragma unroll
                    for (int i = 0; i < 4; ++i) {
                        const int grow = rt * 128 + wr * 64 + i * 16 + r, b = grow >> 12, tt = grow & 4095;
                        u32x2 P[4];
#pragma unroll
                        for (int j = 0; j < 4; ++j) {
                            const f32x4 w0 = *(const f32x4*)(p.decay_w0 + head * 64 + j * 16 + q * 4);
                            f32x4 o;
#pragma unroll
                            for (int e = 0; e < 4; ++e) o[e] = 1.0f - __expf(-0.6065306597f * sigmoidf_(w0[e] + acc[i][j][e]));
                            P[j] = pack4(o);
                        }
                        store_tile16<2>(P, p.SC + ((size_t)(b * 8 + head) * NT_ + tt) * 384, 384, lane);
                    }
                }, lds);
        }
        {
            APlain ap{lora + 32, 160};
            gemm_stream<4, 4, 2, 32, 4>(ap, p.wiclr_t, 32, 32, 4, [](int u, int& ao, int& bo) { ao = 0; bo = u * 128 * 32; },
                [&](const int ct, f32x4 (&acc)[4][4]) {
                    int tl = t; LAUNDER(tl);
                    const int lane = tl & 63, wid = tl >> 6, wr = wid >> 1, wc = wid & 1, r = lane & 15, q = lane >> 4, c0 = ct * 128 + wc * 64 + q * 4;
#pragma unroll
                    for (int i = 0; i < 4; ++i) {
                        bf16_t* ar = abuf + (wr * 64 + i * 16 + r) * 512 + c0;
#pragma unroll
                        for (int j = 0; j < 4; ++j) {
                            const f32x4 a0 = *(const f32x4*)(p.iclr_a0 + c0 + j * 16);
                            f32x4 o;
#pragma unroll
                            for (int e = 0; e < 4; ++e) o[e] = sigmoidf_(a0[e] + acc[i][j][e]);
                            *(u32x2*)(ar + j * 16) = pack4(o);
                        }
                    }
                }, lds);
        }
        {
            APlain ap{lora + 64, 160};
            gemm_stream<4, 4, 2, 32, 4>(ap, p.wgate_t, 96, 96, 4, [](int u, int& ao, int& bo) { ao = 0; bo = u * 128 * 96; },
                [&](const int ct, f32x4 (&acc)[4][4]) {
                    int tl = t; LAUNDER(tl);
                    const int lane = tl & 63, wid = tl >> 6, wr = wid >> 1, wc = wid & 1, r = lane & 15, q = lane >> 4, head = ct * 2 + wc;
#pragma unroll
                    for (int i = 0; i < 4; ++i) {
                        const int grow = rt * 128 + wr * 64 + i * 16 + r;
                        u32x2 P[4];
#pragma unroll
                        for (int j = 0; j < 4; ++j) P[j] = pack4(acc[i][j]);
                        store_tile16<2>(P, p.Gg + (size_t)grow * 512 + head * 64, 512, lane);
                    }
                }, lds);
        }
        asm volatile("s_waitcnt vmcnt(0)" ::: "memory");
        __syncthreads();
#pragma unroll 1
        for (int it = 0; it < 16; ++it) {
            int tl = t; LAUNDER(tl);
            const int lane = tl & 63, w = tl >> 6, c8 = lane * 8;
#pragma unroll
            for (int u = 0; u < 2; ++u) {
                const int row = w + 4 * (it * 2 + u), grow = rt * 128 + row, b = grow >> 12, tt = grow & 4095;
                const bool hp = tt > 0;
                const bf16_t* urow = p.U + (size_t)grow * LDU + c8;
                float kc[8], kp_[8], vc[8], vp[8], rc[8], rp[8], av[8];
                unpack8(*(const u32x4*)(urow + UK), kc); unpack8(*(const u32x4*)(urow + UV), vc); unpack8(*(const u32x4*)(urow + UR), rc);
                unpack8(*(const u32x4*)(abuf + row * 512 + c8), av);
                if (hp) { unpack8(*(const u32x4*)(urow + UK - LDU), kp_); unpack8(*(const u32x4*)(urow + UV - LDU), vp); unpack8(*(const u32x4*)(urow + UR - LDU), rp); }
                else {
#pragma unroll
                    for (int e = 0; e < 8; ++e) { kp_[e] = 0.f; vp[e] = 0.f; rp[e] = 0.f; } }
                float mk[8], mv[8], mr[8], kkw[8], kaw[8];
                *(f32x4*)(mk) = *(const f32x4*)(p.rwkv_mu + 512 + c8); *(f32x4*)(mk + 4) = *(const f32x4*)(p.rwkv_mu + 512 + c8 + 4);
                *(f32x4*)(mv) = *(const f32x4*)(p.rwkv_mu + 1024 + c8); *(f32x4*)(mv + 4) = *(const f32x4*)(p.rwkv_mu + 1024 + c8 + 4);
                *(f32x4*)(mr) = *(const f32x4*)(p.rwkv_mu + c8); *(f32x4*)(mr + 4) = *(const f32x4*)(p.rwkv_mu + c8 + 4);
                *(f32x4*)(kkw) = *(const f32x4*)(p.k_k + c8); *(f32x4*)(kkw + 4) = *(const f32x4*)(p.k_k + c8 + 4);
                *(f32x4*)(kaw) = *(const f32x4*)(p.k_a + c8); *(f32x4*)(kaw + 4) = *(const f32x4*)(p.k_a + c8 + 4);
                float ks[8], kq[8], ssq = 0.f;
#pragma unroll
                for (int e = 0; e < 8; ++e) { ks[e] = kc[e] + (kp_[e] - kc[e]) * mk[e]; kq[e] = ks[e] * kkw[e]; ssq += kq[e] * kq[e]; }
                ssq = dpp_sum8(ssq);
                const float rn = rsqrtf(fmaxf(ssq, 1e-24f));
                float okk[8], obb[8], okp[8], ov[8], orr[8];
#pragma unroll
                for (int e = 0; e < 8; ++e) {
                    okk[e] = kq[e] * rn; obb[e] = av[e] * okk[e]; okp[e] = ks[e] * (1.0f + (av[e] - 1.0f) * kaw[e]);
                    ov[e] = vc[e] + (vp[e] - vc[e]) * mv[e]; orr[e] = rc[e] + (rp[e] - rc[e]) * mr[e];
                }
                {
                    float rkw[8];
                    *(f32x4*)(rkw) = *(const f32x4*)(p.r_k + c8); *(f32x4*)(rkw + 4) = *(const f32x4*)(p.r_k + c8 + 4);
                    float bn = 0.f;
#pragma unroll
                    for (int e = 0; e < 8; ++e) bn += orr[e] * okp[e] * rkw[e];
                    bn = dpp_sum8(bn);
                    if ((lane & 7) == 0) p.bonus[(size_t)grow * 8 + (lane >> 3)] = bn;
                }
                bf16_t* sc = p.SC + ((size_t)(b * 8 + (lane >> 3)) * NT_ + tt) * 384 + (lane & 7) * 8;
                *(u32x4*)(sc + 64) = mk4(pk2(okk[0], okk[1]), pk2(okk[2], okk[3]), pk2(okk[4], okk[5]), pk2(okk[6], okk[7]));
                *(u32x4*)(sc + 128) = mk4(pk2(obb[0], obb[1]), pk2(obb[2], obb[3]), pk2(obb[4], obb[5]), pk2(obb[6], obb[7]));
                *(u32x4*)(sc + 192) = mk4(pk2(okp[0], okp[1]), pk2(okp[2], okp[3]), pk2(okp[4], okp[5]), pk2(okp[6], okp[7]));
                *(u32x4*)(sc + 256) = mk4(pk2(ov[0], ov[1]), pk2(ov[2], ov[3]), pk2(ov[4], ov[5]), pk2(ov[6], ov[7]));
                *(u32x4*)(sc + 320) = mk4(pk2(orr[0], orr[1]), pk2(orr[2], orr[3]), pk2(orr[4], orr[5]), pk2(orr[6], orr[7]));
            }
        }
    }
}

struct ScanOps { f32x2_t d[4], k[4], b[4], p[4], r[4]; float v; };
DI void scan_load(ScanOps& o, const float* __restrict__ q, const float* __restrict__ vp) {
    const f32x4 d0 = *(const f32x4*)(q), d1 = *(const f32x4*)(q + 4), k0 = *(const f32x4*)(q + 64), k1 = *(const f32x4*)(q + 68);
    const f32x4 b0 = *(const f32x4*)(q + 128), b1 = *(const f32x4*)(q + 132), p0 = *(const f32x4*)(q + 192), p1 = *(const f32x4*)(q + 196);
    const f32x4 r0 = *(const f32x4*)(q + 320), r1 = *(const f32x4*)(q + 324);
    o.d[0] = (f32x2_t){d0[0], d0[1]}; o.d[1] = (f32x2_t){d0[2], d0[3]}; o.d[2] = (f32x2_t){d1[0], d1[1]}; o.d[3] = (f32x2_t){d1[2], d1[3]};
    o.k[0] = (f32x2_t){k0[0], k0[1]}; o.k[1] = (f32x2_t){k0[2], k0[3]}; o.k[2] = (f32x2_t){k1[0], k1[1]}; o.k[3] = (f32x2_t){k1[2], k1[3]};
    o.b[0] = (f32x2_t){b0[0], b0[1]}; o.b[1] = (f32x2_t){b0[2], b0[3]}; o.b[2] = (f32x2_t){b1[0], b1[1]}; o.b[3] = (f32x2_t){b1[2], b1[3]};
    o.p[0] = (f32x2_t){p0[0], p0[1]}; o.p[1] = (f32x2_t){p0[2], p0[3]}; o.p[2] = (f32x2_t){p1[0], p1[1]}; o.p[3] = (f32x2_t){p1[2], p1[3]};
    o.r[0] = (f32x2_t){r0[0], r0[1]}; o.r[1] = (f32x2_t){r0[2], r0[3]}; o.r[2] = (f32x2_t){r1[0], r1[1]}; o.r[3] = (f32x2_t){r1[2], r1[3]};
    o.v = *vp;
}
DI void scan_task(const Params& p, unsigned char* lds, const int task) {
    constexpr int CS = 16;
    const int t = TID, lane = t & 63, w = t >> 6;
    const int bh = task >> 1, hf = task & 1, b = bh >> 3, head = bh & 7;
    const int rloc = w * 8 + (lane >> 3), kseg = lane & 7;
    const int vrow = hf * 32 + rloc;
    float* stage = (float*)lds;
    float* ybuf = (float*)(lds + 49152);
    const bf16_t* src = p.SC + (size_t)bh * NT_ * 384;
    f32x2_t s2[4];
#pragma unroll
    for (int j = 0; j < 4; ++j) s2[j] = (f32x2_t){0.f, 0.f};
    u32x4 rg[3];
    __builtin_amdgcn_s_setprio(3);
    __syncthreads();
#pragma unroll
    for (int i = 0; i < 3; ++i) rg[i] = *(const u32x4*)(src + (size_t)(t + 256 * i) * 8);
#pragma unroll
    for (int i = 0; i < 3; ++i) { float* d = stage + (t + 256 * i) * 8;
        *(f32x4*)d = (f32x4){lo2f(rg[i].x), hi2f(rg[i].x), lo2f(rg[i].y), hi2f(rg[i].y)}; *(f32x4*)(d + 4) = (f32x4){lo2f(rg[i].z), hi2f(rg[i].z), lo2f(rg[i].w), hi2f(rg[i].w)}; }
    __syncthreads();
    constexpr int NCH = NT_ / CS;
    for (int c = 0; c < NCH; ++c) {
        const int cur = c & 1;
        if (c + 1 < NCH) {
#pragma unroll
            for (int i = 0; i < 3; ++i) rg[i] = *(const u32x4*)(src + (size_t)(c + 1) * CS * 384 + (size_t)(t + 256 * i) * 8);
        }
        if (c > 0) {
            const float* yb = ybuf + (cur ^ 1) * CS * 32;
            const int st = t >> 4, r2 = (t & 15) * 2;
            *(f32x2_t*)(p.yraw + ((size_t)(b * NT_ + (c - 1) * CS + st)) * 512 + head * 64 + hf * 32 + r2) = *(const f32x2_t*)(yb + st * 32 + r2);
        }
        const float* sb = stage + cur * CS * 384 + kseg * 8;
        float* yb = ybuf + cur * CS * 32;
        float yv[CS];
        ScanOps oc, on;
        scan_load(oc, sb, sb + 256 - kseg * 8 + vrow);
#pragma unroll
        for (int st = 0; st < CS; ++st) {
            if (st + 1 < CS) scan_load(on, sb + (st + 1) * 384, sb + (st + 1) * 384 + 256 - kseg * 8 + vrow);
            f32x2_t t0 = s2[0] * oc.k[0], t1 = s2[1] * oc.k[1];
            t0 = s2[2] * oc.k[2] + t0; t1 = s2[3] * oc.k[3] + t1;
            t0 = t0 + t1;
            float dot = dpp_sum8(t0.x + t0.y);
            const f32x2_t vv2 = {oc.v, oc.v}, nd2 = {-dot, -dot};
            f32x2_t u0, u1;
#pragma unroll
            for (int j = 0; j < 4; ++j) { f32x2_t tmp = s2[j] - s2[j] * oc.d[j]; tmp = vv2 * oc.p[j] + tmp; s2[j] = nd2 * oc.b[j] + tmp; }
            u0 = s2[0] * oc.r[0]; u1 = s2[1] * oc.r[1];
            u0 = s2[2] * oc.r[2] + u0; u1 = s2[3] * oc.r[3] + u1;
            u0 = u0 + u1;
            yv[st] = dpp_sum8(u0.x + u0.y);
            if (st + 1 < CS) oc = on;
        }
        if (kseg == 0) {
#pragma unroll
            for (int st = 0; st < CS; ++st) yb[st * 32 + rloc] = yv[st];
        }
        if (c + 1 < NCH) {
            float* dbase = stage + (cur ^ 1) * CS * 384;
#pragma unroll
            for (int i = 0; i < 3; ++i) { float* d = dbase + (t + 256 * i) * 8;
                *(f32x4*)d = (f32x4){lo2f(rg[i].x), hi2f(rg[i].x), lo2f(rg[i].y), hi2f(rg[i].y)}; *(f32x4*)(d + 4) = (f32x4){lo2f(rg[i].z), hi2f(rg[i].z), lo2f(rg[i].w), hi2f(rg[i].w)}; }
        }
        __syncthreads();
    }
    {
        const float* yb = ybuf + ((NCH - 1) & 1) * CS * 32;
        const int st = t >> 4, r2 = (t & 15) * 2;
        *(f32x2_t*)(p.yraw + ((size_t)(b * NT_ + (NCH - 1) * CS + st)) * 512 + head * 64 + hf * 32 + r2) = *(const f32x2_t*)(yb + st * 32 + r2);
    }
    __builtin_amdgcn_s_setprio(0);
}

DI void attn_item(const Params& p, unsigned char* lds, const int qt, const int bh) {
    constexpr int KROW = 208, VROW = 136, KB = 64 * KROW, BUF = KB + 64 * VROW;
    const int t = TID, lane = t & 63, w = t >> 6, l31 = lane & 31, h = lane >> 5;
    const bf16_t* Kg = p.Kb + (size_t)bh * NT_ * 96;
    const bf16_t* Vg = p.Vt + (size_t)bh * 64 * NT_;
    const int q = qt * 128 + w * 32 + l31;
    bf16x8 qf[6];
    {
        const bf16_t* qrow = p.Q + ((size_t)bh * NT_ + q) * 96 + 8 * h;
#pragma unroll
        for (int s = 0; s < 6; ++s) qf[s] = *(const bf16x8*)(qrow + 16 * s);
    }
    f32x16 O[2];
#pragma unroll
    for (int i = 0; i < 16; ++i) { O[0][i] = 0.f; O[1][i] = 0.f; }
    float m = -INFINITY, l = 0.f;
    f32x16 Mneg;
#pragma unroll
    for (int i = 0; i < 16; ++i) Mneg[i] = 0.f;
    const int njt = 2 * qt + 2;
    int koff[3], kgo[3], voff[2], vgo[2];
#pragma unroll
    for (int i = 0; i < 3; ++i) { const int c = t + 256 * i, r = c / 12, ch = c - r * 12; koff[i] = r * KROW + ch * 16; kgo[i] = r * 96 + ch * 8; }
#pragma unroll
    for (int i = 0; i < 2; ++i) { const int c = t + 256 * i, dv = c >> 3, ch = c & 7; voff[i] = KB + dv * VROW + ch * 16; vgo[i] = dv * NT_ + ch * 8; }
    u32x4 rk0[3], rv0[2], rk1[3], rv1[2];
#define AT_LOAD(RK, RV, J) { _Pragma("unroll") for (int i = 0; i < 3; ++i) RK[i] = *(const u32x4*)(Kg + (size_t)(J) * 64 * 96 + kgo[i]); \
                             _Pragma("unroll") for (int i = 0; i < 2; ++i) RV[i] = *(const u32x4*)(Vg + (J) * 64 + vgo[i]); }
#define AT_WRITE(RK, RV, BUFI) { unsigned char* nb = lds + (BUFI) * BUF; _Pragma("unroll") for (int i = 0; i < 3; ++i) *(u32x4*)(nb + koff[i]) = RK[i]; \
                             _Pragma("unroll") for (int i = 0; i < 2; ++i) { *(u32x2*)(nb + voff[i]) = mk2(RV[i].x, RV[i].y); *(u32x2*)(nb + voff[i] + 8) = mk2(RV[i].z, RV[i].w); } }
    auto tile_compute = [&](const int cur, const int j) {
        const bool active = (j * 64) <= (qt * 128 + w * 32 + 31);
        if (active) {
            const unsigned char* Kt = lds + cur * BUF;
            const unsigned char* Vtile = Kt + KB;
            f32x16 S[2];
            const bool first = (j == 0);
#pragma unroll
            for (int k2 = 0; k2 < 2; ++k2) {
#pragma unroll
                for (int s = 0; s < 6; ++s) {
                    const bf16x8 kf = *(const bf16x8*)(Kt + (k2 * 32 + l31) * KROW + s * 32 + h * 16);
                    if (s == 0) S[k2] = __builtin_amdgcn_mfma_f32_32x32x16_bf16(kf, qf[s], Mneg, 0, 0, 0);
                    else S[k2] = __builtin_amdgcn_mfma_f32_32x32x16_bf16(kf, qf[s], S[k2], 0, 0, 0);
                }
            }
            if (j >= 2 * qt) {
#pragma unroll
                for (int k2 = 0; k2 < 2; ++k2)
#pragma unroll
                    for (int i = 0; i < 16; ++i) { const int key = j * 64 + k2 * 32 + (i & 3) + 8 * (i >> 2) + 4 * h; if (key > q) S[k2][i] = -INFINITY; }
            }
            float mx = S[0][0];
#pragma unroll
            for (int i = 1; i < 16; ++i) mx = fmaxf(mx, S[0][i]);
#pragma unroll
            for (int i = 0; i < 16; ++i) mx = fmaxf(mx, S[1][i]);
            mx = fmaxf(mx, __shfl_xor(mx, 32));
            if (first || __any(mx > 0.f)) {
                const float mn = first ? mx : fmaxf(m, mx + m);
                const float alpha = __builtin_amdgcn_exp2f(m - mn);
                const float delta = first ? mn : mn - m;
                m = mn; l *= alpha;
#pragma unroll
                for (int i = 0; i < 16; ++i) { O[0][i] *= alpha; O[1][i] *= alpha; S[0][i] -= delta; S[1][i] -= delta; Mneg[i] = -mn; }
            }
            f32x2_t ps2 = {0.f, 0.f};
#pragma unroll
            for (int k2 = 0; k2 < 2; ++k2)
#pragma unroll
                for (int i = 0; i < 16; i += 2) {
                    const float e0 = __builtin_amdgcn_exp2f(S[k2][i]), e1 = __builtin_amdgcn_exp2f(S[k2][i + 1]);
                    S[k2][i] = e0; S[k2][i + 1] = e1; ps2 += (f32x2_t){e0, e1};
                }
            l += ps2.x + ps2.y;
#pragma unroll
            for (int k2 = 0; k2 < 2; ++k2)
#pragma unroll
                for (int s2 = 0; s2 < 2; ++s2) {
                    unsigned pw[4];
#pragma unroll
                    for (int e = 0; e < 4; ++e) pw[e] = pk2(S[k2][8 * s2 + 2 * e], S[k2][8 * s2 + 2 * e + 1]);
                    const bf16x8 pf = __builtin_bit_cast(bf16x8, mk4(pw[0], pw[1], pw[2], pw[3]));
#pragma unroll
                    for (int dt = 0; dt < 2; ++dt) {
                        const unsigned char* vp = Vtile + (dt * 32 + l31) * VROW + (k2 * 32 + s2 * 16 + 4 * h) * 2;
                        const u32x2 v0 = *(const u32x2*)(vp), v1 = *(const u32x2*)(vp + 16);
                        const bf16x8 vf = __builtin_bit_cast(bf16x8, mk4(v0.x, v0.y, v1.x, v1.y));
                        O[dt] = __builtin_amdgcn_mfma_f32_32x32x16_bf16(vf, pf, O[dt], 0, 0, 0);
                    }
                }
        }
    };
    AT_LOAD(rk0, rv0, 0)
    if (njt > 1) AT_LOAD(rk1, rv1, 1)
    __syncthreads();
    AT_WRITE(rk0, rv0, 0)
    if (njt > 2) AT_LOAD(rk0, rv0, 2)
    __syncthreads();
#pragma unroll 1
    for (int j = 0; j < njt; j += 2) {
        tile_compute(0, j);
        if (j + 1 < njt) { AT_WRITE(rk1, rv1, 1) if (j + 3 < njt) AT_LOAD(rk1, rv1, j + 3) }
        __syncthreads();
        if (j + 1 >= njt) break;
        tile_compute(1, j + 1);
        if (j + 2 < njt) { AT_WRITE(rk0, rv0, 0) if (j + 4 < njt) AT_LOAD(rk0, rv0, j + 4) }
        __syncthreads();
    }
#undef AT_LOAD
#undef AT_WRITE
    l += __shfl_xor(l, 32);
    const float inv = 1.0f / l;
    bf16_t* yrow = p.Y + ((size_t)((bh >> 3) * NT_ + q)) * DM + 512 + (bh & 7) * 64;
#pragma unroll
    for (int dt = 0; dt < 2; ++dt)
#pragma unroll
        for (int g = 0; g < 4; ++g)
            *(u32x2*)(yrow + dt * 32 + 8 * g + 4 * h) = mk2(pk2(O[dt][4 * g] * inv, O[dt][4 * g + 1] * inv), pk2(O[dt][4 * g + 2] * inv, O[dt][4 * g + 3] * inv));
}

constexpr int REC_BYTES = 12544;
typedef short s16x4 __attribute__((ext_vector_type(4)));
DI f32x4 mfma16(const s16x4 a, const s16x4 b, const f32x4 c) { return __builtin_amdgcn_mfma_f32_16x16x16bf16_1k(a, b, c, 0, 0, 0); }
DI s16x4 cvt4(const f32x4 v) { return __builtin_bit_cast(s16x4, mk2(pk2(v[0], v[1]), pk2(v[2], v[3]))); }
DI void scan_fused(const Params& p, unsigned char* lds, const int bh, const int hf) {
    int t = TID; LAUNDER(t);
    const int lane = t & 63, w = t >> 6, r = lane & 15, g = lane >> 4;
    const int b = bh >> 3, head = bh & 7;
    unsigned char* slot = lds + w * REC_BYTES;
    unsigned char* scr = lds + 4 * REC_BYTES + w * 5120;
    float* AT = (float*)(scr + 4096);
    const bf16_t* scbase = p.SC + (size_t)bh * NT_ * 384;
    f32x4 St[4];
#pragma unroll
    for (int m = 0; m < 4; ++m) St[m] = (f32x4){0.f, 0.f, 0.f, 0.f};
    u32x4 raw[12];
    {
        const u32x4* src = (const u32x4*)(scbase + (size_t)(4 * hf + w) * 16 * 384);
#pragma unroll
        for (int i = 0; i < 12; ++i) raw[i] = src[lane + 64 * i];
    }
    const int offk = (lane >> 4) * 512 + ((lane >> 2) & 3) * 128 + (lane & 3) * 2;
    const int offt = (lane >> 4) * 512 + (lane & 15) * 8;
    __builtin_amdgcn_s_setprio(3);
    __syncthreads();
#pragma unroll 1
    for (int rd = 0; rd < 32; ++rd) {
#pragma unroll
        for (int i = 0; i < 12; ++i) *(u32x4*)(slot + (lane + 64 * i) * 16) = raw[i];
        if (rd + 1 < 32) {
            const u32x4* src = (const u32x4*)(scbase + (size_t)(8 * (rd + 1) + 4 * hf + w) * 16 * 384);
#pragma unroll
            for (int i = 0; i < 12; ++i) raw[i] = src[lane + 64 * i];
        }
        {
            const bf16_t* rawl = (const bf16_t*)slot + lane;
            bf16_t vkap[16], vbet[16], vkt[16], vrt[16], vv[16];
            float L = 0.f, ex = 1.f;
#pragma unroll
            for (int j = 0; j < 16; ++j) {
                const float d = bf2f(rawl[j * 384]), kap = bf2f(rawl[j * 384 + 64]), bet = bf2f(rawl[j * 384 + 128]), kk = bf2f(rawl[j * 384 + 192]), rr = bf2f(rawl[j * 384 + 320]);
                vv[j] = rawl[j * 384 + 256];
                L += __logf(1.0f - d);
                const float el = __expf(L), ei = __expf(-L);
                vkap[j] = f2bf(kap * ex); vbet[j] = f2bf(bet * ei); vkt[j] = f2bf(kk * ei); vrt[j] = f2bf(rr * el);
                ex = el;
            }
            const float gam = ex;
#pragma unroll
            for (int j = 0; j < 16; ++j) {
                *(bf16_t*)(slot + offk + j * 8) = vkap[j];
                *(bf16_t*)(slot + 2048 + offk + j * 8) = vrt[j];
                *(bf16_t*)(slot + 4096 + offt + (j >> 2) * 128 + (j & 3) * 2) = vkt[j];
                *(bf16_t*)(slot + 6144 + offt + (j >> 2) * 128 + (j & 3) * 2) = (bf16_t)(vbet[j] ^ 0x8000u);
                *(bf16_t*)(scr + offk + j * 8) = vkt[j];
                *(bf16_t*)(scr + 2048 + offk + j * 8) = vbet[j];
            }
            unsigned vw[8];
#pragma unroll
            for (int i = 0; i < 8; ++i) vw[i] = (unsigned)vv[2 * i] | ((unsigned)vv[2 * i + 1] << 16);
            *(u32x4*)(slot + 10240 + lane * 32) = mk4(vw[0], vw[1], vw[2], vw[3]);
            *(u32x4*)(slot + 10240 + lane * 32 + 16) = mk4(vw[4], vw[5], vw[6], vw[7]);
            *(float*)(slot + 12288 + lane * 4) = gam;
        }
        {
            f32x4 dB = {0.f, 0.f, 0.f, 0.f}, dE = dB, dF = dB, dA = dB;
#pragma unroll
            for (int m = 0; m < 4; ++m) {
                const s16x4 fk = *(const s16x4*)(slot + m * 512 + lane * 8), fr = *(const s16x4*)(slot + 2048 + m * 512 + lane * 8);
                const s16x4 ft = *(const s16x4*)(scr + m * 512 + lane * 8), fb = *(const s16x4*)(scr + 2048 + m * 512 + lane * 8);
                dB = mfma16(ft, fk, dB); dE = mfma16(ft, fr, dE); dF = mfma16(fb, fr, dF); dA = mfma16(fb, fk, dA);
            }
            f32x4 oB, oE, oF;
#pragma unroll
            for (int jj = 0; jj < 4; ++jj) {
                const int i = 4 * g + jj;
                oB[jj] = i < r ? dB[jj] : 0.f; oE[jj] = i <= r ? dE[jj] : 0.f; oF[jj] = i <= r ? -dF[jj] : 0.f;
                AT[i * 16 + r] = i < r ? dA[jj] : 0.f;
            }
            *(s16x4*)(slot + 16 * 512 + lane * 8) = cvt4(oB);
            *(s16x4*)(slot + 18 * 512 + lane * 8) = cvt4(oE);
            *(s16x4*)(slot + 19 * 512 + lane * 8) = cvt4(oF);
            float T[16];
#pragma unroll
            for (int i = 15; i >= 0; --i) {
                float a0 = (i == r) ? 1.f : 0.f, a1 = 0.f;
#pragma unroll
                for (int q4 = (i + 1) >> 2; q4 < 4; ++q4) {
                    const f32x4 av = *(const f32x4*)(AT + i * 16 + q4 * 4);
#pragma unroll
                    for (int e = 0; e < 4; ++e) { const int m = q4 * 4 + e; if (m > i) { if (e & 1) a1 -= av[e] * T[m]; else a0 -= av[e] * T[m]; } }
                }
                T[i] = (i <= r) ? a0 + a1 : 0.f;
            }
            f32x4 oT;
#pragma unroll
            for (int jj = 0; jj < 4; ++jj) oT[jj] = g == 0 ? T[jj] : (g == 1 ? T[4 + jj] : (g == 2 ? T[8 + jj] : T[12 + jj]));
            *(s16x4*)(slot + 17 * 512 + lane * 8) = cvt4(oT);
        }
        __syncthreads();
        if (hf == 0)
#pragma unroll 2
        for (int cc = 0; cc < 8; ++cc) {
            const unsigned char* buf = smem + (cc >> 2) * LDS_BYTES + (cc & 3) * REC_BYTES;
            s16x4 fr[20];
#pragma unroll
            for (int f = 0; f < 20; ++f) fr[f] = *(const s16x4*)(buf + f * 512 + lane * 8);
            const s16x4 vf = *(const s16x4*)(buf + 10240 + (16 * w + r) * 32 + g * 8);
            s16x4 sb[4];
#pragma unroll
            for (int m = 0; m < 4; ++m) sb[m] = cvt4(St[m]);
            f32x4 X = {0.f, 0.f, 0.f, 0.f}, Yv = X;
#pragma unroll
            for (int m = 0; m < 4; ++m) { X = mfma16(fr[m], sb[m], X); Yv = mfma16(fr[4 + m], sb[m], Yv); }
            X = mfma16(fr[16], vf, X); Yv = mfma16(fr[18], vf, Yv);
            const s16x4 xb = cvt4(X);
            const f32x4 P = mfma16(fr[17], xb, (f32x4){0.f, 0.f, 0.f, 0.f});
            const s16x4 pb = cvt4(P);
            Yv = mfma16(fr[19], pb, Yv);
#pragma unroll
            for (int m = 0; m < 4; ++m) {
                St[m] = mfma16(fr[8 + m], vf, St[m]);
                St[m] = mfma16(fr[12 + m], pb, St[m]);
                St[m] = St[m] * *(const f32x4*)(buf + 12288 + (16 * m + 4 * g) * 4);
            }
            {
                float yv0 = Yv[0], yv1 = Yv[1], yv2 = Yv[2], yv3 = Yv[3];
                asm volatile("" : "+v"(yv0), "+v"(yv1), "+v"(yv2), "+v"(yv3));
                const bool odd = (r & 1) != 0;
                const float own0 = odd ? yv2 : yv0, own1 = odd ? yv3 : yv1, snd0 = odd ? yv0 : yv2, snd1 = odd ? yv1 : yv3;
                const float rcv0 = __builtin_bit_cast(float, __builtin_amdgcn_update_dpp(0, __builtin_bit_cast(int, snd0), 0xB1, 0xF, 0xF, false));
                const float rcv1 = __builtin_bit_cast(float, __builtin_amdgcn_update_dpp(0, __builtin_bit_cast(int, snd1), 0xB1, 0xF, 0xF, false));
                bf16_t* yo = (bf16_t*)p.yraw + ((size_t)(b * NT_ + (8 * rd + cc) * 16 + 4 * g + (odd ? 2 : 0))) * 512 + head * 64 + 16 * w + (r & ~1);
                *(unsigned*)(yo) = odd ? pk2(rcv0, own0) : pk2(own0, rcv0);
                *(unsigned*)(yo + 512) = odd ? pk2(rcv1, own1) : pk2(own1, rcv1);
            }
        }
        __syncthreads();
    }
    __builtin_amdgcn_s_setprio(0);
}

DI void phase4(const Params& p, unsigned char* lds, int bid, int G) {
#if SCAN_CHUNKED
    for (int bh = (int)blockIdx.x; bh < 128; bh += (int)gridDim.x) scan_fused(p, lds, bh, HALF_ID);
#else
    for (int task = bid; task < 256; task += G) scan_task(p, lds, task);
#endif
    STAMP(10);
    int* sh_pair = (int*)(smem + SH_PAIR_OFF);
    const int hq = (int)(xb_xcc_id() & 7u);
    int attempt = 0;
    for (;;) {
        const int qc = (hq + attempt) & 7;
        __syncthreads();
        if (threadIdx.x == 0) *sh_pair = (int)atomicAdd(&p.ctrl[CTRL_ATTNQ8 + qc * 64], 1u);
        __syncthreads();
        const int k = *sh_pair;
        if (k >= 256) { if (++attempt >= 8) break; continue; }
        attn_item(p, lds, 31 - (k & 31), 2 * (qc * 8 + (k >> 5)) + HALF_ID);
    }
}

DI void phase5(const Params& p, unsigned char* lds, int bid, int G) {
    float* tile = (float*)lds;
#define P5_SSQ ((float*)(smem + 137216) + HALF_ID * 128)
    float* biasl = (float*)(lds + 69632) + 128;
    int* lcnt = (int*)(smem + 65536);
    int* lbase = lcnt + 256;
    unsigned char* le = (unsigned char*)(lds + 65536 + 2048);
    unsigned char* lp = le + 1024;
    const unsigned nog[2][2] = {{0u, 0u}, {0u, 0u}};
    for (int rt = bid; rt < NTOK / 128; rt += G) {
        int bx = (int)blockIdx.x; asm volatile("" : "+s"(bx));
        unsigned char* pscr = p.bscr + (size_t)bx * 2 * BSCR_PER_BLOCK;
        float* scoresP = (float*)pscr;
        float* scores = scoresP + HALF_ID * 32768;
        bf16_t* actP = (bf16_t*)(pscr + 262144);
        const int b = rt >> 5;
        const float* mod = p.mod + b * 6144;
        __syncthreads();
        { const int t = TID;
        if (t < 128) P5_SSQ[t] = 0.f;
#pragma unroll 2
        for (int it = 0; it < 16; ++it) {
            int tl = t; LAUNDER(tl);
            const int pr = (tl >> 2) + 64 * it;
            const int row = pr >> 3, head = pr & 7, part = tl & 3, grow = rt * 128 + row, tt = grow & 4095;
            const int ch = head * 64 + part * 16;
            const bf16_t* yr = (const bf16_t*)((const char*)p.yraw + ((unsigned)grow * 512u + (unsigned)ch) * 2u);
            float y[16];
#pragma unroll
            for (int i = 0; i < 2; ++i) { const u32x4 v = *(const u32x4*)(yr + 8 * i);
                y[8 * i] = lo2f(v.x); y[8 * i + 1] = hi2f(v.x); y[8 * i + 2] = lo2f(v.y); y[8 * i + 3] = hi2f(v.y); y[8 * i + 4] = lo2f(v.z); y[8 * i + 5] = hi2f(v.z); y[8 * i + 6] = lo2f(v.w); y[8 * i + 7] = hi2f(v.w); }
            float sm = 0.f;
#pragma unroll
            for (int i = 0; i < 16; ++i) sm += y[i];
            sm += __shfl_xor(sm, 1); sm += __shfl_xor(sm, 2);
            const float mean = sm * (1.0f / 64.0f);
            float vr = 0.f;
#pragma unroll
            for (int i = 0; i < 16; ++i) { const float d = y[i] - mean; vr += d * d; }
            vr += __shfl_xor(vr, 1); vr += __shfl_xor(vr, 2);
            const float rs = rsqrtf(vr * (1.0f / 64.0f) + 64e-5f);
            const bf16_t* sc = (const bf16_t*)((const char*)p.SC + (((unsigned)(b * 8 + head) * NT_ + (unsigned)tt) * 384u + (unsigned)part * 16u) * 2u);
            float vv[16];
#pragma unroll
            for (int i = 0; i < 2; ++i) {
                const u32x4 c = *(const u32x4*)(sc + 256 + 8 * i);
                vv[8 * i] = lo2f(c.x); vv[8 * i + 1] = hi2f(c.x); vv[8 * i + 2] = lo2f(c.y); vv[8 * i + 3] = hi2f(c.y); vv[8 * i + 4] = lo2f(c.z); vv[8 * i + 5] = hi2f(c.z); vv[8 * i + 6] = lo2f(c.w); vv[8 * i + 7] = hi2f(c.w);
            }
            const float bn = p.bonus[(size_t)grow * 8 + head];
            const bf16_t* gg = p.Gg + (size_t)grow * 512 + ch;
            const u32x4 g0 = *(const u32x4*)(gg), g1 = *(const u32x4*)(gg + 8);
            float g[16] = {lo2f(g0.x), hi2f(g0.x), lo2f(g0.y), hi2f(g0.y), lo2f(g0.z), hi2f(g0.z), lo2f(g0.w), hi2f(g0.w), lo2f(g1.x), hi2f(g1.x), lo2f(g1.y), hi2f(g1.y), lo2f(g1.z), hi2f(g1.z), lo2f(g1.w), hi2f(g1.w)};
            float o[16];
#pragma unroll
            for (int i = 0; i < 16; ++i) o[i] = ((y[i] - mean) * rs * p.ln_w[ch + i] + p.ln_b[ch + i] + bn * vv[i]) * g[i];
            bf16_t* yd = p.Y + (size_t)grow * DM + ch;
            *(u32x4*)(yd) = mk4(pk2(o[0], o[1]), pk2(o[2], o[3]), pk2(o[4], o[5]), pk2(o[6], o[7]));
            *(u32x4*)(yd + 8) = mk4(pk2(o[8], o[9]), pk2(o[10], o[11]), pk2(o[12], o[13]), pk2(o[14], o[15]));
        }
        asm volatile("s_waitcnt vmcnt(0)" ::: "memory");
        __syncthreads();
        }
        STAMP(11);
        {
            pg8::Gemm g{p.Y, p.wout_t, NTOK, DM, DM};
            int nu = 4; asm volatile("" : "+s"(nu));
            pg8::PanelOrder S{(int)blockIdx.x, nu};
            pg8::EpiX2 E{p.x, p.out, mod};
            pg8::gemm_phase<pg8::EpiX2, pg8::PanelOrder, true, true, false>((PG8_LAS unsigned char*)smem, g, S, E, nog);
        }
        asm volatile("s_waitcnt vmcnt(0)" ::: "memory");
        __syncthreads();
        STAMP(12);
        { const int t = TID, lane = t & 63, wid = t >> 6; (void)t;
#pragma unroll 1
        for (int mg = 0; mg < 8; ++mg) {
            int ll = lane; LAUNDER(ll);
            f32x4 xv[4][4];
#pragma unroll
            for (int u = 0; u < 4; ++u)
#pragma unroll
                for (int i = 0; i < 4; ++i) xv[u][i] = unpack4(*(const u32x2*)((const char*)p.out + ((unsigned)(rt * 128 + wid + 4 * (mg * 4 + u)) * 4096u + 2048u + (unsigned)(ll * 4 + 256 * i) * 2u)));
#pragma unroll
            for (int u = 0; u < 4; ++u) {
                const int r = wid + 4 * (mg * 4 + u), grow = rt * 128 + r;
                const float rs = rsqrtf(P5_SSQ[r] * (1.0f / DM) + 1e-6f);
#pragma unroll
                for (int i = 0; i < 4; ++i) {
                    const int c = ll * 4 + 256 * i;
                    const f32x4 g = *(const f32x4*)(p.norm_ffn + c), sh = *(const f32x4*)(mod + 3072 + c), sc = *(const f32x4*)(mod + 4096 + c);
                    float o[4];
#pragma unroll
                    for (int e = 0; e < 4; ++e) o[e] = xv[u][i][e] * rs * g[e] * (1.0f + sc[e]) + sh[e];
                    *(u32x2*)(p.H + (size_t)grow * DM + c) = mk2(pk2(o[0], o[1]), pk2(o[2], o[3]));
                }
            }
        }
        asm volatile("s_waitcnt vmcnt(0)" ::: "memory");
        __syncthreads();
        }
        STAMP(13);
        {
            pg8::Gemm g{p.H, p.wr_t, NTOK, 768, DM};
            int nu = 3; asm volatile("" : "+s"(nu));
            pg8::PanelOrder S{(int)blockIdx.x, nu};
            pg8::EpiRouterGu E{scoresP, actP};
            pg8::gemm_phase<pg8::EpiRouterGu, pg8::PanelOrder, true, true, false>((PG8_LAS unsigned char*)smem, g, S, E, nog);
        }
        asm volatile("s_waitcnt vmcnt(0)" ::: "memory");
        __syncthreads();
        STAMP(14);
        { const int t = TID;
        biasl[t] = p.router_bias[t];
        lcnt[t] = 0;
#pragma unroll 1
        for (int hh = 0; hh < 2; ++hh) {
            __syncthreads();
            {
                int tl = t; LAUNDER(tl);
                f32x4 rgs[16];
#pragma unroll
                for (int i = 0; i < 16; ++i) { const int c = tl + 256 * i; rgs[i] = *(const f32x4*)(scores + (c >> 4) * 128 + hh * 64 + (c & 15) * 4); }
#pragma unroll
                for (int i = 0; i < 16; ++i) *(f32x4*)(tile + (tl + 256 * i) * 4) = rgs[i];
            }
            __syncthreads();
            if (t < 64) {
                int tl = t; LAUNDER(tl);
                const int token = rt * 128 + hh * 64 + tl;
                const float* sc = tile + tl;
                float gs[8];
#pragma unroll
                for (int g = 0; g < 8; ++g) {
                    float m1 = -INFINITY, m2 = -INFINITY;
#pragma unroll 8
                    for (int i = 0; i < 32; ++i) { const float v = sc[(g * 32 + i) * 64] + biasl[g * 32 + i]; m2 = fmaxf(m2, fminf(m1, v)); m1 = fmaxf(m1, v); }
                    gs[g] = m1 + m2;
                }
                unsigned selmask = 0u;
#pragma unroll
                for (int g = 0; g < 8; ++g) {
                    int rank = 0;
#pragma unroll
                    for (int g2 = 0; g2 < 8; ++g2) rank += (gs[g2] > gs[g] || (gs[g2] == gs[g] && g2 < g)) ? 1 : 0;
                    selmask |= (rank < 4 ? 1u : 0u) << g;
                }
                float tv[8]; int ti[8];
#pragma unroll
                for (int k = 0; k < 8; ++k) { tv[k] = -INFINITY; ti[k] = 0; }
#pragma unroll 1
                for (int j = 0; j < 4; ++j) {
                    const int g = __builtin_ctz(selmask); selmask &= selmask - 1u;
#pragma unroll 4
                    for (int i = 0; i < 32; ++i) {
                        int e = g * 32 + i;
                        float v = sc[e * 64] + biasl[e];
                        bool ins = false;
#pragma unroll
                        for (int k = 0; k < 8; ++k) {
                            ins = ins || (v > tv[k]);
                            const float tvk = tv[k]; const int tik = ti[k];
                            tv[k] = ins ? v : tvk; ti[k] = ins ? e : tik; v = ins ? tvk : v; e = ins ? tik : e;
                        }
                    }
                }
                float ws[8], wsum = 0.f;
#pragma unroll
                for (int k = 0; k < 8; ++k) { ws[k] = sc[ti[k] * 64]; wsum += ws[k]; }
                const float sc25 = 2.5f / wsum;
#pragma unroll
                for (int k = 0; k < 8; ++k) {
                    p.topk_w[token * 8 + k] = ws[k] * sc25;
                    le[(hh * 64 + tl) * 8 + k] = (unsigned char)ti[k];
                    lp[(hh * 64 + tl) * 8 + k] = (unsigned char)atomicAdd(&lcnt[ti[k]], 1);
                }
            }
        }
        __syncthreads();
        if (HALF_ID == 0) { const int c = lcnt[t]; lbase[t] = c > 0 ? (int)atomicAdd(&p.ctrl[CTRL_ECNT + t * ECNT_STRIDE], (unsigned)c) : 0; }
        __syncthreads();
#pragma unroll
        for (int i = 0; i < 4; ++i) {
            const int a = t + 256 * i, e = le[a];
            p.elist[(size_t)e * NTOK + lbase[e] + lp[a]] = (rt * 128) * 8 + a;
        }
        }
        STAMP(15);
        asm volatile("s_waitcnt vmcnt(0)" ::: "memory");
        __syncthreads();
        STAMP(16);
        {
            pg8::Gemm g{actP, p.wsd_t, 256, DM, 256};
            int nu = 4; asm volatile("" : "+s"(nu));
            pg8::PanelOrder S{0, nu};
            pg8::EpiPlainBf16 E{p.shslot + (size_t)bx * 256 * DM, DM};
            pg8::gemm_phase<pg8::EpiPlainBf16, pg8::PanelOrder, true, true, false>((PG8_LAS unsigned char*)smem, g, S, E, nog);
        }
    }
}

DI void phase6_coop(const Params& p) {
    const int tid0 = (int)threadIdx.x;
    int* cpre = (int*)(smem + 131072);
    int* tmp = cpre + 264;
    int* rowslot = (int*)(smem + 131072 + 4096);
    float* roww = (float*)(rowslot + 256);
    int* sh = (int*)(smem + SH_PAIR_OFF);
    bf16_t* act = (bf16_t*)(p.bscr + (size_t)blockIdx.x * 2 * BSCR_PER_BLOCK);
    __syncthreads();
    int* ebase = tmp + 256;
    int* wtot = ebase + 256;
    if (tid0 < 256) {
        const int c = (int)p.ctrl[CTRL_ECNT + tid0 * ECNT_STRIDE];
        tmp[tid0] = (c + 255) >> 8;
        int v = c;
#pragma unroll
        for (int d = 1; d < 64; d <<= 1) { const int o = __shfl_up(v, d); if ((tid0 & 63) >= d) v += o; }
        if ((tid0 & 63) == 63) wtot[tid0 >> 6] = v;
        ebase[tid0] = v - c;
    }
    __syncthreads();
    if (tid0 < 8) { int sacc = 0; for (int k = 0; k < 32; ++k) { cpre[tid0 * 33 + k] = sacc; sacc += tmp[8 * k + tid0]; } cpre[tid0 * 33 + 32] = sacc; }
    if (tid0 >= 64 && tid0 < 256) { int add = wtot[0]; if (tid0 >= 128) add += wtot[1]; if (tid0 >= 192) add += wtot[2]; ebase[tid0] += add; }
    __syncthreads();
    const int hq = (int)(xb_xcc_id() & 7u);
    int attempt = 0;
    for (;;) {
        const int qc = (hq + attempt) & 7;
        int tid = (int)threadIdx.x; LAUNDER(tid);
        __syncthreads();
        if (tid == 0) *sh = (int)atomicAdd(&p.ctrl[CTRL_Q6 + qc * 64], 1u);
        __syncthreads();
        const int idx = __builtin_amdgcn_readfirstlane(*sh);
        if (idx >= __builtin_amdgcn_readfirstlane(cpre[qc * 33 + 32])) { if (++attempt >= 8) break; continue; }
        int lo = 0, hi = 31;
        while (lo < hi) { const int mid = (lo + hi + 1) >> 1; if (__builtin_amdgcn_readfirstlane(cpre[qc * 33 + mid]) <= idx) lo = mid; else hi = mid - 1; }
        const int e = 8 * lo + qc, tl = idx - __builtin_amdgcn_readfirstlane(cpre[qc * 33 + lo]), cnt = __builtin_amdgcn_readfirstlane((int)p.ctrl[CTRL_ECNT + e * ECNT_STRIDE]);
        const int* el = p.elist + (size_t)e * NTOK + tl * 256;
        const int nvalid = cnt - tl * 256;
        const int pbase = __builtin_amdgcn_readfirstlane(ebase[e]) + tl * 256;
        if (tid < 256) {
            if (tid < nvalid) { const int ts = el[tid]; rowslot[tid] = pbase + tid; roww[tid] = p.topk_w[ts]; p.posmap[ts] = pbase + tid; }
            else { rowslot[tid] = -1; roww[tid] = 0.f; }
        }
        unsigned gv[2][2];
        {
            int tl2 = tid; LAUNDER(tl2);
#pragma unroll
            for (int i = 0; i < 2; ++i) {
                int R, C; pg8::stage_rc(tl2 * 16 + i * 8192, R, C);
#pragma unroll
                for (int h = 0; h < 2; ++h) { const int r = h * 128 + R; const int tok = r < nvalid ? (el[r] >> 3) : 0; gv[h][i] = (unsigned)tok * 2048u + (unsigned)C * 2u; }
            }
        }
        __syncthreads();
        {
            pg8::Gemm g{p.H, p.wegu_t + (size_t)e * 512 * DM, 256, 512, DM};
            int nu = 2; asm volatile("" : "+s"(nu));
            pg8::PanelOrder S{0, nu};
            pg8::EpiSwiglu E{act};
            pg8::gemm_phase<pg8::EpiSwiglu, pg8::PanelOrder, true, true, true>((PG8_LAS unsigned char*)smem, g, S, E, gv);
        }
        asm volatile("s_waitcnt vmcnt(0)" ::: "memory");
        __syncthreads();
        {
            pg8::Gemm g{act, p.wed_t + (size_t)e * 1024 * 256, 256, 1024, 256};
            int nu = 4; asm volatile("" : "+s"(nu));
            pg8::PanelOrder S{0, nu};
            pg8::EpiSlot E{p.slot};
            pg8::gemm_phase<pg8::EpiSlot, pg8::PanelOrder, true, true, false>((PG8_LAS unsigned char*)smem, g, S, E, gv);
        }
    }
}

DI void phase7(const Params& p, int bid, int G) {
    const int lane = TID & 63, gw = bid * 4 + (TID >> 6), nw = G * 4;
#pragma unroll 1
    for (int row0 = gw; row0 < NTOK; row0 += nw) {
        const int row = __builtin_amdgcn_readfirstlane(row0);
        const float* mod = p.mod + (row >> 12) * 6144 + 5120;
        int pos[8];
#pragma unroll
        for (int k = 0; k < 8; ++k) pos[k] = p.posmap[row * 8 + k];
        float s[2][8]; u32x4 xb[2];
#pragma unroll
        for (int i = 0; i < 2; ++i) {
            const int c = lane * 8 + 512 * i;
            xb[i] = *(const u32x4*)((const char*)p.out + ((unsigned)row * 4096u + 2048u + (unsigned)c * 2u));
            { const u32x4 w = *(const u32x4*)(p.shslot + (size_t)row * DM + c);
              s[i][0] = lo2f(w.x); s[i][1] = hi2f(w.x); s[i][2] = lo2f(w.y); s[i][3] = hi2f(w.y); s[i][4] = lo2f(w.z); s[i][5] = hi2f(w.z); s[i][6] = lo2f(w.w); s[i][7] = hi2f(w.w); }
#pragma unroll
            for (int k = 0; k < 8; ++k) {
                const u32x4 w = *(const u32x4*)(p.slot + (size_t)pos[k] * DM + c);
                s[i][0] += lo2f(w.x); s[i][1] += hi2f(w.x); s[i][2] += lo2f(w.y); s[i][3] += hi2f(w.y); s[i][4] += lo2f(w.z); s[i][5] += hi2f(w.z); s[i][6] += lo2f(w.w); s[i][7] += hi2f(w.w);
            }
        }
        asm volatile("s_waitcnt vmcnt(0)" ::: "memory");
#pragma unroll
        for (int i = 0; i < 2; ++i) {
            const int c = lane * 8 + 512 * i;
            const float x2[8] = {lo2f(xb[i].x), hi2f(xb[i].x), lo2f(xb[i].y), hi2f(xb[i].y), lo2f(xb[i].z), hi2f(xb[i].z), lo2f(xb[i].w), hi2f(xb[i].w)};
#pragma unroll
            for (int h = 0; h < 2; ++h) {
                const f32x4 gf = *(const f32x4*)(mod + c + 4 * h);
                f32x4 o;
#pragma unroll
                for (int e = 0; e < 4; ++e) o[e] = x2[4 * h + e] + gf[e] * s[i][4 * h + e];
                *(f32x4*)(p.out + (size_t)row * DM + c + 4 * h) = o;
            }
        }
    }
}

template <int PH> DI void run_phase(const Params& p, unsigned char* lds, int bid, int G) {
    if (PH == 0) phase0(p, lds, bid, G);
    if (PH == 1) phase1(p, bid, G);
    if (PH == 3) phase3(p, lds, bid, G);
    if (PH == 4) phase4(p, lds, bid, G);
    if (PH == 5) phase5(p, lds, bid, G);
    if (PH == 7) phase7(p, bid, G);
}

#if !ONE_LAUNCH
template <int PH> __global__ void __launch_bounds__(256, 2) phase_kernel(Params p) { run_phase<PH>(p, smem, blockIdx.x, gridDim.x); }
#endif

#if ONE_LAUNCH
__global__ void __launch_bounds__(512, 2) mega_kernel(Params p) {
    volatile LAS unsigned* st = (volatile LAS unsigned*)(smem + 2 * LDS_BYTES);
    if (threadIdx.x == 0) { st[0] = 0u; st[1] = 0u; st[2] = 0u; st[3] = 0u; }
    __syncthreads();
    XcdBarrier bar = xcd_barrier_post(p.ctrl, st);
    const int bid = blockIdx.x * 2 + HALF_ID, G = gridDim.x * 2;
    unsigned char* const lds_half = smem + HALF_ID * LDS_BYTES;
    STAMP(0);
    run_phase<0>(p, lds_half, bid, G); xcd_barrier(bar); STAMP(1);
    run_phase<1>(p, lds_half, bid, G); xcd_barrier(bar); STAMP(2);
    phase2_coop(p); xcd_barrier(bar); STAMP(3);
    run_phase<3>(p, lds_half, bid, G); xcd_barrier(bar); STAMP(4);
    run_phase<4>(p, lds_half, bid, G); xcd_barrier(bar); STAMP(5);
    run_phase<5>(p, lds_half, bid, G); xcd_barrier(bar); STAMP(6);
    phase6_coop(p); xcd_barrier(bar); STAMP(7);
    run_phase<7>(p, lds_half, bid, G);
#ifdef PROBE_A
    xcd_barrier(bar); STAMP(8);
    xcd_barrier(bar);
    {
        const unsigned long long* sp = (const unsigned long long*)(p.ctrl + CTRL_STAMP);
        const unsigned long long ta = __hip_atomic_load(sp + PROBE_A, __ATOMIC_RELAXED, __HIP_MEMORY_SCOPE_AGENT), tb = __hip_atomic_load(sp + PROBE_B, __ATOMIC_RELAXED, __HIP_MEMORY_SCOPE_AGENT);
        const unsigned long long t0 = __builtin_amdgcn_s_memrealtime();
        while (__builtin_amdgcn_s_memrealtime() - t0 < tb - ta) __builtin_amdgcn_s_sleep(8);
    }
#endif
}
#define OCC_KERNEL mega_kernel
#else
#define OCC_KERNEL phase_kernel<5>
#endif

static inline size_t al256(size_t x) { return (x + 255) & ~(size_t)255; }

extern "C" void kernel_launch(void* const* d_in, const int* in_sizes, int n_in, void* d_out, int out_size, void* d_ws, size_t ws_size, hipStream_t stream) {
    (void)in_sizes; (void)n_in; (void)out_size;
    Params p{};
    p.x = (const float*)d_in[0]; p.c = (const float*)d_in[1]; p.positions = (const int*)d_in[2]; p.ada_w = (const float*)d_in[3]; p.ada_b = (const float*)d_in[4];
    p.norm_mix = (const float*)d_in[5]; p.w_in = (const float*)d_in[6]; p.rwkv_mu = (const float*)d_in[7]; p.decay_w0 = (const float*)d_in[8]; p.decay_up = (const float*)d_in[9];
    p.iclr_a0 = (const float*)d_in[10]; p.iclr_up = (const float*)d_in[11]; p.gate_up = (const float*)d_in[12]; p.k_k = (const float*)d_in[13]; p.k_a = (const float*)d_in[14];
    p.r_k = (const float*)d_in[15]; p.ln_w = (const float*)d_in[16]; p.ln_b = (const float*)d_in[17]; p.q_a_norm = (const float*)d_in[18]; p.w_q_b = (const float*)d_in[19];
    p.kv_a_norm = (const float*)d_in[20]; p.w_kv_b = (const float*)d_in[21]; p.q_norm = (const float*)d_in[22]; p.k_norm = (const float*)d_in[23]; p.w_out = (const float*)d_in[24];
    p.norm_ffn = (const float*)d_in[25]; p.w_router = (const float*)d_in[26]; p.router_bias = (const float*)d_in[27]; p.w_e_gu = (const float*)d_in[28]; p.w_e_d = (const float*)d_in[29];
    p.w_sh_gu = (const float*)d_in[30]; p.w_sh_d = (const float*)d_in[31];
    p.out = (float*)d_out;

    constexpr int DYN_LDS = 2 * LDS_BYTES + 64;
    static int grid = 0;
    if (!grid) {
        int dev = 0, cus = 0, per_cu = 0;
        (void)hipGetDevice(&dev);
        (void)hipDeviceGetAttribute(&cus, hipDeviceAttributeMultiprocessorCount, dev);
#if ONE_LAUNCH
        (void)hipFuncSetAttribute((const void*)mega_kernel, hipFuncAttributeMaxDynamicSharedMemorySize, DYN_LDS);
#endif
#if !ONE_LAUNCH
        (void)hipFuncSetAttribute((const void*)phase_kernel<0>, hipFuncAttributeMaxDynamicSharedMemorySize, LDS_BYTES);
#endif
#if !ONE_LAUNCH
        (void)hipFuncSetAttribute((const void*)phase_kernel<1>, hipFuncAttributeMaxDynamicSharedMemorySize, LDS_BYTES);
#endif
#if !ONE_LAUNCH
        (void)hipFuncSetAttribute((const void*)phase_kernel<2>, hipFuncAttributeMaxDynamicSharedMemorySize, LDS_BYTES);
#endif
#if !ONE_LAUNCH
        (void)hipFuncSetAttribute((const void*)phase_kernel<3>, hipFuncAttributeMaxDynamicSharedMemorySize, LDS_BYTES);
#endif
#if !ONE_LAUNCH
        (void)hipFuncSetAttribute((const void*)phase_kernel<4>, hipFuncAttributeMaxDynamicSharedMemorySize, LDS_BYTES);
#endif
#if !ONE_LAUNCH
        (void)hipFuncSetAttribute((const void*)phase_kernel<5>, hipFuncAttributeMaxDynamicSharedMemorySize, LDS_BYTES);
#endif
#if !ONE_LAUNCH
        (void)hipFuncSetAttribute((const void*)phase_kernel<6>, hipFuncAttributeMaxDynamicSharedMemorySize, LDS_BYTES);
#endif
#if !ONE_LAUNCH
        (void)hipFuncSetAttribute((const void*)phase_kernel<7>, hipFuncAttributeMaxDynamicSharedMemorySize, LDS_BYTES);
#endif
        (void)hipOccupancyMaxActiveBlocksPerMultiprocessor(&per_cu, (const void*)OCC_KERNEL, 512, DYN_LDS);
        if (cus <= 0) cus = 256;
        if (per_cu < 1) per_cu = 1;
        grid = cus;
    }
    unsigned char* w = (unsigned char*)d_ws; size_t o = 0;
    auto take = [&](size_t bytes) { unsigned char* r = w + o; o = al256(o + bytes); return r; };
    p.ctrl = (unsigned*)take(CTRL_WORDS * 4);
    p.mod = (float*)take((size_t)NB * 6144 * 4);
    p.rope = (float*)take((size_t)NTOK * 32 * 4);
    p.win_t = (bf16_t*)take((size_t)LDU * 1024 * 2);
    p.wq_t = (bf16_t*)take((size_t)768 * 256 * 2);
    p.wkv_t = (bf16_t*)take((size_t)1024 * 128 * 2);
    p.wdec_t = (bf16_t*)take((size_t)512 * 32 * 2);
    p.wiclr_t = (bf16_t*)take((size_t)512 * 32 * 2);
    p.wgate_t = (bf16_t*)take((size_t)512 * 96 * 2);
    p.wout_t = (bf16_t*)take((size_t)1024 * 1024 * 2);
    p.wr_t = (bf16_t*)take((size_t)256 * 1024 * 2);
    p.wsgu_t = (bf16_t*)take((size_t)512 * 1024 * 2);
    p.wsd_t = (bf16_t*)take((size_t)1024 * 256 * 2);
    p.wegu_t = (bf16_t*)take((size_t)NEXP * 512 * 1024 * 2);
    p.wed_t = (bf16_t*)take((size_t)NEXP * 1024 * 256 * 2);
    p.H = (bf16_t*)take((size_t)NTOK * DM * 2);
    p.posmap = (int*)take((size_t)NTOK * 8 * 4);
    p.topk_w = (float*)take((size_t)NTOK * 8 * 4);
    p.bonus = (float*)take((size_t)NTOK * 8 * 4);
    p.elist = (int*)take((size_t)NEXP * NTOK * 4);
    p.bscr = take((size_t)grid * 2 * BSCR_PER_BLOCK);
    const size_t ov = o;
    p.U = (bf16_t*)take((size_t)NTOK * LDU * 2);
    p.Q = (bf16_t*)take((size_t)NTOK * 8 * 96 * 2);
    p.Kb = (bf16_t*)take((size_t)NTOK * 8 * 96 * 2);
    p.Vt = (bf16_t*)take((size_t)NTOK * 8 * 64 * 2);
    p.SC = (bf16_t*)take((size_t)NTOK * 8 * 384 * 2);
    p.Gg = (bf16_t*)take((size_t)NTOK * 512 * 2);
    p.yraw = (float*)take((size_t)NTOK * 512 * 4);
    p.Y = (bf16_t*)take((size_t)NTOK * DM * 2);
    p.shslot = (bf16_t*)(w + ov);
    p.slot = (bf16_t*)(w + ov + (size_t)NTOK * DM * 2);
    const size_t need_slot = ov + (size_t)NTOK * 9 * DM * 2;
    if (o > ws_size || need_slot > ws_size) { fprintf(stderr, "workspace too small: need %zu / %zu, have %zu\n", o, need_slot, ws_size); return; }

    (void)hipMemsetAsync(p.ctrl, 0, CTRL_WORDS * 4, stream);
#if ONE_LAUNCH
    hipLaunchKernelGGL(mega_kernel, dim3(grid), dim3(512), DYN_LDS, stream, p);
#else
    hipLaunchKernelGGL(phase_kernel<0>, dim3(grid), dim3(256), LDS_BYTES, stream, p);
    hipLaunchKernelGGL(phase_kernel<1>, dim3(grid), dim3(256), LDS_BYTES, stream, p);
    hipLaunchKernelGGL(phase_kernel<2>, dim3(grid), dim3(256), LDS_BYTES, stream, p);
    hipLaunchKernelGGL(phase_kernel<3>, dim3(grid), dim3(256), LDS_BYTES, stream, p);
    hipLaunchKernelGGL(phase_kernel<4>, dim3(grid), dim3(256), LDS_BYTES, stream, p);
    hipLaunchKernelGGL(phase_kernel<5>, dim3(grid), dim3(256), LDS_BYTES, stream, p);
    hipLaunchKernelGGL(phase_kernel<6>, dim3(grid), dim3(256), LDS_BYTES, stream, p);
    hipLaunchKernelGGL(phase_kernel<7>, dim3(grid), dim3(256), LDS_BYTES, stream, p);
#endif
}
```
